# Optimizing an MI355X kernel written in HIP

```python
import jax, jax.numpy as jnp
from jax import lax
import numpy as np

D_MODEL = 1024
BATCH = 4
SEQ = 4096
DEPTH = 4

CHUNK = 64
N_MEM = 256
D_FF = 2816
NORM_EPS = 1e-6
RWKV_HEADS = 8
RWKV_HEAD_DIM = 64
RWKV_WIDTH = RWKV_HEADS * RWKV_HEAD_DIM
DECAY_LORA = 64
AAA_LORA = 64
MV_LORA = 32
GATE_LORA = 128
RWKV_LN_EPS = 64e-5
GLA_HEADS = 4
GLA_DK = 64
GLA_DV = 128
GLA_KW = GLA_HEADS * GLA_DK
GLA_VW = GLA_HEADS * GLA_DV
GLA_GATE_LORA = 16
GLA_TAU = 16.0
CONV_WIDTH = 4
XA_HEADS = 4
XA_HEAD_DIM = 128
XA_WIDTH = XA_HEADS * XA_HEAD_DIM
N_BRANCH = 3
BRANCH_WIDTH = 512
RWKV_COLS = 3 * RWKV_WIDTH + DECAY_LORA + AAA_LORA + GATE_LORA
GLA_QKV_COLS = 2 * GLA_KW + GLA_VW
GLA_COLS = GLA_QKV_COLS + GLA_GATE_LORA + GLA_VW
GATE_COLS = N_BRANCH * D_MODEL
W_IN_COLS = RWKV_COLS + GLA_COLS + XA_WIDTH + GATE_COLS

kernel_name = 'hybrid_rwkv7_gla_memattn_macaron'


def split_cols(t, sizes):
    idx = np.cumsum(sizes)[:-1].tolist()
    return jnp.split(t, idx, axis=-1)


def rmsnorm(x, g):
    xf = x.astype(jnp.float32)
    y = xf * lax.rsqrt(jnp.mean(xf * xf, axis=-1, keepdims=True) + NORM_EPS)
    return (y * g.astype(jnp.float32)).astype(x.dtype)


def shift_right(t):
    return jnp.pad(t, ((0, 0), (1, 0), (0, 0)))[:, :-1]


def causal_depthwise_conv(t, w):
    s = t.shape[1]
    tp = jnp.pad(t, ((0, 0), (CONV_WIDTH - 1, 0), (0, 0)))
    out = tp[:, 0:s] * w[0]
    for j in range(1, CONV_WIDTH):
        out = out + tp[:, j:j + s] * w[j]
    return out


def swiglu_ffn(h, w_in, w_out):
    gate, up = jnp.split(h @ w_in, 2, axis=-1)
    return (jax.nn.silu(gate) * up) @ w_out


def rwkv7_mixer(u, v_first, mu, w0, w2, a0, a2, g2, k_k, k_a, r_k, ln_w, ln_b, v_mix):
    b, s, _ = u.shape
    u = u + mu * (shift_right(u) - u)
    r, k, v, wl, al, gl = split_cols(u, (RWKV_WIDTH, RWKV_WIDTH, RWKV_WIDTH, DECAY_LORA, AAA_LORA, GATE_LORA))
    if v_mix is None:
        v_first = v
    else:
        v0, v1, v2 = v_mix
        v = v + (v_first - v) * jax.nn.sigmoid(v0 + (v @ v1) @ v2)
    w_log = -jax.nn.softplus(-(w0 + jnp.tanh(wl) @ w2)) - 0.5
    a = jax.nn.sigmoid(a0 + al @ a2)
    g = jax.nn.sigmoid(gl) @ g2
    hshape = (RWKV_HEADS, RWKV_HEAD_DIM)
    heads = lambda t: t.astype(jnp.float32).reshape(b, s, *hshape)
    r_h, v_h, a_h = heads(r), heads(v), heads(a)
    kk = heads(k) * k_k.astype(jnp.float32).reshape(hshape)
    kk = kk / jnp.maximum(jnp.linalg.norm(kk, axis=-1, keepdims=True), 1e-12)
    k_h = heads(k) * (1.0 + (a_h - 1.0) * k_a.astype(jnp.float32).reshape(hshape))
    decay = jnp.exp(-jnp.exp(heads(w_log)))

    def step(state, inp):
        r_t, w_t, k_t, v_t, kk_t, a_t = inp
        sa = jnp.einsum('bhvk,bhk->bhv', state, -kk_t)
        state = (state * w_t[:, :, None, :] + sa[..., None] * (kk_t * a_t)[:, :, None, :]
                 + v_t[..., None] * k_t[:, :, None, :])
        return state, jnp.einsum('bhvk,bhk->bhv', state, r_t)

    seq_first = lambda t: jnp.moveaxis(t, 1, 0)
    s0 = jnp.zeros((b, RWKV_HEADS, RWKV_HEAD_DIM, RWKV_HEAD_DIM), jnp.float32)
    _, y = lax.scan(step, s0, tuple(seq_first(t) for t in (r_h, decay, k_h, v_h, kk, a_h)))
    y = jnp.moveaxis(y, 0, 1)
    mean = jnp.mean(y, axis=-1, keepdims=True)
    var = jnp.mean(jnp.square(y - mean), axis=-1, keepdims=True)
    yn = (y - mean) * lax.rsqrt(var + RWKV_LN_EPS) * ln_w.astype(jnp.float32).reshape(hshape) \
        + ln_b.astype(jnp.float32).reshape(hshape)
    bonus = jnp.sum(r_h * k_h * r_k.astype(jnp.float32), axis=-1, keepdims=True) * v_h
    out = (yn + bonus).reshape(b, s, RWKV_WIDTH) * g.astype(jnp.float32)
    return out.astype(u.dtype), v_first


def gla_mixer(u, conv_w, a_up, a_bias, norm_w):
    b, s, _ = u.shape
    n_chunks = s // CHUNK
    qkv, al, go = split_cols(u, (GLA_QKV_COLS, GLA_GATE_LORA, GLA_VW))
    qkv = jax.nn.silu(causal_depthwise_conv(qkv, conv_w))
    q, k, v = split_cols(qkv, (GLA_KW, GLA_KW, GLA_VW))
    log_a = jax.nn.log_sigmoid((al @ a_up + a_bias).astype(jnp.float32)) / GLA_TAU
    chunks = lambda t, d: t.astype(jnp.float32).reshape(b, n_chunks, CHUNK, GLA_HEADS, d).transpose(0, 3, 1, 2, 4)
    q = chunks(q, GLA_DK) * (GLA_DK ** -0.5)
    k = chunks(k, GLA_DK)
    v = chunks(v, GLA_DV)
    gcum = jnp.cumsum(chunks(log_a, GLA_DK), axis=3)
    qg, kg = q * jnp.exp(gcum), k * jnp.exp(-gcum)
    qr, kr = q * jnp.exp(-gcum), k * jnp.exp(gcum)
    a_past = jnp.einsum('bhntd,bhnsd->bhnts', qg, kg)
    a_future = jnp.einsum('bhntd,bhnsd->bhnts', qr, kr)
    lower = jnp.tril(jnp.ones((CHUNK, CHUNK), dtype=bool))
    intra = jnp.einsum('bhnts,bhnse->bhnte', jnp.where(lower, a_past, a_future), v)
    g_last = gcum[:, :, :, -1:, :]
    kv_chunk = jnp.einsum('bhnsd,bhnse->bhnde', k * jnp.exp(g_last - gcum), v)
    decay_chunk = jnp.exp(g_last[:, :, :, 0, :])

    def step(state, inp):
        kv_c, dec_c = inp
        return state * dec_c[..., None] + kv_c, state

    s0 = jnp.zeros((b, GLA_HEADS, GLA_DK, GLA_DV), jnp.float32)
    _, s_prev = lax.scan(step, s0, (jnp.moveaxis(kv_chunk, 2, 0), jnp.moveaxis(decay_chunk, 2, 0)))
    inter = jnp.einsum('bhntd,bhnde->bhnte', qg, jnp.moveaxis(s_prev, 0, 2))
    o = (intra + inter).transpose(0, 2, 3, 1, 4).reshape(b, s, GLA_HEADS, GLA_DV)
    o = o * lax.rsqrt(jnp.mean(o * o, axis=-1, keepdims=True) + NORM_EPS) \
        * norm_w.astype(jnp.float32).reshape(GLA_HEADS, GLA_DV)
    out = o.reshape(b, s, GLA_VW) * jax.nn.silu(go.astype(jnp.float32))
    return out.astype(u.dtype)


def memory_attention(q, mem_n, w_kv):
    b, s, _ = q.shape
    m = mem_n.shape[1]
    k, v = jnp.split(mem_n @ w_kv, 2, axis=-1)
    q = q.reshape(b, s, XA_HEADS, XA_HEAD_DIM)
    k = k.reshape(b, m, XA_HEADS, XA_HEAD_DIM)
    v = v.reshape(b, m, XA_HEADS, XA_HEAD_DIM)
    scores = jnp.einsum('bshd,bmhd->bhsm', q, k).astype(jnp.float32) * (XA_HEAD_DIM ** -0.5)
    p = jax.nn.softmax(scores, axis=-1).astype(v.dtype)
    return jnp.einsum('bhsm,bmhd->bshd', p, v).reshape(b, s, XA_WIDTH)


def setup_inputs(seed: int = 0) -> dict:
    key = jax.random.key(seed)
    ks = iter(jax.random.split(key, 40))
    nrm = lambda shape, scale: scale * jax.random.normal(next(ks), shape, jnp.float32)
    gain = lambda shape: 1.0 + nrm(shape, 0.05)
    L = DEPTH
    return {
        'x': nrm((BATCH, SEQ, D_MODEL), 1.0),
        'mem': nrm((BATCH, N_MEM, D_MODEL), 1.0),
        'ffn1_norm': gain((L, D_MODEL)),
        'ffn1_w_in': nrm((L, D_MODEL, 2 * D_FF), D_MODEL ** -0.5),
        'ffn1_w_out': nrm((L, D_FF, D_MODEL), D_FF ** -0.5),
        'mix_norm': gain((L, D_MODEL)),
        'mem_norm': gain((L, D_MODEL)),
        'w_in': nrm((L, D_MODEL, W_IN_COLS), D_MODEL ** -0.5),
        'rwkv_mu': 0.5 + nrm((L, RWKV_COLS), 0.1),
        'rwkv_w0': -1.0 + nrm((L, RWKV_WIDTH), 0.5),
        'rwkv_w2': nrm((L, DECAY_LORA, RWKV_WIDTH), 0.5 * DECAY_LORA ** -0.5),
        'rwkv_a0': nrm((L, RWKV_WIDTH), 0.1),
        'rwkv_a2': nrm((L, AAA_LORA, RWKV_WIDTH), 0.5 * AAA_LORA ** -0.5),
        'rwkv_g2': nrm((L, GATE_LORA, RWKV_WIDTH), GATE_LORA ** -0.5),
        'rwkv_k_k': 0.85 + nrm((L, RWKV_WIDTH), 0.05),
        'rwkv_k_a': 1.0 + nrm((L, RWKV_WIDTH), 0.05),
        'rwkv_r_k': nrm((L, RWKV_HEADS, RWKV_HEAD_DIM), 0.1),
        'rwkv_ln_w': gain((L, RWKV_WIDTH)),
        'rwkv_ln_b': nrm((L, RWKV_WIDTH), 0.02),
        'rwkv_v0': nrm((L - 1, RWKV_WIDTH), 0.1),
        'rwkv_v1': nrm((L - 1, RWKV_WIDTH, MV_LORA), RWKV_WIDTH ** -0.5),
        'rwkv_v2': nrm((L - 1, MV_LORA, RWKV_WIDTH), 0.5 * MV_LORA ** -0.5),
        'gla_conv': nrm((L, CONV_WIDTH, GLA_QKV_COLS), CONV_WIDTH ** -0.5),
        'gla_a_up': nrm((L, GLA_GATE_LORA, GLA_KW), GLA_GATE_LORA ** -0.5),
        'gla_a_bias': 1.0 + nrm((L, GLA_KW), 0.5),
        'gla_norm': gain((L, GLA_VW)),
        'xa_w_kv': nrm((L, D_MODEL, 2 * XA_WIDTH), D_MODEL ** -0.5),
        'w_branch': nrm((L, N_BRANCH, BRANCH_WIDTH, D_MODEL), BRANCH_WIDTH ** -0.5),
        'w_out': nrm((L, D_MODEL, D_MODEL), D_MODEL ** -0.5),
        'ffn2_norm': gain((L, D_MODEL)),
        'ffn2_w_in': nrm((L, D_MODEL, 2 * D_FF), D_MODEL ** -0.5),
        'ffn2_w_out': nrm((L, D_FF, D_MODEL), D_FF ** -0.5),
        'final_norm': gain((D_MODEL,)),
    }


def reference(x, mem, ffn1_norm, ffn1_w_in, ffn1_w_out, mix_norm, mem_norm, w_in, rwkv_mu, rwkv_w0,
              rwkv_w2, rwkv_a0, rwkv_a2, rwkv_g2, rwkv_k_k, rwkv_k_a, rwkv_r_k, rwkv_ln_w, rwkv_ln_b,
              rwkv_v0, rwkv_v1, rwkv_v2, gla_conv, gla_a_up, gla_a_bias, gla_norm, xa_w_kv, w_branch,
              w_out, ffn2_norm, ffn2_w_in, ffn2_w_out, final_norm):
    b, s, d = x.shape
    v_first = None
    for l in range(DEPTH):
        x = x + 0.5 * swiglu_ffn(rmsnorm(x, ffn1_norm[l]), ffn1_w_in[l], ffn1_w_out[l])
        h = rmsnorm(x, mix_norm[l])
        u_rwkv, u_gla, u_xa, u_gate = split_cols(h @ w_in[l], (RWKV_COLS, GLA_COLS, XA_WIDTH, GATE_COLS))
        v_mix = None if l == 0 else (rwkv_v0[l - 1], rwkv_v1[l - 1], rwkv_v2[l - 1])
        y_rwkv, v_first = rwkv7_mixer(u_rwkv, v_first, rwkv_mu[l], rwkv_w0[l], rwkv_w2[l], rwkv_a0[l],
                                      rwkv_a2[l], rwkv_g2[l], rwkv_k_k[l], rwkv_k_a[l], rwkv_r_k[l],
                                      rwkv_ln_w[l], rwkv_ln_b[l], v_mix)
        y_gla = gla_mixer(u_gla, gla_conv[l], gla_a_up[l], gla_a_bias[l], gla_norm[l])
        y_xa = memory_attention(u_xa, rmsnorm(mem, mem_norm[l]), xa_w_kv[l])
        branches = jnp.stack([y_rwkv, y_gla, y_xa], axis=2)
        gates = jax.nn.sigmoid(u_gate.reshape(b, s, N_BRANCH, d))
        merged = jnp.einsum('bsjc,jcd,bsjd->bsd', branches, w_branch[l], gates)
        x = x + merged @ w_out[l]
        x = x + 0.5 * swiglu_ffn(rmsnorm(x, ffn2_norm[l]), ffn2_w_in[l], ffn2_w_out[l])
    return rmsnorm(x, final_norm)
```

```cpp
#include <hip/hip_runtime.h>
#include <hip/hip_cooperative_groups.h>
#include <cstdio>
namespace cg = cooperative_groups;
#ifndef P4SUB
#define P4SUB 7
#endif
#ifndef PHMASK
#define PHMASK 0xFFFF
#endif

#define LAS __attribute__((address_space(3)))
typedef unsigned short bf16_t;
typedef short bf16x8 __attribute__((ext_vector_type(8)));
typedef float f32x4 __attribute__((ext_vector_type(4)));
typedef float f32x2 __attribute__((ext_vector_type(2)));
typedef unsigned u32x4 __attribute__((ext_vector_type(4)));
typedef unsigned u32x2 __attribute__((ext_vector_type(2)));

constexpr int T = 16384, D = 1024, FF = 2816, SEQ = 4096, NL = 4;
constexpr int LDS_BYTES = 135168;

constexpr size_t MB = 1024 * 1024;
constexpr size_t WS_MISC = 0;
constexpr size_t WS_SS = 1 * MB;
constexpr size_t WS_WB = 4 * MB;
constexpr size_t WB_W1A = 0;
constexpr size_t WB_W1B = WB_W1A + (size_t)5632 * 1024 * 2;
constexpr size_t WB_WIN = WB_W1B + (size_t)1024 * 2816 * 2;
constexpr size_t WB_WG = WB_WIN + (size_t)4096 * 1024 * 2;
constexpr size_t WB_WBR = WB_WG + (size_t)3072 * 1024 * 2;
constexpr size_t WB_WO = WB_WBR + (size_t)3 * 1024 * 512 * 2;
constexpr size_t WB_WKV = WB_WO + (size_t)1024 * 1024 * 2;
constexpr size_t WB_W2A = WB_WKV + (size_t)1024 * 1024 * 2;
constexpr size_t WB_W2B = WB_W2A + (size_t)5632 * 1024 * 2;
constexpr size_t WB_LW2 = WB_W2B + (size_t)1024 * 2816 * 2;
constexpr size_t WB_LA2 = WB_LW2 + 512 * 64 * 2;
constexpr size_t WB_LG2 = WB_LA2 + 512 * 64 * 2;
constexpr size_t WB_LV1 = WB_LG2 + 512 * 128 * 2;
constexpr size_t WB_LV2 = WB_LV1 + 32 * 512 * 2;
constexpr size_t WB_END = WB_LV2 + 512 * 32 * 2;
static_assert(WB_END <= 55 * MB, "weights region");
constexpr size_t WS_XB = WS_WB + 55 * MB;
constexpr size_t WS_VF = WS_XB + 32 * MB;
constexpr size_t WS_MEMN = WS_VF + 32 * MB;
constexpr size_t WS_KB = WS_MEMN + 2 * MB;
constexpr size_t WS_VT = WS_KB + 1 * MB;
constexpr size_t WS_GO = WS_VT + 1 * MB;
constexpr size_t WS_BON = WS_GO + 16 * MB;
constexpr size_t WS_Y = WS_BON + 1 * MB;
constexpr size_t WS_KVC = WS_Y + 48 * MB;
constexpr size_t WS_DEC = WS_KVC + 32 * MB;
constexpr size_t WS_SC = WS_DEC + 1 * MB;
constexpr size_t SC_WD = 0;
constexpr size_t SC_V = 32 * MB;
constexpr size_t SC_RKKB = 64 * MB;
constexpr size_t WS_U = WS_SC + 128 * MB;
constexpr size_t U_RWKV = 0;
constexpr size_t U_GLA = (size_t)T * 1792 * 2;
constexpr size_t U_XA = 2 * (size_t)T * 1792 * 2;
constexpr size_t U_YRAW = 0;
constexpr size_t U_SPT = 32 * MB;
constexpr size_t U_MG = 0;
constexpr size_t U_MGB = 64 * MB;
constexpr size_t WS_END = WS_U + 128 * MB;
static_assert(U_XA + (size_t)T * 512 * 2 <= 128 * MB, "U region");

__device__ __forceinline__ unsigned cvt_pk_bf16(float lo, float hi) { unsigned r; asm volatile("v_cvt_pk_bf16_f32 %0, %1, %2" : "=v"(r) : "v"(lo), "v"(hi)); return r; }
__device__ __forceinline__ bf16_t f2bf(float x) { return (bf16_t)(cvt_pk_bf16(x, 0.f) & 0xffffu); }
__device__ __forceinline__ float bf2f(bf16_t b) { return __uint_as_float(((unsigned)b) << 16); }
__device__ __forceinline__ float bflo(unsigned w) { return __uint_as_float(w << 16); }
__device__ __forceinline__ float bfhi(unsigned w) { return __uint_as_float(w & 0xffff0000u); }
__device__ __forceinline__ f32x4 ld_bf4(const bf16_t* p) { const u32x2 w = *(const u32x2*)p; return (f32x4){bflo(w.x), bfhi(w.x), bflo(w.y), bfhi(w.y)}; }
__device__ __forceinline__ void st_bf4(bf16_t* p, f32x4 v) { u32x2 w; w.x = cvt_pk_bf16(v[0], v[1]); w.y = cvt_pk_bf16(v[2], v[3]); *(u32x2*)p = w; }
__device__ __forceinline__ float sigmoidf_(float x) { return 1.0f / (1.0f + __expf(-x)); }
__device__ __forceinline__ float wave_sum(float v) { for (int o = 32; o >= 1; o >>= 1) v += __shfl_xor(v, o); return v; }
__device__ __forceinline__ f32x4 mfma16(bf16x8 a, bf16x8 b, f32x4 c) { return __builtin_amdgcn_mfma_f32_16x16x32_bf16(a, b, c, 0, 0, 0); }

__device__ __forceinline__ float row_rstd(const float* ssp, int row) {
    const f32x4* p = (const f32x4*)(ssp + (size_t)row * 16); const f32x4 a = p[0], b = p[1], c = p[2], d = p[3];
    const float t = (((a[0] + a[1]) + (a[2] + a[3])) + ((b[0] + b[1]) + (b[2] + b[3]))) + (((c[0] + c[1]) + (c[2] + c[3])) + ((d[0] + d[1]) + (d[2] + d[3])));
    return rsqrtf(t * (1.0f / 1024.0f) + 1e-6f);
}
namespace pg8 {
constexpr int BM = 256, BK = 64, HALF = 128, HTB = HALF * BK * 2, STAGE_BYTES = 8 * HTB, NXCD = 8, WGM = 8;
__device__ __forceinline__ int lds_byte(int r, int c) { const int st = (r >> 4) * 2 + (c >> 5), rr = r & 15, cc = c & 31, ob = rr * 64 + cc * 2; return st * 1024 + (ob ^ (((ob >> 9) & 1) << 5)); }
__device__ __forceinline__ void stage_rc(int b, int& R, int& C) { const int st = b / 1024, sb = b % 1024, swz = sb ^ (((sb >> 9) & 1) << 5); R = (st >> 1) * 16 + swz / 64; C = (st & 1) * 32 + (swz % 64) / 2; }
__device__ __forceinline__ int perm32(int rho) { const int n = rho >> 4, i = rho & 15; return 8 * (i >> 2) + 4 * n + (i & 3); }

struct Unit { int pm, pn, z; };
struct Gemm { const bf16_t* A; const bf16_t* Bt; int M, N, K, lda, ldb; unsigned zA, zB; };

struct StaticOrder {
    int nM, nN, nwg, G, c, nz;
    __device__ void init(int M, int N, int G_, int c_, int nz_) { nM = M / BM; nN = N / BM; nwg = nM * nN; G = G_; c = c_; nz = nz_; }
    __device__ bool next(int i, Unit& u) const {
        const int ti = i / nz; u.z = i - ti * nz;
        const long L = (long)ti * G + c; if (L >= nwg) return false;
        int wgid = (int)L; { const int q = nwg / NXCD, r = nwg % NXCD, xcd = wgid % NXCD, off = wgid / NXCD; wgid = (xcd < r ? xcd * (q + 1) : r * (q + 1) + (xcd - r) * q) + off; }
        const int nig = WGM * nN, gid = wgid / nig, fm = gid * WGM, gsz = (nM - fm) < WGM ? (nM - fm) : WGM;
        u.pm = fm + ((wgid % nig) % gsz); u.pn = (wgid % nig) / gsz; return true;
    }
};

template <class Epi>
__device__ __forceinline__ void gemm_phase(LAS unsigned char* lds, const Gemm g, const StaticOrder& S, const Epi& E, const int tid) {
    const int wid = __builtin_amdgcn_readfirstlane(tid >> 6), lane = tid & 63, wr = wid >> 2, wc = wid & 3, fr = lane & 15, fq = lane >> 4;
    const int K = g.K, nt = K / BK;
    unsigned voffA[2], voffB[2];
#pragma unroll
    for (int i = 0; i < 2; ++i) { int R, C; stage_rc(tid * 16 + i * 8192, R, C); const int Rb = Epi::PERM ? ((R & ~31) + perm32(R & 31)) : R;
        voffA[i] = (unsigned)(R * g.lda + C) * 2u; voffB[i] = (unsigned)(Rb * g.ldb + C) * 2u; }
    const unsigned kstep = (unsigned)(BK * 2);
    const unsigned hstepA = (unsigned)HALF * g.lda * 2u, hstepB = (unsigned)HALF * g.ldb * 2u;
    const unsigned tstepA = 2u * hstepA, tstepB = 2u * hstepB;
    const unsigned ldsw = (unsigned)wid * 1024u;
    const int aoff = lds_byte(wr * 64 + fr, fq * 8), boff = lds_byte(wc * 32 + fr, fq * 8);
    const char* const gA = (const char*)g.A; const char* const gB = (const char*)g.Bt;
#define PG8_SA(b, h) (((b) * 2 + (h)) * HTB)
#define PG8_SB(b, h) ((4 + (b) * 2 + (h)) * HTB)
#define PG8_STAGE(bufoff, gbase, soff, voff) do { _Pragma("unroll") for (int _i = 0; _i < 2; ++_i) \
        __builtin_amdgcn_global_load_lds((const unsigned*)(((gbase) + (size_t)(unsigned)(soff)) + (voff)[_i]), (LAS unsigned*)(lds + (bufoff) + ldsw + _i * 8192), 16, 0, 0); } while (0)
#define PG8_LDA(dst, b, h) do { _Pragma("unroll") for (int m = 0; m < 4; ++m) _Pragma("unroll") for (int k = 0; k < 2; ++k) dst[m][k] = *(const LAS bf16x8*)(lds + PG8_SA(b, h) + aoff + m * 2048 + k * 1024); } while (0)
#define PG8_LDB(dst, b, h) do { _Pragma("unroll") for (int n = 0; n < 2; ++n) _Pragma("unroll") for (int k = 0; k < 2; ++k) dst[n][k] = *(const LAS bf16x8*)(lds + PG8_SB(b, h) + boff + n * 2048 + k * 1024); } while (0)
#define PG8_MMA(ai, bj, At, Bt) do { __builtin_amdgcn_s_setprio(1); _Pragma("unroll") for (int m = 0; m < 4; ++m) _Pragma("unroll") for (int n = 0; n < 2; ++n) _Pragma("unroll") for (int k = 0; k < 2; ++k) \
        acc[ai][bj][m][n] = __builtin_amdgcn_mfma_f32_16x16x32_bf16(Bt[n][k], At[m][k], acc[ai][bj][m][n], 0, 0, 0); __builtin_amdgcn_s_setprio(0); } while (0)
#define PG8_WAIT_V(n) asm volatile("s_waitcnt vmcnt(" #n ")" ::: "memory")
#define PG8_WAIT_L(n) asm volatile("s_waitcnt lgkmcnt(" #n ")" ::: "memory")
#define PG8_BAR __builtin_amdgcn_s_barrier()
#define PG8_SCHED __builtin_amdgcn_sched_barrier(0)
    Unit cur, nxt; int ui = 0;
    if (!S.next(0, cur)) return;
    f32x4 acc[2][2][4][2];
#pragma unroll
    for (int a = 0; a < 2; ++a)
#pragma unroll
        for (int b = 0; b < 2; ++b)
#pragma unroll
            for (int m = 0; m < 4; ++m)
#pragma unroll
                for (int n = 0; n < 2; ++n) acc[a][b][m][n] = (f32x4){0.f, 0.f, 0.f, 0.f};
    bf16x8 At[4][2], B0[2][2], B1[2][2];
    unsigned cA = (unsigned)cur.z * g.zA + (unsigned)cur.pm * tstepA, cB = (unsigned)cur.z * g.zB + (unsigned)cur.pn * tstepB;
    PG8_STAGE(PG8_SB(0, 0), gB, cB, voffB); PG8_STAGE(PG8_SA(0, 0), gA, cA, voffA); PG8_STAGE(PG8_SB(0, 1), gB, cB + hstepB, voffB); PG8_STAGE(PG8_SA(0, 1), gA, cA + hstepA, voffA);
    if (wr == 1) PG8_BAR;
    PG8_WAIT_V(4); PG8_BAR;
    PG8_STAGE(PG8_SB(1, 0), gB, cB + kstep, voffB); PG8_STAGE(PG8_SA(1, 0), gA, cA + kstep, voffA); PG8_STAGE(PG8_SB(1, 1), gB, cB + hstepB + kstep, voffB);
    PG8_WAIT_V(6); PG8_BAR;
    for (;;) {
        const bool has_next = S.next(ui + 1, nxt);
        const unsigned nA = has_next ? (unsigned)nxt.z * g.zA + (unsigned)nxt.pm * tstepA : cA, nB = has_next ? (unsigned)nxt.z * g.zB + (unsigned)nxt.pn * tstepB : cB;
        for (int t = 0; t < nt; t += 2) {
            const bool last = (t == nt - 2);
            const unsigned a1 = cA + (unsigned)(t + 1) * kstep;
            const unsigned a2 = last ? nA : cA + (unsigned)(t + 2) * kstep, b2 = last ? nB : cB + (unsigned)(t + 2) * kstep;
            const unsigned a3 = a2 + kstep, b3 = b2 + kstep;
            PG8_LDB(B0, 0, 0); PG8_SCHED; PG8_LDA(At, 0, 0); PG8_STAGE(PG8_SA(1, 1), gA, a1 + hstepA, voffA);
            PG8_WAIT_L(8); PG8_BAR; PG8_WAIT_L(0); PG8_MMA(0, 0, At, B0); PG8_BAR; PG8_SCHED;
            PG8_LDB(B1, 0, 1); PG8_STAGE(PG8_SB(0, 0), gB, b2, voffB);
            PG8_BAR; PG8_WAIT_L(0); PG8_MMA(0, 1, At, B1); PG8_BAR;
            PG8_LDA(At, 0, 1); PG8_STAGE(PG8_SA(0, 0), gA, a2, voffA);
            PG8_BAR; PG8_WAIT_L(0); PG8_MMA(1, 0, At, B0); PG8_BAR; PG8_SCHED;
            PG8_STAGE(PG8_SB(0, 1), gB, b2 + hstepB, voffB);
            PG8_WAIT_V(6); PG8_BAR; PG8_MMA(1, 1, At, B1); PG8_BAR;
            PG8_LDB(B0, 1, 0); PG8_SCHED; PG8_LDA(At, 1, 0); PG8_STAGE(PG8_SA(0, 1), gA, a2 + hstepA, voffA);
            PG8_WAIT_L(8); PG8_BAR; PG8_WAIT_L(0); PG8_MMA(0, 0, At, B0); PG8_BAR; PG8_SCHED;
            PG8_LDB(B1, 1, 1); PG8_STAGE(PG8_SB(1, 0), gB, b3, voffB);
            PG8_BAR; PG8_WAIT_L(0); PG8_MMA(0, 1, At, B1); PG8_BAR;
            PG8_LDA(At, 1, 1); PG8_STAGE(PG8_SA(1, 0), gA, a3, voffA);
            PG8_BAR; PG8_WAIT_L(0); PG8_MMA(1, 0, At, B0); PG8_BAR; PG8_SCHED;
            PG8_STAGE(PG8_SB(1, 1), gB, b3 + hstepB, voffB);
            PG8_WAIT_V(6); PG8_BAR; PG8_MMA(1, 1, At, B1); PG8_BAR;
        }
        E(acc, cur, wr, wc, fr, fq);
        if (!has_next) break;
#pragma unroll
        for (int a = 0; a < 2; ++a)
#pragma unroll
            for (int b = 0; b < 2; ++b)
#pragma unroll
                for (int m = 0; m < 4; ++m)
#pragma unroll
                    for (int n = 0; n < 2; ++n) acc[a][b][m][n] = (f32x4){0.f, 0.f, 0.f, 0.f};
        cur = nxt; cA = nA; cB = nB; ++ui;
    }
    PG8_WAIT_V(0);
    if (wr == 0) PG8_BAR;
    PG8_BAR;
#undef PG8_SA
#undef PG8_SB
#undef PG8_STAGE
#undef PG8_LDA
#undef PG8_LDB
#undef PG8_MMA
#undef PG8_WAIT_V
#undef PG8_WAIT_L
#undef PG8_BAR
#undef PG8_SCHED
}
}
using pg8::Unit;
typedef f32x4 Acc[2][2][4][2];

struct EpiFFNa { static constexpr bool PERM = false; bf16_t* H; const float* ss;
    __device__ __forceinline__ void operator()(const Acc& acc, const Unit& u, int wr, int wc, int fr, int fq) const {
        const int row0 = u.pm * 256 + wr * 64 + fr, hc0 = u.pn * 128 + wc * 16 + 4 * fq;
#pragma unroll
        for (int ai = 0; ai < 2; ++ai)
#pragma unroll
            for (int m = 0; m < 4; ++m) { const int row = row0 + ai * 128 + m * 16; const float rs = row_rstd(ss, row);
#pragma unroll
                for (int bj = 0; bj < 2; ++bj) { const f32x4 gt = acc[ai][bj][m][0] * rs, up = acc[ai][bj][m][1] * rs; f32x4 h;
#pragma unroll
                    for (int j = 0; j < 4; ++j) h[j] = gt[j] * sigmoidf_(gt[j]) * up[j];
                    st_bf4(H + (size_t)row * FF + hc0 + bj * 64, h); } }
    }
};
struct EpiRes { static constexpr bool PERM = false; const float* xin; float* xout; bf16_t* xb; float* ss_out; float scale;
    __device__ __forceinline__ void operator()(const Acc& acc, const Unit& u, int wr, int wc, int fr, int fq) const {
        const int row0 = u.pm * 256 + wr * 64 + fr, col0 = u.pn * 256 + wc * 32 + 4 * fq;
#pragma unroll
        for (int ai = 0; ai < 2; ++ai)
#pragma unroll
            for (int m = 0; m < 4; ++m) { const int row = row0 + ai * 128 + m * 16; float q = 0.f;
#pragma unroll
                for (int bj = 0; bj < 2; ++bj)
#pragma unroll
                    for (int n = 0; n < 2; ++n) { const size_t o = (size_t)row * D + col0 + bj * 128 + n * 16; const f32x4 v = *(const f32x4*)(xin + o) + acc[ai][bj][m][n] * scale;
                        *(f32x4*)(xout + o) = v; st_bf4(xb + o, v); q += (v[0] * v[0] + v[1] * v[1]) + (v[2] * v[2] + v[3] * v[3]); }
                q += __shfl_xor(q, 16); q += __shfl_xor(q, 32);
                if (fq == 0) ss_out[(size_t)row * 16 + u.pn * 4 + wc] = q; }
    }
};
struct EpiU { static constexpr bool PERM = true; bf16_t* Ubase; const float* ss;
    __device__ __forceinline__ void operator()(const Acc& acc, const Unit& u, int wr, int wc, int fr, int fq) const {
        bf16_t* base; int ld, c0;
        if (u.pn < 7) { base = (bf16_t*)((char*)Ubase + U_RWKV); ld = 1792; c0 = u.pn * 256; }
        else if (u.pn < 14) { base = (bf16_t*)((char*)Ubase + U_GLA); ld = 1792; c0 = (u.pn - 7) * 256; }
        else { base = (bf16_t*)((char*)Ubase + U_XA); ld = 512; c0 = (u.pn - 14) * 256; }
        const int row0 = u.pm * 256 + wr * 64 + fr; c0 += wc * 32 + 8 * fq;
#pragma unroll
        for (int ai = 0; ai < 2; ++ai)
#pragma unroll
            for (int m = 0; m < 4; ++m) { const int row = row0 + ai * 128 + m * 16; const float rs = row_rstd(ss, row);
#pragma unroll
                for (int bj = 0; bj < 2; ++bj) { const f32x4 v0 = acc[ai][bj][m][0] * rs, v1 = acc[ai][bj][m][1] * rs; u32x4 w;
                    w.x = cvt_pk_bf16(v0[0], v0[1]); w.y = cvt_pk_bf16(v0[2], v0[3]); w.z = cvt_pk_bf16(v1[0], v1[1]); w.w = cvt_pk_bf16(v1[2], v1[3]);
                    *(u32x4*)(base + (size_t)row * ld + c0 + bj * 128) = w; } }
    }
};
struct EpiGate { static constexpr bool PERM = true; bf16_t* Gt; const float* ss;
    __device__ __forceinline__ void operator()(const Acc& acc, const Unit& u, int wr, int wc, int fr, int fq) const {
        const int row0 = u.pm * 256 + wr * 64 + fr, c0 = u.pn * 256 + wc * 32 + 8 * fq;
#pragma unroll
        for (int ai = 0; ai < 2; ++ai)
#pragma unroll
            for (int m = 0; m < 4; ++m) { const int row = row0 + ai * 128 + m * 16; const float rs = row_rstd(ss, row);
#pragma unroll
                for (int bj = 0; bj < 2; ++bj) { f32x4 v0 = acc[ai][bj][m][0] * rs, v1 = acc[ai][bj][m][1] * rs;
#pragma unroll
                    for (int j = 0; j < 4; ++j) { v0[j] = sigmoidf_(v0[j]); v1[j] = sigmoidf_(v1[j]); }
                    u32x4 w; w.x = cvt_pk_bf16(v0[0], v0[1]); w.y = cvt_pk_bf16(v0[2], v0[3]); w.z = cvt_pk_bf16(v1[0], v1[1]); w.w = cvt_pk_bf16(v1[2], v1[3]);
                    *(u32x4*)(Gt + (size_t)row * 3072 + c0 + bj * 128) = w; } }
    }
};
struct EpiMerge { static constexpr bool PERM = false; const bf16_t* Gt; float* Mg; bf16_t* Mb;
    __device__ __forceinline__ void operator()(const Acc& acc, const Unit& u, int wr, int wc, int fr, int fq) const {
        const int row0 = u.pm * 256 + wr * 64 + fr, col0 = u.pn * 256 + wc * 32 + 4 * fq;
#pragma unroll
        for (int ai = 0; ai < 2; ++ai)
#pragma unroll
            for (int m = 0; m < 4; ++m) { const int row = row0 + ai * 128 + m * 16;
#pragma unroll
                for (int bj = 0; bj < 2; ++bj)
#pragma unroll
                    for (int n = 0; n < 2; ++n) { const int col = col0 + bj * 128 + n * 16; const size_t o = (size_t)row * D + col;
                        f32x4 v = acc[ai][bj][m][n] * ld_bf4(Gt + (size_t)row * 3072 + u.z * 1024 + col);
                        if (u.z > 0) v += *(const f32x4*)(Mg + o);
                        if (u.z < 2) *(f32x4*)(Mg + o) = v; else st_bf4(Mb + o, v); } }
    }
};
struct EpiKV { static constexpr bool PERM = false; bf16_t* Kb; bf16_t* Vt; const float* rstd;
    __device__ __forceinline__ void operator()(const Acc& acc, const Unit& u, int wr, int wc, int fr, int fq) const {
        const int row0 = u.pm * 256 + wr * 64 + fr, col0 = u.pn * 256 + wc * 32 + 4 * fq;
#pragma unroll
        for (int ai = 0; ai < 2; ++ai)
#pragma unroll
            for (int m = 0; m < 4; ++m) { const int row = row0 + ai * 128 + m * 16; const float rs = rstd[row];
#pragma unroll
                for (int bj = 0; bj < 2; ++bj)
#pragma unroll
                    for (int n = 0; n < 2; ++n) { const int col = col0 + bj * 128 + n * 16; const f32x4 v = acc[ai][bj][m][n] * rs;
                        if (col < 512) st_bf4(Kb + (size_t)row * 512 + col, v);
                        else {
#pragma unroll
                            for (int j = 0; j < 4; ++j) Vt[((size_t)(row >> 8) * 512 + (col - 512 + j)) * 256 + (row & 255)] = f2bf(v[j]); } } }
    }
};

template <int MAP> __device__ __forceinline__ int colmap(int n) {
    if (MAP == 1) { const int g = n >> 5, i = n & 31; return i < 16 ? 16 * g + i : FF + 16 * g + (i - 16); }
    if (MAP == 2) { if (n < 3344) return n; if (n < 3584) return -1; return n - 240; }
    return n;
}
template <int MAP>
__device__ void convT(LAS unsigned char* lds, const float* src, int ld, int coff, const float* g, bf16_t* dst, int K, int Kd, int Nd, int G, int bid, int tid) {
    const int nkt = (K + 63) >> 6, nnt = (Nd + 63) >> 6, ntile = nkt * nnt;
    LAS bf16_t* tile = (LAS bf16_t*)lds;
    for (int t = bid; t < ntile; t += G) {
        const int kt = t % nkt, ntl = t / nkt, k0 = kt * 64, n0 = ntl * 64;
        { const int nl = tid & 63, kl0 = tid >> 6, n = n0 + nl; const int c = (n < Nd) ? colmap<MAP>(n) : -1;
#pragma unroll
          for (int i = 0; i < 8; ++i) { const int kl = kl0 + 8 * i, k = k0 + kl; float v = 0.f;
              if (c >= 0 && k < K) { v = src[(size_t)k * ld + coff + c]; if (g) v *= g[k]; }
              tile[nl * 72 + kl] = f2bf(v); } }
        __syncthreads();
        { const int nl = tid >> 3, kc = (tid & 7) * 8, n = n0 + nl, k = k0 + kc;
          if (n < Nd && k < Kd) *(u32x4*)(dst + (size_t)n * Kd + k) = *(LAS u32x4*)(tile + nl * 72 + kc); }
        __syncthreads();
    }
}

template <int K>
__device__ __forceinline__ void wave_gemm(f32x4 (&acc)[4][4], LAS const unsigned char* A, int sA, const bf16_t* Bt, int fr, int fq) {
#pragma unroll
    for (int m = 0; m < 4; ++m)
#pragma unroll
        for (int n = 0; n < 4; ++n) acc[m][n] = (f32x4){0.f, 0.f, 0.f, 0.f};
#pragma unroll
    for (int ks = 0; ks < K / 32; ++ks) { bf16x8 a[4], b[4];
#pragma unroll
        for (int m = 0; m < 4; ++m) a[m] = *(LAS const bf16x8*)(A + (16 * m + fr) * sA + (ks * 32 + fq * 8) * 2);
#pragma unroll
        for (int n = 0; n < 4; ++n) b[n] = *(const bf16x8*)(Bt + (size_t)(16 * n + fr) * K + ks * 32 + fq * 8);
#pragma unroll
        for (int m = 0; m < 4; ++m)
#pragma unroll
            for (int n = 0; n < 4; ++n) acc[m][n] = mfma16(b[n], a[m], acc[m][n]); }
}

template <int K>
__device__ __forceinline__ void row_gemm(f32x4 (&acc)[4], LAS const unsigned char* Arow, const bf16_t* Bt, int fr, int fq) {
#pragma unroll
    for (int n = 0; n < 4; ++n) acc[n] = (f32x4){0.f, 0.f, 0.f, 0.f};
#pragma unroll
    for (int ks = 0; ks < K / 32; ++ks) { const bf16x8 a = *(LAS const bf16x8*)(Arow + (ks * 32 + fq * 8) * 2);
#pragma unroll
        for (int n = 0; n < 4; ++n) { const bf16x8 b = *(const bf16x8*)(Bt + (size_t)(16 * n + fr) * K + ks * 32 + fq * 8); acc[n] = mfma16(b, a, acc[n]); } }
}

struct PrepArgs { const bf16_t* U; const float *mu, *w0, *a0, *kk_, *ka, *rk, *v0; const bf16_t *w2t, *a2t, *g2t, *v1t, *v2t; float* vfirst; float* Wd; float* V; bf16_t* RKKB; bf16_t* Go; float* Bon; int layer; };

__device__ __forceinline__ f32x4 shifted4(const bf16_t* Ut, bool has_prev, int c, const float* mu) {
    const f32x4 u = ld_bf4(Ut + c); f32x4 p = (f32x4){0.f, 0.f, 0.f, 0.f}; if (has_prev) p = ld_bf4(Ut - 1792 + c);
    const f32x4 m = *(const f32x4*)(mu + c); return u + m * (p - u);
}

__device__ void rwkv_prep_tile(LAS unsigned char* lds, const PrepArgs& P, int tt, int tid) {
    constexpr int SW = 144, SG = 272, SV = 1040, SVV = 80;
    LAS unsigned char* LAw = lds; LAS unsigned char* LAa = lds + 9216; LAS unsigned char* LAg = lds + 18432; LAS unsigned char* LAv = lds + 35840; LAS unsigned char* LAvv = lds + 102400;
    const int t0 = tt * 64; const int s0 = t0 & (SEQ - 1);
    const int lane = tid & 63, wave = __builtin_amdgcn_readfirstlane(tid >> 6), fr = lane & 15, fq = lane >> 4;
#pragma unroll 2
    for (int e = 0; e < 32; ++e) { const int idx = tid + 512 * e, i = idx >> 8, c = idx & 255; const bf16_t* Ut = P.U + (size_t)(t0 + i) * 1792 + 1536 + c;
        const float u = bf2f(*Ut), p = (s0 + i > 0) ? bf2f(*(Ut - 1792)) : 0.f; const float x = u + P.mu[1536 + c] * (p - u);
        if (c < 64) { const float e2 = __expf(2.f * x); *(LAS bf16_t*)(LAw + i * SW + c * 2) = f2bf(1.f - 2.f / (e2 + 1.f)); }
        else if (c < 128) *(LAS bf16_t*)(LAa + i * SW + (c - 64) * 2) = f2bf(x);
        else *(LAS bf16_t*)(LAg + i * SG + (c - 128) * 2) = f2bf(sigmoidf_(x)); }
    if (P.layer > 0) {
#pragma unroll 2
        for (int e = 0; e < 16; ++e) { const int idx = tid + 512 * e, i = idx >> 7, c = (idx & 127) * 4; const bf16_t* Ut = P.U + (size_t)(t0 + i) * 1792;
            const f32x4 x = shifted4(Ut, s0 + i > 0, 1024 + c, P.mu); u32x2 w; w.x = cvt_pk_bf16(x[0], x[1]); w.y = cvt_pk_bf16(x[2], x[3]); *(LAS u32x2*)(LAv + i * SV + c * 2) = w; }
    }
    __syncthreads();
    if (P.layer > 0) {
        const int mt = wave >> 1, nt = wave & 1; f32x4 acc = (f32x4){0.f, 0.f, 0.f, 0.f};
#pragma unroll 4
        for (int ks = 0; ks < 16; ++ks) { const bf16x8 a = *(LAS const bf16x8*)(LAv + (16 * mt + fr) * SV + (ks * 32 + fq * 8) * 2);
            const bf16x8 b = *(const bf16x8*)(P.v1t + (size_t)(16 * nt + fr) * 512 + ks * 32 + fq * 8); acc = mfma16(b, a, acc); }
        u32x2 w; w.x = cvt_pk_bf16(acc[0], acc[1]); w.y = cvt_pk_bf16(acc[2], acc[3]); *(LAS u32x2*)(LAvv + (16 * mt + fr) * SVV + (16 * nt + 4 * fq) * 2) = w;
    }
    __syncthreads();
    const int h = wave, cb = 64 * h; const int b_ = t0 >> 12, p = b_ * 8 + h;
#pragma unroll 1
    for (int m = 0; m < 4; ++m) {
        const int i = 16 * m + fr; const bf16_t* Ut = P.U + (size_t)(t0 + i) * 1792; const bool hp = (s0 + i) > 0;
        int fq4 = 4 * fq; asm volatile("" : "+v"(fq4));
        f32x4 aa[4], acc[4];
        row_gemm<64>(aa, LAa + i * SW, P.a2t + (size_t)cb * 64, fr, fq);
#pragma unroll
        for (int n = 0; n < 4; ++n) { const f32x4 a0v = *(const f32x4*)(P.a0 + cb + 16 * n + fq4);
#pragma unroll
            for (int j = 0; j < 4; ++j) aa[n][j] = sigmoidf_(aa[n][j] + a0v[j]); }
        row_gemm<64>(acc, LAw + i * SW, P.w2t + (size_t)cb * 64, fr, fq);
#pragma unroll
        for (int n = 0; n < 4; ++n) { const f32x4 w0v = *(const f32x4*)(P.w0 + cb + 16 * n + fq4); f32x4 d;
#pragma unroll
            for (int j = 0; j < 4; ++j) d[j] = __expf(-0.6065306597f * sigmoidf_(acc[n][j] + w0v[j]));
            *(f32x4*)(P.Wd + ((size_t)p * SEQ + s0 + i) * 64 + 16 * n + fq4) = d; }
        row_gemm<128>(acc, LAg + i * SG, P.g2t + (size_t)cb * 128, fr, fq);
#pragma unroll
        for (int n = 0; n < 4; ++n) st_bf4(P.Go + (size_t)(t0 + i) * 512 + cb + 16 * n + fq4, acc[n]);
        asm volatile("" ::: "memory");
        if (P.layer > 0) row_gemm<32>(acc, LAvv + i * SVV, P.v2t + (size_t)cb * 32, fr, fq);
        float bon = 0.f, nk = 0.f; f32x4 kv[4], rv[4];
#pragma unroll
        for (int n = 0; n < 4; ++n) { const int c = cb + 16 * n + fq4;
            f32x4 v = shifted4(Ut, hp, 1024 + c, P.mu);
            if (P.layer > 0) { const f32x4 vf = *(const f32x4*)(P.vfirst + (size_t)(t0 + i) * 512 + c); const f32x4 v0v = *(const f32x4*)(P.v0 + c);
#pragma unroll
                for (int j = 0; j < 4; ++j) v[j] = v[j] + (vf[j] - v[j]) * sigmoidf_(v0v[j] + acc[n][j]); }
            else *(f32x4*)(P.vfirst + (size_t)(t0 + i) * 512 + c) = v;
            *(f32x4*)(P.V + ((size_t)p * SEQ + s0 + i) * 64 + 16 * n + fq4) = v;
            kv[n] = shifted4(Ut, hp, 512 + c, P.mu); rv[n] = shifted4(Ut, hp, c, P.mu);
            const f32x4 kkw = *(const f32x4*)(P.kk_ + c);
#pragma unroll
            for (int j = 0; j < 4; ++j) { const float x = kv[n][j] * kkw[j]; nk += x * x; } }
        nk += __shfl_xor(nk, 16); nk += __shfl_xor(nk, 32);
        const float inv = 1.0f / fmaxf(sqrtf(nk), 1e-12f);
        bf16_t* O = P.RKKB + ((size_t)p * SEQ + s0 + i) * 256;
#pragma unroll
        for (int n = 0; n < 4; ++n) { const int c = cb + 16 * n + fq4; const f32x4 kkw = *(const f32x4*)(P.kk_ + c), kaw = *(const f32x4*)(P.ka + c), rkw = *(const f32x4*)(P.rk + c);
            f32x4 kk, kh, bb;
#pragma unroll
            for (int j = 0; j < 4; ++j) { const float a = aa[n][j]; kk[j] = kv[n][j] * kkw[j] * inv; kh[j] = kv[n][j] * (1.f + (a - 1.f) * kaw[j]); bb[j] = kk[j] * a; bon += rv[n][j] * kh[j] * rkw[j]; }
            const int cc = 16 * n + fq4; st_bf4(O + cc, rv[n]); st_bf4(O + 64 + cc, kh); st_bf4(O + 128 + cc, kk); st_bf4(O + 192 + cc, bb); }
        bon += __shfl_xor(bon, 16); bon += __shfl_xor(bon, 32);
        if (fq == 0) P.Bon[(size_t)(t0 + i) * 8 + h] = bon;
        asm volatile("" ::: "memory");
    }
    __syncthreads();
}

constexpr int SCAN_CH = 32, SCAN_STEP_B = 1312, SCAN_SLOT_B = SCAN_CH * SCAN_STEP_B;
template <int CTRL> __device__ __forceinline__ float dpp_f(float v) { return __int_as_float(__builtin_amdgcn_update_dpp(0, __float_as_int(v), CTRL, 0xf, 0xf, true)); }
__device__ __forceinline__ float row16_sum(float v) { v += dpp_f<0xB1>(v); v += dpp_f<0x4E>(v); v += dpp_f<0x141>(v); v += dpp_f<0x140>(v); return v; }

__device__ __forceinline__ void scan_load_chunk(LAS unsigned char* slot, const float* Wd, const float* V, const bf16_t* RKKB, int p, int rg, int s0, int ltid, int nthr) {
    for (int idx = ltid; idx < 1600; idx += nthr) {
        if (idx < 512) { const int st = idx >> 4, part = idx & 15; *(LAS f32x4*)(slot + st * SCAN_STEP_B + part * 16) = *(const f32x4*)(Wd + ((size_t)p * SEQ + s0 + st) * 64 + part * 4); }
        else if (idx < 1536) { const int k = idx - 512, st = k >> 5, rem = k & 31, q = rem >> 3, part = rem & 7;
            const u32x4 w = *(const u32x4*)(RKKB + (((size_t)p * SEQ + s0 + st) * 4 + q) * 64 + part * 8);
            const int Q = (q == 0) ? 4 : (q == 1) ? 2 : (q == 2) ? 3 : 1;
            LAS f32x4* d = (LAS f32x4*)(slot + st * SCAN_STEP_B + Q * 256 + part * 32);
            d[0] = (f32x4){bflo(w.x), bfhi(w.x), bflo(w.y), bfhi(w.y)}; d[1] = (f32x4){bflo(w.z), bfhi(w.z), bflo(w.w), bfhi(w.w)}; }
        else { const int k = idx - 1536, st = k >> 1, hf = k & 1; *(LAS f32x4*)(slot + st * SCAN_STEP_B + 1280 + hf * 16) = *(const f32x4*)(V + ((size_t)p * SEQ + s0 + st) * 64 + rg * 8 + hf * 4); }
    }
}

__device__ void rwkv_scan_unit(LAS unsigned char* lds, const float* Wd, const float* V, const bf16_t* RKKB, float* Yraw, int p, int rg, int tid) {
    const int lane = tid & 63, wave = __builtin_amdgcn_readfirstlane(tid >> 6);
    constexpr int NCH = SEQ / SCAN_CH;
    scan_load_chunk(lds, Wd, V, RKKB, p, rg, 0, tid, 512);
    scan_load_chunk(lds + SCAN_SLOT_B, Wd, V, RKKB, p, rg, SCAN_CH, tid, 512);
    __syncthreads();
    f32x4 S = (f32x4){0.f, 0.f, 0.f, 0.f};
    const int kq = lane & 15, rl = wave * 4 + (lane >> 4);
    for (int c = 0; c < NCH; ++c) {
        if (wave >= 2) { if (c + 2 < NCH) scan_load_chunk(lds + ((c + 2) % 3) * SCAN_SLOT_B, Wd, V, RKKB, p, rg, (c + 2) * SCAN_CH, tid - 128, 384); }
        else {
            LAS const unsigned char* sl = lds + (c % 3) * SCAN_SLOT_B + kq * 16;
            LAS const unsigned char* vl = lds + (c % 3) * SCAN_SLOT_B + 1280 + rl * 4;
            float* yo = Yraw + ((size_t)p * SEQ + c * SCAN_CH) * 64 + rg * 8 + rl;
#pragma unroll 4
            for (int st = 0; st < SCAN_CH; ++st) {
                const f32x4 w = *(LAS const f32x4*)(sl + st * SCAN_STEP_B), b = *(LAS const f32x4*)(sl + st * SCAN_STEP_B + 256), k = *(LAS const f32x4*)(sl + st * SCAN_STEP_B + 512),
                            kk = *(LAS const f32x4*)(sl + st * SCAN_STEP_B + 768), r = *(LAS const f32x4*)(sl + st * SCAN_STEP_B + 1024);
                const float v = *(LAS const float*)(vl + st * SCAN_STEP_B);
                float sa = (S[0] * kk[0] + S[1] * kk[1]) + (S[2] * kk[2] + S[3] * kk[3]);
                sa = -row16_sum(sa);
                S = S * w + (b * sa + k * v);
                float y = (S[0] * r[0] + S[1] * r[1]) + (S[2] * r[2] + S[3] * r[3]);
                y = row16_sum(y);
                if (kq == 0) yo[(size_t)st * 64] = y;
            }
        }
        __syncthreads();
    }
}

struct GlaArgs { const bf16_t* Ug; const float *conv, *aup, *abias, *gnorm; float* kvcT; float* dec; bf16_t* spT; bf16_t* Yg; };
constexpr int GL_GC = 0;
constexpr int GL_T0 = 16640;
constexpr int GL_VT = GL_T0 + 4 * 9216;
constexpr int GL_AL = GL_VT + 18432;
constexpr int GL_RS = GL_AL + 9216;

__device__ __forceinline__ float gla_conv_silu(const bf16_t* Ug, const float* conv, int t, int s, int c) {
    float a = 0.f;
#pragma unroll
    for (int j = 0; j < 4; ++j) { const int ds = 3 - j; if (s - ds >= 0) a += conv[j * 1024 + c] * bf2f(Ug[(size_t)(t - ds) * 1792 + c]); }
    return a * sigmoidf_(a);
}
__device__ __forceinline__ void gla_gcum(LAS unsigned char* lds, const GlaArgs& A, int t0, int h, int tid) {
    LAS float* GC = (LAS float*)(lds + GL_GC);
    for (int e = 0; e < 8; ++e) { const int idx = tid + 512 * e, i = idx >> 6, d = idx & 63; float x = A.abias[h * 64 + d];
#pragma unroll
        for (int j = 0; j < 16; ++j) x += bf2f(A.Ug[(size_t)(t0 + i) * 1792 + 1024 + j]) * A.aup[j * 256 + h * 64 + d];
        const float ls = fminf(x, 0.f) - __logf(1.f + __expf(-fabsf(x)));
        GC[i * 65 + d] = ls * (1.0f / 16.0f); }
    __syncthreads();
    { const int lane = tid & 63, wave = tid >> 6;
      for (int dd = 0; dd < 8; ++dd) { const int d = wave * 8 + dd; float x = GC[lane * 65 + d];
          for (int o = 1; o < 64; o <<= 1) { const float y = __shfl_up(x, o); if (lane >= o) x += y; }
          GC[lane * 65 + d] = x; } }
    __syncthreads();
}
__device__ void gla_a_tile(LAS unsigned char* lds, const GlaArgs& A, int tile, int tid) {
    const int bh = tile >> 6, n = tile & 63, b = bh >> 2, h = bh & 3, t0 = b * SEQ + n * 64, s0 = n * 64;
    LAS float* GC = (LAS float*)(lds + GL_GC); LAS bf16_t* KDT = (LAS bf16_t*)(lds + GL_T0); LAS bf16_t* VT = (LAS bf16_t*)(lds + GL_VT);
    gla_gcum(lds, A, t0, h, tid);
    for (int e = 0; e < 24; ++e) { const int idx = tid + 512 * e, i = idx / 192, cc = idx % 192;
        if (cc < 64) { const float k = gla_conv_silu(A.Ug, A.conv, t0 + i, s0 + i, 256 + h * 64 + cc); KDT[cc * 72 + i] = f2bf(k * __expf(GC[63 * 65 + cc] - GC[i * 65 + cc])); }
        else { const int ev = cc - 64; VT[ev * 72 + i] = f2bf(gla_conv_silu(A.Ug, A.conv, t0 + i, s0 + i, 512 + h * 128 + ev)); } }
    if (tid < 64) A.dec[((size_t)bh * 64 + n) * 64 + tid] = __expf(GC[63 * 65 + tid]);
    __syncthreads();
    { const int lane = tid & 63, wave = tid >> 6, fr = lane & 15, fq = lane >> 4; f32x4 acc[4];
#pragma unroll
      for (int nt = 0; nt < 4; ++nt) acc[nt] = (f32x4){0.f, 0.f, 0.f, 0.f};
#pragma unroll
      for (int ks = 0; ks < 2; ++ks) { const bf16x8 a = *(LAS const bf16x8*)(VT + (16 * wave + fr) * 72 + ks * 32 + fq * 8);
#pragma unroll
          for (int nt = 0; nt < 4; ++nt) { const bf16x8 bfr = *(LAS const bf16x8*)(KDT + (16 * nt + fr) * 72 + ks * 32 + fq * 8); acc[nt] = mfma16(bfr, a, acc[nt]); } }
#pragma unroll
      for (int nt = 0; nt < 4; ++nt) *(f32x4*)(A.kvcT + (((size_t)bh * 64 + n) * 128 + 16 * wave + fr) * 64 + 16 * nt + 4 * fq) = acc[nt]; }
    __syncthreads();
}
__device__ void gla_c_tile(LAS unsigned char* lds, const GlaArgs& A, int tile, int tid) {
    const int bh = tile >> 6, n = tile & 63, b = bh >> 2, h = bh & 3, t0 = b * SEQ + n * 64, s0 = n * 64;
    LAS float* GC = (LAS float*)(lds + GL_GC); LAS bf16_t* QG = (LAS bf16_t*)(lds + GL_T0); LAS bf16_t* KG = QG + 64 * 72; LAS bf16_t* QR = KG + 64 * 72; LAS bf16_t* KR = QR + 64 * 72;
    LAS bf16_t* VT = (LAS bf16_t*)(lds + GL_VT); LAS bf16_t* AL = (LAS bf16_t*)(lds + GL_AL); LAS float* RS = (LAS float*)(lds + GL_RS);
    gla_gcum(lds, A, t0, h, tid);
    for (int e = 0; e < 32; ++e) { const int idx = tid + 512 * e, i = idx >> 8, cc = idx & 255;
        if (cc < 64) { const float q = 0.125f * gla_conv_silu(A.Ug, A.conv, t0 + i, s0 + i, h * 64 + cc); const float eg = __expf(GC[i * 65 + cc]); QG[i * 72 + cc] = f2bf(q * eg); QR[i * 72 + cc] = f2bf(q / eg); }
        else if (cc < 128) { const int d = cc - 64; const float k = gla_conv_silu(A.Ug, A.conv, t0 + i, s0 + i, 256 + h * 64 + d); const float eg = __expf(GC[i * 65 + d]); KG[i * 72 + d] = f2bf(k / eg); KR[i * 72 + d] = f2bf(k * eg); }
        else { const int ev = cc - 128; VT[ev * 72 + i] = f2bf(gla_conv_silu(A.Ug, A.conv, t0 + i, s0 + i, 512 + h * 128 + ev)); } }
    __syncthreads();
    const int lane = tid & 63, wave = tid >> 6, fr = lane & 15, fq = lane >> 4; const int mt = wave >> 1;
    {
#pragma unroll
        for (int q = 0; q < 2; ++q) { const int nt = (wave & 1) * 2 + q; f32x4 ap = (f32x4){0.f, 0.f, 0.f, 0.f}, af = ap;
#pragma unroll
            for (int ks = 0; ks < 2; ++ks) { const int ko = ks * 32 + fq * 8;
                ap = mfma16(*(LAS const bf16x8*)(KG + (16 * nt + fr) * 72 + ko), *(LAS const bf16x8*)(QG + (16 * mt + fr) * 72 + ko), ap);
                af = mfma16(*(LAS const bf16x8*)(KR + (16 * nt + fr) * 72 + ko), *(LAS const bf16x8*)(QR + (16 * mt + fr) * 72 + ko), af); }
            const int trow = 16 * mt + fr; f32x4 o;
#pragma unroll
            for (int j = 0; j < 4; ++j) { const int scol = 16 * nt + 4 * fq + j; o[j] = (scol <= trow) ? ap[j] : af[j]; }
            u32x2 w; w.x = cvt_pk_bf16(o[0], o[1]); w.y = cvt_pk_bf16(o[2], o[3]); *(LAS u32x2*)(AL + trow * 72 + 16 * nt + 4 * fq) = w; }
    }
    __syncthreads();
    f32x4 acc[4];
#pragma unroll
    for (int q = 0; q < 4; ++q) acc[q] = (f32x4){0.f, 0.f, 0.f, 0.f};
    const bf16_t* sp = A.spT + ((size_t)bh * 64 + n) * 128 * 64;
#pragma unroll
    for (int ks = 0; ks < 2; ++ks) { const int ko = ks * 32 + fq * 8; const bf16x8 a1 = *(LAS const bf16x8*)(AL + (16 * mt + fr) * 72 + ko), a2 = *(LAS const bf16x8*)(QG + (16 * mt + fr) * 72 + ko);
#pragma unroll
        for (int q = 0; q < 4; ++q) { const int nt = (wave & 1) * 4 + q;
            acc[q] = mfma16(*(LAS const bf16x8*)(VT + (16 * nt + fr) * 72 + ko), a1, acc[q]);
            acc[q] = mfma16(*(const bf16x8*)(sp + (size_t)(16 * nt + fr) * 64 + ko), a2, acc[q]); } }
    float ssq = 0.f;
#pragma unroll
    for (int q = 0; q < 4; ++q) ssq += (acc[q][0] * acc[q][0] + acc[q][1] * acc[q][1]) + (acc[q][2] * acc[q][2] + acc[q][3] * acc[q][3]);
    ssq += __shfl_xor(ssq, 16); ssq += __shfl_xor(ssq, 32);
    if (fq == 0) RS[(16 * mt + fr) * 2 + (wave & 1)] = ssq;
    __syncthreads();
    { const int i = 16 * mt + fr; const float rs = rsqrtf((RS[i * 2] + RS[i * 2 + 1]) * (1.0f / 128.0f) + 1e-6f);
#pragma unroll
      for (int q = 0; q < 4; ++q) { const int ecol = h * 128 + ((wave & 1) * 4 + q) * 16 + 4 * fq; const f32x4 nw = *(const f32x4*)(A.gnorm + ecol); const f32x4 go = ld_bf4(A.Ug + (size_t)(t0 + i) * 1792 + 1040 + ecol); f32x4 o;
#pragma unroll
          for (int j = 0; j < 4; ++j) o[j] = acc[q][j] * rs * nw[j] * go[j] * sigmoidf_(go[j]);
          st_bf4(A.Yg + (size_t)(t0 + i) * 512 + ecol, o); } }
    __syncthreads();
}

__device__ void xa_tile(const bf16_t* Ux, const bf16_t* Kb, const bf16_t* Vt, bf16_t* Yx, int tile, int tid) {
    const int blk = tile & 31, h = (tile >> 5) & 3, b = tile >> 7; const int lane = tid & 63, wave = tid >> 6, fr = lane & 15, fq = lane >> 4;
    const int t = b * SEQ + blk * 128 + 16 * wave + fr;
    bf16x8 qf[4];
#pragma unroll
    for (int ks = 0; ks < 4; ++ks) qf[ks] = *(const bf16x8*)(Ux + (size_t)t * 512 + h * 128 + ks * 32 + fq * 8);
    f32x4 s[16];
#pragma unroll
    for (int nt = 0; nt < 16; ++nt) { s[nt] = (f32x4){0.f, 0.f, 0.f, 0.f}; const bf16_t* kr = Kb + (size_t)(b * 256 + 16 * nt + fr) * 512 + h * 128 + fq * 8;
#pragma unroll
        for (int ks = 0; ks < 4; ++ks) s[nt] = mfma16(*(const bf16x8*)(kr + ks * 32), qf[ks], s[nt]); }
    float mx = -1e30f;
#pragma unroll
    for (int nt = 0; nt < 16; ++nt)
#pragma unroll
        for (int j = 0; j < 4; ++j) mx = fmaxf(mx, s[nt][j]);
    mx = fmaxf(mx, __shfl_xor(mx, 16)); mx = fmaxf(mx, __shfl_xor(mx, 32));
    const float sc = 0.08838834764831845f * 1.4426950408889634f; float l = 0.f;
#pragma unroll
    for (int nt = 0; nt < 16; ++nt)
#pragma unroll
        for (int j = 0; j < 4; ++j) { const float pz = exp2f((s[nt][j] - mx) * sc); s[nt][j] = pz; l += pz; }
    l += __shfl_xor(l, 16); l += __shfl_xor(l, 32);
    f32x4 o[8];
#pragma unroll
    for (int dt = 0; dt < 8; ++dt) o[dt] = (f32x4){0.f, 0.f, 0.f, 0.f};
#pragma unroll
    for (int c = 0; c < 8; ++c) { union { u32x4 u; bf16x8 v; } pf;
        pf.u.x = cvt_pk_bf16(s[2 * c][0], s[2 * c][1]); pf.u.y = cvt_pk_bf16(s[2 * c][2], s[2 * c][3]); pf.u.z = cvt_pk_bf16(s[2 * c + 1][0], s[2 * c + 1][1]); pf.u.w = cvt_pk_bf16(s[2 * c + 1][2], s[2 * c + 1][3]);
#pragma unroll
        for (int dt = 0; dt < 8; ++dt) { const bf16_t* vr = Vt + ((size_t)b * 512 + h * 128 + 16 * dt + fr) * 256 + 32 * c + 4 * fq; union { u32x4 u; bf16x8 v; } vf;
            const u32x2 lo = *(const u32x2*)vr, hi = *(const u32x2*)(vr + 16); vf.u.x = lo.x; vf.u.y = lo.y; vf.u.z = hi.x; vf.u.w = hi.y;
            o[dt] = mfma16(vf.v, pf.v, o[dt]); } }
    const float il = 1.0f / l;
#pragma unroll
    for (int dt = 0; dt < 8; ++dt) st_bf4(Yx + (size_t)t * 512 + h * 128 + 16 * dt + 4 * fq, o[dt] * il);
}

struct Params { const float* in[33]; float* out; unsigned char* ws; };

__device__ __forceinline__ int opaque0() { int z = 0; asm volatile("" : "+s"(z)); return z; }
__device__ __forceinline__ unsigned char* opq(unsigned char* p) { asm volatile("" : "+s"(p)); return p; }
__device__ __forceinline__ int opqv(int v) { asm volatile("" : "+v"(v)); return v; }
__device__ __forceinline__ int opqs(int v) { asm volatile("" : "+s"(v)); return v; }
#define PH_BEGIN unsigned char* ws = opq(P.ws); const int zi = opaque0(); const int tid = opqv((int)threadIdx.x); const int bid = opqs((int)blockIdx.x); const int G = opqs((int)gridDim.x); (void)tid; (void)bid; (void)G; unsigned char* WB = ws + WS_WB; float* SS = (float*)(ws + WS_SS); (void)WB; (void)SS; (void)zi;
#define INP(k) (P.in[(k) + zi])
#define XB_ ((bf16_t*)(ws + WS_XB))
#define U_ (ws + WS_U)
#define SC_ (ws + WS_SC)
#define Y_ ((bf16_t*)(ws + WS_Y))
#define KB_ ((bf16_t*)(ws + WS_KB))
#define VT_ ((bf16_t*)(ws + WS_VT))

__global__ void __launch_bounds__(512) mega(Params P) {
    extern __shared__ __attribute__((aligned(16))) unsigned char lds_raw[];
    LAS unsigned char* lds = (LAS unsigned char*)lds_raw;
    cg::grid_group grid = cg::this_grid();

    for (int ph = 0; ph < NL * 12 + 1; ++ph) {
        const int l = ph / 12, kph = ph - l * 12;
        if (ph == NL * 12) {
#if (PHMASK >> 12) & 1
    { PH_BEGIN
        const int lane = tid & 63, gw = bid * 8 + (tid >> 6), nw = G * 8;
        const float* fn = INP(32); const float* ssf = SS + (size_t)0 * T * 16; float* X = P.out;
        for (int r = gw; r < T; r += nw) { const float rs = row_rstd(ssf, r);
#pragma unroll
            for (int i = 0; i < 4; ++i) { const size_t o = (size_t)r * D + i * 256 + lane * 4; *(f32x4*)(X + o) = *(const f32x4*)(X + o) * rs * *(const f32x4*)(fn + i * 256 + lane * 4); } }
    }
#endif
            break;
        }
        switch (kph) {
        case 0: {
#if (PHMASK >> 0) & 1
        {
            { PH_BEGIN convT<1>(lds, INP(3) + (size_t)l * D * 2 * FF, 2 * FF, 0, INP(2) + (size_t)l * D, (bf16_t*)(WB + WB_W1A), D, D, 2 * FF, G, bid, tid); }
            { PH_BEGIN convT<0>(lds, INP(4) + (size_t)l * FF * D, D, 0, nullptr, (bf16_t*)(WB + WB_W1B), FF, FF, D, G, bid, tid); }
            { PH_BEGIN convT<2>(lds, INP(7) + (size_t)l * D * 6928, 6928, 0, INP(5) + (size_t)l * D, (bf16_t*)(WB + WB_WIN), D, D, 4096, G, bid, tid); }
            { PH_BEGIN convT<0>(lds, INP(7) + (size_t)l * D * 6928, 6928, 3856, INP(5) + (size_t)l * D, (bf16_t*)(WB + WB_WG), D, D, 3072, G, bid, tid); }
            for (int j = 0; j < 3; ++j) { PH_BEGIN convT<0>(lds, INP(27) + ((size_t)l * 3 + j) * 512 * D, D, 0, nullptr, (bf16_t*)(WB + WB_WBR) + (size_t)j * D * 512, 512, 512, D, G, bid, tid); }
            { PH_BEGIN convT<0>(lds, INP(28) + (size_t)l * D * D, D, 0, nullptr, (bf16_t*)(WB + WB_WO), D, D, D, G, bid, tid); }
            { PH_BEGIN convT<0>(lds, INP(26) + (size_t)l * D * D, D, 0, INP(6) + (size_t)l * D, (bf16_t*)(WB + WB_WKV), D, D, D, G, bid, tid); }
            { PH_BEGIN convT<1>(lds, INP(30) + (size_t)l * D * 2 * FF, 2 * FF, 0, INP(29) + (size_t)l * D, (bf16_t*)(WB + WB_W2A), D, D, 2 * FF, G, bid, tid); }
            { PH_BEGIN convT<0>(lds, INP(31) + (size_t)l * FF * D, D, 0, nullptr, (bf16_t*)(WB + WB_W2B), FF, FF, D, G, bid, tid); }
            { PH_BEGIN convT<0>(lds, INP(10) + (size_t)l * 64 * 512, 512, 0, nullptr, (bf16_t*)(WB + WB_LW2), 64, 64, 512, G, bid, tid); }
            { PH_BEGIN convT<0>(lds, INP(12) + (size_t)l * 64 * 512, 512, 0, nullptr, (bf16_t*)(WB + WB_LA2), 64, 64, 512, G, bid, tid); }
            { PH_BEGIN convT<0>(lds, INP(13) + (size_t)l * 128 * 512, 512, 0, nullptr, (bf16_t*)(WB + WB_LG2), 128, 128, 512, G, bid, tid); }
            if (l > 0) {
                { PH_BEGIN convT<0>(lds, INP(20) + (size_t)(l - 1) * 512 * 32, 32, 0, nullptr, (bf16_t*)(WB + WB_LV1), 512, 512, 32, G, bid, tid); }
                { PH_BEGIN convT<0>(lds, INP(21) + (size_t)(l - 1) * 32 * 512, 512, 0, nullptr, (bf16_t*)(WB + WB_LV2), 32, 32, 512, G, bid, tid); }
            }
            if (l == 0) { PH_BEGIN
                const int lane = tid & 63, gw = bid * 8 + (tid >> 6), nw = G * 8;
                float* rstd_mem = (float*)(ws + WS_MISC); bf16_t* MEMN = (bf16_t*)(ws + WS_MEMN);
                for (int r = gw; r < T + 1024; r += nw) {
                    const bool ism = r >= T; const float* src = ism ? INP(1) + (size_t)(r - T) * D : INP(0) + (size_t)r * D; bf16_t* dst = ism ? MEMN + (size_t)(r - T) * D : XB_ + (size_t)r * D; float q = 0.f;
#pragma unroll
                    for (int i = 0; i < 4; ++i) { const f32x4 v = *(const f32x4*)(src + i * 256 + lane * 4); st_bf4(dst + i * 256 + lane * 4, v); q += (v[0] * v[0] + v[1] * v[1]) + (v[2] * v[2] + v[3] * v[3]); }
                    q = wave_sum(q);
                    if (ism) { if (lane == 0) rstd_mem[r - T] = rsqrtf(q * (1.0f / 1024.0f) + 1e-6f); } else if (lane < 16) SS[(size_t)r * 16 + lane] = (lane == 0) ? q : 0.f;
                }
            }
        }
#endif
        } break;
        case 1: {
#if (PHMASK >> 1) & 1
        { PH_BEGIN
            pg8::Gemm g{XB_, (const bf16_t*)(WB + WB_W1A), T, 2 * FF, D, D, D, 0, 0}; pg8::StaticOrder S; S.init(T, 2 * FF, G, bid, 1);
            EpiFFNa E{(bf16_t*)U_, SS + (size_t)0 * T * 16}; pg8::gemm_phase(lds, g, S, E, tid);
        }
        if ((int)blockIdx.x >= (int)gridDim.x - 16) { PH_BEGIN
            pg8::Gemm g2{(const bf16_t*)(ws + WS_MEMN), (const bf16_t*)(WB + WB_WKV), 1024, D, D, D, D, 0, 0}; pg8::StaticOrder S2; S2.init(1024, D, 16, bid - (G - 16), 1);
            EpiKV E2{KB_, VT_, (const float*)(ws + WS_MISC)}; pg8::gemm_phase(lds, g2, S2, E2, tid);
        }
#endif
        } break;
        case 2: {
#if (PHMASK >> 2) & 1
        { PH_BEGIN
            pg8::Gemm g{(const bf16_t*)U_, (const bf16_t*)(WB + WB_W1B), T, D, FF, FF, FF, 0, 0}; pg8::StaticOrder S; S.init(T, D, G, bid, 1);
            EpiRes E{l == 0 ? INP(0) : P.out, P.out, XB_, SS + (size_t)1 * T * 16, 0.5f}; pg8::gemm_phase(lds, g, S, E, tid);
        }
#endif
        } break;
        case 3: {
#if (PHMASK >> 3) & 1
        { PH_BEGIN
            pg8::Gemm g{XB_, (const bf16_t*)(WB + WB_WIN), T, 4096, D, D, D, 0, 0}; pg8::StaticOrder S; S.init(T, 4096, G, bid, 1);
            EpiU E{(bf16_t*)U_, SS + (size_t)1 * T * 16}; pg8::gemm_phase(lds, g, S, E, tid);
        }
#endif
        } break;
        case 4: {
#if (PHMASK >> 4) & 1
#if P4SUB & 1
        { PH_BEGIN
            PrepArgs PA; PA.U = (const bf16_t*)(U_ + U_RWKV); PA.mu = INP(8) + (size_t)l * 1792; PA.w0 = INP(9) + (size_t)l * 512; PA.a0 = INP(11) + (size_t)l * 512;
            PA.kk_ = INP(14) + (size_t)l * 512; PA.ka = INP(15) + (size_t)l * 512; PA.rk = INP(16) + (size_t)l * 512; PA.v0 = INP(19) + (size_t)(l > 0 ? l - 1 : 0) * 512;
            PA.w2t = (const bf16_t*)(WB + WB_LW2); PA.a2t = (const bf16_t*)(WB + WB_LA2); PA.g2t = (const bf16_t*)(WB + WB_LG2); PA.v1t = (const bf16_t*)(WB + WB_LV1); PA.v2t = (const bf16_t*)(WB + WB_LV2);
            PA.vfirst = (float*)(ws + WS_VF); PA.Wd = (float*)(SC_ + SC_WD); PA.V = (float*)(SC_ + SC_V); PA.RKKB = (bf16_t*)(SC_ + SC_RKKB); PA.Go = (bf16_t*)(ws + WS_GO); PA.Bon = (float*)(ws + WS_BON); PA.layer = l;
            for (int tt = bid; tt < 256; tt += G) rwkv_prep_tile(lds, PA, tt, tid);
        }
#endif
#if P4SUB & 2
        { PH_BEGIN
            GlaArgs GA; GA.Ug = (const bf16_t*)(U_ + U_GLA); GA.conv = INP(22) + (size_t)l * 4096; GA.aup = INP(23) + (size_t)l * 4096; GA.abias = INP(24) + (size_t)l * 256; GA.gnorm = INP(25) + (size_t)l * 512;
            GA.kvcT = (float*)(ws + WS_KVC); GA.dec = (float*)(ws + WS_DEC); GA.spT = (bf16_t*)(U_ + U_SPT); GA.Yg = Y_ + (size_t)T * 512;
            for (int tile = bid; tile < 1024; tile += G) gla_a_tile(lds, GA, tile, tid);
        }
#endif
#if P4SUB & 4
        { PH_BEGIN
            for (int tile = bid; tile < 512; tile += G) xa_tile((const bf16_t*)(U_ + U_XA), KB_, VT_, Y_ + (size_t)2 * T * 512, tile, tid);
        }
#endif
#endif
        } break;
        case 5: {
#if (PHMASK >> 5) & 1
        { PH_BEGIN
            bf16_t* spT = (bf16_t*)(U_ + U_SPT); const float* DEC = (const float*)(ws + WS_DEC); const float* KVC = (const float*)(ws + WS_KVC);
            for (int i = bid * 512 + tid; i < 16 * 128 * 64; i += G * 512) { const int bh = i >> 13, ed = i & 8191, d = i & 63; float st = 0.f;
                for (int n = 0; n < 64; ++n) { const size_t o = ((size_t)bh * 64 + n) * 8192 + ed; spT[o] = f2bf(st); st = st * DEC[((size_t)bh * 64 + n) * 64 + d] + KVC[o]; } }
        }
        { PH_BEGIN
            for (int u = bid; u < 256; u += G) { const int xcd = u & 7, j = u >> 3, p = xcd * 4 + (j >> 3), rg = j & 7;
                rwkv_scan_unit(lds, (const float*)(SC_ + SC_WD), (const float*)(SC_ + SC_V), (const bf16_t*)(SC_ + SC_RKKB), (float*)(U_ + U_YRAW), p, rg, tid); }
        }
#endif
        } break;
        case 6: {
#if (PHMASK >> 6) & 1
        { PH_BEGIN
            const int lane = tid & 63, gw = bid * 8 + (tid >> 6), nw = G * 8;
            const float* lnw = INP(17) + (size_t)l * 512; const float* lnb = INP(18) + (size_t)l * 512; const float* Yraw = (const float*)(U_ + U_YRAW); const float* Vv = (const float*)(SC_ + SC_V);
            const float* BON = (const float*)(ws + WS_BON); const bf16_t* GO = (const bf16_t*)(ws + WS_GO); bf16_t* Y = Y_;
            for (int it = gw; it < 32 * SEQ; it += nw) { const int p = it >> 12, s = it & (SEQ - 1), b = p >> 3, h = p & 7, t = b * SEQ + s;
                const float y = Yraw[(size_t)it * 64 + lane]; const float mean = wave_sum(y) * (1.0f / 64.0f); const float dlt = y - mean; const float var = wave_sum(dlt * dlt) * (1.0f / 64.0f);
                const float yn = dlt * rsqrtf(var + 64e-5f) * lnw[h * 64 + lane] + lnb[h * 64 + lane];
                const float o = (yn + BON[(size_t)t * 8 + h] * Vv[(size_t)it * 64 + lane]) * bf2f(GO[(size_t)t * 512 + h * 64 + lane]);
                Y[(size_t)t * 512 + h * 64 + lane] = f2bf(o); }
        }
        { PH_BEGIN
            GlaArgs GA; GA.Ug = (const bf16_t*)(U_ + U_GLA); GA.conv = INP(22) + (size_t)l * 4096; GA.aup = INP(23) + (size_t)l * 4096; GA.abias = INP(24) + (size_t)l * 256; GA.gnorm = INP(25) + (size_t)l * 512;
            GA.kvcT = (float*)(ws + WS_KVC); GA.dec = (float*)(ws + WS_DEC); GA.spT = (bf16_t*)(U_ + U_SPT); GA.Yg = Y_ + (size_t)T * 512;
            for (int tile = bid; tile < 1024; tile += G) gla_c_tile(lds, GA, tile, tid);
        }
#endif
        } break;
        case 7: {
#if (PHMASK >> 7) & 1
        { PH_BEGIN
            pg8::Gemm g{XB_, (const bf16_t*)(WB + WB_WG), T, 3072, D, D, D, 0, 0}; pg8::StaticOrder S; S.init(T, 3072, G, bid, 1);
            EpiGate E{(bf16_t*)SC_, SS + (size_t)1 * T * 16}; pg8::gemm_phase(lds, g, S, E, tid);
        }
#endif
        } break;
        case 8: {
#if (PHMASK >> 8) & 1
        { PH_BEGIN
            pg8::Gemm g{Y_, (const bf16_t*)(WB + WB_WBR), T, D, 512, 512, 512, (unsigned)T * 512u * 2u, (unsigned)D * 512u * 2u}; pg8::StaticOrder S; S.init(T, D, G, bid, 3);
            EpiMerge E{(const bf16_t*)SC_, (float*)(U_ + U_MG), (bf16_t*)(U_ + U_MGB)}; pg8::gemm_phase(lds, g, S, E, tid);
        }
#endif
        } break;
        case 9: {
#if (PHMASK >> 9) & 1
        { PH_BEGIN
            pg8::Gemm g{(const bf16_t*)(U_ + U_MGB), (const bf16_t*)(WB + WB_WO), T, D, D, D, D, 0, 0}; pg8::StaticOrder S; S.init(T, D, G, bid, 1);
            EpiRes E{P.out, P.out, XB_, SS + (size_t)2 * T * 16, 1.0f}; pg8::gemm_phase(lds, g, S, E, tid);
        }
#endif
        } break;
        case 10: {
#if (PHMASK >> 10) & 1
        { PH_BEGIN
            pg8::Gemm g{XB_, (const bf16_t*)(WB + WB_W2A), T, 2 * FF, D, D, D, 0, 0}; pg8::StaticOrder S; S.init(T, 2 * FF, G, bid, 1);
            EpiFFNa E{(bf16_t*)U_, SS + (size_t)2 * T * 16}; pg8::gemm_phase(lds, g, S, E, tid);
        }
#endif
        } break;
        case 11: {
#if (PHMASK >> 11) & 1
        { PH_BEGIN
            pg8::Gemm g{(const bf16_t*)U_, (const bf16_t*)(WB + WB_W2B), T, D, FF, FF, FF, 0, 0}; pg8::StaticOrder S; S.init(T, D, G, bid, 1);
            EpiRes E{P.out, P.out, XB_, SS + (size_t)0 * T * 16, 0.5f}; pg8::gemm_phase(lds, g, S, E, tid);
        }
#endif
        } break;
        default: break;
        }
        grid.sync();
    }
}

extern "C" void kernel_launch(void* const* d_in, const int* in_sizes, int n_in, void* d_out, int out_size, void* d_ws, size_t ws_size, hipStream_t stream) {
    static int grid_blocks = 0;
    if (!grid_blocks) {
        if (n_in != 33 || ws_size < WS_END) { fprintf(stderr, "kernel_launch: need 33 inputs and %zu bytes of workspace (got %d, %zu)\n", (size_t)WS_END, n_in, ws_size); grid_blocks = -1; return; }
        int dev = 0, cus = 0, per_cu = 0;
        hipGetDevice(&dev); hipDeviceGetAttribute(&cus, hipDeviceAttributeMultiprocessorCount, dev);
        if (hipFuncSetAttribute((const void*)mega, hipFuncAttributeMaxDynamicSharedMemorySize, LDS_BYTES) != hipSuccess) { fprintf(stderr, "kernel_launch: hipFuncSetAttribute failed\n"); grid_blocks = -1; return; }
        if (hipOccupancyMaxActiveBlocksPerMultiprocessor(&per_cu, (const void*)mega, 512, LDS_BYTES) != hipSuccess || per_cu < 1) { fprintf(stderr, "kernel_launch: occupancy query says %d\n", per_cu); per_cu = 1; }
        (void)hipGetLastError();
        grid_blocks = cus * per_cu;
    }
    if (grid_blocks < 0) return;
    Params p{};
    for (int i = 0; i < 33; ++i) p.in[i] = (const float*)d_in[i];
    p.out = (float*)d_out; p.ws = (unsigned char*)d_ws;
    void* args[] = {&p};
    hipError_t e = hipLaunchCooperativeKernel((const void*)mega, dim3(grid_blocks), dim3(512), args, LDS_BYTES, stream);
    if (e != hipSuccess) fprintf(stderr, "cooperative launch failed: %s (grid %d)\n", hipGetErrorString(e), grid_blocks);
}
```

```cpp
#include <hip/hip_runtime.h>
#include <hip/hip_cooperative_groups.h>
#include <cstdio>
namespace cg = cooperative_groups;
#ifndef P4SUB
#define P4SUB 7
#endif
#ifndef REP5
#define REP5 1
#endif
#ifndef REP4
#define REP4 1
#endif
#ifndef REP6
#define REP6 1
#endif
#ifndef REP0
#define REP0 1
#endif
#ifndef REPG
#define REPG 1
#endif
#ifndef REPSYNC
#define REPSYNC 1
#endif
#ifndef PHMASK
#define PHMASK 0xFFFF
#endif

#define LAS __attribute__((address_space(3)))
typedef unsigned short bf16_t;
typedef short bf16x8 __attribute__((ext_vector_type(8)));
typedef float f32x4 __attribute__((ext_vector_type(4)));
typedef float f32x2 __attribute__((ext_vector_type(2)));
typedef unsigned u32x4 __attribute__((ext_vector_type(4)));
typedef unsigned u32x2 __attribute__((ext_vector_type(2)));

constexpr int T = 16384, D = 1024, FF = 2816, SEQ = 4096, NL = 4;
constexpr int LDS_BYTES = 135168;

constexpr size_t MB = 1024 * 1024;
constexpr size_t WS_MISC = 0;
constexpr size_t WS_SS = 1 * MB;
constexpr size_t WS_WB = 4 * MB;
constexpr size_t WB_W1A = 0;
constexpr size_t WB_W1B = WB_W1A + (size_t)5632 * 1024 * 2;
constexpr size_t WB_WIN = WB_W1B + (size_t)1024 * 2816 * 2;
constexpr size_t WB_WG = WB_WIN + (size_t)4096 * 1024 * 2;
constexpr size_t WB_WBR = WB_WG + (size_t)3072 * 1024 * 2;
constexpr size_t WB_WO = WB_WBR + (size_t)3 * 1024 * 512 * 2;
constexpr size_t WB_WKV = WB_WO + (size_t)1024 * 1024 * 2;
constexpr size_t WB_W2A = WB_WKV + (size_t)1024 * 1024 * 2;
constexpr size_t WB_W2B = WB_W2A + (size_t)5632 * 1024 * 2;
constexpr size_t WB_LW2 = WB_W2B + (size_t)1024 * 2816 * 2;
constexpr size_t WB_LA2 = WB_LW2 + 512 * 64 * 2;
constexpr size_t WB_LG2 = WB_LA2 + 512 * 64 * 2;
constexpr size_t WB_LV1 = WB_LG2 + 512 * 128 * 2;
constexpr size_t WB_LV2 = WB_LV1 + 32 * 512 * 2;
constexpr size_t WB_END = WB_LV2 + 512 * 32 * 2;
static_assert(WB_END <= 55 * MB, "weights region");
constexpr size_t WS_XB = WS_WB + 55 * MB;
constexpr size_t WS_VF = WS_XB + 32 * MB;
constexpr size_t WS_MEMN = WS_VF + 32 * MB;
constexpr size_t WS_KB = WS_MEMN + 2 * MB;
constexpr size_t WS_VT = WS_KB + 1 * MB;
constexpr size_t WS_GO = WS_VT + 1 * MB;
constexpr size_t WS_BON = WS_GO + 16 * MB;
constexpr size_t WS_Y = WS_BON + 1 * MB;
constexpr size_t WS_KVC = WS_Y + 48 * MB;
constexpr size_t WS_DEC = WS_KVC + 32 * MB;
constexpr size_t WS_SC = WS_DEC + 1 * MB;
constexpr size_t SC_WD = 0;
constexpr size_t SC_V = 32 * MB;
constexpr size_t SC_RKKB = 64 * MB;
constexpr size_t WS_U = WS_SC + 128 * MB;
constexpr size_t U_RWKV = 0;
constexpr size_t U_GLA = (size_t)T * 1792 * 2;
constexpr size_t U_XA = 2 * (size_t)T * 1792 * 2;
constexpr size_t U_YRAW = 0;
constexpr size_t U_SPT = 32 * MB;
constexpr size_t U_MG = 0;
constexpr size_t U_MGB = 64 * MB;
constexpr size_t WS_END = WS_U + 128 * MB;
static_assert(U_XA + (size_t)T * 512 * 2 <= 128 * MB, "U region");

__device__ __forceinline__ unsigned cvt_pk_bf16(float lo, float hi) { unsigned r; asm volatile("v_cvt_pk_bf16_f32 %0, %1, %2" : "=v"(r) : "v"(lo), "v"(hi)); return r; }
__device__ __forceinline__ bf16_t f2bf(float x) { return (bf16_t)(cvt_pk_bf16(x, 0.f) & 0xffffu); }
__device__ __forceinline__ float bf2f(bf16_t b) { return __uint_as_float(((unsigned)b) << 16); }
__device__ __forceinline__ float bflo(unsigned w) { return __uint_as_float(w << 16); }
__device__ __forceinline__ float bfhi(unsigned w) { return __uint_as_float(w & 0xffff0000u); }
__device__ __forceinline__ f32x4 ld_bf4(const bf16_t* p) { const u32x2 w = *(const u32x2*)p; return (f32x4){bflo(w.x), bfhi(w.x), bflo(w.y), bfhi(w.y)}; }
__device__ __forceinline__ void st_bf4(bf16_t* p, f32x4 v) { u32x2 w; w.x = cvt_pk_bf16(v[0], v[1]); w.y = cvt_pk_bf16(v[2], v[3]); *(u32x2*)p = w; }
__device__ __forceinline__ float sigmoidf_(float x) { return 1.0f / (1.0f + __expf(-x)); }
__device__ __forceinline__ float wave_sum(float v) { for (int o = 32; o >= 1; o >>= 1) v += __shfl_xor(v, o); return v; }
__device__ __forceinline__ f32x4 mfma16(bf16x8 a, bf16x8 b, f32x4 c) { return __builtin_amdgcn_mfma_f32_16x16x32_bf16(a, b, c, 0, 0, 0); }

__device__ __forceinline__ float row_rstd(const float* ssp, int row) {
    const f32x4* p = (const f32x4*)(ssp + (size_t)row * 16); const f32x4 a = p[0], b = p[1], c = p[2], d = p[3];
    const float t = (((a[0] + a[1]) + (a[2] + a[3])) + ((b[0] + b[1]) + (b[2] + b[3]))) + (((c[0] + c[1]) + (c[2] + c[3])) + ((d[0] + d[1]) + (d[2] + d[3])));
    return rsqrtf(t * (1.0f / 1024.0f) + 1e-6f);
}
namespace pg8 {
constexpr int BM = 256, BK = 64, HALF = 128, HTB = HALF * BK * 2, STAGE_BYTES = 8 * HTB, NXCD = 8, WGM = 8;
__device__ __forceinline__ int lds_byte(int r, int c) { const int st = (r >> 4) * 2 + (c >> 5), rr = r & 15, cc = c & 31, ob = rr * 64 + cc * 2; return st * 1024 + (ob ^ (((ob >> 9) & 1) << 5)); }
__device__ __forceinline__ void stage_rc(int b, int& R, int& C) { const int st = b / 1024, sb = b % 1024, swz = sb ^ (((sb >> 9) & 1) << 5); R = (st >> 1) * 16 + swz / 64; C = (st & 1) * 32 + (swz % 64) / 2; }
__device__ __forceinline__ int perm32(int rho) { const int n = rho >> 4, i = rho & 15; return 8 * (i >> 2) + 4 * n + (i & 3); }

struct Unit { int pm, pn, z; };
struct Gemm { const bf16_t* A; const bf16_t* Bt; int M, N, K, lda, ldb; unsigned zA, zB; };

struct StaticOrder {
    int nM, nN, nwg, G, c, nz;
    __device__ void init(int M, int N, int G_, int c_, int nz_) { nM = M / BM; nN = N / BM; nwg = nM * nN; G = G_; c = c_; nz = nz_; }
    __device__ bool next(int i, Unit& u) const {
        const int ti = i / nz; u.z = i - ti * nz;
        const long L = (long)ti * G + c; if (L >= nwg) return false;
        int wgid = (int)L; { const int q = nwg / NXCD, r = nwg % NXCD, xcd = wgid % NXCD, off = wgid / NXCD; wgid = (xcd < r ? xcd * (q + 1) : r * (q + 1) + (xcd - r) * q) + off; }
        const int nig = WGM * nN, gid = wgid / nig, fm = gid * WGM, gsz = (nM - fm) < WGM ? (nM - fm) : WGM;
        u.pm = fm + ((wgid % nig) % gsz); u.pn = (wgid % nig) / gsz; return true;
    }
};

template <class Epi>
__device__ __forceinline__ void gemm_phase(LAS unsigned char* lds, const Gemm g, const StaticOrder& S, const Epi& E, const int tid) {
    const int wid = __builtin_amdgcn_readfirstlane(tid >> 6), lane = tid & 63, wr = wid >> 2, wc = wid & 3, fr = lane & 15, fq = lane >> 4;
    const int K = g.K, nt = K / BK;
    unsigned voffA[2], voffB[2];
#pragma unroll
    for (int i = 0; i < 2; ++i) { int R, C; stage_rc(tid * 16 + i * 8192, R, C); const int Rb = Epi::PERM ? ((R & ~31) + perm32(R & 31)) : R;
        voffA[i] = (unsigned)(R * g.lda + C) * 2u; voffB[i] = (unsigned)(Rb * g.ldb + C) * 2u; }
    const unsigned kstep = (unsigned)(BK * 2);
    const unsigned hstepA = (unsigned)HALF * g.lda * 2u, hstepB = (unsigned)HALF * g.ldb * 2u;
    const unsigned tstepA = 2u * hstepA, tstepB = 2u * hstepB;
    const unsigned ldsw = (unsigned)wid * 1024u;
    const int aoff = lds_byte(wr * 64 + fr, fq * 8), boff = lds_byte(wc * 32 + fr, fq * 8);
    const char* const gA = (const char*)g.A; const char* const gB = (const char*)g.Bt;
#define PG8_SA(b, h) (((b) * 2 + (h)) * HTB)
#define PG8_SB(b, h) ((4 + (b) * 2 + (h)) * HTB)
#define PG8_STAGE(bufoff, gbase, soff, voff) do { _Pragma("unroll") for (int _i = 0; _i < 2; ++_i) \
        __builtin_amdgcn_global_load_lds((const unsigned*)(((gbase) + (size_t)(unsigned)(soff)) + (voff)[_i]), (LAS unsigned*)(lds + (bufoff) + ldsw + _i * 8192), 16, 0, 0); } while (0)
#define PG8_LDA(dst, b, h) do { _Pragma("unroll") for (int m = 0; m < 4; ++m) _Pragma("unroll") for (int k = 0; k < 2; ++k) dst[m][k] = *(const LAS bf16x8*)(lds + PG8_SA(b, h) + aoff + m * 2048 + k * 1024); } while (0)
#define PG8_LDB(dst, b, h) do { _Pragma("unroll") for (int n = 0; n < 2; ++n) _Pragma("unroll") for (int k = 0; k < 2; ++k) dst[n][k] = *(const LAS bf16x8*)(lds + PG8_SB(b, h) + boff + n * 2048 + k * 1024); } while (0)
#define PG8_MMA(ai, bj, At, Bt) do { __builtin_amdgcn_s_setprio(1); _Pragma("unroll") for (int m = 0; m < 4; ++m) _Pragma("unroll") for (int n = 0; n < 2; ++n) _Pragma("unroll") for (int k = 0; k < 2; ++k) \
        acc[ai][bj][m][n] = __builtin_amdgcn_mfma_f32_16x16x32_bf16(Bt[n][k], At[m][k], acc[ai][bj][m][n], 0, 0, 0); __builtin_amdgcn_s_setprio(0); } while (0)
#define PG8_WAIT_V(n) asm volatile("s_waitcnt vmcnt(" #n ")" ::: "memory")
#define PG8_WAIT_L(n) asm volatile("s_waitcnt lgkmcnt(" #n ")" ::: "memory")
#define PG8_BAR __builtin_amdgcn_s_barrier()
#define PG8_SCHED __builtin_amdgcn_sched_barrier(0)
    Unit cur, nxt; int ui = 0;
    if (!S.next(0, cur)) return;
    f32x4 acc[2][2][4][2];
#pragma unroll
    for (int a = 0; a < 2; ++a)
#pragma unroll
        for (int b = 0; b < 2; ++b)
#pragma unroll
            for (int m = 0; m < 4; ++m)
#pragma unroll
                for (int n = 0; n < 2; ++n) acc[a][b][m][n] = (f32x4){0.f, 0.f, 0.f, 0.f};
    bf16x8 At[4][2], B0[2][2], B1[2][2];
    unsigned cA = (unsigned)cur.z * g.zA + (unsigned)cur.pm * tstepA, cB = (unsigned)cur.z * g.zB + (unsigned)cur.pn * tstepB;
    PG8_STAGE(PG8_SB(0, 0), gB, cB, voffB); PG8_STAGE(PG8_SA(0, 0), gA, cA, voffA); PG8_STAGE(PG8_SB(0, 1), gB, cB + hstepB, voffB); PG8_STAGE(PG8_SA(0, 1), gA, cA + hstepA, voffA);
    if (wr == 1) PG8_BAR;
    PG8_WAIT_V(4); PG8_BAR;
    PG8_STAGE(PG8_SB(1, 0), gB, cB + kstep, voffB); PG8_STAGE(PG8_SA(1, 0), gA, cA + kstep, voffA); PG8_STAGE(PG8_SB(1, 1), gB, cB + hstepB + kstep, voffB);
    PG8_WAIT_V(6); PG8_BAR;
    for (;;) {
        const bool has_next = S.next(ui + 1, nxt);
        const unsigned nA = has_next ? (unsigned)nxt.z * g.zA + (unsigned)nxt.pm * tstepA : cA, nB = has_next ? (unsigned)nxt.z * g.zB + (unsigned)nxt.pn * tstepB : cB;
        for (int t = 0; t < nt; t += 2) {
            const bool last = (t == nt - 2);
            const unsigned a1 = cA + (unsigned)(t + 1) * kstep;
            const unsigned a2 = last ? nA : cA + (unsigned)(t + 2) * kstep, b2 = last ? nB : cB + (unsigned)(t + 2) * kstep;
            const unsigned a3 = a2 + kstep, b3 = b2 + kstep;
            PG8_LDB(B0, 0, 0); PG8_SCHED; PG8_LDA(At, 0, 0); PG8_STAGE(PG8_SA(1, 1), gA, a1 + hstepA, voffA);
            PG8_WAIT_L(8); PG8_BAR; PG8_WAIT_L(0); PG8_MMA(0, 0, At, B0); PG8_BAR; PG8_SCHED;
            PG8_LDB(B1, 0, 1); PG8_STAGE(PG8_SB(0, 0), gB, b2, voffB);
            PG8_BAR; PG8_WAIT_L(0); PG8_MMA(0, 1, At, B1); PG8_BAR;
            PG8_LDA(At, 0, 1); PG8_STAGE(PG8_SA(0, 0), gA, a2, voffA);
            PG8_BAR; PG8_WAIT_L(0); PG8_MMA(1, 0, At, B0); PG8_BAR; PG8_SCHED;
            PG8_STAGE(PG8_SB(0, 1), gB, b2 + hstepB, voffB);
            PG8_WAIT_V(6); PG8_BAR; PG8_MMA(1, 1, At, B1); PG8_BAR;
            PG8_LDB(B0, 1, 0); PG8_SCHED; PG8_LDA(At, 1, 0); PG8_STAGE(PG8_SA(0, 1), gA, a2 + hstepA, voffA);
            PG8_WAIT_L(8); PG8_BAR; PG8_WAIT_L(0); PG8_MMA(0, 0, At, B0); PG8_BAR; PG8_SCHED;
            PG8_LDB(B1, 1, 1); PG8_STAGE(PG8_SB(1, 0), gB, b3, voffB);
            PG8_BAR; PG8_WAIT_L(0); PG8_MMA(0, 1, At, B1); PG8_BAR;
            PG8_LDA(At, 1, 1); PG8_STAGE(PG8_SA(1, 0), gA, a3, voffA);
            PG8_BAR; PG8_WAIT_L(0); PG8_MMA(1, 0, At, B0); PG8_BAR; PG8_SCHED;
            PG8_STAGE(PG8_SB(1, 1), gB, b3 + hstepB, voffB);
            PG8_WAIT_V(6); PG8_BAR; PG8_MMA(1, 1, At, B1); PG8_BAR;
        }
        E(acc, cur, wr, wc, fr, fq);
        if (!has_next) break;
#pragma unroll
        for (int a = 0; a < 2; ++a)
#pragma unroll
            for (int b = 0; b < 2; ++b)
#pragma unroll
                for (int m = 0; m < 4; ++m)
#pragma unroll
                    for (int n = 0; n < 2; ++n) acc[a][b][m][n] = (f32x4){0.f, 0.f, 0.f, 0.f};
        cur = nxt; cA = nA; cB = nB; ++ui;
    }
    PG8_WAIT_V(0);
    if (wr == 0) PG8_BAR;
    PG8_BAR;
#undef PG8_SA
#undef PG8_SB
#undef PG8_STAGE
#undef PG8_LDA
#undef PG8_LDB
#undef PG8_MMA
#undef PG8_WAIT_V
#undef PG8_WAIT_L
#undef PG8_BAR
#undef PG8_SCHED
}
}
using pg8::Unit;
typedef f32x4 Acc[2][2][4][2];

struct EpiFFNa { static constexpr bool PERM = false; bf16_t* H; const float* ss;
    __device__ __forceinline__ void operator()(const Acc& acc, const Unit& u, int wr, int wc, int fr, int fq) const {
        const int row0 = u.pm * 256 + wr * 64 + fr, hc0 = u.pn * 128 + wc * 16 + 4 * fq;
#pragma unroll
        for (int ai = 0; ai < 2; ++ai)
#pragma unroll
            for (int m = 0; m < 4; ++m) { const int row = row0 + ai * 128 + m * 16; const float rs = row_rstd(ss, row);
#pragma unroll
                for (int bj = 0; bj < 2; ++bj) { const f32x4 gt = acc[ai][bj][m][0] * rs, up = acc[ai][bj][m][1] * rs; f32x4 h;
#pragma unroll
                    for (int j = 0; j < 4; ++j) h[j] = gt[j] * sigmoidf_(gt[j]) * up[j];
                    st_bf4(H + (size_t)row * FF + hc0 + bj * 64, h); } }
    }
};
struct EpiRes { static constexpr bool PERM = false; const float* xin; float* xout; bf16_t* xb; float* ss_out; float scale;
    __device__ __forceinline__ void operator()(const Acc& acc, const Unit& u, int wr, int wc, int fr, int fq) const {
        const int row0 = u.pm * 256 + wr * 64 + fr, col0 = u.pn * 256 + wc * 32 + 4 * fq;
#pragma unroll
        for (int ai = 0; ai < 2; ++ai)
#pragma unroll
            for (int m = 0; m < 4; ++m) { const int row = row0 + ai * 128 + m * 16; float q = 0.f;
#pragma unroll
                for (int bj = 0; bj < 2; ++bj)
#pragma unroll
                    for (int n = 0; n < 2; ++n) { const size_t o = (size_t)row * D + col0 + bj * 128 + n * 16; const f32x4 v = *(const f32x4*)(xin + o) + acc[ai][bj][m][n] * scale;
                        *(f32x4*)(xout + o) = v; st_bf4(xb + o, v); q += (v[0] * v[0] + v[1] * v[1]) + (v[2] * v[2] + v[3] * v[3]); }
                q += __shfl_xor(q, 16); q += __shfl_xor(q, 32);
                if (fq == 0) ss_out[(size_t)row * 16 + u.pn * 4 + wc] = q; }
    }
};
struct EpiU { static constexpr bool PERM = true; bf16_t* Ubase; const float* ss;
    __device__ __forceinline__ void operator()(const Acc& acc, const Unit& u, int wr, int wc, int fr, int fq) const {
        bf16_t* base; int ld, c0;
        if (u.pn < 7) { base = (bf16_t*)((char*)Ubase + U_RWKV); ld = 1792; c0 = u.pn * 256; }
        else if (u.pn < 14) { base = (bf16_t*)((char*)Ubase + U_GLA); ld = 1792; c0 = (u.pn - 7) * 256; }
        else { base = (bf16_t*)((char*)Ubase + U_XA); ld = 512; c0 = (u.pn - 14) * 256; }
        const int row0 = u.pm * 256 + wr * 64 + fr; c0 += wc * 32 + 8 * fq;
#pragma unroll
        for (int ai = 0; ai < 2; ++ai)
#pragma unroll
            for (int m = 0; m < 4; ++m) { const int row = row0 + ai * 128 + m * 16; const float rs = row_rstd(ss, row);
#pragma unroll
                for (int bj = 0; bj < 2; ++bj) { const f32x4 v0 = acc[ai][bj][m][0] * rs, v1 = acc[ai][bj][m][1] * rs; u32x4 w;
                    w.x = cvt_pk_bf16(v0[0], v0[1]); w.y = cvt_pk_bf16(v0[2], v0[3]); w.z = cvt_pk_bf16(v1[0], v1[1]); w.w = cvt_pk_bf16(v1[2], v1[3]);
                    *(u32x4*)(base + (size_t)row * ld + c0 + bj * 128) = w; } }
    }
};
struct EpiGate { static constexpr bool PERM = true; bf16_t* Gt; const float* ss;
    __device__ __forceinline__ void operator()(const Acc& acc, const Unit& u, int wr, int wc, int fr, int fq) const {
        const int row0 = u.pm * 256 + wr * 64 + fr, c0 = u.pn * 256 + wc * 32 + 8 * fq;
#pragma unroll
        for (int ai = 0; ai < 2; ++ai)
#pragma unroll
            for (int m = 0; m < 4; ++m) { const int row = row0 + ai * 128 + m * 16; const float rs = row_rstd(ss, row);
#pragma unroll
                for (int bj = 0; bj < 2; ++bj) { f32x4 v0 = acc[ai][bj][m][0] * rs, v1 = acc[ai][bj][m][1] * rs;
#pragma unroll
                    for (int j = 0; j < 4; ++j) { v0[j] = sigmoidf_(v0[j]); v1[j] = sigmoidf_(v1[j]); }
                    u32x4 w; w.x = cvt_pk_bf16(v0[0], v0[1]); w.y = cvt_pk_bf16(v0[2], v0[3]); w.z = cvt_pk_bf16(v1[0], v1[1]); w.w = cvt_pk_bf16(v1[2], v1[3]);
                    *(u32x4*)(Gt + (size_t)row * 3072 + c0 + bj * 128) = w; } }
    }
};
struct EpiMerge { static constexpr bool PERM = false; const bf16_t* Gt; float* Mg; bf16_t* Mb;
    __device__ __forceinline__ void operator()(const Acc& acc, const Unit& u, int wr, int wc, int fr, int fq) const {
        const int row0 = u.pm * 256 + wr * 64 + fr, col0 = u.pn * 256 + wc * 32 + 4 * fq;
#pragma unroll
        for (int ai = 0; ai < 2; ++ai)
#pragma unroll
            for (int m = 0; m < 4; ++m) { const int row = row0 + ai * 128 + m * 16;
#pragma unroll
                for (int bj = 0; bj < 2; ++bj)
#pragma unroll
                    for (int n = 0; n < 2; ++n) { const int col = col0 + bj * 128 + n * 16; const size_t o = (size_t)row * D + col;
                        f32x4 v = acc[ai][bj][m][n] * ld_bf4(Gt + (size_t)row * 3072 + u.z * 1024 + col);
                        if (u.z > 0) v += *(const f32x4*)(Mg + o);
                        if (u.z < 2) *(f32x4*)(Mg + o) = v; else st_bf4(Mb + o, v); } }
    }
};
struct EpiKV { static constexpr bool PERM = false; bf16_t* Kb; bf16_t* Vt; const float* rstd;
    __device__ __forceinline__ void operator()(const Acc& acc, const Unit& u, int wr, int wc, int fr, int fq) const {
        const int row0 = u.pm * 256 + wr * 64 + fr, col0 = u.pn * 256 + wc * 32 + 4 * fq;
#pragma unroll
        for (int ai = 0; ai < 2; ++ai)
#pragma unroll
            for (int m = 0; m < 4; ++m) { const int row = row0 + ai * 128 + m * 16; const float rs = rstd[row];
#pragma unroll
                for (int bj = 0; bj < 2; ++bj)
#pragma unroll
                    for (int n = 0; n < 2; ++n) { const int col = col0 + bj * 128 + n * 16; const f32x4 v = acc[ai][bj][m][n] * rs;
                        if (col < 512) st_bf4(Kb + (size_t)row * 512 + col, v);
                        else {
#pragma unroll
                            for (int j = 0; j < 4; ++j) Vt[((size_t)(row >> 8) * 512 + (col - 512 + j)) * 256 + (row & 255)] = f2bf(v[j]); } } }
    }
};

template <int MAP> __device__ __forceinline__ int colmap(int n) {
    if (MAP == 1) { const int g = n >> 5, i = n & 31; return i < 16 ? 16 * g + i : FF + 16 * g + (i - 16); }
    if (MAP == 2) { if (n < 3344) return n; if (n < 3584) return -1; return n - 240; }
    return n;
}
template <int MAP>
__device__ void convT(LAS unsigned char* lds, const float* src, int ld, int coff, const float* g, bf16_t* dst, int K, int Kd, int Nd, int G, int bid, int tid) {
    const int nkt = (K + 63) >> 6, nnt = (Nd + 63) >> 6, ntile = nkt * nnt;
    LAS bf16_t* tile = (LAS bf16_t*)lds;
    for (int t = bid; t < ntile; t += G) {
        const int kt = t % nkt, ntl = t / nkt, k0 = kt * 64, n0 = ntl * 64;
        { const int nl = tid & 63, kl0 = tid >> 6, n = n0 + nl; const int c = (n < Nd) ? colmap<MAP>(n) : -1;
#pragma unroll
          for (int i = 0; i < 8; ++i) { const int kl = kl0 + 8 * i, k = k0 + kl; float v = 0.f;
              if (c >= 0 && k < K) { v = src[(size_t)k * ld + coff + c]; if (g) v *= g[k]; }
              tile[nl * 72 + kl] = f2bf(v); } }
        __syncthreads();
        { const int nl = tid >> 3, kc = (tid & 7) * 8, n = n0 + nl, k = k0 + kc;
          if (n < Nd && k < Kd) *(u32x4*)(dst + (size_t)n * Kd + k) = *(LAS u32x4*)(tile + nl * 72 + kc); }
        __syncthreads();
    }
}

template <int K>
__device__ __forceinline__ void wave_gemm(f32x4 (&acc)[4][4], LAS const unsigned char* A, int sA, const bf16_t* Bt, int fr, int fq) {
#pragma unroll
    for (int m = 0; m < 4; ++m)
#pragma unroll
        for (int n = 0; n < 4; ++n) acc[m][n] = (f32x4){0.f, 0.f, 0.f, 0.f};
#pragma unroll
    for (int ks = 0; ks < K / 32; ++ks) { bf16x8 a[4], b[4];
#pragma unroll
        for (int m = 0; m < 4; ++m) a[m] = *(LAS const bf16x8*)(A + (16 * m + fr) * sA + (ks * 32 + fq * 8) * 2);
#pragma unroll
        for (int n = 0; n < 4; ++n) b[n] = *(const bf16x8*)(Bt + (size_t)(16 * n + fr) * K + ks * 32 + fq * 8);
#pragma unroll
        for (int m = 0; m < 4; ++m)
#pragma unroll
            for (int n = 0; n < 4; ++n) acc[m][n] = mfma16(b[n], a[m], acc[m][n]); }
}

template <int K>
__device__ __forceinline__ void row_gemm(f32x4 (&acc)[4], LAS const unsigned char* Arow, const bf16_t* Bt, int fr, int fq) {
#pragma unroll
    for (int n = 0; n < 4; ++n) acc[n] = (f32x4){0.f, 0.f, 0.f, 0.f};
#pragma unroll
    for (int ks = 0; ks < K / 32; ++ks) { const bf16x8 a = *(LAS const bf16x8*)(Arow + (ks * 32 + fq * 8) * 2);
#pragma unroll
        for (int n = 0; n < 4; ++n) { const bf16x8 b = *(const bf16x8*)(Bt + (size_t)(16 * n + fr) * K + ks * 32 + fq * 8); acc[n] = mfma16(b, a, acc[n]); } }
}

struct PrepArgs { const bf16_t* U; const float *mu, *w0, *a0, *kk_, *ka, *rk, *v0; const bf16_t *w2t, *a2t, *g2t, *v1t, *v2t; float* vfirst; float* Wd; float* V; bf16_t* RKKB; bf16_t* Go; float* Bon; int layer; };

__device__ __forceinline__ f32x4 shifted4(const bf16_t* Ut, bool has_prev, int c, const float* mu) {
    const f32x4 u = ld_bf4(Ut + c); f32x4 p = (f32x4){0.f, 0.f, 0.f, 0.f}; if (has_prev) p = ld_bf4(Ut - 1792 + c);
    const f32x4 m = *(const f32x4*)(mu + c); return u + m * (p - u);
}

__device__ void rwkv_prep_tile(LAS unsigned char* lds, const PrepArgs& P, int tt, int tid) {
    constexpr int SW = 144, SG = 272, SV = 1040, SVV = 80;
    LAS unsigned char* LAw = lds; LAS unsigned char* LAa = lds + 9216; LAS unsigned char* LAg = lds + 18432; LAS unsigned char* LAv = lds + 35840; LAS unsigned char* LAvv = lds + 102400;
    const int t0 = tt * 64; const int s0 = t0 & (SEQ - 1);
    const int lane = tid & 63, wave = __builtin_amdgcn_readfirstlane(tid >> 6), fr = lane & 15, fq = lane >> 4;
#pragma unroll 2
    for (int e = 0; e < 32; ++e) { const int idx = tid + 512 * e, i = idx >> 8, c = idx & 255; const bf16_t* Ut = P.U + (size_t)(t0 + i) * 1792 + 1536 + c;
        const float u = bf2f(*Ut), p = (s0 + i > 0) ? bf2f(*(Ut - 1792)) : 0.f; const float x = u + P.mu[1536 + c] * (p - u);
        if (c < 64) { const float e2 = __expf(2.f * x); *(LAS bf16_t*)(LAw + i * SW + c * 2) = f2bf(1.f - 2.f / (e2 + 1.f)); }
        else if (c < 128) *(LAS bf16_t*)(LAa + i * SW + (c - 64) * 2) = f2bf(x);
        else *(LAS bf16_t*)(LAg + i * SG + (c - 128) * 2) = f2bf(sigmoidf_(x)); }
    if (P.layer > 0) {
#pragma unroll 2
        for (int e = 0; e < 16; ++e) { const int idx = tid + 512 * e, i = idx >> 7, c = (idx & 127) * 4; const bf16_t* Ut = P.U + (size_t)(t0 + i) * 1792;
            const f32x4 x = shifted4(Ut, s0 + i > 0, 1024 + c, P.mu); u32x2 w; w.x = cvt_pk_bf16(x[0], x[1]); w.y = cvt_pk_bf16(x[2], x[3]); *(LAS u32x2*)(LAv + i * SV + c * 2) = w; }
    }
    __syncthreads();
    if (P.layer > 0) {
        const int mt = wave >> 1, nt = wave & 1; f32x4 acc = (f32x4){0.f, 0.f, 0.f, 0.f};
#pragma unroll 4
        for (int ks = 0; ks < 16; ++ks) { const bf16x8 a = *(LAS const bf16x8*)(LAv + (16 * mt + fr) * SV + (ks * 32 + fq * 8) * 2);
            const bf16x8 b = *(const bf16x8*)(P.v1t + (size_t)(16 * nt + fr) * 512 + ks * 32 + fq * 8); acc = mfma16(b, a, acc); }
        u32x2 w; w.x = cvt_pk_bf16(acc[0], acc[1]); w.y = cvt_pk_bf16(acc[2], acc[3]); *(LAS u32x2*)(LAvv + (16 * mt + fr) * SVV + (16 * nt + 4 * fq) * 2) = w;
    }
    __syncthreads();
    const int h = wave, cb = 64 * h; const int b_ = t0 >> 12, p = b_ * 8 + h;
#pragma unroll 1
    for (int m = 0; m < 4; ++m) {
        const int i = 16 * m + fr; const bf16_t* Ut = P.U + (size_t)(t0 + i) * 1792; const bool hp = (s0 + i) > 0;
        int fq4 = 4 * fq; asm volatile("" : "+v"(fq4));
        f32x4 aa[4], acc[4];
        row_gemm<64>(aa, LAa + i * SW, P.a2t + (size_t)cb * 64, fr, fq);
#pragma unroll
        for (int n = 0; n < 4; ++n) { const f32x4 a0v = *(const f32x4*)(P.a0 + cb + 16 * n + fq4);
#pragma unroll
            for (int j = 0; j < 4; ++j) aa[n][j] = sigmoidf_(aa[n][j] + a0v[j]); }
        row_gemm<64>(acc, LAw + i * SW, P.w2t + (size_t)cb * 64, fr, fq);
#pragma unroll
        for (int n = 0; n < 4; ++n) { const f32x4 w0v = *(const f32x4*)(P.w0 + cb + 16 * n + fq4); f32x4 d;
#pragma unroll
            for (int j = 0; j < 4; ++j) d[j] = __expf(-0.6065306597f * sigmoidf_(acc[n][j] + w0v[j]));
            *(f32x4*)(P.Wd + ((size_t)p * SEQ + s0 + i) * 64 + 16 * n + fq4) = d; }
        row_gemm<128>(acc, LAg + i * SG, P.g2t + (size_t)cb * 128, fr, fq);
#pragma unroll
        for (int n = 0; n < 4; ++n) st_bf4(P.Go + (size_t)(t0 + i) * 512 + cb + 16 * n + fq4, acc[n]);
        asm volatile("" ::: "memory");
        if (P.layer > 0) row_gemm<32>(acc, LAvv + i * SVV, P.v2t + (size_t)cb * 32, fr, fq);
        float bon = 0.f, nk = 0.f; f32x4 kv[4], rv[4];
#pragma unroll
        for (int n = 0; n < 4; ++n) { const int c = cb + 16 * n + fq4;
            f32x4 v = shifted4(Ut, hp, 1024 + c, P.mu);
            if (P.layer > 0) { const f32x4 vf = *(const f32x4*)(P.vfirst + (size_t)(t0 + i) * 512 + c); const f32x4 v0v = *(const f32x4*)(P.v0 + c);
#pragma unroll
                for (int j = 0; j < 4; ++j) v[j] = v[j] + (vf[j] - v[j]) * sigmoidf_(v0v[j] + acc[n][j]); }
            else *(f32x4*)(P.vfirst + (size_t)(t0 + i) * 512 + c) = v;
            *(f32x4*)(P.V + ((size_t)p * SEQ + s0 + i) * 64 + 16 * n + fq4) = v;
            kv[n] = shifted4(Ut, hp, 512 + c, P.mu); rv[n] = shifted4(Ut, hp, c, P.mu);
            const f32x4 kkw = *(const f32x4*)(P.kk_ + c);
#pragma unroll
            for (int j = 0; j < 4; ++j) { const float x = kv[n][j] * kkw[j]; nk += x * x; } }
        nk += __shfl_xor(nk, 16); nk += __shfl_xor(nk, 32);
        const float inv = 1.0f / fmaxf(sqrtf(nk), 1e-12f);
        bf16_t* O = P.RKKB + ((size_t)p * SEQ + s0 + i) * 256;
#pragma unroll
        for (int n = 0; n < 4; ++n) { const int c = cb + 16 * n + fq4; const f32x4 kkw = *(const f32x4*)(P.kk_ + c), kaw = *(const f32x4*)(P.ka + c), rkw = *(const f32x4*)(P.rk + c);
            f32x4 kk, kh, bb;
#pragma unroll
            for (int j = 0; j < 4; ++j) { const float a = aa[n][j]; kk[j] = kv[n][j] * kkw[j] * inv; kh[j] = kv[n][j] * (1.f + (a - 1.f) * kaw[j]); bb[j] = kk[j] * a; bon += rv[n][j] * kh[j] * rkw[j]; }
            const int cc = 16 * n + fq4; st_bf4(O + cc, rv[n]); st_bf4(O + 64 + cc, kh); st_bf4(O + 128 + cc, kk); st_bf4(O + 192 + cc, bb); }
        bon += __shfl_xor(bon, 16); bon += __shfl_xor(bon, 32);
        if (fq == 0) P.Bon[(size_t)(t0 + i) * 8 + h] = bon;
        asm volatile("" ::: "memory");
    }
    __syncthreads();
}

constexpr int SCAN_CH = 32, SCAN_STEP_B = 1312, SCAN_SLOT_B = SCAN_CH * SCAN_STEP_B;
template <int CTRL> __device__ __forceinline__ float dpp_f(float v) { return __int_as_float(__builtin_amdgcn_update_dpp(0, __float_as_int(v), CTRL, 0xf, 0xf, true)); }
__device__ __forceinline__ float row16_sum(float v) { v += dpp_f<0xB1>(v); v += dpp_f<0x4E>(v); v += dpp_f<0x141>(v); v += dpp_f<0x140>(v); return v; }

__device__ __forceinline__ void scan_load_chunk(LAS unsigned char* slot, const float* Wd, const float* V, const bf16_t* RKKB, int p, int rg, int s0, int ltid, int nthr) {
    for (int idx = ltid; idx < 1600; idx += nthr) {
        if (idx < 512) { const int st = idx >> 4, part = idx & 15; *(LAS f32x4*)(slot + st * SCAN_STEP_B + part * 16) = *(const f32x4*)(Wd + ((size_t)p * SEQ + s0 + st) * 64 + part * 4); }
        else if (idx < 1536) { const int k = idx - 512, st = k >> 5, rem = k & 31, q = rem >> 3, part = rem & 7;
            const u32x4 w = *(const u32x4*)(RKKB + (((size_t)p * SEQ + s0 + st) * 4 + q) * 64 + part * 8);
            const int Q = (q == 0) ? 4 : (q == 1) ? 2 : (q == 2) ? 3 : 1;
            LAS f32x4* d = (LAS f32x4*)(slot + st * SCAN_STEP_B + Q * 256 + part * 32);
            d[0] = (f32x4){bflo(w.x), bfhi(w.x), bflo(w.y), bfhi(w.y)}; d[1] = (f32x4){bflo(w.z), bfhi(w.z), bflo(w.w), bfhi(w.w)}; }
        else { const int k = idx - 1536, st = k >> 1, hf = k & 1; *(LAS f32x4*)(slot + st * SCAN_STEP_B + 1280 + hf * 16) = *(const f32x4*)(V + ((size_t)p * SEQ + s0 + st) * 64 + rg * 8 + hf * 4); }
    }
}

__device__ void rwkv_scan_unit(LAS unsigned char* lds, const float* Wd, const float* V, const bf16_t* RKKB, float* Yraw, int p, int rg, int tid) {
    const int lane = tid & 63, wave = __builtin_amdgcn_readfirstlane(tid >> 6);
    constexpr int NCH = SEQ / SCAN_CH;
    scan_load_chunk(lds, Wd, V, RKKB, p, rg, 0, tid, 512);
    scan_load_chunk(lds + SCAN_SLOT_B, Wd, V, RKKB, p, rg, SCAN_CH, tid, 512);
    __syncthreads();
    f32x4 S = (f32x4){0.f, 0.f, 0.f, 0.f};
    const int kq = lane & 15, rl = wave * 4 + (lane >> 4);
    for (int c = 0; c < NCH; ++c) {
        if (wave >= 2) { if (c + 2 < NCH) scan_load_chunk(lds + ((c + 2) % 3) * SCAN_SLOT_B, Wd, V, RKKB, p, rg, (c + 2) * SCAN_CH, tid - 128, 384); }
        else {
            LAS const unsigned char* sl = lds + (c % 3) * SCAN_SLOT_B + kq * 16;
            LAS const unsigned char* vl = lds + (c % 3) * SCAN_SLOT_B + 1280 + rl * 4;
            float* yo = Yraw + ((size_t)p * SEQ + c * SCAN_CH + kq) * 64 + rg * 8 + rl;
            f32x4 w = *(LAS const f32x4*)(sl), b = *(LAS const f32x4*)(sl + 256), k = *(LAS const f32x4*)(sl + 512), kk = *(LAS const f32x4*)(sl + 768), r = *(LAS const f32x4*)(sl + 1024);
            float v = *(LAS const float*)(vl); float ykeep = 0.f;
#pragma unroll
            for (int st = 0; st < SCAN_CH; ++st) {
                f32x4 wn = w, bn = b, kn = k, kkn = kk, rn = r; float vn = v;
                if (st + 1 < SCAN_CH) { const int o = (st + 1) * SCAN_STEP_B;
                    wn = *(LAS const f32x4*)(sl + o); bn = *(LAS const f32x4*)(sl + o + 256); kn = *(LAS const f32x4*)(sl + o + 512); kkn = *(LAS const f32x4*)(sl + o + 768); rn = *(LAS const f32x4*)(sl + o + 1024);
                    vn = *(LAS const float*)(vl + o); }
                float sa = (S[0] * kk[0] + S[1] * kk[1]) + (S[2] * kk[2] + S[3] * kk[3]);
                const f32x4 kvt = k * v;
                sa = -row16_sum(sa);
                S = S * w + (b * sa + kvt);
                float y = (S[0] * r[0] + S[1] * r[1]) + (S[2] * r[2] + S[3] * r[3]);
                y = row16_sum(y);
                ykeep = (kq == (st & 15)) ? y : ykeep;
                if ((st & 15) == 15) yo[(size_t)(st - 15) * 64] = ykeep;
                w = wn; b = bn; k = kn; kk = kkn; r = rn; v = vn;
            }
        }
        __syncthreads();
    }
}

struct GlaArgs { const bf16_t* Ug; const float *conv, *aup, *abias, *gnorm; float* kvcT; float* dec; bf16_t* spT; bf16_t* Yg; };
constexpr int GL_GC = 0;
constexpr int GL_T0 = 16640;
constexpr int GL_VT = GL_T0 + 4 * 9216;
constexpr int GL_AL = GL_VT + 18432;
constexpr int GL_RS = GL_AL + 9216;

__device__ __forceinline__ float gla_conv_silu(const bf16_t* Ug, const float* conv, int t, int s, int c) {
    float a = 0.f;
#pragma unroll
    for (int j = 0; j < 4; ++j) { const int ds = 3 - j; if (s - ds >= 0) a += conv[j * 1024 + c] * bf2f(Ug[(size_t)(t - ds) * 1792 + c]); }
    return a * sigmoidf_(a);
}
__device__ __forceinline__ void gla_gcum(LAS unsigned char* lds, const GlaArgs& A, int t0, int h, int tid) {
    LAS float* GC = (LAS float*)(lds + GL_GC);
    for (int e = 0; e < 8; ++e) { const int idx = tid + 512 * e, i = idx >> 6, d = idx & 63; float x = A.abias[h * 64 + d];
#pragma unroll
        for (int j = 0; j < 16; ++j) x += bf2f(A.Ug[(size_t)(t0 + i) * 1792 + 1024 + j]) * A.aup[j * 256 + h * 64 + d];
        const float ls = fminf(x, 0.f) - __logf(1.f + __expf(-fabsf(x)));
        GC[i * 65 + d] = ls * (1.0f / 16.0f); }
    __syncthreads();
    { const int lane = tid & 63, wave = tid >> 6;
      for (int dd = 0; dd < 8; ++dd) { const int d = wave * 8 + dd; float x = GC[lane * 65 + d];
          for (int o = 1; o < 64; o <<= 1) { const float y = __shfl_up(x, o); if (lane >= o) x += y; }
          GC[lane * 65 + d] = x; } }
    __syncthreads();
}
__device__ void gla_a_tile(LAS unsigned char* lds, const GlaArgs& A, int tile, int tid) {
    const int bh = tile >> 6, n = tile & 63, b = bh >> 2, h = bh & 3, t0 = b * SEQ + n * 64, s0 = n * 64;
    LAS float* GC = (LAS float*)(lds + GL_GC); LAS bf16_t* KDT = (LAS bf16_t*)(lds + GL_T0); LAS bf16_t* VT = (LAS bf16_t*)(lds + GL_VT);
    gla_gcum(lds, A, t0, h, tid);
    for (int e = 0; e < 24; ++e) { const int idx = tid + 512 * e, i = idx / 192, cc = idx % 192;
        if (cc < 64) { const float k = gla_conv_silu(A.Ug, A.conv, t0 + i, s0 + i, 256 + h * 64 + cc); KDT[cc * 72 + i] = f2bf(k * __expf(GC[63 * 65 + cc] - GC[i * 65 + cc])); }
        else { const int ev = cc - 64; VT[ev * 72 + i] = f2bf(gla_conv_silu(A.Ug, A.conv, t0 + i, s0 + i, 512 + h * 128 + ev)); } }
    if (tid < 64) A.dec[((size_t)bh * 64 + n) * 64 + tid] = __expf(GC[63 * 65 + tid]);
    __syncthreads();
    { const int lane = tid & 63, wave = tid >> 6, fr = lane & 15, fq = lane >> 4; f32x4 acc[4];
#pragma unroll
      for (int nt = 0; nt < 4; ++nt) acc[nt] = (f32x4){0.f, 0.f, 0.f, 0.f};
#pragma unroll
      for (int ks = 0; ks < 2; ++ks) { const bf16x8 a = *(LAS const bf16x8*)(VT + (16 * wave + fr) * 72 + ks * 32 + fq * 8);
#pragma unroll
          for (int nt = 0; nt < 4; ++nt) { const bf16x8 bfr = *(LAS const bf16x8*)(KDT + (16 * nt + fr) * 72 + ks * 32 + fq * 8); acc[nt] = mfma16(bfr, a, acc[nt]); } }
#pragma unroll
      for (int nt = 0; nt < 4; ++nt) *(f32x4*)(A.kvcT + (((size_t)bh * 64 + n) * 128 + 16 * wave + fr) * 64 + 16 * nt + 4 * fq) = acc[nt]; }
    __syncthreads();
}
__device__ void gla_c_tile(LAS unsigned char* lds, const GlaArgs& A, int tile, int tid) {
    const int bh = tile >> 6, n = tile & 63, b = bh >> 2, h = bh & 3, t0 = b * SEQ + n * 64, s0 = n * 64;
    LAS float* GC = (LAS float*)(lds + GL_GC); LAS bf16_t* QG = (LAS bf16_t*)(lds + GL_T0); LAS bf16_t* KG = QG + 64 * 72; LAS bf16_t* QR = KG + 64 * 72; LAS bf16_t* KR = QR + 64 * 72;
    LAS bf16_t* VT = (LAS bf16_t*)(lds + GL_VT); LAS bf16_t* AL = (LAS bf16_t*)(lds + GL_AL); LAS float* RS = (LAS float*)(lds + GL_RS);
    gla_gcum(lds, A, t0, h, tid);
    for (int e = 0; e < 32; ++e) { const int idx = tid + 512 * e, i = idx >> 8, cc = idx & 255;
        if (cc < 64) { const float q = 0.125f * gla_conv_silu(A.Ug, A.conv, t0 + i, s0 + i, h * 64 + cc); const float eg = __expf(GC[i * 65 + cc]); QG[i * 72 + cc] = f2bf(q * eg); QR[i * 72 + cc] = f2bf(q / eg); }
        else if (cc < 128) { const int d = cc - 64; const float k = gla_conv_silu(A.Ug, A.conv, t0 + i, s0 + i, 256 + h * 64 + d); const float eg = __expf(GC[i * 65 + d]); KG[i * 72 + d] = f2bf(k / eg); KR[i * 72 + d] = f2bf(k * eg); }
        else { const int ev = cc - 128; VT[ev * 72 + i] = f2bf(gla_conv_silu(A.Ug, A.conv, t0 + i, s0 + i, 512 + h * 128 + ev)); } }
    __syncthreads();
    const int lane = tid & 63, wave = tid >> 6, fr = lane & 15, fq = lane >> 4; const int mt = wave >> 1;
    {
#pragma unroll
        for (int q = 0; q < 2; ++q) { const int nt = (wave & 1) * 2 + q; f32x4 ap = (f32x4){0.f, 0.f, 0.f, 0.f}, af = ap;
#pragma unroll
            for (int ks = 0; ks < 2; ++ks) { const int ko = ks * 32 + fq * 8;
                ap = mfma16(*(LAS const bf16x8*)(KG + (16 * nt + fr) * 72 + ko), *(LAS const bf16x8*)(QG + (16 * mt + fr) * 72 + ko), ap);
                af = mfma16(*(LAS const bf16x8*)(KR + (16 * nt + fr) * 72 + ko), *(LAS const bf16x8*)(QR + (16 * mt + fr) * 72 + ko), af); }
            const int trow = 16 * mt + fr; f32x4 o;
#pragma unroll
            for (int j = 0; j < 4; ++j) { const int scol = 16 * nt + 4 * fq + j; o[j] = (scol <= trow) ? ap[j] : af[j]; }
            u32x2 w; w.x = cvt_pk_bf16(o[0], o[1]); w.y = cvt_pk_bf16(o[2], o[3]); *(LAS u32x2*)(AL + trow * 72 + 16 * nt + 4 * fq) = w; }
    }
    __syncthreads();
    f32x4 acc[4];
#pragma unroll
    for (int q = 0; q < 4; ++q) acc[q] = (f32x4){0.f, 0.f, 0.f, 0.f};
    const bf16_t* sp = A.spT + ((size_t)bh * 64 + n) * 128 * 64;
#pragma unroll
    for (int ks = 0; ks < 2; ++ks) { const int ko = ks * 32 + fq * 8; const bf16x8 a1 = *(LAS const bf16x8*)(AL + (16 * mt + fr) * 72 + ko), a2 = *(LAS const bf16x8*)(QG + (16 * mt + fr) * 72 + ko);
#pragma unroll
        for (int q = 0; q < 4; ++q) { const int nt = (wave & 1) * 4 + q;
            acc[q] = mfma16(*(LAS const bf16x8*)(VT + (16 * nt + fr) * 72 + ko), a1, acc[q]);
            acc[q] = mfma16(*(const bf16x8*)(sp + (size_t)(16 * nt + fr) * 64 + ko), a2, acc[q]); } }
    float ssq = 0.f;
#pragma unroll
    for (int q = 0; q < 4; ++q) ssq += (acc[q][0] * acc[q][0] + acc[q][1] * acc[q][1]) + (acc[q][2] * acc[q][2] + acc[q][3] * acc[q][3]);
    ssq += __shfl_xor(ssq, 16); ssq += __shfl_xor(ssq, 32);
    if (fq == 0) RS[(16 * mt + fr) * 2 + (wave & 1)] = ssq;
    __syncthreads();
    { const int i = 16 * mt + fr; const float rs = rsqrtf((RS[i * 2] + RS[i * 2 + 1]) * (1.0f / 128.0f) + 1e-6f);
#pragma unroll
      for (int q = 0; q < 4; ++q) { const int ecol = h * 128 + ((wave & 1) * 4 + q) * 16 + 4 * fq; const f32x4 nw = *(const f32x4*)(A.gnorm + ecol); const f32x4 go = ld_bf4(A.Ug + (size_t)(t0 + i) * 1792 + 1040 + ecol); f32x4 o;
#pragma unroll
          for (int j = 0; j < 4; ++j) o[j] = acc[q][j] * rs * nw[j] * go[j] * sigmoidf_(go[j]);
          st_bf4(A.Yg + (size_t)(t0 + i) * 512 + ecol, o); } }
    __syncthreads();
}

__device__ void xa_tile(const bf16_t* Ux, const bf16_t* Kb, const bf16_t* Vt, bf16_t* Yx, int tile, int tid) {
    const int blk = tile & 31, h = (tile >> 5) & 3, b = tile >> 7; const int lane = tid & 63, wave = tid >> 6, fr = lane & 15, fq = lane >> 4;
    const int t = b * SEQ + blk * 128 + 16 * wave + fr;
    bf16x8 qf[4];
#pragma unroll
    for (int ks = 0; ks < 4; ++ks) qf[ks] = *(const bf16x8*)(Ux + (size_t)t * 512 + h * 128 + ks * 32 + fq * 8);
    f32x4 s[16];
#pragma unroll
    for (int nt = 0; nt < 16; ++nt) { s[nt] = (f32x4){0.f, 0.f, 0.f, 0.f}; const bf16_t* kr = Kb + (size_t)(b * 256 + 16 * nt + fr) * 512 + h * 128 + fq * 8;
#pragma unroll
        for (int ks = 0; ks < 4; ++ks) s[nt] = mfma16(*(const bf16x8*)(kr + ks * 32), qf[ks], s[nt]); }
    float mx = -1e30f;
#pragma unroll
    for (int nt = 0; nt < 16; ++nt)
#pragma unroll
        for (int j = 0; j < 4; ++j) mx = fmaxf(mx, s[nt][j]);
    mx = fmaxf(mx, __shfl_xor(mx, 16)); mx = fmaxf(mx, __shfl_xor(mx, 32));
    const float sc = 0.08838834764831845f * 1.4426950408889634f; float l = 0.f;
#pragma unroll
    for (int nt = 0; nt < 16; ++nt)
#pragma unroll
        for (int j = 0; j < 4; ++j) { const float pz = exp2f((s[nt][j] - mx) * sc); s[nt][j] = pz; l += pz; }
    l += __shfl_xor(l, 16); l += __shfl_xor(l, 32);
    f32x4 o[8];
#pragma unroll
    for (int dt = 0; dt < 8; ++dt) o[dt] = (f32x4){0.f, 0.f, 0.f, 0.f};
#pragma unroll
    for (int c = 0; c < 8; ++c) { union { u32x4 u; bf16x8 v; } pf;
        pf.u.x = cvt_pk_bf16(s[2 * c][0], s[2 * c][1]); pf.u.y = cvt_pk_bf16(s[2 * c][2], s[2 * c][3]); pf.u.z = cvt_pk_bf16(s[2 * c + 1][0], s[2 * c + 1][1]); pf.u.w = cvt_pk_bf16(s[2 * c + 1][2], s[2 * c + 1][3]);
#pragma unroll
        for (int dt = 0; dt < 8; ++dt) { const bf16_t* vr = Vt + ((size_t)b * 512 + h * 128 + 16 * dt + fr) * 256 + 32 * c + 4 * fq; union { u32x4 u; bf16x8 v; } vf;
            const u32x2 lo = *(const u32x2*)vr, hi = *(const u32x2*)(vr + 16); vf.u.x = lo.x; vf.u.y = lo.y; vf.u.z = hi.x; vf.u.w = hi.y;
            o[dt] = mfma16(vf.v, pf.v, o[dt]); } }
    const float il = 1.0f / l;
#pragma unroll
    for (int dt = 0; dt < 8; ++dt) st_bf4(Yx + (size_t)t * 512 + h * 128 + 16 * dt + 4 * fq, o[dt] * il);
}

struct Params { const float* in[33]; float* out; unsigned char* ws; };

__device__ __forceinline__ int opaque0() { int z = 0; asm volatile("" : "+s"(z)); return z; }
typedef __attribute__((address_space(1))) unsigned char* gptr_t;
typedef __attribute__((address_space(1))) const float* gcf_t;
__device__ __forceinline__ int opqv(int v) { asm volatile("" : "+v"(v)); return v; }
__device__ __forceinline__ int opqs(int v) { asm volatile("" : "+s"(v)); return v; }
#define PH_BEGIN const int zi = opaque0(); unsigned char* ws = P.ws + zi; float* const OUT = P.out + zi; (void)OUT; const int tid = opqv((int)threadIdx.x); const int bid = opqs((int)blockIdx.x); const int G = opqs((int)gridDim.x); (void)tid; (void)bid; (void)G; unsigned char* WB = ws + WS_WB; float* SS = (float*)(ws + WS_SS); (void)WB; (void)SS; (void)zi;
#define INP(k) (P.in[(k)] + zi)
#define XB_ ((bf16_t*)(ws + WS_XB))
#define U_ (ws + WS_U)
#define SC_ (ws + WS_SC)
#define Y_ ((bf16_t*)(ws + WS_Y))
#define KB_ ((bf16_t*)(ws + WS_KB))
#define VT_ ((bf16_t*)(ws + WS_VT))

constexpr size_t WS_BAR = WS_MISC + 8192;
__device__ __forceinline__ void grid_bar(unsigned* ctr, unsigned target) {
    asm volatile("s_waitcnt vmcnt(0)" ::: "memory");
    __syncthreads();
    if (threadIdx.x == 0) {
        __builtin_amdgcn_fence(__ATOMIC_RELEASE, "agent");
        asm volatile("s_waitcnt vmcnt(0)" ::: "memory");
        __hip_atomic_fetch_add(ctr, 1u, __ATOMIC_RELAXED, __HIP_MEMORY_SCOPE_AGENT);
        while (__hip_atomic_load(ctr, __ATOMIC_RELAXED, __HIP_MEMORY_SCOPE_AGENT) < target) __builtin_amdgcn_s_sleep(2);
        __builtin_amdgcn_fence(__ATOMIC_ACQUIRE, "agent");
        asm volatile("s_waitcnt vmcnt(0)" ::: "memory");
    }
    __syncthreads();
}

__global__ void __launch_bounds__(512) mega(Params P) {
    extern __shared__ __attribute__((aligned(16))) unsigned char lds_raw[];
    LAS unsigned char* lds = (LAS unsigned char*)lds_raw;
    cg::grid_group grid = cg::this_grid();

    for (int ph = 0; ph < NL * 12 + 1; ++ph) {
        const int l = ph / 12, kph = ph - l * 12;
        if (ph == NL * 12) {
#if (PHMASK >> 12) & 1
    { PH_BEGIN
        const int lane = tid & 63, gw = bid * 8 + (tid >> 6), nw = G * 8;
        const float* fn = INP(32); const float* ssf = SS + (size_t)0 * T * 16; float* X = OUT;
        for (int r = gw; r < T; r += nw) { const float rs = row_rstd(ssf, r);
#pragma unroll
            for (int i = 0; i < 4; ++i) { const size_t o = (size_t)r * D + i * 256 + lane * 4; *(f32x4*)(X + o) = *(const f32x4*)(X + o) * rs * *(const f32x4*)(fn + i * 256 + lane * 4); } }
    }
#endif
            break;
        }
        switch (kph) {
        case 0: {
#if (PHMASK >> 0) & 1
        for (int rep = 0; rep < REP0; ++rep) {
        {
            { PH_BEGIN convT<1>(lds, INP(3) + (size_t)l * D * 2 * FF, 2 * FF, 0, INP(2) + (size_t)l * D, (bf16_t*)(WB + WB_W1A), D, D, 2 * FF, G, bid, tid); }
            { PH_BEGIN convT<0>(lds, INP(4) + (size_t)l * FF * D, D, 0, nullptr, (bf16_t*)(WB + WB_W1B), FF, FF, D, G, bid, tid); }
            { PH_BEGIN convT<2>(lds, INP(7) + (size_t)l * D * 6928, 6928, 0, INP(5) + (size_t)l * D, (bf16_t*)(WB + WB_WIN), D, D, 4096, G, bid, tid); }
            { PH_BEGIN convT<0>(lds, INP(7) + (size_t)l * D * 6928, 6928, 3856, INP(5) + (size_t)l * D, (bf16_t*)(WB + WB_WG), D, D, 3072, G, bid, tid); }
            for (int j = 0; j < 3; ++j) { PH_BEGIN convT<0>(lds, INP(27) + ((size_t)l * 3 + j) * 512 * D, D, 0, nullptr, (bf16_t*)(WB + WB_WBR) + (size_t)j * D * 512, 512, 512, D, G, bid, tid); }
            { PH_BEGIN convT<0>(lds, INP(28) + (size_t)l * D * D, D, 0, nullptr, (bf16_t*)(WB + WB_WO), D, D, D, G, bid, tid); }
            { PH_BEGIN convT<0>(lds, INP(26) + (size_t)l * D * D, D, 0, INP(6) + (size_t)l * D, (bf16_t*)(WB + WB_WKV), D, D, D, G, bid, tid); }
            { PH_BEGIN convT<1>(lds, INP(30) + (size_t)l * D * 2 * FF, 2 * FF, 0, INP(29) + (size_t)l * D, (bf16_t*)(WB + WB_W2A), D, D, 2 * FF, G, bid, tid); }
            { PH_BEGIN convT<0>(lds, INP(31) + (size_t)l * FF * D, D, 0, nullptr, (bf16_t*)(WB + WB_W2B), FF, FF, D, G, bid, tid); }
            { PH_BEGIN convT<0>(lds, INP(10) + (size_t)l * 64 * 512, 512, 0, nullptr, (bf16_t*)(WB + WB_LW2), 64, 64, 512, G, bid, tid); }
            { PH_BEGIN convT<0>(lds, INP(12) + (size_t)l * 64 * 512, 512, 0, nullptr, (bf16_t*)(WB + WB_LA2), 64, 64, 512, G, bid, tid); }
            { PH_BEGIN convT<0>(lds, INP(13) + (size_t)l * 128 * 512, 512, 0, nullptr, (bf16_t*)(WB + WB_LG2), 128, 128, 512, G, bid, tid); }
            if (l > 0) {
                { PH_BEGIN convT<0>(lds, INP(20) + (size_t)(l - 1) * 512 * 32, 32, 0, nullptr, (bf16_t*)(WB + WB_LV1), 512, 512, 32, G, bid, tid); }
                { PH_BEGIN convT<0>(lds, INP(21) + (size_t)(l - 1) * 32 * 512, 512, 0, nullptr, (bf16_t*)(WB + WB_LV2), 32, 32, 512, G, bid, tid); }
            }
            if (l == 0) { PH_BEGIN
                const int lane = tid & 63, gw = bid * 8 + (tid >> 6), nw = G * 8;
                float* rstd_mem = (float*)(ws + WS_MISC); bf16_t* MEMN = (bf16_t*)(ws + WS_MEMN);
                for (int r = gw; r < T + 1024; r += nw) {
                    const bool ism = r >= T; const float* src = ism ? INP(1) + (size_t)(r - T) * D : INP(0) + (size_t)r * D; bf16_t* dst = ism ? MEMN + (size_t)(r - T) * D : XB_ + (size_t)r * D; float q = 0.f;
#pragma unroll
                    for (int i = 0; i < 4; ++i) { const f32x4 v = *(const f32x4*)(src + i * 256 + lane * 4); st_bf4(dst + i * 256 + lane * 4, v); q += (v[0] * v[0] + v[1] * v[1]) + (v[2] * v[2] + v[3] * v[3]); }
                    q = wave_sum(q);
                    if (ism) { if (lane == 0) rstd_mem[r - T] = rsqrtf(q * (1.0f / 1024.0f) + 1e-6f); } else if (lane < 16) SS[(size_t)r * 16 + lane] = (lane == 0) ? q : 0.f;
                }
            }
        }
        }
#endif
        } break;
        case 1: {
#if (PHMASK >> 1) & 1
        for (int rep = 0; rep < REPG; ++rep) {
        { PH_BEGIN
            pg8::Gemm g{XB_, (const bf16_t*)(WB + WB_W1A), T, 2 * FF, D, D, D, 0, 0}; pg8::StaticOrder S; S.init(T, 2 * FF, G, bid, 1);
            EpiFFNa E{(bf16_t*)U_, SS + (size_t)0 * T * 16}; pg8::gemm_phase(lds, g, S, E, tid);
        }
        if ((int)blockIdx.x >= (int)gridDim.x - 16) { PH_BEGIN
            pg8::Gemm g2{(const bf16_t*)(ws + WS_MEMN), (const bf16_t*)(WB + WB_WKV), 1024, D, D, D, D, 0, 0}; pg8::StaticOrder S2; S2.init(1024, D, 16, bid - (G - 16), 1);
            EpiKV E2{KB_, VT_, (const float*)(ws + WS_MISC)}; pg8::gemm_phase(lds, g2, S2, E2, tid);
        }
        }
#endif
        } break;
        case 2: {
#if (PHMASK >> 2) & 1
        { PH_BEGIN
            pg8::Gemm g{(const bf16_t*)U_, (const bf16_t*)(WB + WB_W1B), T, D, FF, FF, FF, 0, 0}; pg8::StaticOrder S; S.init(T, D, G, bid, 1);
            EpiRes E{l == 0 ? INP(0) : OUT, OUT, XB_, SS + (size_t)1 * T * 16, 0.5f}; pg8::gemm_phase(lds, g, S, E, tid);
        }
#endif
        } break;
        case 3: {
#if (PHMASK >> 3) & 1
        for (int rep = 0; rep < REPG; ++rep) {
        { PH_BEGIN
            pg8::Gemm g{XB_, (const bf16_t*)(WB + WB_WIN), T, 4096, D, D, D, 0, 0}; pg8::StaticOrder S; S.init(T, 4096, G, bid, 1);
            EpiU E{(bf16_t*)U_, SS + (size_t)1 * T * 16}; pg8::gemm_phase(lds, g, S, E, tid);
        }
        }
#endif
        } break;
        case 4: {
#if (PHMASK >> 4) & 1
        for (int rep = 0; rep < REP4; ++rep) {
#if P4SUB & 1
        { PH_BEGIN
            PrepArgs PA; PA.U = (const bf16_t*)(U_ + U_RWKV); PA.mu = INP(8) + (size_t)l * 1792; PA.w0 = INP(9) + (size_t)l * 512; PA.a0 = INP(11) + (size_t)l * 512;
            PA.kk_ = INP(14) + (size_t)l * 512; PA.ka = INP(15) + (size_t)l * 512; PA.rk = INP(16) + (size_t)l * 512; PA.v0 = INP(19) + (size_t)(l > 0 ? l - 1 : 0) * 512;
            PA.w2t = (const bf16_t*)(WB + WB_LW2); PA.a2t = (const bf16_t*)(WB + WB_LA2); PA.g2t = (const bf16_t*)(WB + WB_LG2); PA.v1t = (const bf16_t*)(WB + WB_LV1); PA.v2t = (const bf16_t*)(WB + WB_LV2);
            PA.vfirst = (float*)(ws + WS_VF); PA.Wd = (float*)(SC_ + SC_WD); PA.V = (float*)(SC_ + SC_V); PA.RKKB = (bf16_t*)(SC_ + SC_RKKB); PA.Go = (bf16_t*)(ws + WS_GO); PA.Bon = (float*)(ws + WS_BON); PA.layer = l;
            for (int tt = bid; tt < 256; tt += G) rwkv_prep_tile(lds, PA, tt, tid);
        }
#endif
#if P4SUB & 2
        { PH_BEGIN
            GlaArgs GA; GA.Ug = (const bf16_t*)(U_ + U_GLA); GA.conv = INP(22) + (size_t)l * 4096; GA.aup = INP(23) + (size_t)l * 4096; GA.abias = INP(24) + (size_t)l * 256; GA.gnorm = INP(25) + (size_t)l * 512;
            GA.kvcT = (float*)(ws + WS_KVC); GA.dec = (float*)(ws + WS_DEC); GA.spT = (bf16_t*)(U_ + U_SPT); GA.Yg = Y_ + (size_t)T * 512;
            for (int tile = bid; tile < 1024; tile += G) gla_a_tile(lds, GA, tile, tid);
        }
#endif
#if P4SUB & 4
        { PH_BEGIN
            for (int tile = bid; tile < 512; tile += G) xa_tile((const bf16_t*)(U_ + U_XA), KB_, VT_, Y_ + (size_t)2 * T * 512, tile, tid);
        }
#endif
        }
#endif
        } break;
        case 5: {
#if (PHMASK >> 5) & 1
        for (int rep = 0; rep < REP5; ++rep) {
        { PH_BEGIN
            bf16_t* spT = (bf16_t*)(U_ + U_SPT); const float* DEC = (const float*)(ws + WS_DEC); const float* KVC = (const float*)(ws + WS_KVC);
            for (int i = bid * 512 + tid; i < 16 * 128 * 64; i += G * 512) { const int bh = i >> 13, ed = i & 8191, d = i & 63; float st = 0.f;
                for (int n = 0; n < 64; ++n) { const size_t o = ((size_t)bh * 64 + n) * 8192 + ed; spT[o] = f2bf(st); st = st * DEC[((size_t)bh * 64 + n) * 64 + d] + KVC[o]; } }
        }
        { PH_BEGIN
            for (int u = bid; u < 256; u += G) { const int xcd = u & 7, j = u >> 3, p = xcd * 4 + (j >> 3), rg = j & 7;
                rwkv_scan_unit(lds, (const float*)(SC_ + SC_WD), (const float*)(SC_ + SC_V), (const bf16_t*)(SC_ + SC_RKKB), (float*)(U_ + U_YRAW), p, rg, tid); }
        }
        }
#endif
        } break;
        case 6: {
#if (PHMASK >> 6) & 1
        for (int rep = 0; rep < REP6; ++rep) {
        { PH_BEGIN
            const int lane = tid & 63, gw = bid * 8 + (tid >> 6), nw = G * 8;
            const float* lnw = INP(17) + (size_t)l * 512; const float* lnb = INP(18) + (size_t)l * 512; const float* Yraw = (const float*)(U_ + U_YRAW); const float* Vv = (const float*)(SC_ + SC_V);
            const float* BON = (const float*)(ws + WS_BON); const bf16_t* GO = (const bf16_t*)(ws + WS_GO); bf16_t* Y = Y_;
            for (int it = gw; it < 32 * SEQ; it += nw) { const int p = it >> 12, s = it & (SEQ - 1), b = p >> 3, h = p & 7, t = b * SEQ + s;
                const float y = Yraw[(size_t)it * 64 + lane]; const float mean = wave_sum(y) * (1.0f / 64.0f); const float dlt = y - mean; const float var = wave_sum(dlt * dlt) * (1.0f / 64.0f);
                const float yn = dlt * rsqrtf(var + 64e-5f) * lnw[h * 64 + lane] + lnb[h * 64 + lane];
                const float o = (yn + BON[(size_t)t * 8 + h] * Vv[(size_t)it * 64 + lane]) * bf2f(GO[(size_t)t * 512 + h * 64 + lane]);
                Y[(size_t)t * 512 + h * 64 + lane] = f2bf(o); }
        }
        { PH_BEGIN
            GlaArgs GA; GA.Ug = (const bf16_t*)(U_ + U_GLA); GA.conv = INP(22) + (size_t)l * 4096; GA.aup = INP(23) + (size_t)l * 4096; GA.abias = INP(24) + (size_t)l * 256; GA.gnorm = INP(25) + (size_t)l * 512;
            GA.kvcT = (float*)(ws + WS_KVC); GA.dec = (float*)(ws + WS_DEC); GA.spT = (bf16_t*)(U_ + U_SPT); GA.Yg = Y_ + (size_t)T * 512;
            for (int tile = bid; tile < 1024; tile += G) gla_c_tile(lds, GA, tile, tid);
        }
        }
#endif
        } break;
        case 7: {
#if (PHMASK >> 7) & 1
        for (int rep = 0; rep < REPG; ++rep) {
        { PH_BEGIN
            pg8::Gemm g{XB_, (const bf16_t*)(WB + WB_WG), T, 3072, D, D, D, 0, 0}; pg8::StaticOrder S; S.init(T, 3072, G, bid, 1);
            EpiGate E{(bf16_t*)SC_, SS + (size_t)1 * T * 16}; pg8::gemm_phase(lds, g, S, E, tid);
        }
        }
#endif
        } break;
        case 8: {
#if (PHMASK >> 8) & 1
        for (int rep = 0; rep < REPG; ++rep) {
        { PH_BEGIN
            pg8::Gemm g{Y_, (const bf16_t*)(WB + WB_WBR), T, D, 512, 512, 512, (unsigned)T * 512u * 2u, (unsigned)D * 512u * 2u}; pg8::StaticOrder S; S.init(T, D, G, bid, 3);
            EpiMerge E{(const bf16_t*)SC_, (float*)(U_ + U_MG), (bf16_t*)(U_ + U_MGB)}; pg8::gemm_phase(lds, g, S, E, tid);
        }
        }
#endif
        } break;
        case 9: {
#if (PHMASK >> 9) & 1
        { PH_BEGIN
            pg8::Gemm g{(const bf16_t*)(U_ + U_MGB), (const bf16_t*)(WB + WB_WO), T, D, D, D, D, 0, 0}; pg8::StaticOrder S; S.init(T, D, G, bid, 1);
            EpiRes E{OUT, OUT, XB_, SS + (size_t)2 * T * 16, 1.0f}; pg8::gemm_phase(lds, g, S, E, tid);
        }
#endif
        } break;
        case 10: {
#if (PHMASK >> 10) & 1
        for (int rep = 0; rep < REPG; ++rep) {
        { PH_BEGIN
            pg8::Gemm g{XB_, (const bf16_t*)(WB + WB_W2A), T, 2 * FF, D, D, D, 0, 0}; pg8::StaticOrder S; S.init(T, 2 * FF, G, bid, 1);
            EpiFFNa E{(bf16_t*)U_, SS + (size_t)2 * T * 16}; pg8::gemm_phase(lds, g, S, E, tid);
        }
        }
#endif
        } break;
        case 11: {
#if (PHMASK >> 11) & 1
        { PH_BEGIN
            pg8::Gemm g{(const bf16_t*)U_, (const bf16_t*)(WB + WB_W2B), T, D, FF, FF, FF, 0, 0}; pg8::StaticOrder S; S.init(T, D, G, bid, 1);
            EpiRes E{OUT, OUT, XB_, SS + (size_t)0 * T * 16, 0.5f}; pg8::gemm_phase(lds, g, S, E, tid);
        }
#endif
        } break;
        default: break;
        }
        if (ph == 0) grid.sync();
        else grid_bar((unsigned*)(P.ws + WS_BAR), (unsigned)ph * gridDim.x);
    }
}

extern "C" void kernel_launch(void* const* d_in, const int* in_sizes, int n_in, void* d_out, int out_size, void* d_ws, size_t ws_size, hipStream_t stream) {
    static int grid_blocks = 0;
    if (!grid_blocks) {
        if (n_in != 33 || ws_size < WS_END) { fprintf(stderr, "kernel_launch: need 33 inputs and %zu bytes of workspace (got %d, %zu)\n", (size_t)WS_END, n_in, ws_size); grid_blocks = -1; return; }
        int dev = 0, cus = 0, per_cu = 0;
        hipGetDevice(&dev); hipDeviceGetAttribute(&cus, hipDeviceAttributeMultiprocessorCount, dev);
        if (hipFuncSetAttribute((const void*)mega, hipFuncAttributeMaxDynamicSharedMemorySize, LDS_BYTES) != hipSuccess) { fprintf(stderr, "kernel_launch: hipFuncSetAttribute failed\n"); grid_blocks = -1; return; }
        if (hipOccupancyMaxActiveBlocksPerMultiprocessor(&per_cu, (const void*)mega, 512, LDS_BYTES) != hipSuccess || per_cu < 1) { fprintf(stderr, "kernel_launch: occupancy query says %d\n", per_cu); per_cu = 1; }
        (void)hipGetLastError();
        grid_blocks = cus * per_cu;
    }
    if (grid_blocks < 0) return;
    if (hipMemsetAsync((char*)d_ws + WS_BAR, 0, 256, stream) != hipSuccess) { fprintf(stderr, "kernel_launch: memset failed\n"); return; }
    Params p{};
    for (int i = 0; i < 33; ++i) p.in[i] = (const float*)d_in[i];
    p.out = (float*)d_out; p.ws = (unsigned char*)d_ws;
    void* args[] = {&p};
    hipError_t e = hipLaunchCooperativeKernel((const void*)mega, dim3(grid_blocks), dim3(512), args, LDS_BYTES, stream);
    if (e != hipSuccess) fprintf(stderr, "cooperative launch failed: %s (grid %d)\n", hipGetErrorString(e), grid_blocks);
}
```

```cpp
#include <hip/hip_runtime.h>
#include <hip/hip_cooperative_groups.h>
#include <cstdio>
namespace cg = cooperative_groups;
#ifndef P4SUB
#define P4SUB 7
#endif
#ifndef REP5
#define REP5 1
#endif
#ifndef REP4
#define REP4 1
#endif
#ifndef REP6
#define REP6 1
#endif
#ifndef REP0
#define REP0 1
#endif
#ifndef REPG
#define REPG 1
#endif
#ifndef REPSYNC
#define REPSYNC 1
#endif
#ifndef PHMASK
#define PHMASK 0xFFFF
#endif

#define LAS __attribute__((address_space(3)))
typedef unsigned short bf16_t;
typedef short bf16x8 __attribute__((ext_vector_type(8)));
typedef float f32x4 __attribute__((ext_vector_type(4)));
typedef float f32x2 __attribute__((ext_vector_type(2)));
typedef unsigned u32x4 __attribute__((ext_vector_type(4)));
typedef unsigned u32x2 __attribute__((ext_vector_type(2)));

constexpr int T = 16384, D = 1024, FF = 2816, SEQ = 4096, NL = 4;
constexpr int LDS_BYTES = 135168;

constexpr size_t MB = 1024 * 1024;
constexpr size_t WS_MISC = 0;
constexpr size_t WS_SS = 1 * MB;
constexpr size_t WS_WB = 4 * MB;
constexpr size_t WB_W1A = 0;
constexpr size_t WB_W1B = WB_W1A + (size_t)5632 * 1024 * 2;
constexpr size_t WB_WIN = WB_W1B + (size_t)1024 * 2816 * 2;
constexpr size_t WB_WG = WB_WIN + (size_t)4096 * 1024 * 2;
constexpr size_t WB_WBR = WB_WG + (size_t)3072 * 1024 * 2;
constexpr size_t WB_WO = WB_WBR + (size_t)3 * 1024 * 512 * 2;
constexpr size_t WB_WKV = WB_WO + (size_t)1024 * 1024 * 2;
constexpr size_t WB_W2A = WB_WKV + (size_t)1024 * 1024 * 2;
constexpr size_t WB_W2B = WB_W2A + (size_t)5632 * 1024 * 2;
constexpr size_t WB_LW2 = WB_W2B + (size_t)1024 * 2816 * 2;
constexpr size_t WB_LA2 = WB_LW2 + 512 * 64 * 2;
constexpr size_t WB_LG2 = WB_LA2 + 512 * 64 * 2;
constexpr size_t WB_LV1 = WB_LG2 + 512 * 128 * 2;
constexpr size_t WB_LV2 = WB_LV1 + 32 * 512 * 2;
constexpr size_t WB_END = WB_LV2 + 512 * 32 * 2;
static_assert(WB_END <= 55 * MB, "weights region");
constexpr size_t WS_XB = WS_WB + 55 * MB;
constexpr size_t WS_VF = WS_XB + 32 * MB;
constexpr size_t WS_MEMN = WS_VF + 32 * MB;
constexpr size_t WS_KB = WS_MEMN + 2 * MB;
constexpr size_t WS_VT = WS_KB + 1 * MB;
constexpr size_t WS_GO = WS_VT + 1 * MB;
constexpr size_t WS_BON = WS_GO + 16 * MB;
constexpr size_t WS_Y = WS_BON + 1 * MB;
constexpr size_t WS_KVC = WS_Y + 48 * MB;
constexpr size_t WS_DEC = WS_KVC + 32 * MB;
constexpr size_t WS_SC = WS_DEC + 1 * MB;
constexpr size_t SC_WD = 0;
constexpr size_t SC_V = 32 * MB;
constexpr size_t SC_RKKB = 64 * MB;
constexpr size_t WS_U = WS_SC + 128 * MB;
constexpr size_t U_RWKV = 0;
constexpr size_t U_GLA = (size_t)T * 1792 * 2;
constexpr size_t U_XA = 2 * (size_t)T * 1792 * 2;
constexpr size_t U_YRAW = 0;
constexpr size_t U_SPT = 32 * MB;
constexpr size_t U_MG = 0;
constexpr size_t U_MGB = 64 * MB;
constexpr size_t WS_END = WS_U + 128 * MB;
static_assert(U_XA + (size_t)T * 512 * 2 <= 128 * MB, "U region");

typedef __bf16 bf16x2_t __attribute__((ext_vector_type(2)));
__device__ __forceinline__ unsigned cvt_pk_bf16(float lo, float hi) { const f32x2 v = {lo, hi}; const bf16x2_t r = __builtin_convertvector(v, bf16x2_t); return __builtin_bit_cast(unsigned, r); }
__device__ __forceinline__ bf16_t f2bf(float x) { return (bf16_t)(cvt_pk_bf16(x, 0.f) & 0xffffu); }
__device__ __forceinline__ float bf2f(bf16_t b) { return __uint_as_float(((unsigned)b) << 16); }
__device__ __forceinline__ float bflo(unsigned w) { return __uint_as_float(w << 16); }
__device__ __forceinline__ float bfhi(unsigned w) { return __uint_as_float(w & 0xffff0000u); }
__device__ __forceinline__ f32x4 ld_bf4(const bf16_t* p) { const u32x2 w = *(const u32x2*)p; return (f32x4){bflo(w.x), bfhi(w.x), bflo(w.y), bfhi(w.y)}; }
__device__ __forceinline__ void st_bf4(bf16_t* p, f32x4 v) { u32x2 w; w.x = cvt_pk_bf16(v[0], v[1]); w.y = cvt_pk_bf16(v[2], v[3]); *(u32x2*)p = w; }
__device__ __forceinline__ float sigmoidf_(float x) { return 1.0f / (1.0f + __expf(-x)); }
__device__ __forceinline__ float wave_sum(float v) { for (int o = 32; o >= 1; o >>= 1) v += __shfl_xor(v, o); return v; }
__device__ __forceinline__ f32x4 mfma16(bf16x8 a, bf16x8 b, f32x4 c) { return __builtin_amdgcn_mfma_f32_16x16x32_bf16(a, b, c, 0, 0, 0); }

__device__ __forceinline__ float row_rstd(const float* ssp, int row) {
    const f32x4* p = (const f32x4*)(ssp + (size_t)row * 16); const f32x4 a = p[0], b = p[1], c = p[2], d = p[3];
    const float t = (((a[0] + a[1]) + (a[2] + a[3])) + ((b[0] + b[1]) + (b[2] + b[3]))) + (((c[0] + c[1]) + (c[2] + c[3])) + ((d[0] + d[1]) + (d[2] + d[3])));
    return rsqrtf(t * (1.0f / 1024.0f) + 1e-6f);
}
namespace pg8 {
constexpr int BM = 256, BK = 64, HALF = 128, HTB = HALF * BK * 2, STAGE_BYTES = 8 * HTB, NXCD = 8, WGM = 8;
__device__ __forceinline__ int lds_byte(int r, int c) { const int st = (r >> 4) * 2 + (c >> 5), rr = r & 15, cc = c & 31, ob = rr * 64 + cc * 2; return st * 1024 + (ob ^ (((ob >> 9) & 1) << 5)); }
__device__ __forceinline__ void stage_rc(int b, int& R, int& C) { const int st = b / 1024, sb = b % 1024, swz = sb ^ (((sb >> 9) & 1) << 5); R = (st >> 1) * 16 + swz / 64; C = (st & 1) * 32 + (swz % 64) / 2; }
__device__ __forceinline__ int perm32(int rho) { const int n = rho >> 4, i = rho & 15; return 8 * (i >> 2) + 4 * n + (i & 3); }

struct Unit { int pm, pn, z; };
struct Gemm { const bf16_t* A; const bf16_t* Bt; int M, N, K, lda, ldb; unsigned zA, zB; };

struct StaticOrder {
    int nM, nN, nwg, G, c, nz;
    __device__ void init(int M, int N, int G_, int c_, int nz_) { nM = M / BM; nN = N / BM; nwg = nM * nN; G = G_; c = c_; nz = nz_; }
    __device__ bool next(int i, Unit& u) const {
        const int ti = i / nz; u.z = i - ti * nz;
        const long L = (long)ti * G + c; if (L >= nwg) return false;
        int wgid = (int)L; { const int q = nwg / NXCD, r = nwg % NXCD, xcd = wgid % NXCD, off = wgid / NXCD; wgid = (xcd < r ? xcd * (q + 1) : r * (q + 1) + (xcd - r) * q) + off; }
        const int nig = WGM * nN, gid = wgid / nig, fm = gid * WGM, gsz = (nM - fm) < WGM ? (nM - fm) : WGM;
        u.pm = fm + ((wgid % nig) % gsz); u.pn = (wgid % nig) / gsz; return true;
    }
};

template <class Epi>
__device__ __forceinline__ void gemm_phase(LAS unsigned char* lds, const Gemm g, const StaticOrder& S, const Epi& E, const int tid) {
    const int wid = __builtin_amdgcn_readfirstlane(tid >> 6), lane = tid & 63, wr = wid >> 2, wc = wid & 3, fr = lane & 15, fq = lane >> 4;
    const int K = g.K, nt = K / BK;
    unsigned voffA[2], voffB[2];
#pragma unroll
    for (int i = 0; i < 2; ++i) { int R, C; stage_rc(tid * 16 + i * 8192, R, C); const int Rb = Epi::PERM ? ((R & ~31) + perm32(R & 31)) : R;
        voffA[i] = (unsigned)(R * g.lda + C) * 2u; voffB[i] = (unsigned)(Rb * g.ldb + C) * 2u; }
    const unsigned kstep = (unsigned)(BK * 2);
    const unsigned hstepA = (unsigned)HALF * g.lda * 2u, hstepB = (unsigned)HALF * g.ldb * 2u;
    const unsigned tstepA = 2u * hstepA, tstepB = 2u * hstepB;
    const unsigned ldsw = (unsigned)wid * 1024u;
    const int aoff = lds_byte(wr * 64 + fr, fq * 8), boff = lds_byte(wc * 32 + fr, fq * 8);
    const char* const gA = (const char*)g.A; const char* const gB = (const char*)g.Bt;
#define PG8_SA(b, h) (((b) * 2 + (h)) * HTB)
#define PG8_SB(b, h) ((4 + (b) * 2 + (h)) * HTB)
#define PG8_STAGE(bufoff, gbase, soff, voff) do { _Pragma("unroll") for (int _i = 0; _i < 2; ++_i) \
        __builtin_amdgcn_global_load_lds((const unsigned*)(((gbase) + (size_t)(unsigned)(soff)) + (voff)[_i]), (LAS unsigned*)(lds + (bufoff) + ldsw + _i * 8192), 16, 0, 0); } while (0)
#define PG8_LDA(dst, b, h) do { _Pragma("unroll") for (int m = 0; m < 4; ++m) _Pragma("unroll") for (int k = 0; k < 2; ++k) dst[m][k] = *(const LAS bf16x8*)(lds + PG8_SA(b, h) + aoff + m * 2048 + k * 1024); } while (0)
#define PG8_LDB(dst, b, h) do { _Pragma("unroll") for (int n = 0; n < 2; ++n) _Pragma("unroll") for (int k = 0; k < 2; ++k) dst[n][k] = *(const LAS bf16x8*)(lds + PG8_SB(b, h) + boff + n * 2048 + k * 1024); } while (0)
#define PG8_MMA(ai, bj, At, Bt) do { __builtin_amdgcn_s_setprio(1); _Pragma("unroll") for (int m = 0; m < 4; ++m) _Pragma("unroll") for (int n = 0; n < 2; ++n) _Pragma("unroll") for (int k = 0; k < 2; ++k) \
        acc[ai][bj][m][n] = __builtin_amdgcn_mfma_f32_16x16x32_bf16(Bt[n][k], At[m][k], acc[ai][bj][m][n], 0, 0, 0); __builtin_amdgcn_s_setprio(0); } while (0)
#define PG8_WAIT_V(n) asm volatile("s_waitcnt vmcnt(" #n ")" ::: "memory")
#define PG8_WAIT_L(n) asm volatile("s_waitcnt lgkmcnt(" #n ")" ::: "memory")
#define PG8_BAR __builtin_amdgcn_s_barrier()
#define PG8_SCHED __builtin_amdgcn_sched_barrier(0)
    Unit cur, nxt; int ui = 0;
    if (!S.next(0, cur)) return;
    f32x4 acc[2][2][4][2];
#pragma unroll
    for (int a = 0; a < 2; ++a)
#pragma unroll
        for (int b = 0; b < 2; ++b)
#pragma unroll
            for (int m = 0; m < 4; ++m)
#pragma unroll
                for (int n = 0; n < 2; ++n) acc[a][b][m][n] = (f32x4){0.f, 0.f, 0.f, 0.f};
    bf16x8 At[4][2], B0[2][2], B1[2][2];
    unsigned cA = (unsigned)cur.z * g.zA + (unsigned)cur.pm * tstepA, cB = (unsigned)cur.z * g.zB + (unsigned)cur.pn * tstepB;
    PG8_STAGE(PG8_SB(0, 0), gB, cB, voffB); PG8_STAGE(PG8_SA(0, 0), gA, cA, voffA); PG8_STAGE(PG8_SB(0, 1), gB, cB + hstepB, voffB); PG8_STAGE(PG8_SA(0, 1), gA, cA + hstepA, voffA);
    if (wr == 1) PG8_BAR;
    PG8_WAIT_V(4); PG8_BAR;
    PG8_STAGE(PG8_SB(1, 0), gB, cB + kstep, voffB); PG8_STAGE(PG8_SA(1, 0), gA, cA + kstep, voffA); PG8_STAGE(PG8_SB(1, 1), gB, cB + hstepB + kstep, voffB);
    PG8_WAIT_V(6); PG8_BAR;
    for (;;) {
        const bool has_next = S.next(ui + 1, nxt);
        const unsigned nA = has_next ? (unsigned)nxt.z * g.zA + (unsigned)nxt.pm * tstepA : cA, nB = has_next ? (unsigned)nxt.z * g.zB + (unsigned)nxt.pn * tstepB : cB;
        for (int t = 0; t < nt; t += 2) {
            const bool last = (t == nt - 2);
            const unsigned a1 = cA + (unsigned)(t + 1) * kstep;
            const unsigned a2 = last ? nA : cA + (unsigned)(t + 2) * kstep, b2 = last ? nB : cB + (unsigned)(t + 2) * kstep;
            const unsigned a3 = a2 + kstep, b3 = b2 + kstep;
            PG8_LDB(B0, 0, 0); PG8_SCHED; PG8_LDA(At, 0, 0); PG8_STAGE(PG8_SA(1, 1), gA, a1 + hstepA, voffA);
            PG8_WAIT_L(8); PG8_BAR; PG8_WAIT_L(0); PG8_MMA(0, 0, At, B0); PG8_BAR; PG8_SCHED;
            PG8_LDB(B1, 0, 1); PG8_STAGE(PG8_SB(0, 0), gB, b2, voffB);
            PG8_BAR; PG8_WAIT_L(0); PG8_MMA(0, 1, At, B1); PG8_BAR;
            PG8_LDA(At, 0, 1); PG8_STAGE(PG8_SA(0, 0), gA, a2, voffA);
            PG8_BAR; PG8_WAIT_L(0); PG8_MMA(1, 0, At, B0); PG8_BAR; PG8_SCHED;
            PG8_STAGE(PG8_SB(0, 1), gB, b2 + hstepB, voffB);
            PG8_WAIT_V(6); PG8_BAR; PG8_MMA(1, 1, At, B1); PG8_BAR;
            PG8_LDB(B0, 1, 0); PG8_SCHED; PG8_LDA(At, 1, 0); PG8_STAGE(PG8_SA(0, 1), gA, a2 + hstepA, voffA);
            PG8_WAIT_L(8); PG8_BAR; PG8_WAIT_L(0); PG8_MMA(0, 0, At, B0); PG8_BAR; PG8_SCHED;
            PG8_LDB(B1, 1, 1); PG8_STAGE(PG8_SB(1, 0), gB, b3, voffB);
            PG8_BAR; PG8_WAIT_L(0); PG8_MMA(0, 1, At, B1); PG8_BAR;
            PG8_LDA(At, 1, 1); PG8_STAGE(PG8_SA(1, 0), gA, a3, voffA);
            PG8_BAR; PG8_WAIT_L(0); PG8_MMA(1, 0, At, B0); PG8_BAR; PG8_SCHED;
            PG8_STAGE(PG8_SB(1, 1), gB, b3 + hstepB, voffB);
            PG8_WAIT_V(6); PG8_BAR; PG8_MMA(1, 1, At, B1); PG8_BAR;
        }
        E(acc, cur, wr, wc, fr, fq);
        if (!has_next) break;
#pragma unroll
        for (int a = 0; a < 2; ++a)
#pragma unroll
            for (int b = 0; b < 2; ++b)
#pragma unroll
                for (int m = 0; m < 4; ++m)
#pragma unroll
                    for (int n = 0; n < 2; ++n) acc[a][b][m][n] = (f32x4){0.f, 0.f, 0.f, 0.f};
        cur = nxt; cA = nA; cB = nB; ++ui;
    }
    PG8_WAIT_V(0);
    if (wr == 0) PG8_BAR;
    PG8_BAR;
#undef PG8_SA
#undef PG8_SB
#undef PG8_STAGE
#undef PG8_LDA
#undef PG8_LDB
#undef PG8_MMA
#undef PG8_WAIT_V
#undef PG8_WAIT_L
#undef PG8_BAR
#undef PG8_SCHED
}
}
using pg8::Unit;
typedef f32x4 Acc[2][2][4][2];

struct EpiFFNa { static constexpr bool PERM = false; bf16_t* H; const float* ss;
    __device__ __forceinline__ void operator()(const Acc& acc, const Unit& u, int wr, int wc, int fr, int fq) const {
        const int row0 = u.pm * 256 + wr * 64 + fr, hc0 = u.pn * 128 + wc * 16 + 4 * fq;
#pragma unroll
        for (int ai = 0; ai < 2; ++ai)
#pragma unroll
            for (int m = 0; m < 4; ++m) { const int row = row0 + ai * 128 + m * 16; const float rs = row_rstd(ss, row);
#pragma unroll
                for (int bj = 0; bj < 2; ++bj) { const f32x4 gt = acc[ai][bj][m][0] * rs, up = acc[ai][bj][m][1] * rs; f32x4 h;
#pragma unroll
                    for (int j = 0; j < 4; ++j) h[j] = gt[j] * sigmoidf_(gt[j]) * up[j];
                    st_bf4(H + (size_t)row * FF + hc0 + bj * 64, h); } }
    }
};
struct EpiRes { static constexpr bool PERM = false; const float* xin; float* xout; bf16_t* xb; float* ss_out; float scale;
    __device__ __forceinline__ void operator()(const Acc& acc, const Unit& u, int wr, int wc, int fr, int fq) const {
        const int row0 = u.pm * 256 + wr * 64 + fr, col0 = u.pn * 256 + wc * 32 + 4 * fq;
#pragma unroll
        for (int ai = 0; ai < 2; ++ai)
#pragma unroll
            for (int m = 0; m < 4; ++m) { const int row = row0 + ai * 128 + m * 16; float q = 0.f;
#pragma unroll
                for (int bj = 0; bj < 2; ++bj)
#pragma unroll
                    for (int n = 0; n < 2; ++n) { const size_t o = (size_t)row * D + col0 + bj * 128 + n * 16; const f32x4 v = *(const f32x4*)(xin + o) + acc[ai][bj][m][n] * scale;
                        *(f32x4*)(xout + o) = v; st_bf4(xb + o, v); q += (v[0] * v[0] + v[1] * v[1]) + (v[2] * v[2] + v[3] * v[3]); }
                q += __shfl_xor(q, 16); q += __shfl_xor(q, 32);
                if (fq == 0) ss_out[(size_t)row * 16 + u.pn * 4 + wc] = q; }
    }
};
struct EpiU { static constexpr bool PERM = true; bf16_t* Ubase; const float* ss;
    __device__ __forceinline__ void operator()(const Acc& acc, const Unit& u, int wr, int wc, int fr, int fq) const {
        bf16_t* base; int ld, c0;
        if (u.pn < 7) { base = (bf16_t*)((char*)Ubase + U_RWKV); ld = 1792; c0 = u.pn * 256; }
        else if (u.pn < 14) { base = (bf16_t*)((char*)Ubase + U_GLA); ld = 1792; c0 = (u.pn - 7) * 256; }
        else { base = (bf16_t*)((char*)Ubase + U_XA); ld = 512; c0 = (u.pn - 14) * 256; }
        const int row0 = u.pm * 256 + wr * 64 + fr; c0 += wc * 32 + 8 * fq;
#pragma unroll
        for (int ai = 0; ai < 2; ++ai)
#pragma unroll
            for (int m = 0; m < 4; ++m) { const int row = row0 + ai * 128 + m * 16; const float rs = row_rstd(ss, row);
#pragma unroll
                for (int bj = 0; bj < 2; ++bj) { const f32x4 v0 = acc[ai][bj][m][0] * rs, v1 = acc[ai][bj][m][1] * rs; u32x4 w;
                    w.x = cvt_pk_bf16(v0[0], v0[1]); w.y = cvt_pk_bf16(v0[2], v0[3]); w.z = cvt_pk_bf16(v1[0], v1[1]); w.w = cvt_pk_bf16(v1[2], v1[3]);
                    *(u32x4*)(base + (size_t)row * ld + c0 + bj * 128) = w; } }
    }
};
struct EpiGate { static constexpr bool PERM = true; bf16_t* Gt; const float* ss;
    __device__ __forceinline__ void operator()(const Acc& acc, const Unit& u, int wr, int wc, int fr, int fq) const {
        const int row0 = u.pm * 256 + wr * 64 + fr, c0 = u.pn * 256 + wc * 32 + 8 * fq;
#pragma unroll
        for (int ai = 0; ai < 2; ++ai)
#pragma unroll
            for (int m = 0; m < 4; ++m) { const int row = row0 + ai * 128 + m * 16; const float rs = row_rstd(ss, row);
#pragma unroll
                for (int bj = 0; bj < 2; ++bj) { f32x4 v0 = acc[ai][bj][m][0] * rs, v1 = acc[ai][bj][m][1] * rs;
#pragma unroll
                    for (int j = 0; j < 4; ++j) { v0[j] = sigmoidf_(v0[j]); v1[j] = sigmoidf_(v1[j]); }
                    u32x4 w; w.x = cvt_pk_bf16(v0[0], v0[1]); w.y = cvt_pk_bf16(v0[2], v0[3]); w.z = cvt_pk_bf16(v1[0], v1[1]); w.w = cvt_pk_bf16(v1[2], v1[3]);
                    *(u32x4*)(Gt + (size_t)row * 3072 + c0 + bj * 128) = w; } }
    }
};
struct EpiMerge { static constexpr bool PERM = false; const bf16_t* Gt; float* Mg; bf16_t* Mb;
    __device__ __forceinline__ void operator()(const Acc& acc, const Unit& u, int wr, int wc, int fr, int fq) const {
        const int row0 = u.pm * 256 + wr * 64 + fr, col0 = u.pn * 256 + wc * 32 + 4 * fq;
#pragma unroll
        for (int ai = 0; ai < 2; ++ai)
#pragma unroll
            for (int m = 0; m < 4; ++m) { const int row = row0 + ai * 128 + m * 16;
#pragma unroll
                for (int bj = 0; bj < 2; ++bj)
#pragma unroll
                    for (int n = 0; n < 2; ++n) { const int col = col0 + bj * 128 + n * 16; const size_t o = (size_t)row * D + col;
                        f32x4 v = acc[ai][bj][m][n] * ld_bf4(Gt + (size_t)row * 3072 + u.z * 1024 + col);
                        if (u.z > 0) v += *(const f32x4*)(Mg + o);
                        if (u.z < 2) *(f32x4*)(Mg + o) = v; else st_bf4(Mb + o, v); } }
    }
};
struct EpiKV { static constexpr bool PERM = false; bf16_t* Kb; bf16_t* Vt; const float* rstd;
    __device__ __forceinline__ void operator()(const Acc& acc, const Unit& u, int wr, int wc, int fr, int fq) const {
        const int row0 = u.pm * 256 + wr * 64 + fr, col0 = u.pn * 256 + wc * 32 + 4 * fq;
#pragma unroll
        for (int ai = 0; ai < 2; ++ai)
#pragma unroll
            for (int m = 0; m < 4; ++m) { const int row = row0 + ai * 128 + m * 16; const float rs = rstd[row];
#pragma unroll
                for (int bj = 0; bj < 2; ++bj)
#pragma unroll
                    for (int n = 0; n < 2; ++n) { const int col = col0 + bj * 128 + n * 16; const f32x4 v = acc[ai][bj][m][n] * rs;
                        if (col < 512) st_bf4(Kb + (size_t)row * 512 + col, v);
                        else {
#pragma unroll
                            for (int j = 0; j < 4; ++j) Vt[((size_t)(row >> 8) * 512 + (col - 512 + j)) * 256 + (row & 255)] = f2bf(v[j]); } } }
    }
};

template <int MAP> __device__ __forceinline__ int colmap(int n) {
    if (MAP == 1) { const int g = n >> 5, i = n & 31; return i < 16 ? 16 * g + i : FF + 16 * g + (i - 16); }
    if (MAP == 2) { if (n < 3344) return n; if (n < 3584) return -1; return n - 240; }
    return n;
}
template <int MAP>
__device__ __forceinline__ void convT(LAS unsigned char* lds, const float* src, int ld, int coff, const float* g, bf16_t* dst, int K, int Kd, int Nd, int G, int bid, int tid) {
    const int nkt = (K + 63) >> 6, nnt = (Nd + 63) >> 6, ntile = nkt * nnt;
    LAS bf16_t* tile = (LAS bf16_t*)lds;
    for (int t = bid; t < ntile; t += G) {
        const int kt = t % nkt, ntl = t / nkt, k0 = kt * 64, n0 = ntl * 64;
        { const int nl = tid & 63, kl0 = tid >> 6, n = n0 + nl; const int c = (n < Nd) ? colmap<MAP>(n) : -1;
#pragma unroll
          for (int i = 0; i < 8; ++i) { const int kl = kl0 + 8 * i, k = k0 + kl; float v = 0.f;
              if (c >= 0 && k < K) { v = src[(size_t)k * ld + coff + c]; if (g) v *= g[k]; }
              tile[nl * 72 + kl] = f2bf(v); } }
        __syncthreads();
        { const int nl = tid >> 3, kc = (tid & 7) * 8, n = n0 + nl, k = k0 + kc;
          if (n < Nd && k < Kd) *(u32x4*)(dst + (size_t)n * Kd + k) = *(LAS u32x4*)(tile + nl * 72 + kc); }
        __syncthreads();
    }
}

template <int K>
__device__ __forceinline__ void wave_gemm(f32x4 (&acc)[4][4], LAS const unsigned char* A, int sA, const bf16_t* Bt, int fr, int fq) {
#pragma unroll
    for (int m = 0; m < 4; ++m)
#pragma unroll
        for (int n = 0; n < 4; ++n) acc[m][n] = (f32x4){0.f, 0.f, 0.f, 0.f};
#pragma unroll
    for (int ks = 0; ks < K / 32; ++ks) { bf16x8 a[4], b[4];
#pragma unroll
        for (int m = 0; m < 4; ++m) a[m] = *(LAS const bf16x8*)(A + (16 * m + fr) * sA + (ks * 32 + fq * 8) * 2);
#pragma unroll
        for (int n = 0; n < 4; ++n) b[n] = *(const bf16x8*)(Bt + (size_t)(16 * n + fr) * K + ks * 32 + fq * 8);
#pragma unroll
        for (int m = 0; m < 4; ++m)
#pragma unroll
            for (int n = 0; n < 4; ++n) acc[m][n] = mfma16(b[n], a[m], acc[m][n]); }
}

template <int K>
__device__ __forceinline__ void row_gemm(f32x4 (&acc)[4], LAS const unsigned char* Arow, const bf16_t* Bt, int fr, int fq) {
#pragma unroll
    for (int n = 0; n < 4; ++n) acc[n] = (f32x4){0.f, 0.f, 0.f, 0.f};
#pragma unroll
    for (int ks = 0; ks < K / 32; ++ks) { const bf16x8 a = *(LAS const bf16x8*)(Arow + (ks * 32 + fq * 8) * 2);
#pragma unroll
        for (int n = 0; n < 4; ++n) { const bf16x8 b = *(const bf16x8*)(Bt + (size_t)(16 * n + fr) * K + ks * 32 + fq * 8); acc[n] = mfma16(b, a, acc[n]); } }
}

struct PrepArgs { const bf16_t* U; const float *mu, *w0, *a0, *kk_, *ka, *rk, *v0; const bf16_t *w2t, *a2t, *g2t, *v1t, *v2t; float* vfirst; float* Wd; float* V; bf16_t* RKKB; bf16_t* Go; float* Bon; int layer; };

__device__ __forceinline__ f32x4 shifted4(const bf16_t* Ut, bool has_prev, int c, const float* mu) {
    const f32x4 u = ld_bf4(Ut + c); f32x4 p = (f32x4){0.f, 0.f, 0.f, 0.f}; if (has_prev) p = ld_bf4(Ut - 1792 + c);
    const f32x4 m = *(const f32x4*)(mu + c); return u + m * (p - u);
}

__device__ __forceinline__ void rwkv_prep_tile(LAS unsigned char* lds, const PrepArgs& P, int tt, int tid) {
    constexpr int SW = 144, SG = 272, SV = 1040, SVV = 80;
    LAS unsigned char* LAw = lds; LAS unsigned char* LAa = lds + 9216; LAS unsigned char* LAg = lds + 18432; LAS unsigned char* LAv = lds + 35840; LAS unsigned char* LAvv = lds + 102400;
    const int t0 = tt * 64; const int s0 = t0 & (SEQ - 1);
    const int lane = tid & 63, wave = __builtin_amdgcn_readfirstlane(tid >> 6), fr = lane & 15, fq = lane >> 4;
#pragma unroll 2
    for (int e = 0; e < 32; ++e) { const int idx = tid + 512 * e, i = idx >> 8, c = idx & 255; const bf16_t* Ut = P.U + (size_t)(t0 + i) * 1792 + 1536 + c;
        const float u = bf2f(*Ut), p = (s0 + i > 0) ? bf2f(*(Ut - 1792)) : 0.f; const float x = u + P.mu[1536 + c] * (p - u);
        if (c < 64) { const float e2 = __expf(2.f * x); *(LAS bf16_t*)(LAw + i * SW + c * 2) = f2bf(1.f - 2.f / (e2 + 1.f)); }
        else if (c < 128) *(LAS bf16_t*)(LAa + i * SW + (c - 64) * 2) = f2bf(x);
        else *(LAS bf16_t*)(LAg + i * SG + (c - 128) * 2) = f2bf(sigmoidf_(x)); }
    if (P.layer > 0) {
#pragma unroll 2
        for (int e = 0; e < 16; ++e) { const int idx = tid + 512 * e, i = idx >> 7, c = (idx & 127) * 4; const bf16_t* Ut = P.U + (size_t)(t0 + i) * 1792;
            const f32x4 x = shifted4(Ut, s0 + i > 0, 1024 + c, P.mu); u32x2 w; w.x = cvt_pk_bf16(x[0], x[1]); w.y = cvt_pk_bf16(x[2], x[3]); *(LAS u32x2*)(LAv + i * SV + c * 2) = w; }
    }
    __syncthreads();
    if (P.layer > 0) {
        const int mt = wave >> 1, nt = wave & 1; f32x4 acc = (f32x4){0.f, 0.f, 0.f, 0.f};
#pragma unroll 4
        for (int ks = 0; ks < 16; ++ks) { const bf16x8 a = *(LAS const bf16x8*)(LAv + (16 * mt + fr) * SV + (ks * 32 + fq * 8) * 2);
            const bf16x8 b = *(const bf16x8*)(P.v1t + (size_t)(16 * nt + fr) * 512 + ks * 32 + fq * 8); acc = mfma16(b, a, acc); }
        u32x2 w; w.x = cvt_pk_bf16(acc[0], acc[1]); w.y = cvt_pk_bf16(acc[2], acc[3]); *(LAS u32x2*)(LAvv + (16 * mt + fr) * SVV + (16 * nt + 4 * fq) * 2) = w;
    }
    __syncthreads();
    const int h = wave, cb = 64 * h; const int b_ = t0 >> 12, p = b_ * 8 + h;
#pragma unroll 1
    for (int m = 0; m < 4; ++m) {
        const int i = 16 * m + fr; const bf16_t* Ut = P.U + (size_t)(t0 + i) * 1792; const bool hp = (s0 + i) > 0;
        int fq4 = 4 * fq; asm volatile("" : "+v"(fq4));
        f32x4 aa[4], acc[4];
        row_gemm<64>(aa, LAa + i * SW, P.a2t + (size_t)cb * 64, fr, fq);
#pragma unroll
        for (int n = 0; n < 4; ++n) { const f32x4 a0v = *(const f32x4*)(P.a0 + cb + 16 * n + fq4);
#pragma unroll
            for (int j = 0; j < 4; ++j) aa[n][j] = sigmoidf_(aa[n][j] + a0v[j]); }
        row_gemm<64>(acc, LAw + i * SW, P.w2t + (size_t)cb * 64, fr, fq);
#pragma unroll
        for (int n = 0; n < 4; ++n) { const f32x4 w0v = *(const f32x4*)(P.w0 + cb + 16 * n + fq4); f32x4 d;
#pragma unroll
            for (int j = 0; j < 4; ++j) d[j] = __expf(-0.6065306597f * sigmoidf_(acc[n][j] + w0v[j]));
            *(f32x4*)(P.Wd + ((size_t)p * SEQ + s0 + i) * 64 + 16 * n + fq4) = d; }
        row_gemm<128>(acc, LAg + i * SG, P.g2t + (size_t)cb * 128, fr, fq);
#pragma unroll
        for (int n = 0; n < 4; ++n) st_bf4(P.Go + (size_t)(t0 + i) * 512 + cb + 16 * n + fq4, acc[n]);
        asm volatile("" ::: "memory");
        if (P.layer > 0) row_gemm<32>(acc, LAvv + i * SVV, P.v2t + (size_t)cb * 32, fr, fq);
        float bon = 0.f, nk = 0.f; f32x4 kv[4], rv[4];
#pragma unroll
        for (int n = 0; n < 4; ++n) { const int c = cb + 16 * n + fq4;
            f32x4 v = shifted4(Ut, hp, 1024 + c, P.mu);
            if (P.layer > 0) { const f32x4 vf = *(const f32x4*)(P.vfirst + (size_t)(t0 + i) * 512 + c); const f32x4 v0v = *(const f32x4*)(P.v0 + c);
#pragma unroll
                for (int j = 0; j < 4; ++j) v[j] = v[j] + (vf[j] - v[j]) * sigmoidf_(v0v[j] + acc[n][j]); }
            else *(f32x4*)(P.vfirst + (size_t)(t0 + i) * 512 + c) = v;
            *(f32x4*)(P.V + ((size_t)p * SEQ + s0 + i) * 64 + 16 * n + fq4) = v;
            kv[n] = shifted4(Ut, hp, 512 + c, P.mu); rv[n] = shifted4(Ut, hp, c, P.mu);
            const f32x4 kkw = *(const f32x4*)(P.kk_ + c);
#pragma unroll
            for (int j = 0; j < 4; ++j) { const float x = kv[n][j] * kkw[j]; nk += x * x; } }
        nk += __shfl_xor(nk, 16); nk += __shfl_xor(nk, 32);
        const float inv = 1.0f / fmaxf(sqrtf(nk), 1e-12f);
        bf16_t* O = P.RKKB + ((size_t)p * SEQ + s0 + i) * 256;
#pragma unroll
        for (int n = 0; n < 4; ++n) { const int c = cb + 16 * n + fq4; const f32x4 kkw = *(const f32x4*)(P.kk_ + c), kaw = *(const f32x4*)(P.ka + c), rkw = *(const f32x4*)(P.rk + c);
            f32x4 kk, kh, bb;
#pragma unroll
            for (int j = 0; j < 4; ++j) { const float a = aa[n][j]; kk[j] = kv[n][j] * kkw[j] * inv; kh[j] = kv[n][j] * (1.f + (a - 1.f) * kaw[j]); bb[j] = kk[j] * a; bon += rv[n][j] * kh[j] * rkw[j]; }
            const int cc = 16 * n + fq4; st_bf4(O + cc, rv[n]); st_bf4(O + 64 + cc, kh); st_bf4(O + 128 + cc, kk); st_bf4(O + 192 + cc, bb); }
        bon += __shfl_xor(bon, 16); bon += __shfl_xor(bon, 32);
        if (fq == 0) P.Bon[(size_t)(t0 + i) * 8 + h] = bon;
        asm volatile("" ::: "memory");
    }
    __syncthreads();
}

constexpr int SCAN_CH = 32, SCAN_STEP_B = 1312, SCAN_SLOT_B = SCAN_CH * SCAN_STEP_B;
template <int CTRL> __device__ __forceinline__ float dpp_f(float v) { return __int_as_float(__builtin_amdgcn_update_dpp(0, __float_as_int(v), CTRL, 0xf, 0xf, true)); }
__device__ __forceinline__ float row16_sum(float v) { v += dpp_f<0xB1>(v); v += dpp_f<0x4E>(v); v += dpp_f<0x141>(v); v += dpp_f<0x140>(v); return v; }

__device__ __forceinline__ void scan_load_chunk(LAS unsigned char* slot, const float* Wd, const float* V, const bf16_t* RKKB, int p, int rg, int s0, int ltid, int nthr) {
    for (int idx = ltid; idx < 1600; idx += nthr) {
        if (idx < 512) { const int st = idx >> 4, part = idx & 15; *(LAS f32x4*)(slot + st * SCAN_STEP_B + part * 16) = *(const f32x4*)(Wd + ((size_t)p * SEQ + s0 + st) * 64 + part * 4); }
        else if (idx < 1536) { const int k = idx - 512, st = k >> 5, rem = k & 31, q = rem >> 3, part = rem & 7;
            const u32x4 w = *(const u32x4*)(RKKB + (((size_t)p * SEQ + s0 + st) * 4 + q) * 64 + part * 8);
            const int Q = (q == 0) ? 4 : (q == 1) ? 2 : (q == 2) ? 3 : 1;
            LAS f32x4* d = (LAS f32x4*)(slot + st * SCAN_STEP_B + Q * 256 + part * 32);
            d[0] = (f32x4){bflo(w.x), bfhi(w.x), bflo(w.y), bfhi(w.y)}; d[1] = (f32x4){bflo(w.z), bfhi(w.z), bflo(w.w), bfhi(w.w)}; }
        else { const int k = idx - 1536, st = k >> 1, hf = k & 1; *(LAS f32x4*)(slot + st * SCAN_STEP_B + 1280 + hf * 16) = *(const f32x4*)(V + ((size_t)p * SEQ + s0 + st) * 64 + rg * 8 + hf * 4); }
    }
}

__device__ __forceinline__ void rwkv_scan_unit(LAS unsigned char* lds, const float* Wd, const float* V, const bf16_t* RKKB, float* Yraw, int p, int rg, int tid) {
    const int lane = tid & 63, wave = __builtin_amdgcn_readfirstlane(tid >> 6);
    constexpr int NCH = SEQ / SCAN_CH;
    scan_load_chunk(lds, Wd, V, RKKB, p, rg, 0, tid, 512);
    scan_load_chunk(lds + SCAN_SLOT_B, Wd, V, RKKB, p, rg, SCAN_CH, tid, 512);
    __syncthreads();
    f32x4 S = (f32x4){0.f, 0.f, 0.f, 0.f};
    const int kq = lane & 15, rl = wave * 4 + (lane >> 4);
    for (int c = 0; c < NCH; ++c) {
        if (wave >= 2) { if (c + 2 < NCH) scan_load_chunk(lds + ((c + 2) % 3) * SCAN_SLOT_B, Wd, V, RKKB, p, rg, (c + 2) * SCAN_CH, tid - 128, 384); }
        else {
            LAS const unsigned char* sl = lds + (c % 3) * SCAN_SLOT_B + kq * 16;
            LAS const unsigned char* vl = lds + (c % 3) * SCAN_SLOT_B + 1280 + rl * 4;
            float* yo = Yraw + ((size_t)p * SEQ + c * SCAN_CH + kq) * 64 + rg * 8 + rl;
            f32x4 w = *(LAS const f32x4*)(sl), b = *(LAS const f32x4*)(sl + 256), k = *(LAS const f32x4*)(sl + 512), kk = *(LAS const f32x4*)(sl + 768), r = *(LAS const f32x4*)(sl + 1024);
            float v = *(LAS const float*)(vl); float ykeep = 0.f;
#pragma unroll
            for (int st = 0; st < SCAN_CH; ++st) {
                f32x4 wn = w, bn = b, kn = k, kkn = kk, rn = r; float vn = v;
                if (st + 1 < SCAN_CH) { const int o = (st + 1) * SCAN_STEP_B;
                    wn = *(LAS const f32x4*)(sl + o); bn = *(LAS const f32x4*)(sl + o + 256); kn = *(LAS const f32x4*)(sl + o + 512); kkn = *(LAS const f32x4*)(sl + o + 768); rn = *(LAS const f32x4*)(sl + o + 1024);
                    vn = *(LAS const float*)(vl + o); }
                float sa = (S[0] * kk[0] + S[1] * kk[1]) + (S[2] * kk[2] + S[3] * kk[3]);
                const f32x4 kvt = k * v;
                sa = -row16_sum(sa);
                S = S * w + (b * sa + kvt);
                float y = (S[0] * r[0] + S[1] * r[1]) + (S[2] * r[2] + S[3] * r[3]);
                y = row16_sum(y);
                ykeep = (kq == (st & 15)) ? y : ykeep;
                if ((st & 15) == 15) yo[(size_t)(st - 15) * 64] = ykeep;
                w = wn; b = bn; k = kn; kk = kkn; r = rn; v = vn;
            }
        }
        __syncthreads();
    }
}

struct GlaArgs { const bf16_t* Ug; const float *conv, *aup, *abias, *gnorm; float* kvcT; float* dec; bf16_t* spT; bf16_t* Yg; };
constexpr int GL_GC = 0;
constexpr int GL_T0 = 16640;
constexpr int GL_VT = GL_T0 + 4 * 9216;
constexpr int GL_AL = GL_VT + 18432;
constexpr int GL_RS = GL_AL + 9216;

__device__ __forceinline__ void gla_conv8(f32x4 (&out)[8], const bf16_t* Ug, const float* conv, int t0, int s0, int i0, int c0) {
    f32x4 w[4];
#pragma unroll
    for (int j = 0; j < 4; ++j) w[j] = *(const f32x4*)(conv + j * 1024 + c0);
#pragma unroll
    for (int e = 0; e < 8; ++e) { const int i = i0 + 8 * e; f32x4 a = (f32x4){0.f, 0.f, 0.f, 0.f};
#pragma unroll
        for (int j = 0; j < 4; ++j) { const int ds = 3 - j; if (s0 + i - ds >= 0) a += w[j] * ld_bf4(Ug + (size_t)(t0 + i - ds) * 1792 + c0); }
#pragma unroll
        for (int q = 0; q < 4; ++q) a[q] = a[q] * sigmoidf_(a[q]);
        out[e] = a; }
}
__device__ __forceinline__ void gla_gcum(LAS unsigned char* lds, const GlaArgs& A, int t0, int h, int tid) {
    LAS float* GC = (LAS float*)(lds + GL_GC);
    { const int d = tid & 63, i0 = tid >> 6; float au[16]; const float ab = A.abias[h * 64 + d];
#pragma unroll
      for (int j = 0; j < 16; ++j) au[j] = A.aup[j * 256 + h * 64 + d];
#pragma unroll
      for (int e = 0; e < 8; ++e) { const int i = i0 + 8 * e; const u32x4* ap = (const u32x4*)(A.Ug + (size_t)(t0 + i) * 1792 + 1024); const u32x4 a0 = ap[0], a1 = ap[1];
          float x = ab;
          x += bflo(a0.x) * au[0] + bfhi(a0.x) * au[1] + bflo(a0.y) * au[2] + bfhi(a0.y) * au[3] + bflo(a0.z) * au[4] + bfhi(a0.z) * au[5] + bflo(a0.w) * au[6] + bfhi(a0.w) * au[7];
          x += bflo(a1.x) * au[8] + bfhi(a1.x) * au[9] + bflo(a1.y) * au[10] + bfhi(a1.y) * au[11] + bflo(a1.z) * au[12] + bfhi(a1.z) * au[13] + bflo(a1.w) * au[14] + bfhi(a1.w) * au[15];
          const float ls = fminf(x, 0.f) - __logf(1.f + __expf(-fabsf(x)));
          GC[i * 65 + d] = ls * (1.0f / 16.0f); } }
    __syncthreads();
    { const int lane = tid & 63, wave = tid >> 6;
#pragma unroll
      for (int dd = 0; dd < 8; ++dd) { const int d = wave * 8 + dd; float x = GC[lane * 65 + d];
#pragma unroll
          for (int o = 1; o < 64; o <<= 1) { const float y = __shfl_up(x, o); if (lane >= o) x += y; }
          GC[lane * 65 + d] = x; } }
    __syncthreads();
}
__device__ __forceinline__ void gla_a_tile(LAS unsigned char* lds, const GlaArgs& A, int tile, int tid) {
    const int bh = tile >> 6, n = tile & 63, b = bh >> 2, h = bh & 3, t0 = b * SEQ + n * 64, s0 = n * 64;
    LAS float* GC = (LAS float*)(lds + GL_GC); LAS bf16_t* KDT = (LAS bf16_t*)(lds + GL_T0); LAS bf16_t* VT = (LAS bf16_t*)(lds + GL_VT);
    gla_gcum(lds, A, t0, h, tid);
    { const int cc = (tid & 63) * 4, i0 = tid >> 6;
      if (cc >= 64) { f32x4 o[8]; const int c0 = (cc < 128) ? 256 + h * 64 + (cc - 64) : 512 + h * 128 + (cc - 128);
          gla_conv8(o, A.Ug, A.conv, t0, s0, i0, c0);
          if (cc < 128) { const int d = cc - 64;
#pragma unroll
              for (int e = 0; e < 8; ++e) { const int i = i0 + 8 * e;
#pragma unroll
                  for (int q = 0; q < 4; ++q) KDT[(d + q) * 72 + i] = f2bf(o[e][q] * __expf(GC[63 * 65 + d + q] - GC[i * 65 + d + q])); } }
          else { const int ev = cc - 128;
#pragma unroll
              for (int e = 0; e < 8; ++e) { const int i = i0 + 8 * e;
#pragma unroll
                  for (int q = 0; q < 4; ++q) VT[(ev + q) * 72 + i] = f2bf(o[e][q]); } } } }
    if (tid < 64) A.dec[((size_t)bh * 64 + n) * 64 + tid] = __expf(GC[63 * 65 + tid]);
    __syncthreads();
    { const int lane = tid & 63, wave = tid >> 6, fr = lane & 15, fq = lane >> 4; f32x4 acc[4];
#pragma unroll
      for (int nt = 0; nt < 4; ++nt) acc[nt] = (f32x4){0.f, 0.f, 0.f, 0.f};
#pragma unroll
      for (int ks = 0; ks < 2; ++ks) { const bf16x8 a = *(LAS const bf16x8*)(VT + (16 * wave + fr) * 72 + ks * 32 + fq * 8);
#pragma unroll
          for (int nt = 0; nt < 4; ++nt) { const bf16x8 bfr = *(LAS const bf16x8*)(KDT + (16 * nt + fr) * 72 + ks * 32 + fq * 8); acc[nt] = mfma16(bfr, a, acc[nt]); } }
#pragma unroll
      for (int nt = 0; nt < 4; ++nt) *(f32x4*)(A.kvcT + (((size_t)bh * 64 + n) * 128 + 16 * wave + fr) * 64 + 16 * nt + 4 * fq) = acc[nt]; }
    __syncthreads();
}
__device__ __forceinline__ void gla_c_tile(LAS unsigned char* lds, const GlaArgs& A, int tile, int tid) {
    const int bh = tile >> 6, n = tile & 63, b = bh >> 2, h = bh & 3, t0 = b * SEQ + n * 64, s0 = n * 64;
    LAS float* GC = (LAS float*)(lds + GL_GC); LAS bf16_t* QG = (LAS bf16_t*)(lds + GL_T0); LAS bf16_t* KG = QG + 64 * 72; LAS bf16_t* QR = KG + 64 * 72; LAS bf16_t* KR = QR + 64 * 72;
    LAS bf16_t* VT = (LAS bf16_t*)(lds + GL_VT); LAS bf16_t* AL = (LAS bf16_t*)(lds + GL_AL); LAS float* RS = (LAS float*)(lds + GL_RS);
    gla_gcum(lds, A, t0, h, tid);
    { const int cc = (tid & 63) * 4, i0 = tid >> 6; f32x4 o[8];
      const int c0 = (cc < 64) ? h * 64 + cc : (cc < 128) ? 256 + h * 64 + (cc - 64) : 512 + h * 128 + (cc - 128);
      gla_conv8(o, A.Ug, A.conv, t0, s0, i0, c0);
      if (cc < 128) { const int d = cc & 63; const bool isq = cc < 64; LAS bf16_t* T1 = isq ? QG : KR; LAS bf16_t* T2 = isq ? QR : KG; const float sc = isq ? 0.125f : 1.0f;
#pragma unroll
          for (int e = 0; e < 8; ++e) { const int i = i0 + 8 * e; f32x4 x1, x2;
#pragma unroll
              for (int q = 0; q < 4; ++q) { const float eg = __expf(GC[i * 65 + d + q]); const float x = o[e][q] * sc; x1[q] = x * eg; x2[q] = x / eg; }
              u32x2 w1, w2; w1.x = cvt_pk_bf16(x1[0], x1[1]); w1.y = cvt_pk_bf16(x1[2], x1[3]); w2.x = cvt_pk_bf16(x2[0], x2[1]); w2.y = cvt_pk_bf16(x2[2], x2[3]);
              *(LAS u32x2*)(T1 + i * 72 + d) = w1; *(LAS u32x2*)(T2 + i * 72 + d) = w2; } }
      else { const int ev = cc - 128;
#pragma unroll
          for (int e = 0; e < 8; ++e) { const int i = i0 + 8 * e;
#pragma unroll
              for (int q = 0; q < 4; ++q) VT[(ev + q) * 72 + i] = f2bf(o[e][q]); } } }
    __syncthreads();
    const int lane = tid & 63, wave = tid >> 6, fr = lane & 15, fq = lane >> 4; const int mt = wave >> 1;
    {
#pragma unroll
        for (int q = 0; q < 2; ++q) { const int nt = (wave & 1) * 2 + q; f32x4 ap = (f32x4){0.f, 0.f, 0.f, 0.f}, af = ap;
#pragma unroll
            for (int ks = 0; ks < 2; ++ks) { const int ko = ks * 32 + fq * 8;
                ap = mfma16(*(LAS const bf16x8*)(KG + (16 * nt + fr) * 72 + ko), *(LAS const bf16x8*)(QG + (16 * mt + fr) * 72 + ko), ap);
                af = mfma16(*(LAS const bf16x8*)(KR + (16 * nt + fr) * 72 + ko), *(LAS const bf16x8*)(QR + (16 * mt + fr) * 72 + ko), af); }
            const int trow = 16 * mt + fr; f32x4 o;
#pragma unroll
            for (int j = 0; j < 4; ++j) { const int scol = 16 * nt + 4 * fq + j; o[j] = (scol <= trow) ? ap[j] : af[j]; }
            u32x2 w; w.x = cvt_pk_bf16(o[0], o[1]); w.y = cvt_pk_bf16(o[2], o[3]); *(LAS u32x2*)(AL + trow * 72 + 16 * nt + 4 * fq) = w; }
    }
    __syncthreads();
    f32x4 acc[4];
#pragma unroll
    for (int q = 0; q < 4; ++q) acc[q] = (f32x4){0.f, 0.f, 0.f, 0.f};
    const bf16_t* sp = A.spT + ((size_t)bh * 64 + n) * 128 * 64;
#pragma unroll
    for (int ks = 0; ks < 2; ++ks) { const int ko = ks * 32 + fq * 8; const bf16x8 a1 = *(LAS const bf16x8*)(AL + (16 * mt + fr) * 72 + ko), a2 = *(LAS const bf16x8*)(QG + (16 * mt + fr) * 72 + ko);
#pragma unroll
        for (int q = 0; q < 4; ++q) { const int nt = (wave & 1) * 4 + q;
            acc[q] = mfma16(*(LAS const bf16x8*)(VT + (16 * nt + fr) * 72 + ko), a1, acc[q]);
            acc[q] = mfma16(*(const bf16x8*)(sp + (size_t)(16 * nt + fr) * 64 + ko), a2, acc[q]); } }
    float ssq = 0.f;
#pragma unroll
    for (int q = 0; q < 4; ++q) ssq += (acc[q][0] * acc[q][0] + acc[q][1] * acc[q][1]) + (acc[q][2] * acc[q][2] + acc[q][3] * acc[q][3]);
    ssq += __shfl_xor(ssq, 16); ssq += __shfl_xor(ssq, 32);
    if (fq == 0) RS[(16 * mt + fr) * 2 + (wave & 1)] = ssq;
    __syncthreads();
    { const int i = 16 * mt + fr; const float rs = rsqrtf((RS[i * 2] + RS[i * 2 + 1]) * (1.0f / 128.0f) + 1e-6f);
#pragma unroll
      for (int q = 0; q < 4; ++q) { const int ecol = h * 128 + ((wave & 1) * 4 + q) * 16 + 4 * fq; const f32x4 nw = *(const f32x4*)(A.gnorm + ecol); const f32x4 go = ld_bf4(A.Ug + (size_t)(t0 + i) * 1792 + 1040 + ecol); f32x4 o;
#pragma unroll
          for (int j = 0; j < 4; ++j) o[j] = acc[q][j] * rs * nw[j] * go[j] * sigmoidf_(go[j]);
          st_bf4(A.Yg + (size_t)(t0 + i) * 512 + ecol, o); } }
    __syncthreads();
}

__device__ __forceinline__ void xa_tile(const bf16_t* Ux, const bf16_t* Kb, const bf16_t* Vt, bf16_t* Yx, int tile, int tid) {
    const int blk = tile & 31, h = (tile >> 5) & 3, b = tile >> 7; const int lane = tid & 63, wave = tid >> 6, fr = lane & 15, fq = lane >> 4;
    const int t = b * SEQ + blk * 128 + 16 * wave + fr;
    bf16x8 qf[4];
#pragma unroll
    for (int ks = 0; ks < 4; ++ks) qf[ks] = *(const bf16x8*)(Ux + (size_t)t * 512 + h * 128 + ks * 32 + fq * 8);
    f32x4 s[16];
#pragma unroll
    for (int nt = 0; nt < 16; ++nt) { s[nt] = (f32x4){0.f, 0.f, 0.f, 0.f}; const bf16_t* kr = Kb + (size_t)(b * 256 + 16 * nt + fr) * 512 + h * 128 + fq * 8;
#pragma unroll
        for (int ks = 0; ks < 4; ++ks) s[nt] = mfma16(*(const bf16x8*)(kr + ks * 32), qf[ks], s[nt]); }
    float mx = -1e30f;
#pragma unroll
    for (int nt = 0; nt < 16; ++nt)
#pragma unroll
        for (int j = 0; j < 4; ++j) mx = fmaxf(mx, s[nt][j]);
    mx = fmaxf(mx, __shfl_xor(mx, 16)); mx = fmaxf(mx, __shfl_xor(mx, 32));
    const float sc = 0.08838834764831845f * 1.4426950408889634f; float l = 0.f;
#pragma unroll
    for (int nt = 0; nt < 16; ++nt)
#pragma unroll
        for (int j = 0; j < 4; ++j) { const float pz = exp2f((s[nt][j] - mx) * sc); s[nt][j] = pz; l += pz; }
    l += __shfl_xor(l, 16); l += __shfl_xor(l, 32);
    f32x4 o[8];
#pragma unroll
    for (int dt = 0; dt < 8; ++dt) o[dt] = (f32x4){0.f, 0.f, 0.f, 0.f};
#pragma unroll
    for (int c = 0; c < 8; ++c) { union { u32x4 u; bf16x8 v; } pf;
        pf.u.x = cvt_pk_bf16(s[2 * c][0], s[2 * c][1]); pf.u.y = cvt_pk_bf16(s[2 * c][2], s[2 * c][3]); pf.u.z = cvt_pk_bf16(s[2 * c + 1][0], s[2 * c + 1][1]); pf.u.w = cvt_pk_bf16(s[2 * c + 1][2], s[2 * c + 1][3]);
#pragma unroll
        for (int dt = 0; dt < 8; ++dt) { const bf16_t* vr = Vt + ((size_t)b * 512 + h * 128 + 16 * dt + fr) * 256 + 32 * c + 4 * fq; union { u32x4 u; bf16x8 v; } vf;
            const u32x2 lo = *(const u32x2*)vr, hi = *(const u32x2*)(vr + 16); vf.u.x = lo.x; vf.u.y = lo.y; vf.u.z = hi.x; vf.u.w = hi.y;
            o[dt] = mfma16(vf.v, pf.v, o[dt]); } }
    const float il = 1.0f / l;
#pragma unroll
    for (int dt = 0; dt < 8; ++dt) st_bf4(Yx + (size_t)t * 512 + h * 128 + 16 * dt + 4 * fq, o[dt] * il);
}

struct Params { const float* in[33]; float* out; unsigned char* ws; };

__device__ __forceinline__ int opaque0() { int z = 0; asm volatile("" : "+s"(z)); return z; }
typedef __attribute__((address_space(1))) unsigned char* gptr_t;
typedef __attribute__((address_space(1))) const float* gcf_t;
__device__ __forceinline__ int opqv(int v) { asm volatile("" : "+v"(v)); return v; }
__device__ __forceinline__ int opqs(int v) { asm volatile("" : "+s"(v)); return v; }
#define PH_BEGIN const int zi = opaque0(); unsigned char* ws = P.ws + zi; float* const OUT = P.out + zi; (void)OUT; const int tid = opqv((int)threadIdx.x); const int bid = opqs((int)blockIdx.x); const int G = opqs((int)gridDim.x); (void)tid; (void)bid; (void)G; unsigned char* WB = ws + WS_WB; float* SS = (float*)(ws + WS_SS); (void)WB; (void)SS; (void)zi;
#define INP(k) (P.in[(k)] + zi)
#define XB_ ((bf16_t*)(ws + WS_XB))
#define U_ (ws + WS_U)
#define SC_ (ws + WS_SC)
#define Y_ ((bf16_t*)(ws + WS_Y))
#define KB_ ((bf16_t*)(ws + WS_KB))
#define VT_ ((bf16_t*)(ws + WS_VT))

constexpr size_t WS_BAR = WS_MISC + 8192;
__device__ __forceinline__ void grid_bar(unsigned* ctr, unsigned target) {
    asm volatile("s_waitcnt vmcnt(0)" ::: "memory");
    __syncthreads();
    if (threadIdx.x == 0) {
        __builtin_amdgcn_fence(__ATOMIC_RELEASE, "agent");
        asm volatile("s_waitcnt vmcnt(0)" ::: "memory");
        __hip_atomic_fetch_add(ctr, 1u, __ATOMIC_RELAXED, __HIP_MEMORY_SCOPE_AGENT);
        while (__hip_atomic_load(ctr, __ATOMIC_RELAXED, __HIP_MEMORY_SCOPE_AGENT) < target) __builtin_amdgcn_s_sleep(2);
        __builtin_amdgcn_fence(__ATOMIC_ACQUIRE, "agent");
        asm volatile("s_waitcnt vmcnt(0)" ::: "memory");
    }
    __syncthreads();
}

__global__ void __launch_bounds__(512) mega(Params P) {
    extern __shared__ __attribute__((aligned(16))) unsigned char lds_raw[];
    LAS unsigned char* lds = (LAS unsigned char*)lds_raw;
    cg::grid_group grid = cg::this_grid();

    for (int ph = 0; ph < NL * 12 + 1; ++ph) {
        const int l = ph / 12, kph = ph - l * 12;
        if (ph == NL * 12) {
#if (PHMASK >> 12) & 1
    { PH_BEGIN
        const int lane = tid & 63, gw = bid * 8 + (tid >> 6), nw = G * 8;
        const float* fn = INP(32); const float* ssf = SS + (size_t)0 * T * 16; float* X = OUT;
        for (int r = gw; r < T; r += nw) { const float rs = row_rstd(ssf, r);
#pragma unroll
            for (int i = 0; i < 4; ++i) { const size_t o = (size_t)r * D + i * 256 + lane * 4; *(f32x4*)(X + o) = *(const f32x4*)(X + o) * rs * *(const f32x4*)(fn + i * 256 + lane * 4); } }
    }
#endif
            break;
        }
        switch (kph) {
        case 0: {
#if (PHMASK >> 0) & 1
        for (int rep = 0; rep < REP0; ++rep) {
        {
            { PH_BEGIN convT<1>(lds, INP(3) + (size_t)l * D * 2 * FF, 2 * FF, 0, INP(2) + (size_t)l * D, (bf16_t*)(WB + WB_W1A), D, D, 2 * FF, G, bid, tid); }
            { PH_BEGIN convT<0>(lds, INP(4) + (size_t)l * FF * D, D, 0, nullptr, (bf16_t*)(WB + WB_W1B), FF, FF, D, G, bid, tid); }
            { PH_BEGIN convT<2>(lds, INP(7) + (size_t)l * D * 6928, 6928, 0, INP(5) + (size_t)l * D, (bf16_t*)(WB + WB_WIN), D, D, 4096, G, bid, tid); }
            { PH_BEGIN convT<0>(lds, INP(7) + (size_t)l * D * 6928, 6928, 3856, INP(5) + (size_t)l * D, (bf16_t*)(WB + WB_WG), D, D, 3072, G, bid, tid); }
            for (int j = 0; j < 3; ++j) { PH_BEGIN convT<0>(lds, INP(27) + ((size_t)l * 3 + j) * 512 * D, D, 0, nullptr, (bf16_t*)(WB + WB_WBR) + (size_t)j * D * 512, 512, 512, D, G, bid, tid); }
            { PH_BEGIN convT<0>(lds, INP(28) + (size_t)l * D * D, D, 0, nullptr, (bf16_t*)(WB + WB_WO), D, D, D, G, bid, tid); }
            { PH_BEGIN convT<0>(lds, INP(26) + (size_t)l * D * D, D, 0, INP(6) + (size_t)l * D, (bf16_t*)(WB + WB_WKV), D, D, D, G, bid, tid); }
            { PH_BEGIN convT<1>(lds, INP(30) + (size_t)l * D * 2 * FF, 2 * FF, 0, INP(29) + (size_t)l * D, (bf16_t*)(WB + WB_W2A), D, D, 2 * FF, G, bid, tid); }
            { PH_BEGIN convT<0>(lds, INP(31) + (size_t)l * FF * D, D, 0, nullptr, (bf16_t*)(WB + WB_W2B), FF, FF, D, G, bid, tid); }
            { PH_BEGIN convT<0>(lds, INP(10) + (size_t)l * 64 * 512, 512, 0, nullptr, (bf16_t*)(WB + WB_LW2), 64, 64, 512, G, bid, tid); }
            { PH_BEGIN convT<0>(lds, INP(12) + (size_t)l * 64 * 512, 512, 0, nullptr, (bf16_t*)(WB + WB_LA2), 64, 64, 512, G, bid, tid); }
            { PH_BEGIN convT<0>(lds, INP(13) + (size_t)l * 128 * 512, 512, 0, nullptr, (bf16_t*)(WB + WB_LG2), 128, 128, 512, G, bid, tid); }
            if (l > 0) {
                { PH_BEGIN convT<0>(lds, INP(20) + (size_t)(l - 1) * 512 * 32, 32, 0, nullptr, (bf16_t*)(WB + WB_LV1), 512, 512, 32, G, bid, tid); }
                { PH_BEGIN convT<0>(lds, INP(21) + (size_t)(l - 1) * 32 * 512, 512, 0, nullptr, (bf16_t*)(WB + WB_LV2), 32, 32, 512, G, bid, tid); }
            }
            if (l == 0) { PH_BEGIN
                const int lane = tid & 63, gw = bid * 8 + (tid >> 6), nw = G * 8;
                float* rstd_mem = (float*)(ws + WS_MISC); bf16_t* MEMN = (bf16_t*)(ws + WS_MEMN);
                for (int r = gw; r < T + 1024; r += nw) {
                    const bool ism = r >= T; const float* src = ism ? INP(1) + (size_t)(r - T) * D : INP(0) + (size_t)r * D; bf16_t* dst = ism ? MEMN + (size_t)(r - T) * D : XB_ + (size_t)r * D; float q = 0.f;
#pragma unroll
                    for (int i = 0; i < 4; ++i) { const f32x4 v = *(const f32x4*)(src + i * 256 + lane * 4); st_bf4(dst + i * 256 + lane * 4, v); q += (v[0] * v[0] + v[1] * v[1]) + (v[2] * v[2] + v[3] * v[3]); }
                    q = wave_sum(q);
                    if (ism) { if (lane == 0) rstd_mem[r - T] = rsqrtf(q * (1.0f / 1024.0f) + 1e-6f); } else if (lane < 16) SS[(size_t)r * 16 + lane] = (lane == 0) ? q : 0.f;
                }
            }
        }
        }
#endif
        } break;
        case 1: {
#if (PHMASK >> 1) & 1
        for (int rep = 0; rep < REPG; ++rep) {
        { PH_BEGIN
            pg8::Gemm g{XB_, (const bf16_t*)(WB + WB_W1A), T, 2 * FF, D, D, D, 0, 0}; pg8::StaticOrder S; S.init(T, 2 * FF, G, bid, 1);
            EpiFFNa E{(bf16_t*)U_, SS + (size_t)0 * T * 16}; pg8::gemm_phase(lds, g, S, E, tid);
        }
        if ((int)blockIdx.x >= (int)gridDim.x - 16) { PH_BEGIN
            pg8::Gemm g2{(const bf16_t*)(ws + WS_MEMN), (const bf16_t*)(WB + WB_WKV), 1024, D, D, D, D, 0, 0}; pg8::StaticOrder S2; S2.init(1024, D, 16, bid - (G - 16), 1);
            EpiKV E2{KB_, VT_, (const float*)(ws + WS_MISC)}; pg8::gemm_phase(lds, g2, S2, E2, tid);
        }
        }
#endif
        } break;
        case 2: {
#if (PHMASK >> 2) & 1
        { PH_BEGIN
            pg8::Gemm g{(const bf16_t*)U_, (const bf16_t*)(WB + WB_W1B), T, D, FF, FF, FF, 0, 0}; pg8::StaticOrder S; S.init(T, D, G, bid, 1);
            EpiRes E{l == 0 ? INP(0) : OUT, OUT, XB_, SS + (size_t)1 * T * 16, 0.5f}; pg8::gemm_phase(lds, g, S, E, tid);
        }
#endif
        } break;
        case 3: {
#if (PHMASK >> 3) & 1
        for (int rep = 0; rep < REPG; ++rep) {
        { PH_BEGIN
            pg8::Gemm g{XB_, (const bf16_t*)(WB + WB_WIN), T, 4096, D, D, D, 0, 0}; pg8::StaticOrder S; S.init(T, 4096, G, bid, 1);
            EpiU E{(bf16_t*)U_, SS + (size_t)1 * T * 16}; pg8::gemm_phase(lds, g, S, E, tid);
        }
        }
#endif
        } break;
        case 4: {
#if (PHMASK >> 4) & 1
        for (int rep = 0; rep < REP4; ++rep) {
#if P4SUB & 1
        { PH_BEGIN
            PrepArgs PA; PA.U = (const bf16_t*)(U_ + U_RWKV); PA.mu = INP(8) + (size_t)l * 1792; PA.w0 = INP(9) + (size_t)l * 512; PA.a0 = INP(11) + (size_t)l * 512;
            PA.kk_ = INP(14) + (size_t)l * 512; PA.ka = INP(15) + (size_t)l * 512; PA.rk = INP(16) + (size_t)l * 512; PA.v0 = INP(19) + (size_t)(l > 0 ? l - 1 : 0) * 512;
            PA.w2t = (const bf16_t*)(WB + WB_LW2); PA.a2t = (const bf16_t*)(WB + WB_LA2); PA.g2t = (const bf16_t*)(WB + WB_LG2); PA.v1t = (const bf16_t*)(WB + WB_LV1); PA.v2t = (const bf16_t*)(WB + WB_LV2);
            PA.vfirst = (float*)(ws + WS_VF); PA.Wd = (float*)(SC_ + SC_WD); PA.V = (float*)(SC_ + SC_V); PA.RKKB = (bf16_t*)(SC_ + SC_RKKB); PA.Go = (bf16_t*)(ws + WS_GO); PA.Bon = (float*)(ws + WS_BON); PA.layer = l;
            for (int tt = bid; tt < 256; tt += G) rwkv_prep_tile(lds, PA, tt, tid);
        }
#endif
#if P4SUB & 2
        { PH_BEGIN
            GlaArgs GA; GA.Ug = (const bf16_t*)(U_ + U_GLA); GA.conv = INP(22) + (size_t)l * 4096; GA.aup = INP(23) + (size_t)l * 4096; GA.abias = INP(24) + (size_t)l * 256; GA.gnorm = INP(25) + (size_t)l * 512;
            GA.kvcT = (float*)(ws + WS_KVC); GA.dec = (float*)(ws + WS_DEC); GA.spT = (bf16_t*)(U_ + U_SPT); GA.Yg = Y_ + (size_t)T * 512;
            for (int tile = bid; tile < 1024; tile += G) gla_a_tile(lds, GA, tile, tid);
        }
#endif
#if P4SUB & 4
        { PH_BEGIN
            for (int tile = bid; tile < 512; tile += G) xa_tile((const bf16_t*)(U_ + U_XA), KB_, VT_, Y_ + (size_t)2 * T * 512, tile, tid);
        }
#endif
        }
#endif
        } break;
        case 5: {
#if (PHMASK >> 5) & 1
        for (int rep = 0; rep < REP5; ++rep) {
        { PH_BEGIN
            bf16_t* spT = (bf16_t*)(U_ + U_SPT); const float* DEC = (const float*)(ws + WS_DEC); const float* KVC = (const float*)(ws + WS_KVC);
            for (int i = bid * 512 + tid; i < 16 * 128 * 64; i += G * 512) { const int bh = i >> 13, ed = i & 8191, d = i & 63; float st = 0.f;
#pragma unroll 16
                for (int n = 0; n < 64; ++n) { const size_t o = ((size_t)bh * 64 + n) * 8192 + ed; spT[o] = f2bf(st); st = st * DEC[((size_t)bh * 64 + n) * 64 + d] + KVC[o]; } }
        }
        { PH_BEGIN
            for (int u = bid; u < 256; u += G) { const int xcd = u & 7, j = u >> 3, p = xcd * 4 + (j >> 3), rg = j & 7;
                rwkv_scan_unit(lds, (const float*)(SC_ + SC_WD), (const float*)(SC_ + SC_V), (const bf16_t*)(SC_ + SC_RKKB), (float*)(U_ + U_YRAW), p, rg, tid); }
        }
        }
#endif
        } break;
        case 6: {
#if (PHMASK >> 6) & 1
        for (int rep = 0; rep < REP6; ++rep) {
        { PH_BEGIN
            const int lane = tid & 63, gw = bid * 8 + (tid >> 6), nw = G * 8;
            const float* lnw = INP(17) + (size_t)l * 512; const float* lnb = INP(18) + (size_t)l * 512; const float* Yraw = (const float*)(U_ + U_YRAW); const float* Vv = (const float*)(SC_ + SC_V);
            const float* BON = (const float*)(ws + WS_BON); const bf16_t* GO = (const bf16_t*)(ws + WS_GO); bf16_t* Y = Y_;
            const int kq = lane & 15, sub = lane >> 4;
#pragma unroll 4
            for (int it0 = gw * 4; it0 < 32 * SEQ; it0 += nw * 4) { const int it = it0 + sub; const int p = it >> 12, s = it & (SEQ - 1), b = p >> 3, h = p & 7, t = b * SEQ + s;
                const f32x4 y = *(const f32x4*)(Yraw + (size_t)it * 64 + kq * 4); const f32x4 vv = *(const f32x4*)(Vv + (size_t)it * 64 + kq * 4);
                const f32x4 gg = ld_bf4(GO + (size_t)t * 512 + h * 64 + kq * 4); const f32x4 lw = *(const f32x4*)(lnw + h * 64 + kq * 4), lb = *(const f32x4*)(lnb + h * 64 + kq * 4); const float bon = BON[(size_t)t * 8 + h];
                const float mean = row16_sum((y[0] + y[1]) + (y[2] + y[3])) * (1.0f / 64.0f); const f32x4 dl = y - mean;
                const float var = row16_sum((dl[0] * dl[0] + dl[1] * dl[1]) + (dl[2] * dl[2] + dl[3] * dl[3])) * (1.0f / 64.0f); const float rs = rsqrtf(var + 64e-5f);
                st_bf4(Y + (size_t)t * 512 + h * 64 + kq * 4, ((dl * rs) * lw + lb + vv * bon) * gg); }
        }
        { PH_BEGIN
            GlaArgs GA; GA.Ug = (const bf16_t*)(U_ + U_GLA); GA.conv = INP(22) + (size_t)l * 4096; GA.aup = INP(23) + (size_t)l * 4096; GA.abias = INP(24) + (size_t)l * 256; GA.gnorm = INP(25) + (size_t)l * 512;
            GA.kvcT = (float*)(ws + WS_KVC); GA.dec = (float*)(ws + WS_DEC); GA.spT = (bf16_t*)(U_ + U_SPT); GA.Yg = Y_ + (size_t)T * 512;
            for (int tile = bid; tile < 1024; tile += G) gla_c_tile(lds, GA, tile, tid);
        }
        }
#endif
        } break;
        case 7: {
#if (PHMASK >> 7) & 1
        for (int rep = 0; rep < REPG; ++rep) {
        { PH_BEGIN
            pg8::Gemm g{XB_, (const bf16_t*)(WB + WB_WG), T, 3072, D, D, D, 0, 0}; pg8::StaticOrder S; S.init(T, 3072, G, bid, 1);
            EpiGate E{(bf16_t*)SC_, SS + (size_t)1 * T * 16}; pg8::gemm_phase(lds, g, S, E, tid);
        }
        }
#endif
        } break;
        case 8: {
#if (PHMASK >> 8) & 1
        for (int rep = 0; rep < REPG; ++rep) {
        { PH_BEGIN
            pg8::Gemm g{Y_, (const bf16_t*)(WB + WB_WBR), T, D, 512, 512, 512, (unsigned)T * 512u * 2u, (unsigned)D * 512u * 2u}; pg8::StaticOrder S; S.init(T, D, G, bid, 3);
            EpiMerge E{(const bf16_t*)SC_, (float*)(U_ + U_MG), (bf16_t*)(U_ + U_MGB)}; pg8::gemm_phase(lds, g, S, E, tid);
        }
        }
#endif
        } break;
        case 9: {
#if (PHMASK >> 9) & 1
        { PH_BEGIN
            pg8::Gemm g{(const bf16_t*)(U_ + U_MGB), (const bf16_t*)(WB + WB_WO), T, D, D, D, D, 0, 0}; pg8::StaticOrder S; S.init(T, D, G, bid, 1);
            EpiRes E{OUT, OUT, XB_, SS + (size_t)2 * T * 16, 1.0f}; pg8::gemm_phase(lds, g, S, E, tid);
        }
#endif
        } break;
        case 10: {
#if (PHMASK >> 10) & 1
        for (int rep = 0; rep < REPG; ++rep) {
        { PH_BEGIN
            pg8::Gemm g{XB_, (const bf16_t*)(WB + WB_W2A), T, 2 * FF, D, D, D, 0, 0}; pg8::StaticOrder S; S.init(T, 2 * FF, G, bid, 1);
            EpiFFNa E{(bf16_t*)U_, SS + (size_t)2 * T * 16}; pg8::gemm_phase(lds, g, S, E, tid);
        }
        }
#endif
        } break;
        case 11: {
#if (PHMASK >> 11) & 1
        { PH_BEGIN
            pg8::Gemm g{(const bf16_t*)U_, (const bf16_t*)(WB + WB_W2B), T, D, FF, FF, FF, 0, 0}; pg8::StaticOrder S; S.init(T, D, G, bid, 1);
            EpiRes E{OUT, OUT, XB_, SS + (size_t)0 * T * 16, 0.5f}; pg8::gemm_phase(lds, g, S, E, tid);
        }
#endif
        } break;
        default: break;
        }
        if (ph == 0) grid.sync();
        else grid_bar((unsigned*)(P.ws + WS_BAR), (unsigned)ph * gridDim.x);
    }
}

extern "C" void kernel_launch(void* const* d_in, const int* in_sizes, int n_in, void* d_out, int out_size, void* d_ws, size_t ws_size, hipStream_t stream) {
    static int grid_blocks = 0;
    if (!grid_blocks) {
        if (n_in != 33 || ws_size < WS_END) { fprintf(stderr, "kernel_launch: need 33 inputs and %zu bytes of workspace (got %d, %zu)\n", (size_t)WS_END, n_in, ws_size); grid_blocks = -1; return; }
        int dev = 0, cus = 0, per_cu = 0;
        hipGetDevice(&dev); hipDeviceGetAttribute(&cus, hipDeviceAttributeMultiprocessorCount, dev);
        if (hipFuncSetAttribute((const void*)mega, hipFuncAttributeMaxDynamicSharedMemorySize, LDS_BYTES) != hipSuccess) { fprintf(stderr, "kernel_launch: hipFuncSetAttribute failed\n"); grid_blocks = -1; return; }
        if (hipOccupancyMaxActiveBlocksPerMultiprocessor(&per_cu, (const void*)mega, 512, LDS_BYTES) != hipSuccess || per_cu < 1) { fprintf(stderr, "kernel_launch: occupancy query says %d\n", per_cu); per_cu = 1; }
        (void)hipGetLastError();
        grid_blocks = cus * per_cu;
    }
    if (grid_blocks < 0) return;
    if (hipMemsetAsync((char*)d_ws + WS_BAR, 0, 256, stream) != hipSuccess) { fprintf(stderr, "kernel_launch: memset failed\n"); return; }
    Params p{};
    for (int i = 0; i < 33; ++i) p.in[i] = (const float*)d_in[i];
    p.out = (float*)d_out; p.ws = (unsigned char*)d_ws;
    void* args[] = {&p};
    hipError_t e = hipLaunchCooperativeKernel((const void*)mega, dim3(grid_blocks), dim3(512), args, LDS_BYTES, stream);
    if (e != hipSuccess) fprintf(stderr, "cooperative launch failed: %s (grid %d)\n", hipGetErrorString(e), grid_blocks);
}
```

```cpp
#include <hip/hip_runtime.h>
#include <hip/hip_cooperative_groups.h>
#include <cstdio>
namespace cg = cooperative_groups;
#ifndef P4SUB
#define P4SUB 7
#endif
#ifndef REP5
#define REP5 1
#endif
#ifndef REP4
#define REP4 1
#endif
#ifndef REP6
#define REP6 1
#endif
#ifndef REP0
#define REP0 1
#endif
#ifndef REPG
#define REPG 1
#endif
#ifndef REPSYNC
#define REPSYNC 1
#endif
#ifndef PHMASK
#define PHMASK 0xFFFF
#endif

#define LAS __attribute__((address_space(3)))
typedef unsigned short bf16_t;
typedef short bf16x8 __attribute__((ext_vector_type(8)));
typedef float f32x4 __attribute__((ext_vector_type(4)));
typedef float f32x2 __attribute__((ext_vector_type(2)));
typedef unsigned u32x4 __attribute__((ext_vector_type(4)));
typedef unsigned u32x2 __attribute__((ext_vector_type(2)));

constexpr int T = 16384, D = 1024, FF = 2816, SEQ = 4096, NL = 4;
constexpr int LDS_BYTES = 135168;

constexpr size_t MB = 1024 * 1024;
constexpr size_t WS_MISC = 0;
constexpr size_t WS_SS = 1 * MB;
constexpr size_t WS_WB = 4 * MB;
constexpr size_t WB_W1A = 0;
constexpr size_t WB_W1B = WB_W1A + (size_t)5632 * 1024 * 2;
constexpr size_t WB_WIN = WB_W1B + (size_t)1024 * 2816 * 2;
constexpr size_t WB_WG = WB_WIN + (size_t)4096 * 1024 * 2;
constexpr size_t WB_WBR = WB_WG + (size_t)3072 * 1024 * 2;
constexpr size_t WB_WO = WB_WBR + (size_t)3 * 1024 * 512 * 2;
constexpr size_t WB_WKV = WB_WO + (size_t)1024 * 1024 * 2;
constexpr size_t WB_W2A = WB_WKV + (size_t)1024 * 1024 * 2;
constexpr size_t WB_W2B = WB_W2A + (size_t)5632 * 1024 * 2;
constexpr size_t WB_LW2 = WB_W2B + (size_t)1024 * 2816 * 2;
constexpr size_t WB_LA2 = WB_LW2 + 512 * 64 * 2;
constexpr size_t WB_LG2 = WB_LA2 + 512 * 64 * 2;
constexpr size_t WB_LV1 = WB_LG2 + 512 * 128 * 2;
constexpr size_t WB_LV2 = WB_LV1 + 32 * 512 * 2;
constexpr size_t WB_END = WB_LV2 + 512 * 32 * 2;
static_assert(WB_END <= 55 * MB, "weights region");
constexpr size_t WS_XB = WS_WB + 55 * MB;
constexpr size_t WS_VF = WS_XB + 32 * MB;
constexpr size_t WS_MEMN = WS_VF + 32 * MB;
constexpr size_t WS_KB = WS_MEMN + 2 * MB;
constexpr size_t WS_VT = WS_KB + 1 * MB;
constexpr size_t WS_GO = WS_VT + 1 * MB;
constexpr size_t WS_BON = WS_GO + 16 * MB;
constexpr size_t WS_Y = WS_BON + 1 * MB;
constexpr size_t WS_KVC = WS_Y + 48 * MB;
constexpr size_t WS_DEC = WS_KVC + 32 * MB;
constexpr size_t WS_SC = WS_DEC + 1 * MB;
constexpr size_t SC_WD = 0;
constexpr size_t SC_V = 32 * MB;
constexpr size_t SC_RKKB = 64 * MB;
constexpr size_t WS_U = WS_SC + 128 * MB;
constexpr size_t U_RWKV = 0;
constexpr size_t U_GLA = (size_t)T * 1792 * 2;
constexpr size_t U_XA = 2 * (size_t)T * 1792 * 2;
constexpr size_t U_YRAW = 0;
constexpr size_t U_SPT = 32 * MB;
constexpr size_t U_MG = 0;
constexpr size_t U_MGB = 64 * MB;
constexpr size_t WS_END = WS_U + 128 * MB;
static_assert(U_XA + (size_t)T * 512 * 2 <= 128 * MB, "U region");

typedef __bf16 bf16x2_t __attribute__((ext_vector_type(2)));
__device__ __forceinline__ unsigned cvt_pk_bf16(float lo, float hi) { const f32x2 v = {lo, hi}; const bf16x2_t r = __builtin_convertvector(v, bf16x2_t); return __builtin_bit_cast(unsigned, r); }
__device__ __forceinline__ bf16_t f2bf(float x) { return (bf16_t)(cvt_pk_bf16(x, 0.f) & 0xffffu); }
__device__ __forceinline__ float bf2f(bf16_t b) { return __uint_as_float(((unsigned)b) << 16); }
__device__ __forceinline__ float bflo(unsigned w) { return __uint_as_float(w << 16); }
__device__ __forceinline__ float bfhi(unsigned w) { return __uint_as_float(w & 0xffff0000u); }
__device__ __forceinline__ f32x4 ld_bf4(const bf16_t* p) { const u32x2 w = *(const u32x2*)p; return (f32x4){bflo(w.x), bfhi(w.x), bflo(w.y), bfhi(w.y)}; }
__device__ __forceinline__ void st_bf4(bf16_t* p, f32x4 v) { u32x2 w; w.x = cvt_pk_bf16(v[0], v[1]); w.y = cvt_pk_bf16(v[2], v[3]); *(u32x2*)p = w; }
__device__ __forceinline__ float sigmoidf_(float x) { return 1.0f / (1.0f + __expf(-x)); }
__device__ __forceinline__ float wave_sum(float v) { for (int o = 32; o >= 1; o >>= 1) v += __shfl_xor(v, o); return v; }
__device__ __forceinline__ f32x4 mfma16(bf16x8 a, bf16x8 b, f32x4 c) { return __builtin_amdgcn_mfma_f32_16x16x32_bf16(a, b, c, 0, 0, 0); }

__device__ __forceinline__ float row_rstd(const float* ssp, int row) {
    const f32x4* p = (const f32x4*)(ssp + (size_t)row * 16); const f32x4 a = p[0], b = p[1], c = p[2], d = p[3];
    const float t = (((a[0] + a[1]) + (a[2] + a[3])) + ((b[0] + b[1]) + (b[2] + b[3]))) + (((c[0] + c[1]) + (c[2] + c[3])) + ((d[0] + d[1]) + (d[2] + d[3])));
    return rsqrtf(t * (1.0f / 1024.0f) + 1e-6f);
}
namespace pg8 {
constexpr int BM = 256, BK = 64, HALF = 128, HTB = HALF * BK * 2, STAGE_BYTES = 8 * HTB, NXCD = 8, WGM = 8;
__device__ __forceinline__ int lds_byte(int r, int c) { const int st = (r >> 4) * 2 + (c >> 5), rr = r & 15, cc = c & 31, ob = rr * 64 + cc * 2; return st * 1024 + (ob ^ (((ob >> 9) & 1) << 5)); }
__device__ __forceinline__ void stage_rc(int b, int& R, int& C) { const int st = b / 1024, sb = b % 1024, swz = sb ^ (((sb >> 9) & 1) << 5); R = (st >> 1) * 16 + swz / 64; C = (st & 1) * 32 + (swz % 64) / 2; }
__device__ __forceinline__ int perm32(int rho) { const int n = rho >> 4, i = rho & 15; return 8 * (i >> 2) + 4 * n + (i & 3); }

struct Unit { int pm, pn, z; };
struct Gemm { const bf16_t* A; const bf16_t* Bt; int M, N, K, lda, ldb; unsigned zA, zB; };

struct StaticOrder {
    int nM, nN, nwg, G, c, nz;
    __device__ void init(int M, int N, int G_, int c_, int nz_) { nM = M / BM; nN = N / BM; nwg = nM * nN; G = G_; c = c_; nz = nz_; }
    __device__ bool next(int i, Unit& u) const {
        const int ti = i / nz; u.z = i - ti * nz;
        const long L = (long)ti * G + c; if (L >= nwg) return false;
        int wgid = (int)L; { const int q = nwg / NXCD, r = nwg % NXCD, xcd = wgid % NXCD, off = wgid / NXCD; wgid = (xcd < r ? xcd * (q + 1) : r * (q + 1) + (xcd - r) * q) + off; }
        const int nig = WGM * nN, gid = wgid / nig, fm = gid * WGM, gsz = (nM - fm) < WGM ? (nM - fm) : WGM;
        u.pm = fm + ((wgid % nig) % gsz); u.pn = (wgid % nig) / gsz; return true;
    }
};

template <class Epi>
__device__ __forceinline__ void gemm_phase(LAS unsigned char* lds, const Gemm g, const StaticOrder& S, const Epi& E, const int tid) {
    const int wid = __builtin_amdgcn_readfirstlane(tid >> 6), lane = tid & 63, wr = wid >> 2, wc = wid & 3, fr = lane & 15, fq = lane >> 4;
    const int K = g.K, nt = K / BK;
    unsigned voffA[2], voffB[2];
#pragma unroll
    for (int i = 0; i < 2; ++i) { int R, C; stage_rc(tid * 16 + i * 8192, R, C); const int Rb = Epi::PERM ? ((R & ~31) + perm32(R & 31)) : R;
        voffA[i] = (unsigned)(R * g.lda + C) * 2u; voffB[i] = (unsigned)(Rb * g.ldb + C) * 2u; }
    const unsigned kstep = (unsigned)(BK * 2);
    const unsigned hstepA = (unsigned)HALF * g.lda * 2u, hstepB = (unsigned)HALF * g.ldb * 2u;
    const unsigned tstepA = 2u * hstepA, tstepB = 2u * hstepB;
    const unsigned ldsw = (unsigned)wid * 1024u;
    const int aoff = lds_byte(wr * 64 + fr, fq * 8), boff = lds_byte(wc * 32 + fr, fq * 8);
    const char* const gA = (const char*)g.A; const char* const gB = (const char*)g.Bt;
#define PG8_SA(b, h) (((b) * 2 + (h)) * HTB)
#define PG8_SB(b, h) ((4 + (b) * 2 + (h)) * HTB)
#define PG8_STAGE(bufoff, gbase, soff, voff) do { _Pragma("unroll") for (int _i = 0; _i < 2; ++_i) \
        __builtin_amdgcn_global_load_lds((const unsigned*)(((gbase) + (size_t)(unsigned)(soff)) + (voff)[_i]), (LAS unsigned*)(lds + (bufoff) + ldsw + _i * 8192), 16, 0, 0); } while (0)
#define PG8_LDA(dst, b, h) do { _Pragma("unroll") for (int m = 0; m < 4; ++m) _Pragma("unroll") for (int k = 0; k < 2; ++k) dst[m][k] = *(const LAS bf16x8*)(lds + PG8_SA(b, h) + aoff + m * 2048 + k * 1024); } while (0)
#define PG8_LDB(dst, b, h) do { _Pragma("unroll") for (int n = 0; n < 2; ++n) _Pragma("unroll") for (int k = 0; k < 2; ++k) dst[n][k] = *(const LAS bf16x8*)(lds + PG8_SB(b, h) + boff + n * 2048 + k * 1024); } while (0)
#define PG8_MMA(ai, bj, At, Bt) do { __builtin_amdgcn_s_setprio(1); _Pragma("unroll") for (int m = 0; m < 4; ++m) _Pragma("unroll") for (int n = 0; n < 2; ++n) _Pragma("unroll") for (int k = 0; k < 2; ++k) \
        acc[ai][bj][m][n] = __builtin_amdgcn_mfma_f32_16x16x32_bf16(Bt[n][k], At[m][k], acc[ai][bj][m][n], 0, 0, 0); __builtin_amdgcn_s_setprio(0); } while (0)
#define PG8_WAIT_V(n) asm volatile("s_waitcnt vmcnt(" #n ")" ::: "memory")
#define PG8_WAIT_L(n) asm volatile("s_waitcnt lgkmcnt(" #n ")" ::: "memory")
#define PG8_BAR __builtin_amdgcn_s_barrier()
#define PG8_SCHED __builtin_amdgcn_sched_barrier(0)
    Unit cur, nxt; int ui = 0;
    if (!S.next(0, cur)) return;
    f32x4 acc[2][2][4][2];
#pragma unroll
    for (int a = 0; a < 2; ++a)
#pragma unroll
        for (int b = 0; b < 2; ++b)
#pragma unroll
            for (int m = 0; m < 4; ++m)
#pragma unroll
                for (int n = 0; n < 2; ++n) acc[a][b][m][n] = (f32x4){0.f, 0.f, 0.f, 0.f};
    bf16x8 At[4][2], B0[2][2], B1[2][2];
    unsigned cA = (unsigned)cur.z * g.zA + (unsigned)cur.pm * tstepA, cB = (unsigned)cur.z * g.zB + (unsigned)cur.pn * tstepB;
    PG8_STAGE(PG8_SB(0, 0), gB, cB, voffB); PG8_STAGE(PG8_SA(0, 0), gA, cA, voffA); PG8_STAGE(PG8_SB(0, 1), gB, cB + hstepB, voffB); PG8_STAGE(PG8_SA(0, 1), gA, cA + hstepA, voffA);
    if (wr == 1) PG8_BAR;
    PG8_WAIT_V(4); PG8_BAR;
    PG8_STAGE(PG8_SB(1, 0), gB, cB + kstep, voffB); PG8_STAGE(PG8_SA(1, 0), gA, cA + kstep, voffA); PG8_STAGE(PG8_SB(1, 1), gB, cB + hstepB + kstep, voffB);
    PG8_WAIT_V(6); PG8_BAR;
    for (;;) {
        const bool has_next = S.next(ui + 1, nxt);
        const unsigned nA = has_next ? (unsigned)nxt.z * g.zA + (unsigned)nxt.pm * tstepA : cA, nB = has_next ? (unsigned)nxt.z * g.zB + (unsigned)nxt.pn * tstepB : cB;
        for (int t = 0; t < nt; t += 2) {
            const bool last = (t == nt - 2);
            const unsigned a1 = cA + (unsigned)(t + 1) * kstep;
            const unsigned a2 = last ? nA : cA + (unsigned)(t + 2) * kstep, b2 = last ? nB : cB + (unsigned)(t + 2) * kstep;
            const unsigned a3 = a2 + kstep, b3 = b2 + kstep;
            PG8_LDB(B0, 0, 0); PG8_SCHED; PG8_LDA(At, 0, 0); PG8_STAGE(PG8_SA(1, 1), gA, a1 + hstepA, voffA);
            PG8_WAIT_L(8); PG8_BAR; PG8_WAIT_L(0); PG8_MMA(0, 0, At, B0); PG8_BAR; PG8_SCHED;
            PG8_LDB(B1, 0, 1); PG8_STAGE(PG8_SB(0, 0), gB, b2, voffB);
            PG8_BAR; PG8_WAIT_L(0); PG8_MMA(0, 1, At, B1); PG8_BAR;
            PG8_LDA(At, 0, 1); PG8_STAGE(PG8_SA(0, 0), gA, a2, voffA);
            PG8_BAR; PG8_WAIT_L(0); PG8_MMA(1, 0, At, B0); PG8_BAR; PG8_SCHED;
            PG8_STAGE(PG8_SB(0, 1), gB, b2 + hstepB, voffB);
            PG8_WAIT_V(6); PG8_BAR; PG8_MMA(1, 1, At, B1); PG8_BAR;
            PG8_LDB(B0, 1, 0); PG8_SCHED; PG8_LDA(At, 1, 0); PG8_STAGE(PG8_SA(0, 1), gA, a2 + hstepA, voffA);
            PG8_WAIT_L(8); PG8_BAR; PG8_WAIT_L(0); PG8_MMA(0, 0, At, B0); PG8_BAR; PG8_SCHED;
            PG8_LDB(B1, 1, 1); PG8_STAGE(PG8_SB(1, 0), gB, b3, voffB);
            PG8_BAR; PG8_WAIT_L(0); PG8_MMA(0, 1, At, B1); PG8_BAR;
            PG8_LDA(At, 1, 1); PG8_STAGE(PG8_SA(1, 0), gA, a3, voffA);
            PG8_BAR; PG8_WAIT_L(0); PG8_MMA(1, 0, At, B0); PG8_BAR; PG8_SCHED;
            PG8_STAGE(PG8_SB(1, 1), gB, b3 + hstepB, voffB);
            PG8_WAIT_V(6); PG8_BAR; PG8_MMA(1, 1, At, B1); PG8_BAR;
        }
        E(acc, cur, wr, wc, fr, fq);
        if (!has_next) break;
#pragma unroll
        for (int a = 0; a < 2; ++a)
#pragma unroll
            for (int b = 0; b < 2; ++b)
#pragma unroll
                for (int m = 0; m < 4; ++m)
#pragma unroll
                    for (int n = 0; n < 2; ++n) acc[a][b][m][n] = (f32x4){0.f, 0.f, 0.f, 0.f};
        cur = nxt; cA = nA; cB = nB; ++ui;
    }
    PG8_WAIT_V(0);
    if (wr == 0) PG8_BAR;
    PG8_BAR;
#undef PG8_SA
#undef PG8_SB
#undef PG8_STAGE
#undef PG8_LDA
#undef PG8_LDB
#undef PG8_MMA
#undef PG8_WAIT_V
#undef PG8_WAIT_L
#undef PG8_BAR
#undef PG8_SCHED
}
}
using pg8::Unit;
typedef f32x4 Acc[2][2][4][2];

struct EpiFFNa { static constexpr bool PERM = false; bf16_t* H; const float* ss;
    __device__ __forceinline__ void operator()(const Acc& acc, const Unit& u, int wr, int wc, int fr, int fq) const {
        const int row0 = u.pm * 256 + wr * 64 + fr, hc0 = u.pn * 128 + wc * 16 + 4 * fq;
#pragma unroll
        for (int ai = 0; ai < 2; ++ai)
#pragma unroll
            for (int m = 0; m < 4; ++m) { const int row = row0 + ai * 128 + m * 16; const float rs = row_rstd(ss, row);
#pragma unroll
                for (int bj = 0; bj < 2; ++bj) { const f32x4 gt = acc[ai][bj][m][0] * rs, up = acc[ai][bj][m][1] * rs; f32x4 h;
#pragma unroll
                    for (int j = 0; j < 4; ++j) h[j] = gt[j] * sigmoidf_(gt[j]) * up[j];
                    st_bf4(H + (size_t)row * FF + hc0 + bj * 64, h); } }
    }
};
struct EpiRes { static constexpr bool PERM = false; const float* xin; float* xout; bf16_t* xb; float* ss_out; float scale;
    __device__ __forceinline__ void operator()(const Acc& acc, const Unit& u, int wr, int wc, int fr, int fq) const {
        const int row0 = u.pm * 256 + wr * 64 + fr, col0 = u.pn * 256 + wc * 32 + 4 * fq;
#pragma unroll
        for (int ai = 0; ai < 2; ++ai)
#pragma unroll
            for (int m = 0; m < 4; ++m) { const int row = row0 + ai * 128 + m * 16; float q = 0.f;
#pragma unroll
                for (int bj = 0; bj < 2; ++bj)
#pragma unroll
                    for (int n = 0; n < 2; ++n) { const size_t o = (size_t)row * D + col0 + bj * 128 + n * 16; const f32x4 v = *(const f32x4*)(xin + o) + acc[ai][bj][m][n] * scale;
                        *(f32x4*)(xout + o) = v; st_bf4(xb + o, v); q += (v[0] * v[0] + v[1] * v[1]) + (v[2] * v[2] + v[3] * v[3]); }
                q += __shfl_xor(q, 16); q += __shfl_xor(q, 32);
                if (fq == 0) ss_out[(size_t)row * 16 + u.pn * 4 + wc] = q; }
    }
};
struct EpiU { static constexpr bool PERM = true; bf16_t* Ubase; const float* ss;
    __device__ __forceinline__ void operator()(const Acc& acc, const Unit& u, int wr, int wc, int fr, int fq) const {
        bf16_t* base; int ld, c0;
        if (u.pn < 7) { base = (bf16_t*)((char*)Ubase + U_RWKV); ld = 1792; c0 = u.pn * 256; }
        else if (u.pn < 14) { base = (bf16_t*)((char*)Ubase + U_GLA); ld = 1792; c0 = (u.pn - 7) * 256; }
        else { base = (bf16_t*)((char*)Ubase + U_XA); ld = 512; c0 = (u.pn - 14) * 256; }
        const int row0 = u.pm * 256 + wr * 64 + fr; c0 += wc * 32 + 8 * fq;
#pragma unroll
        for (int ai = 0; ai < 2; ++ai)
#pragma unroll
            for (int m = 0; m < 4; ++m) { const int row = row0 + ai * 128 + m * 16; const float rs = row_rstd(ss, row);
#pragma unroll
                for (int bj = 0; bj < 2; ++bj) { const f32x4 v0 = acc[ai][bj][m][0] * rs, v1 = acc[ai][bj][m][1] * rs; u32x4 w;
                    w.x = cvt_pk_bf16(v0[0], v0[1]); w.y = cvt_pk_bf16(v0[2], v0[3]); w.z = cvt_pk_bf16(v1[0], v1[1]); w.w = cvt_pk_bf16(v1[2], v1[3]);
                    *(u32x4*)(base + (size_t)row * ld + c0 + bj * 128) = w; } }
    }
};
struct EpiGate { static constexpr bool PERM = true; bf16_t* Gt; const float* ss;
    __device__ __forceinline__ void operator()(const Acc& acc, const Unit& u, int wr, int wc, int fr, int fq) const {
        const int row0 = u.pm * 256 + wr * 64 + fr, c0 = u.pn * 256 + wc * 32 + 8 * fq;
#pragma unroll
        for (int ai = 0; ai < 2; ++ai)
#pragma unroll
            for (int m = 0; m < 4; ++m) { const int row = row0 + ai * 128 + m * 16; const float rs = row_rstd(ss, row);
#pragma unroll
                for (int bj = 0; bj < 2; ++bj) { f32x4 v0 = acc[ai][bj][m][0] * rs, v1 = acc[ai][bj][m][1] * rs;
#pragma unroll
                    for (int j = 0; j < 4; ++j) { v0[j] = sigmoidf_(v0[j]); v1[j] = sigmoidf_(v1[j]); }
                    u32x4 w; w.x = cvt_pk_bf16(v0[0], v0[1]); w.y = cvt_pk_bf16(v0[2], v0[3]); w.z = cvt_pk_bf16(v1[0], v1[1]); w.w = cvt_pk_bf16(v1[2], v1[3]);
                    *(u32x4*)(Gt + (size_t)row * 3072 + c0 + bj * 128) = w; } }
    }
};
struct EpiMerge { static constexpr bool PERM = false; const bf16_t* Gt; float* Mg; bf16_t* Mb;
    __device__ __forceinline__ void operator()(const Acc& acc, const Unit& u, int wr, int wc, int fr, int fq) const {
        const int row0 = u.pm * 256 + wr * 64 + fr, col0 = u.pn * 256 + wc * 32 + 4 * fq;
#pragma unroll
        for (int ai = 0; ai < 2; ++ai)
#pragma unroll
            for (int m = 0; m < 4; ++m) { const int row = row0 + ai * 128 + m * 16;
#pragma unroll
                for (int bj = 0; bj < 2; ++bj)
#pragma unroll
                    for (int n = 0; n < 2; ++n) { const int col = col0 + bj * 128 + n * 16; const size_t o = (size_t)row * D + col;
                        f32x4 v = acc[ai][bj][m][n] * ld_bf4(Gt + (size_t)row * 3072 + u.z * 1024 + col);
                        if (u.z > 0) v += *(const f32x4*)(Mg + o);
                        if (u.z < 2) *(f32x4*)(Mg + o) = v; else st_bf4(Mb + o, v); } }
    }
};
struct EpiKV { static constexpr bool PERM = false; bf16_t* Kb; bf16_t* Vt; const float* rstd;
    __device__ __forceinline__ void operator()(const Acc& acc, const Unit& u, int wr, int wc, int fr, int fq) const {
        const int row0 = u.pm * 256 + wr * 64 + fr, col0 = u.pn * 256 + wc * 32 + 4 * fq;
#pragma unroll
        for (int ai = 0; ai < 2; ++ai)
#pragma unroll
            for (int m = 0; m < 4; ++m) { const int row = row0 + ai * 128 + m * 16; const float rs = rstd[row];
#pragma unroll
                for (int bj = 0; bj < 2; ++bj)
#pragma unroll
                    for (int n = 0; n < 2; ++n) { const int col = col0 + bj * 128 + n * 16; const f32x4 v = acc[ai][bj][m][n] * rs;
                        if (col < 512) st_bf4(Kb + (size_t)row * 512 + col, v);
                        else {
#pragma unroll
                            for (int j = 0; j < 4; ++j) Vt[((size_t)(row >> 8) * 512 + (col - 512 + j)) * 256 + (row & 255)] = f2bf(v[j]); } } }
    }
};

template <int MAP> __device__ __forceinline__ int colmap(int n) {
    if (MAP == 1) { const int g = n >> 5, i = n & 31; return i < 16 ? 16 * g + i : FF + 16 * g + (i - 16); }
    if (MAP == 2) { if (n < 3344) return n; if (n < 3584) return -1; return n - 240; }
    return n;
}
template <int MAP>
__device__ __forceinline__ void convT(LAS unsigned char* lds, const float* src, int ld, int coff, const float* g, bf16_t* dst, int K, int Kd, int Nd, int G, int bid, int tid) {
    const int nkt = (K + 63) >> 6, nnt = (Nd + 63) >> 6, ntile = nkt * nnt;
    LAS bf16_t* tile = (LAS bf16_t*)lds;
    for (int t = bid; t < ntile; t += G) {
        const int kt = t % nkt, ntl = t / nkt, k0 = kt * 64, n0 = ntl * 64;
        { const int nl = tid & 63, kl0 = tid >> 6, n = n0 + nl; const int c = (n < Nd) ? colmap<MAP>(n) : -1;
#pragma unroll
          for (int i = 0; i < 8; ++i) { const int kl = kl0 + 8 * i, k = k0 + kl; float v = 0.f;
              if (c >= 0 && k < K) { v = src[(size_t)k * ld + coff + c]; if (g) v *= g[k]; }
              tile[nl * 72 + kl] = f2bf(v); } }
        __syncthreads();
        { const int nl = tid >> 3, kc = (tid & 7) * 8, n = n0 + nl, k = k0 + kc;
          if (n < Nd && k < Kd) *(u32x4*)(dst + (size_t)n * Kd + k) = *(LAS u32x4*)(tile + nl * 72 + kc); }
        __syncthreads();
    }
}

template <int MAP>
__device__ __forceinline__ void convT_w(const float* src, int ld, int coff, const float* g, bf16_t* dst, int K, int Kd, int Nd, int wslot, int nslots, int lane) {
    const int nkt = K >> 4, nnt = (Nd + 255) >> 8, ntile = nkt * nnt;
    for (int t = wslot; t < ntile; t += nslots) {
        const int kt = t % nkt, ntl = t / nkt, k0 = kt * 16, n = ntl * 256 + lane * 4; const int c = (n < Nd) ? colmap<MAP>(n) : -1;
        const float* sp = src + (size_t)k0 * ld + coff + (c >= 0 ? c : 0);
        f32x4 v[16];
#pragma unroll
        for (int kk = 0; kk < 16; ++kk) { v[kk] = *(const f32x4*)(sp + (size_t)kk * ld); if (g) v[kk] *= g[k0 + kk]; if (c < 0) v[kk] = (f32x4){0.f, 0.f, 0.f, 0.f}; }
        if (n < Nd) {
#pragma unroll
            for (int j = 0; j < 4; ++j) { u32x4 lo, hi;
                lo.x = cvt_pk_bf16(v[0][j], v[1][j]); lo.y = cvt_pk_bf16(v[2][j], v[3][j]); lo.z = cvt_pk_bf16(v[4][j], v[5][j]); lo.w = cvt_pk_bf16(v[6][j], v[7][j]);
                hi.x = cvt_pk_bf16(v[8][j], v[9][j]); hi.y = cvt_pk_bf16(v[10][j], v[11][j]); hi.z = cvt_pk_bf16(v[12][j], v[13][j]); hi.w = cvt_pk_bf16(v[14][j], v[15][j]);
                bf16_t* dp = dst + (size_t)(n + j) * Kd + k0; *(u32x4*)dp = lo; *(u32x4*)(dp + 8) = hi; }
        }
    }
}

template <int K>
__device__ __forceinline__ void wave_gemm(f32x4 (&acc)[4][4], LAS const unsigned char* A, int sA, const bf16_t* Bt, int fr, int fq) {
#pragma unroll
    for (int m = 0; m < 4; ++m)
#pragma unroll
        for (int n = 0; n < 4; ++n) acc[m][n] = (f32x4){0.f, 0.f, 0.f, 0.f};
#pragma unroll
    for (int ks = 0; ks < K / 32; ++ks) { bf16x8 a[4], b[4];
#pragma unroll
        for (int m = 0; m < 4; ++m) a[m] = *(LAS const bf16x8*)(A + (16 * m + fr) * sA + (ks * 32 + fq * 8) * 2);
#pragma unroll
        for (int n = 0; n < 4; ++n) b[n] = *(const bf16x8*)(Bt + (size_t)(16 * n + fr) * K + ks * 32 + fq * 8);
#pragma unroll
        for (int m = 0; m < 4; ++m)
#pragma unroll
            for (int n = 0; n < 4; ++n) acc[m][n] = mfma16(b[n], a[m], acc[m][n]); }
}

template <int K>
__device__ __forceinline__ void row_gemm(f32x4 (&acc)[4], LAS const unsigned char* Arow, const bf16_t* Bt, int fr, int fq) {
#pragma unroll
    for (int n = 0; n < 4; ++n) acc[n] = (f32x4){0.f, 0.f, 0.f, 0.f};
#pragma unroll
    for (int ks = 0; ks < K / 32; ++ks) { const bf16x8 a = *(LAS const bf16x8*)(Arow + (ks * 32 + fq * 8) * 2);
#pragma unroll
        for (int n = 0; n < 4; ++n) { const bf16x8 b = *(const bf16x8*)(Bt + (size_t)(16 * n + fr) * K + ks * 32 + fq * 8); acc[n] = mfma16(b, a, acc[n]); } }
}

struct PrepArgs { const bf16_t* U; const float *mu, *w0, *a0, *kk_, *ka, *rk, *v0; const bf16_t *w2t, *a2t, *g2t, *v1t, *v2t; float* vfirst; float* Wd; float* V; bf16_t* RKKB; bf16_t* Go; float* Bon; int layer; };

__device__ __forceinline__ f32x4 shifted4(const bf16_t* Ut, bool has_prev, int c, const float* mu) {
    const f32x4 u = ld_bf4(Ut + c); f32x4 p = (f32x4){0.f, 0.f, 0.f, 0.f}; if (has_prev) p = ld_bf4(Ut - 1792 + c);
    const f32x4 m = *(const f32x4*)(mu + c); return u + m * (p - u);
}

__device__ __forceinline__ void rwkv_prep_tile(LAS unsigned char* lds, const PrepArgs& P, int tt, int tid) {
    constexpr int SW = 144, SG = 272, SV = 1040, SVV = 80;
    LAS unsigned char* LAw = lds; LAS unsigned char* LAa = lds + 9216; LAS unsigned char* LAg = lds + 18432; LAS unsigned char* LAv = lds + 35840; LAS unsigned char* LAvv = lds + 102400;
    const int t0 = tt * 64; const int s0 = t0 & (SEQ - 1);
    const int lane = tid & 63, wave = __builtin_amdgcn_readfirstlane(tid >> 6), fr = lane & 15, fq = lane >> 4;
#pragma unroll 2
    for (int e = 0; e < 4; ++e) { const int idx = tid + 512 * e, i = idx >> 5, c = (idx & 31) * 8; const bf16_t* Ut = P.U + (size_t)(t0 + i) * 1792; const bool hp = s0 + i > 0;
        f32x4 x0 = shifted4(Ut, hp, 1536 + c, P.mu), x1 = shifted4(Ut, hp, 1536 + c + 4, P.mu);
        if (c < 64) {
#pragma unroll
            for (int q = 0; q < 4; ++q) { const float ea = __expf(2.f * x0[q]), eb = __expf(2.f * x1[q]); x0[q] = 1.f - 2.f / (ea + 1.f); x1[q] = 1.f - 2.f / (eb + 1.f); } }
        else if (c >= 128) {
#pragma unroll
            for (int q = 0; q < 4; ++q) { x0[q] = sigmoidf_(x0[q]); x1[q] = sigmoidf_(x1[q]); } }
        u32x4 o; o.x = cvt_pk_bf16(x0[0], x0[1]); o.y = cvt_pk_bf16(x0[2], x0[3]); o.z = cvt_pk_bf16(x1[0], x1[1]); o.w = cvt_pk_bf16(x1[2], x1[3]);
        LAS unsigned char* dstp = (c < 64) ? (LAw + i * SW + c * 2) : (c < 128) ? (LAa + i * SW + (c - 64) * 2) : (LAg + i * SG + (c - 128) * 2);
        *(LAS u32x4*)dstp = o; }
    if (P.layer > 0) {
#pragma unroll 2
        for (int e = 0; e < 8; ++e) { const int idx = tid + 512 * e, i = idx >> 6, c = (idx & 63) * 8; const bf16_t* Ut = P.U + (size_t)(t0 + i) * 1792; const bool hp = s0 + i > 0;
            const f32x4 x0 = shifted4(Ut, hp, 1024 + c, P.mu), x1 = shifted4(Ut, hp, 1024 + c + 4, P.mu);
            u32x4 o; o.x = cvt_pk_bf16(x0[0], x0[1]); o.y = cvt_pk_bf16(x0[2], x0[3]); o.z = cvt_pk_bf16(x1[0], x1[1]); o.w = cvt_pk_bf16(x1[2], x1[3]);
            *(LAS u32x4*)(LAv + i * SV + c * 2) = o; }
    }
    __syncthreads();
    if (P.layer > 0) {
        const int mt = wave >> 1, nt = wave & 1; f32x4 acc = (f32x4){0.f, 0.f, 0.f, 0.f};
#pragma unroll 4
        for (int ks = 0; ks < 16; ++ks) { const bf16x8 a = *(LAS const bf16x8*)(LAv + (16 * mt + fr) * SV + (ks * 32 + fq * 8) * 2);
            const bf16x8 b = *(const bf16x8*)(P.v1t + (size_t)(16 * nt + fr) * 512 + ks * 32 + fq * 8); acc = mfma16(b, a, acc); }
        u32x2 w; w.x = cvt_pk_bf16(acc[0], acc[1]); w.y = cvt_pk_bf16(acc[2], acc[3]); *(LAS u32x2*)(LAvv + (16 * mt + fr) * SVV + (16 * nt + 4 * fq) * 2) = w;
    }
    __syncthreads();
    const int h = wave, cb = 64 * h; const int b_ = t0 >> 12, p = b_ * 8 + h;
#pragma unroll 1
    for (int m = 0; m < 4; ++m) {
        const int i = 16 * m + fr; const bf16_t* Ut = P.U + (size_t)(t0 + i) * 1792; const bool hp = (s0 + i) > 0;
        int fq4 = 4 * fq; asm volatile("" : "+v"(fq4));
        f32x4 aa[4], acc[4];
        row_gemm<64>(aa, LAa + i * SW, P.a2t + (size_t)cb * 64, fr, fq);
#pragma unroll
        for (int n = 0; n < 4; ++n) { const f32x4 a0v = *(const f32x4*)(P.a0 + cb + 16 * n + fq4);
#pragma unroll
            for (int j = 0; j < 4; ++j) aa[n][j] = sigmoidf_(aa[n][j] + a0v[j]); }
        row_gemm<64>(acc, LAw + i * SW, P.w2t + (size_t)cb * 64, fr, fq);
#pragma unroll
        for (int n = 0; n < 4; ++n) { const f32x4 w0v = *(const f32x4*)(P.w0 + cb + 16 * n + fq4); f32x4 d;
#pragma unroll
            for (int j = 0; j < 4; ++j) d[j] = __expf(-0.6065306597f * sigmoidf_(acc[n][j] + w0v[j]));
            *(f32x4*)(P.Wd + ((size_t)p * SEQ + s0 + i) * 64 + 16 * n + fq4) = d; }
        row_gemm<128>(acc, LAg + i * SG, P.g2t + (size_t)cb * 128, fr, fq);
#pragma unroll
        for (int n = 0; n < 4; ++n) st_bf4(P.Go + (size_t)(t0 + i) * 512 + cb + 16 * n + fq4, acc[n]);
        asm volatile("" ::: "memory");
        if (P.layer > 0) row_gemm<32>(acc, LAvv + i * SVV, P.v2t + (size_t)cb * 32, fr, fq);
        float bon = 0.f, nk = 0.f; f32x4 kv[4], rv[4];
#pragma unroll
        for (int n = 0; n < 4; ++n) { const int c = cb + 16 * n + fq4;
            f32x4 v = shifted4(Ut, hp, 1024 + c, P.mu);
            if (P.layer > 0) { const f32x4 vf = *(const f32x4*)(P.vfirst + (size_t)(t0 + i) * 512 + c); const f32x4 v0v = *(const f32x4*)(P.v0 + c);
#pragma unroll
                for (int j = 0; j < 4; ++j) v[j] = v[j] + (vf[j] - v[j]) * sigmoidf_(v0v[j] + acc[n][j]); }
            else *(f32x4*)(P.vfirst + (size_t)(t0 + i) * 512 + c) = v;
            *(f32x4*)(P.V + ((size_t)p * SEQ + s0 + i) * 64 + 16 * n + fq4) = v;
            kv[n] = shifted4(Ut, hp, 512 + c, P.mu); rv[n] = shifted4(Ut, hp, c, P.mu);
            const f32x4 kkw = *(const f32x4*)(P.kk_ + c);
#pragma unroll
            for (int j = 0; j < 4; ++j) { const float x = kv[n][j] * kkw[j]; nk += x * x; } }
        nk += __shfl_xor(nk, 16); nk += __shfl_xor(nk, 32);
        const float inv = 1.0f / fmaxf(sqrtf(nk), 1e-12f);
        bf16_t* O = P.RKKB + ((size_t)p * SEQ + s0 + i) * 256;
#pragma unroll
        for (int n = 0; n < 4; ++n) { const int c = cb + 16 * n + fq4; const f32x4 kkw = *(const f32x4*)(P.kk_ + c), kaw = *(const f32x4*)(P.ka + c), rkw = *(const f32x4*)(P.rk + c);
            f32x4 kk, kh, bb;
#pragma unroll
            for (int j = 0; j < 4; ++j) { const float a = aa[n][j]; kk[j] = kv[n][j] * kkw[j] * inv; kh[j] = kv[n][j] * (1.f + (a - 1.f) * kaw[j]); bb[j] = kk[j] * a; bon += rv[n][j] * kh[j] * rkw[j]; }
            const int cc = 16 * n + fq4; st_bf4(O + cc, rv[n]); st_bf4(O + 64 + cc, kh); st_bf4(O + 128 + cc, kk); st_bf4(O + 192 + cc, bb); }
        bon += __shfl_xor(bon, 16); bon += __shfl_xor(bon, 32);
        if (fq == 0) P.Bon[(size_t)(t0 + i) * 8 + h] = bon;
        asm volatile("" ::: "memory");
    }
    __syncthreads();
}

constexpr int SCAN_CH = 32, SCAN_STEP_B = 1312, SCAN_SLOT_B = SCAN_CH * SCAN_STEP_B;
template <int CTRL> __device__ __forceinline__ float dpp_f(float v) { return __int_as_float(__builtin_amdgcn_update_dpp(0, __float_as_int(v), CTRL, 0xf, 0xf, true)); }
__device__ __forceinline__ float row16_sum(float v) { v += dpp_f<0xB1>(v); v += dpp_f<0x4E>(v); v += dpp_f<0x141>(v); v += dpp_f<0x140>(v); return v; }

__device__ __forceinline__ void scan_load_chunk(LAS unsigned char* slot, const float* Wd, const float* V, const bf16_t* RKKB, int p, int rg, int s0, int ltid, int nthr) {
    for (int idx = ltid; idx < 1600; idx += nthr) {
        if (idx < 512) { const int st = idx >> 4, part = idx & 15; *(LAS f32x4*)(slot + st * SCAN_STEP_B + part * 16) = *(const f32x4*)(Wd + ((size_t)p * SEQ + s0 + st) * 64 + part * 4); }
        else if (idx < 1536) { const int k = idx - 512, st = k >> 5, rem = k & 31, q = rem >> 3, part = rem & 7;
            const u32x4 w = *(const u32x4*)(RKKB + (((size_t)p * SEQ + s0 + st) * 4 + q) * 64 + part * 8);
            const int Q = (q == 0) ? 4 : (q == 1) ? 2 : (q == 2) ? 3 : 1;
            LAS f32x4* d = (LAS f32x4*)(slot + st * SCAN_STEP_B + Q * 256 + part * 32);
            d[0] = (f32x4){bflo(w.x), bfhi(w.x), bflo(w.y), bfhi(w.y)}; d[1] = (f32x4){bflo(w.z), bfhi(w.z), bflo(w.w), bfhi(w.w)}; }
        else { const int k = idx - 1536, st = k >> 1, hf = k & 1; *(LAS f32x4*)(slot + st * SCAN_STEP_B + 1280 + hf * 16) = *(const f32x4*)(V + ((size_t)p * SEQ + s0 + st) * 64 + rg * 8 + hf * 4); }
    }
}

__device__ __forceinline__ void rwkv_scan_unit(LAS unsigned char* lds, const float* Wd, const float* V, const bf16_t* RKKB, float* Yraw, int p, int rg, int tid) {
    const int lane = tid & 63, wave = __builtin_amdgcn_readfirstlane(tid >> 6);
    constexpr int NCH = SEQ / SCAN_CH;
    scan_load_chunk(lds, Wd, V, RKKB, p, rg, 0, tid, 512);
    scan_load_chunk(lds + SCAN_SLOT_B, Wd, V, RKKB, p, rg, SCAN_CH, tid, 512);
    __syncthreads();
    f32x4 S = (f32x4){0.f, 0.f, 0.f, 0.f};
    const int kq = lane & 15, rl = wave * 4 + (lane >> 4);
    for (int c = 0; c < NCH; ++c) {
        if (wave >= 2) { if (c + 2 < NCH) scan_load_chunk(lds + ((c + 2) % 3) * SCAN_SLOT_B, Wd, V, RKKB, p, rg, (c + 2) * SCAN_CH, tid - 128, 384); }
        else {
            LAS const unsigned char* sl = lds + (c % 3) * SCAN_SLOT_B + kq * 16;
            LAS const unsigned char* vl = lds + (c % 3) * SCAN_SLOT_B + 1280 + rl * 4;
            float* yo = Yraw + ((size_t)p * SEQ + c * SCAN_CH + kq) * 64 + rg * 8 + rl;
            f32x4 w = *(LAS const f32x4*)(sl), b = *(LAS const f32x4*)(sl + 256), k = *(LAS const f32x4*)(sl + 512), kk = *(LAS const f32x4*)(sl + 768), r = *(LAS const f32x4*)(sl + 1024);
            float v = *(LAS const float*)(vl); float ykeep = 0.f;
#pragma unroll
            for (int st = 0; st < SCAN_CH; ++st) {
                f32x4 wn = w, bn = b, kn = k, kkn = kk, rn = r; float vn = v;
                if (st + 1 < SCAN_CH) { const int o = (st + 1) * SCAN_STEP_B;
                    wn = *(LAS const f32x4*)(sl + o); bn = *(LAS const f32x4*)(sl + o + 256); kn = *(LAS const f32x4*)(sl + o + 512); kkn = *(LAS const f32x4*)(sl + o + 768); rn = *(LAS const f32x4*)(sl + o + 1024);
                    vn = *(LAS const float*)(vl + o); }
                float sa = (S[0] * kk[0] + S[1] * kk[1]) + (S[2] * kk[2] + S[3] * kk[3]);
                const f32x4 kvt = k * v;
                sa = -row16_sum(sa);
                S = S * w + (b * sa + kvt);
                float y = (S[0] * r[0] + S[1] * r[1]) + (S[2] * r[2] + S[3] * r[3]);
                y = row16_sum(y);
                ykeep = (kq == (st & 15)) ? y : ykeep;
                if ((st & 15) == 15) yo[(size_t)(st - 15) * 64] = ykeep;
                w = wn; b = bn; k = kn; kk = kkn; r = rn; v = vn;
            }
        }
        __syncthreads();
    }
}

struct GlaArgs { const bf16_t* Ug; const float *conv, *aup, *abias, *gnorm; float* kvcT; float* dec; bf16_t* spT; bf16_t* Yg; };
constexpr int GL_GC = 0;
constexpr int GL_T0 = 16640;
constexpr int GL_VT = GL_T0 + 4 * 9216;
constexpr int GL_AL = GL_VT + 18432;
constexpr int GL_RS = GL_AL + 9216;

__device__ __forceinline__ void gla_conv8(f32x4 (&out)[8], const bf16_t* Ug, const float* conv, int t0, int s0, int i0, int c0) {
    f32x4 w[4];
#pragma unroll
    for (int j = 0; j < 4; ++j) w[j] = *(const f32x4*)(conv + j * 1024 + c0);
#pragma unroll
    for (int e = 0; e < 8; ++e) { const int i = i0 + 8 * e; f32x4 a = (f32x4){0.f, 0.f, 0.f, 0.f};
#pragma unroll
        for (int j = 0; j < 4; ++j) { const int ds = 3 - j; if (s0 + i - ds >= 0) a += w[j] * ld_bf4(Ug + (size_t)(t0 + i - ds) * 1792 + c0); }
#pragma unroll
        for (int q = 0; q < 4; ++q) a[q] = a[q] * sigmoidf_(a[q]);
        out[e] = a; }
}
__device__ __forceinline__ void gla_gcum(LAS unsigned char* lds, const GlaArgs& A, int t0, int h, int tid) {
    LAS float* GC = (LAS float*)(lds + GL_GC);
    { const int d = tid & 63, i0 = tid >> 6; float au[16]; const float ab = A.abias[h * 64 + d];
#pragma unroll
      for (int j = 0; j < 16; ++j) au[j] = A.aup[j * 256 + h * 64 + d];
#pragma unroll
      for (int e = 0; e < 8; ++e) { const int i = i0 + 8 * e; const u32x4* ap = (const u32x4*)(A.Ug + (size_t)(t0 + i) * 1792 + 1024); const u32x4 a0 = ap[0], a1 = ap[1];
          float x = ab;
          x += bflo(a0.x) * au[0] + bfhi(a0.x) * au[1] + bflo(a0.y) * au[2] + bfhi(a0.y) * au[3] + bflo(a0.z) * au[4] + bfhi(a0.z) * au[5] + bflo(a0.w) * au[6] + bfhi(a0.w) * au[7];
          x += bflo(a1.x) * au[8] + bfhi(a1.x) * au[9] + bflo(a1.y) * au[10] + bfhi(a1.y) * au[11] + bflo(a1.z) * au[12] + bfhi(a1.z) * au[13] + bflo(a1.w) * au[14] + bfhi(a1.w) * au[15];
          const float ls = fminf(x, 0.f) - __logf(1.f + __expf(-fabsf(x)));
          GC[i * 65 + d] = ls * (1.0f / 16.0f); } }
    __syncthreads();
    { const int lane = tid & 63, wave = tid >> 6;
#pragma unroll
      for (int dd = 0; dd < 8; ++dd) { const int d = wave * 8 + dd; float x = GC[lane * 65 + d];
#pragma unroll
          for (int o = 1; o < 64; o <<= 1) { const float y = __shfl_up(x, o); if (lane >= o) x += y; }
          GC[lane * 65 + d] = x; } }
    __syncthreads();
}
__device__ __forceinline__ void gla_a_tile(LAS unsigned char* lds, const GlaArgs& A, int tile, int tid) {
    const int bh = tile >> 6, n = tile & 63, b = bh >> 2, h = bh & 3, t0 = b * SEQ + n * 64, s0 = n * 64;
    LAS float* GC = (LAS float*)(lds + GL_GC); LAS bf16_t* KDT = (LAS bf16_t*)(lds + GL_T0); LAS bf16_t* VT = (LAS bf16_t*)(lds + GL_VT);
    gla_gcum(lds, A, t0, h, tid);
    { const int cc = (tid & 63) * 4, i0 = tid >> 6;
      if (cc >= 64) { f32x4 o[8]; const int c0 = (cc < 128) ? 256 + h * 64 + (cc - 64) : 512 + h * 128 + (cc - 128);
          gla_conv8(o, A.Ug, A.conv, t0, s0, i0, c0);
          if (cc < 128) { const int d = cc - 64;
#pragma unroll
              for (int e = 0; e < 8; ++e) { const int i = i0 + 8 * e;
#pragma unroll
                  for (int q = 0; q < 4; ++q) KDT[(d + q) * 72 + i] = f2bf(o[e][q] * __expf(GC[63 * 65 + d + q] - GC[i * 65 + d + q])); } }
          else { const int ev = cc - 128;
#pragma unroll
              for (int e = 0; e < 8; ++e) { const int i = i0 + 8 * e;
#pragma unroll
                  for (int q = 0; q < 4; ++q) VT[(ev + q) * 72 + i] = f2bf(o[e][q]); } } } }
    if (tid < 64) A.dec[((size_t)bh * 64 + n) * 64 + tid] = __expf(GC[63 * 65 + tid]);
    __syncthreads();
    { const int lane = tid & 63, wave = tid >> 6, fr = lane & 15, fq = lane >> 4; f32x4 acc[4];
#pragma unroll
      for (int nt = 0; nt < 4; ++nt) acc[nt] = (f32x4){0.f, 0.f, 0.f, 0.f};
#pragma unroll
      for (int ks = 0; ks < 2; ++ks) { const bf16x8 a = *(LAS const bf16x8*)(VT + (16 * wave + fr) * 72 + ks * 32 + fq * 8);
#pragma unroll
          for (int nt = 0; nt < 4; ++nt) { const bf16x8 bfr = *(LAS const bf16x8*)(KDT + (16 * nt + fr) * 72 + ks * 32 + fq * 8); acc[nt] = mfma16(bfr, a, acc[nt]); } }
#pragma unroll
      for (int nt = 0; nt < 4; ++nt) *(f32x4*)(A.kvcT + (((size_t)bh * 64 + n) * 128 + 16 * wave + fr) * 64 + 16 * nt + 4 * fq) = acc[nt]; }
    __syncthreads();
}
__device__ __forceinline__ void gla_c_tile(LAS unsigned char* lds, const GlaArgs& A, int tile, int tid) {
    const int bh = tile >> 6, n = tile & 63, b = bh >> 2, h = bh & 3, t0 = b * SEQ + n * 64, s0 = n * 64;
    LAS float* GC = (LAS float*)(lds + GL_GC); LAS bf16_t* QG = (LAS bf16_t*)(lds + GL_T0); LAS bf16_t* KG = QG + 64 * 72; LAS bf16_t* QR = KG + 64 * 72; LAS bf16_t* KR = QR + 64 * 72;
    LAS bf16_t* VT = (LAS bf16_t*)(lds + GL_VT); LAS bf16_t* AL = (LAS bf16_t*)(lds + GL_AL); LAS float* RS = (LAS float*)(lds + GL_RS);
    gla_gcum(lds, A, t0, h, tid);
    { const int cc = (tid & 63) * 4, i0 = tid >> 6; f32x4 o[8];
      const int c0 = (cc < 64) ? h * 64 + cc : (cc < 128) ? 256 + h * 64 + (cc - 64) : 512 + h * 128 + (cc - 128);
      gla_conv8(o, A.Ug, A.conv, t0, s0, i0, c0);
      if (cc < 128) { const int d = cc & 63; const bool isq = cc < 64; LAS bf16_t* T1 = isq ? QG : KR; LAS bf16_t* T2 = isq ? QR : KG; const float sc = isq ? 0.125f : 1.0f;
#pragma unroll
          for (int e = 0; e < 8; ++e) { const int i = i0 + 8 * e; f32x4 x1, x2;
#pragma unroll
              for (int q = 0; q < 4; ++q) { const float eg = __expf(GC[i * 65 + d + q]); const float x = o[e][q] * sc; x1[q] = x * eg; x2[q] = x / eg; }
              u32x2 w1, w2; w1.x = cvt_pk_bf16(x1[0], x1[1]); w1.y = cvt_pk_bf16(x1[2], x1[3]); w2.x = cvt_pk_bf16(x2[0], x2[1]); w2.y = cvt_pk_bf16(x2[2], x2[3]);
              *(LAS u32x2*)(T1 + i * 72 + d) = w1; *(LAS u32x2*)(T2 + i * 72 + d) = w2; } }
      else { const int ev = cc - 128;
#pragma unroll
          for (int e = 0; e < 8; ++e) { const int i = i0 + 8 * e;
#pragma unroll
              for (int q = 0; q < 4; ++q) VT[(ev + q) * 72 + i] = f2bf(o[e][q]); } } }
    __syncthreads();
    const int lane = tid & 63, wave = tid >> 6, fr = lane & 15, fq = lane >> 4; const int mt = wave >> 1;
    {
#pragma unroll
        for (int q = 0; q < 2; ++q) { const int nt = (wave & 1) * 2 + q; f32x4 ap = (f32x4){0.f, 0.f, 0.f, 0.f}, af = ap;
#pragma unroll
            for (int ks = 0; ks < 2; ++ks) { const int ko = ks * 32 + fq * 8;
                ap = mfma16(*(LAS const bf16x8*)(KG + (16 * nt + fr) * 72 + ko), *(LAS const bf16x8*)(QG + (16 * mt + fr) * 72 + ko), ap);
                af = mfma16(*(LAS const bf16x8*)(KR + (16 * nt + fr) * 72 + ko), *(LAS const bf16x8*)(QR + (16 * mt + fr) * 72 + ko), af); }
            const int trow = 16 * mt + fr; f32x4 o;
#pragma unroll
            for (int j = 0; j < 4; ++j) { const int scol = 16 * nt + 4 * fq + j; o[j] = (scol <= trow) ? ap[j] : af[j]; }
            u32x2 w; w.x = cvt_pk_bf16(o[0], o[1]); w.y = cvt_pk_bf16(o[2], o[3]); *(LAS u32x2*)(AL + trow * 72 + 16 * nt + 4 * fq) = w; }
    }
    __syncthreads();
    f32x4 acc[4];
#pragma unroll
    for (int q = 0; q < 4; ++q) acc[q] = (f32x4){0.f, 0.f, 0.f, 0.f};
    const bf16_t* sp = A.spT + ((size_t)bh * 64 + n) * 128 * 64;
#pragma unroll
    for (int ks = 0; ks < 2; ++ks) { const int ko = ks * 32 + fq * 8; const bf16x8 a1 = *(LAS const bf16x8*)(AL + (16 * mt + fr) * 72 + ko), a2 = *(LAS const bf16x8*)(QG + (16 * mt + fr) * 72 + ko);
#pragma unroll
        for (int q = 0; q < 4; ++q) { const int nt = (wave & 1) * 4 + q;
            acc[q] = mfma16(*(LAS const bf16x8*)(VT + (16 * nt + fr) * 72 + ko), a1, acc[q]);
            acc[q] = mfma16(*(const bf16x8*)(sp + (size_t)(16 * nt + fr) * 64 + ko), a2, acc[q]); } }
    float ssq = 0.f;
#pragma unroll
    for (int q = 0; q < 4; ++q) ssq += (acc[q][0] * acc[q][0] + acc[q][1] * acc[q][1]) + (acc[q][2] * acc[q][2] + acc[q][3] * acc[q][3]);
    ssq += __shfl_xor(ssq, 16); ssq += __shfl_xor(ssq, 32);
    if (fq == 0) RS[(16 * mt + fr) * 2 + (wave & 1)] = ssq;
    __syncthreads();
    { const int i = 16 * mt + fr; const float rs = rsqrtf((RS[i * 2] + RS[i * 2 + 1]) * (1.0f / 128.0f) + 1e-6f);
#pragma unroll
      for (int q = 0; q < 4; ++q) { const int ecol = h * 128 + ((wave & 1) * 4 + q) * 16 + 4 * fq; const f32x4 nw = *(const f32x4*)(A.gnorm + ecol); const f32x4 go = ld_bf4(A.Ug + (size_t)(t0 + i) * 1792 + 1040 + ecol); f32x4 o;
#pragma unroll
          for (int j = 0; j < 4; ++j) o[j] = acc[q][j] * rs * nw[j] * go[j] * sigmoidf_(go[j]);
          st_bf4(A.Yg + (size_t)(t0 + i) * 512 + ecol, o); } }
    __syncthreads();
}

__device__ __forceinline__ void xa_tile(const bf16_t* Ux, const bf16_t* Kb, const bf16_t* Vt, bf16_t* Yx, int tile, int tid) {
    const int blk = tile & 31, h = (tile >> 5) & 3, b = tile >> 7; const int lane = tid & 63, wave = tid >> 6, fr = lane & 15, fq = lane >> 4;
    const int t = b * SEQ + blk * 128 + 16 * wave + fr;
    bf16x8 qf[4];
#pragma unroll
    for (int ks = 0; ks < 4; ++ks) qf[ks] = *(const bf16x8*)(Ux + (size_t)t * 512 + h * 128 + ks * 32 + fq * 8);
    f32x4 s[16];
#pragma unroll
    for (int nt = 0; nt < 16; ++nt) { s[nt] = (f32x4){0.f, 0.f, 0.f, 0.f}; const bf16_t* kr = Kb + (size_t)(b * 256 + 16 * nt + fr) * 512 + h * 128 + fq * 8;
#pragma unroll
        for (int ks = 0; ks < 4; ++ks) s[nt] = mfma16(*(const bf16x8*)(kr + ks * 32), qf[ks], s[nt]); }
    float mx = -1e30f;
#pragma unroll
    for (int nt = 0; nt < 16; ++nt)
#pragma unroll
        for (int j = 0; j < 4; ++j) mx = fmaxf(mx, s[nt][j]);
    mx = fmaxf(mx, __shfl_xor(mx, 16)); mx = fmaxf(mx, __shfl_xor(mx, 32));
    const float sc = 0.08838834764831845f * 1.4426950408889634f; float l = 0.f;
#pragma unroll
    for (int nt = 0; nt < 16; ++nt)
#pragma unroll
        for (int j = 0; j < 4; ++j) { const float pz = exp2f((s[nt][j] - mx) * sc); s[nt][j] = pz; l += pz; }
    l += __shfl_xor(l, 16); l += __shfl_xor(l, 32);
    f32x4 o[8];
#pragma unroll
    for (int dt = 0; dt < 8; ++dt) o[dt] = (f32x4){0.f, 0.f, 0.f, 0.f};
#pragma unroll
    for (int c = 0; c < 8; ++c) { union { u32x4 u; bf16x8 v; } pf;
        pf.u.x = cvt_pk_bf16(s[2 * c][0], s[2 * c][1]); pf.u.y = cvt_pk_bf16(s[2 * c][2], s[2 * c][3]); pf.u.z = cvt_pk_bf16(s[2 * c + 1][0], s[2 * c + 1][1]); pf.u.w = cvt_pk_bf16(s[2 * c + 1][2], s[2 * c + 1][3]);
#pragma unroll
        for (int dt = 0; dt < 8; ++dt) { const bf16_t* vr = Vt + ((size_t)b * 512 + h * 128 + 16 * dt + fr) * 256 + 32 * c + 4 * fq; union { u32x4 u; bf16x8 v; } vf;
            const u32x2 lo = *(const u32x2*)vr, hi = *(const u32x2*)(vr + 16); vf.u.x = lo.x; vf.u.y = lo.y; vf.u.z = hi.x; vf.u.w = hi.y;
            o[dt] = mfma16(vf.v, pf.v, o[dt]); } }
    const float il = 1.0f / l;
#pragma unroll
    for (int dt = 0; dt < 8; ++dt) st_bf4(Yx + (size_t)t * 512 + h * 128 + 16 * dt + 4 * fq, o[dt] * il);
}

struct Params { const float* in[33]; float* out; unsigned char* ws; };

__device__ __forceinline__ int opaque0() { int z = 0; asm volatile("" : "+s"(z)); return z; }
typedef __attribute__((address_space(1))) unsigned char* gptr_t;
typedef __attribute__((address_space(1))) const float* gcf_t;
__device__ __forceinline__ int opqv(int v) { asm volatile("" : "+v"(v)); return v; }
__device__ __forceinline__ int opqs(int v) { asm volatile("" : "+s"(v)); return v; }
#define PH_BEGIN const int zi = opaque0(); unsigned char* ws = P.ws + zi; float* const OUT = P.out + zi; (void)OUT; const int tid = opqv((int)threadIdx.x); const int bid = opqs((int)blockIdx.x); const int G = opqs((int)gridDim.x); (void)tid; (void)bid; (void)G; unsigned char* WB = ws + WS_WB; float* SS = (float*)(ws + WS_SS); (void)WB; (void)SS; (void)zi;
#define INP(k) (P.in[(k)] + zi)
#define XB_ ((bf16_t*)(ws + WS_XB))
#define U_ (ws + WS_U)
#define SC_ (ws + WS_SC)
#define Y_ ((bf16_t*)(ws + WS_Y))
#define KB_ ((bf16_t*)(ws + WS_KB))
#define VT_ ((bf16_t*)(ws + WS_VT))

constexpr size_t WS_BAR = WS_MISC + 8192;
__device__ __forceinline__ void grid_bar(unsigned* ctr, unsigned target) {
    asm volatile("s_waitcnt vmcnt(0)" ::: "memory");
    __syncthreads();
    if (threadIdx.x == 0) {
        __builtin_amdgcn_fence(__ATOMIC_RELEASE, "agent");
        asm volatile("s_waitcnt vmcnt(0)" ::: "memory");
        __hip_atomic_fetch_add(ctr, 1u, __ATOMIC_RELAXED, __HIP_MEMORY_SCOPE_AGENT);
        while (__hip_atomic_load(ctr, __ATOMIC_RELAXED, __HIP_MEMORY_SCOPE_AGENT) < target) __builtin_amdgcn_s_sleep(2);
        __builtin_amdgcn_fence(__ATOMIC_ACQUIRE, "agent");
        asm volatile("s_waitcnt vmcnt(0)" ::: "memory");
    }
    __syncthreads();
}

__global__ void __launch_bounds__(512) mega(Params P) {
    extern __shared__ __attribute__((aligned(16))) unsigned char lds_raw[];
    LAS unsigned char* lds = (LAS unsigned char*)lds_raw;
    cg::grid_group grid = cg::this_grid();

    for (int ph = 0; ph < NL * 12 + 1; ++ph) {
        const int l = ph / 12, kph = ph - l * 12;
        if (ph == NL * 12) {
#if (PHMASK >> 12) & 1
    { PH_BEGIN
        const int lane = tid & 63, gw = bid * 8 + (tid >> 6), nw = G * 8;
        const float* fn = INP(32); const float* ssf = SS + (size_t)0 * T * 16; float* X = OUT;
        for (int r = gw; r < T; r += nw) { const float rs = row_rstd(ssf, r);
#pragma unroll
            for (int i = 0; i < 4; ++i) { const size_t o = (size_t)r * D + i * 256 + lane * 4; *(f32x4*)(X + o) = *(const f32x4*)(X + o) * rs * *(const f32x4*)(fn + i * 256 + lane * 4); } }
    }
#endif
            break;
        }
        switch (kph) {
        case 0: {
#if (PHMASK >> 0) & 1
        for (int rep = 0; rep < REP0; ++rep) {
        {
            { PH_BEGIN convT_w<1>(INP(3) + (size_t)l * D * 2 * FF, 2 * FF, 0, INP(2) + (size_t)l * D, (bf16_t*)(WB + WB_W1A), D, D, 2 * FF, bid * 8 + (tid >> 6), G * 8, tid & 63); }
            { PH_BEGIN convT_w<0>(INP(4) + (size_t)l * FF * D, D, 0, nullptr, (bf16_t*)(WB + WB_W1B), FF, FF, D, bid * 8 + (tid >> 6), G * 8, tid & 63); }
            { PH_BEGIN convT_w<2>(INP(7) + (size_t)l * D * 6928, 6928, 0, INP(5) + (size_t)l * D, (bf16_t*)(WB + WB_WIN), D, D, 4096, bid * 8 + (tid >> 6), G * 8, tid & 63); }
            { PH_BEGIN convT_w<0>(INP(7) + (size_t)l * D * 6928, 6928, 3856, INP(5) + (size_t)l * D, (bf16_t*)(WB + WB_WG), D, D, 3072, bid * 8 + (tid >> 6), G * 8, tid & 63); }
            for (int j = 0; j < 3; ++j) { PH_BEGIN convT_w<0>(INP(27) + ((size_t)l * 3 + j) * 512 * D, D, 0, nullptr, (bf16_t*)(WB + WB_WBR) + (size_t)j * D * 512, 512, 512, D, bid * 8 + (tid >> 6), G * 8, tid & 63); }
            { PH_BEGIN convT_w<0>(INP(28) + (size_t)l * D * D, D, 0, nullptr, (bf16_t*)(WB + WB_WO), D, D, D, bid * 8 + (tid >> 6), G * 8, tid & 63); }
            { PH_BEGIN convT_w<0>(INP(26) + (size_t)l * D * D, D, 0, INP(6) + (size_t)l * D, (bf16_t*)(WB + WB_WKV), D, D, D, bid * 8 + (tid >> 6), G * 8, tid & 63); }
            { PH_BEGIN convT_w<1>(INP(30) + (size_t)l * D * 2 * FF, 2 * FF, 0, INP(29) + (size_t)l * D, (bf16_t*)(WB + WB_W2A), D, D, 2 * FF, bid * 8 + (tid >> 6), G * 8, tid & 63); }
            { PH_BEGIN convT_w<0>(INP(31) + (size_t)l * FF * D, D, 0, nullptr, (bf16_t*)(WB + WB_W2B), FF, FF, D, bid * 8 + (tid >> 6), G * 8, tid & 63); }
            { PH_BEGIN convT_w<0>(INP(10) + (size_t)l * 64 * 512, 512, 0, nullptr, (bf16_t*)(WB + WB_LW2), 64, 64, 512, bid * 8 + (tid >> 6), G * 8, tid & 63); }
            { PH_BEGIN convT_w<0>(INP(12) + (size_t)l * 64 * 512, 512, 0, nullptr, (bf16_t*)(WB + WB_LA2), 64, 64, 512, bid * 8 + (tid >> 6), G * 8, tid & 63); }
            { PH_BEGIN convT_w<0>(INP(13) + (size_t)l * 128 * 512, 512, 0, nullptr, (bf16_t*)(WB + WB_LG2), 128, 128, 512, bid * 8 + (tid >> 6), G * 8, tid & 63); }
            if (l > 0) {
                { PH_BEGIN convT_w<0>(INP(20) + (size_t)(l - 1) * 512 * 32, 32, 0, nullptr, (bf16_t*)(WB + WB_LV1), 512, 512, 32, bid * 8 + (tid >> 6), G * 8, tid & 63); }
                { PH_BEGIN convT_w<0>(INP(21) + (size_t)(l - 1) * 32 * 512, 512, 0, nullptr, (bf16_t*)(WB + WB_LV2), 32, 32, 512, bid * 8 + (tid >> 6), G * 8, tid & 63); }
            }
            if (l == 0) { PH_BEGIN
                const int lane = tid & 63, gw = bid * 8 + (tid >> 6), nw = G * 8;
                float* rstd_mem = (float*)(ws + WS_MISC); bf16_t* MEMN = (bf16_t*)(ws + WS_MEMN);
                for (int r = gw; r < T + 1024; r += nw) {
                    const bool ism = r >= T; const float* src = ism ? INP(1) + (size_t)(r - T) * D : INP(0) + (size_t)r * D; bf16_t* dst = ism ? MEMN + (size_t)(r - T) * D : XB_ + (size_t)r * D; float q = 0.f;
#pragma unroll
                    for (int i = 0; i < 4; ++i) { const f32x4 v = *(const f32x4*)(src + i * 256 + lane * 4); st_bf4(dst + i * 256 + lane * 4, v); q += (v[0] * v[0] + v[1] * v[1]) + (v[2] * v[2] + v[3] * v[3]); }
                    q = wave_sum(q);
                    if (ism) { if (lane == 0) rstd_mem[r - T] = rsqrtf(q * (1.0f / 1024.0f) + 1e-6f); } else if (lane < 16) SS[(size_t)r * 16 + lane] = (lane == 0) ? q : 0.f;
                }
            }
        }
        }
#endif
        } break;
        case 1: {
#if (PHMASK >> 1) & 1
        for (int rep = 0; rep < REPG; ++rep) {
        { PH_BEGIN
            pg8::Gemm g{XB_, (const bf16_t*)(WB + WB_W1A), T, 2 * FF, D, D, D, 0, 0}; pg8::StaticOrder S; S.init(T, 2 * FF, G, bid, 1);
            EpiFFNa E{(bf16_t*)U_, SS + (size_t)0 * T * 16}; pg8::gemm_phase(lds, g, S, E, tid);
        }
        if ((int)blockIdx.x >= (int)gridDim.x - 16) { PH_BEGIN
            pg8::Gemm g2{(const bf16_t*)(ws + WS_MEMN), (const bf16_t*)(WB + WB_WKV), 1024, D, D, D, D, 0, 0}; pg8::StaticOrder S2; S2.init(1024, D, 16, bid - (G - 16), 1);
            EpiKV E2{KB_, VT_, (const float*)(ws + WS_MISC)}; pg8::gemm_phase(lds, g2, S2, E2, tid);
        }
        }
#endif
        } break;
        case 2: {
#if (PHMASK >> 2) & 1
        { PH_BEGIN
            pg8::Gemm g{(const bf16_t*)U_, (const bf16_t*)(WB + WB_W1B), T, D, FF, FF, FF, 0, 0}; pg8::StaticOrder S; S.init(T, D, G, bid, 1);
            EpiRes E{l == 0 ? INP(0) : OUT, OUT, XB_, SS + (size_t)1 * T * 16, 0.5f}; pg8::gemm_phase(lds, g, S, E, tid);
        }
#endif
        } break;
        case 3: {
#if (PHMASK >> 3) & 1
        for (int rep = 0; rep < REPG; ++rep) {
        { PH_BEGIN
            pg8::Gemm g{XB_, (const bf16_t*)(WB + WB_WIN), T, 4096, D, D, D, 0, 0}; pg8::StaticOrder S; S.init(T, 4096, G, bid, 1);
            EpiU E{(bf16_t*)U_, SS + (size_t)1 * T * 16}; pg8::gemm_phase(lds, g, S, E, tid);
        }
        }
#endif
        } break;
        case 4: {
#if (PHMASK >> 4) & 1
        for (int rep = 0; rep < REP4; ++rep) {
#if P4SUB & 1
        { PH_BEGIN
            PrepArgs PA; PA.U = (const bf16_t*)(U_ + U_RWKV); PA.mu = INP(8) + (size_t)l * 1792; PA.w0 = INP(9) + (size_t)l * 512; PA.a0 = INP(11) + (size_t)l * 512;
            PA.kk_ = INP(14) + (size_t)l * 512; PA.ka = INP(15) + (size_t)l * 512; PA.rk = INP(16) + (size_t)l * 512; PA.v0 = INP(19) + (size_t)(l > 0 ? l - 1 : 0) * 512;
            PA.w2t = (const bf16_t*)(WB + WB_LW2); PA.a2t = (const bf16_t*)(WB + WB_LA2); PA.g2t = (const bf16_t*)(WB + WB_LG2); PA.v1t = (const bf16_t*)(WB + WB_LV1); PA.v2t = (const bf16_t*)(WB + WB_LV2);
            PA.vfirst = (float*)(ws + WS_VF); PA.Wd = (float*)(SC_ + SC_WD); PA.V = (float*)(SC_ + SC_V); PA.RKKB = (bf16_t*)(SC_ + SC_RKKB); PA.Go = (bf16_t*)(ws + WS_GO); PA.Bon = (float*)(ws + WS_BON); PA.layer = l;
            for (int tt = bid; tt < 256; tt += G) rwkv_prep_tile(lds, PA, tt, tid);
        }
#endif
#if P4SUB & 2
        { PH_BEGIN
            GlaArgs GA; GA.Ug = (const bf16_t*)(U_ + U_GLA); GA.conv = INP(22) + (size_t)l * 4096; GA.aup = INP(23) + (size_t)l * 4096; GA.abias = INP(24) + (size_t)l * 256; GA.gnorm = INP(25) + (size_t)l * 512;
            GA.kvcT = (float*)(ws + WS_KVC); GA.dec = (float*)(ws + WS_DEC); GA.spT = (bf16_t*)(U_ + U_SPT); GA.Yg = Y_ + (size_t)T * 512;
            for (int tile = bid; tile < 1024; tile += G) gla_a_tile(lds, GA, tile, tid);
        }
#endif
#if P4SUB & 4
        { PH_BEGIN
            for (int tile = bid; tile < 512; tile += G) xa_tile((const bf16_t*)(U_ + U_XA), KB_, VT_, Y_ + (size_t)2 * T * 512, tile, tid);
        }
#endif
        }
#endif
        } break;
        case 5: {
#if (PHMASK >> 5) & 1
        for (int rep = 0; rep < REP5; ++rep) {
        { PH_BEGIN
            bf16_t* spT = (bf16_t*)(U_ + U_SPT); const float* DEC = (const float*)(ws + WS_DEC); const float* KVC = (const float*)(ws + WS_KVC);
            for (int i = bid * 512 + tid; i < 16 * 128 * 64; i += G * 512) { const int bh = i >> 13, ed = i & 8191, d = i & 63; float st = 0.f;
                for (int n0 = 0; n0 < 64; n0 += 16) { float kv[16], dc[16];
#pragma unroll
                    for (int q = 0; q < 16; ++q) { kv[q] = KVC[((size_t)bh * 64 + n0 + q) * 8192 + ed]; dc[q] = DEC[((size_t)bh * 64 + n0 + q) * 64 + d]; }
#pragma unroll
                    for (int q = 0; q < 16; ++q) { spT[((size_t)bh * 64 + n0 + q) * 8192 + ed] = f2bf(st); st = st * dc[q] + kv[q]; } } }
        }
        { PH_BEGIN
            for (int u = bid; u < 256; u += G) { const int xcd = u & 7, j = u >> 3, p = xcd * 4 + (j >> 3), rg = j & 7;
                rwkv_scan_unit(lds, (const float*)(SC_ + SC_WD), (const float*)(SC_ + SC_V), (const bf16_t*)(SC_ + SC_RKKB), (float*)(U_ + U_YRAW), p, rg, tid); }
        }
        }
#endif
        } break;
        case 6: {
#if (PHMASK >> 6) & 1
        for (int rep = 0; rep < REP6; ++rep) {
        { PH_BEGIN
            const int lane = tid & 63, gw = bid * 8 + (tid >> 6), nw = G * 8;
            const float* lnw = INP(17) + (size_t)l * 512; const float* lnb = INP(18) + (size_t)l * 512; const float* Yraw = (const float*)(U_ + U_YRAW); const float* Vv = (const float*)(SC_ + SC_V);
            const float* BON = (const float*)(ws + WS_BON); const bf16_t* GO = (const bf16_t*)(ws + WS_GO); bf16_t* Y = Y_;
            const int kq = lane & 15, sub = lane >> 4;
#pragma unroll 4
            for (int it0 = gw * 4; it0 < 32 * SEQ; it0 += nw * 4) { const int it = it0 + sub; const int p = it >> 12, s = it & (SEQ - 1), b = p >> 3, h = p & 7, t = b * SEQ + s;
                const f32x4 y = *(const f32x4*)(Yraw + (size_t)it * 64 + kq * 4); const f32x4 vv = *(const f32x4*)(Vv + (size_t)it * 64 + kq * 4);
                const f32x4 gg = ld_bf4(GO + (size_t)t * 512 + h * 64 + kq * 4); const f32x4 lw = *(const f32x4*)(lnw + h * 64 + kq * 4), lb = *(const f32x4*)(lnb + h * 64 + kq * 4); const float bon = BON[(size_t)t * 8 + h];
                const float mean = row16_sum((y[0] + y[1]) + (y[2] + y[3])) * (1.0f / 64.0f); const f32x4 dl = y - mean;
                const float var = row16_sum((dl[0] * dl[0] + dl[1] * dl[1]) + (dl[2] * dl[2] + dl[3] * dl[3])) * (1.0f / 64.0f); const float rs = rsqrtf(var + 64e-5f);
                st_bf4(Y + (size_t)t * 512 + h * 64 + kq * 4, ((dl * rs) * lw + lb + vv * bon) * gg); }
        }
        { PH_BEGIN
            GlaArgs GA; GA.Ug = (const bf16_t*)(U_ + U_GLA); GA.conv = INP(22) + (size_t)l * 4096; GA.aup = INP(23) + (size_t)l * 4096; GA.abias = INP(24) + (size_t)l * 256; GA.gnorm = INP(25) + (size_t)l * 512;
            GA.kvcT = (float*)(ws + WS_KVC); GA.dec = (float*)(ws + WS_DEC); GA.spT = (bf16_t*)(U_ + U_SPT); GA.Yg = Y_ + (size_t)T * 512;
            for (int tile = bid; tile < 1024; tile += G) gla_c_tile(lds, GA, tile, tid);
        }
        }
#endif
        } break;
        case 7: {
#if (PHMASK >> 7) & 1
        for (int rep = 0; rep < REPG; ++rep) {
        { PH_BEGIN
            pg8::Gemm g{XB_, (const bf16_t*)(WB + WB_WG), T, 3072, D, D, D, 0, 0}; pg8::StaticOrder S; S.init(T, 3072, G, bid, 1);
            EpiGate E{(bf16_t*)SC_, SS + (size_t)1 * T * 16}; pg8::gemm_phase(lds, g, S, E, tid);
        }
        }
#endif
        } break;
        case 8: {
#if (PHMASK >> 8) & 1
        for (int rep = 0; rep < REPG; ++rep) {
        { PH_BEGIN
            pg8::Gemm g{Y_, (const bf16_t*)(WB + WB_WBR), T, D, 512, 512, 512, (unsigned)T * 512u * 2u, (unsigned)D * 512u * 2u}; pg8::StaticOrder S; S.init(T, D, G, bid, 3);
            EpiMerge E{(const bf16_t*)SC_, (float*)(U_ + U_MG), (bf16_t*)(U_ + U_MGB)}; pg8::gemm_phase(lds, g, S, E, tid);
        }
        }
#endif
        } break;
        case 9: {
#if (PHMASK >> 9) & 1
        { PH_BEGIN
            pg8::Gemm g{(const bf16_t*)(U_ + U_MGB), (const bf16_t*)(WB + WB_WO), T, D, D, D, D, 0, 0}; pg8::StaticOrder S; S.init(T, D, G, bid, 1);
            EpiRes E{OUT, OUT, XB_, SS + (size_t)2 * T * 16, 1.0f}; pg8::gemm_phase(lds, g, S, E, tid);
        }
#endif
        } break;
        case 10: {
#if (PHMASK >> 10) & 1
        for (int rep = 0; rep < REPG; ++rep) {
        { PH_BEGIN
            pg8::Gemm g{XB_, (const bf16_t*)(WB + WB_W2A), T, 2 * FF, D, D, D, 0, 0}; pg8::StaticOrder S; S.init(T, 2 * FF, G, bid, 1);
            EpiFFNa E{(bf16_t*)U_, SS + (size_t)2 * T * 16}; pg8::gemm_phase(lds, g, S, E, tid);
        }
        }
#endif
        } break;
        case 11: {
#if (PHMASK >> 11) & 1
        { PH_BEGIN
            pg8::Gemm g{(const bf16_t*)U_, (const bf16_t*)(WB + WB_W2B), T, D, FF, FF, FF, 0, 0}; pg8::StaticOrder S; S.init(T, D, G, bid, 1);
            EpiRes E{OUT, OUT, XB_, SS + (size_t)0 * T * 16, 0.5f}; pg8::gemm_phase(lds, g, S, E, tid);
        }
#endif
        } break;
        default: break;
        }
        if (ph == 0) grid.sync();
        else grid_bar((unsigned*)(P.ws + WS_BAR), (unsigned)ph * gridDim.x);
    }
}

extern "C" void kernel_launch(void* const* d_in, const int* in_sizes, int n_in, void* d_out, int out_size, void* d_ws, size_t ws_size, hipStream_t stream) {
    static int grid_blocks = 0;
    if (!grid_blocks) {
        if (n_in != 33 || ws_size < WS_END) { fprintf(stderr, "kernel_launch: need 33 inputs and %zu bytes of workspace (got %d, %zu)\n", (size_t)WS_END, n_in, ws_size); grid_blocks = -1; return; }
        int dev = 0, cus = 0, per_cu = 0;
        hipGetDevice(&dev); hipDeviceGetAttribute(&cus, hipDeviceAttributeMultiprocessorCount, dev);
        if (hipFuncSetAttribute((const void*)mega, hipFuncAttributeMaxDynamicSharedMemorySize, LDS_BYTES) != hipSuccess) { fprintf(stderr, "kernel_launch: hipFuncSetAttribute failed\n"); grid_blocks = -1; return; }
        if (hipOccupancyMaxActiveBlocksPerMultiprocessor(&per_cu, (const void*)mega, 512, LDS_BYTES) != hipSuccess || per_cu < 1) { fprintf(stderr, "kernel_launch: occupancy query says %d\n", per_cu); per_cu = 1; }
        (void)hipGetLastError();
        grid_blocks = cus * per_cu;
    }
    if (grid_blocks < 0) return;
    if (hipMemsetAsync((char*)d_ws + WS_BAR, 0, 256, stream) != hipSuccess) { fprintf(stderr, "kernel_launch: memset failed\n"); return; }
    Params p{};
    for (int i = 0; i < 33; ++i) p.in[i] = (const float*)d_in[i];
    p.out = (float*)d_out; p.ws = (unsigned char*)d_ws;
    void* args[] = {&p};
    hipError_t e = hipLaunchCooperativeKernel((const void*)mega, dim3(grid_blocks), dim3(512), args, LDS_BYTES, stream);
    if (e != hipSuccess) fprintf(stderr, "cooperative launch failed: %s (grid %d)\n", hipGetErrorString(e), grid_blocks);
}
```

```cpp
#include <hip/hip_runtime.h>
#include <hip/hip_cooperative_groups.h>
#include <cstdio>
namespace cg = cooperative_groups;
#ifndef P4SUB
#define P4SUB 7
#endif
#ifndef REP5
#define REP5 1
#endif
#ifndef REP4
#define REP4 1
#endif
#ifndef REP6
#define REP6 1
#endif
#ifndef REP0
#define REP0 1
#endif
#ifndef REPG
#define REPG 1
#endif
#ifndef REPSYNC
#define REPSYNC 1
#endif
#ifndef PHMASK
#define PHMASK 0xFFFF
#endif

#define LAS __attribute__((address_space(3)))
typedef unsigned short bf16_t;
typedef short bf16x8 __attribute__((ext_vector_type(8)));
typedef float f32x4 __attribute__((ext_vector_type(4)));
typedef float f32x2 __attribute__((ext_vector_type(2)));
typedef unsigned u32x4 __attribute__((ext_vector_type(4)));
typedef unsigned u32x2 __attribute__((ext_vector_type(2)));

constexpr int T = 16384, D = 1024, FF = 2816, SEQ = 4096, NL = 4;
constexpr int LDS_BYTES = 139264;

constexpr size_t MB = 1024 * 1024;
constexpr size_t WS_MISC = 0;
constexpr size_t WS_SS = 1 * MB;
constexpr size_t WS_WB = 4 * MB;
constexpr size_t WB_W1A = 0;
constexpr size_t WB_W1B = WB_W1A + (size_t)5632 * 1024 * 2;
constexpr size_t WB_WIN = WB_W1B + (size_t)1024 * 2816 * 2;
constexpr size_t WB_WG = WB_WIN + (size_t)4096 * 1024 * 2;
constexpr size_t WB_WBR = WB_WG + (size_t)3072 * 1024 * 2;
constexpr size_t WB_WO = WB_WBR + (size_t)3 * 1024 * 512 * 2;
constexpr size_t WB_WKV = WB_WO + (size_t)1024 * 1024 * 2;
constexpr size_t WB_W2A = WB_WKV + (size_t)1024 * 1024 * 2;
constexpr size_t WB_W2B = WB_W2A + (size_t)5632 * 1024 * 2;
constexpr size_t WB_LW2 = WB_W2B + (size_t)1024 * 2816 * 2;
constexpr size_t WB_LA2 = WB_LW2 + 512 * 64 * 2;
constexpr size_t WB_LG2 = WB_LA2 + 512 * 64 * 2;
constexpr size_t WB_LV1 = WB_LG2 + 512 * 128 * 2;
constexpr size_t WB_LV2 = WB_LV1 + 32 * 512 * 2;
constexpr size_t WB_END = WB_LV2 + 512 * 32 * 2;
static_assert(WB_END <= 55 * MB, "weights region");
constexpr size_t WS_XB = WS_WB + 55 * MB;
constexpr size_t WS_VF = WS_XB + 32 * MB;
constexpr size_t WS_MEMN = WS_VF + 32 * MB;
constexpr size_t WS_KB = WS_MEMN + 2 * MB;
constexpr size_t WS_VT = WS_KB + 1 * MB;
constexpr size_t WS_GO = WS_VT + 1 * MB;
constexpr size_t WS_BON = WS_GO + 16 * MB;
constexpr size_t WS_Y = WS_BON + 1 * MB;
constexpr size_t WS_KVC = WS_Y + 48 * MB;
constexpr size_t WS_DEC = WS_KVC + 32 * MB;
constexpr size_t WS_SC = WS_DEC + 1 * MB;
constexpr size_t SC_WD = 0;
constexpr size_t SC_V = 32 * MB;
constexpr size_t SC_RKKB = 64 * MB;
constexpr size_t WS_U = WS_SC + 128 * MB;
constexpr size_t U_RWKV = 0;
constexpr size_t U_GLA = (size_t)T * 1792 * 2;
constexpr size_t U_XA = 2 * (size_t)T * 1792 * 2;
constexpr size_t U_YRAW = 0;
constexpr size_t U_SPT = 32 * MB;
constexpr size_t U_MG = 0;
constexpr size_t U_MGB = 64 * MB;
constexpr size_t WS_END = WS_U + 128 * MB;
static_assert(U_XA + (size_t)T * 512 * 2 <= 128 * MB, "U region");

typedef __bf16 bf16x2_t __attribute__((ext_vector_type(2)));
__device__ __forceinline__ unsigned cvt_pk_bf16(float lo, float hi) { const f32x2 v = {lo, hi}; const bf16x2_t r = __builtin_convertvector(v, bf16x2_t); return __builtin_bit_cast(unsigned, r); }
__device__ __forceinline__ bf16_t f2bf(float x) { return (bf16_t)(cvt_pk_bf16(x, 0.f) & 0xffffu); }
__device__ __forceinline__ float bf2f(bf16_t b) { return __uint_as_float(((unsigned)b) << 16); }
__device__ __forceinline__ float bflo(unsigned w) { return __uint_as_float(w << 16); }
__device__ __forceinline__ float bfhi(unsigned w) { return __uint_as_float(w & 0xffff0000u); }
__device__ __forceinline__ f32x4 ld_bf4(const bf16_t* p) { const u32x2 w = *(const u32x2*)p; return (f32x4){bflo(w.x), bfhi(w.x), bflo(w.y), bfhi(w.y)}; }
__device__ __forceinline__ void st_bf4(bf16_t* p, f32x4 v) { u32x2 w; w.x = cvt_pk_bf16(v[0], v[1]); w.y = cvt_pk_bf16(v[2], v[3]); *(u32x2*)p = w; }
__device__ __forceinline__ float sigmoidf_(float x) { return 1.0f / (1.0f + __expf(-x)); }
__device__ __forceinline__ float wave_sum(float v) { for (int o = 32; o >= 1; o >>= 1) v += __shfl_xor(v, o); return v; }
__device__ __forceinline__ f32x4 mfma16(bf16x8 a, bf16x8 b, f32x4 c) { return __builtin_amdgcn_mfma_f32_16x16x32_bf16(a, b, c, 0, 0, 0); }

__device__ __forceinline__ float row_rstd(const float* ssp, int row) {
    const f32x4* p = (const f32x4*)(ssp + (size_t)row * 16); const f32x4 a = p[0], b = p[1], c = p[2], d = p[3];
    const float t = (((a[0] + a[1]) + (a[2] + a[3])) + ((b[0] + b[1]) + (b[2] + b[3]))) + (((c[0] + c[1]) + (c[2] + c[3])) + ((d[0] + d[1]) + (d[2] + d[3])));
    return rsqrtf(t * (1.0f / 1024.0f) + 1e-6f);
}
namespace pg8 {
constexpr int BM = 256, BK = 64, HALF = 128, HTB = HALF * BK * 2, STAGE_BYTES = 8 * HTB, NXCD = 8, WGM = 8;
__device__ __forceinline__ int lds_byte(int r, int c) { const int st = (r >> 4) * 2 + (c >> 5), rr = r & 15, cc = c & 31, ob = rr * 64 + cc * 2; return st * 1024 + (ob ^ (((ob >> 9) & 1) << 5)); }
__device__ __forceinline__ void stage_rc(int b, int& R, int& C) { const int st = b / 1024, sb = b % 1024, swz = sb ^ (((sb >> 9) & 1) << 5); R = (st >> 1) * 16 + swz / 64; C = (st & 1) * 32 + (swz % 64) / 2; }
__device__ __forceinline__ int perm32(int rho) { const int n = rho >> 4, i = rho & 15; return 8 * (i >> 2) + 4 * n + (i & 3); }

struct Unit { int pm, pn, z; };
struct Gemm { const bf16_t* A; const bf16_t* Bt; int M, N, K, lda, ldb; unsigned zA, zB; };

struct StaticOrder {
    int nM, nN, nwg, G, c, nz;
    __device__ void init(int M, int N, int G_, int c_, int nz_) { nM = M / BM; nN = N / BM; nwg = nM * nN; G = G_; c = c_; nz = nz_; }
    __device__ bool next(int i, Unit& u) const {
        const int ti = i / nz; u.z = i - ti * nz;
        const long L = (long)ti * G + c; if (L >= nwg) return false;
        int wgid = (int)L; { const int q = nwg / NXCD, r = nwg % NXCD, xcd = wgid % NXCD, off = wgid / NXCD; wgid = (xcd < r ? xcd * (q + 1) : r * (q + 1) + (xcd - r) * q) + off; }
        const int nig = WGM * nN, gid = wgid / nig, fm = gid * WGM, gsz = (nM - fm) < WGM ? (nM - fm) : WGM;
        u.pm = fm + ((wgid % nig) % gsz); u.pn = (wgid % nig) / gsz; return true;
    }
};

template <class Epi>
__device__ __forceinline__ void gemm_phase(LAS unsigned char* lds, const Gemm g, const StaticOrder& S, const Epi& E, const int tid) {
    const int wid = __builtin_amdgcn_readfirstlane(tid >> 6), lane = tid & 63, wr = wid >> 2, wc = wid & 3, fr = lane & 15, fq = lane >> 4;
    const int K = g.K, nt = K / BK;
    unsigned voffA[2], voffB[2];
#pragma unroll
    for (int i = 0; i < 2; ++i) { int R, C; stage_rc(tid * 16 + i * 8192, R, C); const int Rb = Epi::PERM ? ((R & ~31) + perm32(R & 31)) : R;
        voffA[i] = (unsigned)(R * g.lda + C) * 2u; voffB[i] = (unsigned)(Rb * g.ldb + C) * 2u; }
    const unsigned kstep = (unsigned)(BK * 2);
    const unsigned hstepA = (unsigned)HALF * g.lda * 2u, hstepB = (unsigned)HALF * g.ldb * 2u;
    const unsigned tstepA = 2u * hstepA, tstepB = 2u * hstepB;
    const unsigned ldsw = (unsigned)wid * 1024u;
    const int aoff = lds_byte(wr * 64 + fr, fq * 8), boff = lds_byte(wc * 32 + fr, fq * 8);
    const char* const gA = (const char*)g.A; const char* const gB = (const char*)g.Bt;
#define PG8_SA(b, h) (((b) * 2 + (h)) * HTB)
#define PG8_SB(b, h) ((4 + (b) * 2 + (h)) * HTB)
#define PG8_STAGE(bufoff, gbase, soff, voff) do { _Pragma("unroll") for (int _i = 0; _i < 2; ++_i) \
        __builtin_amdgcn_global_load_lds((const unsigned*)(((gbase) + (size_t)(unsigned)(soff)) + (voff)[_i]), (LAS unsigned*)(lds + (bufoff) + ldsw + _i * 8192), 16, 0, 0); } while (0)
#define PG8_LDA(dst, b, h) do { _Pragma("unroll") for (int m = 0; m < 4; ++m) _Pragma("unroll") for (int k = 0; k < 2; ++k) dst[m][k] = *(const LAS bf16x8*)(lds + PG8_SA(b, h) + aoff + m * 2048 + k * 1024); } while (0)
#define PG8_LDB(dst, b, h) do { _Pragma("unroll") for (int n = 0; n < 2; ++n) _Pragma("unroll") for (int k = 0; k < 2; ++k) dst[n][k] = *(const LAS bf16x8*)(lds + PG8_SB(b, h) + boff + n * 2048 + k * 1024); } while (0)
#define PG8_MMA(ai, bj, At, Bt) do { __builtin_amdgcn_s_setprio(1); _Pragma("unroll") for (int m = 0; m < 4; ++m) _Pragma("unroll") for (int n = 0; n < 2; ++n) _Pragma("unroll") for (int k = 0; k < 2; ++k) \
        acc[ai][bj][m][n] = __builtin_amdgcn_mfma_f32_16x16x32_bf16(Bt[n][k], At[m][k], acc[ai][bj][m][n], 0, 0, 0); __builtin_amdgcn_s_setprio(0); } while (0)
#define PG8_WAIT_V(n) asm volatile("s_waitcnt vmcnt(" #n ")" ::: "memory")
#define PG8_WAIT_L(n) asm volatile("s_waitcnt lgkmcnt(" #n ")" ::: "memory")
#define PG8_BAR __builtin_amdgcn_s_barrier()
#define PG8_SCHED __builtin_amdgcn_sched_barrier(0)
    Unit cur, nxt; int ui = 0;
    if (!S.next(0, cur)) return;
    f32x4 acc[2][2][4][2];
#pragma unroll
    for (int a = 0; a < 2; ++a)
#pragma unroll
        for (int b = 0; b < 2; ++b)
#pragma unroll
            for (int m = 0; m < 4; ++m)
#pragma unroll
                for (int n = 0; n < 2; ++n) acc[a][b][m][n] = (f32x4){0.f, 0.f, 0.f, 0.f};
    bf16x8 At[4][2], B0[2][2], B1[2][2];
    unsigned cA = (unsigned)cur.z * g.zA + (unsigned)cur.pm * tstepA, cB = (unsigned)cur.z * g.zB + (unsigned)cur.pn * tstepB;
    PG8_STAGE(PG8_SB(0, 0), gB, cB, voffB); PG8_STAGE(PG8_SA(0, 0), gA, cA, voffA); PG8_STAGE(PG8_SB(0, 1), gB, cB + hstepB, voffB); PG8_STAGE(PG8_SA(0, 1), gA, cA + hstepA, voffA);
    if (wr == 1) PG8_BAR;
    PG8_WAIT_V(4); PG8_BAR;
    PG8_STAGE(PG8_SB(1, 0), gB, cB + kstep, voffB); PG8_STAGE(PG8_SA(1, 0), gA, cA + kstep, voffA); PG8_STAGE(PG8_SB(1, 1), gB, cB + hstepB + kstep, voffB);
    PG8_WAIT_V(6); PG8_BAR;
    for (;;) {
        const bool has_next = S.next(ui + 1, nxt);
        const unsigned nA = has_next ? (unsigned)nxt.z * g.zA + (unsigned)nxt.pm * tstepA : cA, nB = has_next ? (unsigned)nxt.z * g.zB + (unsigned)nxt.pn * tstepB : cB;
        for (int t = 0; t < nt; t += 2) {
            const bool last = (t == nt - 2);
            const unsigned a1 = cA + (unsigned)(t + 1) * kstep;
            const unsigned a2 = last ? nA : cA + (unsigned)(t + 2) * kstep, b2 = last ? nB : cB + (unsigned)(t + 2) * kstep;
            const unsigned a3 = a2 + kstep, b3 = b2 + kstep;
            PG8_LDB(B0, 0, 0); PG8_SCHED; PG8_LDA(At, 0, 0); PG8_STAGE(PG8_SA(1, 1), gA, a1 + hstepA, voffA);
            PG8_WAIT_L(8); PG8_BAR; PG8_WAIT_L(0); PG8_MMA(0, 0, At, B0); PG8_BAR; PG8_SCHED;
            PG8_LDB(B1, 0, 1); PG8_STAGE(PG8_SB(0, 0), gB, b2, voffB);
            PG8_BAR; PG8_WAIT_L(0); PG8_MMA(0, 1, At, B1); PG8_BAR;
            PG8_LDA(At, 0, 1); PG8_STAGE(PG8_SA(0, 0), gA, a2, voffA);
            PG8_BAR; PG8_WAIT_L(0); PG8_MMA(1, 0, At, B0); PG8_BAR; PG8_SCHED;
            PG8_STAGE(PG8_SB(0, 1), gB, b2 + hstepB, voffB);
            PG8_WAIT_V(6); PG8_BAR; PG8_MMA(1, 1, At, B1); PG8_BAR;
            PG8_LDB(B0, 1, 0); PG8_SCHED; PG8_LDA(At, 1, 0); PG8_STAGE(PG8_SA(0, 1), gA, a2 + hstepA, voffA);
            PG8_WAIT_L(8); PG8_BAR; PG8_WAIT_L(0); PG8_MMA(0, 0, At, B0); PG8_BAR; PG8_SCHED;
            PG8_LDB(B1, 1, 1); PG8_STAGE(PG8_SB(1, 0), gB, b3, voffB);
            PG8_BAR; PG8_WAIT_L(0); PG8_MMA(0, 1, At, B1); PG8_BAR;
            PG8_LDA(At, 1, 1); PG8_STAGE(PG8_SA(1, 0), gA, a3, voffA);
            PG8_BAR; PG8_WAIT_L(0); PG8_MMA(1, 0, At, B0); PG8_BAR; PG8_SCHED;
            PG8_STAGE(PG8_SB(1, 1), gB, b3 + hstepB, voffB);
            PG8_WAIT_V(6); PG8_BAR; PG8_MMA(1, 1, At, B1); PG8_BAR;
        }
        E(acc, cur, wr, wc, fr, fq);
        if (!has_next) break;
#pragma unroll
        for (int a = 0; a < 2; ++a)
#pragma unroll
            for (int b = 0; b < 2; ++b)
#pragma unroll
                for (int m = 0; m < 4; ++m)
#pragma unroll
                    for (int n = 0; n < 2; ++n) acc[a][b][m][n] = (f32x4){0.f, 0.f, 0.f, 0.f};
        cur = nxt; cA = nA; cB = nB; ++ui;
    }
    PG8_WAIT_V(0);
    if (wr == 0) PG8_BAR;
    PG8_BAR;
#undef PG8_SA
#undef PG8_SB
#undef PG8_STAGE
#undef PG8_LDA
#undef PG8_LDB
#undef PG8_MMA
#undef PG8_WAIT_V
#undef PG8_WAIT_L
#undef PG8_BAR
#undef PG8_SCHED
}
}
using pg8::Unit;
typedef f32x4 Acc[2][2][4][2];

struct EpiFFNa { static constexpr bool PERM = false; bf16_t* H; const float* ss;
    __device__ __forceinline__ void operator()(const Acc& acc, const Unit& u, int wr, int wc, int fr, int fq) const {
        const int row0 = u.pm * 256 + wr * 64 + fr, hc0 = u.pn * 128 + wc * 16 + 4 * fq;
#pragma unroll
        for (int ai = 0; ai < 2; ++ai)
#pragma unroll
            for (int m = 0; m < 4; ++m) { const int row = row0 + ai * 128 + m * 16; const float rs = row_rstd(ss, row);
#pragma unroll
                for (int bj = 0; bj < 2; ++bj) { const f32x4 gt = acc[ai][bj][m][0] * rs, up = acc[ai][bj][m][1] * rs; f32x4 h;
#pragma unroll
                    for (int j = 0; j < 4; ++j) h[j] = gt[j] * sigmoidf_(gt[j]) * up[j];
                    st_bf4(H + (size_t)row * FF + hc0 + bj * 64, h); } }
    }
};
struct EpiRes { static constexpr bool PERM = false; const float* xin; float* xout; bf16_t* xb; float* ss_out; float scale;
    __device__ __forceinline__ void operator()(const Acc& acc, const Unit& u, int wr, int wc, int fr, int fq) const {
        const int row0 = u.pm * 256 + wr * 64 + fr, col0 = u.pn * 256 + wc * 32 + 4 * fq;
#pragma unroll
        for (int ai = 0; ai < 2; ++ai)
#pragma unroll
            for (int m = 0; m < 4; ++m) { const int row = row0 + ai * 128 + m * 16; float q = 0.f;
#pragma unroll
                for (int bj = 0; bj < 2; ++bj)
#pragma unroll
                    for (int n = 0; n < 2; ++n) { const size_t o = (size_t)row * D + col0 + bj * 128 + n * 16; const f32x4 v = *(const f32x4*)(xin + o) + acc[ai][bj][m][n] * scale;
                        *(f32x4*)(xout + o) = v; st_bf4(xb + o, v); q += (v[0] * v[0] + v[1] * v[1]) + (v[2] * v[2] + v[3] * v[3]); }
                q += __shfl_xor(q, 16); q += __shfl_xor(q, 32);
                if (fq == 0) ss_out[(size_t)row * 16 + u.pn * 4 + wc] = q; }
    }
};
struct EpiU { static constexpr bool PERM = true; bf16_t* Ubase; const float* ss;
    __device__ __forceinline__ void operator()(const Acc& acc, const Unit& u, int wr, int wc, int fr, int fq) const {
        bf16_t* base; int ld, c0;
        if (u.pn < 7) { base = (bf16_t*)((char*)Ubase + U_RWKV); ld = 1792; c0 = u.pn * 256; }
        else if (u.pn < 14) { base = (bf16_t*)((char*)Ubase + U_GLA); ld = 1792; c0 = (u.pn - 7) * 256; }
        else { base = (bf16_t*)((char*)Ubase + U_XA); ld = 512; c0 = (u.pn - 14) * 256; }
        const int row0 = u.pm * 256 + wr * 64 + fr; c0 += wc * 32 + 8 * fq;
#pragma unroll
        for (int ai = 0; ai < 2; ++ai)
#pragma unroll
            for (int m = 0; m < 4; ++m) { const int row = row0 + ai * 128 + m * 16; const float rs = row_rstd(ss, row);
#pragma unroll
                for (int bj = 0; bj < 2; ++bj) { const f32x4 v0 = acc[ai][bj][m][0] * rs, v1 = acc[ai][bj][m][1] * rs; u32x4 w;
                    w.x = cvt_pk_bf16(v0[0], v0[1]); w.y = cvt_pk_bf16(v0[2], v0[3]); w.z = cvt_pk_bf16(v1[0], v1[1]); w.w = cvt_pk_bf16(v1[2], v1[3]);
                    *(u32x4*)(base + (size_t)row * ld + c0 + bj * 128) = w; } }
    }
};
struct EpiGate { static constexpr bool PERM = true; bf16_t* Gt; const float* ss;
    __device__ __forceinline__ void operator()(const Acc& acc, const Unit& u, int wr, int wc, int fr, int fq) const {
        const int row0 = u.pm * 256 + wr * 64 + fr, c0 = u.pn * 256 + wc * 32 + 8 * fq;
#pragma unroll
        for (int ai = 0; ai < 2; ++ai)
#pragma unroll
            for (int m = 0; m < 4; ++m) { const int row = row0 + ai * 128 + m * 16; const float rs = row_rstd(ss, row);
#pragma unroll
                for (int bj = 0; bj < 2; ++bj) { f32x4 v0 = acc[ai][bj][m][0] * rs, v1 = acc[ai][bj][m][1] * rs;
#pragma unroll
                    for (int j = 0; j < 4; ++j) { v0[j] = sigmoidf_(v0[j]); v1[j] = sigmoidf_(v1[j]); }
                    u32x4 w; w.x = cvt_pk_bf16(v0[0], v0[1]); w.y = cvt_pk_bf16(v0[2], v0[3]); w.z = cvt_pk_bf16(v1[0], v1[1]); w.w = cvt_pk_bf16(v1[2], v1[3]);
                    *(u32x4*)(Gt + (size_t)row * 3072 + c0 + bj * 128) = w; } }
    }
};
struct EpiMerge { static constexpr bool PERM = false; const bf16_t* Gt; float* Mg; bf16_t* Mb;
    __device__ __forceinline__ void operator()(const Acc& acc, const Unit& u, int wr, int wc, int fr, int fq) const {
        const int row0 = u.pm * 256 + wr * 64 + fr, col0 = u.pn * 256 + wc * 32 + 4 * fq;
#pragma unroll
        for (int ai = 0; ai < 2; ++ai)
#pragma unroll
            for (int m = 0; m < 4; ++m) { const int row = row0 + ai * 128 + m * 16;
#pragma unroll
                for (int bj = 0; bj < 2; ++bj)
#pragma unroll
                    for (int n = 0; n < 2; ++n) { const int col = col0 + bj * 128 + n * 16; const size_t o = (size_t)row * D + col;
                        f32x4 v = acc[ai][bj][m][n] * ld_bf4(Gt + (size_t)row * 3072 + u.z * 1024 + col);
                        if (u.z > 0) v += *(const f32x4*)(Mg + o);
                        if (u.z < 2) *(f32x4*)(Mg + o) = v; else st_bf4(Mb + o, v); } }
    }
};
struct EpiKV { static constexpr bool PERM = false; bf16_t* Kb; bf16_t* Vt; const float* rstd;
    __device__ __forceinline__ void operator()(const Acc& acc, const Unit& u, int wr, int wc, int fr, int fq) const {
        const int row0 = u.pm * 256 + wr * 64 + fr, col0 = u.pn * 256 + wc * 32 + 4 * fq;
#pragma unroll
        for (int ai = 0; ai < 2; ++ai)
#pragma unroll
            for (int m = 0; m < 4; ++m) { const int row = row0 + ai * 128 + m * 16; const float rs = rstd[row];
#pragma unroll
                for (int bj = 0; bj < 2; ++bj)
#pragma unroll
                    for (int n = 0; n < 2; ++n) { const int col = col0 + bj * 128 + n * 16; const f32x4 v = acc[ai][bj][m][n] * rs;
                        if (col < 512) st_bf4(Kb + (size_t)row * 512 + col, v);
                        else {
#pragma unroll
                            for (int j = 0; j < 4; ++j) Vt[((size_t)(row >> 8) * 512 + (col - 512 + j)) * 256 + (row & 255)] = f2bf(v[j]); } } }
    }
};

template <int MAP> __device__ __forceinline__ int colmap(int n) {
    if (MAP == 1) { const int g = n >> 5, i = n & 31; return i < 16 ? 16 * g + i : FF + 16 * g + (i - 16); }
    if (MAP == 2) { if (n < 3344) return n; if (n < 3584) return -1; return n - 240; }
    return n;
}
template <int MAP>
__device__ __forceinline__ void convT(LAS unsigned char* lds, const float* src, int ld, int coff, const float* g, bf16_t* dst, int K, int Kd, int Nd, int G, int bid, int tid) {
    const int nkt = (K + 63) >> 6, nnt = (Nd + 63) >> 6, ntile = nkt * nnt;
    LAS bf16_t* tile = (LAS bf16_t*)lds;
    for (int t = bid; t < ntile; t += G) {
        const int kt = t % nkt, ntl = t / nkt, k0 = kt * 64, n0 = ntl * 64;
        { const int nl = tid & 63, kl0 = tid >> 6, n = n0 + nl; const int c = (n < Nd) ? colmap<MAP>(n) : -1;
#pragma unroll
          for (int i = 0; i < 8; ++i) { const int kl = kl0 + 8 * i, k = k0 + kl; float v = 0.f;
              if (c >= 0 && k < K) { v = src[(size_t)k * ld + coff + c]; if (g) v *= g[k]; }
              tile[nl * 72 + kl] = f2bf(v); } }
        __syncthreads();
        { const int nl = tid >> 3, kc = (tid & 7) * 8, n = n0 + nl, k = k0 + kc;
          if (n < Nd && k < Kd) *(u32x4*)(dst + (size_t)n * Kd + k) = *(LAS u32x4*)(tile + nl * 72 + kc); }
        __syncthreads();
    }
}

template <int MAP>
__device__ __forceinline__ void convT_w(const float* src, int ld, int coff, const float* g, bf16_t* dst, int K, int Kd, int Nd, int wslot, int nslots, int lane) {
    const int nkt = K >> 4, nnt = (Nd + 255) >> 8, ntile = nkt * nnt;
    for (int t = wslot; t < ntile; t += nslots) {
        const int kt = t % nkt, ntl = t / nkt, k0 = kt * 16, n = ntl * 256 + lane * 4; const int c = (n < Nd) ? colmap<MAP>(n) : -1;
        const float* sp = src + (size_t)k0 * ld + coff + (c >= 0 ? c : 0);
        f32x4 v[16];
#pragma unroll
        for (int kk = 0; kk < 16; ++kk) { v[kk] = *(const f32x4*)(sp + (size_t)kk * ld); if (g) v[kk] *= g[k0 + kk]; if (c < 0) v[kk] = (f32x4){0.f, 0.f, 0.f, 0.f}; }
        if (n < Nd) {
#pragma unroll
            for (int j = 0; j < 4; ++j) { u32x4 lo, hi;
                lo.x = cvt_pk_bf16(v[0][j], v[1][j]); lo.y = cvt_pk_bf16(v[2][j], v[3][j]); lo.z = cvt_pk_bf16(v[4][j], v[5][j]); lo.w = cvt_pk_bf16(v[6][j], v[7][j]);
                hi.x = cvt_pk_bf16(v[8][j], v[9][j]); hi.y = cvt_pk_bf16(v[10][j], v[11][j]); hi.z = cvt_pk_bf16(v[12][j], v[13][j]); hi.w = cvt_pk_bf16(v[14][j], v[15][j]);
                bf16_t* dp = dst + (size_t)(n + j) * Kd + k0; *(u32x4*)dp = lo; *(u32x4*)(dp + 8) = hi; }
        }
    }
}

template <int K>
__device__ __forceinline__ void wave_gemm(f32x4 (&acc)[4][4], LAS const unsigned char* A, int sA, const bf16_t* Bt, int fr, int fq) {
#pragma unroll
    for (int m = 0; m < 4; ++m)
#pragma unroll
        for (int n = 0; n < 4; ++n) acc[m][n] = (f32x4){0.f, 0.f, 0.f, 0.f};
#pragma unroll
    for (int ks = 0; ks < K / 32; ++ks) { bf16x8 a[4], b[4];
#pragma unroll
        for (int m = 0; m < 4; ++m) a[m] = *(LAS const bf16x8*)(A + (16 * m + fr) * sA + (ks * 32 + fq * 8) * 2);
#pragma unroll
        for (int n = 0; n < 4; ++n) b[n] = *(const bf16x8*)(Bt + (size_t)(16 * n + fr) * K + ks * 32 + fq * 8);
#pragma unroll
        for (int m = 0; m < 4; ++m)
#pragma unroll
            for (int n = 0; n < 4; ++n) acc[m][n] = mfma16(b[n], a[m], acc[m][n]); }
}

template <int K>
__device__ __forceinline__ void row_gemm(f32x4 (&acc)[4], LAS const unsigned char* Arow, const bf16_t* Bt, int fr, int fq) {
#pragma unroll
    for (int n = 0; n < 4; ++n) acc[n] = (f32x4){0.f, 0.f, 0.f, 0.f};
#pragma unroll
    for (int ks = 0; ks < K / 32; ++ks) { const bf16x8 a = *(LAS const bf16x8*)(Arow + (ks * 32 + fq * 8) * 2);
#pragma unroll
        for (int n = 0; n < 4; ++n) { const bf16x8 b = *(const bf16x8*)(Bt + (size_t)(16 * n + fr) * K + ks * 32 + fq * 8); acc[n] = mfma16(b, a, acc[n]); } }
}

struct PrepArgs { const bf16_t* U; const float *mu, *w0, *a0, *kk_, *ka, *rk, *v0; const bf16_t *w2t, *a2t, *g2t, *v1t, *v2t; float* vfirst; float* Wd; float* V; bf16_t* RKKB; bf16_t* Go; float* Bon; int layer; };

__device__ __forceinline__ f32x4 shifted4(const bf16_t* Ut, bool has_prev, int c, const float* mu) {
    const f32x4 u = ld_bf4(Ut + c); f32x4 p = (f32x4){0.f, 0.f, 0.f, 0.f}; if (has_prev) p = ld_bf4(Ut - 1792 + c);
    const f32x4 m = *(const f32x4*)(mu + c); return u + m * (p - u);
}

__device__ __forceinline__ void rwkv_prep_tile(LAS unsigned char* lds, const PrepArgs& P, int tt, int tid) {
    constexpr int SW = 144, SG = 272, SV = 1040, SVV = 80;
    LAS unsigned char* LAw = lds; LAS unsigned char* LAa = lds + 9216; LAS unsigned char* LAg = lds + 18432; LAS unsigned char* LAv = lds + 35840; LAS unsigned char* LAvv = lds + 102400;
    const int t0 = tt * 64; const int s0 = t0 & (SEQ - 1);
    const int lane = tid & 63, wave = __builtin_amdgcn_readfirstlane(tid >> 6), fr = lane & 15, fq = lane >> 4;
#pragma unroll 2
    for (int e = 0; e < 4; ++e) { const int idx = tid + 512 * e, i = idx >> 5, c = (idx & 31) * 8; const bf16_t* Ut = P.U + (size_t)(t0 + i) * 1792; const bool hp = s0 + i > 0;
        f32x4 x0 = shifted4(Ut, hp, 1536 + c, P.mu), x1 = shifted4(Ut, hp, 1536 + c + 4, P.mu);
        if (c < 64) {
#pragma unroll
            for (int q = 0; q < 4; ++q) { const float ea = __expf(2.f * x0[q]), eb = __expf(2.f * x1[q]); x0[q] = 1.f - 2.f / (ea + 1.f); x1[q] = 1.f - 2.f / (eb + 1.f); } }
        else if (c >= 128) {
#pragma unroll
            for (int q = 0; q < 4; ++q) { x0[q] = sigmoidf_(x0[q]); x1[q] = sigmoidf_(x1[q]); } }
        u32x4 o; o.x = cvt_pk_bf16(x0[0], x0[1]); o.y = cvt_pk_bf16(x0[2], x0[3]); o.z = cvt_pk_bf16(x1[0], x1[1]); o.w = cvt_pk_bf16(x1[2], x1[3]);
        LAS unsigned char* dstp = (c < 64) ? (LAw + i * SW + c * 2) : (c < 128) ? (LAa + i * SW + (c - 64) * 2) : (LAg + i * SG + (c - 128) * 2);
        *(LAS u32x4*)dstp = o; }
    if (P.layer > 0) {
#pragma unroll 2
        for (int e = 0; e < 8; ++e) { const int idx = tid + 512 * e, i = idx >> 6, c = (idx & 63) * 8; const bf16_t* Ut = P.U + (size_t)(t0 + i) * 1792; const bool hp = s0 + i > 0;
            const f32x4 x0 = shifted4(Ut, hp, 1024 + c, P.mu), x1 = shifted4(Ut, hp, 1024 + c + 4, P.mu);
            u32x4 o; o.x = cvt_pk_bf16(x0[0], x0[1]); o.y = cvt_pk_bf16(x0[2], x0[3]); o.z = cvt_pk_bf16(x1[0], x1[1]); o.w = cvt_pk_bf16(x1[2], x1[3]);
            *(LAS u32x4*)(LAv + i * SV + c * 2) = o; }
    }
    __syncthreads();
    if (P.layer > 0) {
        const int mt = wave >> 1, nt = wave & 1; f32x4 acc = (f32x4){0.f, 0.f, 0.f, 0.f};
#pragma unroll 4
        for (int ks = 0; ks < 16; ++ks) { const bf16x8 a = *(LAS const bf16x8*)(LAv + (16 * mt + fr) * SV + (ks * 32 + fq * 8) * 2);
            const bf16x8 b = *(const bf16x8*)(P.v1t + (size_t)(16 * nt + fr) * 512 + ks * 32 + fq * 8); acc = mfma16(b, a, acc); }
        u32x2 w; w.x = cvt_pk_bf16(acc[0], acc[1]); w.y = cvt_pk_bf16(acc[2], acc[3]); *(LAS u32x2*)(LAvv + (16 * mt + fr) * SVV + (16 * nt + 4 * fq) * 2) = w;
    }
    __syncthreads();
    const int h = wave, cb = 64 * h; const int b_ = t0 >> 12, p = b_ * 8 + h;
#pragma unroll 1
    for (int m = 0; m < 4; ++m) {
        const int i = 16 * m + fr; const bf16_t* Ut = P.U + (size_t)(t0 + i) * 1792; const bool hp = (s0 + i) > 0;
        int fq4 = 4 * fq; asm volatile("" : "+v"(fq4));
        f32x4 aa[4], acc[4];
        row_gemm<64>(aa, LAa + i * SW, P.a2t + (size_t)cb * 64, fr, fq);
#pragma unroll
        for (int n = 0; n < 4; ++n) { const f32x4 a0v = *(const f32x4*)(P.a0 + cb + 16 * n + fq4);
#pragma unroll
            for (int j = 0; j < 4; ++j) aa[n][j] = sigmoidf_(aa[n][j] + a0v[j]); }
        row_gemm<64>(acc, LAw + i * SW, P.w2t + (size_t)cb * 64, fr, fq);
#pragma unroll
        for (int n = 0; n < 4; ++n) { const f32x4 w0v = *(const f32x4*)(P.w0 + cb + 16 * n + fq4); f32x4 d;
#pragma unroll
            for (int j = 0; j < 4; ++j) d[j] = __expf(-0.6065306597f * sigmoidf_(acc[n][j] + w0v[j]));
            *(f32x4*)(P.Wd + ((size_t)p * SEQ + s0 + i) * 64 + 16 * n + fq4) = d; }
        row_gemm<128>(acc, LAg + i * SG, P.g2t + (size_t)cb * 128, fr, fq);
#pragma unroll
        for (int n = 0; n < 4; ++n) st_bf4(P.Go + (size_t)(t0 + i) * 512 + cb + 16 * n + fq4, acc[n]);
        asm volatile("" ::: "memory");
        if (P.layer > 0) row_gemm<32>(acc, LAvv + i * SVV, P.v2t + (size_t)cb * 32, fr, fq);
        float bon = 0.f, nk = 0.f; f32x4 kv[4], rv[4];
#pragma unroll
        for (int n = 0; n < 4; ++n) { const int c = cb + 16 * n + fq4;
            f32x4 v = shifted4(Ut, hp, 1024 + c, P.mu);
            if (P.layer > 0) { const f32x4 vf = *(const f32x4*)(P.vfirst + (size_t)(t0 + i) * 512 + c); const f32x4 v0v = *(const f32x4*)(P.v0 + c);
#pragma unroll
                for (int j = 0; j < 4; ++j) v[j] = v[j] + (vf[j] - v[j]) * sigmoidf_(v0v[j] + acc[n][j]); }
            else *(f32x4*)(P.vfirst + (size_t)(t0 + i) * 512 + c) = v;
            *(f32x4*)(P.V + ((size_t)p * SEQ + s0 + i) * 64 + 16 * n + fq4) = v;
            kv[n] = shifted4(Ut, hp, 512 + c, P.mu); rv[n] = shifted4(Ut, hp, c, P.mu);
            const f32x4 kkw = *(const f32x4*)(P.kk_ + c);
#pragma unroll
            for (int j = 0; j < 4; ++j) { const float x = kv[n][j] * kkw[j]; nk += x * x; } }
        nk += __shfl_xor(nk, 16); nk += __shfl_xor(nk, 32);
        const float inv = 1.0f / fmaxf(sqrtf(nk), 1e-12f);
        bf16_t* O = P.RKKB + ((size_t)p * SEQ + s0 + i) * 256;
#pragma unroll
        for (int n = 0; n < 4; ++n) { const int c = cb + 16 * n + fq4; const f32x4 kkw = *(const f32x4*)(P.kk_ + c), kaw = *(const f32x4*)(P.ka + c), rkw = *(const f32x4*)(P.rk + c);
            f32x4 kk, kh, bb;
#pragma unroll
            for (int j = 0; j < 4; ++j) { const float a = aa[n][j]; kk[j] = kv[n][j] * kkw[j] * inv; kh[j] = kv[n][j] * (1.f + (a - 1.f) * kaw[j]); bb[j] = kk[j] * a; bon += rv[n][j] * kh[j] * rkw[j]; }
            const int cc = 16 * n + fq4; st_bf4(O + cc, rv[n]); st_bf4(O + 64 + cc, kh); st_bf4(O + 128 + cc, kk); st_bf4(O + 192 + cc, bb); }
        bon += __shfl_xor(bon, 16); bon += __shfl_xor(bon, 32);
        if (fq == 0) P.Bon[(size_t)(t0 + i) * 8 + h] = bon;
        asm volatile("" ::: "memory");
    }
    __syncthreads();
}

constexpr int SCAN_CH = 32, SCAN_STEP_B = 1344, SCAN_SLOT_B = SCAN_CH * SCAN_STEP_B;
template <int CTRL> __device__ __forceinline__ float dpp_f(float v) { return __int_as_float(__builtin_amdgcn_update_dpp(0, __float_as_int(v), CTRL, 0xf, 0xf, true)); }
__device__ __forceinline__ float row16_sum(float v) { v += dpp_f<0xB1>(v); v += dpp_f<0x4E>(v); v += dpp_f<0x141>(v); v += dpp_f<0x140>(v); return v; }

__device__ __forceinline__ float tr16_sum(const float (&p)[16], int kq) {
    const bool b3 = (kq & 8) != 0, b2 = (kq & 4) != 0, b1 = (kq & 2) != 0, b0 = (kq & 1) != 0;
    float q[8], r[4], u[2];
#pragma unroll
    for (int t = 0; t < 8; ++t) { const float keep = b3 ? p[t + 8] : p[t], send = b3 ? p[t] : p[t + 8]; q[t] = keep + dpp_f<0x140>(send); }
#pragma unroll
    for (int t = 0; t < 4; ++t) { const float keep = b2 ? q[t + 4] : q[t], send = b2 ? q[t] : q[t + 4]; r[t] = keep + dpp_f<0x141>(send); }
#pragma unroll
    for (int t = 0; t < 2; ++t) { const float keep = b1 ? r[t + 2] : r[t], send = b1 ? r[t] : r[t + 2]; u[t] = keep + dpp_f<0x4E>(send); }
    const float keep = b0 ? u[1] : u[0], send = b0 ? u[0] : u[1];
    return keep + dpp_f<0xB1>(send);
}

__device__ __forceinline__ void scan_load_chunk(LAS unsigned char* slot, const float* Wd, const float* V, const bf16_t* RKKB, int p, int rg, int s0, int lt) {
    u32x4 r[7];
    const size_t base = (size_t)p * SEQ + s0;
#pragma unroll
    for (int j = 0; j < 2; ++j) { const int idx = lt + 256 * j, st = idx >> 4, part = idx & 15; r[j] = *(const u32x4*)(Wd + (base + st) * 64 + part * 4); }
#pragma unroll
    for (int j = 2; j < 6; ++j) { const int k = lt + 256 * (j - 2), st = k >> 5, rem = k & 31, q = rem >> 3, part = rem & 7; r[j] = *(const u32x4*)(RKKB + ((base + st) * 4 + q) * 64 + part * 8); }
    if (lt < 128) { const int st = lt >> 2, hf = lt & 3; r[6] = *(const u32x4*)(V + (base + st) * 64 + rg * 16 + hf * 4); }
#pragma unroll
    for (int j = 0; j < 2; ++j) { const int idx = lt + 256 * j, st = idx >> 4, part = idx & 15; *(LAS u32x4*)(slot + st * SCAN_STEP_B + part * 16) = r[j]; }
#pragma unroll
    for (int j = 2; j < 6; ++j) { const int k = lt + 256 * (j - 2), st = k >> 5, rem = k & 31, q = rem >> 3, part = rem & 7; const u32x4 w = r[j];
        const int Q = (q == 0) ? 4 : (q == 1) ? 2 : (q == 2) ? 3 : 1;
        LAS f32x4* d = (LAS f32x4*)(slot + st * SCAN_STEP_B + Q * 256 + part * 32);
        d[0] = (f32x4){bflo(w.x), bfhi(w.x), bflo(w.y), bfhi(w.y)}; d[1] = (f32x4){bflo(w.z), bfhi(w.z), bflo(w.w), bfhi(w.w)}; }
    if (lt < 128) { const int st = lt >> 2, hf = lt & 3; *(LAS u32x4*)(slot + st * SCAN_STEP_B + 1280 + hf * 16) = r[6]; }
}

__device__ __forceinline__ void rwkv_scan_unit(LAS unsigned char* lds, const float* Wd, const float* V, const bf16_t* RKKB, float* Yraw, int p, int rg, int tid) {
    const int lane = tid & 63, wave = __builtin_amdgcn_readfirstlane(tid >> 6);
    constexpr int NCH = SEQ / SCAN_CH;
    scan_load_chunk(lds + (tid >> 8) * SCAN_SLOT_B, Wd, V, RKKB, p, rg, (tid >> 8) * SCAN_CH, tid & 255);
    __syncthreads();
    f32x4 S = (f32x4){0.f, 0.f, 0.f, 0.f};
    const int kq = lane & 15, rl = wave * 4 + (lane >> 4);
    for (int c = 0; c < NCH; ++c) {
        if (wave >= 4) { if (c + 2 < NCH) scan_load_chunk(lds + ((c + 2) % 3) * SCAN_SLOT_B, Wd, V, RKKB, p, rg, (c + 2) * SCAN_CH, tid - 256); }
        else {
            LAS const unsigned char* sl = lds + (c % 3) * SCAN_SLOT_B + kq * 16;
            LAS const unsigned char* vl = lds + (c % 3) * SCAN_SLOT_B + 1280 + rl * 4;
            float* yo = Yraw + ((size_t)p * SEQ + c * SCAN_CH + kq) * 64 + rg * 16 + rl;
            f32x4 w = *(LAS const f32x4*)(sl), b = *(LAS const f32x4*)(sl + 256), k = *(LAS const f32x4*)(sl + 512), kk = *(LAS const f32x4*)(sl + 768), r = *(LAS const f32x4*)(sl + 1024);
            float v = *(LAS const float*)(vl); float yp[16];
#pragma unroll
            for (int st = 0; st < SCAN_CH; ++st) {
                f32x4 wn = w, bn = b, kn = k, kkn = kk, rn = r; float vn = v;
                if (st + 1 < SCAN_CH) { const int o = (st + 1) * SCAN_STEP_B;
                    wn = *(LAS const f32x4*)(sl + o); bn = *(LAS const f32x4*)(sl + o + 256); kn = *(LAS const f32x4*)(sl + o + 512); kkn = *(LAS const f32x4*)(sl + o + 768); rn = *(LAS const f32x4*)(sl + o + 1024);
                    vn = *(LAS const float*)(vl + o); }
                float sa = (S[0] * kk[0] + S[1] * kk[1]) + (S[2] * kk[2] + S[3] * kk[3]);
                const f32x4 kvt = k * v;
                sa = -row16_sum(sa);
                S = S * w + (b * sa + kvt);
                yp[st & 15] = (S[0] * r[0] + S[1] * r[1]) + (S[2] * r[2] + S[3] * r[3]);
                if ((st & 15) == 15) yo[(size_t)(st - 15) * 64] = tr16_sum(yp, kq);
                w = wn; b = bn; k = kn; kk = kkn; r = rn; v = vn;
            }
        }
        __syncthreads();
    }
}

struct GlaArgs { const bf16_t* Ug; const float *conv, *aup, *abias, *gnorm; float* kvcT; float* dec; bf16_t* spT; bf16_t* Yg; };
constexpr int GL_GC = 0;
constexpr int GL_T0 = 16640;
constexpr int GL_VT = GL_T0 + 4 * 9216;
constexpr int GL_AL = GL_VT + 18432;
constexpr int GL_RS = GL_AL + 9216;

__device__ __forceinline__ void gla_conv8(f32x4 (&out)[8], const bf16_t* Ug, const float* conv, int t0, int s0, int i0, int c0) {
    f32x4 w[4];
#pragma unroll
    for (int j = 0; j < 4; ++j) w[j] = *(const f32x4*)(conv + j * 1024 + c0);
#pragma unroll
    for (int e = 0; e < 8; ++e) { const int i = i0 + 8 * e; f32x4 a = (f32x4){0.f, 0.f, 0.f, 0.f};
#pragma unroll
        for (int j = 0; j < 4; ++j) { const int ds = 3 - j; if (s0 + i - ds >= 0) a += w[j] * ld_bf4(Ug + (size_t)(t0 + i - ds) * 1792 + c0); }
#pragma unroll
        for (int q = 0; q < 4; ++q) a[q] = a[q] * sigmoidf_(a[q]);
        out[e] = a; }
}
__device__ __forceinline__ void gla_gcum(LAS unsigned char* lds, const GlaArgs& A, int t0, int h, int tid) {
    LAS float* GC = (LAS float*)(lds + GL_GC);
    { const int d = tid & 63, i0 = tid >> 6; float au[16]; const float ab = A.abias[h * 64 + d];
#pragma unroll
      for (int j = 0; j < 16; ++j) au[j] = A.aup[j * 256 + h * 64 + d];
#pragma unroll
      for (int e = 0; e < 8; ++e) { const int i = i0 + 8 * e; const u32x4* ap = (const u32x4*)(A.Ug + (size_t)(t0 + i) * 1792 + 1024); const u32x4 a0 = ap[0], a1 = ap[1];
          float x = ab;
          x += bflo(a0.x) * au[0] + bfhi(a0.x) * au[1] + bflo(a0.y) * au[2] + bfhi(a0.y) * au[3] + bflo(a0.z) * au[4] + bfhi(a0.z) * au[5] + bflo(a0.w) * au[6] + bfhi(a0.w) * au[7];
          x += bflo(a1.x) * au[8] + bfhi(a1.x) * au[9] + bflo(a1.y) * au[10] + bfhi(a1.y) * au[11] + bflo(a1.z) * au[12] + bfhi(a1.z) * au[13] + bflo(a1.w) * au[14] + bfhi(a1.w) * au[15];
          const float ls = fminf(x, 0.f) - __logf(1.f + __expf(-fabsf(x)));
          GC[i * 65 + d] = ls * (1.0f / 16.0f); } }
    __syncthreads();
    { const int lane = tid & 63, wave = tid >> 6;
#pragma unroll
      for (int dd = 0; dd < 8; ++dd) { const int d = wave * 8 + dd; float x = GC[lane * 65 + d];
#pragma unroll
          for (int o = 1; o < 64; o <<= 1) { const float y = __shfl_up(x, o); if (lane >= o) x += y; }
          GC[lane * 65 + d] = x; } }
    __syncthreads();
}
__device__ __forceinline__ void gla_a_tile(LAS unsigned char* lds, const GlaArgs& A, int tile, int tid) {
    const int bh = tile >> 6, n = tile & 63, b = bh >> 2, h = bh & 3, t0 = b * SEQ + n * 64, s0 = n * 64;
    LAS float* GC = (LAS float*)(lds + GL_GC); LAS bf16_t* KDT = (LAS bf16_t*)(lds + GL_T0); LAS bf16_t* VT = (LAS bf16_t*)(lds + GL_VT);
    gla_gcum(lds, A, t0, h, tid);
    { const int cc = (tid & 63) * 4, i0 = tid >> 6;
      if (cc >= 64) { f32x4 o[8]; const int c0 = (cc < 128) ? 256 + h * 64 + (cc - 64) : 512 + h * 128 + (cc - 128);
          gla_conv8(o, A.Ug, A.conv, t0, s0, i0, c0);
          if (cc < 128) { const int d = cc - 64;
#pragma unroll
              for (int e = 0; e < 8; ++e) { const int i = i0 + 8 * e;
#pragma unroll
                  for (int q = 0; q < 4; ++q) KDT[(d + q) * 72 + i] = f2bf(o[e][q] * __expf(GC[63 * 65 + d + q] - GC[i * 65 + d + q])); } }
          else { const int ev = cc - 128;
#pragma unroll
              for (int e = 0; e < 8; ++e) { const int i = i0 + 8 * e;
#pragma unroll
                  for (int q = 0; q < 4; ++q) VT[(ev + q) * 72 + i] = f2bf(o[e][q]); } } } }
    if (tid < 64) A.dec[((size_t)bh * 64 + n) * 64 + tid] = __expf(GC[63 * 65 + tid]);
    __syncthreads();
    { const int lane = tid & 63, wave = tid >> 6, fr = lane & 15, fq = lane >> 4; f32x4 acc[4];
#pragma unroll
      for (int nt = 0; nt < 4; ++nt) acc[nt] = (f32x4){0.f, 0.f, 0.f, 0.f};
#pragma unroll
      for (int ks = 0; ks < 2; ++ks) { const bf16x8 a = *(LAS const bf16x8*)(VT + (16 * wave + fr) * 72 + ks * 32 + fq * 8);
#pragma unroll
          for (int nt = 0; nt < 4; ++nt) { const bf16x8 bfr = *(LAS const bf16x8*)(KDT + (16 * nt + fr) * 72 + ks * 32 + fq * 8); acc[nt] = mfma16(bfr, a, acc[nt]); } }
#pragma unroll
      for (int nt = 0; nt < 4; ++nt) *(f32x4*)(A.kvcT + (((size_t)bh * 64 + n) * 128 + 16 * wave + fr) * 64 + 16 * nt + 4 * fq) = acc[nt]; }
    __syncthreads();
}
__device__ __forceinline__ void gla_c_tile(LAS unsigned char* lds, const GlaArgs& A, int tile, int tid) {
    const int bh = tile >> 6, n = tile & 63, b = bh >> 2, h = bh & 3, t0 = b * SEQ + n * 64, s0 = n * 64;
    LAS float* GC = (LAS float*)(lds + GL_GC); LAS bf16_t* QG = (LAS bf16_t*)(lds + GL_T0); LAS bf16_t* KG = QG + 64 * 72; LAS bf16_t* QR = KG + 64 * 72; LAS bf16_t* KR = QR + 64 * 72;
    LAS bf16_t* VT = (LAS bf16_t*)(lds + GL_VT); LAS bf16_t* AL = (LAS bf16_t*)(lds + GL_AL); LAS float* RS = (LAS float*)(lds + GL_RS);
    gla_gcum(lds, A, t0, h, tid);
    { const int cc = (tid & 63) * 4, i0 = tid >> 6; f32x4 o[8];
      const int c0 = (cc < 64) ? h * 64 + cc : (cc < 128) ? 256 + h * 64 + (cc - 64) : 512 + h * 128 + (cc - 128);
      gla_conv8(o, A.Ug, A.conv, t0, s0, i0, c0);
      if (cc < 128) { const int d = cc & 63; const bool isq = cc < 64; LAS bf16_t* T1 = isq ? QG : KR; LAS bf16_t* T2 = isq ? QR : KG; const float sc = isq ? 0.125f : 1.0f;
#pragma unroll
          for (int e = 0; e < 8; ++e) { const int i = i0 + 8 * e; f32x4 x1, x2;
#pragma unroll
              for (int q = 0; q < 4; ++q) { const float eg = __expf(GC[i * 65 + d + q]); const float x = o[e][q] * sc; x1[q] = x * eg; x2[q] = x / eg; }
              u32x2 w1, w2; w1.x = cvt_pk_bf16(x1[0], x1[1]); w1.y = cvt_pk_bf16(x1[2], x1[3]); w2.x = cvt_pk_bf16(x2[0], x2[1]); w2.y = cvt_pk_bf16(x2[2], x2[3]);
              *(LAS u32x2*)(T1 + i * 72 + d) = w1; *(LAS u32x2*)(T2 + i * 72 + d) = w2; } }
      else { const int ev = cc - 128;
#pragma unroll
          for (int e = 0; e < 8; ++e) { const int i = i0 + 8 * e;
#pragma unroll
              for (int q = 0; q < 4; ++q) VT[(ev + q) * 72 + i] = f2bf(o[e][q]); } } }
    __syncthreads();
    const int lane = tid & 63, wave = tid >> 6, fr = lane & 15, fq = lane >> 4; const int mt = wave >> 1;
    {
#pragma unroll
        for (int q = 0; q < 2; ++q) { const int nt = (wave & 1) * 2 + q; f32x4 ap = (f32x4){0.f, 0.f, 0.f, 0.f}, af = ap;
#pragma unroll
            for (int ks = 0; ks < 2; ++ks) { const int ko = ks * 32 + fq * 8;
                ap = mfma16(*(LAS const bf16x8*)(KG + (16 * nt + fr) * 72 + ko), *(LAS const bf16x8*)(QG + (16 * mt + fr) * 72 + ko), ap);
                af = mfma16(*(LAS const bf16x8*)(KR + (16 * nt + fr) * 72 + ko), *(LAS const bf16x8*)(QR + (16 * mt + fr) * 72 + ko), af); }
            const int trow = 16 * mt + fr; f32x4 o;
#pragma unroll
            for (int j = 0; j < 4; ++j) { const int scol = 16 * nt + 4 * fq + j; o[j] = (scol <= trow) ? ap[j] : af[j]; }
            u32x2 w; w.x = cvt_pk_bf16(o[0], o[1]); w.y = cvt_pk_bf16(o[2], o[3]); *(LAS u32x2*)(AL + trow * 72 + 16 * nt + 4 * fq) = w; }
    }
    __syncthreads();
    f32x4 acc[4];
#pragma unroll
    for (int q = 0; q < 4; ++q) acc[q] = (f32x4){0.f, 0.f, 0.f, 0.f};
    const bf16_t* sp = A.spT + ((size_t)bh * 64 + n) * 128 * 64;
#pragma unroll
    for (int ks = 0; ks < 2; ++ks) { const int ko = ks * 32 + fq * 8; const bf16x8 a1 = *(LAS const bf16x8*)(AL + (16 * mt + fr) * 72 + ko), a2 = *(LAS const bf16x8*)(QG + (16 * mt + fr) * 72 + ko);
#pragma unroll
        for (int q = 0; q < 4; ++q) { const int nt = (wave & 1) * 4 + q;
            acc[q] = mfma16(*(LAS const bf16x8*)(VT + (16 * nt + fr) * 72 + ko), a1, acc[q]);
            acc[q] = mfma16(*(const bf16x8*)(sp + (size_t)(16 * nt + fr) * 64 + ko), a2, acc[q]); } }
    float ssq = 0.f;
#pragma unroll
    for (int q = 0; q < 4; ++q) ssq += (acc[q][0] * acc[q][0] + acc[q][1] * acc[q][1]) + (acc[q][2] * acc[q][2] + acc[q][3] * acc[q][3]);
    ssq += __shfl_xor(ssq, 16); ssq += __shfl_xor(ssq, 32);
    if (fq == 0) RS[(16 * mt + fr) * 2 + (wave & 1)] = ssq;
    __syncthreads();
    { const int i = 16 * mt + fr; const float rs = rsqrtf((RS[i * 2] + RS[i * 2 + 1]) * (1.0f / 128.0f) + 1e-6f);
#pragma unroll
      for (int q = 0; q < 4; ++q) { const int ecol = h * 128 + ((wave & 1) * 4 + q) * 16 + 4 * fq; const f32x4 nw = *(const f32x4*)(A.gnorm + ecol); const f32x4 go = ld_bf4(A.Ug + (size_t)(t0 + i) * 1792 + 1040 + ecol); f32x4 o;
#pragma unroll
          for (int j = 0; j < 4; ++j) o[j] = acc[q][j] * rs * nw[j] * go[j] * sigmoidf_(go[j]);
          st_bf4(A.Yg + (size_t)(t0 + i) * 512 + ecol, o); } }
    __syncthreads();
}

__device__ __forceinline__ void xa_tile(const bf16_t* Ux, const bf16_t* Kb, const bf16_t* Vt, bf16_t* Yx, int tile, int tid) {
    const int blk = tile & 31, h = (tile >> 5) & 3, b = tile >> 7; const int lane = tid & 63, wave = tid >> 6, fr = lane & 15, fq = lane >> 4;
    const int t = b * SEQ + blk * 128 + 16 * wave + fr;
    bf16x8 qf[4];
#pragma unroll
    for (int ks = 0; ks < 4; ++ks) qf[ks] = *(const bf16x8*)(Ux + (size_t)t * 512 + h * 128 + ks * 32 + fq * 8);
    f32x4 s[16];
#pragma unroll
    for (int nt = 0; nt < 16; ++nt) { s[nt] = (f32x4){0.f, 0.f, 0.f, 0.f}; const bf16_t* kr = Kb + (size_t)(b * 256 + 16 * nt + fr) * 512 + h * 128 + fq * 8;
#pragma unroll
        for (int ks = 0; ks < 4; ++ks) s[nt] = mfma16(*(const bf16x8*)(kr + ks * 32), qf[ks], s[nt]); }
    float mx = -1e30f;
#pragma unroll
    for (int nt = 0; nt < 16; ++nt)
#pragma unroll
        for (int j = 0; j < 4; ++j) mx = fmaxf(mx, s[nt][j]);
    mx = fmaxf(mx, __shfl_xor(mx, 16)); mx = fmaxf(mx, __shfl_xor(mx, 32));
    const float sc = 0.08838834764831845f * 1.4426950408889634f; float l = 0.f;
#pragma unroll
    for (int nt = 0; nt < 16; ++nt)
#pragma unroll
        for (int j = 0; j < 4; ++j) { const float pz = exp2f((s[nt][j] - mx) * sc); s[nt][j] = pz; l += pz; }
    l += __shfl_xor(l, 16); l += __shfl_xor(l, 32);
    f32x4 o[8];
#pragma unroll
    for (int dt = 0; dt < 8; ++dt) o[dt] = (f32x4){0.f, 0.f, 0.f, 0.f};
#pragma unroll
    for (int c = 0; c < 8; ++c) { union { u32x4 u; bf16x8 v; } pf;
        pf.u.x = cvt_pk_bf16(s[2 * c][0], s[2 * c][1]); pf.u.y = cvt_pk_bf16(s[2 * c][2], s[2 * c][3]); pf.u.z = cvt_pk_bf16(s[2 * c + 1][0], s[2 * c + 1][1]); pf.u.w = cvt_pk_bf16(s[2 * c + 1][2], s[2 * c + 1][3]);
#pragma unroll
        for (int dt = 0; dt < 8; ++dt) { const bf16_t* vr = Vt + ((size_t)b * 512 + h * 128 + 16 * dt + fr) * 256 + 32 * c + 4 * fq; union { u32x4 u; bf16x8 v; } vf;
            const u32x2 lo = *(const u32x2*)vr, hi = *(const u32x2*)(vr + 16); vf.u.x = lo.x; vf.u.y = lo.y; vf.u.z = hi.x; vf.u.w = hi.y;
            o[dt] = mfma16(vf.v, pf.v, o[dt]); } }
    const float il = 1.0f / l;
#pragma unroll
    for (int dt = 0; dt < 8; ++dt) st_bf4(Yx + (size_t)t * 512 + h * 128 + 16 * dt + 4 * fq, o[dt] * il);
}

constexpr int XK_STRIDE = 272, XV_STRIDE = 528, XV_OFF = 256 * XK_STRIDE;
__device__ __forceinline__ void xa_pair(LAS unsigned char* lds, const bf16_t* Ux, const bf16_t* Kb, const bf16_t* Vt, bf16_t* Yx, int pair, int tid) {
    const int bh = pair >> 4, b = bh >> 2, h = bh & 3, blk0 = (pair & 15) * 2; const int lane = tid & 63, wave = tid >> 6, fr = lane & 15, fq = lane >> 4;
#pragma unroll
    for (int e = 0; e < 8; ++e) { const int ch = tid + 512 * e; const int key = ch >> 4, part = ch & 15;
        *(LAS u32x4*)(lds + key * XK_STRIDE + part * 16) = *(const u32x4*)(Kb + (size_t)(b * 256 + key) * 512 + h * 128 + part * 8);
        const int dr = ch >> 5, pv = ch & 31;
        *(LAS u32x4*)(lds + XV_OFF + dr * XV_STRIDE + pv * 16) = *(const u32x4*)(Vt + ((size_t)b * 512 + h * 128 + dr) * 256 + pv * 8); }
    __syncthreads();
#pragma unroll 1
    for (int tq = 0; tq < 2; ++tq) {
        const int t = b * SEQ + (blk0 + tq) * 128 + 16 * wave + fr;
        bf16x8 qf[4];
#pragma unroll
        for (int ks = 0; ks < 4; ++ks) qf[ks] = *(const bf16x8*)(Ux + (size_t)t * 512 + h * 128 + ks * 32 + fq * 8);
        f32x4 s[16];
#pragma unroll
        for (int nt = 0; nt < 16; ++nt) { s[nt] = (f32x4){0.f, 0.f, 0.f, 0.f}; LAS const unsigned char* kr = lds + (16 * nt + fr) * XK_STRIDE + fq * 16;
#pragma unroll
            for (int ks = 0; ks < 4; ++ks) s[nt] = mfma16(*(LAS const bf16x8*)(kr + ks * 64), qf[ks], s[nt]);
            if (nt & 1) asm volatile("" ::: "memory"); }
        float mx = -1e30f;
#pragma unroll
        for (int nt = 0; nt < 16; ++nt)
#pragma unroll
            for (int j = 0; j < 4; ++j) mx = fmaxf(mx, s[nt][j]);
        mx = fmaxf(mx, __shfl_xor(mx, 16)); mx = fmaxf(mx, __shfl_xor(mx, 32));
        const float sc = 0.08838834764831845f * 1.4426950408889634f; float l = 0.f;
#pragma unroll
        for (int nt = 0; nt < 16; ++nt)
#pragma unroll
            for (int j = 0; j < 4; ++j) { const float pz = exp2f((s[nt][j] - mx) * sc); s[nt][j] = pz; l += pz; }
        l += __shfl_xor(l, 16); l += __shfl_xor(l, 32);
        f32x4 o[8];
#pragma unroll
        for (int dt = 0; dt < 8; ++dt) o[dt] = (f32x4){0.f, 0.f, 0.f, 0.f};
#pragma unroll
        for (int c = 0; c < 8; ++c) { union { u32x4 u; bf16x8 v; } pf;
            pf.u.x = cvt_pk_bf16(s[2 * c][0], s[2 * c][1]); pf.u.y = cvt_pk_bf16(s[2 * c][2], s[2 * c][3]); pf.u.z = cvt_pk_bf16(s[2 * c + 1][0], s[2 * c + 1][1]); pf.u.w = cvt_pk_bf16(s[2 * c + 1][2], s[2 * c + 1][3]);
#pragma unroll
            for (int dt = 0; dt < 8; ++dt) { LAS const unsigned char* vr = lds + XV_OFF + (16 * dt + fr) * XV_STRIDE + (32 * c + 4 * fq) * 2; union { u32x4 u; bf16x8 v; } vf;
                const u32x2 lo = *(LAS const u32x2*)vr, hi = *(LAS const u32x2*)(vr + 32); vf.u.x = lo.x; vf.u.y = lo.y; vf.u.z = hi.x; vf.u.w = hi.y;
                o[dt] = mfma16(vf.v, pf.v, o[dt]); }
            asm volatile("" ::: "memory"); }
        const float il = 1.0f / l;
#pragma unroll
        for (int dt = 0; dt < 8; ++dt) st_bf4(Yx + (size_t)t * 512 + h * 128 + 16 * dt + 4 * fq, o[dt] * il);
    }
    __syncthreads();
}

struct Params { const float* in[33]; float* out; unsigned char* ws; };

__device__ __forceinline__ int opaque0() { int z = 0; asm volatile("" : "+s"(z)); return z; }
typedef __attribute__((address_space(1))) unsigned char* gptr_t;
typedef __attribute__((address_space(1))) const float* gcf_t;
__device__ __forceinline__ int opqv(int v) { asm volatile("" : "+v"(v)); return v; }
__device__ __forceinline__ int opqs(int v) { asm volatile("" : "+s"(v)); return v; }
#define PH_BEGIN const int zi = opaque0(); unsigned char* ws = P.ws + zi; float* const OUT = P.out + zi; (void)OUT; const int tid = opqv((int)threadIdx.x); const int bid = opqs((int)blockIdx.x); const int G = opqs((int)gridDim.x); (void)tid; (void)bid; (void)G; unsigned char* WB = ws + WS_WB; float* SS = (float*)(ws + WS_SS); (void)WB; (void)SS; (void)zi;
#define INP(k) (P.in[(k)] + zi)
#define XB_ ((bf16_t*)(ws + WS_XB))
#define U_ (ws + WS_U)
#define SC_ (ws + WS_SC)
#define Y_ ((bf16_t*)(ws + WS_Y))
#define KB_ ((bf16_t*)(ws + WS_KB))
#define VT_ ((bf16_t*)(ws + WS_VT))

constexpr size_t WS_BAR = WS_MISC + 8192;
__device__ __forceinline__ void grid_bar(unsigned* ctr, unsigned target) {
    asm volatile("s_waitcnt vmcnt(0)" ::: "memory");
    __syncthreads();
    if (threadIdx.x == 0) {
        __builtin_amdgcn_fence(__ATOMIC_RELEASE, "agent");
        asm volatile("s_waitcnt vmcnt(0)" ::: "memory");
        __hip_atomic_fetch_add(ctr, 1u, __ATOMIC_RELAXED, __HIP_MEMORY_SCOPE_AGENT);
        while (__hip_atomic_load(ctr, __ATOMIC_RELAXED, __HIP_MEMORY_SCOPE_AGENT) < target) __builtin_amdgcn_s_sleep(2);
        __builtin_amdgcn_fence(__ATOMIC_ACQUIRE, "agent");
        asm volatile("s_waitcnt vmcnt(0)" ::: "memory");
    }
    __syncthreads();
}

__global__ void __launch_bounds__(512) mega(Params P) {
    extern __shared__ __attribute__((aligned(16))) unsigned char lds_raw[];
    LAS unsigned char* lds = (LAS unsigned char*)lds_raw;
    cg::grid_group grid = cg::this_grid();

    unsigned nsub = 0;
    for (int ph = 0; ph < NL * 12 + 1; ++ph) {
        const int l = ph / 12, kph = ph - l * 12;
        if (ph == NL * 12) {
#if (PHMASK >> 12) & 1
    { PH_BEGIN
        const int lane = tid & 63, gw = bid * 8 + (tid >> 6), nw = G * 8;
        const float* fn = INP(32); const float* ssf = SS + (size_t)0 * T * 16; float* X = OUT;
        for (int r = gw; r < T; r += nw) { const float rs = row_rstd(ssf, r);
#pragma unroll
            for (int i = 0; i < 4; ++i) { const size_t o = (size_t)r * D + i * 256 + lane * 4; *(f32x4*)(X + o) = *(const f32x4*)(X + o) * rs * *(const f32x4*)(fn + i * 256 + lane * 4); } }
    }
#endif
            break;
        }
        switch (kph) {
        case 0: {
#if (PHMASK >> 0) & 1
        for (int rep = 0; rep < REP0; ++rep) {
        {
            { PH_BEGIN convT_w<1>(INP(3) + (size_t)l * D * 2 * FF, 2 * FF, 0, INP(2) + (size_t)l * D, (bf16_t*)(WB + WB_W1A), D, D, 2 * FF, bid * 8 + (tid >> 6), G * 8, tid & 63); }
            { PH_BEGIN convT_w<0>(INP(4) + (size_t)l * FF * D, D, 0, nullptr, (bf16_t*)(WB + WB_W1B), FF, FF, D, bid * 8 + (tid >> 6), G * 8, tid & 63); }
            { PH_BEGIN convT_w<2>(INP(7) + (size_t)l * D * 6928, 6928, 0, INP(5) + (size_t)l * D, (bf16_t*)(WB + WB_WIN), D, D, 4096, bid * 8 + (tid >> 6), G * 8, tid & 63); }
            { PH_BEGIN convT_w<0>(INP(7) + (size_t)l * D * 6928, 6928, 3856, INP(5) + (size_t)l * D, (bf16_t*)(WB + WB_WG), D, D, 3072, bid * 8 + (tid >> 6), G * 8, tid & 63); }
            for (int j = 0; j < 3; ++j) { PH_BEGIN convT_w<0>(INP(27) + ((size_t)l * 3 + j) * 512 * D, D, 0, nullptr, (bf16_t*)(WB + WB_WBR) + (size_t)j * D * 512, 512, 512, D, bid * 8 + (tid >> 6), G * 8, tid & 63); }
            { PH_BEGIN convT_w<0>(INP(28) + (size_t)l * D * D, D, 0, nullptr, (bf16_t*)(WB + WB_WO), D, D, D, bid * 8 + (tid >> 6), G * 8, tid & 63); }
            { PH_BEGIN convT_w<0>(INP(26) + (size_t)l * D * D, D, 0, INP(6) + (size_t)l * D, (bf16_t*)(WB + WB_WKV), D, D, D, bid * 8 + (tid >> 6), G * 8, tid & 63); }
            { PH_BEGIN convT_w<1>(INP(30) + (size_t)l * D * 2 * FF, 2 * FF, 0, INP(29) + (size_t)l * D, (bf16_t*)(WB + WB_W2A), D, D, 2 * FF, bid * 8 + (tid >> 6), G * 8, tid & 63); }
            { PH_BEGIN convT_w<0>(INP(31) + (size_t)l * FF * D, D, 0, nullptr, (bf16_t*)(WB + WB_W2B), FF, FF, D, bid * 8 + (tid >> 6), G * 8, tid & 63); }
            { PH_BEGIN convT_w<0>(INP(10) + (size_t)l * 64 * 512, 512, 0, nullptr, (bf16_t*)(WB + WB_LW2), 64, 64, 512, bid * 8 + (tid >> 6), G * 8, tid & 63); }
            { PH_BEGIN convT_w<0>(INP(12) + (size_t)l * 64 * 512, 512, 0, nullptr, (bf16_t*)(WB + WB_LA2), 64, 64, 512, bid * 8 + (tid >> 6), G * 8, tid & 63); }
            { PH_BEGIN convT_w<0>(INP(13) + (size_t)l * 128 * 512, 512, 0, nullptr, (bf16_t*)(WB + WB_LG2), 128, 128, 512, bid * 8 + (tid >> 6), G * 8, tid & 63); }
            if (l > 0) {
                { PH_BEGIN convT_w<0>(INP(20) + (size_t)(l - 1) * 512 * 32, 32, 0, nullptr, (bf16_t*)(WB + WB_LV1), 512, 512, 32, bid * 8 + (tid >> 6), G * 8, tid & 63); }
                { PH_BEGIN convT_w<0>(INP(21) + (size_t)(l - 1) * 32 * 512, 512, 0, nullptr, (bf16_t*)(WB + WB_LV2), 32, 32, 512, bid * 8 + (tid >> 6), G * 8, tid & 63); }
            }
            if (l == 0) { PH_BEGIN
                const int lane = tid & 63, gw = bid * 8 + (tid >> 6), nw = G * 8;
                float* rstd_mem = (float*)(ws + WS_MISC); bf16_t* MEMN = (bf16_t*)(ws + WS_MEMN);
                for (int r = gw; r < T + 1024; r += nw) {
                    const bool ism = r >= T; const float* src = ism ? INP(1) + (size_t)(r - T) * D : INP(0) + (size_t)r * D; bf16_t* dst = ism ? MEMN + (size_t)(r - T) * D : XB_ + (size_t)r * D; float q = 0.f;
#pragma unroll
                    for (int i = 0; i < 4; ++i) { const f32x4 v = *(const f32x4*)(src + i * 256 + lane * 4); st_bf4(dst + i * 256 + lane * 4, v); q += (v[0] * v[0] + v[1] * v[1]) + (v[2] * v[2] + v[3] * v[3]); }
                    q = wave_sum(q);
                    if (ism) { if (lane == 0) rstd_mem[r - T] = rsqrtf(q * (1.0f / 1024.0f) + 1e-6f); } else if (lane < 16) SS[(size_t)r * 16 + lane] = (lane == 0) ? q : 0.f;
                }
            }
        }
        }
#endif
        } break;
        case 1: {
#if (PHMASK >> 1) & 1
        for (int rep = 0; rep < REPG; ++rep) {
        { PH_BEGIN
            pg8::Gemm g{XB_, (const bf16_t*)(WB + WB_W1A), T, 2 * FF, D, D, D, 0, 0}; pg8::StaticOrder S; S.init(T, 2 * FF, G, bid, 1);
            EpiFFNa E{(bf16_t*)U_, SS + (size_t)0 * T * 16}; pg8::gemm_phase(lds, g, S, E, tid);
        }
        if ((int)blockIdx.x >= (int)gridDim.x - 16) { PH_BEGIN
            pg8::Gemm g2{(const bf16_t*)(ws + WS_MEMN), (const bf16_t*)(WB + WB_WKV), 1024, D, D, D, D, 0, 0}; pg8::StaticOrder S2; S2.init(1024, D, 16, bid - (G - 16), 1);
            EpiKV E2{KB_, VT_, (const float*)(ws + WS_MISC)}; pg8::gemm_phase(lds, g2, S2, E2, tid);
        }
        }
#endif
        } break;
        case 2: {
#if (PHMASK >> 2) & 1
        { PH_BEGIN
            pg8::Gemm g{(const bf16_t*)U_, (const bf16_t*)(WB + WB_W1B), T, D, FF, FF, FF, 0, 0}; pg8::StaticOrder S; S.init(T, D, G, bid, 1);
            EpiRes E{l == 0 ? INP(0) : OUT, OUT, XB_, SS + (size_t)1 * T * 16, 0.5f}; pg8::gemm_phase(lds, g, S, E, tid);
        }
#endif
        } break;
        case 3: {
#if (PHMASK >> 3) & 1
        for (int rep = 0; rep < REPG; ++rep) {
        { PH_BEGIN
            pg8::Gemm g{XB_, (const bf16_t*)(WB + WB_WIN), T, 4096, D, D, D, 0, 0}; pg8::StaticOrder S; S.init(T, 4096, G, bid, 1);
            EpiU E{(bf16_t*)U_, SS + (size_t)1 * T * 16}; pg8::gemm_phase(lds, g, S, E, tid);
        }
        }
#endif
        } break;
        case 4: {
#if (PHMASK >> 4) & 1
        { PH_BEGIN
            PrepArgs PA; PA.U = (const bf16_t*)(U_ + U_RWKV); PA.mu = INP(8) + (size_t)l * 1792; PA.w0 = INP(9) + (size_t)l * 512; PA.a0 = INP(11) + (size_t)l * 512;
            PA.kk_ = INP(14) + (size_t)l * 512; PA.ka = INP(15) + (size_t)l * 512; PA.rk = INP(16) + (size_t)l * 512; PA.v0 = INP(19) + (size_t)(l > 0 ? l - 1 : 0) * 512;
            PA.w2t = (const bf16_t*)(WB + WB_LW2); PA.a2t = (const bf16_t*)(WB + WB_LA2); PA.g2t = (const bf16_t*)(WB + WB_LG2); PA.v1t = (const bf16_t*)(WB + WB_LV1); PA.v2t = (const bf16_t*)(WB + WB_LV2);
            PA.vfirst = (float*)(ws + WS_VF); PA.Wd = (float*)(SC_ + SC_WD); PA.V = (float*)(SC_ + SC_V); PA.RKKB = (bf16_t*)(SC_ + SC_RKKB); PA.Go = (bf16_t*)(ws + WS_GO); PA.Bon = (float*)(ws + WS_BON); PA.layer = l;
            for (int tt = bid; tt < 256; tt += G) rwkv_prep_tile(lds, PA, tt, tid);
        }
        { PH_BEGIN
            for (int pair = bid; pair < 256; pair += G) xa_pair(lds, (const bf16_t*)(U_ + U_XA), KB_, VT_, Y_ + (size_t)2 * T * 512, pair, tid);
        }
#endif
        } break;
        case 5: {
#if (PHMASK >> 5) & 1
        if ((int)blockIdx.x < 128) { PH_BEGIN
            const int xcd = bid & 7, j = bid >> 3, p = xcd * 4 + (j >> 2), rg = j & 3;
            rwkv_scan_unit(lds, (const float*)(SC_ + SC_WD), (const float*)(SC_ + SC_V), (const bf16_t*)(SC_ + SC_RKKB), (float*)(U_ + U_YRAW), p, rg, tid);
        } else {
            { PH_BEGIN
            GlaArgs GA; GA.Ug = (const bf16_t*)(U_ + U_GLA); GA.conv = INP(22) + (size_t)l * 4096; GA.aup = INP(23) + (size_t)l * 4096; GA.abias = INP(24) + (size_t)l * 256; GA.gnorm = INP(25) + (size_t)l * 512;
            GA.kvcT = (float*)(ws + WS_KVC); GA.dec = (float*)(ws + WS_DEC); GA.spT = (bf16_t*)(U_ + U_SPT); GA.Yg = Y_ + (size_t)T * 512;
            for (int tile = bid - 128; tile < 1024; tile += 128) gla_a_tile(lds, GA, tile, tid);
            }
            ++nsub; grid_bar((unsigned*)(P.ws + WS_BAR + 128), nsub * 128u);
            { PH_BEGIN
            bf16_t* spT = (bf16_t*)(U_ + U_SPT); const float* DEC = (const float*)(ws + WS_DEC); const float* KVC = (const float*)(ws + WS_KVC);
            for (int i = (bid - 128) * 512 + tid; i < 16 * 128 * 64; i += 128 * 512) { const int bh = i >> 13, ed = i & 8191, d = i & 63; float st = 0.f;
                for (int n0 = 0; n0 < 64; n0 += 16) { float kv[16], dc[16];
#pragma unroll
                    for (int q = 0; q < 16; ++q) { kv[q] = KVC[((size_t)bh * 64 + n0 + q) * 8192 + ed]; dc[q] = DEC[((size_t)bh * 64 + n0 + q) * 64 + d]; }
#pragma unroll
                    for (int q = 0; q < 16; ++q) { spT[((size_t)bh * 64 + n0 + q) * 8192 + ed] = f2bf(st); st = st * dc[q] + kv[q]; } } }
            }
            ++nsub; grid_bar((unsigned*)(P.ws + WS_BAR + 128), nsub * 128u);
            { PH_BEGIN
            GlaArgs GA; GA.Ug = (const bf16_t*)(U_ + U_GLA); GA.conv = INP(22) + (size_t)l * 4096; GA.aup = INP(23) + (size_t)l * 4096; GA.abias = INP(24) + (size_t)l * 256; GA.gnorm = INP(25) + (size_t)l * 512;
            GA.kvcT = (float*)(ws + WS_KVC); GA.dec = (float*)(ws + WS_DEC); GA.spT = (bf16_t*)(U_ + U_SPT); GA.Yg = Y_ + (size_t)T * 512;
            for (int tile = bid - 128; tile < 1024; tile += 128) gla_c_tile(lds, GA, tile, tid);
            }
        }
#endif
        } break;
        case 6: {
#if (PHMASK >> 6) & 1
        { PH_BEGIN
            const int lane = tid & 63, gw = bid * 8 + (tid >> 6), nw = G * 8;
            const float* lnw = INP(17) + (size_t)l * 512; const float* lnb = INP(18) + (size_t)l * 512; const float* Yraw = (const float*)(U_ + U_YRAW); const float* Vv = (const float*)(SC_ + SC_V);
            const float* BON = (const float*)(ws + WS_BON); const bf16_t* GO = (const bf16_t*)(ws + WS_GO); bf16_t* Y = Y_;
            const int kq = lane & 15, sub = lane >> 4;
#pragma unroll 4
            for (int it0 = gw * 4; it0 < 32 * SEQ; it0 += nw * 4) { const int it = it0 + sub; const int p = it >> 12, s = it & (SEQ - 1), b = p >> 3, h = p & 7, t = b * SEQ + s;
                const f32x4 y = *(const f32x4*)(Yraw + (size_t)it * 64 + kq * 4); const f32x4 vv = *(const f32x4*)(Vv + (size_t)it * 64 + kq * 4);
                const f32x4 gg = ld_bf4(GO + (size_t)t * 512 + h * 64 + kq * 4); const f32x4 lw = *(const f32x4*)(lnw + h * 64 + kq * 4), lb = *(const f32x4*)(lnb + h * 64 + kq * 4); const float bon = BON[(size_t)t * 8 + h];
                const float mean = row16_sum((y[0] + y[1]) + (y[2] + y[3])) * (1.0f / 64.0f); const f32x4 dl = y - mean;
                const float var = row16_sum((dl[0] * dl[0] + dl[1] * dl[1]) + (dl[2] * dl[2] + dl[3] * dl[3])) * (1.0f / 64.0f); const float rs = rsqrtf(var + 64e-5f);
                st_bf4(Y + (size_t)t * 512 + h * 64 + kq * 4, ((dl * rs) * lw + lb + vv * bon) * gg); }
        }
#endif
        } break;
        case 7: {
#if (PHMASK >> 7) & 1
        for (int rep = 0; rep < REPG; ++rep) {
        { PH_BEGIN
            pg8::Gemm g{XB_, (const bf16_t*)(WB + WB_WG), T, 3072, D, D, D, 0, 0}; pg8::StaticOrder S; S.init(T, 3072, G, bid, 1);
            EpiGate E{(bf16_t*)SC_, SS + (size_t)1 * T * 16}; pg8::gemm_phase(lds, g, S, E, tid);
        }
        }
#endif
        } break;
        case 8: {
#if (PHMASK >> 8) & 1
        for (int rep = 0; rep < REPG; ++rep) {
        { PH_BEGIN
            pg8::Gemm g{Y_, (const bf16_t*)(WB + WB_WBR), T, D, 512, 512, 512, (unsigned)T * 512u * 2u, (unsigned)D * 512u * 2u}; pg8::StaticOrder S; S.init(T, D, G, bid, 3);
            EpiMerge E{(const bf16_t*)SC_, (float*)(U_ + U_MG), (bf16_t*)(U_ + U_MGB)}; pg8::gemm_phase(lds, g, S, E, tid);
        }
        }
#endif
        } break;
        case 9: {
#if (PHMASK >> 9) & 1
        { PH_BEGIN
            pg8::Gemm g{(const bf16_t*)(U_ + U_MGB), (const bf16_t*)(WB + WB_WO), T, D, D, D, D, 0, 0}; pg8::StaticOrder S; S.init(T, D, G, bid, 1);
            EpiRes E{OUT, OUT, XB_, SS + (size_t)2 * T * 16, 1.0f}; pg8::gemm_phase(lds, g, S, E, tid);
        }
#endif
        } break;
        case 10: {
#if (PHMASK >> 10) & 1
        for (int rep = 0; rep < REPG; ++rep) {
        { PH_BEGIN
            pg8::Gemm g{XB_, (const bf16_t*)(WB + WB_W2A), T, 2 * FF, D, D, D, 0, 0}; pg8::StaticOrder S; S.init(T, 2 * FF, G, bid, 1);
            EpiFFNa E{(bf16_t*)U_, SS + (size_t)2 * T * 16}; pg8::gemm_phase(lds, g, S, E, tid);
        }
        }
#endif
        } break;
        case 11: {
#if (PHMASK >> 11) & 1
        { PH_BEGIN
            pg8::Gemm g{(const bf16_t*)U_, (const bf16_t*)(WB + WB_W2B), T, D, FF, FF, FF, 0, 0}; pg8::StaticOrder S; S.init(T, D, G, bid, 1);
            EpiRes E{OUT, OUT, XB_, SS + (size_t)0 * T * 16, 0.5f}; pg8::gemm_phase(lds, g, S, E, tid);
        }
#endif
        } break;
        default: break;
        }
        if (ph == 0) grid.sync();
        else grid_bar((unsigned*)(P.ws + WS_BAR), (unsigned)ph * gridDim.x);
    }
}

extern "C" void kernel_launch(void* const* d_in, const int* in_sizes, int n_in, void* d_out, int out_size, void* d_ws, size_t ws_size, hipStream_t stream) {
    static int grid_blocks = 0;
    if (!grid_blocks) {
        if (n_in != 33 || ws_size < WS_END) { fprintf(stderr, "kernel_launch: need 33 inputs and %zu bytes of workspace (got %d, %zu)\n", (size_t)WS_END, n_in, ws_size); grid_blocks = -1; return; }
        int dev = 0, cus = 0, per_cu = 0;
        hipGetDevice(&dev); hipDeviceGetAttribute(&cus, hipDeviceAttributeMultiprocessorCount, dev);
        if (hipFuncSetAttribute((const void*)mega, hipFuncAttributeMaxDynamicSharedMemorySize, LDS_BYTES) != hipSuccess) { fprintf(stderr, "kernel_launch: hipFuncSetAttribute failed\n"); grid_blocks = -1; return; }
        if (hipOccupancyMaxActiveBlocksPerMultiprocessor(&per_cu, (const void*)mega, 512, LDS_BYTES) != hipSuccess || per_cu < 1) { fprintf(stderr, "kernel_launch: occupancy query says %d\n", per_cu); per_cu = 1; }
        (void)hipGetLastError();
        grid_blocks = cus * per_cu;
        if (grid_blocks != 256) { fprintf(stderr, "kernel_launch: this kernel splits a 256-workgroup grid in its scan phase (got %d)\n", grid_blocks); grid_blocks = -1; return; }
    }
    if (grid_blocks < 0) return;
    if (hipMemsetAsync((char*)d_ws + WS_BAR, 0, 256, stream) != hipSuccess) { fprintf(stderr, "kernel_launch: memset failed\n"); return; }
    Params p{};
    for (int i = 0; i < 33; ++i) p.in[i] = (const float*)d_in[i];
    p.out = (float*)d_out; p.ws = (unsigned char*)d_ws;
    void* args[] = {&p};
    hipError_t e = hipLaunchCooperativeKernel((const void*)mega, dim3(grid_blocks), dim3(512), args, LDS_BYTES, stream);
    if (e != hipSuccess) fprintf(stderr, "cooperative launch failed: %s (grid %d)\n", hipGetErrorString(e), grid_blocks);
}
```

```cpp
#include <hip/hip_runtime.h>
#include <hip/hip_cooperative_groups.h>
#include <cstdio>
namespace cg = cooperative_groups;
#ifndef P4SUB
#define P4SUB 7
#endif
#ifndef REP5
#define REP5 1
#endif
#ifndef REP4
#define REP4 1
#endif
#ifndef REP6
#define REP6 1
#endif
#ifndef REP0
#define REP0 1
#endif
#ifndef REPG
#define REPG 1
#endif
#ifndef REPSYNC
#define REPSYNC 1
#endif
#ifndef NA4
#define NA4 2
#endif
#ifndef PHMASK
#define PHMASK 0xFFFF
#endif

#define LAS __attribute__((address_space(3)))
typedef unsigned short bf16_t;
typedef short bf16x8 __attribute__((ext_vector_type(8)));
typedef float f32x4 __attribute__((ext_vector_type(4)));
typedef float f32x2 __attribute__((ext_vector_type(2)));
typedef unsigned u32x4 __attribute__((ext_vector_type(4)));
typedef unsigned u32x2 __attribute__((ext_vector_type(2)));

constexpr int T = 16384, D = 1024, FF = 2816, SEQ = 4096, NL = 4;
constexpr int LDS_BYTES = 139264;

constexpr size_t MB = 1024 * 1024;
constexpr size_t WS_MISC = 0;
constexpr size_t WS_SS = 1 * MB;
constexpr size_t WS_WB = 4 * MB;
constexpr size_t WB_W1A = 0;
constexpr size_t WB_W1B = WB_W1A + (size_t)5632 * 1024 * 2;
constexpr size_t WB_WIN = WB_W1B + (size_t)1024 * 2816 * 2;
constexpr size_t WB_WG = WB_WIN + (size_t)4096 * 1024 * 2;
constexpr size_t WB_WBR = WB_WG + (size_t)3072 * 1024 * 2;
constexpr size_t WB_WO = WB_WBR + (size_t)3 * 1024 * 512 * 2;
constexpr size_t WB_WKV = WB_WO + (size_t)1024 * 1024 * 2;
constexpr size_t WB_W2A = WB_WKV + (size_t)1024 * 1024 * 2;
constexpr size_t WB_W2B = WB_W2A + (size_t)5632 * 1024 * 2;
constexpr size_t WB_LW2 = WB_W2B + (size_t)1024 * 2816 * 2;
constexpr size_t WB_LA2 = WB_LW2 + 512 * 64 * 2;
constexpr size_t WB_LG2 = WB_LA2 + 512 * 64 * 2;
constexpr size_t WB_LV1 = WB_LG2 + 512 * 128 * 2;
constexpr size_t WB_LV2 = WB_LV1 + 32 * 512 * 2;
constexpr size_t WB_END = WB_LV2 + 512 * 32 * 2;
static_assert(WB_END <= 55 * MB, "weights region");
constexpr size_t WS_XB = WS_WB + 55 * MB;
constexpr size_t WS_VF = WS_XB + 32 * MB;
constexpr size_t WS_MEMN = WS_VF + 32 * MB;
constexpr size_t WS_KB = WS_MEMN + 2 * MB;
constexpr size_t WS_VT = WS_KB + 1 * MB;
constexpr size_t WS_GO = WS_VT + 1 * MB;
constexpr size_t WS_BON = WS_GO + 16 * MB;
constexpr size_t WS_Y = WS_BON + 1 * MB;
constexpr size_t WS_KVC = WS_Y + 48 * MB;
constexpr size_t WS_DEC = WS_KVC + 32 * MB;
constexpr size_t WS_SC = WS_DEC + 1 * MB;
constexpr size_t SC_WD = 0;
constexpr size_t SC_V = 32 * MB;
constexpr size_t SC_RKKB = 64 * MB;
constexpr size_t WS_U = WS_SC + 128 * MB;
constexpr size_t U_RWKV = 0;
constexpr size_t U_GLA = (size_t)T * 1792 * 2;
constexpr size_t U_XA = 2 * (size_t)T * 1792 * 2;
constexpr size_t U_YRAW = 0;
constexpr size_t U_SPT = 32 * MB;
constexpr size_t U_MG = 0;
constexpr size_t U_MGB = 64 * MB;
constexpr size_t WS_END = WS_U + 128 * MB;
static_assert(U_XA + (size_t)T * 512 * 2 <= 128 * MB, "U region");

typedef __bf16 bf16x2_t __attribute__((ext_vector_type(2)));
__device__ __forceinline__ unsigned cvt_pk_bf16(float lo, float hi) { const f32x2 v = {lo, hi}; const bf16x2_t r = __builtin_convertvector(v, bf16x2_t); return __builtin_bit_cast(unsigned, r); }
__device__ __forceinline__ bf16_t f2bf(float x) { return (bf16_t)(cvt_pk_bf16(x, 0.f) & 0xffffu); }
__device__ __forceinline__ float bf2f(bf16_t b) { return __uint_as_float(((unsigned)b) << 16); }
__device__ __forceinline__ float bflo(unsigned w) { return __uint_as_float(w << 16); }
__device__ __forceinline__ float bfhi(unsigned w) { return __uint_as_float(w & 0xffff0000u); }
__device__ __forceinline__ f32x4 ld_bf4(const bf16_t* p) { const u32x2 w = *(const u32x2*)p; return (f32x4){bflo(w.x), bfhi(w.x), bflo(w.y), bfhi(w.y)}; }
__device__ __forceinline__ void st_bf4(bf16_t* p, f32x4 v) { u32x2 w; w.x = cvt_pk_bf16(v[0], v[1]); w.y = cvt_pk_bf16(v[2], v[3]); *(u32x2*)p = w; }
__device__ __forceinline__ float sigmoidf_(float x) { return 1.0f / (1.0f + __expf(-x)); }
__device__ __forceinline__ float wave_sum(float v) { for (int o = 32; o >= 1; o >>= 1) v += __shfl_xor(v, o); return v; }
__device__ __forceinline__ f32x4 mfma16(bf16x8 a, bf16x8 b, f32x4 c) { return __builtin_amdgcn_mfma_f32_16x16x32_bf16(a, b, c, 0, 0, 0); }

__device__ __forceinline__ float row_rstd(const float* ssp, int row) {
    const f32x4* p = (const f32x4*)(ssp + (size_t)row * 16); const f32x4 a = p[0], b = p[1], c = p[2], d = p[3];
    const float t = (((a[0] + a[1]) + (a[2] + a[3])) + ((b[0] + b[1]) + (b[2] + b[3]))) + (((c[0] + c[1]) + (c[2] + c[3])) + ((d[0] + d[1]) + (d[2] + d[3])));
    return rsqrtf(t * (1.0f / 1024.0f) + 1e-6f);
}
namespace pg8 {
constexpr int BM = 256, BK = 64, HALF = 128, HTB = HALF * BK * 2, STAGE_BYTES = 8 * HTB, NXCD = 8, WGM = 8;
__device__ __forceinline__ int lds_byte(int r, int c) { const int st = (r >> 4) * 2 + (c >> 5), rr = r & 15, cc = c & 31, ob = rr * 64 + cc * 2; return st * 1024 + (ob ^ (((ob >> 9) & 1) << 5)); }
__device__ __forceinline__ void stage_rc(int b, int& R, int& C) { const int st = b / 1024, sb = b % 1024, swz = sb ^ (((sb >> 9) & 1) << 5); R = (st >> 1) * 16 + swz / 64; C = (st & 1) * 32 + (swz % 64) / 2; }
__device__ __forceinline__ int perm32(int rho) { const int n = rho >> 4, i = rho & 15; return 8 * (i >> 2) + 4 * n + (i & 3); }

struct Unit { int pm, pn, z; };
struct Gemm { const bf16_t* A; const bf16_t* Bt; int M, N, K, lda, ldb; unsigned zA, zB; };

struct StaticOrder {
    int nM, nN, nwg, G, c, nz;
    __device__ void init(int M, int N, int G_, int c_, int nz_) { nM = M / BM; nN = N / BM; nwg = nM * nN; G = G_; c = c_; nz = nz_; }
    __device__ bool next(int i, Unit& u) const {
        const int ti = i / nz; u.z = i - ti * nz;
        const long L = (long)ti * G + c; if (L >= nwg) return false;
        int wgid = (int)L; { const int q = nwg / NXCD, r = nwg % NXCD, xcd = wgid % NXCD, off = wgid / NXCD; wgid = (xcd < r ? xcd * (q + 1) : r * (q + 1) + (xcd - r) * q) + off; }
        const int nig = WGM * nN, gid = wgid / nig, fm = gid * WGM, gsz = (nM - fm) < WGM ? (nM - fm) : WGM;
        u.pm = fm + ((wgid % nig) % gsz); u.pn = (wgid % nig) / gsz; return true;
    }
};

template <class Epi>
__device__ __forceinline__ void gemm_phase(LAS unsigned char* lds, const Gemm g, const StaticOrder& S, const Epi& E, const int tid) {
    const int wid = __builtin_amdgcn_readfirstlane(tid >> 6), lane = tid & 63, wr = wid >> 2, wc = wid & 3, fr = lane & 15, fq = lane >> 4;
    const int K = g.K, nt = K / BK;
    unsigned voffA[2], voffB[2];
#pragma unroll
    for (int i = 0; i < 2; ++i) { int R, C; stage_rc(tid * 16 + i * 8192, R, C); const int Rb = Epi::PERM ? ((R & ~31) + perm32(R & 31)) : R;
        voffA[i] = (unsigned)(R * g.lda + C) * 2u; voffB[i] = (unsigned)(Rb * g.ldb + C) * 2u; }
    const unsigned kstep = (unsigned)(BK * 2);
    const unsigned hstepA = (unsigned)HALF * g.lda * 2u, hstepB = (unsigned)HALF * g.ldb * 2u;
    const unsigned tstepA = 2u * hstepA, tstepB = 2u * hstepB;
    const unsigned ldsw = (unsigned)wid * 1024u;
    const int aoff = lds_byte(wr * 64 + fr, fq * 8), boff = lds_byte(wc * 32 + fr, fq * 8);
    const char* const gA = (const char*)g.A; const char* const gB = (const char*)g.Bt;
#define PG8_SA(b, h) (((b) * 2 + (h)) * HTB)
#define PG8_SB(b, h) ((4 + (b) * 2 + (h)) * HTB)
#define PG8_STAGE(bufoff, gbase, soff, voff) do { _Pragma("unroll") for (int _i = 0; _i < 2; ++_i) \
        __builtin_amdgcn_global_load_lds((const unsigned*)(((gbase) + (size_t)(unsigned)(soff)) + (voff)[_i]), (LAS unsigned*)(lds + (bufoff) + ldsw + _i * 8192), 16, 0, 0); } while (0)
#define PG8_LDA(dst, b, h) do { _Pragma("unroll") for (int m = 0; m < 4; ++m) _Pragma("unroll") for (int k = 0; k < 2; ++k) dst[m][k] = *(const LAS bf16x8*)(lds + PG8_SA(b, h) + aoff + m * 2048 + k * 1024); } while (0)
#define PG8_LDB(dst, b, h) do { _Pragma("unroll") for (int n = 0; n < 2; ++n) _Pragma("unroll") for (int k = 0; k < 2; ++k) dst[n][k] = *(const LAS bf16x8*)(lds + PG8_SB(b, h) + boff + n * 2048 + k * 1024); } while (0)
#define PG8_MMA(ai, bj, At, Bt) do { __builtin_amdgcn_s_setprio(1); _Pragma("unroll") for (int m = 0; m < 4; ++m) _Pragma("unroll") for (int n = 0; n < 2; ++n) _Pragma("unroll") for (int k = 0; k < 2; ++k) \
        acc[ai][bj][m][n] = __builtin_amdgcn_mfma_f32_16x16x32_bf16(Bt[n][k], At[m][k], acc[ai][bj][m][n], 0, 0, 0); __builtin_amdgcn_s_setprio(0); } while (0)
#define PG8_WAIT_V(n) asm volatile("s_waitcnt vmcnt(" #n ")" ::: "memory")
#define PG8_WAIT_L(n) asm volatile("s_waitcnt lgkmcnt(" #n ")" ::: "memory")
#define PG8_BAR __builtin_amdgcn_s_barrier()
#define PG8_SCHED __builtin_amdgcn_sched_barrier(0)
    Unit cur, nxt; int ui = 0;
    if (!S.next(0, cur)) return;
    f32x4 acc[2][2][4][2];
#pragma unroll
    for (int a = 0; a < 2; ++a)
#pragma unroll
        for (int b = 0; b < 2; ++b)
#pragma unroll
            for (int m = 0; m < 4; ++m)
#pragma unroll
                for (int n = 0; n < 2; ++n) acc[a][b][m][n] = (f32x4){0.f, 0.f, 0.f, 0.f};
    bf16x8 At[4][2], B0[2][2], B1[2][2];
    unsigned cA = (unsigned)cur.z * g.zA + (unsigned)cur.pm * tstepA, cB = (unsigned)cur.z * g.zB + (unsigned)cur.pn * tstepB;
    PG8_STAGE(PG8_SB(0, 0), gB, cB, voffB); PG8_STAGE(PG8_SA(0, 0), gA, cA, voffA); PG8_STAGE(PG8_SB(0, 1), gB, cB + hstepB, voffB); PG8_STAGE(PG8_SA(0, 1), gA, cA + hstepA, voffA);
    if (wr == 1) PG8_BAR;
    PG8_WAIT_V(4); PG8_BAR;
    PG8_STAGE(PG8_SB(1, 0), gB, cB + kstep, voffB); PG8_STAGE(PG8_SA(1, 0), gA, cA + kstep, voffA); PG8_STAGE(PG8_SB(1, 1), gB, cB + hstepB + kstep, voffB);
    PG8_WAIT_V(6); PG8_BAR;
    for (;;) {
        const bool has_next = S.next(ui + 1, nxt);
        const unsigned nA = has_next ? (unsigned)nxt.z * g.zA + (unsigned)nxt.pm * tstepA : cA, nB = has_next ? (unsigned)nxt.z * g.zB + (unsigned)nxt.pn * tstepB : cB;
        for (int t = 0; t < nt; t += 2) {
            const bool last = (t == nt - 2);
            const unsigned a1 = cA + (unsigned)(t + 1) * kstep;
            const unsigned a2 = last ? nA : cA + (unsigned)(t + 2) * kstep, b2 = last ? nB : cB + (unsigned)(t + 2) * kstep;
            const unsigned a3 = a2 + kstep, b3 = b2 + kstep;
            PG8_LDB(B0, 0, 0); PG8_SCHED; PG8_LDA(At, 0, 0); PG8_STAGE(PG8_SA(1, 1), gA, a1 + hstepA, voffA);
            PG8_WAIT_L(8); PG8_BAR; PG8_WAIT_L(0); PG8_MMA(0, 0, At, B0); PG8_BAR; PG8_SCHED;
            PG8_LDB(B1, 0, 1); PG8_STAGE(PG8_SB(0, 0), gB, b2, voffB);
            PG8_BAR; PG8_WAIT_L(0); PG8_MMA(0, 1, At, B1); PG8_BAR;
            PG8_LDA(At, 0, 1); PG8_STAGE(PG8_SA(0, 0), gA, a2, voffA);
            PG8_BAR; PG8_WAIT_L(0); PG8_MMA(1, 0, At, B0); PG8_BAR; PG8_SCHED;
            PG8_STAGE(PG8_SB(0, 1), gB, b2 + hstepB, voffB);
            PG8_WAIT_V(6); PG8_BAR; PG8_MMA(1, 1, At, B1); PG8_BAR;
            PG8_LDB(B0, 1, 0); PG8_SCHED; PG8_LDA(At, 1, 0); PG8_STAGE(PG8_SA(0, 1), gA, a2 + hstepA, voffA);
            PG8_WAIT_L(8); PG8_BAR; PG8_WAIT_L(0); PG8_MMA(0, 0, At, B0); PG8_BAR; PG8_SCHED;
            PG8_LDB(B1, 1, 1); PG8_STAGE(PG8_SB(1, 0), gB, b3, voffB);
            PG8_BAR; PG8_WAIT_L(0); PG8_MMA(0, 1, At, B1); PG8_BAR;
            PG8_LDA(At, 1, 1); PG8_STAGE(PG8_SA(1, 0), gA, a3, voffA);
            PG8_BAR; PG8_WAIT_L(0); PG8_MMA(1, 0, At, B0); PG8_BAR; PG8_SCHED;
            PG8_STAGE(PG8_SB(1, 1), gB, b3 + hstepB, voffB);
            PG8_WAIT_V(6); PG8_BAR; PG8_MMA(1, 1, At, B1); PG8_BAR;
        }
        E(acc, cur, wr, wc, fr, fq);
        if (!has_next) break;
#pragma unroll
        for (int a = 0; a < 2; ++a)
#pragma unroll
            for (int b = 0; b < 2; ++b)
#pragma unroll
                for (int m = 0; m < 4; ++m)
#pragma unroll
                    for (int n = 0; n < 2; ++n) acc[a][b][m][n] = (f32x4){0.f, 0.f, 0.f, 0.f};
        cur = nxt; cA = nA; cB = nB; ++ui;
    }
    PG8_WAIT_V(0);
    if (wr == 0) PG8_BAR;
    PG8_BAR;
#undef PG8_SA
#undef PG8_SB
#undef PG8_STAGE
#undef PG8_LDA
#undef PG8_LDB
#undef PG8_MMA
#undef PG8_WAIT_V
#undef PG8_WAIT_L
#undef PG8_BAR
#undef PG8_SCHED
}
}
using pg8::Unit;
typedef f32x4 Acc[2][2][4][2];

struct EpiFFNa { static constexpr bool PERM = false; bf16_t* H; const float* ss;
    __device__ __forceinline__ void operator()(const Acc& acc, const Unit& u, int wr, int wc, int fr, int fq) const {
        const int row0 = u.pm * 256 + wr * 64 + fr, hc0 = u.pn * 128 + wc * 16 + 4 * fq;
#pragma unroll
        for (int ai = 0; ai < 2; ++ai)
#pragma unroll
            for (int m = 0; m < 4; ++m) { const int row = row0 + ai * 128 + m * 16; const float rs = row_rstd(ss, row);
#pragma unroll
                for (int bj = 0; bj < 2; ++bj) { const f32x4 gt = acc[ai][bj][m][0] * rs, up = acc[ai][bj][m][1] * rs; f32x4 h;
#pragma unroll
                    for (int j = 0; j < 4; ++j) h[j] = gt[j] * sigmoidf_(gt[j]) * up[j];
                    st_bf4(H + (size_t)row * FF + hc0 + bj * 64, h); } }
    }
};
struct EpiRes { static constexpr bool PERM = false; const float* xin; float* xout; bf16_t* xb; float* ss_out; float scale;
    __device__ __forceinline__ void operator()(const Acc& acc, const Unit& u, int wr, int wc, int fr, int fq) const {
        const int row0 = u.pm * 256 + wr * 64 + fr, col0 = u.pn * 256 + wc * 32 + 4 * fq;
#pragma unroll
        for (int ai = 0; ai < 2; ++ai)
#pragma unroll
            for (int m = 0; m < 4; ++m) { const int row = row0 + ai * 128 + m * 16; float q = 0.f;
#pragma unroll
                for (int bj = 0; bj < 2; ++bj)
#pragma unroll
                    for (int n = 0; n < 2; ++n) { const size_t o = (size_t)row * D + col0 + bj * 128 + n * 16; const f32x4 v = *(const f32x4*)(xin + o) + acc[ai][bj][m][n] * scale;
                        *(f32x4*)(xout + o) = v; st_bf4(xb + o, v); q += (v[0] * v[0] + v[1] * v[1]) + (v[2] * v[2] + v[3] * v[3]); }
                q += __shfl_xor(q, 16); q += __shfl_xor(q, 32);
                if (fq == 0) ss_out[(size_t)row * 16 + u.pn * 4 + wc] = q; }
    }
};
struct EpiU { static constexpr bool PERM = true; bf16_t* Ubase; const float* ss;
    __device__ __forceinline__ void operator()(const Acc& acc, const Unit& u, int wr, int wc, int fr, int fq) const {
        bf16_t* base; int ld, c0;
        if (u.pn < 7) { base = (bf16_t*)((char*)Ubase + U_RWKV); ld = 1792; c0 = u.pn * 256; }
        else if (u.pn < 14) { base = (bf16_t*)((char*)Ubase + U_GLA); ld = 1792; c0 = (u.pn - 7) * 256; }
        else { base = (bf16_t*)((char*)Ubase + U_XA); ld = 512; c0 = (u.pn - 14) * 256; }
        const int row0 = u.pm * 256 + wr * 64 + fr; c0 += wc * 32 + 8 * fq;
#pragma unroll
        for (int ai = 0; ai < 2; ++ai)
#pragma unroll
            for (int m = 0; m < 4; ++m) { const int row = row0 + ai * 128 + m * 16; const float rs = row_rstd(ss, row);
#pragma unroll
                for (int bj = 0; bj < 2; ++bj) { const f32x4 v0 = acc[ai][bj][m][0] * rs, v1 = acc[ai][bj][m][1] * rs; u32x4 w;
                    w.x = cvt_pk_bf16(v0[0], v0[1]); w.y = cvt_pk_bf16(v0[2], v0[3]); w.z = cvt_pk_bf16(v1[0], v1[1]); w.w = cvt_pk_bf16(v1[2], v1[3]);
                    *(u32x4*)(base + (size_t)row * ld + c0 + bj * 128) = w; } }
    }
};
struct EpiGate { static constexpr bool PERM = true; bf16_t* Gt; const float* ss;
    __device__ __forceinline__ void operator()(const Acc& acc, const Unit& u, int wr, int wc, int fr, int fq) const {
        const int row0 = u.pm * 256 + wr * 64 + fr, c0 = u.pn * 256 + wc * 32 + 8 * fq;
#pragma unroll
        for (int ai = 0; ai < 2; ++ai)
#pragma unroll
            for (int m = 0; m < 4; ++m) { const int row = row0 + ai * 128 + m * 16; const float rs = row_rstd(ss, row);
#pragma unroll
                for (int bj = 0; bj < 2; ++bj) { f32x4 v0 = acc[ai][bj][m][0] * rs, v1 = acc[ai][bj][m][1] * rs;
#pragma unroll
                    for (int j = 0; j < 4; ++j) { v0[j] = sigmoidf_(v0[j]); v1[j] = sigmoidf_(v1[j]); }
                    u32x4 w; w.x = cvt_pk_bf16(v0[0], v0[1]); w.y = cvt_pk_bf16(v0[2], v0[3]); w.z = cvt_pk_bf16(v1[0], v1[1]); w.w = cvt_pk_bf16(v1[2], v1[3]);
                    *(u32x4*)(Gt + (size_t)row * 3072 + c0 + bj * 128) = w; } }
    }
};
struct EpiMerge { static constexpr bool PERM = false; const bf16_t* Gt; float* Mg; bf16_t* Mb;
    __device__ __forceinline__ void operator()(const Acc& acc, const Unit& u, int wr, int wc, int fr, int fq) const {
        const int row0 = u.pm * 256 + wr * 64 + fr, col0 = u.pn * 256 + wc * 32 + 4 * fq;
#pragma unroll
        for (int ai = 0; ai < 2; ++ai)
#pragma unroll
            for (int m = 0; m < 4; ++m) { const int row = row0 + ai * 128 + m * 16;
#pragma unroll
                for (int bj = 0; bj < 2; ++bj)
#pragma unroll
                    for (int n = 0; n < 2; ++n) { const int col = col0 + bj * 128 + n * 16; const size_t o = (size_t)row * D + col;
                        f32x4 v = acc[ai][bj][m][n] * ld_bf4(Gt + (size_t)row * 3072 + u.z * 1024 + col);
                        if (u.z > 0) v += *(const f32x4*)(Mg + o);
                        if (u.z < 2) *(f32x4*)(Mg + o) = v; else st_bf4(Mb + o, v); } }
    }
};
struct EpiKV { static constexpr bool PERM = false; bf16_t* Kb; bf16_t* Vt; const float* rstd;
    __device__ __forceinline__ void operator()(const Acc& acc, const Unit& u, int wr, int wc, int fr, int fq) const {
        const int row0 = u.pm * 256 + wr * 64 + fr, col0 = u.pn * 256 + wc * 32 + 4 * fq;
#pragma unroll
        for (int ai = 0; ai < 2; ++ai)
#pragma unroll
            for (int m = 0; m < 4; ++m) { const int row = row0 + ai * 128 + m * 16; const float rs = rstd[row];
#pragma unroll
                for (int bj = 0; bj < 2; ++bj)
#pragma unroll
                    for (int n = 0; n < 2; ++n) { const int col = col0 + bj * 128 + n * 16; const f32x4 v = acc[ai][bj][m][n] * rs;
                        if (col < 512) st_bf4(Kb + (size_t)row * 512 + col, v);
                        else {
#pragma unroll
                            for (int j = 0; j < 4; ++j) Vt[((size_t)(row >> 8) * 512 + (col - 512 + j)) * 256 + (row & 255)] = f2bf(v[j]); } } }
    }
};

template <int MAP> __device__ __forceinline__ int colmap(int n) {
    if (MAP == 1) { const int g = n >> 5, i = n & 31; return i < 16 ? 16 * g + i : FF + 16 * g + (i - 16); }
    if (MAP == 2) { if (n < 3344) return n; if (n < 3584) return -1; return n - 240; }
    return n;
}
template <int MAP>
__device__ __forceinline__ void convT(LAS unsigned char* lds, const float* src, int ld, int coff, const float* g, bf16_t* dst, int K, int Kd, int Nd, int G, int bid, int tid) {
    const int nkt = (K + 63) >> 6, nnt = (Nd + 63) >> 6, ntile = nkt * nnt;
    LAS bf16_t* tile = (LAS bf16_t*)lds;
    for (int t = bid; t < ntile; t += G) {
        const int kt = t % nkt, ntl = t / nkt, k0 = kt * 64, n0 = ntl * 64;
        { const int nl = tid & 63, kl0 = tid >> 6, n = n0 + nl; const int c = (n < Nd) ? colmap<MAP>(n) : -1;
#pragma unroll
          for (int i = 0; i < 8; ++i) { const int kl = kl0 + 8 * i, k = k0 + kl; float v = 0.f;
              if (c >= 0 && k < K) { v = src[(size_t)k * ld + coff + c]; if (g) v *= g[k]; }
              tile[nl * 72 + kl] = f2bf(v); } }
        __syncthreads();
        { const int nl = tid >> 3, kc = (tid & 7) * 8, n = n0 + nl, k = k0 + kc;
          if (n < Nd && k < Kd) *(u32x4*)(dst + (size_t)n * Kd + k) = *(LAS u32x4*)(tile + nl * 72 + kc); }
        __syncthreads();
    }
}

template <int MAP>
__device__ __forceinline__ void convT_w(const float* src, int ld, int coff, const float* g, bf16_t* dst, int K, int Kd, int Nd, int wslot, int nslots, int lane) {
    const int nkt = K >> 4, nnt = (Nd + 255) >> 8, ntile = nkt * nnt;
    for (int t = wslot; t < ntile; t += nslots) {
        const int kt = t % nkt, ntl = t / nkt, k0 = kt * 16, n = ntl * 256 + lane * 4; const int c = (n < Nd) ? colmap<MAP>(n) : -1;
        const float* sp = src + (size_t)k0 * ld + coff + (c >= 0 ? c : 0);
        f32x4 v[16];
#pragma unroll
        for (int kk = 0; kk < 16; ++kk) { v[kk] = *(const f32x4*)(sp + (size_t)kk * ld); if (g) v[kk] *= g[k0 + kk]; if (c < 0) v[kk] = (f32x4){0.f, 0.f, 0.f, 0.f}; }
        if (n < Nd) {
#pragma unroll
            for (int j = 0; j < 4; ++j) { u32x4 lo, hi;
                lo.x = cvt_pk_bf16(v[0][j], v[1][j]); lo.y = cvt_pk_bf16(v[2][j], v[3][j]); lo.z = cvt_pk_bf16(v[4][j], v[5][j]); lo.w = cvt_pk_bf16(v[6][j], v[7][j]);
                hi.x = cvt_pk_bf16(v[8][j], v[9][j]); hi.y = cvt_pk_bf16(v[10][j], v[11][j]); hi.z = cvt_pk_bf16(v[12][j], v[13][j]); hi.w = cvt_pk_bf16(v[14][j], v[15][j]);
                bf16_t* dp = dst + (size_t)(n + j) * Kd + k0; *(u32x4*)dp = lo; *(u32x4*)(dp + 8) = hi; }
        }
    }
}

template <int K>
__device__ __forceinline__ void wave_gemm(f32x4 (&acc)[4][4], LAS const unsigned char* A, int sA, const bf16_t* Bt, int fr, int fq) {
#pragma unroll
    for (int m = 0; m < 4; ++m)
#pragma unroll
        for (int n = 0; n < 4; ++n) acc[m][n] = (f32x4){0.f, 0.f, 0.f, 0.f};
#pragma unroll
    for (int ks = 0; ks < K / 32; ++ks) { bf16x8 a[4], b[4];
#pragma unroll
        for (int m = 0; m < 4; ++m) a[m] = *(LAS const bf16x8*)(A + (16 * m + fr) * sA + (ks * 32 + fq * 8) * 2);
#pragma unroll
        for (int n = 0; n < 4; ++n) b[n] = *(const bf16x8*)(Bt + (size_t)(16 * n + fr) * K + ks * 32 + fq * 8);
#pragma unroll
        for (int m = 0; m < 4; ++m)
#pragma unroll
            for (int n = 0; n < 4; ++n) acc[m][n] = mfma16(b[n], a[m], acc[m][n]); }
}

template <int K>
__device__ __forceinline__ void row_gemm(f32x4 (&acc)[4], LAS const unsigned char* Arow, const bf16_t* Bt, int fr, int fq) {
#pragma unroll
    for (int n = 0; n < 4; ++n) acc[n] = (f32x4){0.f, 0.f, 0.f, 0.f};
#pragma unroll
    for (int ks = 0; ks < K / 32; ++ks) { const bf16x8 a = *(LAS const bf16x8*)(Arow + (ks * 32 + fq * 8) * 2);
#pragma unroll
        for (int n = 0; n < 4; ++n) { const bf16x8 b = *(const bf16x8*)(Bt + (size_t)(16 * n + fr) * K + ks * 32 + fq * 8); acc[n] = mfma16(b, a, acc[n]); } }
}

struct PrepArgs { const bf16_t* U; const float *mu, *w0, *a0, *kk_, *ka, *rk, *v0; const bf16_t *w2t, *a2t, *g2t, *v1t, *v2t; float* vfirst; float* Wd; float* V; bf16_t* RKKB; bf16_t* Go; float* Bon; int layer; };

__device__ __forceinline__ f32x4 shifted4(const bf16_t* Ut, bool has_prev, int c, const float* mu) {
    const f32x4 u = ld_bf4(Ut + c); f32x4 p = (f32x4){0.f, 0.f, 0.f, 0.f}; if (has_prev) p = ld_bf4(Ut - 1792 + c);
    const f32x4 m = *(const f32x4*)(mu + c); return u + m * (p - u);
}

__device__ __forceinline__ void rwkv_prep_tile(LAS unsigned char* lds, const PrepArgs& P, int tt, int tid) {
    constexpr int SW = 144, SG = 272, SV = 1040, SVV = 80;
    LAS unsigned char* LAw = lds; LAS unsigned char* LAa = lds + 9216; LAS unsigned char* LAg = lds + 18432; LAS unsigned char* LAv = lds + 35840; LAS unsigned char* LAvv = lds + 102400;
    const int t0 = tt * 64; const int s0 = t0 & (SEQ - 1);
    const int lane = tid & 63, wave = __builtin_amdgcn_readfirstlane(tid >> 6), fr = lane & 15, fq = lane >> 4;
#pragma unroll 2
    for (int e = 0; e < 4; ++e) { const int idx = tid + 512 * e, i = idx >> 5, c = (idx & 31) * 8; const bf16_t* Ut = P.U + (size_t)(t0 + i) * 1792; const bool hp = s0 + i > 0;
        f32x4 x0 = shifted4(Ut, hp, 1536 + c, P.mu), x1 = shifted4(Ut, hp, 1536 + c + 4, P.mu);
        if (c < 64) {
#pragma unroll
            for (int q = 0; q < 4; ++q) { const float ea = __expf(2.f * x0[q]), eb = __expf(2.f * x1[q]); x0[q] = 1.f - 2.f / (ea + 1.f); x1[q] = 1.f - 2.f / (eb + 1.f); } }
        else if (c >= 128) {
#pragma unroll
            for (int q = 0; q < 4; ++q) { x0[q] = sigmoidf_(x0[q]); x1[q] = sigmoidf_(x1[q]); } }
        u32x4 o; o.x = cvt_pk_bf16(x0[0], x0[1]); o.y = cvt_pk_bf16(x0[2], x0[3]); o.z = cvt_pk_bf16(x1[0], x1[1]); o.w = cvt_pk_bf16(x1[2], x1[3]);
        LAS unsigned char* dstp = (c < 64) ? (LAw + i * SW + c * 2) : (c < 128) ? (LAa + i * SW + (c - 64) * 2) : (LAg + i * SG + (c - 128) * 2);
        *(LAS u32x4*)dstp = o; }
    if (P.layer > 0) {
#pragma unroll 2
        for (int e = 0; e < 8; ++e) { const int idx = tid + 512 * e, i = idx >> 6, c = (idx & 63) * 8; const bf16_t* Ut = P.U + (size_t)(t0 + i) * 1792; const bool hp = s0 + i > 0;
            const f32x4 x0 = shifted4(Ut, hp, 1024 + c, P.mu), x1 = shifted4(Ut, hp, 1024 + c + 4, P.mu);
            u32x4 o; o.x = cvt_pk_bf16(x0[0], x0[1]); o.y = cvt_pk_bf16(x0[2], x0[3]); o.z = cvt_pk_bf16(x1[0], x1[1]); o.w = cvt_pk_bf16(x1[2], x1[3]);
            *(LAS u32x4*)(LAv + i * SV + c * 2) = o; }
    }
    __syncthreads();
    if (P.layer > 0) {
        const int mt = wave >> 1, nt = wave & 1; f32x4 acc = (f32x4){0.f, 0.f, 0.f, 0.f};
#pragma unroll 4
        for (int ks = 0; ks < 16; ++ks) { const bf16x8 a = *(LAS const bf16x8*)(LAv + (16 * mt + fr) * SV + (ks * 32 + fq * 8) * 2);
            const bf16x8 b = *(const bf16x8*)(P.v1t + (size_t)(16 * nt + fr) * 512 + ks * 32 + fq * 8); acc = mfma16(b, a, acc); }
        u32x2 w; w.x = cvt_pk_bf16(acc[0], acc[1]); w.y = cvt_pk_bf16(acc[2], acc[3]); *(LAS u32x2*)(LAvv + (16 * mt + fr) * SVV + (16 * nt + 4 * fq) * 2) = w;
    }
    __syncthreads();
    const int h = wave, cb = 64 * h; const int b_ = t0 >> 12, p = b_ * 8 + h;
#pragma unroll 1
    for (int m = 0; m < 4; ++m) {
        const int i = 16 * m + fr; const bf16_t* Ut = P.U + (size_t)(t0 + i) * 1792; const bool hp = (s0 + i) > 0;
        int fq4 = 4 * fq; asm volatile("" : "+v"(fq4));
        f32x4 aa[4], acc[4];
        row_gemm<64>(aa, LAa + i * SW, P.a2t + (size_t)cb * 64, fr, fq);
#pragma unroll
        for (int n = 0; n < 4; ++n) { const f32x4 a0v = *(const f32x4*)(P.a0 + cb + 16 * n + fq4);
#pragma unroll
            for (int j = 0; j < 4; ++j) aa[n][j] = sigmoidf_(aa[n][j] + a0v[j]); }
        row_gemm<64>(acc, LAw + i * SW, P.w2t + (size_t)cb * 64, fr, fq);
#pragma unroll
        for (int n = 0; n < 4; ++n) { const f32x4 w0v = *(const f32x4*)(P.w0 + cb + 16 * n + fq4); f32x4 d;
#pragma unroll
            for (int j = 0; j < 4; ++j) d[j] = __expf(-0.6065306597f * sigmoidf_(acc[n][j] + w0v[j]));
            *(f32x4*)(P.Wd + ((size_t)p * SEQ + s0 + i) * 64 + 16 * n + fq4) = d; }
        row_gemm<128>(acc, LAg + i * SG, P.g2t + (size_t)cb * 128, fr, fq);
#pragma unroll
        for (int n = 0; n < 4; ++n) st_bf4(P.Go + (size_t)(t0 + i) * 512 + cb + 16 * n + fq4, acc[n]);
        asm volatile("" ::: "memory");
        if (P.layer > 0) row_gemm<32>(acc, LAvv + i * SVV, P.v2t + (size_t)cb * 32, fr, fq);
        float bon = 0.f, nk = 0.f; f32x4 kv[4], rv[4];
#pragma unroll
        for (int n = 0; n < 4; ++n) { const int c = cb + 16 * n + fq4;
            f32x4 v = shifted4(Ut, hp, 1024 + c, P.mu);
            if (P.layer > 0) { const f32x4 vf = *(const f32x4*)(P.vfirst + (size_t)(t0 + i) * 512 + c); const f32x4 v0v = *(const f32x4*)(P.v0 + c);
#pragma unroll
                for (int j = 0; j < 4; ++j) v[j] = v[j] + (vf[j] - v[j]) * sigmoidf_(v0v[j] + acc[n][j]); }
            else *(f32x4*)(P.vfirst + (size_t)(t0 + i) * 512 + c) = v;
            *(f32x4*)(P.V + ((size_t)p * SEQ + s0 + i) * 64 + 16 * n + fq4) = v;
            kv[n] = shifted4(Ut, hp, 512 + c, P.mu); rv[n] = shifted4(Ut, hp, c, P.mu);
            const f32x4 kkw = *(const f32x4*)(P.kk_ + c);
#pragma unroll
            for (int j = 0; j < 4; ++j) { const float x = kv[n][j] * kkw[j]; nk += x * x; } }
        nk += __shfl_xor(nk, 16); nk += __shfl_xor(nk, 32);
        const float inv = 1.0f / fmaxf(sqrtf(nk), 1e-12f);
        bf16_t* O = P.RKKB + ((size_t)p * SEQ + s0 + i) * 256;
#pragma unroll
        for (int n = 0; n < 4; ++n) { const int c = cb + 16 * n + fq4; const f32x4 kkw = *(const f32x4*)(P.kk_ + c), kaw = *(const f32x4*)(P.ka + c), rkw = *(const f32x4*)(P.rk + c);
            f32x4 kk, kh, bb;
#pragma unroll
            for (int j = 0; j < 4; ++j) { const float a = aa[n][j]; kk[j] = kv[n][j] * kkw[j] * inv; kh[j] = kv[n][j] * (1.f + (a - 1.f) * kaw[j]); bb[j] = kk[j] * a; bon += rv[n][j] * kh[j] * rkw[j]; }
            const int cc = 16 * n + fq4; st_bf4(O + cc, rv[n]); st_bf4(O + 64 + cc, kh); st_bf4(O + 128 + cc, kk); st_bf4(O + 192 + cc, bb); }
        bon += __shfl_xor(bon, 16); bon += __shfl_xor(bon, 32);
        if (fq == 0) P.Bon[(size_t)(t0 + i) * 8 + h] = bon;
        asm volatile("" ::: "memory");
    }
    __syncthreads();
}

constexpr int SCAN_CH = 32, SCAN_STEP_B = 1344, SCAN_SLOT_B = SCAN_CH * SCAN_STEP_B;
template <int CTRL> __device__ __forceinline__ float dpp_f(float v) { return __int_as_float(__builtin_amdgcn_update_dpp(0, __float_as_int(v), CTRL, 0xf, 0xf, true)); }
__device__ __forceinline__ float row16_sum(float v) { v += dpp_f<0xB1>(v); v += dpp_f<0x4E>(v); v += dpp_f<0x141>(v); v += dpp_f<0x140>(v); return v; }

__device__ __forceinline__ float tr16_sum(const float (&p)[16], int kq) {
    const bool b3 = (kq & 8) != 0, b2 = (kq & 4) != 0, b1 = (kq & 2) != 0, b0 = (kq & 1) != 0;
    float q[8], r[4], u[2];
#pragma unroll
    for (int t = 0; t < 8; ++t) { const float keep = b3 ? p[t + 8] : p[t], send = b3 ? p[t] : p[t + 8]; q[t] = keep + dpp_f<0x140>(send); }
#pragma unroll
    for (int t = 0; t < 4; ++t) { const float keep = b2 ? q[t + 4] : q[t], send = b2 ? q[t] : q[t + 4]; r[t] = keep + dpp_f<0x141>(send); }
#pragma unroll
    for (int t = 0; t < 2; ++t) { const float keep = b1 ? r[t + 2] : r[t], send = b1 ? r[t] : r[t + 2]; u[t] = keep + dpp_f<0x4E>(send); }
    const float keep = b0 ? u[1] : u[0], send = b0 ? u[0] : u[1];
    return keep + dpp_f<0xB1>(send);
}

__device__ __forceinline__ void scan_load_chunk(LAS unsigned char* slot, const float* Wd, const float* V, const bf16_t* RKKB, int p, int rg, int s0, int lt) {
    u32x4 r[7];
    const size_t base = (size_t)p * SEQ + s0;
#pragma unroll
    for (int j = 0; j < 2; ++j) { const int idx = lt + 256 * j, st = idx >> 4, part = idx & 15; r[j] = *(const u32x4*)(Wd + (base + st) * 64 + part * 4); }
#pragma unroll
    for (int j = 2; j < 6; ++j) { const int k = lt + 256 * (j - 2), st = k >> 5, rem = k & 31, q = rem >> 3, part = rem & 7; r[j] = *(const u32x4*)(RKKB + ((base + st) * 4 + q) * 64 + part * 8); }
    if (lt < 128) { const int st = lt >> 2, hf = lt & 3; r[6] = *(const u32x4*)(V + (base + st) * 64 + rg * 16 + hf * 4); }
#pragma unroll
    for (int j = 0; j < 2; ++j) { const int idx = lt + 256 * j, st = idx >> 4, part = idx & 15; *(LAS u32x4*)(slot + st * SCAN_STEP_B + part * 16) = r[j]; }
#pragma unroll
    for (int j = 2; j < 6; ++j) { const int k = lt + 256 * (j - 2), st = k >> 5, rem = k & 31, q = rem >> 3, part = rem & 7; const u32x4 w = r[j];
        const int Q = (q == 0) ? 4 : (q == 1) ? 2 : (q == 2) ? 3 : 1;
        LAS f32x4* d = (LAS f32x4*)(slot + st * SCAN_STEP_B + Q * 256 + part * 32);
        d[0] = (f32x4){bflo(w.x), bfhi(w.x), bflo(w.y), bfhi(w.y)}; d[1] = (f32x4){bflo(w.z), bfhi(w.z), bflo(w.w), bfhi(w.w)}; }
    if (lt < 128) { const int st = lt >> 2, hf = lt & 3; *(LAS u32x4*)(slot + st * SCAN_STEP_B + 1280 + hf * 16) = r[6]; }
}

__device__ __forceinline__ void rwkv_scan_unit(LAS unsigned char* lds, const float* Wd, const float* V, const bf16_t* RKKB, float* Yraw, int p, int rg, int tid) {
    const int lane = tid & 63, wave = __builtin_amdgcn_readfirstlane(tid >> 6);
    constexpr int NCH = SEQ / SCAN_CH;
    scan_load_chunk(lds + (tid >> 8) * SCAN_SLOT_B, Wd, V, RKKB, p, rg, (tid >> 8) * SCAN_CH, tid & 255);
    __syncthreads();
    f32x4 S = (f32x4){0.f, 0.f, 0.f, 0.f};
    const int kq = lane & 15, rl = wave * 4 + (lane >> 4);
    for (int c = 0; c < NCH; ++c) {
        if (wave >= 4) { if (c + 2 < NCH) scan_load_chunk(lds + ((c + 2) % 3) * SCAN_SLOT_B, Wd, V, RKKB, p, rg, (c + 2) * SCAN_CH, tid - 256); }
        else {
            LAS const unsigned char* sl = lds + (c % 3) * SCAN_SLOT_B + kq * 16;
            LAS const unsigned char* vl = lds + (c % 3) * SCAN_SLOT_B + 1280 + rl * 4;
            float* yo = Yraw + ((size_t)p * SEQ + c * SCAN_CH + kq) * 64 + rg * 16 + rl;
            f32x4 w = *(LAS const f32x4*)(sl), b = *(LAS const f32x4*)(sl + 256), k = *(LAS const f32x4*)(sl + 512), kk = *(LAS const f32x4*)(sl + 768), r = *(LAS const f32x4*)(sl + 1024);
            float v = *(LAS const float*)(vl); float yp[16];
#pragma unroll
            for (int st = 0; st < SCAN_CH; ++st) {
                f32x4 wn = w, bn = b, kn = k, kkn = kk, rn = r; float vn = v;
                if (st + 1 < SCAN_CH) { const int o = (st + 1) * SCAN_STEP_B;
                    wn = *(LAS const f32x4*)(sl + o); bn = *(LAS const f32x4*)(sl + o + 256); kn = *(LAS const f32x4*)(sl + o + 512); kkn = *(LAS const f32x4*)(sl + o + 768); rn = *(LAS const f32x4*)(sl + o + 1024);
                    vn = *(LAS const float*)(vl + o); }
                float sa = (S[0] * kk[0] + S[1] * kk[1]) + (S[2] * kk[2] + S[3] * kk[3]);
                const f32x4 kvt = k * v;
                sa = -row16_sum(sa);
                S = S * w + (b * sa + kvt);
                yp[st & 15] = (S[0] * r[0] + S[1] * r[1]) + (S[2] * r[2] + S[3] * r[3]);
                if ((st & 15) == 15) yo[(size_t)(st - 15) * 64] = tr16_sum(yp, kq);
                w = wn; b = bn; k = kn; kk = kkn; r = rn; v = vn;
            }
        }
        __syncthreads();
    }
}

struct GlaArgs { const bf16_t* Ug; const float *conv, *aup, *abias, *gnorm; float* kvcT; float* dec; bf16_t* spT; bf16_t* Yg; };
constexpr int GL_GC = 0;
constexpr int GL_T0 = 16640;
constexpr int GL_VT = GL_T0 + 4 * 9216;
constexpr int GL_AL = GL_VT + 18432;
constexpr int GL_RS = GL_AL + 9216;

__device__ __forceinline__ void gla_conv8(f32x4 (&out)[8], const bf16_t* Ug, const float* conv, int t0, int s0, int i0, int c0) {
    f32x4 w[4];
#pragma unroll
    for (int j = 0; j < 4; ++j) w[j] = *(const f32x4*)(conv + j * 1024 + c0);
#pragma unroll
    for (int e = 0; e < 8; ++e) { const int i = i0 + 8 * e; f32x4 a = (f32x4){0.f, 0.f, 0.f, 0.f};
#pragma unroll
        for (int j = 0; j < 4; ++j) { const int ds = 3 - j; if (s0 + i - ds >= 0) a += w[j] * ld_bf4(Ug + (size_t)(t0 + i - ds) * 1792 + c0); }
#pragma unroll
        for (int q = 0; q < 4; ++q) a[q] = a[q] * sigmoidf_(a[q]);
        out[e] = a; }
}
__device__ __forceinline__ void gla_gcum(LAS unsigned char* lds, const GlaArgs& A, int t0, int h, int tid) {
    LAS float* GC = (LAS float*)(lds + GL_GC);
    { const int d = tid & 63, i0 = tid >> 6; float au[16]; const float ab = A.abias[h * 64 + d];
#pragma unroll
      for (int j = 0; j < 16; ++j) au[j] = A.aup[j * 256 + h * 64 + d];
#pragma unroll
      for (int e = 0; e < 8; ++e) { const int i = i0 + 8 * e; const u32x4* ap = (const u32x4*)(A.Ug + (size_t)(t0 + i) * 1792 + 1024); const u32x4 a0 = ap[0], a1 = ap[1];
          float x = ab;
          x += bflo(a0.x) * au[0] + bfhi(a0.x) * au[1] + bflo(a0.y) * au[2] + bfhi(a0.y) * au[3] + bflo(a0.z) * au[4] + bfhi(a0.z) * au[5] + bflo(a0.w) * au[6] + bfhi(a0.w) * au[7];
          x += bflo(a1.x) * au[8] + bfhi(a1.x) * au[9] + bflo(a1.y) * au[10] + bfhi(a1.y) * au[11] + bflo(a1.z) * au[12] + bfhi(a1.z) * au[13] + bflo(a1.w) * au[14] + bfhi(a1.w) * au[15];
          const float ls = fminf(x, 0.f) - __logf(1.f + __expf(-fabsf(x)));
          GC[i * 65 + d] = ls * (1.0f / 16.0f); } }
    __syncthreads();
    { const int lane = tid & 63, wave = tid >> 6;
#pragma unroll
      for (int dd = 0; dd < 8; ++dd) { const int d = wave * 8 + dd; float x = GC[lane * 65 + d];
#pragma unroll
          for (int o = 1; o < 64; o <<= 1) { const float y = __shfl_up(x, o); if (lane >= o) x += y; }
          GC[lane * 65 + d] = x; } }
    __syncthreads();
}
__device__ __forceinline__ void gla_a_tile(LAS unsigned char* lds, const GlaArgs& A, int tile, int tid) {
    const int bh = tile >> 6, n = tile & 63, b = bh >> 2, h = bh & 3, t0 = b * SEQ + n * 64, s0 = n * 64;
    LAS float* GC = (LAS float*)(lds + GL_GC); LAS bf16_t* KDT = (LAS bf16_t*)(lds + GL_T0); LAS bf16_t* VT = (LAS bf16_t*)(lds + GL_VT);
    gla_gcum(lds, A, t0, h, tid);
    { const int cc = (tid & 63) * 4, i0 = tid >> 6;
      if (cc >= 64) { f32x4 o[8]; const int c0 = (cc < 128) ? 256 + h * 64 + (cc - 64) : 512 + h * 128 + (cc - 128);
          gla_conv8(o, A.Ug, A.conv, t0, s0, i0, c0);
          if (cc < 128) { const int d = cc - 64;
#pragma unroll
              for (int e = 0; e < 8; ++e) { const int i = i0 + 8 * e;
#pragma unroll
                  for (int q = 0; q < 4; ++q) KDT[(d + q) * 72 + i] = f2bf(o[e][q] * __expf(GC[63 * 65 + d + q] - GC[i * 65 + d + q])); } }
          else { const int ev = cc - 128;
#pragma unroll
              for (int e = 0; e < 8; ++e) { const int i = i0 + 8 * e;
#pragma unroll
                  for (int q = 0; q < 4; ++q) VT[(ev + q) * 72 + i] = f2bf(o[e][q]); } } } }
    if (tid < 64) A.dec[((size_t)bh * 64 + n) * 64 + tid] = __expf(GC[63 * 65 + tid]);
    __syncthreads();
    { const int lane = tid & 63, wave = tid >> 6, fr = lane & 15, fq = lane >> 4; f32x4 acc[4];
#pragma unroll
      for (int nt = 0; nt < 4; ++nt) acc[nt] = (f32x4){0.f, 0.f, 0.f, 0.f};
#pragma unroll
      for (int ks = 0; ks < 2; ++ks) { const bf16x8 a = *(LAS const bf16x8*)(VT + (16 * wave + fr) * 72 + ks * 32 + fq * 8);
#pragma unroll
          for (int nt = 0; nt < 4; ++nt) { const bf16x8 bfr = *(LAS const bf16x8*)(KDT + (16 * nt + fr) * 72 + ks * 32 + fq * 8); acc[nt] = mfma16(bfr, a, acc[nt]); } }
#pragma unroll
      for (int nt = 0; nt < 4; ++nt) *(f32x4*)(A.kvcT + (((size_t)bh * 64 + n) * 128 + 16 * wave + fr) * 64 + 16 * nt + 4 * fq) = acc[nt]; }
    __syncthreads();
}
__device__ __forceinline__ void gla_c_tile(LAS unsigned char* lds, const GlaArgs& A, int tile, int tid) {
    const int bh = tile >> 6, n = tile & 63, b = bh >> 2, h = bh & 3, t0 = b * SEQ + n * 64, s0 = n * 64;
    LAS float* GC = (LAS float*)(lds + GL_GC); LAS bf16_t* QG = (LAS bf16_t*)(lds + GL_T0); LAS bf16_t* KG = QG + 64 * 72; LAS bf16_t* QR = KG + 64 * 72; LAS bf16_t* KR = QR + 64 * 72;
    LAS bf16_t* VT = (LAS bf16_t*)(lds + GL_VT); LAS bf16_t* AL = (LAS bf16_t*)(lds + GL_AL); LAS float* RS = (LAS float*)(lds + GL_RS);
    gla_gcum(lds, A, t0, h, tid);
    { const int cc = (tid & 63) * 4, i0 = tid >> 6; f32x4 o[8];
      const int c0 = (cc < 64) ? h * 64 + cc : (cc < 128) ? 256 + h * 64 + (cc - 64) : 512 + h * 128 + (cc - 128);
      gla_conv8(o, A.Ug, A.conv, t0, s0, i0, c0);
      if (cc < 128) { const int d = cc & 63; const bool isq = cc < 64; LAS bf16_t* T1 = isq ? QG : KR; LAS bf16_t* T2 = isq ? QR : KG; const float sc = isq ? 0.125f : 1.0f;
#pragma unroll
          for (int e = 0; e < 8; ++e) { const int i = i0 + 8 * e; f32x4 x1, x2;
#pragma unroll
              for (int q = 0; q < 4; ++q) { const float eg = __expf(GC[i * 65 + d + q]); const float x = o[e][q] * sc; x1[q] = x * eg; x2[q] = x / eg; }
              u32x2 w1, w2; w1.x = cvt_pk_bf16(x1[0], x1[1]); w1.y = cvt_pk_bf16(x1[2], x1[3]); w2.x = cvt_pk_bf16(x2[0], x2[1]); w2.y = cvt_pk_bf16(x2[2], x2[3]);
              *(LAS u32x2*)(T1 + i * 72 + d) = w1; *(LAS u32x2*)(T2 + i * 72 + d) = w2; } }
      else { const int ev = cc - 128;
#pragma unroll
          for (int e = 0; e < 8; ++e) { const int i = i0 + 8 * e;
#pragma unroll
              for (int q = 0; q < 4; ++q) VT[(ev + q) * 72 + i] = f2bf(o[e][q]); } } }
    __syncthreads();
    const int lane = tid & 63, wave = tid >> 6, fr = lane & 15, fq = lane >> 4; const int mt = wave >> 1;
    {
#pragma unroll
        for (int q = 0; q < 2; ++q) { const int nt = (wave & 1) * 2 + q; f32x4 ap = (f32x4){0.f, 0.f, 0.f, 0.f}, af = ap;
#pragma unroll
            for (int ks = 0; ks < 2; ++ks) { const int ko = ks * 32 + fq * 8;
                ap = mfma16(*(LAS const bf16x8*)(KG + (16 * nt + fr) * 72 + ko), *(LAS const bf16x8*)(QG + (16 * mt + fr) * 72 + ko), ap);
                af = mfma16(*(LAS const bf16x8*)(KR + (16 * nt + fr) * 72 + ko), *(LAS const bf16x8*)(QR + (16 * mt + fr) * 72 + ko), af); }
            const int trow = 16 * mt + fr; f32x4 o;
#pragma unroll
            for (int j = 0; j < 4; ++j) { const int scol = 16 * nt + 4 * fq + j; o[j] = (scol <= trow) ? ap[j] : af[j]; }
            u32x2 w; w.x = cvt_pk_bf16(o[0], o[1]); w.y = cvt_pk_bf16(o[2], o[3]); *(LAS u32x2*)(AL + trow * 72 + 16 * nt + 4 * fq) = w; }
    }
    __syncthreads();
    f32x4 acc[4];
#pragma unroll
    for (int q = 0; q < 4; ++q) acc[q] = (f32x4){0.f, 0.f, 0.f, 0.f};
    const bf16_t* sp = A.spT + ((size_t)bh * 64 + n) * 128 * 64;
#pragma unroll
    for (int ks = 0; ks < 2; ++ks) { const int ko = ks * 32 + fq * 8; const bf16x8 a1 = *(LAS const bf16x8*)(AL + (16 * mt + fr) * 72 + ko), a2 = *(LAS const bf16x8*)(QG + (16 * mt + fr) * 72 + ko);
#pragma unroll
        for (int q = 0; q < 4; ++q) { const int nt = (wave & 1) * 4 + q;
            acc[q] = mfma16(*(LAS const bf16x8*)(VT + (16 * nt + fr) * 72 + ko), a1, acc[q]);
            acc[q] = mfma16(*(const bf16x8*)(sp + (size_t)(16 * nt + fr) * 64 + ko), a2, acc[q]); } }
    float ssq = 0.f;
#pragma unroll
    for (int q = 0; q < 4; ++q) ssq += (acc[q][0] * acc[q][0] + acc[q][1] * acc[q][1]) + (acc[q][2] * acc[q][2] + acc[q][3] * acc[q][3]);
    ssq += __shfl_xor(ssq, 16); ssq += __shfl_xor(ssq, 32);
    if (fq == 0) RS[(16 * mt + fr) * 2 + (wave & 1)] = ssq;
    __syncthreads();
    { const int i = 16 * mt + fr; const float rs = rsqrtf((RS[i * 2] + RS[i * 2 + 1]) * (1.0f / 128.0f) + 1e-6f);
#pragma unroll
      for (int q = 0; q < 4; ++q) { const int ecol = h * 128 + ((wave & 1) * 4 + q) * 16 + 4 * fq; const f32x4 nw = *(const f32x4*)(A.gnorm + ecol); const f32x4 go = ld_bf4(A.Ug + (size_t)(t0 + i) * 1792 + 1040 + ecol); f32x4 o;
#pragma unroll
          for (int j = 0; j < 4; ++j) o[j] = acc[q][j] * rs * nw[j] * go[j] * sigmoidf_(go[j]);
          st_bf4(A.Yg + (size_t)(t0 + i) * 512 + ecol, o); } }
    __syncthreads();
}

__device__ __forceinline__ void xa_tile(const bf16_t* Ux, const bf16_t* Kb, const bf16_t* Vt, bf16_t* Yx, int tile, int tid) {
    const int blk = tile & 31, h = (tile >> 5) & 3, b = tile >> 7; const int lane = tid & 63, wave = tid >> 6, fr = lane & 15, fq = lane >> 4;
    const int t = b * SEQ + blk * 128 + 16 * wave + fr;
    bf16x8 qf[4];
#pragma unroll
    for (int ks = 0; ks < 4; ++ks) qf[ks] = *(const bf16x8*)(Ux + (size_t)t * 512 + h * 128 + ks * 32 + fq * 8);
    f32x4 s[16];
#pragma unroll
    for (int nt = 0; nt < 16; ++nt) { s[nt] = (f32x4){0.f, 0.f, 0.f, 0.f}; const bf16_t* kr = Kb + (size_t)(b * 256 + 16 * nt + fr) * 512 + h * 128 + fq * 8;
#pragma unroll
        for (int ks = 0; ks < 4; ++ks) s[nt] = mfma16(*(const bf16x8*)(kr + ks * 32), qf[ks], s[nt]); }
    float mx = -1e30f;
#pragma unroll
    for (int nt = 0; nt < 16; ++nt)
#pragma unroll
        for (int j = 0; j < 4; ++j) mx = fmaxf(mx, s[nt][j]);
    mx = fmaxf(mx, __shfl_xor(mx, 16)); mx = fmaxf(mx, __shfl_xor(mx, 32));
    const float sc = 0.08838834764831845f * 1.4426950408889634f; float l = 0.f;
#pragma unroll
    for (int nt = 0; nt < 16; ++nt)
#pragma unroll
        for (int j = 0; j < 4; ++j) { const float pz = exp2f((s[nt][j] - mx) * sc); s[nt][j] = pz; l += pz; }
    l += __shfl_xor(l, 16); l += __shfl_xor(l, 32);
    f32x4 o[8];
#pragma unroll
    for (int dt = 0; dt < 8; ++dt) o[dt] = (f32x4){0.f, 0.f, 0.f, 0.f};
#pragma unroll
    for (int c = 0; c < 8; ++c) { union { u32x4 u; bf16x8 v; } pf;
        pf.u.x = cvt_pk_bf16(s[2 * c][0], s[2 * c][1]); pf.u.y = cvt_pk_bf16(s[2 * c][2], s[2 * c][3]); pf.u.z = cvt_pk_bf16(s[2 * c + 1][0], s[2 * c + 1][1]); pf.u.w = cvt_pk_bf16(s[2 * c + 1][2], s[2 * c + 1][3]);
#pragma unroll
        for (int dt = 0; dt < 8; ++dt) { const bf16_t* vr = Vt + ((size_t)b * 512 + h * 128 + 16 * dt + fr) * 256 + 32 * c + 4 * fq; union { u32x4 u; bf16x8 v; } vf;
            const u32x2 lo = *(const u32x2*)vr, hi = *(const u32x2*)(vr + 16); vf.u.x = lo.x; vf.u.y = lo.y; vf.u.z = hi.x; vf.u.w = hi.y;
            o[dt] = mfma16(vf.v, pf.v, o[dt]); } }
    const float il = 1.0f / l;
#pragma unroll
    for (int dt = 0; dt < 8; ++dt) st_bf4(Yx + (size_t)t * 512 + h * 128 + 16 * dt + 4 * fq, o[dt] * il);
}

constexpr int XK_STRIDE = 272, XV_STRIDE = 528, XV_OFF = 256 * XK_STRIDE;
__device__ __forceinline__ void xa_pair(LAS unsigned char* lds, const bf16_t* Ux, const bf16_t* Kb, const bf16_t* Vt, bf16_t* Yx, int pair, int tid) {
    const int bh = pair >> 4, b = bh >> 2, h = bh & 3, blk0 = (pair & 15) * 2; const int lane = tid & 63, wave = tid >> 6, fr = lane & 15, fq = lane >> 4;
#pragma unroll
    for (int e = 0; e < 8; ++e) { const int ch = tid + 512 * e; const int key = ch >> 4, part = ch & 15;
        *(LAS u32x4*)(lds + key * XK_STRIDE + part * 16) = *(const u32x4*)(Kb + (size_t)(b * 256 + key) * 512 + h * 128 + part * 8);
        const int dr = ch >> 5, pv = ch & 31;
        *(LAS u32x4*)(lds + XV_OFF + dr * XV_STRIDE + pv * 16) = *(const u32x4*)(Vt + ((size_t)b * 512 + h * 128 + dr) * 256 + pv * 8); }
    __syncthreads();
#pragma unroll 1
    for (int tq = 0; tq < 2; ++tq) {
        const int t = b * SEQ + (blk0 + tq) * 128 + 16 * wave + fr;
        bf16x8 qf[4];
#pragma unroll
        for (int ks = 0; ks < 4; ++ks) qf[ks] = *(const bf16x8*)(Ux + (size_t)t * 512 + h * 128 + ks * 32 + fq * 8);
        f32x4 s[16];
#pragma unroll
        for (int nt = 0; nt < 16; ++nt) { s[nt] = (f32x4){0.f, 0.f, 0.f, 0.f}; LAS const unsigned char* kr = lds + (16 * nt + fr) * XK_STRIDE + fq * 16;
#pragma unroll
            for (int ks = 0; ks < 4; ++ks) s[nt] = mfma16(*(LAS const bf16x8*)(kr + ks * 64), qf[ks], s[nt]);
            if (nt & 1) asm volatile("" ::: "memory"); }
        float mx = -1e30f;
#pragma unroll
        for (int nt = 0; nt < 16; ++nt)
#pragma unroll
            for (int j = 0; j < 4; ++j) mx = fmaxf(mx, s[nt][j]);
        mx = fmaxf(mx, __shfl_xor(mx, 16)); mx = fmaxf(mx, __shfl_xor(mx, 32));
        const float sc = 0.08838834764831845f * 1.4426950408889634f; float l = 0.f;
#pragma unroll
        for (int nt = 0; nt < 16; ++nt)
#pragma unroll
            for (int j = 0; j < 4; ++j) { const float pz = exp2f((s[nt][j] - mx) * sc); s[nt][j] = pz; l += pz; }
        l += __shfl_xor(l, 16); l += __shfl_xor(l, 32);
        f32x4 o[8];
#pragma unroll
        for (int dt = 0; dt < 8; ++dt) o[dt] = (f32x4){0.f, 0.f, 0.f, 0.f};
#pragma unroll
        for (int c = 0; c < 8; ++c) { union { u32x4 u; bf16x8 v; } pf;
            pf.u.x = cvt_pk_bf16(s[2 * c][0], s[2 * c][1]); pf.u.y = cvt_pk_bf16(s[2 * c][2], s[2 * c][3]); pf.u.z = cvt_pk_bf16(s[2 * c + 1][0], s[2 * c + 1][1]); pf.u.w = cvt_pk_bf16(s[2 * c + 1][2], s[2 * c + 1][3]);
#pragma unroll
            for (int dt = 0; dt < 8; ++dt) { LAS const unsigned char* vr = lds + XV_OFF + (16 * dt + fr) * XV_STRIDE + (32 * c + 4 * fq) * 2; union { u32x4 u; bf16x8 v; } vf;
                const u32x2 lo = *(LAS const u32x2*)vr, hi = *(LAS const u32x2*)(vr + 32); vf.u.x = lo.x; vf.u.y = lo.y; vf.u.z = hi.x; vf.u.w = hi.y;
                o[dt] = mfma16(vf.v, pf.v, o[dt]); }
            asm volatile("" ::: "memory"); }
        const float il = 1.0f / l;
#pragma unroll
        for (int dt = 0; dt < 8; ++dt) st_bf4(Yx + (size_t)t * 512 + h * 128 + 16 * dt + 4 * fq, o[dt] * il);
    }
    __syncthreads();
}

struct Params { const float* in[33]; float* out; unsigned char* ws; };

__device__ __forceinline__ int opaque0() { int z = 0; asm volatile("" : "+s"(z)); return z; }
typedef __attribute__((address_space(1))) unsigned char* gptr_t;
typedef __attribute__((address_space(1))) const float* gcf_t;
__device__ __forceinline__ int opqv(int v) { asm volatile("" : "+v"(v)); return v; }
__device__ __forceinline__ int opqs(int v) { asm volatile("" : "+s"(v)); return v; }
#define PH_BEGIN const int zi = opaque0(); unsigned char* ws = P.ws + zi; float* const OUT = P.out + zi; (void)OUT; const int tid = opqv((int)threadIdx.x); const int bid = opqs((int)blockIdx.x); const int G = opqs((int)gridDim.x); (void)tid; (void)bid; (void)G; unsigned char* WB = ws + WS_WB; float* SS = (float*)(ws + WS_SS); (void)WB; (void)SS; (void)zi;
#define INP(k) (P.in[(k)] + zi)
#define XB_ ((bf16_t*)(ws + WS_XB))
#define U_ (ws + WS_U)
#define SC_ (ws + WS_SC)
#define Y_ ((bf16_t*)(ws + WS_Y))
#define KB_ ((bf16_t*)(ws + WS_KB))
#define VT_ ((bf16_t*)(ws + WS_VT))

constexpr size_t WS_BAR = WS_MISC + 8192;
__device__ __forceinline__ void grid_bar(unsigned* ctr, unsigned target) {
    asm volatile("s_waitcnt vmcnt(0)" ::: "memory");
    __syncthreads();
    if (threadIdx.x == 0) {
        __builtin_amdgcn_fence(__ATOMIC_RELEASE, "agent");
        asm volatile("s_waitcnt vmcnt(0)" ::: "memory");
        __hip_atomic_fetch_add(ctr, 1u, __ATOMIC_RELAXED, __HIP_MEMORY_SCOPE_AGENT);
        while (__hip_atomic_load(ctr, __ATOMIC_RELAXED, __HIP_MEMORY_SCOPE_AGENT) < target) __builtin_amdgcn_s_sleep(2);
        __builtin_amdgcn_fence(__ATOMIC_ACQUIRE, "agent");
        asm volatile("s_waitcnt vmcnt(0)" ::: "memory");
    }
    __syncthreads();
}

__global__ void __launch_bounds__(512) mega(Params P) {
    extern __shared__ __attribute__((aligned(16))) unsigned char lds_raw[];
    LAS unsigned char* lds = (LAS unsigned char*)lds_raw;
    cg::grid_group grid = cg::this_grid();

    unsigned nsub = 0;
    for (int ph = 0; ph < NL * 12 + 1; ++ph) {
        const int l = ph / 12, kph = ph - l * 12;
        if (ph == NL * 12) {
#if (PHMASK >> 12) & 1
    { PH_BEGIN
        const int lane = tid & 63, gw = bid * 8 + (tid >> 6), nw = G * 8;
        const float* fn = INP(32); const float* ssf = SS + (size_t)0 * T * 16; float* X = OUT;
        for (int r = gw; r < T; r += nw) { const float rs = row_rstd(ssf, r);
#pragma unroll
            for (int i = 0; i < 4; ++i) { const size_t o = (size_t)r * D + i * 256 + lane * 4; *(f32x4*)(X + o) = *(const f32x4*)(X + o) * rs * *(const f32x4*)(fn + i * 256 + lane * 4); } }
    }
#endif
            break;
        }
        switch (kph) {
        case 0: {
#if (PHMASK >> 0) & 1
        for (int rep = 0; rep < REP0; ++rep) {
        {
            { PH_BEGIN convT_w<1>(INP(3) + (size_t)l * D * 2 * FF, 2 * FF, 0, INP(2) + (size_t)l * D, (bf16_t*)(WB + WB_W1A), D, D, 2 * FF, bid * 8 + (tid >> 6), G * 8, tid & 63); }
            { PH_BEGIN convT_w<0>(INP(4) + (size_t)l * FF * D, D, 0, nullptr, (bf16_t*)(WB + WB_W1B), FF, FF, D, bid * 8 + (tid >> 6), G * 8, tid & 63); }
            { PH_BEGIN convT_w<2>(INP(7) + (size_t)l * D * 6928, 6928, 0, INP(5) + (size_t)l * D, (bf16_t*)(WB + WB_WIN), D, D, 4096, bid * 8 + (tid >> 6), G * 8, tid & 63); }
            { PH_BEGIN convT_w<0>(INP(7) + (size_t)l * D * 6928, 6928, 3856, INP(5) + (size_t)l * D, (bf16_t*)(WB + WB_WG), D, D, 3072, bid * 8 + (tid >> 6), G * 8, tid & 63); }
            for (int j = 0; j < 3; ++j) { PH_BEGIN convT_w<0>(INP(27) + ((size_t)l * 3 + j) * 512 * D, D, 0, nullptr, (bf16_t*)(WB + WB_WBR) + (size_t)j * D * 512, 512, 512, D, bid * 8 + (tid >> 6), G * 8, tid & 63); }
            { PH_BEGIN convT_w<0>(INP(28) + (size_t)l * D * D, D, 0, nullptr, (bf16_t*)(WB + WB_WO), D, D, D, bid * 8 + (tid >> 6), G * 8, tid & 63); }
            { PH_BEGIN convT_w<0>(INP(26) + (size_t)l * D * D, D, 0, INP(6) + (size_t)l * D, (bf16_t*)(WB + WB_WKV), D, D, D, bid * 8 + (tid >> 6), G * 8, tid & 63); }
            { PH_BEGIN convT_w<1>(INP(30) + (size_t)l * D * 2 * FF, 2 * FF, 0, INP(29) + (size_t)l * D, (bf16_t*)(WB + WB_W2A), D, D, 2 * FF, bid * 8 + (tid >> 6), G * 8, tid & 63); }
            { PH_BEGIN convT_w<0>(INP(31) + (size_t)l * FF * D, D, 0, nullptr, (bf16_t*)(WB + WB_W2B), FF, FF, D, bid * 8 + (tid >> 6), G * 8, tid & 63); }
            { PH_BEGIN convT_w<0>(INP(10) + (size_t)l * 64 * 512, 512, 0, nullptr, (bf16_t*)(WB + WB_LW2), 64, 64, 512, bid * 8 + (tid >> 6), G * 8, tid & 63); }
            { PH_BEGIN convT_w<0>(INP(12) + (size_t)l * 64 * 512, 512, 0, nullptr, (bf16_t*)(WB + WB_LA2), 64, 64, 512, bid * 8 + (tid >> 6), G * 8, tid & 63); }
            { PH_BEGIN convT_w<0>(INP(13) + (size_t)l * 128 * 512, 512, 0, nullptr, (bf16_t*)(WB + WB_LG2), 128, 128, 512, bid * 8 + (tid >> 6), G * 8, tid & 63); }
            if (l > 0) {
                { PH_BEGIN convT_w<0>(INP(20) + (size_t)(l - 1) * 512 * 32, 32, 0, nullptr, (bf16_t*)(WB + WB_LV1), 512, 512, 32, bid * 8 + (tid >> 6), G * 8, tid & 63); }
                { PH_BEGIN convT_w<0>(INP(21) + (size_t)(l - 1) * 32 * 512, 512, 0, nullptr, (bf16_t*)(WB + WB_LV2), 32, 32, 512, bid * 8 + (tid >> 6), G * 8, tid & 63); }
            }
            if (l == 0) { PH_BEGIN
                const int lane = tid & 63, gw = bid * 8 + (tid >> 6), nw = G * 8;
                float* rstd_mem = (float*)(ws + WS_MISC); bf16_t* MEMN = (bf16_t*)(ws + WS_MEMN);
                for (int r = gw; r < T + 1024; r += nw) {
                    const bool ism = r >= T; const float* src = ism ? INP(1) + (size_t)(r - T) * D : INP(0) + (size_t)r * D; bf16_t* dst = ism ? MEMN + (size_t)(r - T) * D : XB_ + (size_t)r * D; float q = 0.f;
#pragma unroll
                    for (int i = 0; i < 4; ++i) { const f32x4 v = *(const f32x4*)(src + i * 256 + lane * 4); st_bf4(dst + i * 256 + lane * 4, v); q += (v[0] * v[0] + v[1] * v[1]) + (v[2] * v[2] + v[3] * v[3]); }
                    q = wave_sum(q);
                    if (ism) { if (lane == 0) rstd_mem[r - T] = rsqrtf(q * (1.0f / 1024.0f) + 1e-6f); } else if (lane < 16) SS[(size_t)r * 16 + lane] = (lane == 0) ? q : 0.f;
                }
            }
        }
        }
#endif
        } break;
        case 1: {
#if (PHMASK >> 1) & 1
        for (int rep = 0; rep < REPG; ++rep) {
        { PH_BEGIN
            pg8::Gemm g{XB_, (const bf16_t*)(WB + WB_W1A), T, 2 * FF, D, D, D, 0, 0}; pg8::StaticOrder S; S.init(T, 2 * FF, G, bid, 1);
            EpiFFNa E{(bf16_t*)U_, SS + (size_t)0 * T * 16}; pg8::gemm_phase(lds, g, S, E, tid);
        }
        if ((int)blockIdx.x >= (int)gridDim.x - 16) { PH_BEGIN
            pg8::Gemm g2{(const bf16_t*)(ws + WS_MEMN), (const bf16_t*)(WB + WB_WKV), 1024, D, D, D, D, 0, 0}; pg8::StaticOrder S2; S2.init(1024, D, 16, bid - (G - 16), 1);
            EpiKV E2{KB_, VT_, (const float*)(ws + WS_MISC)}; pg8::gemm_phase(lds, g2, S2, E2, tid);
        }
        }
#endif
        } break;
        case 2: {
#if (PHMASK >> 2) & 1
        { PH_BEGIN
            pg8::Gemm g{(const bf16_t*)U_, (const bf16_t*)(WB + WB_W1B), T, D, FF, FF, FF, 0, 0}; pg8::StaticOrder S; S.init(T, D, G, bid, 1);
            EpiRes E{l == 0 ? INP(0) : OUT, OUT, XB_, SS + (size_t)1 * T * 16, 0.5f}; pg8::gemm_phase(lds, g, S, E, tid);
        }
#endif
        } break;
        case 3: {
#if (PHMASK >> 3) & 1
        for (int rep = 0; rep < REPG; ++rep) {
        { PH_BEGIN
            pg8::Gemm g{XB_, (const bf16_t*)(WB + WB_WIN), T, 4096, D, D, D, 0, 0}; pg8::StaticOrder S; S.init(T, 4096, G, bid, 1);
            EpiU E{(bf16_t*)U_, SS + (size_t)1 * T * 16}; pg8::gemm_phase(lds, g, S, E, tid);
        }
        }
#endif
        } break;
        case 4: {
#if (PHMASK >> 4) & 1
        { PH_BEGIN
            PrepArgs PA; PA.U = (const bf16_t*)(U_ + U_RWKV); PA.mu = INP(8) + (size_t)l * 1792; PA.w0 = INP(9) + (size_t)l * 512; PA.a0 = INP(11) + (size_t)l * 512;
            PA.kk_ = INP(14) + (size_t)l * 512; PA.ka = INP(15) + (size_t)l * 512; PA.rk = INP(16) + (size_t)l * 512; PA.v0 = INP(19) + (size_t)(l > 0 ? l - 1 : 0) * 512;
            PA.w2t = (const bf16_t*)(WB + WB_LW2); PA.a2t = (const bf16_t*)(WB + WB_LA2); PA.g2t = (const bf16_t*)(WB + WB_LG2); PA.v1t = (const bf16_t*)(WB + WB_LV1); PA.v2t = (const bf16_t*)(WB + WB_LV2);
            PA.vfirst = (float*)(ws + WS_VF); PA.Wd = (float*)(SC_ + SC_WD); PA.V = (float*)(SC_ + SC_V); PA.RKKB = (bf16_t*)(SC_ + SC_RKKB); PA.Go = (bf16_t*)(ws + WS_GO); PA.Bon = (float*)(ws + WS_BON); PA.layer = l;
            for (int tt = bid; tt < 256; tt += G) rwkv_prep_tile(lds, PA, tt, tid);
        }
        { PH_BEGIN
            for (int pair = bid; pair < 256; pair += G) xa_pair(lds, (const bf16_t*)(U_ + U_XA), KB_, VT_, Y_ + (size_t)2 * T * 512, pair, tid);
        }
        { PH_BEGIN
            GlaArgs GA; GA.Ug = (const bf16_t*)(U_ + U_GLA); GA.conv = INP(22) + (size_t)l * 4096; GA.aup = INP(23) + (size_t)l * 4096; GA.abias = INP(24) + (size_t)l * 256; GA.gnorm = INP(25) + (size_t)l * 512;
            GA.kvcT = (float*)(ws + WS_KVC); GA.dec = (float*)(ws + WS_DEC); GA.spT = (bf16_t*)(U_ + U_SPT); GA.Yg = Y_ + (size_t)T * 512;
            for (int tile = bid; tile < NA4 * 256; tile += G) gla_a_tile(lds, GA, tile, tid);
        }
#endif
        } break;
        case 5: {
#if (PHMASK >> 5) & 1
        if ((int)blockIdx.x < 128) { PH_BEGIN
            const int xcd = bid & 7, j = bid >> 3, p = xcd * 4 + (j >> 2), rg = j & 3;
            rwkv_scan_unit(lds, (const float*)(SC_ + SC_WD), (const float*)(SC_ + SC_V), (const bf16_t*)(SC_ + SC_RKKB), (float*)(U_ + U_YRAW), p, rg, tid);
        } else {
            { PH_BEGIN
            GlaArgs GA; GA.Ug = (const bf16_t*)(U_ + U_GLA); GA.conv = INP(22) + (size_t)l * 4096; GA.aup = INP(23) + (size_t)l * 4096; GA.abias = INP(24) + (size_t)l * 256; GA.gnorm = INP(25) + (size_t)l * 512;
            GA.kvcT = (float*)(ws + WS_KVC); GA.dec = (float*)(ws + WS_DEC); GA.spT = (bf16_t*)(U_ + U_SPT); GA.Yg = Y_ + (size_t)T * 512;
            for (int tile = NA4 * 256 + bid - 128; tile < 1024; tile += 128) gla_a_tile(lds, GA, tile, tid);
            }
            ++nsub; grid_bar((unsigned*)(P.ws + WS_BAR + 128), nsub * 128u);
            { PH_BEGIN
            bf16_t* spT = (bf16_t*)(U_ + U_SPT); const float* DEC = (const float*)(ws + WS_DEC); const float* KVC = (const float*)(ws + WS_KVC);
            for (int i = (bid - 128) * 512 + tid; i < 16 * 128 * 64; i += 128 * 512) { const int bh = i >> 13, ed = i & 8191, d = i & 63; float st = 0.f;
                for (int n0 = 0; n0 < 64; n0 += 16) { float kv[16], dc[16];
#pragma unroll
                    for (int q = 0; q < 16; ++q) { kv[q] = KVC[((size_t)bh * 64 + n0 + q) * 8192 + ed]; dc[q] = DEC[((size_t)bh * 64 + n0 + q) * 64 + d]; }
#pragma unroll
                    for (int q = 0; q < 16; ++q) { spT[((size_t)bh * 64 + n0 + q) * 8192 + ed] = f2bf(st); st = st * dc[q] + kv[q]; } } }
            }
            ++nsub; grid_bar((unsigned*)(P.ws + WS_BAR + 128), nsub * 128u);
            { PH_BEGIN
            GlaArgs GA; GA.Ug = (const bf16_t*)(U_ + U_GLA); GA.conv = INP(22) + (size_t)l * 4096; GA.aup = INP(23) + (size_t)l * 4096; GA.abias = INP(24) + (size_t)l * 256; GA.gnorm = INP(25) + (size_t)l * 512;
            GA.kvcT = (float*)(ws + WS_KVC); GA.dec = (float*)(ws + WS_DEC); GA.spT = (bf16_t*)(U_ + U_SPT); GA.Yg = Y_ + (size_t)T * 512;
            for (int tile = bid - 128; tile < 1024; tile += 128) gla_c_tile(lds, GA, tile, tid);
            }
        }
#endif
        } break;
        case 6: {
#if (PHMASK >> 6) & 1
        { PH_BEGIN
            const int lane = tid & 63, gw = bid * 8 + (tid >> 6), nw = G * 8;
            const float* lnw = INP(17) + (size_t)l * 512; const float* lnb = INP(18) + (size_t)l * 512; const float* Yraw = (const float*)(U_ + U_YRAW); const float* Vv = (const float*)(SC_ + SC_V);
            const float* BON = (const float*)(ws + WS_BON); const bf16_t* GO = (const bf16_t*)(ws + WS_GO); bf16_t* Y = Y_;
            const int kq = lane & 15, sub = lane >> 4;
#pragma unroll 4
            for (int it0 = gw * 4; it0 < 32 * SEQ; it0 += nw * 4) { const int it = it0 + sub; const int p = it >> 12, s = it & (SEQ - 1), b = p >> 3, h = p & 7, t = b * SEQ + s;
                const f32x4 y = *(const f32x4*)(Yraw + (size_t)it * 64 + kq * 4); const f32x4 vv = *(const f32x4*)(Vv + (size_t)it * 64 + kq * 4);
                const f32x4 gg = ld_bf4(GO + (size_t)t * 512 + h * 64 + kq * 4); const f32x4 lw = *(const f32x4*)(lnw + h * 64 + kq * 4), lb = *(const f32x4*)(lnb + h * 64 + kq * 4); const float bon = BON[(size_t)t * 8 + h];
                const float mean = row16_sum((y[0] + y[1]) + (y[2] + y[3])) * (1.0f / 64.0f); const f32x4 dl = y - mean;
                const float var = row16_sum((dl[0] * dl[0] + dl[1] * dl[1]) + (dl[2] * dl[2] + dl[3] * dl[3])) * (1.0f / 64.0f); const float rs = rsqrtf(var + 64e-5f);
                st_bf4(Y + (size_t)t * 512 + h * 64 + kq * 4, ((dl * rs) * lw + lb + vv * bon) * gg); }
        }
#endif
        } break;
        case 7: {
#if (PHMASK >> 7) & 1
        for (int rep = 0; rep < REPG; ++rep) {
        { PH_BEGIN
            pg8::Gemm g{XB_, (const bf16_t*)(WB + WB_WG), T, 3072, D, D, D, 0, 0}; pg8::StaticOrder S; S.init(T, 3072, G, bid, 1);
            EpiGate E{(bf16_t*)SC_, SS + (size_t)1 * T * 16}; pg8::gemm_phase(lds, g, S, E, tid);
        }
        }
#endif
        } break;
        case 8: {
#if (PHMASK >> 8) & 1
        for (int rep = 0; rep < REPG; ++rep) {
        { PH_BEGIN
            pg8::Gemm g{Y_, (const bf16_t*)(WB + WB_WBR), T, D, 512, 512, 512, (unsigned)T * 512u * 2u, (unsigned)D * 512u * 2u}; pg8::StaticOrder S; S.init(T, D, G, bid, 3);
            EpiMerge E{(const bf16_t*)SC_, (float*)(U_ + U_MG), (bf16_t*)(U_ + U_MGB)}; pg8::gemm_phase(lds, g, S, E, tid);
        }
        }
#endif
        } break;
        case 9: {
#if (PHMASK >> 9) & 1
        { PH_BEGIN
            pg8::Gemm g{(const bf16_t*)(U_ + U_MGB), (const bf16_t*)(WB + WB_WO), T, D, D, D, D, 0, 0}; pg8::StaticOrder S; S.init(T, D, G, bid, 1);
            EpiRes E{OUT, OUT, XB_, SS + (size_t)2 * T * 16, 1.0f}; pg8::gemm_phase(lds, g, S, E, tid);
        }
#endif
        } break;
        case 10: {
#if (PHMASK >> 10) & 1
        for (int rep = 0; rep < REPG; ++rep) {
        { PH_BEGIN
            pg8::Gemm g{XB_, (const bf16_t*)(WB + WB_W2A), T, 2 * FF, D, D, D, 0, 0}; pg8::StaticOrder S; S.init(T, 2 * FF, G, bid, 1);
            EpiFFNa E{(bf16_t*)U_, SS + (size_t)2 * T * 16}; pg8::gemm_phase(lds, g, S, E, tid);
        }
        }
#endif
        } break;
        case 11: {
#if (PHMASK >> 11) & 1
        { PH_BEGIN
            pg8::Gemm g{(const bf16_t*)U_, (const bf16_t*)(WB + WB_W2B), T, D, FF, FF, FF, 0, 0}; pg8::StaticOrder S; S.init(T, D, G, bid, 1);
            EpiRes E{OUT, OUT, XB_, SS + (size_t)0 * T * 16, 0.5f}; pg8::gemm_phase(lds, g, S, E, tid);
        }
#endif
        } break;
        default: break;
        }
        if (ph == 0) grid.sync();
        else grid_bar((unsigned*)(P.ws + WS_BAR), (unsigned)ph * gridDim.x);
    }
}

extern "C" void kernel_launch(void* const* d_in, const int* in_sizes, int n_in, void* d_out, int out_size, void* d_ws, size_t ws_size, hipStream_t stream) {
    static int grid_blocks = 0;
    if (!grid_blocks) {
        if (n_in != 33 || ws_size < WS_END) { fprintf(stderr, "kernel_launch: need 33 inputs and %zu bytes of workspace (got %d, %zu)\n", (size_t)WS_END, n_in, ws_size); grid_blocks = -1; return; }
        int dev = 0, cus = 0, per_cu = 0;
        hipGetDevice(&dev); hipDeviceGetAttribute(&cus, hipDeviceAttributeMultiprocessorCount, dev);
        if (hipFuncSetAttribute((const void*)mega, hipFuncAttributeMaxDynamicSharedMemorySize, LDS_BYTES) != hipSuccess) { fprintf(stderr, "kernel_launch: hipFuncSetAttribute failed\n"); grid_blocks = -1; return; }
        if (hipOccupancyMaxActiveBlocksPerMultiprocessor(&per_cu, (const void*)mega, 512, LDS_BYTES) != hipSuccess || per_cu < 1) { fprintf(stderr, "kernel_launch: occupancy query says %d\n", per_cu); per_cu = 1; }
        (void)hipGetLastError();
        grid_blocks = cus * per_cu;
        if (grid_blocks != 256) { fprintf(stderr, "kernel_launch: this kernel splits a 256-workgroup grid in its scan phase (got %d)\n", grid_blocks); grid_blocks = -1; return; }
    }
    if (grid_blocks < 0) return;
    if (hipMemsetAsync((char*)d_ws + WS_BAR, 0, 256, stream) != hipSuccess) { fprintf(stderr, "kernel_launch: memset failed\n"); return; }
    Params p{};
    for (int i = 0; i < 33; ++i) p.in[i] = (const float*)d_in[i];
    p.out = (float*)d_out; p.ws = (unsigned char*)d_ws;
    void* args[] = {&p};
    hipError_t e = hipLaunchCooperativeKernel((const void*)mega, dim3(grid_blocks), dim3(512), args, LDS_BYTES, stream);
    if (e != hipSuccess) fprintf(stderr, "cooperative launch failed: %s (grid %d)\n", hipGetErrorString(e), grid_blocks);
}
```

```cpp
#include <hip/hip_runtime.h>
#include <hip/hip_cooperative_groups.h>
#include <cstdio>
namespace cg = cooperative_groups;
#ifndef P4SUB
#define P4SUB 7
#endif
#ifndef REP5
#define REP5 1
#endif
#ifndef REP4
#define REP4 1
#endif
#ifndef REP6
#define REP6 1
#endif
#ifndef REP0
#define REP0 1
#endif
#ifndef REPG
#define REPG 1
#endif
#ifndef REPSYNC
#define REPSYNC 1
#endif
#ifndef NA4
#define NA4 2
#endif
#ifndef PHMASK
#define PHMASK 0xFFFF
#endif

#define LAS __attribute__((address_space(3)))
typedef unsigned short bf16_t;
typedef short bf16x8 __attribute__((ext_vector_type(8)));
typedef float f32x4 __attribute__((ext_vector_type(4)));
typedef float f32x2 __attribute__((ext_vector_type(2)));
typedef unsigned u32x4 __attribute__((ext_vector_type(4)));
typedef unsigned u32x2 __attribute__((ext_vector_type(2)));

constexpr int T = 16384, D = 1024, FF = 2816, SEQ = 4096, NL = 4;
constexpr int LDS_BYTES = 139264;

constexpr size_t MB = 1024 * 1024;
constexpr size_t WS_MISC = 0;
constexpr size_t WS_SS = 1 * MB;
constexpr size_t WS_WB = 4 * MB;
constexpr size_t WB_W1A = 0;
constexpr size_t WB_W1B = WB_W1A + (size_t)5632 * 1024 * 2;
constexpr size_t WB_WIN = WB_W1B + (size_t)1024 * 2816 * 2;
constexpr size_t WB_WG = WB_WIN + (size_t)4096 * 1024 * 2;
constexpr size_t WB_WBR = WB_WG + (size_t)3072 * 1024 * 2;
constexpr size_t WB_WO = WB_WBR + (size_t)3 * 1024 * 512 * 2;
constexpr size_t WB_WKV = WB_WO + (size_t)1024 * 1024 * 2;
constexpr size_t WB_W2A = WB_WKV + (size_t)1024 * 1024 * 2;
constexpr size_t WB_W2B = WB_W2A + (size_t)5632 * 1024 * 2;
constexpr size_t WB_LW2 = WB_W2B + (size_t)1024 * 2816 * 2;
constexpr size_t WB_LA2 = WB_LW2 + 512 * 64 * 2;
constexpr size_t WB_LG2 = WB_LA2 + 512 * 64 * 2;
constexpr size_t WB_LV1 = WB_LG2 + 512 * 128 * 2;
constexpr size_t WB_LV2 = WB_LV1 + 32 * 512 * 2;
constexpr size_t WB_END = WB_LV2 + 512 * 32 * 2;
static_assert(WB_END <= 55 * MB, "weights region");
constexpr size_t WS_XB = WS_WB + 55 * MB;
constexpr size_t WS_VF = WS_XB + 32 * MB;
constexpr size_t WS_MEMN = WS_VF + 32 * MB;
constexpr size_t WS_KB = WS_MEMN + 2 * MB;
constexpr size_t WS_VT = WS_KB + 1 * MB;
constexpr size_t WS_GO = WS_VT + 1 * MB;
constexpr size_t WS_BON = WS_GO + 16 * MB;
constexpr size_t WS_Y = WS_BON + 1 * MB;
constexpr size_t WS_KVC = WS_Y + 48 * MB;
constexpr size_t WS_DEC = WS_KVC + 32 * MB;
constexpr size_t WS_SC = WS_DEC + 1 * MB;
constexpr size_t SC_WD = 0;
constexpr size_t SC_V = 32 * MB;
constexpr size_t SC_RKKB = 64 * MB;
constexpr size_t WS_U = WS_SC + 128 * MB;
constexpr size_t U_RWKV = 0;
constexpr size_t U_GLA = (size_t)T * 1792 * 2;
constexpr size_t U_XA = 2 * (size_t)T * 1792 * 2;
constexpr size_t U_YRAW = 0;
constexpr size_t U_SPT = 32 * MB;
constexpr size_t U_MG = 0;
constexpr size_t U_MGB = 64 * MB;
constexpr size_t WS_END = WS_U + 128 * MB;
static_assert(U_XA + (size_t)T * 512 * 2 <= 128 * MB, "U region");

typedef __bf16 bf16x2_t __attribute__((ext_vector_type(2)));
__device__ __forceinline__ unsigned cvt_pk_bf16(float lo, float hi) { const f32x2 v = {lo, hi}; const bf16x2_t r = __builtin_convertvector(v, bf16x2_t); return __builtin_bit_cast(unsigned, r); }
__device__ __forceinline__ bf16_t f2bf(float x) { return (bf16_t)(cvt_pk_bf16(x, 0.f) & 0xffffu); }
__device__ __forceinline__ float bf2f(bf16_t b) { return __uint_as_float(((unsigned)b) << 16); }
__device__ __forceinline__ float bflo(unsigned w) { return __uint_as_float(w << 16); }
__device__ __forceinline__ float bfhi(unsigned w) { return __uint_as_float(w & 0xffff0000u); }
__device__ __forceinline__ f32x4 ld_bf4(const bf16_t* p) { const u32x2 w = *(const u32x2*)p; return (f32x4){bflo(w.x), bfhi(w.x), bflo(w.y), bfhi(w.y)}; }
__device__ __forceinline__ void st_bf4(bf16_t* p, f32x4 v) { u32x2 w; w.x = cvt_pk_bf16(v[0], v[1]); w.y = cvt_pk_bf16(v[2], v[3]); *(u32x2*)p = w; }
__device__ __forceinline__ float sigmoidf_(float x) { return 1.0f / (1.0f + __expf(-x)); }
__device__ __forceinline__ float wave_sum(float v) { for (int o = 32; o >= 1; o >>= 1) v += __shfl_xor(v, o); return v; }
__device__ __forceinline__ f32x4 mfma16(bf16x8 a, bf16x8 b, f32x4 c) { return __builtin_amdgcn_mfma_f32_16x16x32_bf16(a, b, c, 0, 0, 0); }

__device__ __forceinline__ float row_rstd(const float* ssp, int row) {
    const f32x4* p = (const f32x4*)(ssp + (size_t)row * 16); const f32x4 a = p[0], b = p[1], c = p[2], d = p[3];
    const float t = (((a[0] + a[1]) + (a[2] + a[3])) + ((b[0] + b[1]) + (b[2] + b[3]))) + (((c[0] + c[1]) + (c[2] + c[3])) + ((d[0] + d[1]) + (d[2] + d[3])));
    return rsqrtf(t * (1.0f / 1024.0f) + 1e-6f);
}
namespace pg8 {
constexpr int BM = 256, BK = 64, HALF = 128, HTB = HALF * BK * 2, STAGE_BYTES = 8 * HTB, NXCD = 8, WGM = 8;
__device__ __forceinline__ int lds_byte(int r, int c) { const int st = (r >> 4) * 2 + (c >> 5), rr = r & 15, cc = c & 31, ob = rr * 64 + cc * 2; return st * 1024 + (ob ^ (((ob >> 9) & 1) << 5)); }
__device__ __forceinline__ void stage_rc(int b, int& R, int& C) { const int st = b / 1024, sb = b % 1024, swz = sb ^ (((sb >> 9) & 1) << 5); R = (st >> 1) * 16 + swz / 64; C = (st & 1) * 32 + (swz % 64) / 2; }
__device__ __forceinline__ int perm32(int rho) { const int n = rho >> 4, i = rho & 15; return 8 * (i >> 2) + 4 * n + (i & 3); }

struct Unit { int pm, pn, z; };
struct Gemm { const bf16_t* A; const bf16_t* Bt; int M, N, K, lda, ldb; unsigned zA, zB; };

struct StaticOrder {
    int nM, nN, nwg, G, c, nz;
    __device__ void init(int M, int N, int G_, int c_, int nz_) { nM = M / BM; nN = N / BM; nwg = nM * nN; G = G_; c = c_; nz = nz_; }
    __device__ bool next(int i, Unit& u) const {
        const int ti = i / nz; u.z = i - ti * nz;
        const long L = (long)ti * G + c; if (L >= nwg) return false;
        int wgid = (int)L; { const int q = nwg / NXCD, r = nwg % NXCD, xcd = wgid % NXCD, off = wgid / NXCD; wgid = (xcd < r ? xcd * (q + 1) : r * (q + 1) + (xcd - r) * q) + off; }
        const int nig = WGM * nN, gid = wgid / nig, fm = gid * WGM, gsz = (nM - fm) < WGM ? (nM - fm) : WGM;
        u.pm = fm + ((wgid % nig) % gsz); u.pn = (wgid % nig) / gsz; return true;
    }
};

template <class Epi>
__device__ __forceinline__ void gemm_phase(LAS unsigned char* lds, const Gemm g, const StaticOrder& S, const Epi& E, const int tid) {
    const int wid = __builtin_amdgcn_readfirstlane(tid >> 6), lane = tid & 63, wr = wid >> 2, wc = wid & 3, fr = lane & 15, fq = lane >> 4;
    const int K = g.K, nt = K / BK;
    unsigned voffA[2], voffB[2];
#pragma unroll
    for (int i = 0; i < 2; ++i) { int R, C; stage_rc(tid * 16 + i * 8192, R, C); const int Rb = Epi::PERM ? ((R & ~31) + perm32(R & 31)) : R;
        voffA[i] = (unsigned)(R * g.lda + C) * 2u; voffB[i] = (unsigned)(Rb * g.ldb + C) * 2u; }
    const unsigned kstep = (unsigned)(BK * 2);
    const unsigned hstepA = (unsigned)HALF * g.lda * 2u, hstepB = (unsigned)HALF * g.ldb * 2u;
    const unsigned tstepA = 2u * hstepA, tstepB = 2u * hstepB;
    const unsigned ldsw = (unsigned)wid * 1024u;
    const int aoff = lds_byte(wr * 64 + fr, fq * 8), boff = lds_byte(wc * 32 + fr, fq * 8);
    const char* const gA = (const char*)g.A; const char* const gB = (const char*)g.Bt;
#define PG8_SA(b, h) (((b) * 2 + (h)) * HTB)
#define PG8_SB(b, h) ((4 + (b) * 2 + (h)) * HTB)
#define PG8_STAGE(bufoff, gbase, soff, voff) do { _Pragma("unroll") for (int _i = 0; _i < 2; ++_i) \
        __builtin_amdgcn_global_load_lds((const unsigned*)(((gbase) + (size_t)(unsigned)(soff)) + (voff)[_i]), (LAS unsigned*)(lds + (bufoff) + ldsw + _i * 8192), 16, 0, 0); } while (0)
#define PG8_LDA(dst, b, h) do { _Pragma("unroll") for (int m = 0; m < 4; ++m) _Pragma("unroll") for (int k = 0; k < 2; ++k) dst[m][k] = *(const LAS bf16x8*)(lds + PG8_SA(b, h) + aoff + m * 2048 + k * 1024); } while (0)
#define PG8_LDB(dst, b, h) do { _Pragma("unroll") for (int n = 0; n < 2; ++n) _Pragma("unroll") for (int k = 0; k < 2; ++k) dst[n][k] = *(const LAS bf16x8*)(lds + PG8_SB(b, h) + boff + n * 2048 + k * 1024); } while (0)
#define PG8_MMA(ai, bj, At, Bt) do { __builtin_amdgcn_s_setprio(1); _Pragma("unroll") for (int m = 0; m < 4; ++m) _Pragma("unroll") for (int n = 0; n < 2; ++n) _Pragma("unroll") for (int k = 0; k < 2; ++k) \
        acc[ai][bj][m][n] = __builtin_amdgcn_mfma_f32_16x16x32_bf16(Bt[n][k], At[m][k], acc[ai][bj][m][n], 0, 0, 0); __builtin_amdgcn_s_setprio(0); } while (0)
#define PG8_WAIT_V(n) asm volatile("s_waitcnt vmcnt(" #n ")" ::: "memory")
#define PG8_WAIT_L(n) asm volatile("s_waitcnt lgkmcnt(" #n ")" ::: "memory")
#define PG8_BAR __builtin_amdgcn_s_barrier()
#define PG8_SCHED __builtin_amdgcn_sched_barrier(0)
    Unit cur, nxt; int ui = 0;
    if (!S.next(0, cur)) return;
    f32x4 acc[2][2][4][2];
#pragma unroll
    for (int a = 0; a < 2; ++a)
#pragma unroll
        for (int b = 0; b < 2; ++b)
#pragma unroll
            for (int m = 0; m < 4; ++m)
#pragma unroll
                for (int n = 0; n < 2; ++n) acc[a][b][m][n] = (f32x4){0.f, 0.f, 0.f, 0.f};
    bf16x8 At[4][2], B0[2][2], B1[2][2];
    unsigned cA = (unsigned)cur.z * g.zA + (unsigned)cur.pm * tstepA, cB = (unsigned)cur.z * g.zB + (unsigned)cur.pn * tstepB;
    PG8_STAGE(PG8_SB(0, 0), gB, cB, voffB); PG8_STAGE(PG8_SA(0, 0), gA, cA, voffA); PG8_STAGE(PG8_SB(0, 1), gB, cB + hstepB, voffB); PG8_STAGE(PG8_SA(0, 1), gA, cA + hstepA, voffA);
    if (wr == 1) PG8_BAR;
    PG8_WAIT_V(4); PG8_BAR;
    PG8_STAGE(PG8_SB(1, 0), gB, cB + kstep, voffB); PG8_STAGE(PG8_SA(1, 0), gA, cA + kstep, voffA); PG8_STAGE(PG8_SB(1, 1), gB, cB + hstepB + kstep, voffB);
    PG8_WAIT_V(6); PG8_BAR;
    for (;;) {
        const bool has_next = S.next(ui + 1, nxt);
        const unsigned nA = has_next ? (unsigned)nxt.z * g.zA + (unsigned)nxt.pm * tstepA : cA, nB = has_next ? (unsigned)nxt.z * g.zB + (unsigned)nxt.pn * tstepB : cB;
        for (int t = 0; t < nt; t += 2) {
            const bool last = (t == nt - 2);
            const unsigned a1 = cA + (unsigned)(t + 1) * kstep;
            const unsigned a2 = last ? nA : cA + (unsigned)(t + 2) * kstep, b2 = last ? nB : cB + (unsigned)(t + 2) * kstep;
            const unsigned a3 = a2 + kstep, b3 = b2 + kstep;
            PG8_LDB(B0, 0, 0); PG8_SCHED; PG8_LDA(At, 0, 0); PG8_STAGE(PG8_SA(1, 1), gA, a1 + hstepA, voffA);
            PG8_WAIT_L(8); PG8_BAR; PG8_WAIT_L(0); PG8_MMA(0, 0, At, B0); PG8_BAR; PG8_SCHED;
            PG8_LDB(B1, 0, 1); PG8_STAGE(PG8_SB(0, 0), gB, b2, voffB);
            PG8_BAR; PG8_WAIT_L(0); PG8_MMA(0, 1, At, B1); PG8_BAR;
            PG8_LDA(At, 0, 1); PG8_STAGE(PG8_SA(0, 0), gA, a2, voffA);
            PG8_BAR; PG8_WAIT_L(0); PG8_MMA(1, 0, At, B0); PG8_BAR; PG8_SCHED;
            PG8_STAGE(PG8_SB(0, 1), gB, b2 + hstepB, voffB);
            PG8_WAIT_V(6); PG8_BAR; PG8_MMA(1, 1, At, B1); PG8_BAR;
            PG8_LDB(B0, 1, 0); PG8_SCHED; PG8_LDA(At, 1, 0); PG8_STAGE(PG8_SA(0, 1), gA, a2 + hstepA, voffA);
            PG8_WAIT_L(8); PG8_BAR; PG8_WAIT_L(0); PG8_MMA(0, 0, At, B0); PG8_BAR; PG8_SCHED;
            PG8_LDB(B1, 1, 1); PG8_STAGE(PG8_SB(1, 0), gB, b3, voffB);
            PG8_BAR; PG8_WAIT_L(0); PG8_MMA(0, 1, At, B1); PG8_BAR;
            PG8_LDA(At, 1, 1); PG8_STAGE(PG8_SA(1, 0), gA, a3, voffA);
            PG8_BAR; PG8_WAIT_L(0); PG8_MMA(1, 0, At, B0); PG8_BAR; PG8_SCHED;
            PG8_STAGE(PG8_SB(1, 1), gB, b3 + hstepB, voffB);
            PG8_WAIT_V(6); PG8_BAR; PG8_MMA(1, 1, At, B1); PG8_BAR;
        }
        E(acc, cur, wr, wc, fr, fq);
        if (!has_next) break;
#pragma unroll
        for (int a = 0; a < 2; ++a)
#pragma unroll
            for (int b = 0; b < 2; ++b)
#pragma unroll
                for (int m = 0; m < 4; ++m)
#pragma unroll
                    for (int n = 0; n < 2; ++n) acc[a][b][m][n] = (f32x4){0.f, 0.f, 0.f, 0.f};
        cur = nxt; cA = nA; cB = nB; ++ui;
    }
    PG8_WAIT_V(0);
    if (wr == 0) PG8_BAR;
    PG8_BAR;
#undef PG8_SA
#undef PG8_SB
#undef PG8_STAGE
#undef PG8_LDA
#undef PG8_LDB
#undef PG8_MMA
#undef PG8_WAIT_V
#undef PG8_WAIT_L
#undef PG8_BAR
#undef PG8_SCHED
}
}
using pg8::Unit;
typedef f32x4 Acc[2][2][4][2];

struct EpiFFNa { static constexpr bool PERM = false; bf16_t* H; const float* ss;
    __device__ __forceinline__ void operator()(const Acc& acc, const Unit& u, int wr, int wc, int fr, int fq) const {
        const int row0 = u.pm * 256 + wr * 64 + fr, hc0 = u.pn * 128 + wc * 16 + 4 * fq;
#pragma unroll
        for (int ai = 0; ai < 2; ++ai)
#pragma unroll
            for (int m = 0; m < 4; ++m) { const int row = row0 + ai * 128 + m * 16; const float rs = row_rstd(ss, row);
#pragma unroll
                for (int bj = 0; bj < 2; ++bj) { const f32x4 gt = acc[ai][bj][m][0] * rs, up = acc[ai][bj][m][1] * rs; f32x4 h;
#pragma unroll
                    for (int j = 0; j < 4; ++j) h[j] = gt[j] * sigmoidf_(gt[j]) * up[j];
                    st_bf4(H + (size_t)row * FF + hc0 + bj * 64, h); } }
    }
};
struct EpiRes { static constexpr bool PERM = false; const float* xin; float* xout; bf16_t* xb; float* ss_out; float scale;
    __device__ __forceinline__ void operator()(const Acc& acc, const Unit& u, int wr, int wc, int fr, int fq) const {
        const int row0 = u.pm * 256 + wr * 64 + fr, col0 = u.pn * 256 + wc * 32 + 4 * fq;
#pragma unroll
        for (int ai = 0; ai < 2; ++ai)
#pragma unroll
            for (int m = 0; m < 4; ++m) { const int row = row0 + ai * 128 + m * 16; float q = 0.f;
#pragma unroll
                for (int bj = 0; bj < 2; ++bj)
#pragma unroll
                    for (int n = 0; n < 2; ++n) { const size_t o = (size_t)row * D + col0 + bj * 128 + n * 16; const f32x4 v = *(const f32x4*)(xin + o) + acc[ai][bj][m][n] * scale;
                        *(f32x4*)(xout + o) = v; st_bf4(xb + o, v); q += (v[0] * v[0] + v[1] * v[1]) + (v[2] * v[2] + v[3] * v[3]); }
                q += __shfl_xor(q, 16); q += __shfl_xor(q, 32);
                if (fq == 0) ss_out[(size_t)row * 16 + u.pn * 4 + wc] = q; }
    }
};
struct EpiU { static constexpr bool PERM = true; bf16_t* Ubase; const float* ss;
    __device__ __forceinline__ void operator()(const Acc& acc, const Unit& u, int wr, int wc, int fr, int fq) const {
        bf16_t* base; int ld, c0;
        if (u.pn < 7) { base = (bf16_t*)((char*)Ubase + U_RWKV); ld = 1792; c0 = u.pn * 256; }
        else if (u.pn < 14) { base = (bf16_t*)((char*)Ubase + U_GLA); ld = 1792; c0 = (u.pn - 7) * 256; }
        else { base = (bf16_t*)((char*)Ubase + U_XA); ld = 512; c0 = (u.pn - 14) * 256; }
        const int row0 = u.pm * 256 + wr * 64 + fr; c0 += wc * 32 + 8 * fq;
#pragma unroll
        for (int ai = 0; ai < 2; ++ai)
#pragma unroll
            for (int m = 0; m < 4; ++m) { const int row = row0 + ai * 128 + m * 16; const float rs = row_rstd(ss, row);
#pragma unroll
                for (int bj = 0; bj < 2; ++bj) { const f32x4 v0 = acc[ai][bj][m][0] * rs, v1 = acc[ai][bj][m][1] * rs; u32x4 w;
                    w.x = cvt_pk_bf16(v0[0], v0[1]); w.y = cvt_pk_bf16(v0[2], v0[3]); w.z = cvt_pk_bf16(v1[0], v1[1]); w.w = cvt_pk_bf16(v1[2], v1[3]);
                    *(u32x4*)(base + (size_t)row * ld + c0 + bj * 128) = w; } }
    }
};
struct EpiGate { static constexpr bool PERM = true; bf16_t* Gt; const float* ss;
    __device__ __forceinline__ void operator()(const Acc& acc, const Unit& u, int wr, int wc, int fr, int fq) const {
        const int row0 = u.pm * 256 + wr * 64 + fr, c0 = u.pn * 256 + wc * 32 + 8 * fq;
#pragma unroll
        for (int ai = 0; ai < 2; ++ai)
#pragma unroll
            for (int m = 0; m < 4; ++m) { const int row = row0 + ai * 128 + m * 16; const float rs = row_rstd(ss, row);
#pragma unroll
                for (int bj = 0; bj < 2; ++bj) { f32x4 v0 = acc[ai][bj][m][0] * rs, v1 = acc[ai][bj][m][1] * rs;
#pragma unroll
                    for (int j = 0; j < 4; ++j) { v0[j] = sigmoidf_(v0[j]); v1[j] = sigmoidf_(v1[j]); }
                    u32x4 w; w.x = cvt_pk_bf16(v0[0], v0[1]); w.y = cvt_pk_bf16(v0[2], v0[3]); w.z = cvt_pk_bf16(v1[0], v1[1]); w.w = cvt_pk_bf16(v1[2], v1[3]);
                    *(u32x4*)(Gt + (size_t)row * 3072 + c0 + bj * 128) = w; } }
    }
};
struct EpiMerge { static constexpr bool PERM = false; const bf16_t* Gt; float* Mg; bf16_t* Mb;
    __device__ __forceinline__ void operator()(const Acc& acc, const Unit& u, int wr, int wc, int fr, int fq) const {
        const int row0 = u.pm * 256 + wr * 64 + fr, col0 = u.pn * 256 + wc * 32 + 4 * fq;
#pragma unroll
        for (int ai = 0; ai < 2; ++ai)
#pragma unroll
            for (int m = 0; m < 4; ++m) { const int row = row0 + ai * 128 + m * 16;
#pragma unroll
                for (int bj = 0; bj < 2; ++bj)
#pragma unroll
                    for (int n = 0; n < 2; ++n) { const int col = col0 + bj * 128 + n * 16; const size_t o = (size_t)row * D + col;
                        f32x4 v = acc[ai][bj][m][n] * ld_bf4(Gt + (size_t)row * 3072 + u.z * 1024 + col);
                        if (u.z > 0) v += *(const f32x4*)(Mg + o);
                        if (u.z < 2) *(f32x4*)(Mg + o) = v; else st_bf4(Mb + o, v); } }
    }
};
struct EpiKV { static constexpr bool PERM = false; bf16_t* Kb; bf16_t* Vt; const float* rstd;
    __device__ __forceinline__ void operator()(const Acc& acc, const Unit& u, int wr, int wc, int fr, int fq) const {
        const int row0 = u.pm * 256 + wr * 64 + fr, col0 = u.pn * 256 + wc * 32 + 4 * fq;
#pragma unroll
        for (int ai = 0; ai < 2; ++ai)
#pragma unroll
            for (int m = 0; m < 4; ++m) { const int row = row0 + ai * 128 + m * 16; const float rs = rstd[row];
#pragma unroll
                for (int bj = 0; bj < 2; ++bj)
#pragma unroll
                    for (int n = 0; n < 2; ++n) { const int col = col0 + bj * 128 + n * 16; const f32x4 v = acc[ai][bj][m][n] * rs;
                        if (col < 512) st_bf4(Kb + (size_t)row * 512 + col, v);
                        else {
#pragma unroll
                            for (int j = 0; j < 4; ++j) Vt[((size_t)(row >> 8) * 512 + (col - 512 + j)) * 256 + (row & 255)] = f2bf(v[j]); } } }
    }
};

template <int MAP> __device__ __forceinline__ int colmap(int n) {
    if (MAP == 1) { const int g = n >> 5, i = n & 31; return i < 16 ? 16 * g + i : FF + 16 * g + (i - 16); }
    if (MAP == 2) { if (n < 3344) return n; if (n < 3584) return -1; return n - 240; }
    return n;
}
template <int MAP>
__device__ __forceinline__ void convT(LAS unsigned char* lds, const float* src, int ld, int coff, const float* g, bf16_t* dst, int K, int Kd, int Nd, int G, int bid, int tid) {
    const int nkt = (K + 63) >> 6, nnt = (Nd + 63) >> 6, ntile = nkt * nnt;
    LAS bf16_t* tile = (LAS bf16_t*)lds;
    for (int t = bid; t < ntile; t += G) {
        const int kt = t % nkt, ntl = t / nkt, k0 = kt * 64, n0 = ntl * 64;
        { const int nl = tid & 63, kl0 = tid >> 6, n = n0 + nl; const int c = (n < Nd) ? colmap<MAP>(n) : -1;
#pragma unroll
          for (int i = 0; i < 8; ++i) { const int kl = kl0 + 8 * i, k = k0 + kl; float v = 0.f;
              if (c >= 0 && k < K) { v = src[(size_t)k * ld + coff + c]; if (g) v *= g[k]; }
              tile[nl * 72 + kl] = f2bf(v); } }
        __syncthreads();
        { const int nl = tid >> 3, kc = (tid & 7) * 8, n = n0 + nl, k = k0 + kc;
          if (n < Nd && k < Kd) *(u32x4*)(dst + (size_t)n * Kd + k) = *(LAS u32x4*)(tile + nl * 72 + kc); }
        __syncthreads();
    }
}

template <int MAP>
__device__ __forceinline__ void convT_w(const float* src, int ld, int coff, const float* g, bf16_t* dst, int K, int Kd, int Nd, int wslot, int nslots, int lane) {
    const int nkt = K >> 4, nnt = (Nd + 255) >> 8, ntile = nkt * nnt;
    for (int t = wslot; t < ntile; t += nslots) {
        const int kt = t % nkt, ntl = t / nkt, k0 = kt * 16, n = ntl * 256 + lane * 4; const int c = (n < Nd) ? colmap<MAP>(n) : -1;
        const float* sp = src + (size_t)k0 * ld + coff + (c >= 0 ? c : 0);
        f32x4 v[16];
#pragma unroll
        for (int kk = 0; kk < 16; ++kk) { v[kk] = *(const f32x4*)(sp + (size_t)kk * ld); if (g) v[kk] *= g[k0 + kk]; if (c < 0) v[kk] = (f32x4){0.f, 0.f, 0.f, 0.f}; }
        if (n < Nd) {
#pragma unroll
            for (int j = 0; j < 4; ++j) { u32x4 lo, hi;
                lo.x = cvt_pk_bf16(v[0][j], v[1][j]); lo.y = cvt_pk_bf16(v[2][j], v[3][j]); lo.z = cvt_pk_bf16(v[4][j], v[5][j]); lo.w = cvt_pk_bf16(v[6][j], v[7][j]);
                hi.x = cvt_pk_bf16(v[8][j], v[9][j]); hi.y = cvt_pk_bf16(v[10][j], v[11][j]); hi.z = cvt_pk_bf16(v[12][j], v[13][j]); hi.w = cvt_pk_bf16(v[14][j], v[15][j]);
                bf16_t* dp = dst + (size_t)(n + j) * Kd + k0; *(u32x4*)dp = lo; *(u32x4*)(dp + 8) = hi; }
        }
    }
}

template <int K>
__device__ __forceinline__ void wave_gemm(f32x4 (&acc)[4][4], LAS const unsigned char* A, int sA, const bf16_t* Bt, int fr, int fq) {
#pragma unroll
    for (int m = 0; m < 4; ++m)
#pragma unroll
        for (int n = 0; n < 4; ++n) acc[m][n] = (f32x4){0.f, 0.f, 0.f, 0.f};
#pragma unroll
    for (int ks = 0; ks < K / 32; ++ks) { bf16x8 a[4], b[4];
#pragma unroll
        for (int m = 0; m < 4; ++m) a[m] = *(LAS const bf16x8*)(A + (16 * m + fr) * sA + (ks * 32 + fq * 8) * 2);
#pragma unroll
        for (int n = 0; n < 4; ++n) b[n] = *(const bf16x8*)(Bt + (size_t)(16 * n + fr) * K + ks * 32 + fq * 8);
#pragma unroll
        for (int m = 0; m < 4; ++m)
#pragma unroll
            for (int n = 0; n < 4; ++n) acc[m][n] = mfma16(b[n], a[m], acc[m][n]); }
}

template <int K>
__device__ __forceinline__ void row_gemm(f32x4 (&acc)[4], LAS const unsigned char* Arow, const bf16_t* Bt, int fr, int fq) {
#pragma unroll
    for (int n = 0; n < 4; ++n) acc[n] = (f32x4){0.f, 0.f, 0.f, 0.f};
#pragma unroll
    for (int ks = 0; ks < K / 32; ++ks) { const bf16x8 a = *(LAS const bf16x8*)(Arow + (ks * 32 + fq * 8) * 2);
#pragma unroll
        for (int n = 0; n < 4; ++n) { const bf16x8 b = *(const bf16x8*)(Bt + (size_t)(16 * n + fr) * K + ks * 32 + fq * 8); acc[n] = mfma16(b, a, acc[n]); } }
}

struct PrepArgs { const bf16_t* U; const float *mu, *w0, *a0, *kk_, *ka, *rk, *v0; const bf16_t *w2t, *a2t, *g2t, *v1t, *v2t; float* vfirst; float* Wd; float* V; bf16_t* RKKB; bf16_t* Go; float* Bon; int layer; };

__device__ __forceinline__ f32x4 shifted4(const bf16_t* Ut, bool has_prev, int c, const float* mu) {
    const f32x4 u = ld_bf4(Ut + c); f32x4 p = (f32x4){0.f, 0.f, 0.f, 0.f}; if (has_prev) p = ld_bf4(Ut - 1792 + c);
    const f32x4 m = *(const f32x4*)(mu + c); return u + m * (p - u);
}

__device__ __forceinline__ void rwkv_prep_tile(LAS unsigned char* lds, const PrepArgs& P, int tt, int tid) {
    constexpr int SW = 144, SG = 272, SV = 1040, SVV = 80;
    LAS unsigned char* LAw = lds; LAS unsigned char* LAa = lds + 9216; LAS unsigned char* LAg = lds + 18432; LAS unsigned char* LAv = lds + 35840; LAS unsigned char* LAvv = lds + 102400;
    const int t0 = tt * 64; const int s0 = t0 & (SEQ - 1);
    const int lane = tid & 63, wave = __builtin_amdgcn_readfirstlane(tid >> 6), fr = lane & 15, fq = lane >> 4;
#pragma unroll 2
    for (int e = 0; e < 4; ++e) { const int idx = tid + 512 * e, i = idx >> 5, c = (idx & 31) * 8; const bf16_t* Ut = P.U + (size_t)(t0 + i) * 1792; const bool hp = s0 + i > 0;
        f32x4 x0 = shifted4(Ut, hp, 1536 + c, P.mu), x1 = shifted4(Ut, hp, 1536 + c + 4, P.mu);
        if (c < 64) {
#pragma unroll
            for (int q = 0; q < 4; ++q) { const float ea = __expf(2.f * x0[q]), eb = __expf(2.f * x1[q]); x0[q] = 1.f - 2.f / (ea + 1.f); x1[q] = 1.f - 2.f / (eb + 1.f); } }
        else if (c >= 128) {
#pragma unroll
            for (int q = 0; q < 4; ++q) { x0[q] = sigmoidf_(x0[q]); x1[q] = sigmoidf_(x1[q]); } }
        u32x4 o; o.x = cvt_pk_bf16(x0[0], x0[1]); o.y = cvt_pk_bf16(x0[2], x0[3]); o.z = cvt_pk_bf16(x1[0], x1[1]); o.w = cvt_pk_bf16(x1[2], x1[3]);
        LAS unsigned char* dstp = (c < 64) ? (LAw + i * SW + c * 2) : (c < 128) ? (LAa + i * SW + (c - 64) * 2) : (LAg + i * SG + (c - 128) * 2);
        *(LAS u32x4*)dstp = o; }
    if (P.layer > 0) {
#pragma unroll 2
        for (int e = 0; e < 8; ++e) { const int idx = tid + 512 * e, i = idx >> 6, c = (idx & 63) * 8; const bf16_t* Ut = P.U + (size_t)(t0 + i) * 1792; const bool hp = s0 + i > 0;
            const f32x4 x0 = shifted4(Ut, hp, 1024 + c, P.mu), x1 = shifted4(Ut, hp, 1024 + c + 4, P.mu);
            u32x4 o; o.x = cvt_pk_bf16(x0[0], x0[1]); o.y = cvt_pk_bf16(x0[2], x0[3]); o.z = cvt_pk_bf16(x1[0], x1[1]); o.w = cvt_pk_bf16(x1[2], x1[3]);
            *(LAS u32x4*)(LAv + i * SV + c * 2) = o; }
    }
    __syncthreads();
    if (P.layer > 0) {
        const int mt = wave >> 1, nt = wave & 1; f32x4 acc = (f32x4){0.f, 0.f, 0.f, 0.f};
#pragma unroll 4
        for (int ks = 0; ks < 16; ++ks) { const bf16x8 a = *(LAS const bf16x8*)(LAv + (16 * mt + fr) * SV + (ks * 32 + fq * 8) * 2);
            const bf16x8 b = *(const bf16x8*)(P.v1t + (size_t)(16 * nt + fr) * 512 + ks * 32 + fq * 8); acc = mfma16(b, a, acc); }
        u32x2 w; w.x = cvt_pk_bf16(acc[0], acc[1]); w.y = cvt_pk_bf16(acc[2], acc[3]); *(LAS u32x2*)(LAvv + (16 * mt + fr) * SVV + (16 * nt + 4 * fq) * 2) = w;
    }
    __syncthreads();
    const int h = wave, cb = 64 * h; const int b_ = t0 >> 12, p = b_ * 8 + h;
#pragma unroll 1
    for (int m = 0; m < 4; ++m) {
        const int i = 16 * m + fr; const bf16_t* Ut = P.U + (size_t)(t0 + i) * 1792; const bool hp = (s0 + i) > 0;
        int fq4 = 4 * fq; asm volatile("" : "+v"(fq4));
        f32x4 aa[4], acc[4];
        row_gemm<64>(aa, LAa + i * SW, P.a2t + (size_t)cb * 64, fr, fq);
#pragma unroll
        for (int n = 0; n < 4; ++n) { const f32x4 a0v = *(const f32x4*)(P.a0 + cb + 16 * n + fq4);
#pragma unroll
            for (int j = 0; j < 4; ++j) aa[n][j] = sigmoidf_(aa[n][j] + a0v[j]); }
        row_gemm<64>(acc, LAw + i * SW, P.w2t + (size_t)cb * 64, fr, fq);
#pragma unroll
        for (int n = 0; n < 4; ++n) { const f32x4 w0v = *(const f32x4*)(P.w0 + cb + 16 * n + fq4); f32x4 d;
#pragma unroll
            for (int j = 0; j < 4; ++j) d[j] = __expf(-0.6065306597f * sigmoidf_(acc[n][j] + w0v[j]));
            *(f32x4*)(P.Wd + ((size_t)p * SEQ + s0 + i) * 64 + 16 * n + fq4) = d; }
        row_gemm<128>(acc, LAg + i * SG, P.g2t + (size_t)cb * 128, fr, fq);
#pragma unroll
        for (int n = 0; n < 4; ++n) st_bf4(P.Go + (size_t)(t0 + i) * 512 + cb + 16 * n + fq4, acc[n]);
        asm volatile("" ::: "memory");
        if (P.layer > 0) row_gemm<32>(acc, LAvv + i * SVV, P.v2t + (size_t)cb * 32, fr, fq);
        float bon = 0.f, nk = 0.f; f32x4 kv[4], rv[4];
#pragma unroll
        for (int n = 0; n < 4; ++n) { const int c = cb + 16 * n + fq4;
            f32x4 v = shifted4(Ut, hp, 1024 + c, P.mu);
            if (P.layer > 0) { const f32x4 vf = *(const f32x4*)(P.vfirst + (size_t)(t0 + i) * 512 + c); const f32x4 v0v = *(const f32x4*)(P.v0 + c);
#pragma unroll
                for (int j = 0; j < 4; ++j) v[j] = v[j] + (vf[j] - v[j]) * sigmoidf_(v0v[j] + acc[n][j]); }
            else *(f32x4*)(P.vfirst + (size_t)(t0 + i) * 512 + c) = v;
            *(f32x4*)(P.V + ((size_t)p * SEQ + s0 + i) * 64 + 16 * n + fq4) = v;
            kv[n] = shifted4(Ut, hp, 512 + c, P.mu); rv[n] = shifted4(Ut, hp, c, P.mu);
            const f32x4 kkw = *(const f32x4*)(P.kk_ + c);
#pragma unroll
            for (int j = 0; j < 4; ++j) { const float x = kv[n][j] * kkw[j]; nk += x * x; } }
        nk += __shfl_xor(nk, 16); nk += __shfl_xor(nk, 32);
        const float inv = 1.0f / fmaxf(sqrtf(nk), 1e-12f);
        bf16_t* O = P.RKKB + ((size_t)p * SEQ + s0 + i) * 256;
#pragma unroll
        for (int n = 0; n < 4; ++n) { const int c = cb + 16 * n + fq4; const f32x4 kkw = *(const f32x4*)(P.kk_ + c), kaw = *(const f32x4*)(P.ka + c), rkw = *(const f32x4*)(P.rk + c);
            f32x4 kk, kh, bb;
#pragma unroll
            for (int j = 0; j < 4; ++j) { const float a = aa[n][j]; kk[j] = kv[n][j] * kkw[j] * inv; kh[j] = kv[n][j] * (1.f + (a - 1.f) * kaw[j]); bb[j] = kk[j] * a; bon += rv[n][j] * kh[j] * rkw[j]; }
            const int cc = 16 * n + fq4; st_bf4(O + cc, rv[n]); st_bf4(O + 64 + cc, kh); st_bf4(O + 128 + cc, kk); st_bf4(O + 192 + cc, bb); }
        bon += __shfl_xor(bon, 16); bon += __shfl_xor(bon, 32);
        if (fq == 0) P.Bon[(size_t)(t0 + i) * 8 + h] = bon;
        asm volatile("" ::: "memory");
    }
    __syncthreads();
}

constexpr int SCAN_CH = 32, SCAN_STEP_B = 1344, SCAN_SLOT_B = SCAN_CH * SCAN_STEP_B;
template <int CTRL> __device__ __forceinline__ float dpp_f(float v) { return __int_as_float(__builtin_amdgcn_update_dpp(0, __float_as_int(v), CTRL, 0xf, 0xf, true)); }
__device__ __forceinline__ float row16_sum(float v) { v += dpp_f<0xB1>(v); v += dpp_f<0x4E>(v); v += dpp_f<0x141>(v); v += dpp_f<0x140>(v); return v; }

__device__ __forceinline__ float tr16_sum(const float (&p)[16], int kq) {
    const bool b3 = (kq & 8) != 0, b2 = (kq & 4) != 0, b1 = (kq & 2) != 0, b0 = (kq & 1) != 0;
    float q[8], r[4], u[2];
#pragma unroll
    for (int t = 0; t < 8; ++t) { const float keep = b3 ? p[t + 8] : p[t], send = b3 ? p[t] : p[t + 8]; q[t] = keep + dpp_f<0x140>(send); }
#pragma unroll
    for (int t = 0; t < 4; ++t) { const float keep = b2 ? q[t + 4] : q[t], send = b2 ? q[t] : q[t + 4]; r[t] = keep + dpp_f<0x141>(send); }
#pragma unroll
    for (int t = 0; t < 2; ++t) { const float keep = b1 ? r[t + 2] : r[t], send = b1 ? r[t] : r[t + 2]; u[t] = keep + dpp_f<0x4E>(send); }
    const float keep = b0 ? u[1] : u[0], send = b0 ? u[0] : u[1];
    return keep + dpp_f<0xB1>(send);
}

__device__ __forceinline__ void scan_load_chunk(LAS unsigned char* slot, const float* Wd, const float* V, const bf16_t* RKKB, int p, int rg, int s0, int lt) {
    u32x4 r[7];
    const size_t base = (size_t)p * SEQ + s0;
#pragma unroll
    for (int j = 0; j < 2; ++j) { const int idx = lt + 256 * j, st = idx >> 4, part = idx & 15; r[j] = *(const u32x4*)(Wd + (base + st) * 64 + part * 4); }
#pragma unroll
    for (int j = 2; j < 6; ++j) { const int k = lt + 256 * (j - 2), st = k >> 5, rem = k & 31, q = rem >> 3, part = rem & 7; r[j] = *(const u32x4*)(RKKB + ((base + st) * 4 + q) * 64 + part * 8); }
    if (lt < 128) { const int st = lt >> 2, hf = lt & 3; r[6] = *(const u32x4*)(V + (base + st) * 64 + rg * 16 + hf * 4); }
#pragma unroll
    for (int j = 0; j < 2; ++j) { const int idx = lt + 256 * j, st = idx >> 4, part = idx & 15; *(LAS u32x4*)(slot + st * SCAN_STEP_B + part * 16) = r[j]; }
#pragma unroll
    for (int j = 2; j < 6; ++j) { const int k = lt + 256 * (j - 2), st = k >> 5, rem = k & 31, q = rem >> 3, part = rem & 7; const u32x4 w = r[j];
        const int Q = (q == 0) ? 4 : (q == 1) ? 2 : (q == 2) ? 3 : 1;
        LAS f32x4* d = (LAS f32x4*)(slot + st * SCAN_STEP_B + Q * 256 + part * 32);
        d[0] = (f32x4){bflo(w.x), bfhi(w.x), bflo(w.y), bfhi(w.y)}; d[1] = (f32x4){bflo(w.z), bfhi(w.z), bflo(w.w), bfhi(w.w)}; }
    if (lt < 128) { const int st = lt >> 2, hf = lt & 3; *(LAS u32x4*)(slot + st * SCAN_STEP_B + 1280 + hf * 16) = r[6]; }
}

__device__ __forceinline__ void rwkv_scan_unit(LAS unsigned char* lds, const float* Wd, const float* V, const bf16_t* RKKB, float* Yraw, int p, int rg, int tid) {
    const int lane = tid & 63, wave = __builtin_amdgcn_readfirstlane(tid >> 6);
    constexpr int NCH = SEQ / SCAN_CH;
    scan_load_chunk(lds + (tid >> 8) * SCAN_SLOT_B, Wd, V, RKKB, p, rg, (tid >> 8) * SCAN_CH, tid & 255);
    __syncthreads();
    f32x4 S = (f32x4){0.f, 0.f, 0.f, 0.f};
    const int kq = lane & 15, rl = wave * 4 + (lane >> 4);
    for (int c = 0; c < NCH; ++c) {
        if (wave >= 4) { if (c + 2 < NCH) scan_load_chunk(lds + ((c + 2) % 3) * SCAN_SLOT_B, Wd, V, RKKB, p, rg, (c + 2) * SCAN_CH, tid - 256); }
        else {
            LAS const unsigned char* sl = lds + (c % 3) * SCAN_SLOT_B + kq * 16;
            LAS const unsigned char* vl = lds + (c % 3) * SCAN_SLOT_B + 1280 + rl * 4;
            float* yo = Yraw + ((size_t)p * SEQ + c * SCAN_CH + kq) * 64 + rg * 16 + rl;
            f32x4 w = *(LAS const f32x4*)(sl), b = *(LAS const f32x4*)(sl + 256), k = *(LAS const f32x4*)(sl + 512), kk = *(LAS const f32x4*)(sl + 768), r = *(LAS const f32x4*)(sl + 1024);
            float v = *(LAS const float*)(vl); float yp[16];
#pragma unroll
            for (int st = 0; st < SCAN_CH; ++st) {
                f32x4 wn = w, bn = b, kn = k, kkn = kk, rn = r; float vn = v;
                if (st + 1 < SCAN_CH) { const int o = (st + 1) * SCAN_STEP_B;
                    wn = *(LAS const f32x4*)(sl + o); bn = *(LAS const f32x4*)(sl + o + 256); kn = *(LAS const f32x4*)(sl + o + 512); kkn = *(LAS const f32x4*)(sl + o + 768); rn = *(LAS const f32x4*)(sl + o + 1024);
                    vn = *(LAS const float*)(vl + o); }
                float sa = (S[0] * kk[0] + S[1] * kk[1]) + (S[2] * kk[2] + S[3] * kk[3]);
                const f32x4 kvt = k * v;
                sa = -row16_sum(sa);
                S = S * w + (b * sa + kvt);
                yp[st & 15] = (S[0] * r[0] + S[1] * r[1]) + (S[2] * r[2] + S[3] * r[3]);
                if ((st & 15) == 15) yo[(size_t)(st - 15) * 64] = tr16_sum(yp, kq);
                w = wn; b = bn; k = kn; kk = kkn; r = rn; v = vn;
            }
        }
        __syncthreads();
    }
}

struct GlaArgs { const bf16_t* Ug; const float *conv, *aup, *abias, *gnorm; float* kvcT; float* dec; bf16_t* spT; bf16_t* Yg; };
constexpr int GL_GC = 0;
constexpr int GL_T0 = 16640;
constexpr int GL_VT = GL_T0 + 4 * 9216;
constexpr int GL_AL = GL_VT + 18432;
constexpr int GL_RS = GL_AL + 9216;

__device__ __forceinline__ void gla_conv8(f32x4 (&out)[8], const bf16_t* Ug, const float* conv, int t0, int s0, int i0, int c0) {
    f32x4 w[4];
#pragma unroll
    for (int j = 0; j < 4; ++j) w[j] = *(const f32x4*)(conv + j * 1024 + c0);
#pragma unroll
    for (int e = 0; e < 8; ++e) { const int i = i0 + 8 * e; f32x4 a = (f32x4){0.f, 0.f, 0.f, 0.f};
#pragma unroll
        for (int j = 0; j < 4; ++j) { const int ds = 3 - j; if (s0 + i - ds >= 0) a += w[j] * ld_bf4(Ug + (size_t)(t0 + i - ds) * 1792 + c0); }
#pragma unroll
        for (int q = 0; q < 4; ++q) a[q] = a[q] * sigmoidf_(a[q]);
        out[e] = a; }
}
__device__ __forceinline__ void gla_gcum(LAS unsigned char* lds, const GlaArgs& A, int t0, int h, int tid) {
    LAS float* GC = (LAS float*)(lds + GL_GC);
    { const int d = tid & 63, i0 = tid >> 6; float au[16]; const float ab = A.abias[h * 64 + d];
#pragma unroll
      for (int j = 0; j < 16; ++j) au[j] = A.aup[j * 256 + h * 64 + d];
#pragma unroll
      for (int e = 0; e < 8; ++e) { const int i = i0 + 8 * e; const u32x4* ap = (const u32x4*)(A.Ug + (size_t)(t0 + i) * 1792 + 1024); const u32x4 a0 = ap[0], a1 = ap[1];
          float x = ab;
          x += bflo(a0.x) * au[0] + bfhi(a0.x) * au[1] + bflo(a0.y) * au[2] + bfhi(a0.y) * au[3] + bflo(a0.z) * au[4] + bfhi(a0.z) * au[5] + bflo(a0.w) * au[6] + bfhi(a0.w) * au[7];
          x += bflo(a1.x) * au[8] + bfhi(a1.x) * au[9] + bflo(a1.y) * au[10] + bfhi(a1.y) * au[11] + bflo(a1.z) * au[12] + bfhi(a1.z) * au[13] + bflo(a1.w) * au[14] + bfhi(a1.w) * au[15];
          const float ls = fminf(x, 0.f) - __logf(1.f + __expf(-fabsf(x)));
          GC[i * 65 + d] = ls * (1.0f / 16.0f); } }
    __syncthreads();
    { const int lane = tid & 63, wave = tid >> 6;
#pragma unroll
      for (int dd = 0; dd < 8; ++dd) { const int d = wave * 8 + dd; float x = GC[lane * 65 + d];
#pragma unroll
          for (int o = 1; o < 64; o <<= 1) { const float y = __shfl_up(x, o); if (lane >= o) x += y; }
          GC[lane * 65 + d] = x; } }
    __syncthreads();
}
__device__ __forceinline__ void gla_a_tile(LAS unsigned char* lds, const GlaArgs& A, int tile, int tid) {
    const int bh = tile >> 6, n = tile & 63, b = bh >> 2, h = bh & 3, t0 = b * SEQ + n * 64, s0 = n * 64;
    LAS float* GC = (LAS float*)(lds + GL_GC); LAS bf16_t* KDT = (LAS bf16_t*)(lds + GL_T0); LAS bf16_t* VT = (LAS bf16_t*)(lds + GL_VT);
    gla_gcum(lds, A, t0, h, tid);
    { const int cc = (tid & 63) * 4, i0 = tid >> 6;
      if (cc >= 64) { f32x4 o[8]; const int c0 = (cc < 128) ? 256 + h * 64 + (cc - 64) : 512 + h * 128 + (cc - 128);
          gla_conv8(o, A.Ug, A.conv, t0, s0, i0, c0);
          if (cc < 128) { const int d = cc - 64;
#pragma unroll
              for (int e = 0; e < 8; ++e) { const int i = i0 + 8 * e;
#pragma unroll
                  for (int q = 0; q < 4; ++q) KDT[(d + q) * 72 + i] = f2bf(o[e][q] * __expf(GC[63 * 65 + d + q] - GC[i * 65 + d + q])); } }
          else { const int ev = cc - 128;
#pragma unroll
              for (int e = 0; e < 8; ++e) { const int i = i0 + 8 * e;
#pragma unroll
                  for (int q = 0; q < 4; ++q) VT[(ev + q) * 72 + i] = f2bf(o[e][q]); } } } }
    if (tid < 64) A.dec[((size_t)bh * 64 + n) * 64 + tid] = __expf(GC[63 * 65 + tid]);
    __syncthreads();
    { const int lane = tid & 63, wave = tid >> 6, fr = lane & 15, fq = lane >> 4; f32x4 acc[4];
#pragma unroll
      for (int nt = 0; nt < 4; ++nt) acc[nt] = (f32x4){0.f, 0.f, 0.f, 0.f};
#pragma unroll
      for (int ks = 0; ks < 2; ++ks) { const bf16x8 a = *(LAS const bf16x8*)(VT + (16 * wave + fr) * 72 + ks * 32 + fq * 8);
#pragma unroll
          for (int nt = 0; nt < 4; ++nt) { const bf16x8 bfr = *(LAS const bf16x8*)(KDT + (16 * nt + fr) * 72 + ks * 32 + fq * 8); acc[nt] = mfma16(bfr, a, acc[nt]); } }
#pragma unroll
      for (int nt = 0; nt < 4; ++nt) *(f32x4*)(A.kvcT + (((size_t)bh * 64 + n) * 128 + 16 * wave + fr) * 64 + 16 * nt + 4 * fq) = acc[nt]; }
    __syncthreads();
}
__device__ __forceinline__ void gla_c_tile(LAS unsigned char* lds, const GlaArgs& A, int tile, int tid) {
    const int bh = tile >> 6, n = tile & 63, b = bh >> 2, h = bh & 3, t0 = b * SEQ + n * 64, s0 = n * 64;
    LAS float* GC = (LAS float*)(lds + GL_GC); LAS bf16_t* QG = (LAS bf16_t*)(lds + GL_T0); LAS bf16_t* KG = QG + 64 * 72; LAS bf16_t* QR = KG + 64 * 72; LAS bf16_t* KR = QR + 64 * 72;
    LAS bf16_t* VT = (LAS bf16_t*)(lds + GL_VT); LAS bf16_t* AL = (LAS bf16_t*)(lds + GL_AL); LAS float* RS = (LAS float*)(lds + GL_RS);
    gla_gcum(lds, A, t0, h, tid);
    { const int cc = (tid & 63) * 4, i0 = tid >> 6; f32x4 o[8];
      const int c0 = (cc < 64) ? h * 64 + cc : (cc < 128) ? 256 + h * 64 + (cc - 64) : 512 + h * 128 + (cc - 128);
      gla_conv8(o, A.Ug, A.conv, t0, s0, i0, c0);
      if (cc < 128) { const int d = cc & 63; const bool isq = cc < 64; LAS bf16_t* T1 = isq ? QG : KR; LAS bf16_t* T2 = isq ? QR : KG; const float sc = isq ? 0.125f : 1.0f;
#pragma unroll
          for (int e = 0; e < 8; ++e) { const int i = i0 + 8 * e; f32x4 x1, x2;
#pragma unroll
              for (int q = 0; q < 4; ++q) { const float eg = __expf(GC[i * 65 + d + q]); const float x = o[e][q] * sc; x1[q] = x * eg; x2[q] = x / eg; }
              u32x2 w1, w2; w1.x = cvt_pk_bf16(x1[0], x1[1]); w1.y = cvt_pk_bf16(x1[2], x1[3]); w2.x = cvt_pk_bf16(x2[0], x2[1]); w2.y = cvt_pk_bf16(x2[2], x2[3]);
              *(LAS u32x2*)(T1 + i * 72 + d) = w1; *(LAS u32x2*)(T2 + i * 72 + d) = w2; } }
      else { const int ev = cc - 128;
#pragma unroll
          for (int e = 0; e < 8; ++e) { const int i = i0 + 8 * e;
#pragma unroll
              for (int q = 0; q < 4; ++q) VT[(ev + q) * 72 + i] = f2bf(o[e][q]); } } }
    __syncthreads();
    const int lane = tid & 63, wave = tid >> 6, fr = lane & 15, fq = lane >> 4; const int mt = wave >> 1;
    {
#pragma unroll
        for (int q = 0; q < 2; ++q) { const int nt = (wave & 1) * 2 + q; f32x4 ap = (f32x4){0.f, 0.f, 0.f, 0.f}, af = ap;
#pragma unroll
            for (int ks = 0; ks < 2; ++ks) { const int ko = ks * 32 + fq * 8;
                ap = mfma16(*(LAS const bf16x8*)(KG + (16 * nt + fr) * 72 + ko), *(LAS const bf16x8*)(QG + (16 * mt + fr) * 72 + ko), ap);
                af = mfma16(*(LAS const bf16x8*)(KR + (16 * nt + fr) * 72 + ko), *(LAS const bf16x8*)(QR + (16 * mt + fr) * 72 + ko), af); }
            const int trow = 16 * mt + fr; f32x4 o;
#pragma unroll
            for (int j = 0; j < 4; ++j) { const int scol = 16 * nt + 4 * fq + j; o[j] = (scol <= trow) ? ap[j] : af[j]; }
            u32x2 w; w.x = cvt_pk_bf16(o[0], o[1]); w.y = cvt_pk_bf16(o[2], o[3]); *(LAS u32x2*)(AL + trow * 72 + 16 * nt + 4 * fq) = w; }
    }
    __syncthreads();
    f32x4 acc[4];
#pragma unroll
    for (int q = 0; q < 4; ++q) acc[q] = (f32x4){0.f, 0.f, 0.f, 0.f};
    const bf16_t* sp = A.spT + ((size_t)bh * 64 + n) * 128 * 64;
#pragma unroll
    for (int ks = 0; ks < 2; ++ks) { const int ko = ks * 32 + fq * 8; const bf16x8 a1 = *(LAS const bf16x8*)(AL + (16 * mt + fr) * 72 + ko), a2 = *(LAS const bf16x8*)(QG + (16 * mt + fr) * 72 + ko);
#pragma unroll
        for (int q = 0; q < 4; ++q) { const int nt = (wave & 1) * 4 + q;
            acc[q] = mfma16(*(LAS const bf16x8*)(VT + (16 * nt + fr) * 72 + ko), a1, acc[q]);
            acc[q] = mfma16(*(const bf16x8*)(sp + (size_t)(16 * nt + fr) * 64 + ko), a2, acc[q]); } }
    float ssq = 0.f;
#pragma unroll
    for (int q = 0; q < 4; ++q) ssq += (acc[q][0] * acc[q][0] + acc[q][1] * acc[q][1]) + (acc[q][2] * acc[q][2] + acc[q][3] * acc[q][3]);
    ssq += __shfl_xor(ssq, 16); ssq += __shfl_xor(ssq, 32);
    if (fq == 0) RS[(16 * mt + fr) * 2 + (wave & 1)] = ssq;
    __syncthreads();
    { const int i = 16 * mt + fr; const float rs = rsqrtf((RS[i * 2] + RS[i * 2 + 1]) * (1.0f / 128.0f) + 1e-6f);
#pragma unroll
      for (int q = 0; q < 4; ++q) { const int ecol = h * 128 + ((wave & 1) * 4 + q) * 16 + 4 * fq; const f32x4 nw = *(const f32x4*)(A.gnorm + ecol); const f32x4 go = ld_bf4(A.Ug + (size_t)(t0 + i) * 1792 + 1040 + ecol); f32x4 o;
#pragma unroll
          for (int j = 0; j < 4; ++j) o[j] = acc[q][j] * rs * nw[j] * go[j] * sigmoidf_(go[j]);
          st_bf4(A.Yg + (size_t)(t0 + i) * 512 + ecol, o); } }
    __syncthreads();
}

__device__ __forceinline__ void xa_tile(const bf16_t* Ux, const bf16_t* Kb, const bf16_t* Vt, bf16_t* Yx, int tile, int tid) {
    const int blk = tile & 31, h = (tile >> 5) & 3, b = tile >> 7; const int lane = tid & 63, wave = tid >> 6, fr = lane & 15, fq = lane >> 4;
    const int t = b * SEQ + blk * 128 + 16 * wave + fr;
    bf16x8 qf[4];
#pragma unroll
    for (int ks = 0; ks < 4; ++ks) qf[ks] = *(const bf16x8*)(Ux + (size_t)t * 512 + h * 128 + ks * 32 + fq * 8);
    f32x4 s[16];
#pragma unroll
    for (int nt = 0; nt < 16; ++nt) { s[nt] = (f32x4){0.f, 0.f, 0.f, 0.f}; const bf16_t* kr = Kb + (size_t)(b * 256 + 16 * nt + fr) * 512 + h * 128 + fq * 8;
#pragma unroll
        for (int ks = 0; ks < 4; ++ks) s[nt] = mfma16(*(const bf16x8*)(kr + ks * 32), qf[ks], s[nt]); }
    float mx = -1e30f;
#pragma unroll
    for (int nt = 0; nt < 16; ++nt)
#pragma unroll
        for (int j = 0; j < 4; ++j) mx = fmaxf(mx, s[nt][j]);
    mx = fmaxf(mx, __shfl_xor(mx, 16)); mx = fmaxf(mx, __shfl_xor(mx, 32));
    const float sc = 0.08838834764831845f * 1.4426950408889634f; float l = 0.f;
#pragma unroll
    for (int nt = 0; nt < 16; ++nt)
#pragma unroll
        for (int j = 0; j < 4; ++j) { const float pz = exp2f((s[nt][j] - mx) * sc); s[nt][j] = pz; l += pz; }
    l += __shfl_xor(l, 16); l += __shfl_xor(l, 32);
    f32x4 o[8];
#pragma unroll
    for (int dt = 0; dt < 8; ++dt) o[dt] = (f32x4){0.f, 0.f, 0.f, 0.f};
#pragma unroll
    for (int c = 0; c < 8; ++c) { union { u32x4 u; bf16x8 v; } pf;
        pf.u.x = cvt_pk_bf16(s[2 * c][0], s[2 * c][1]); pf.u.y = cvt_pk_bf16(s[2 * c][2], s[2 * c][3]); pf.u.z = cvt_pk_bf16(s[2 * c + 1][0], s[2 * c + 1][1]); pf.u.w = cvt_pk_bf16(s[2 * c + 1][2], s[2 * c + 1][3]);
#pragma unroll
        for (int dt = 0; dt < 8; ++dt) { const bf16_t* vr = Vt + ((size_t)b * 512 + h * 128 + 16 * dt + fr) * 256 + 32 * c + 4 * fq; union { u32x4 u; bf16x8 v; } vf;
            const u32x2 lo = *(const u32x2*)vr, hi = *(const u32x2*)(vr + 16); vf.u.x = lo.x; vf.u.y = lo.y; vf.u.z = hi.x; vf.u.w = hi.y;
            o[dt] = mfma16(vf.v, pf.v, o[dt]); } }
    const float il = 1.0f / l;
#pragma unroll
    for (int dt = 0; dt < 8; ++dt) st_bf4(Yx + (size_t)t * 512 + h * 128 + 16 * dt + 4 * fq, o[dt] * il);
}

constexpr int XK_STRIDE = 272, XV_STRIDE = 528, XV_OFF = 256 * XK_STRIDE;
__device__ __forceinline__ void xa_pair(LAS unsigned char* lds, const bf16_t* Ux, const bf16_t* Kb, const bf16_t* Vt, bf16_t* Yx, int pair, int tid) {
    const int bh = pair >> 4, b = bh >> 2, h = bh & 3, blk0 = (pair & 15) * 2; const int lane = tid & 63, wave = tid >> 6, fr = lane & 15, fq = lane >> 4;
#pragma unroll
    for (int e = 0; e < 8; ++e) { const int ch = tid + 512 * e; const int key = ch >> 4, part = ch & 15;
        *(LAS u32x4*)(lds + key * XK_STRIDE + part * 16) = *(const u32x4*)(Kb + (size_t)(b * 256 + key) * 512 + h * 128 + part * 8);
        const int dr = ch >> 5, pv = ch & 31;
        *(LAS u32x4*)(lds + XV_OFF + dr * XV_STRIDE + pv * 16) = *(const u32x4*)(Vt + ((size_t)b * 512 + h * 128 + dr) * 256 + pv * 8); }
    __syncthreads();
#pragma unroll 1
    for (int tq = 0; tq < 2; ++tq) {
        const int t = b * SEQ + (blk0 + tq) * 128 + 16 * wave + fr;
        bf16x8 qf[4];
#pragma unroll
        for (int ks = 0; ks < 4; ++ks) qf[ks] = *(const bf16x8*)(Ux + (size_t)t * 512 + h * 128 + ks * 32 + fq * 8);
        f32x4 s[16];
#pragma unroll
        for (int nt = 0; nt < 16; ++nt) { s[nt] = (f32x4){0.f, 0.f, 0.f, 0.f}; LAS const unsigned char* kr = lds + (16 * nt + fr) * XK_STRIDE + fq * 16;
#pragma unroll
            for (int ks = 0; ks < 4; ++ks) s[nt] = mfma16(*(LAS const bf16x8*)(kr + ks * 64), qf[ks], s[nt]);
            if (nt & 1) asm volatile("" ::: "memory"); }
        float mx = -1e30f;
#pragma unroll
        for (int nt = 0; nt < 16; ++nt)
#pragma unroll
            for (int j = 0; j < 4; ++j) mx = fmaxf(mx, s[nt][j]);
        mx = fmaxf(mx, __shfl_xor(mx, 16)); mx = fmaxf(mx, __shfl_xor(mx, 32));
        const float sc = 0.08838834764831845f * 1.4426950408889634f; float l = 0.f;
#pragma unroll
        for (int nt = 0; nt < 16; ++nt)
#pragma unroll
            for (int j = 0; j < 4; ++j) { const float pz = exp2f((s[nt][j] - mx) * sc); s[nt][j] = pz; l += pz; }
        l += __shfl_xor(l, 16); l += __shfl_xor(l, 32);
        f32x4 o[8];
#pragma unroll
        for (int dt = 0; dt < 8; ++dt) o[dt] = (f32x4){0.f, 0.f, 0.f, 0.f};
#pragma unroll
        for (int c = 0; c < 8; ++c) { union { u32x4 u; bf16x8 v; } pf;
            pf.u.x = cvt_pk_bf16(s[2 * c][0], s[2 * c][1]); pf.u.y = cvt_pk_bf16(s[2 * c][2], s[2 * c][3]); pf.u.z = cvt_pk_bf16(s[2 * c + 1][0], s[2 * c + 1][1]); pf.u.w = cvt_pk_bf16(s[2 * c + 1][2], s[2 * c + 1][3]);
#pragma unroll
            for (int dt = 0; dt < 8; ++dt) { LAS const unsigned char* vr = lds + XV_OFF + (16 * dt + fr) * XV_STRIDE + (32 * c + 4 * fq) * 2; union { u32x4 u; bf16x8 v; } vf;
                const u32x2 lo = *(LAS const u32x2*)vr, hi = *(LAS const u32x2*)(vr + 32); vf.u.x = lo.x; vf.u.y = lo.y; vf.u.z = hi.x; vf.u.w = hi.y;
                o[dt] = mfma16(vf.v, pf.v, o[dt]); }
            asm volatile("" ::: "memory"); }
        const float il = 1.0f / l;
#pragma unroll
        for (int dt = 0; dt < 8; ++dt) st_bf4(Yx + (size_t)t * 512 + h * 128 + 16 * dt + 4 * fq, o[dt] * il);
    }
    __syncthreads();
}

struct Params { const float* in[33]; float* out; unsigned char* ws; };

__device__ __forceinline__ int opaque0() { int z = 0; asm volatile("" : "+s"(z)); return z; }
typedef __attribute__((address_space(1))) unsigned char* gptr_t;
typedef __attribute__((address_space(1))) const float* gcf_t;
__device__ __forceinline__ int opqv(int v) { asm volatile("" : "+v"(v)); return v; }
__device__ __forceinline__ int opqs(int v) { asm volatile("" : "+s"(v)); return v; }
#define PH_BEGIN const int zi = opaque0(); unsigned char* ws = P.ws + zi; float* const OUT = P.out + zi; (void)OUT; const int tid = opqv((int)threadIdx.x); const int bid = opqs((int)blockIdx.x); const int G = opqs((int)gridDim.x); (void)tid; (void)bid; (void)G; unsigned char* WB = ws + WS_WB; float* SS = (float*)(ws + WS_SS); (void)WB; (void)SS; (void)zi;
#define INP(k) (P.in[(k)] + zi)
#define XB_ ((bf16_t*)(ws + WS_XB))
#define U_ (ws + WS_U)
#define SC_ (ws + WS_SC)
#define Y_ ((bf16_t*)(ws + WS_Y))
#define KB_ ((bf16_t*)(ws + WS_KB))
#define VT_ ((bf16_t*)(ws + WS_VT))

constexpr size_t WS_BAR = WS_MISC + 8192;
__device__ __forceinline__ void grid_bar(unsigned* ctr, unsigned target) {
    asm volatile("s_waitcnt vmcnt(0)" ::: "memory");
    __syncthreads();
    if (threadIdx.x == 0) {
        __builtin_amdgcn_fence(__ATOMIC_RELEASE, "agent");
        asm volatile("s_waitcnt vmcnt(0)" ::: "memory");
        __hip_atomic_fetch_add(ctr, 1u, __ATOMIC_RELAXED, __HIP_MEMORY_SCOPE_AGENT);
        while (__hip_atomic_load(ctr, __ATOMIC_RELAXED, __HIP_MEMORY_SCOPE_AGENT) < target) __builtin_amdgcn_s_sleep(2);
        __builtin_amdgcn_fence(__ATOMIC_ACQUIRE, "agent");
        asm volatile("s_waitcnt vmcnt(0)" ::: "memory");
    }
    __syncthreads();
}

#define XB_TMO      128
#define XB_XCNT(j)  (256  + 64 * (j))
#define XB_XSUB(j)  (1280 + 64 * (j))
#define XB_XGEN(j)  (2304 + 64 * (j))
#define XB_TOP      3328
#define XB_TOPGEN   3392
#define XCD_BAR_WORDS 3456
#define XB_SPIN_CAP (1u << 18)
constexpr size_t WS_XBAR = WS_MISC + 16384;
__device__ __forceinline__ unsigned xb_ld(unsigned* p)              { return __hip_atomic_load(p, __ATOMIC_RELAXED, __HIP_MEMORY_SCOPE_AGENT); }
__device__ __forceinline__ unsigned xb_add(unsigned* p, unsigned v) { return __hip_atomic_fetch_add(p, v, __ATOMIC_RELAXED, __HIP_MEMORY_SCOPE_AGENT); }
__device__ __forceinline__ unsigned xb_xcc_id() { return (unsigned)__builtin_amdgcn_s_getreg((3 << 11) | 20) & 0xFu; }
#define XB_SPIN(cond, bar) do { unsigned _sp = 0; while (cond) { __builtin_amdgcn_s_sleep(1); \
    if ((++_sp & 255u) == 0u) { if (xb_ld(&(bar)[XB_TMO])) break; if (_sp > XB_SPIN_CAP) { atomicAdd(&(bar)[XB_TMO], 1u); break; } } } } while (0)
__device__ __forceinline__ void xcd_barrier_complete(unsigned* bar, unsigned x, unsigned& nloc, unsigned& nx) {
    const unsigned G = gridDim.x * gridDim.y * gridDim.z;
    unsigned sum, cnt, mine, sp = 0u;
    for (;;) {
        sum = 0u; cnt = 0u; mine = 0u;
#pragma unroll
        for (unsigned j = 0; j < 16; ++j) { const unsigned c = xb_ld(&bar[XB_XCNT(j)]); sum += c; cnt += (c > 0u) ? 1u : 0u; mine = (j == x) ? c : mine; }
        if (sum == G) break;
        __builtin_amdgcn_s_sleep(1);
        if ((++sp & 255u) == 0u) { if (xb_ld(&bar[XB_TMO])) break; if (sp > XB_SPIN_CAP) { atomicAdd(&bar[XB_TMO], 1u); break; } }
    }
    nloc = mine > 0u ? mine : 1u; nx = cnt > 0u ? cnt : 1u;
}
__device__ __forceinline__ void xcd_barrier(unsigned* bar, volatile LAS unsigned* st) {
    asm volatile("s_waitcnt vmcnt(0)" ::: "memory");
    __syncthreads();
    if (threadIdx.x == 0) {
        const unsigned x = xb_xcc_id();
        __builtin_amdgcn_s_waitcnt(0);
        unsigned nloc = st[0], nx = st[1];
        if (nloc == 0u) { xcd_barrier_complete(bar, x, nloc, nx); st[0] = nloc; st[1] = nx; }
        const unsigned old = xb_add(&bar[XB_XSUB(x)], 1u);
        const unsigned gen = old / nloc;
        if (old + 1u == (gen + 1u) * nloc) {
            __builtin_amdgcn_fence(__ATOMIC_RELEASE, "agent");
            asm volatile("s_waitcnt vmcnt(0)" ::: "memory");
            const unsigned og = xb_add(&bar[XB_TOP], 1u);
            const unsigned tg = og / nx;
            if (og + 1u == (tg + 1u) * nx) xb_add(&bar[XB_TOPGEN], 1u);
            else XB_SPIN(xb_ld(&bar[XB_TOPGEN]) == tg, bar);
            __builtin_amdgcn_fence(__ATOMIC_ACQUIRE, "agent");
            xb_add(&bar[XB_XGEN(x)], 1u);
            asm volatile("s_waitcnt vmcnt(0)" ::: "memory");
        } else {
            XB_SPIN(xb_ld(&bar[XB_XGEN(x)]) == gen, bar);
            __builtin_amdgcn_fence(__ATOMIC_ACQUIRE, "agent");
            asm volatile("s_waitcnt vmcnt(0)" ::: "memory");
        }
    }
    __syncthreads();
}

__global__ void __launch_bounds__(512) mega(Params P) {
    extern __shared__ __attribute__((aligned(16))) unsigned char lds_raw[];
    LAS unsigned char* lds = (LAS unsigned char*)lds_raw;
    cg::grid_group grid = cg::this_grid();
    volatile LAS unsigned* xst = (volatile LAS unsigned*)(lds + LDS_BYTES - 16);
    if (threadIdx.x == 0) { xst[0] = 0u; xst[1] = 0u; (void)xb_add(&((unsigned*)(P.ws + WS_XBAR))[XB_XCNT(xb_xcc_id())], 1u); }
    __syncthreads();

    unsigned nsub = 0;
    for (int ph = 0; ph < NL * 12 + 1; ++ph) {
        const int l = ph / 12, kph = ph - l * 12;
        if (ph == NL * 12) {
#if (PHMASK >> 12) & 1
    { PH_BEGIN
        const int lane = tid & 63, gw = bid * 8 + (tid >> 6), nw = G * 8;
        const float* fn = INP(32); const float* ssf = SS + (size_t)0 * T * 16; float* X = OUT;
        for (int r = gw; r < T; r += nw) { const float rs = row_rstd(ssf, r);
#pragma unroll
            for (int i = 0; i < 4; ++i) { const size_t o = (size_t)r * D + i * 256 + lane * 4; *(f32x4*)(X + o) = *(const f32x4*)(X + o) * rs * *(const f32x4*)(fn + i * 256 + lane * 4); } }
    }
#endif
            break;
        }
        switch (kph) {
        case 0: {
#if (PHMASK >> 0) & 1
        for (int rep = 0; rep < REP0; ++rep) {
        {
            { PH_BEGIN convT_w<1>(INP(3) + (size_t)l * D * 2 * FF, 2 * FF, 0, INP(2) + (size_t)l * D, (bf16_t*)(WB + WB_W1A), D, D, 2 * FF, bid * 8 + (tid >> 6), G * 8, tid & 63); }
            { PH_BEGIN convT_w<0>(INP(4) + (size_t)l * FF * D, D, 0, nullptr, (bf16_t*)(WB + WB_W1B), FF, FF, D, bid * 8 + (tid >> 6), G * 8, tid & 63); }
            { PH_BEGIN convT_w<2>(INP(7) + (size_t)l * D * 6928, 6928, 0, INP(5) + (size_t)l * D, (bf16_t*)(WB + WB_WIN), D, D, 4096, bid * 8 + (tid >> 6), G * 8, tid & 63); }
            { PH_BEGIN convT_w<0>(INP(7) + (size_t)l * D * 6928, 6928, 3856, INP(5) + (size_t)l * D, (bf16_t*)(WB + WB_WG), D, D, 3072, bid * 8 + (tid >> 6), G * 8, tid & 63); }
            for (int j = 0; j < 3; ++j) { PH_BEGIN convT_w<0>(INP(27) + ((size_t)l * 3 + j) * 512 * D, D, 0, nullptr, (bf16_t*)(WB + WB_WBR) + (size_t)j * D * 512, 512, 512, D, bid * 8 + (tid >> 6), G * 8, tid & 63); }
            { PH_BEGIN convT_w<0>(INP(28) + (size_t)l * D * D, D, 0, nullptr, (bf16_t*)(WB + WB_WO), D, D, D, bid * 8 + (tid >> 6), G * 8, tid & 63); }
            { PH_BEGIN convT_w<0>(INP(26) + (size_t)l * D * D, D, 0, INP(6) + (size_t)l * D, (bf16_t*)(WB + WB_WKV), D, D, D, bid * 8 + (tid >> 6), G * 8, tid & 63); }
            { PH_BEGIN convT_w<1>(INP(30) + (size_t)l * D * 2 * FF, 2 * FF, 0, INP(29) + (size_t)l * D, (bf16_t*)(WB + WB_W2A), D, D, 2 * FF, bid * 8 + (tid >> 6), G * 8, tid & 63); }
            { PH_BEGIN convT_w<0>(INP(31) + (size_t)l * FF * D, D, 0, nullptr, (bf16_t*)(WB + WB_W2B), FF, FF, D, bid * 8 + (tid >> 6), G * 8, tid & 63); }
            { PH_BEGIN convT_w<0>(INP(10) + (size_t)l * 64 * 512, 512, 0, nullptr, (bf16_t*)(WB + WB_LW2), 64, 64, 512, bid * 8 + (tid >> 6), G * 8, tid & 63); }
            { PH_BEGIN convT_w<0>(INP(12) + (size_t)l * 64 * 512, 512, 0, nullptr, (bf16_t*)(WB + WB_LA2), 64, 64, 512, bid * 8 + (tid >> 6), G * 8, tid & 63); }
            { PH_BEGIN convT_w<0>(INP(13) + (size_t)l * 128 * 512, 512, 0, nullptr, (bf16_t*)(WB + WB_LG2), 128, 128, 512, bid * 8 + (tid >> 6), G * 8, tid & 63); }
            if (l > 0) {
                { PH_BEGIN convT_w<0>(INP(20) + (size_t)(l - 1) * 512 * 32, 32, 0, nullptr, (bf16_t*)(WB + WB_LV1), 512, 512, 32, bid * 8 + (tid >> 6), G * 8, tid & 63); }
                { PH_BEGIN convT_w<0>(INP(21) + (size_t)(l - 1) * 32 * 512, 512, 0, nullptr, (bf16_t*)(WB + WB_LV2), 32, 32, 512, bid * 8 + (tid >> 6), G * 8, tid & 63); }
            }
            if (l == 0) { PH_BEGIN
                const int lane = tid & 63, gw = bid * 8 + (tid >> 6), nw = G * 8;
                float* rstd_mem = (float*)(ws + WS_MISC); bf16_t* MEMN = (bf16_t*)(ws + WS_MEMN);
                for (int r = gw; r < T + 1024; r += nw) {
                    const bool ism = r >= T; const float* src = ism ? INP(1) + (size_t)(r - T) * D : INP(0) + (size_t)r * D; bf16_t* dst = ism ? MEMN + (size_t)(r - T) * D : XB_ + (size_t)r * D; float q = 0.f;
#pragma unroll
                    for (int i = 0; i < 4; ++i) { const f32x4 v = *(const f32x4*)(src + i * 256 + lane * 4); st_bf4(dst + i * 256 + lane * 4, v); q += (v[0] * v[0] + v[1] * v[1]) + (v[2] * v[2] + v[3] * v[3]); }
                    q = wave_sum(q);
                    if (ism) { if (lane == 0) rstd_mem[r - T] = rsqrtf(q * (1.0f / 1024.0f) + 1e-6f); } else if (lane < 16) SS[(size_t)r * 16 + lane] = (lane == 0) ? q : 0.f;
                }
            }
        }
        }
#endif
        } break;
        case 1: {
#if (PHMASK >> 1) & 1
        for (int rep = 0; rep < REPG; ++rep) {
        { PH_BEGIN
            pg8::Gemm g{XB_, (const bf16_t*)(WB + WB_W1A), T, 2 * FF, D, D, D, 0, 0}; pg8::StaticOrder S; S.init(T, 2 * FF, G, bid, 1);
            EpiFFNa E{(bf16_t*)U_, SS + (size_t)0 * T * 16}; pg8::gemm_phase(lds, g, S, E, tid);
        }
        if ((int)blockIdx.x >= (int)gridDim.x - 16) { PH_BEGIN
            pg8::Gemm g2{(const bf16_t*)(ws + WS_MEMN), (const bf16_t*)(WB + WB_WKV), 1024, D, D, D, D, 0, 0}; pg8::StaticOrder S2; S2.init(1024, D, 16, bid - (G - 16), 1);
            EpiKV E2{KB_, VT_, (const float*)(ws + WS_MISC)}; pg8::gemm_phase(lds, g2, S2, E2, tid);
        }
        }
#endif
        } break;
        case 2: {
#if (PHMASK >> 2) & 1
        { PH_BEGIN
            pg8::Gemm g{(const bf16_t*)U_, (const bf16_t*)(WB + WB_W1B), T, D, FF, FF, FF, 0, 0}; pg8::StaticOrder S; S.init(T, D, G, bid, 1);
            EpiRes E{l == 0 ? INP(0) : OUT, OUT, XB_, SS + (size_t)1 * T * 16, 0.5f}; pg8::gemm_phase(lds, g, S, E, tid);
        }
#endif
        } break;
        case 3: {
#if (PHMASK >> 3) & 1
        for (int rep = 0; rep < REPG; ++rep) {
        { PH_BEGIN
            pg8::Gemm g{XB_, (const bf16_t*)(WB + WB_WIN), T, 4096, D, D, D, 0, 0}; pg8::StaticOrder S; S.init(T, 4096, G, bid, 1);
            EpiU E{(bf16_t*)U_, SS + (size_t)1 * T * 16}; pg8::gemm_phase(lds, g, S, E, tid);
        }
        }
#endif
        } break;
        case 4: {
#if (PHMASK >> 4) & 1
        { PH_BEGIN
            PrepArgs PA; PA.U = (const bf16_t*)(U_ + U_RWKV); PA.mu = INP(8) + (size_t)l * 1792; PA.w0 = INP(9) + (size_t)l * 512; PA.a0 = INP(11) + (size_t)l * 512;
            PA.kk_ = INP(14) + (size_t)l * 512; PA.ka = INP(15) + (size_t)l * 512; PA.rk = INP(16) + (size_t)l * 512; PA.v0 = INP(19) + (size_t)(l > 0 ? l - 1 : 0) * 512;
            PA.w2t = (const bf16_t*)(WB + WB_LW2); PA.a2t = (const bf16_t*)(WB + WB_LA2); PA.g2t = (const bf16_t*)(WB + WB_LG2); PA.v1t = (const bf16_t*)(WB + WB_LV1); PA.v2t = (const bf16_t*)(WB + WB_LV2);
            PA.vfirst = (float*)(ws + WS_VF); PA.Wd = (float*)(SC_ + SC_WD); PA.V = (float*)(SC_ + SC_V); PA.RKKB = (bf16_t*)(SC_ + SC_RKKB); PA.Go = (bf16_t*)(ws + WS_GO); PA.Bon = (float*)(ws + WS_BON); PA.layer = l;
            for (int tt = bid; tt < 256; tt += G) rwkv_prep_tile(lds, PA, tt, tid);
        }
        { PH_BEGIN
            for (int pair = bid; pair < 256; pair += G) xa_pair(lds, (const bf16_t*)(U_ + U_XA), KB_, VT_, Y_ + (size_t)2 * T * 512, pair, tid);
        }
        { PH_BEGIN
            GlaArgs GA; GA.Ug = (const bf16_t*)(U_ + U_GLA); GA.conv = INP(22) + (size_t)l * 4096; GA.aup = INP(23) + (size_t)l * 4096; GA.abias = INP(24) + (size_t)l * 256; GA.gnorm = INP(25) + (size_t)l * 512;
            GA.kvcT = (float*)(ws + WS_KVC); GA.dec = (float*)(ws + WS_DEC); GA.spT = (bf16_t*)(U_ + U_SPT); GA.Yg = Y_ + (size_t)T * 512;
            for (int tile = bid; tile < NA4 * 256; tile += G) gla_a_tile(lds, GA, tile, tid);
        }
#endif
        } break;
        case 5: {
#if (PHMASK >> 5) & 1
        if ((int)blockIdx.x < 128) { PH_BEGIN
            const int xcd = bid & 7, j = bid >> 3, p = xcd * 4 + (j >> 2), rg = j & 3;
            rwkv_scan_unit(lds, (const float*)(SC_ + SC_WD), (const float*)(SC_ + SC_V), (const bf16_t*)(SC_ + SC_RKKB), (float*)(U_ + U_YRAW), p, rg, tid);
        } else {
            { PH_BEGIN
            GlaArgs GA; GA.Ug = (const bf16_t*)(U_ + U_GLA); GA.conv = INP(22) + (size_t)l * 4096; GA.aup = INP(23) + (size_t)l * 4096; GA.abias = INP(24) + (size_t)l * 256; GA.gnorm = INP(25) + (size_t)l * 512;
            GA.kvcT = (float*)(ws + WS_KVC); GA.dec = (float*)(ws + WS_DEC); GA.spT = (bf16_t*)(U_ + U_SPT); GA.Yg = Y_ + (size_t)T * 512;
            for (int tile = NA4 * 256 + bid - 128; tile < 1024; tile += 128) gla_a_tile(lds, GA, tile, tid);
            }
            ++nsub; grid_bar((unsigned*)(P.ws + WS_BAR + 128), nsub * 128u);
            { PH_BEGIN
            bf16_t* spT = (bf16_t*)(U_ + U_SPT); const float* DEC = (const float*)(ws + WS_DEC); const float* KVC = (const float*)(ws + WS_KVC);
            for (int i = (bid - 128) * 512 + tid; i < 16 * 128 * 64; i += 128 * 512) { const int bh = i >> 13, ed = i & 8191, d = i & 63; float st = 0.f;
                for (int n0 = 0; n0 < 64; n0 += 16) { float kv[16], dc[16];
#pragma unroll
                    for (int q = 0; q < 16; ++q) { kv[q] = KVC[((size_t)bh * 64 + n0 + q) * 8192 + ed]; dc[q] = DEC[((size_t)bh * 64 + n0 + q) * 64 + d]; }
#pragma unroll
                    for (int q = 0; q < 16; ++q) { spT[((size_t)bh * 64 + n0 + q) * 8192 + ed] = f2bf(st); st = st * dc[q] + kv[q]; } } }
            }
            ++nsub; grid_bar((unsigned*)(P.ws + WS_BAR + 128), nsub * 128u);
            { PH_BEGIN
            GlaArgs GA; GA.Ug = (const bf16_t*)(U_ + U_GLA); GA.conv = INP(22) + (size_t)l * 4096; GA.aup = INP(23) + (size_t)l * 4096; GA.abias = INP(24) + (size_t)l * 256; GA.gnorm = INP(25) + (size_t)l * 512;
            GA.kvcT = (float*)(ws + WS_KVC); GA.dec = (float*)(ws + WS_DEC); GA.spT = (bf16_t*)(U_ + U_SPT); GA.Yg = Y_ + (size_t)T * 512;
            for (int tile = bid - 128; tile < 1024; tile += 128) gla_c_tile(lds, GA, tile, tid);
            }
        }
#endif
        } break;
        case 6: {
#if (PHMASK >> 6) & 1
        { PH_BEGIN
            const int lane = tid & 63, gw = bid * 8 + (tid >> 6), nw = G * 8;
            const float* lnw = INP(17) + (size_t)l * 512; const float* lnb = INP(18) + (size_t)l * 512; const float* Yraw = (const float*)(U_ + U_YRAW); const float* Vv = (const float*)(SC_ + SC_V);
            const float* BON = (const float*)(ws + WS_BON); const bf16_t* GO = (const bf16_t*)(ws + WS_GO); bf16_t* Y = Y_;
            const int kq = lane & 15, sub = lane >> 4;
#pragma unroll 4
            for (int it0 = gw * 4; it0 < 32 * SEQ; it0 += nw * 4) { const int it = it0 + sub; const int p = it >> 12, s = it & (SEQ - 1), b = p >> 3, h = p & 7, t = b * SEQ + s;
                const f32x4 y = *(const f32x4*)(Yraw + (size_t)it * 64 + kq * 4); const f32x4 vv = *(const f32x4*)(Vv + (size_t)it * 64 + kq * 4);
                const f32x4 gg = ld_bf4(GO + (size_t)t * 512 + h * 64 + kq * 4); const f32x4 lw = *(const f32x4*)(lnw + h * 64 + kq * 4), lb = *(const f32x4*)(lnb + h * 64 + kq * 4); const float bon = BON[(size_t)t * 8 + h];
                const float mean = row16_sum((y[0] + y[1]) + (y[2] + y[3])) * (1.0f / 64.0f); const f32x4 dl = y - mean;
                const float var = row16_sum((dl[0] * dl[0] + dl[1] * dl[1]) + (dl[2] * dl[2] + dl[3] * dl[3])) * (1.0f / 64.0f); const float rs = rsqrtf(var + 64e-5f);
                st_bf4(Y + (size_t)t * 512 + h * 64 + kq * 4, ((dl * rs) * lw + lb + vv * bon) * gg); }
        }
#endif
        } break;
        case 7: {
#if (PHMASK >> 7) & 1
        for (int rep = 0; rep < REPG; ++rep) {
        { PH_BEGIN
            pg8::Gemm g{XB_, (const bf16_t*)(WB + WB_WG), T, 3072, D, D, D, 0, 0}; pg8::StaticOrder S; S.init(T, 3072, G, bid, 1);
            EpiGate E{(bf16_t*)SC_, SS + (size_t)1 * T * 16}; pg8::gemm_phase(lds, g, S, E, tid);
        }
        }
#endif
        } break;
        case 8: {
#if (PHMASK >> 8) & 1
        for (int rep = 0; rep < REPG; ++rep) {
        { PH_BEGIN
            pg8::Gemm g{Y_, (const bf16_t*)(WB + WB_WBR), T, D, 512, 512, 512, (unsigned)T * 512u * 2u, (unsigned)D * 512u * 2u}; pg8::StaticOrder S; S.init(T, D, G, bid, 3);
            EpiMerge E{(const bf16_t*)SC_, (float*)(U_ + U_MG), (bf16_t*)(U_ + U_MGB)}; pg8::gemm_phase(lds, g, S, E, tid);
        }
        }
#endif
        } break;
        case 9: {
#if (PHMASK >> 9) & 1
        { PH_BEGIN
            pg8::Gemm g{(const bf16_t*)(U_ + U_MGB), (const bf16_t*)(WB + WB_WO), T, D, D, D, D, 0, 0}; pg8::StaticOrder S; S.init(T, D, G, bid, 1);
            EpiRes E{OUT, OUT, XB_, SS + (size_t)2 * T * 16, 1.0f}; pg8::gemm_phase(lds, g, S, E, tid);
        }
#endif
        } break;
        case 10: {
#if (PHMASK >> 10) & 1
        for (int rep = 0; rep < REPG; ++rep) {
        { PH_BEGIN
            pg8::Gemm g{XB_, (const bf16_t*)(WB + WB_W2A), T, 2 * FF, D, D, D, 0, 0}; pg8::StaticOrder S; S.init(T, 2 * FF, G, bid, 1);
            EpiFFNa E{(bf16_t*)U_, SS + (size_t)2 * T * 16}; pg8::gemm_phase(lds, g, S, E, tid);
        }
        }
#endif
        } break;
        case 11: {
#if (PHMASK >> 11) & 1
        { PH_BEGIN
            pg8::Gemm g{(const bf16_t*)U_, (const bf16_t*)(WB + WB_W2B), T, D, FF, FF, FF, 0, 0}; pg8::StaticOrder S; S.init(T, D, G, bid, 1);
            EpiRes E{OUT, OUT, XB_, SS + (size_t)0 * T * 16, 0.5f}; pg8::gemm_phase(lds, g, S, E, tid);
        }
#endif
        } break;
        default: break;
        }
        if (ph == 0) grid.sync();
        else xcd_barrier((unsigned*)(P.ws + WS_XBAR), xst);
    }
}

extern "C" void kernel_launch(void* const* d_in, const int* in_sizes, int n_in, void* d_out, int out_size, void* d_ws, size_t ws_size, hipStream_t stream) {
    static int grid_blocks = 0;
    if (!grid_blocks) {
        if (n_in != 33 || ws_size < WS_END) { fprintf(stderr, "kernel_launch: need 33 inputs and %zu bytes of workspace (got %d, %zu)\n", (size_t)WS_END, n_in, ws_size); grid_blocks = -1; return; }
        int dev = 0, cus = 0, per_cu = 0;
        hipGetDevice(&dev); hipDeviceGetAttribute(&cus, hipDeviceAttributeMultiprocessorCount, dev);
        if (hipFuncSetAttribute((const void*)mega, hipFuncAttributeMaxDynamicSharedMemorySize, LDS_BYTES) != hipSuccess) { fprintf(stderr, "kernel_launch: hipFuncSetAttribute failed\n"); grid_blocks = -1; return; }
        if (hipOccupancyMaxActiveBlocksPerMultiprocessor(&per_cu, (const void*)mega, 512, LDS_BYTES) != hipSuccess || per_cu < 1) { fprintf(stderr, "kernel_launch: occupancy query says %d\n", per_cu); per_cu = 1; }
        (void)hipGetLastError();
        grid_blocks = cus * per_cu;
        if (grid_blocks != 256) { fprintf(stderr, "kernel_launch: this kernel splits a 256-workgroup grid in its scan phase (got %d)\n", grid_blocks); grid_blocks = -1; return; }
    }
    if (grid_blocks < 0) return;
    if (hipMemsetAsync((char*)d_ws + WS_BAR, 0, (WS_XBAR - WS_BAR) + XCD_BAR_WORDS * 4, stream) != hipSuccess) { fprintf(stderr, "kernel_launch: memset failed\n"); return; }
    Params p{};
    for (int i = 0; i < 33; ++i) p.in[i] = (const float*)d_in[i];
    p.out = (float*)d_out; p.ws = (unsigned char*)d_ws;
    void* args[] = {&p};
    hipError_t e = hipLaunchCooperativeKernel((const void*)mega, dim3(grid_blocks), dim3(512), args, LDS_BYTES, stream);
    if (e != hipSuccess) fprintf(stderr, "cooperative launch failed: %s (grid %d)\n", hipGetErrorString(e), grid_blocks);
}
```

```cpp
#include <hip/hip_runtime.h>
#include <hip/hip_cooperative_groups.h>
#include <cstdio>
namespace cg = cooperative_groups;
#ifndef P4SUB
#define P4SUB 7
#endif
#ifndef REP5
#define REP5 1
#endif
#ifndef REP4
#define REP4 1
#endif
#ifndef REP6
#define REP6 1
#endif
#ifndef REP0
#define REP0 1
#endif
#ifndef REPG
#define REPG 1
#endif
#ifndef REPSYNC
#define REPSYNC 1
#endif
#ifndef NA4
#define NA4 2
#endif
#ifndef PHMASK
#define PHMASK 0xFFFF
#endif

#define LAS __attribute__((address_space(3)))
typedef unsigned short bf16_t;
typedef short bf16x8 __attribute__((ext_vector_type(8)));
typedef float f32x4 __attribute__((ext_vector_type(4)));
typedef float f32x2 __attribute__((ext_vector_type(2)));
typedef unsigned u32x4 __attribute__((ext_vector_type(4)));
typedef unsigned u32x2 __attribute__((ext_vector_type(2)));

constexpr int T = 16384, D = 1024, FF = 2816, SEQ = 4096, NL = 4;
constexpr int LDS_BYTES = 139264;

constexpr size_t MB = 1024 * 1024;
constexpr size_t WS_MISC = 0;
constexpr size_t WS_SS = 1 * MB;
constexpr size_t WS_WB = 4 * MB;
constexpr size_t WB_W1A = 0;
constexpr size_t WB_W1B = WB_W1A + (size_t)5632 * 1024 * 2;
constexpr size_t WB_WIN = WB_W1B + (size_t)1024 * 2816 * 2;
constexpr size_t WB_WG = WB_WIN + (size_t)4096 * 1024 * 2;
constexpr size_t WB_WBR = WB_WG + (size_t)3072 * 1024 * 2;
constexpr size_t WB_WO = WB_WBR + (size_t)3 * 1024 * 512 * 2;
constexpr size_t WB_WKV = WB_WO + (size_t)1024 * 1024 * 2;
constexpr size_t WB_W2A = WB_WKV + (size_t)1024 * 1024 * 2;
constexpr size_t WB_W2B = WB_W2A + (size_t)5632 * 1024 * 2;
constexpr size_t WB_LW2 = WB_W2B + (size_t)1024 * 2816 * 2;
constexpr size_t WB_LA2 = WB_LW2 + 512 * 64 * 2;
constexpr size_t WB_LG2 = WB_LA2 + 512 * 64 * 2;
constexpr size_t WB_LV1 = WB_LG2 + 512 * 128 * 2;
constexpr size_t WB_LV2 = WB_LV1 + 32 * 512 * 2;
constexpr size_t WB_END = WB_LV2 + 512 * 32 * 2;
static_assert(WB_END <= 55 * MB, "weights region");
constexpr size_t WS_XB = WS_WB + 55 * MB;
constexpr size_t WS_VF = WS_XB + 32 * MB;
constexpr size_t WS_MEMN = WS_VF + 32 * MB;
constexpr size_t WS_KB = WS_MEMN + 2 * MB;
constexpr size_t WS_VT = WS_KB + 1 * MB;
constexpr size_t WS_GO = WS_VT + 1 * MB;
constexpr size_t WS_BON = WS_GO + 16 * MB;
constexpr size_t WS_Y = WS_BON + 1 * MB;
constexpr size_t WS_KVC = WS_Y + 48 * MB;
constexpr size_t WS_DEC = WS_KVC + 32 * MB;
constexpr size_t WS_SC = WS_DEC + 1 * MB;
constexpr size_t SC_WD = 0;
constexpr size_t SC_V = 32 * MB;
constexpr size_t SC_RKKB = 64 * MB;
constexpr size_t WS_U = WS_SC + 128 * MB;
constexpr size_t U_RWKV = 0;
constexpr size_t U_GLA = (size_t)T * 1792 * 2;
constexpr size_t U_XA = 2 * (size_t)T * 1792 * 2;
constexpr size_t U_YRAW = 0;
constexpr size_t U_SPT = 32 * MB;
constexpr size_t U_MG = 0;
constexpr size_t U_MGB = 64 * MB;
constexpr size_t WS_END = WS_U + 128 * MB;
static_assert(U_XA + (size_t)T * 512 * 2 <= 128 * MB, "U region");

typedef __bf16 bf16x2_t __attribute__((ext_vector_type(2)));
__device__ __forceinline__ unsigned cvt_pk_bf16(float lo, float hi) { const f32x2 v = {lo, hi}; const bf16x2_t r = __builtin_convertvector(v, bf16x2_t); return __builtin_bit_cast(unsigned, r); }
__device__ __forceinline__ bf16_t f2bf(float x) { return (bf16_t)(cvt_pk_bf16(x, 0.f) & 0xffffu); }
__device__ __forceinline__ float bf2f(bf16_t b) { return __uint_as_float(((unsigned)b) << 16); }
__device__ __forceinline__ float bflo(unsigned w) { return __uint_as_float(w << 16); }
__device__ __forceinline__ float bfhi(unsigned w) { return __uint_as_float(w & 0xffff0000u); }
__device__ __forceinline__ f32x4 ld_bf4(const bf16_t* p) { const u32x2 w = *(const u32x2*)p; return (f32x4){bflo(w.x), bfhi(w.x), bflo(w.y), bfhi(w.y)}; }
__device__ __forceinline__ void st_bf4(bf16_t* p, f32x4 v) { u32x2 w; w.x = cvt_pk_bf16(v[0], v[1]); w.y = cvt_pk_bf16(v[2], v[3]); *(u32x2*)p = w; }
__device__ __forceinline__ float sigmoidf_(float x) { return 1.0f / (1.0f + __expf(-x)); }
__device__ __forceinline__ float wave_sum(float v) { for (int o = 32; o >= 1; o >>= 1) v += __shfl_xor(v, o); return v; }
__device__ __forceinline__ f32x4 mfma16(bf16x8 a, bf16x8 b, f32x4 c) { return __builtin_amdgcn_mfma_f32_16x16x32_bf16(a, b, c, 0, 0, 0); }

__device__ __forceinline__ float row_rstd(const float* ssp, int row) {
    const f32x4* p = (const f32x4*)(ssp + (size_t)row * 16); const f32x4 a = p[0], b = p[1], c = p[2], d = p[3];
    const float t = (((a[0] + a[1]) + (a[2] + a[3])) + ((b[0] + b[1]) + (b[2] + b[3]))) + (((c[0] + c[1]) + (c[2] + c[3])) + ((d[0] + d[1]) + (d[2] + d[3])));
    return rsqrtf(t * (1.0f / 1024.0f) + 1e-6f);
}
namespace pg8 {
constexpr int BM = 256, BK = 64, HALF = 128, HTB = HALF * BK * 2, STAGE_BYTES = 8 * HTB, NXCD = 8, WGM = 8;
__device__ __forceinline__ int lds_byte(int r, int c) { const int st = (r >> 4) * 2 + (c >> 5), rr = r & 15, cc = c & 31, ob = rr * 64 + cc * 2; return st * 1024 + (ob ^ (((ob >> 9) & 1) << 5)); }
__device__ __forceinline__ void stage_rc(int b, int& R, int& C) { const int st = b / 1024, sb = b % 1024, swz = sb ^ (((sb >> 9) & 1) << 5); R = (st >> 1) * 16 + swz / 64; C = (st & 1) * 32 + (swz % 64) / 2; }
__device__ __forceinline__ int perm32(int rho) { const int n = rho >> 4, i = rho & 15; return 8 * (i >> 2) + 4 * n + (i & 3); }

struct Unit { int pm, pn, z; };
struct Gemm { const bf16_t* A; const bf16_t* Bt; int M, N, K, lda, ldb; unsigned zA, zB; };

struct StaticOrder {
    int nM, nN, nwg, G, c, nz;
    __device__ void init(int M, int N, int G_, int c_, int nz_) { nM = M / BM; nN = N / BM; nwg = nM * nN; G = G_; c = c_; nz = nz_; }
    __device__ bool next(int i, Unit& u) const {
        const int ti = i / nz; u.z = i - ti * nz;
        const long L = (long)ti * G + c; if (L >= nwg) return false;
        int wgid = (int)L; { const int q = nwg / NXCD, r = nwg % NXCD, xcd = wgid % NXCD, off = wgid / NXCD; wgid = (xcd < r ? xcd * (q + 1) : r * (q + 1) + (xcd - r) * q) + off; }
        const int nig = WGM * nN, gid = wgid / nig, fm = gid * WGM, gsz = (nM - fm) < WGM ? (nM - fm) : WGM;
        u.pm = fm + ((wgid % nig) % gsz); u.pn = (wgid % nig) / gsz; return true;
    }
};

template <class Epi>
__device__ __forceinline__ void gemm_phase(LAS unsigned char* lds, const Gemm g, const StaticOrder& S, const Epi& E, const int tid) {
    const int wid = __builtin_amdgcn_readfirstlane(tid >> 6), lane = tid & 63, wr = wid >> 2, wc = wid & 3, fr = lane & 15, fq = lane >> 4;
    const int K = g.K, nt = K / BK;
    unsigned voffA[2], voffB[2];
#pragma unroll
    for (int i = 0; i < 2; ++i) { int R, C; stage_rc(tid * 16 + i * 8192, R, C); const int Rb = Epi::PERM ? ((R & ~31) + perm32(R & 31)) : R;
        voffA[i] = (unsigned)(R * g.lda + C) * 2u; voffB[i] = (unsigned)(Rb * g.ldb + C) * 2u; }
    const unsigned kstep = (unsigned)(BK * 2);
    const unsigned hstepA = (unsigned)HALF * g.lda * 2u, hstepB = (unsigned)HALF * g.ldb * 2u;
    const unsigned tstepA = 2u * hstepA, tstepB = 2u * hstepB;
    const unsigned ldsw = (unsigned)wid * 1024u;
    const int aoff = lds_byte(wr * 64 + fr, fq * 8), boff = lds_byte(wc * 32 + fr, fq * 8);
    const char* const gA = (const char*)g.A; const char* const gB = (const char*)g.Bt;
#define PG8_SA(b, h) (((b) * 2 + (h)) * HTB)
#define PG8_SB(b, h) ((4 + (b) * 2 + (h)) * HTB)
#define PG8_STAGE(bufoff, gbase, soff, voff) do { _Pragma("unroll") for (int _i = 0; _i < 2; ++_i) \
        __builtin_amdgcn_global_load_lds((const unsigned*)(((gbase) + (size_t)(unsigned)(soff)) + (voff)[_i]), (LAS unsigned*)(lds + (bufoff) + ldsw + _i * 8192), 16, 0, 0); } while (0)
#define PG8_LDA(dst, b, h) do { _Pragma("unroll") for (int m = 0; m < 4; ++m) _Pragma("unroll") for (int k = 0; k < 2; ++k) dst[m][k] = *(const LAS bf16x8*)(lds + PG8_SA(b, h) + aoff + m * 2048 + k * 1024); } while (0)
#define PG8_LDB(dst, b, h) do { _Pragma("unroll") for (int n = 0; n < 2; ++n) _Pragma("unroll") for (int k = 0; k < 2; ++k) dst[n][k] = *(const LAS bf16x8*)(lds + PG8_SB(b, h) + boff + n * 2048 + k * 1024); } while (0)
#define PG8_MMA(ai, bj, At, Bt) do { __builtin_amdgcn_s_setprio(1); _Pragma("unroll") for (int m = 0; m < 4; ++m) _Pragma("unroll") for (int n = 0; n < 2; ++n) _Pragma("unroll") for (int k = 0; k < 2; ++k) \
        acc[ai][bj][m][n] = __builtin_amdgcn_mfma_f32_16x16x32_bf16(Bt[n][k], At[m][k], acc[ai][bj][m][n], 0, 0, 0); __builtin_amdgcn_s_setprio(0); } while (0)
#define PG8_WAIT_V(n) asm volatile("s_waitcnt vmcnt(" #n ")" ::: "memory")
#define PG8_WAIT_L(n) asm volatile("s_waitcnt lgkmcnt(" #n ")" ::: "memory")
#define PG8_BAR __builtin_amdgcn_s_barrier()
#define PG8_SCHED __builtin_amdgcn_sched_barrier(0)
    Unit cur, nxt; int ui = 0;
    if (!S.next(0, cur)) return;
    f32x4 acc[2][2][4][2];
#pragma unroll
    for (int a = 0; a < 2; ++a)
#pragma unroll
        for (int b = 0; b < 2; ++b)
#pragma unroll
            for (int m = 0; m < 4; ++m)
#pragma unroll
                for (int n = 0; n < 2; ++n) acc[a][b][m][n] = (f32x4){0.f, 0.f, 0.f, 0.f};
    bf16x8 At[4][2], B0[2][2], B1[2][2];
    unsigned cA = (unsigned)cur.z * g.zA + (unsigned)cur.pm * tstepA, cB = (unsigned)cur.z * g.zB + (unsigned)cur.pn * tstepB;
    PG8_STAGE(PG8_SB(0, 0), gB, cB, voffB); PG8_STAGE(PG8_SA(0, 0), gA, cA, voffA); PG8_STAGE(PG8_SB(0, 1), gB, cB + hstepB, voffB); PG8_STAGE(PG8_SA(0, 1), gA, cA + hstepA, voffA);
    if (wr == 1) PG8_BAR;
    PG8_WAIT_V(4); PG8_BAR;
    PG8_STAGE(PG8_SB(1, 0), gB, cB + kstep, voffB); PG8_STAGE(PG8_SA(1, 0), gA, cA + kstep, voffA); PG8_STAGE(PG8_SB(1, 1), gB, cB + hstepB + kstep, voffB);
    PG8_WAIT_V(6); PG8_BAR;
    for (;;) {
        const bool has_next = S.next(ui + 1, nxt);
        const unsigned nA = has_next ? (unsigned)nxt.z * g.zA + (unsigned)nxt.pm * tstepA : cA, nB = has_next ? (unsigned)nxt.z * g.zB + (unsigned)nxt.pn * tstepB : cB;
        for (int t = 0; t < nt; t += 2) {
            const bool last = (t == nt - 2);
            const unsigned a1 = cA + (unsigned)(t + 1) * kstep;
            const unsigned a2 = last ? nA : cA + (unsigned)(t + 2) * kstep, b2 = last ? nB : cB + (unsigned)(t + 2) * kstep;
            const unsigned a3 = a2 + kstep, b3 = b2 + kstep;
            PG8_LDB(B0, 0, 0); PG8_SCHED; PG8_LDA(At, 0, 0); PG8_STAGE(PG8_SA(1, 1), gA, a1 + hstepA, voffA);
            PG8_WAIT_L(8); PG8_BAR; PG8_WAIT_L(0); PG8_MMA(0, 0, At, B0); PG8_BAR; PG8_SCHED;
            PG8_LDB(B1, 0, 1); PG8_STAGE(PG8_SB(0, 0), gB, b2, voffB);
            PG8_BAR; PG8_WAIT_L(0); PG8_MMA(0, 1, At, B1); PG8_BAR;
            PG8_LDA(At, 0, 1); PG8_STAGE(PG8_SA(0, 0), gA, a2, voffA);
            PG8_BAR; PG8_WAIT_L(0); PG8_MMA(1, 0, At, B0); PG8_BAR; PG8_SCHED;
            PG8_STAGE(PG8_SB(0, 1), gB, b2 + hstepB, voffB);
            PG8_WAIT_V(6); PG8_BAR; PG8_MMA(1, 1, At, B1); PG8_BAR;
            PG8_LDB(B0, 1, 0); PG8_SCHED; PG8_LDA(At, 1, 0); PG8_STAGE(PG8_SA(0, 1), gA, a2 + hstepA, voffA);
            PG8_WAIT_L(8); PG8_BAR; PG8_WAIT_L(0); PG8_MMA(0, 0, At, B0); PG8_BAR; PG8_SCHED;
            PG8_LDB(B1, 1, 1); PG8_STAGE(PG8_SB(1, 0), gB, b3, voffB);
            PG8_BAR; PG8_WAIT_L(0); PG8_MMA(0, 1, At, B1); PG8_BAR;
            PG8_LDA(At, 1, 1); PG8_STAGE(PG8_SA(1, 0), gA, a3, voffA);
            PG8_BAR; PG8_WAIT_L(0); PG8_MMA(1, 0, At, B0); PG8_BAR; PG8_SCHED;
            PG8_STAGE(PG8_SB(1, 1), gB, b3 + hstepB, voffB);
            PG8_WAIT_V(6); PG8_BAR; PG8_MMA(1, 1, At, B1); PG8_BAR;
        }
        E(acc, cur, wr, wc, fr, fq);
        if (!has_next) break;
#pragma unroll
        for (int a = 0; a < 2; ++a)
#pragma unroll
            for (int b = 0; b < 2; ++b)
#pragma unroll
                for (int m = 0; m < 4; ++m)
#pragma unroll
                    for (int n = 0; n < 2; ++n) acc[a][b][m][n] = (f32x4){0.f, 0.f, 0.f, 0.f};
        cur = nxt; cA = nA; cB = nB; ++ui;
    }
    PG8_WAIT_V(0);
    if (wr == 0) PG8_BAR;
    PG8_BAR;
#undef PG8_SA
#undef PG8_SB
#undef PG8_STAGE
#undef PG8_LDA
#undef PG8_LDB
#undef PG8_MMA
#undef PG8_WAIT_V
#undef PG8_WAIT_L
#undef PG8_BAR
#undef PG8_SCHED
}
}
using pg8::Unit;
typedef f32x4 Acc[2][2][4][2];

struct EpiFFNa { static constexpr bool PERM = false; bf16_t* H; const float* ss;
    __device__ __forceinline__ void operator()(const Acc& acc, const Unit& u, int wr, int wc, int fr, int fq) const {
        const int row0 = u.pm * 256 + wr * 64 + fr, hc0 = u.pn * 128 + wc * 16 + 4 * fq;
#pragma unroll
        for (int ai = 0; ai < 2; ++ai)
#pragma unroll
            for (int m = 0; m < 4; ++m) { const int row = row0 + ai * 128 + m * 16; const float rs = row_rstd(ss, row);
#pragma unroll
                for (int bj = 0; bj < 2; ++bj) { const f32x4 gt = acc[ai][bj][m][0] * rs, up = acc[ai][bj][m][1] * rs; f32x4 h;
#pragma unroll
                    for (int j = 0; j < 4; ++j) h[j] = gt[j] * sigmoidf_(gt[j]) * up[j];
                    st_bf4(H + (size_t)row * FF + hc0 + bj * 64, h); } }
    }
};
struct EpiRes { static constexpr bool PERM = false; const float* xin; float* xout; bf16_t* xb; float* ss_out; float scale;
    __device__ __forceinline__ void operator()(const Acc& acc, const Unit& u, int wr, int wc, int fr, int fq) const {
        const int row0 = u.pm * 256 + wr * 64 + fr, col0 = u.pn * 256 + wc * 32 + 4 * fq;
#pragma unroll
        for (int ai = 0; ai < 2; ++ai)
#pragma unroll
            for (int m = 0; m < 4; ++m) { const int row = row0 + ai * 128 + m * 16; float q = 0.f;
#pragma unroll
                for (int bj = 0; bj < 2; ++bj)
#pragma unroll
                    for (int n = 0; n < 2; ++n) { const size_t o = (size_t)row * D + col0 + bj * 128 + n * 16; const f32x4 v = *(const f32x4*)(xin + o) + acc[ai][bj][m][n] * scale;
                        *(f32x4*)(xout + o) = v; st_bf4(xb + o, v); q += (v[0] * v[0] + v[1] * v[1]) + (v[2] * v[2] + v[3] * v[3]); }
                q += __shfl_xor(q, 16); q += __shfl_xor(q, 32);
                if (fq == 0) ss_out[(size_t)row * 16 + u.pn * 4 + wc] = q; }
    }
};
struct EpiU { static constexpr bool PERM = true; bf16_t* Ubase; const float* ss;
    __device__ __forceinline__ void operator()(const Acc& acc, const Unit& u, int wr, int wc, int fr, int fq) const {
        bf16_t* base; int ld, c0;
        if (u.pn < 7) { base = (bf16_t*)((char*)Ubase + U_RWKV); ld = 1792; c0 = u.pn * 256; }
        else if (u.pn < 14) { base = (bf16_t*)((char*)Ubase + U_GLA); ld = 1792; c0 = (u.pn - 7) * 256; }
        else { base = (bf16_t*)((char*)Ubase + U_XA); ld = 512; c0 = (u.pn - 14) * 256; }
        const int row0 = u.pm * 256 + wr * 64 + fr; c0 += wc * 32 + 8 * fq;
#pragma unroll
        for (int ai = 0; ai < 2; ++ai)
#pragma unroll
            for (int m = 0; m < 4; ++m) { const int row = row0 + ai * 128 + m * 16; const float rs = row_rstd(ss, row);
#pragma unroll
                for (int bj = 0; bj < 2; ++bj) { const f32x4 v0 = acc[ai][bj][m][0] * rs, v1 = acc[ai][bj][m][1] * rs; u32x4 w;
                    w.x = cvt_pk_bf16(v0[0], v0[1]); w.y = cvt_pk_bf16(v0[2], v0[3]); w.z = cvt_pk_bf16(v1[0], v1[1]); w.w = cvt_pk_bf16(v1[2], v1[3]);
                    *(u32x4*)(base + (size_t)row * ld + c0 + bj * 128) = w; } }
    }
};
struct EpiGate { static constexpr bool PERM = true; bf16_t* Gt; const float* ss;
    __device__ __forceinline__ void operator()(const Acc& acc, const Unit& u, int wr, int wc, int fr, int fq) const {
        const int row0 = u.pm * 256 + wr * 64 + fr, c0 = u.pn * 256 + wc * 32 + 8 * fq;
#pragma unroll
        for (int ai = 0; ai < 2; ++ai)
#pragma unroll
            for (int m = 0; m < 4; ++m) { const int row = row0 + ai * 128 + m * 16; const float rs = row_rstd(ss, row);
#pragma unroll
                for (int bj = 0; bj < 2; ++bj) { f32x4 v0 = acc[ai][bj][m][0] * rs, v1 = acc[ai][bj][m][1] * rs;
#pragma unroll
                    for (int j = 0; j < 4; ++j) { v0[j] = sigmoidf_(v0[j]); v1[j] = sigmoidf_(v1[j]); }
                    u32x4 w; w.x = cvt_pk_bf16(v0[0], v0[1]); w.y = cvt_pk_bf16(v0[2], v0[3]); w.z = cvt_pk_bf16(v1[0], v1[1]); w.w = cvt_pk_bf16(v1[2], v1[3]);
                    *(u32x4*)(Gt + (size_t)row * 3072 + c0 + bj * 128) = w; } }
    }
};
struct EpiMerge { static constexpr bool PERM = false; const bf16_t* Gt; float* Mg; bf16_t* Mb;
    __device__ __forceinline__ void operator()(const Acc& acc, const Unit& u, int wr, int wc, int fr, int fq) const {
        const int row0 = u.pm * 256 + wr * 64 + fr, col0 = u.pn * 256 + wc * 32 + 4 * fq;
#pragma unroll
        for (int ai = 0; ai < 2; ++ai)
#pragma unroll
            for (int m = 0; m < 4; ++m) { const int row = row0 + ai * 128 + m * 16;
#pragma unroll
                for (int bj = 0; bj < 2; ++bj)
#pragma unroll
                    for (int n = 0; n < 2; ++n) { const int col = col0 + bj * 128 + n * 16; const size_t o = (size_t)row * D + col;
                        f32x4 v = acc[ai][bj][m][n] * ld_bf4(Gt + (size_t)row * 3072 + u.z * 1024 + col);
                        if (u.z > 0) v += *(const f32x4*)(Mg + o);
                        if (u.z < 2) *(f32x4*)(Mg + o) = v; else st_bf4(Mb + o, v); } }
    }
};
struct EpiKV { static constexpr bool PERM = false; bf16_t* Kb; bf16_t* Vt; const float* rstd;
    __device__ __forceinline__ void operator()(const Acc& acc, const Unit& u, int wr, int wc, int fr, int fq) const {
        const int row0 = u.pm * 256 + wr * 64 + fr, col0 = u.pn * 256 + wc * 32 + 4 * fq;
#pragma unroll
        for (int ai = 0; ai < 2; ++ai)
#pragma unroll
            for (int m = 0; m < 4; ++m) { const int row = row0 + ai * 128 + m * 16; const float rs = rstd[row];
#pragma unroll
                for (int bj = 0; bj < 2; ++bj)
#pragma unroll
                    for (int n = 0; n < 2; ++n) { const int col = col0 + bj * 128 + n * 16; const f32x4 v = acc[ai][bj][m][n] * rs;
                        if (col < 512) st_bf4(Kb + (size_t)row * 512 + col, v);
                        else {
#pragma unroll
                            for (int j = 0; j < 4; ++j) Vt[((size_t)(row >> 8) * 512 + (col - 512 + j)) * 256 + (row & 255)] = f2bf(v[j]); } } }
    }
};

template <int MAP> __device__ __forceinline__ int colmap(int n) {
    if (MAP == 1) { const int g = n >> 5, i = n & 31; return i < 16 ? 16 * g + i : FF + 16 * g + (i - 16); }
    if (MAP == 2) { if (n < 3344) return n; if (n < 3584) return -1; return n - 240; }
    return n;
}
template <int MAP>
__device__ __forceinline__ void convT(LAS unsigned char* lds, const float* src, int ld, int coff, const float* g, bf16_t* dst, int K, int Kd, int Nd, int G, int bid, int tid) {
    const int nkt = (K + 63) >> 6, nnt = (Nd + 63) >> 6, ntile = nkt * nnt;
    LAS bf16_t* tile = (LAS bf16_t*)lds;
    for (int t = bid; t < ntile; t += G) {
        const int kt = t % nkt, ntl = t / nkt, k0 = kt * 64, n0 = ntl * 64;
        { const int nl = tid & 63, kl0 = tid >> 6, n = n0 + nl; const int c = (n < Nd) ? colmap<MAP>(n) : -1;
#pragma unroll
          for (int i = 0; i < 8; ++i) { const int kl = kl0 + 8 * i, k = k0 + kl; float v = 0.f;
              if (c >= 0 && k < K) { v = src[(size_t)k * ld + coff + c]; if (g) v *= g[k]; }
              tile[nl * 72 + kl] = f2bf(v); } }
        __syncthreads();
        { const int nl = tid >> 3, kc = (tid & 7) * 8, n = n0 + nl, k = k0 + kc;
          if (n < Nd && k < Kd) *(u32x4*)(dst + (size_t)n * Kd + k) = *(LAS u32x4*)(tile + nl * 72 + kc); }
        __syncthreads();
    }
}

template <int MAP>
__device__ __forceinline__ void convT_w(const float* src, int ld, int coff, const float* g, bf16_t* dst, int K, int Kd, int Nd, int wslot, int nslots, int lane, int tile_base) {
    const int nkt = K >> 4, nnt = (Nd + 255) >> 8, ntile = nkt * nnt;
    for (int t = ((wslot - tile_base) % nslots + nslots) % nslots; t < ntile; t += nslots) {
        const int kt = t % nkt, ntl = t / nkt, k0 = kt * 16, n = ntl * 256 + lane * 4; const int c = (n < Nd) ? colmap<MAP>(n) : -1;
        const float* sp = src + (size_t)k0 * ld + coff + (c >= 0 ? c : 0);
        f32x4 v[16];
#pragma unroll
        for (int kk = 0; kk < 16; ++kk) { v[kk] = *(const f32x4*)(sp + (size_t)kk * ld); if (g) v[kk] *= g[k0 + kk]; if (c < 0) v[kk] = (f32x4){0.f, 0.f, 0.f, 0.f}; }
        if (n < Nd) {
#pragma unroll
            for (int j = 0; j < 4; ++j) { u32x4 lo, hi;
                lo.x = cvt_pk_bf16(v[0][j], v[1][j]); lo.y = cvt_pk_bf16(v[2][j], v[3][j]); lo.z = cvt_pk_bf16(v[4][j], v[5][j]); lo.w = cvt_pk_bf16(v[6][j], v[7][j]);
                hi.x = cvt_pk_bf16(v[8][j], v[9][j]); hi.y = cvt_pk_bf16(v[10][j], v[11][j]); hi.z = cvt_pk_bf16(v[12][j], v[13][j]); hi.w = cvt_pk_bf16(v[14][j], v[15][j]);
                bf16_t* dp = dst + (size_t)(n + j) * Kd + k0; *(u32x4*)dp = lo; *(u32x4*)(dp + 8) = hi; }
        }
    }
}

template <int K>
__device__ __forceinline__ void wave_gemm(f32x4 (&acc)[4][4], LAS const unsigned char* A, int sA, const bf16_t* Bt, int fr, int fq) {
#pragma unroll
    for (int m = 0; m < 4; ++m)
#pragma unroll
        for (int n = 0; n < 4; ++n) acc[m][n] = (f32x4){0.f, 0.f, 0.f, 0.f};
#pragma unroll
    for (int ks = 0; ks < K / 32; ++ks) { bf16x8 a[4], b[4];
#pragma unroll
        for (int m = 0; m < 4; ++m) a[m] = *(LAS const bf16x8*)(A + (16 * m + fr) * sA + (ks * 32 + fq * 8) * 2);
#pragma unroll
        for (int n = 0; n < 4; ++n) b[n] = *(const bf16x8*)(Bt + (size_t)(16 * n + fr) * K + ks * 32 + fq * 8);
#pragma unroll
        for (int m = 0; m < 4; ++m)
#pragma unroll
            for (int n = 0; n < 4; ++n) acc[m][n] = mfma16(b[n], a[m], acc[m][n]); }
}

template <int K>
__device__ __forceinline__ void row_gemm(f32x4 (&acc)[4], LAS const unsigned char* Arow, const bf16_t* Bt, int fr, int fq) {
#pragma unroll
    for (int n = 0; n < 4; ++n) acc[n] = (f32x4){0.f, 0.f, 0.f, 0.f};
#pragma unroll
    for (int ks = 0; ks < K / 32; ++ks) { const bf16x8 a = *(LAS const bf16x8*)(Arow + (ks * 32 + fq * 8) * 2);
#pragma unroll
        for (int n = 0; n < 4; ++n) { const bf16x8 b = *(const bf16x8*)(Bt + (size_t)(16 * n + fr) * K + ks * 32 + fq * 8); acc[n] = mfma16(b, a, acc[n]); } }
}

struct PrepArgs { const bf16_t* U; const float *mu, *w0, *a0, *kk_, *ka, *rk, *v0; const bf16_t *w2t, *a2t, *g2t, *v1t, *v2t; float* vfirst; float* Wd; float* V; bf16_t* RKKB; bf16_t* Go; float* Bon; int layer; };

__device__ __forceinline__ f32x4 shifted4(const bf16_t* Ut, bool has_prev, int c, const float* mu) {
    const f32x4 u = ld_bf4(Ut + c); f32x4 p = (f32x4){0.f, 0.f, 0.f, 0.f}; if (has_prev) p = ld_bf4(Ut - 1792 + c);
    const f32x4 m = *(const f32x4*)(mu + c); return u + m * (p - u);
}

__device__ __forceinline__ void rwkv_prep_tile(LAS unsigned char* lds, const PrepArgs& P, int tt, int tid) {
    constexpr int SW = 144, SG = 272, SV = 1040, SVV = 80;
    LAS unsigned char* LAw = lds; LAS unsigned char* LAa = lds + 9216; LAS unsigned char* LAg = lds + 18432; LAS unsigned char* LAv = lds + 35840; LAS unsigned char* LAvv = lds + 102400;
    const int t0 = tt * 64; const int s0 = t0 & (SEQ - 1);
    const int lane = tid & 63, wave = __builtin_amdgcn_readfirstlane(tid >> 6), fr = lane & 15, fq = lane >> 4;
#pragma unroll 2
    for (int e = 0; e < 4; ++e) { const int idx = tid + 512 * e, i = idx >> 5, c = (idx & 31) * 8; const bf16_t* Ut = P.U + (size_t)(t0 + i) * 1792; const bool hp = s0 + i > 0;
        f32x4 x0 = shifted4(Ut, hp, 1536 + c, P.mu), x1 = shifted4(Ut, hp, 1536 + c + 4, P.mu);
        if (c < 64) {
#pragma unroll
            for (int q = 0; q < 4; ++q) { const float ea = __expf(2.f * x0[q]), eb = __expf(2.f * x1[q]); x0[q] = 1.f - 2.f / (ea + 1.f); x1[q] = 1.f - 2.f / (eb + 1.f); } }
        else if (c >= 128) {
#pragma unroll
            for (int q = 0; q < 4; ++q) { x0[q] = sigmoidf_(x0[q]); x1[q] = sigmoidf_(x1[q]); } }
        u32x4 o; o.x = cvt_pk_bf16(x0[0], x0[1]); o.y = cvt_pk_bf16(x0[2], x0[3]); o.z = cvt_pk_bf16(x1[0], x1[1]); o.w = cvt_pk_bf16(x1[2], x1[3]);
        LAS unsigned char* dstp = (c < 64) ? (LAw + i * SW + c * 2) : (c < 128) ? (LAa + i * SW + (c - 64) * 2) : (LAg + i * SG + (c - 128) * 2);
        *(LAS u32x4*)dstp = o; }
    if (P.layer > 0) {
#pragma unroll 2
        for (int e = 0; e < 8; ++e) { const int idx = tid + 512 * e, i = idx >> 6, c = (idx & 63) * 8; const bf16_t* Ut = P.U + (size_t)(t0 + i) * 1792; const bool hp = s0 + i > 0;
            const f32x4 x0 = shifted4(Ut, hp, 1024 + c, P.mu), x1 = shifted4(Ut, hp, 1024 + c + 4, P.mu);
            u32x4 o; o.x = cvt_pk_bf16(x0[0], x0[1]); o.y = cvt_pk_bf16(x0[2], x0[3]); o.z = cvt_pk_bf16(x1[0], x1[1]); o.w = cvt_pk_bf16(x1[2], x1[3]);
            *(LAS u32x4*)(LAv + i * SV + c * 2) = o; }
    }
    __syncthreads();
    if (P.layer > 0) {
        const int mt = wave >> 1, nt = wave & 1; f32x4 acc = (f32x4){0.f, 0.f, 0.f, 0.f};
#pragma unroll 4
        for (int ks = 0; ks < 16; ++ks) { const bf16x8 a = *(LAS const bf16x8*)(LAv + (16 * mt + fr) * SV + (ks * 32 + fq * 8) * 2);
            const bf16x8 b = *(const bf16x8*)(P.v1t + (size_t)(16 * nt + fr) * 512 + ks * 32 + fq * 8); acc = mfma16(b, a, acc); }
        u32x2 w; w.x = cvt_pk_bf16(acc[0], acc[1]); w.y = cvt_pk_bf16(acc[2], acc[3]); *(LAS u32x2*)(LAvv + (16 * mt + fr) * SVV + (16 * nt + 4 * fq) * 2) = w;
    }
    __syncthreads();
    const int h = wave, cb = 64 * h; const int b_ = t0 >> 12, p = b_ * 8 + h;
#pragma unroll 1
    for (int m = 0; m < 4; ++m) {
        const int i = 16 * m + fr; const bf16_t* Ut = P.U + (size_t)(t0 + i) * 1792; const bool hp = (s0 + i) > 0;
        int fq4 = 4 * fq; asm volatile("" : "+v"(fq4));
        f32x4 aa[4], acc[4];
        row_gemm<64>(aa, LAa + i * SW, P.a2t + (size_t)cb * 64, fr, fq);
#pragma unroll
        for (int n = 0; n < 4; ++n) { const f32x4 a0v = *(const f32x4*)(P.a0 + cb + 16 * n + fq4);
#pragma unroll
            for (int j = 0; j < 4; ++j) aa[n][j] = sigmoidf_(aa[n][j] + a0v[j]); }
        row_gemm<64>(acc, LAw + i * SW, P.w2t + (size_t)cb * 64, fr, fq);
#pragma unroll
        for (int n = 0; n < 4; ++n) { const f32x4 w0v = *(const f32x4*)(P.w0 + cb + 16 * n + fq4); f32x4 d;
#pragma unroll
            for (int j = 0; j < 4; ++j) d[j] = __expf(-0.6065306597f * sigmoidf_(acc[n][j] + w0v[j]));
            *(f32x4*)(P.Wd + ((size_t)p * SEQ + s0 + i) * 64 + 16 * n + fq4) = d; }
        row_gemm<128>(acc, LAg + i * SG, P.g2t + (size_t)cb * 128, fr, fq);
#pragma unroll
        for (int n = 0; n < 4; ++n) st_bf4(P.Go + (size_t)(t0 + i) * 512 + cb + 16 * n + fq4, acc[n]);
        asm volatile("" ::: "memory");
        if (P.layer > 0) row_gemm<32>(acc, LAvv + i * SVV, P.v2t + (size_t)cb * 32, fr, fq);
        float bon = 0.f, nk = 0.f; f32x4 kv[4], rv[4];
#pragma unroll
        for (int n = 0; n < 4; ++n) { const int c = cb + 16 * n + fq4;
            f32x4 v = shifted4(Ut, hp, 1024 + c, P.mu);
            if (P.layer > 0) { const f32x4 vf = *(const f32x4*)(P.vfirst + (size_t)(t0 + i) * 512 + c); const f32x4 v0v = *(const f32x4*)(P.v0 + c);
#pragma unroll
                for (int j = 0; j < 4; ++j) v[j] = v[j] + (vf[j] - v[j]) * sigmoidf_(v0v[j] + acc[n][j]); }
            else *(f32x4*)(P.vfirst + (size_t)(t0 + i) * 512 + c) = v;
            *(f32x4*)(P.V + ((size_t)p * SEQ + s0 + i) * 64 + 16 * n + fq4) = v;
            kv[n] = shifted4(Ut, hp, 512 + c, P.mu); rv[n] = shifted4(Ut, hp, c, P.mu);
            const f32x4 kkw = *(const f32x4*)(P.kk_ + c);
#pragma unroll
            for (int j = 0; j < 4; ++j) { const float x = kv[n][j] * kkw[j]; nk += x * x; } }
        nk += __shfl_xor(nk, 16); nk += __shfl_xor(nk, 32);
        const float inv = 1.0f / fmaxf(sqrtf(nk), 1e-12f);
        bf16_t* O = P.RKKB + ((size_t)p * SEQ + s0 + i) * 256;
#pragma unroll
        for (int n = 0; n < 4; ++n) { const int c = cb + 16 * n + fq4; const f32x4 kkw = *(const f32x4*)(P.kk_ + c), kaw = *(const f32x4*)(P.ka + c), rkw = *(const f32x4*)(P.rk + c);
            f32x4 kk, kh, bb;
#pragma unroll
            for (int j = 0; j < 4; ++j) { const float a = aa[n][j]; kk[j] = kv[n][j] * kkw[j] * inv; kh[j] = kv[n][j] * (1.f + (a - 1.f) * kaw[j]); bb[j] = kk[j] * a; bon += rv[n][j] * kh[j] * rkw[j]; }
            const int cc = 16 * n + fq4; st_bf4(O + cc, rv[n]); st_bf4(O + 64 + cc, kh); st_bf4(O + 128 + cc, kk); st_bf4(O + 192 + cc, bb); }
        bon += __shfl_xor(bon, 16); bon += __shfl_xor(bon, 32);
        if (fq == 0) P.Bon[(size_t)(t0 + i) * 8 + h] = bon;
        asm volatile("" ::: "memory");
    }
    __syncthreads();
}

constexpr int SCAN_CH = 32, SCAN_STEP_B = 1344, SCAN_SLOT_B = SCAN_CH * SCAN_STEP_B;
template <int CTRL> __device__ __forceinline__ float dpp_f(float v) { return __int_as_float(__builtin_amdgcn_update_dpp(0, __float_as_int(v), CTRL, 0xf, 0xf, true)); }
__device__ __forceinline__ float row16_sum(float v) { v += dpp_f<0xB1>(v); v += dpp_f<0x4E>(v); v += dpp_f<0x141>(v); v += dpp_f<0x140>(v); return v; }

__device__ __forceinline__ float tr16_sum(const float (&p)[16], int kq) {
    const bool b3 = (kq & 8) != 0, b2 = (kq & 4) != 0, b1 = (kq & 2) != 0, b0 = (kq & 1) != 0;
    float q[8], r[4], u[2];
#pragma unroll
    for (int t = 0; t < 8; ++t) { const float keep = b3 ? p[t + 8] : p[t], send = b3 ? p[t] : p[t + 8]; q[t] = keep + dpp_f<0x140>(send); }
#pragma unroll
    for (int t = 0; t < 4; ++t) { const float keep = b2 ? q[t + 4] : q[t], send = b2 ? q[t] : q[t + 4]; r[t] = keep + dpp_f<0x141>(send); }
#pragma unroll
    for (int t = 0; t < 2; ++t) { const float keep = b1 ? r[t + 2] : r[t], send = b1 ? r[t] : r[t + 2]; u[t] = keep + dpp_f<0x4E>(send); }
    const float keep = b0 ? u[1] : u[0], send = b0 ? u[0] : u[1];
    return keep + dpp_f<0xB1>(send);
}

__device__ __forceinline__ void scan_load_chunk(LAS unsigned char* slot, const float* Wd, const float* V, const bf16_t* RKKB, int p, int rg, int s0, int lt) {
    u32x4 r[7];
    const size_t base = (size_t)p * SEQ + s0;
#pragma unroll
    for (int j = 0; j < 2; ++j) { const int idx = lt + 256 * j, st = idx >> 4, part = idx & 15; r[j] = *(const u32x4*)(Wd + (base + st) * 64 + part * 4); }
#pragma unroll
    for (int j = 2; j < 6; ++j) { const int k = lt + 256 * (j - 2), st = k >> 5, rem = k & 31, q = rem >> 3, part = rem & 7; r[j] = *(const u32x4*)(RKKB + ((base + st) * 4 + q) * 64 + part * 8); }
    if (lt < 128) { const int st = lt >> 2, hf = lt & 3; r[6] = *(const u32x4*)(V + (base + st) * 64 + rg * 16 + hf * 4); }
#pragma unroll
    for (int j = 0; j < 2; ++j) { const int idx = lt + 256 * j, st = idx >> 4, part = idx & 15; *(LAS u32x4*)(slot + st * SCAN_STEP_B + part * 16) = r[j]; }
#pragma unroll
    for (int j = 2; j < 6; ++j) { const int k = lt + 256 * (j - 2), st = k >> 5, rem = k & 31, q = rem >> 3, part = rem & 7; const u32x4 w = r[j];
        const int Q = (q == 0) ? 4 : (q == 1) ? 2 : (q == 2) ? 3 : 1;
        LAS f32x4* d = (LAS f32x4*)(slot + st * SCAN_STEP_B + Q * 256 + part * 32);
        d[0] = (f32x4){bflo(w.x), bfhi(w.x), bflo(w.y), bfhi(w.y)}; d[1] = (f32x4){bflo(w.z), bfhi(w.z), bflo(w.w), bfhi(w.w)}; }
    if (lt < 128) { const int st = lt >> 2, hf = lt & 3; *(LAS u32x4*)(slot + st * SCAN_STEP_B + 1280 + hf * 16) = r[6]; }
}

__device__ __forceinline__ void rwkv_scan_unit(LAS unsigned char* lds, const float* Wd, const float* V, const bf16_t* RKKB, float* Yraw, int p, int rg, int tid) {
    const int lane = tid & 63, wave = __builtin_amdgcn_readfirstlane(tid >> 6);
    constexpr int NCH = SEQ / SCAN_CH;
    scan_load_chunk(lds + (tid >> 8) * SCAN_SLOT_B, Wd, V, RKKB, p, rg, (tid >> 8) * SCAN_CH, tid & 255);
    __syncthreads();
    f32x4 S = (f32x4){0.f, 0.f, 0.f, 0.f};
    const int kq = lane & 15, rl = wave * 4 + (lane >> 4);
    for (int c = 0; c < NCH; ++c) {
        if (wave >= 4) { if (c + 2 < NCH) scan_load_chunk(lds + ((c + 2) % 3) * SCAN_SLOT_B, Wd, V, RKKB, p, rg, (c + 2) * SCAN_CH, tid - 256); }
        else {
            LAS const unsigned char* sl = lds + (c % 3) * SCAN_SLOT_B + kq * 16;
            LAS const unsigned char* vl = lds + (c % 3) * SCAN_SLOT_B + 1280 + rl * 4;
            float* yo = Yraw + ((size_t)p * SEQ + c * SCAN_CH + kq) * 64 + rg * 16 + rl;
            f32x4 w = *(LAS const f32x4*)(sl), b = *(LAS const f32x4*)(sl + 256), k = *(LAS const f32x4*)(sl + 512), kk = *(LAS const f32x4*)(sl + 768), r = *(LAS const f32x4*)(sl + 1024);
            float v = *(LAS const float*)(vl); float yp[16];
#pragma unroll
            for (int st = 0; st < SCAN_CH; ++st) {
                f32x4 wn = w, bn = b, kn = k, kkn = kk, rn = r; float vn = v;
                if (st + 1 < SCAN_CH) { const int o = (st + 1) * SCAN_STEP_B;
                    wn = *(LAS const f32x4*)(sl + o); bn = *(LAS const f32x4*)(sl + o + 256); kn = *(LAS const f32x4*)(sl + o + 512); kkn = *(LAS const f32x4*)(sl + o + 768); rn = *(LAS const f32x4*)(sl + o + 1024);
                    vn = *(LAS const float*)(vl + o); }
                float sa = (S[0] * kk[0] + S[1] * kk[1]) + (S[2] * kk[2] + S[3] * kk[3]);
                const f32x4 kvt = k * v;
                sa = -row16_sum(sa);
                S = S * w + (b * sa + kvt);
                yp[st & 15] = (S[0] * r[0] + S[1] * r[1]) + (S[2] * r[2] + S[3] * r[3]);
                if ((st & 15) == 15) yo[(size_t)(st - 15) * 64] = tr16_sum(yp, kq);
                w = wn; b = bn; k = kn; kk = kkn; r = rn; v = vn;
            }
        }
        __syncthreads();
    }
}

struct GlaArgs { const bf16_t* Ug; const float *conv, *aup, *abias, *gnorm; float* kvcT; float* dec; bf16_t* spT; bf16_t* Yg; };
constexpr int GL_GC = 0;
constexpr int GL_T0 = 16640;
constexpr int GL_VT = GL_T0 + 4 * 9216;
constexpr int GL_AL = GL_VT + 18432;
constexpr int GL_RS = GL_AL + 9216;

__device__ __forceinline__ void gla_conv8(f32x4 (&out)[8], const bf16_t* Ug, const float* conv, int t0, int s0, int i0, int c0) {
    f32x4 w[4];
#pragma unroll
    for (int j = 0; j < 4; ++j) w[j] = *(const f32x4*)(conv + j * 1024 + c0);
#pragma unroll
    for (int e = 0; e < 8; ++e) { const int i = i0 + 8 * e; f32x4 a = (f32x4){0.f, 0.f, 0.f, 0.f};
#pragma unroll
        for (int j = 0; j < 4; ++j) { const int ds = 3 - j; if (s0 + i - ds >= 0) a += w[j] * ld_bf4(Ug + (size_t)(t0 + i - ds) * 1792 + c0); }
#pragma unroll
        for (int q = 0; q < 4; ++q) a[q] = a[q] * sigmoidf_(a[q]);
        out[e] = a; }
}
__device__ __forceinline__ void gla_gcum(LAS unsigned char* lds, const GlaArgs& A, int t0, int h, int tid) {
    LAS float* GC = (LAS float*)(lds + GL_GC);
    { const int d = tid & 63, i0 = tid >> 6; float au[16]; const float ab = A.abias[h * 64 + d];
#pragma unroll
      for (int j = 0; j < 16; ++j) au[j] = A.aup[j * 256 + h * 64 + d];
#pragma unroll
      for (int e = 0; e < 8; ++e) { const int i = i0 + 8 * e; const u32x4* ap = (const u32x4*)(A.Ug + (size_t)(t0 + i) * 1792 + 1024); const u32x4 a0 = ap[0], a1 = ap[1];
          float x = ab;
          x += bflo(a0.x) * au[0] + bfhi(a0.x) * au[1] + bflo(a0.y) * au[2] + bfhi(a0.y) * au[3] + bflo(a0.z) * au[4] + bfhi(a0.z) * au[5] + bflo(a0.w) * au[6] + bfhi(a0.w) * au[7];
          x += bflo(a1.x) * au[8] + bfhi(a1.x) * au[9] + bflo(a1.y) * au[10] + bfhi(a1.y) * au[11] + bflo(a1.z) * au[12] + bfhi(a1.z) * au[13] + bflo(a1.w) * au[14] + bfhi(a1.w) * au[15];
          const float ls = fminf(x, 0.f) - __logf(1.f + __expf(-fabsf(x)));
          GC[i * 65 + d] = ls * (1.0f / 16.0f); } }
    __syncthreads();
    { const int lane = tid & 63, wave = tid >> 6;
#pragma unroll
      for (int dd = 0; dd < 8; ++dd) { const int d = wave * 8 + dd; float x = GC[lane * 65 + d];
#pragma unroll
          for (int o = 1; o < 64; o <<= 1) { const float y = __shfl_up(x, o); if (lane >= o) x += y; }
          GC[lane * 65 + d] = x; } }
    __syncthreads();
}
__device__ __forceinline__ void gla_a_tile(LAS unsigned char* lds, const GlaArgs& A, int tile, int tid) {
    const int bh = tile >> 6, n = tile & 63, b = bh >> 2, h = bh & 3, t0 = b * SEQ + n * 64, s0 = n * 64;
    LAS float* GC = (LAS float*)(lds + GL_GC); LAS bf16_t* KDT = (LAS bf16_t*)(lds + GL_T0); LAS bf16_t* VT = (LAS bf16_t*)(lds + GL_VT);
    gla_gcum(lds, A, t0, h, tid);
    { const int cc = (tid & 63) * 4, i0 = tid >> 6;
      if (cc >= 64) { f32x4 o[8]; const int c0 = (cc < 128) ? 256 + h * 64 + (cc - 64) : 512 + h * 128 + (cc - 128);
          gla_conv8(o, A.Ug, A.conv, t0, s0, i0, c0);
          if (cc < 128) { const int d = cc - 64;
#pragma unroll
              for (int e = 0; e < 8; ++e) { const int i = i0 + 8 * e;
#pragma unroll
                  for (int q = 0; q < 4; ++q) KDT[(d + q) * 72 + i] = f2bf(o[e][q] * __expf(GC[63 * 65 + d + q] - GC[i * 65 + d + q])); } }
          else { const int ev = cc - 128;
#pragma unroll
              for (int e = 0; e < 8; ++e) { const int i = i0 + 8 * e;
#pragma unroll
                  for (int q = 0; q < 4; ++q) VT[(ev + q) * 72 + i] = f2bf(o[e][q]); } } } }
    if (tid < 64) A.dec[((size_t)bh * 64 + n) * 64 + tid] = __expf(GC[63 * 65 + tid]);
    __syncthreads();
    { const int lane = tid & 63, wave = tid >> 6, fr = lane & 15, fq = lane >> 4; f32x4 acc[4];
#pragma unroll
      for (int nt = 0; nt < 4; ++nt) acc[nt] = (f32x4){0.f, 0.f, 0.f, 0.f};
#pragma unroll
      for (int ks = 0; ks < 2; ++ks) { const bf16x8 a = *(LAS const bf16x8*)(VT + (16 * wave + fr) * 72 + ks * 32 + fq * 8);
#pragma unroll
          for (int nt = 0; nt < 4; ++nt) { const bf16x8 bfr = *(LAS const bf16x8*)(KDT + (16 * nt + fr) * 72 + ks * 32 + fq * 8); acc[nt] = mfma16(bfr, a, acc[nt]); } }
#pragma unroll
      for (int nt = 0; nt < 4; ++nt) *(f32x4*)(A.kvcT + (((size_t)bh * 64 + n) * 128 + 16 * wave + fr) * 64 + 16 * nt + 4 * fq) = acc[nt]; }
    __syncthreads();
}
__device__ __forceinline__ void gla_c_tile(LAS unsigned char* lds, const GlaArgs& A, int tile, int tid) {
    const int bh = tile >> 6, n = tile & 63, b = bh >> 2, h = bh & 3, t0 = b * SEQ + n * 64, s0 = n * 64;
    LAS float* GC = (LAS float*)(lds + GL_GC); LAS bf16_t* QG = (LAS bf16_t*)(lds + GL_T0); LAS bf16_t* KG = QG + 64 * 72; LAS bf16_t* QR = KG + 64 * 72; LAS bf16_t* KR = QR + 64 * 72;
    LAS bf16_t* VT = (LAS bf16_t*)(lds + GL_VT); LAS bf16_t* AL = (LAS bf16_t*)(lds + GL_AL); LAS float* RS = (LAS float*)(lds + GL_RS);
    gla_gcum(lds, A, t0, h, tid);
    { const int cc = (tid & 63) * 4, i0 = tid >> 6; f32x4 o[8];
      const int c0 = (cc < 64) ? h * 64 + cc : (cc < 128) ? 256 + h * 64 + (cc - 64) : 512 + h * 128 + (cc - 128);
      gla_conv8(o, A.Ug, A.conv, t0, s0, i0, c0);
      if (cc < 128) { const int d = cc & 63; const bool isq = cc < 64; LAS bf16_t* T1 = isq ? QG : KR; LAS bf16_t* T2 = isq ? QR : KG; const float sc = isq ? 0.125f : 1.0f;
#pragma unroll
          for (int e = 0; e < 8; ++e) { const int i = i0 + 8 * e; f32x4 x1, x2;
#pragma unroll
              for (int q = 0; q < 4; ++q) { const float eg = __expf(GC[i * 65 + d + q]); const float x = o[e][q] * sc; x1[q] = x * eg; x2[q] = x / eg; }
              u32x2 w1, w2; w1.x = cvt_pk_bf16(x1[0], x1[1]); w1.y = cvt_pk_bf16(x1[2], x1[3]); w2.x = cvt_pk_bf16(x2[0], x2[1]); w2.y = cvt_pk_bf16(x2[2], x2[3]);
              *(LAS u32x2*)(T1 + i * 72 + d) = w1; *(LAS u32x2*)(T2 + i * 72 + d) = w2; } }
      else { const int ev = cc - 128;
#pragma unroll
          for (int e = 0; e < 8; ++e) { const int i = i0 + 8 * e;
#pragma unroll
              for (int q = 0; q < 4; ++q) VT[(ev + q) * 72 + i] = f2bf(o[e][q]); } } }
    __syncthreads();
    const int lane = tid & 63, wave = tid >> 6, fr = lane & 15, fq = lane >> 4; const int mt = wave >> 1;
    {
#pragma unroll
        for (int q = 0; q < 2; ++q) { const int nt = (wave & 1) * 2 + q; f32x4 ap = (f32x4){0.f, 0.f, 0.f, 0.f}, af = ap;
#pragma unroll
            for (int ks = 0; ks < 2; ++ks) { const int ko = ks * 32 + fq * 8;
                ap = mfma16(*(LAS const bf16x8*)(KG + (16 * nt + fr) * 72 + ko), *(LAS const bf16x8*)(QG + (16 * mt + fr) * 72 + ko), ap);
                af = mfma16(*(LAS const bf16x8*)(KR + (16 * nt + fr) * 72 + ko), *(LAS const bf16x8*)(QR + (16 * mt + fr) * 72 + ko), af); }
            const int trow = 16 * mt + fr; f32x4 o;
#pragma unroll
            for (int j = 0; j < 4; ++j) { const int scol = 16 * nt + 4 * fq + j; o[j] = (scol <= trow) ? ap[j] : af[j]; }
            u32x2 w; w.x = cvt_pk_bf16(o[0], o[1]); w.y = cvt_pk_bf16(o[2], o[3]); *(LAS u32x2*)(AL + trow * 72 + 16 * nt + 4 * fq) = w; }
    }
    __syncthreads();
    f32x4 acc[4];
#pragma unroll
    for (int q = 0; q < 4; ++q) acc[q] = (f32x4){0.f, 0.f, 0.f, 0.f};
    const bf16_t* sp = A.spT + ((size_t)bh * 64 + n) * 128 * 64;
#pragma unroll
    for (int ks = 0; ks < 2; ++ks) { const int ko = ks * 32 + fq * 8; const bf16x8 a1 = *(LAS const bf16x8*)(AL + (16 * mt + fr) * 72 + ko), a2 = *(LAS const bf16x8*)(QG + (16 * mt + fr) * 72 + ko);
#pragma unroll
        for (int q = 0; q < 4; ++q) { const int nt = (wave & 1) * 4 + q;
            acc[q] = mfma16(*(LAS const bf16x8*)(VT + (16 * nt + fr) * 72 + ko), a1, acc[q]);
            acc[q] = mfma16(*(const bf16x8*)(sp + (size_t)(16 * nt + fr) * 64 + ko), a2, acc[q]); } }
    float ssq = 0.f;
#pragma unroll
    for (int q = 0; q < 4; ++q) ssq += (acc[q][0] * acc[q][0] + acc[q][1] * acc[q][1]) + (acc[q][2] * acc[q][2] + acc[q][3] * acc[q][3]);
    ssq += __shfl_xor(ssq, 16); ssq += __shfl_xor(ssq, 32);
    if (fq == 0) RS[(16 * mt + fr) * 2 + (wave & 1)] = ssq;
    __syncthreads();
    { const int i = 16 * mt + fr; const float rs = rsqrtf((RS[i * 2] + RS[i * 2 + 1]) * (1.0f / 128.0f) + 1e-6f);
#pragma unroll
      for (int q = 0; q < 4; ++q) { const int ecol = h * 128 + ((wave & 1) * 4 + q) * 16 + 4 * fq; const f32x4 nw = *(const f32x4*)(A.gnorm + ecol); const f32x4 go = ld_bf4(A.Ug + (size_t)(t0 + i) * 1792 + 1040 + ecol); f32x4 o;
#pragma unroll
          for (int j = 0; j < 4; ++j) o[j] = acc[q][j] * rs * nw[j] * go[j] * sigmoidf_(go[j]);
          st_bf4(A.Yg + (size_t)(t0 + i) * 512 + ecol, o); } }
    __syncthreads();
}

__device__ __forceinline__ void xa_tile(const bf16_t* Ux, const bf16_t* Kb, const bf16_t* Vt, bf16_t* Yx, int tile, int tid) {
    const int blk = tile & 31, h = (tile >> 5) & 3, b = tile >> 7; const int lane = tid & 63, wave = tid >> 6, fr = lane & 15, fq = lane >> 4;
    const int t = b * SEQ + blk * 128 + 16 * wave + fr;
    bf16x8 qf[4];
#pragma unroll
    for (int ks = 0; ks < 4; ++ks) qf[ks] = *(const bf16x8*)(Ux + (size_t)t * 512 + h * 128 + ks * 32 + fq * 8);
    f32x4 s[16];
#pragma unroll
    for (int nt = 0; nt < 16; ++nt) { s[nt] = (f32x4){0.f, 0.f, 0.f, 0.f}; const bf16_t* kr = Kb + (size_t)(b * 256 + 16 * nt + fr) * 512 + h * 128 + fq * 8;
#pragma unroll
        for (int ks = 0; ks < 4; ++ks) s[nt] = mfma16(*(const bf16x8*)(kr + ks * 32), qf[ks], s[nt]); }
    float mx = -1e30f;
#pragma unroll
    for (int nt = 0; nt < 16; ++nt)
#pragma unroll
        for (int j = 0; j < 4; ++j) mx = fmaxf(mx, s[nt][j]);
    mx = fmaxf(mx, __shfl_xor(mx, 16)); mx = fmaxf(mx, __shfl_xor(mx, 32));
    const float sc = 0.08838834764831845f * 1.4426950408889634f; float l = 0.f;
#pragma unroll
    for (int nt = 0; nt < 16; ++nt)
#pragma unroll
        for (int j = 0; j < 4; ++j) { const float pz = exp2f((s[nt][j] - mx) * sc); s[nt][j] = pz; l += pz; }
    l += __shfl_xor(l, 16); l += __shfl_xor(l, 32);
    f32x4 o[8];
#pragma unroll
    for (int dt = 0; dt < 8; ++dt) o[dt] = (f32x4){0.f, 0.f, 0.f, 0.f};
#pragma unroll
    for (int c = 0; c < 8; ++c) { union { u32x4 u; bf16x8 v; } pf;
        pf.u.x = cvt_pk_bf16(s[2 * c][0], s[2 * c][1]); pf.u.y = cvt_pk_bf16(s[2 * c][2], s[2 * c][3]); pf.u.z = cvt_pk_bf16(s[2 * c + 1][0], s[2 * c + 1][1]); pf.u.w = cvt_pk_bf16(s[2 * c + 1][2], s[2 * c + 1][3]);
#pragma unroll
        for (int dt = 0; dt < 8; ++dt) { const bf16_t* vr = Vt + ((size_t)b * 512 + h * 128 + 16 * dt + fr) * 256 + 32 * c + 4 * fq; union { u32x4 u; bf16x8 v; } vf;
            const u32x2 lo = *(const u32x2*)vr, hi = *(const u32x2*)(vr + 16); vf.u.x = lo.x; vf.u.y = lo.y; vf.u.z = hi.x; vf.u.w = hi.y;
            o[dt] = mfma16(vf.v, pf.v, o[dt]); } }
    const float il = 1.0f / l;
#pragma unroll
    for (int dt = 0; dt < 8; ++dt) st_bf4(Yx + (size_t)t * 512 + h * 128 + 16 * dt + 4 * fq, o[dt] * il);
}

constexpr int XK_STRIDE = 272, XV_STRIDE = 528, XV_OFF = 256 * XK_STRIDE;
__device__ __forceinline__ void xa_pair(LAS unsigned char* lds, const bf16_t* Ux, const bf16_t* Kb, const bf16_t* Vt, bf16_t* Yx, int pair, int tid) {
    const int bh = pair >> 4, b = bh >> 2, h = bh & 3, blk0 = (pair & 15) * 2; const int lane = tid & 63, wave = tid >> 6, fr = lane & 15, fq = lane >> 4;
#pragma unroll
    for (int e = 0; e < 8; ++e) { const int ch = tid + 512 * e; const int key = ch >> 4, part = ch & 15;
        *(LAS u32x4*)(lds + key * XK_STRIDE + part * 16) = *(const u32x4*)(Kb + (size_t)(b * 256 + key) * 512 + h * 128 + part * 8);
        const int dr = ch >> 5, pv = ch & 31;
        *(LAS u32x4*)(lds + XV_OFF + dr * XV_STRIDE + pv * 16) = *(const u32x4*)(Vt + ((size_t)b * 512 + h * 128 + dr) * 256 + pv * 8); }
    __syncthreads();
#pragma unroll 1
    for (int tq = 0; tq < 2; ++tq) {
        const int t = b * SEQ + (blk0 + tq) * 128 + 16 * wave + fr;
        bf16x8 qf[4];
#pragma unroll
        for (int ks = 0; ks < 4; ++ks) qf[ks] = *(const bf16x8*)(Ux + (size_t)t * 512 + h * 128 + ks * 32 + fq * 8);
        f32x4 s[16];
#pragma unroll
        for (int nt = 0; nt < 16; ++nt) { s[nt] = (f32x4){0.f, 0.f, 0.f, 0.f}; LAS const unsigned char* kr = lds + (16 * nt + fr) * XK_STRIDE + fq * 16;
#pragma unroll
            for (int ks = 0; ks < 4; ++ks) s[nt] = mfma16(*(LAS const bf16x8*)(kr + ks * 64), qf[ks], s[nt]);
            if (nt & 1) asm volatile("" ::: "memory"); }
        float mx = -1e30f;
#pragma unroll
        for (int nt = 0; nt < 16; ++nt)
#pragma unroll
            for (int j = 0; j < 4; ++j) mx = fmaxf(mx, s[nt][j]);
        mx = fmaxf(mx, __shfl_xor(mx, 16)); mx = fmaxf(mx, __shfl_xor(mx, 32));
        const float sc = 0.08838834764831845f * 1.4426950408889634f; float l = 0.f;
#pragma unroll
        for (int nt = 0; nt < 16; ++nt)
#pragma unroll
            for (int j = 0; j < 4; ++j) { const float pz = exp2f((s[nt][j] - mx) * sc); s[nt][j] = pz; l += pz; }
        l += __shfl_xor(l, 16); l += __shfl_xor(l, 32);
        f32x4 o[8];
#pragma unroll
        for (int dt = 0; dt < 8; ++dt) o[dt] = (f32x4){0.f, 0.f, 0.f, 0.f};
#pragma unroll
        for (int c = 0; c < 8; ++c) { union { u32x4 u; bf16x8 v; } pf;
            pf.u.x = cvt_pk_bf16(s[2 * c][0], s[2 * c][1]); pf.u.y = cvt_pk_bf16(s[2 * c][2], s[2 * c][3]); pf.u.z = cvt_pk_bf16(s[2 * c + 1][0], s[2 * c + 1][1]); pf.u.w = cvt_pk_bf16(s[2 * c + 1][2], s[2 * c + 1][3]);
#pragma unroll
            for (int dt = 0; dt < 8; ++dt) { LAS const unsigned char* vr = lds + XV_OFF + (16 * dt + fr) * XV_STRIDE + (32 * c + 4 * fq) * 2; union { u32x4 u; bf16x8 v; } vf;
                const u32x2 lo = *(LAS const u32x2*)vr, hi = *(LAS const u32x2*)(vr + 32); vf.u.x = lo.x; vf.u.y = lo.y; vf.u.z = hi.x; vf.u.w = hi.y;
                o[dt] = mfma16(vf.v, pf.v, o[dt]); }
            asm volatile("" ::: "memory"); }
        const float il = 1.0f / l;
#pragma unroll
        for (int dt = 0; dt < 8; ++dt) st_bf4(Yx + (size_t)t * 512 + h * 128 + 16 * dt + 4 * fq, o[dt] * il);
    }
    __syncthreads();
}

struct Params { const float* in[33]; float* out; unsigned char* ws; };

__device__ __forceinline__ int opaque0() { int z = 0; asm volatile("" : "+s"(z)); return z; }
typedef __attribute__((address_space(1))) unsigned char* gptr_t;
typedef __attribute__((address_space(1))) const float* gcf_t;
__device__ __forceinline__ int opqv(int v) { asm volatile("" : "+v"(v)); return v; }
__device__ __forceinline__ int opqs(int v) { asm volatile("" : "+s"(v)); return v; }
#define PH_BEGIN const int zi = opaque0(); unsigned char* ws = P.ws + zi; float* const OUT = P.out + zi; (void)OUT; const int tid = opqv((int)threadIdx.x); const int bid = opqs((int)blockIdx.x); const int G = opqs((int)gridDim.x); (void)tid; (void)bid; (void)G; unsigned char* WB = ws + WS_WB; float* SS = (float*)(ws + WS_SS); (void)WB; (void)SS; (void)zi;
#define INP(k) (P.in[(k)] + zi)
#define XB_ ((bf16_t*)(ws + WS_XB))
#define U_ (ws + WS_U)
#define SC_ (ws + WS_SC)
#define Y_ ((bf16_t*)(ws + WS_Y))
#define KB_ ((bf16_t*)(ws + WS_KB))
#define VT_ ((bf16_t*)(ws + WS_VT))

constexpr size_t WS_BAR = WS_MISC + 8192;
__device__ __forceinline__ void grid_bar(unsigned* ctr, unsigned target) {
    asm volatile("s_waitcnt vmcnt(0)" ::: "memory");
    __syncthreads();
    if (threadIdx.x == 0) {
        __builtin_amdgcn_fence(__ATOMIC_RELEASE, "agent");
        asm volatile("s_waitcnt vmcnt(0)" ::: "memory");
        __hip_atomic_fetch_add(ctr, 1u, __ATOMIC_RELAXED, __HIP_MEMORY_SCOPE_AGENT);
        while (__hip_atomic_load(ctr, __ATOMIC_RELAXED, __HIP_MEMORY_SCOPE_AGENT) < target) __builtin_amdgcn_s_sleep(2);
        __builtin_amdgcn_fence(__ATOMIC_ACQUIRE, "agent");
        asm volatile("s_waitcnt vmcnt(0)" ::: "memory");
    }
    __syncthreads();
}

#define XB_TMO      128
#define XB_XCNT(j)  (256  + 64 * (j))
#define XB_XSUB(j)  (1280 + 64 * (j))
#define XB_XGEN(j)  (2304 + 64 * (j))
#define XB_TOP      3328
#define XB_TOPGEN   3392
#define XCD_BAR_WORDS 3456
#define XB_SPIN_CAP (1u << 18)
constexpr size_t WS_XBAR2 = WS_MISC + 32768;
constexpr size_t WS_XBAR = WS_MISC + 16384;
__device__ __forceinline__ unsigned xb_ld(unsigned* p)              { return __hip_atomic_load(p, __ATOMIC_RELAXED, __HIP_MEMORY_SCOPE_AGENT); }
__device__ __forceinline__ unsigned xb_add(unsigned* p, unsigned v) { return __hip_atomic_fetch_add(p, v, __ATOMIC_RELAXED, __HIP_MEMORY_SCOPE_AGENT); }
__device__ __forceinline__ unsigned xb_xcc_id() { return (unsigned)__builtin_amdgcn_s_getreg((3 << 11) | 20) & 0xFu; }
#define XB_SPIN(cond, bar) do { unsigned _sp = 0; while (cond) { __builtin_amdgcn_s_sleep(1); \
    if ((++_sp & 255u) == 0u) { if (xb_ld(&(bar)[XB_TMO])) break; if (_sp > XB_SPIN_CAP) { atomicAdd(&(bar)[XB_TMO], 1u); break; } } } } while (0)
__device__ __forceinline__ void xcd_barrier_complete(unsigned* bar, unsigned x, unsigned& nloc, unsigned& nx, const unsigned G) {
    unsigned sum, cnt, mine, sp = 0u;
    for (;;) {
        sum = 0u; cnt = 0u; mine = 0u;
#pragma unroll
        for (unsigned j = 0; j < 16; ++j) { const unsigned c = xb_ld(&bar[XB_XCNT(j)]); sum += c; cnt += (c > 0u) ? 1u : 0u; mine = (j == x) ? c : mine; }
        if (sum == G) break;
        __builtin_amdgcn_s_sleep(1);
        if ((++sp & 255u) == 0u) { if (xb_ld(&bar[XB_TMO])) break; if (sp > XB_SPIN_CAP) { atomicAdd(&bar[XB_TMO], 1u); break; } }
    }
    nloc = mine > 0u ? mine : 1u; nx = cnt > 0u ? cnt : 1u;
}
__device__ __forceinline__ void xcd_barrier(unsigned* bar, volatile LAS unsigned* st, const unsigned total) {
    asm volatile("s_waitcnt vmcnt(0)" ::: "memory");
    __syncthreads();
    if (threadIdx.x == 0) {
        const unsigned x = xb_xcc_id();
        __builtin_amdgcn_s_waitcnt(0);
        unsigned nloc = st[0], nx = st[1];
        if (nloc == 0u) { xcd_barrier_complete(bar, x, nloc, nx, total); st[0] = nloc; st[1] = nx; }
        const unsigned old = xb_add(&bar[XB_XSUB(x)], 1u);
        const unsigned gen = old / nloc;
        if (old + 1u == (gen + 1u) * nloc) {
            __builtin_amdgcn_fence(__ATOMIC_RELEASE, "agent");
            asm volatile("s_waitcnt vmcnt(0)" ::: "memory");
            const unsigned og = xb_add(&bar[XB_TOP], 1u);
            const unsigned tg = og / nx;
            if (og + 1u == (tg + 1u) * nx) xb_add(&bar[XB_TOPGEN], 1u);
            else XB_SPIN(xb_ld(&bar[XB_TOPGEN]) == tg, bar);
            __builtin_amdgcn_fence(__ATOMIC_ACQUIRE, "agent");
            xb_add(&bar[XB_XGEN(x)], 1u);
            asm volatile("s_waitcnt vmcnt(0)" ::: "memory");
        } else {
            XB_SPIN(xb_ld(&bar[XB_XGEN(x)]) == gen, bar);
            __builtin_amdgcn_fence(__ATOMIC_ACQUIRE, "agent");
            asm volatile("s_waitcnt vmcnt(0)" ::: "memory");
        }
    }
    __syncthreads();
}

__global__ void __launch_bounds__(512) mega(Params P) {
    extern __shared__ __attribute__((aligned(16))) unsigned char lds_raw[];
    LAS unsigned char* lds = (LAS unsigned char*)lds_raw;
    cg::grid_group grid = cg::this_grid();
    volatile LAS unsigned* xst = (volatile LAS unsigned*)(lds + LDS_BYTES - 16);
    if (threadIdx.x == 0) { xst[0] = 0u; xst[1] = 0u; xst[2] = 0u; xst[3] = 0u; (void)xb_add(&((unsigned*)(P.ws + WS_XBAR))[XB_XCNT(xb_xcc_id())], 1u);
        if (blockIdx.x >= 128) (void)xb_add(&((unsigned*)(P.ws + WS_XBAR2))[XB_XCNT(xb_xcc_id())], 1u); }
    __syncthreads();

    unsigned nsub = 0;
    for (int ph = 0; ph < NL * 12 + 1; ++ph) {
        const int l = ph / 12, kph = ph - l * 12;
        if (ph == NL * 12) {
#if (PHMASK >> 12) & 1
    { PH_BEGIN
        const int lane = tid & 63, gw = bid * 8 + (tid >> 6), nw = G * 8;
        const float* fn = INP(32); const float* ssf = SS + (size_t)0 * T * 16; float* X = OUT;
        for (int r = gw; r < T; r += nw) { const float rs = row_rstd(ssf, r);
#pragma unroll
            for (int i = 0; i < 4; ++i) { const size_t o = (size_t)r * D + i * 256 + lane * 4; *(f32x4*)(X + o) = *(const f32x4*)(X + o) * rs * *(const f32x4*)(fn + i * 256 + lane * 4); } }
    }
#endif
            break;
        }
        switch (kph) {
        case 0: {
#if (PHMASK >> 0) & 1
        for (int rep = 0; rep < REP0; ++rep) {
        {
            { PH_BEGIN convT_w<1>(INP(3) + (size_t)l * D * 2 * FF, 2 * FF, 0, INP(2) + (size_t)l * D, (bf16_t*)(WB + WB_W1A), D, D, 2 * FF, bid * 8 + (tid >> 6), G * 8, tid & 63, 0); }
            { PH_BEGIN convT_w<0>(INP(4) + (size_t)l * FF * D, D, 0, nullptr, (bf16_t*)(WB + WB_W1B), FF, FF, D, bid * 8 + (tid >> 6), G * 8, tid & 63, 1408); }
            { PH_BEGIN convT_w<2>(INP(7) + (size_t)l * D * 6928, 6928, 0, INP(5) + (size_t)l * D, (bf16_t*)(WB + WB_WIN), D, D, 4096, bid * 8 + (tid >> 6), G * 8, tid & 63, 2112); }
            { PH_BEGIN convT_w<0>(INP(7) + (size_t)l * D * 6928, 6928, 3856, INP(5) + (size_t)l * D, (bf16_t*)(WB + WB_WG), D, D, 3072, bid * 8 + (tid >> 6), G * 8, tid & 63, 3136); }
            for (int j = 0; j < 3; ++j) { PH_BEGIN convT_w<0>(INP(27) + ((size_t)l * 3 + j) * 512 * D, D, 0, nullptr, (bf16_t*)(WB + WB_WBR) + (size_t)j * D * 512, 512, 512, D, bid * 8 + (tid >> 6), G * 8, tid & 63, 3904 + 128 * j); }
            { PH_BEGIN convT_w<0>(INP(28) + (size_t)l * D * D, D, 0, nullptr, (bf16_t*)(WB + WB_WO), D, D, D, bid * 8 + (tid >> 6), G * 8, tid & 63, 4288); }
            { PH_BEGIN convT_w<0>(INP(26) + (size_t)l * D * D, D, 0, INP(6) + (size_t)l * D, (bf16_t*)(WB + WB_WKV), D, D, D, bid * 8 + (tid >> 6), G * 8, tid & 63, 4544); }
            { PH_BEGIN convT_w<1>(INP(30) + (size_t)l * D * 2 * FF, 2 * FF, 0, INP(29) + (size_t)l * D, (bf16_t*)(WB + WB_W2A), D, D, 2 * FF, bid * 8 + (tid >> 6), G * 8, tid & 63, 4800); }
            { PH_BEGIN convT_w<0>(INP(31) + (size_t)l * FF * D, D, 0, nullptr, (bf16_t*)(WB + WB_W2B), FF, FF, D, bid * 8 + (tid >> 6), G * 8, tid & 63, 6208); }
            { PH_BEGIN convT_w<0>(INP(10) + (size_t)l * 64 * 512, 512, 0, nullptr, (bf16_t*)(WB + WB_LW2), 64, 64, 512, bid * 8 + (tid >> 6), G * 8, tid & 63, 6912); }
            { PH_BEGIN convT_w<0>(INP(12) + (size_t)l * 64 * 512, 512, 0, nullptr, (bf16_t*)(WB + WB_LA2), 64, 64, 512, bid * 8 + (tid >> 6), G * 8, tid & 63, 6920); }
            { PH_BEGIN convT_w<0>(INP(13) + (size_t)l * 128 * 512, 512, 0, nullptr, (bf16_t*)(WB + WB_LG2), 128, 128, 512, bid * 8 + (tid >> 6), G * 8, tid & 63, 6928); }
            if (l > 0) {
                { PH_BEGIN convT_w<0>(INP(20) + (size_t)(l - 1) * 512 * 32, 32, 0, nullptr, (bf16_t*)(WB + WB_LV1), 512, 512, 32, bid * 8 + (tid >> 6), G * 8, tid & 63, 6944); }
                { PH_BEGIN convT_w<0>(INP(21) + (size_t)(l - 1) * 32 * 512, 512, 0, nullptr, (bf16_t*)(WB + WB_LV2), 32, 32, 512, bid * 8 + (tid >> 6), G * 8, tid & 63, 6976); }
            }
            if (l == 0) { PH_BEGIN
                const int lane = tid & 63, gw = bid * 8 + (tid >> 6), nw = G * 8;
                float* rstd_mem = (float*)(ws + WS_MISC); bf16_t* MEMN = (bf16_t*)(ws + WS_MEMN);
                for (int r = gw; r < T + 1024; r += nw) {
                    const bool ism = r >= T; const float* src = ism ? INP(1) + (size_t)(r - T) * D : INP(0) + (size_t)r * D; bf16_t* dst = ism ? MEMN + (size_t)(r - T) * D : XB_ + (size_t)r * D; float q = 0.f;
#pragma unroll
                    for (int i = 0; i < 4; ++i) { const f32x4 v = *(const f32x4*)(src + i * 256 + lane * 4); st_bf4(dst + i * 256 + lane * 4, v); q += (v[0] * v[0] + v[1] * v[1]) + (v[2] * v[2] + v[3] * v[3]); }
                    q = wave_sum(q);
                    if (ism) { if (lane == 0) rstd_mem[r - T] = rsqrtf(q * (1.0f / 1024.0f) + 1e-6f); } else if (lane < 16) SS[(size_t)r * 16 + lane] = (lane == 0) ? q : 0.f;
                }
            }
        }
        }
#endif
        } break;
        case 1: {
#if (PHMASK >> 1) & 1
        for (int rep = 0; rep < REPG; ++rep) {
        { PH_BEGIN
            pg8::Gemm g{XB_, (const bf16_t*)(WB + WB_W1A), T, 2 * FF, D, D, D, 0, 0}; pg8::StaticOrder S; S.init(T, 2 * FF, G, bid, 1);
            EpiFFNa E{(bf16_t*)U_, SS + (size_t)0 * T * 16}; pg8::gemm_phase(lds, g, S, E, tid);
        }
        if ((int)blockIdx.x >= (int)gridDim.x - 16) { PH_BEGIN
            pg8::Gemm g2{(const bf16_t*)(ws + WS_MEMN), (const bf16_t*)(WB + WB_WKV), 1024, D, D, D, D, 0, 0}; pg8::StaticOrder S2; S2.init(1024, D, 16, bid - (G - 16), 1);
            EpiKV E2{KB_, VT_, (const float*)(ws + WS_MISC)}; pg8::gemm_phase(lds, g2, S2, E2, tid);
        }
        }
#endif
        } break;
        case 2: {
#if (PHMASK >> 2) & 1
        { PH_BEGIN
            pg8::Gemm g{(const bf16_t*)U_, (const bf16_t*)(WB + WB_W1B), T, D, FF, FF, FF, 0, 0}; pg8::StaticOrder S; S.init(T, D, G, bid, 1);
            EpiRes E{l == 0 ? INP(0) : OUT, OUT, XB_, SS + (size_t)1 * T * 16, 0.5f}; pg8::gemm_phase(lds, g, S, E, tid);
        }
#endif
        } break;
        case 3: {
#if (PHMASK >> 3) & 1
        for (int rep = 0; rep < REPG; ++rep) {
        { PH_BEGIN
            pg8::Gemm g{XB_, (const bf16_t*)(WB + WB_WIN), T, 4096, D, D, D, 0, 0}; pg8::StaticOrder S; S.init(T, 4096, G, bid, 1);
            EpiU E{(bf16_t*)U_, SS + (size_t)1 * T * 16}; pg8::gemm_phase(lds, g, S, E, tid);
        }
        }
#endif
        } break;
        case 4: {
#if (PHMASK >> 4) & 1
        { PH_BEGIN
            PrepArgs PA; PA.U = (const bf16_t*)(U_ + U_RWKV); PA.mu = INP(8) + (size_t)l * 1792; PA.w0 = INP(9) + (size_t)l * 512; PA.a0 = INP(11) + (size_t)l * 512;
            PA.kk_ = INP(14) + (size_t)l * 512; PA.ka = INP(15) + (size_t)l * 512; PA.rk = INP(16) + (size_t)l * 512; PA.v0 = INP(19) + (size_t)(l > 0 ? l - 1 : 0) * 512;
            PA.w2t = (const bf16_t*)(WB + WB_LW2); PA.a2t = (const bf16_t*)(WB + WB_LA2); PA.g2t = (const bf16_t*)(WB + WB_LG2); PA.v1t = (const bf16_t*)(WB + WB_LV1); PA.v2t = (const bf16_t*)(WB + WB_LV2);
            PA.vfirst = (float*)(ws + WS_VF); PA.Wd = (float*)(SC_ + SC_WD); PA.V = (float*)(SC_ + SC_V); PA.RKKB = (bf16_t*)(SC_ + SC_RKKB); PA.Go = (bf16_t*)(ws + WS_GO); PA.Bon = (float*)(ws + WS_BON); PA.layer = l;
            for (int tt = bid; tt < 256; tt += G) rwkv_prep_tile(lds, PA, tt, tid);
        }
        { PH_BEGIN
            for (int pair = bid; pair < 256; pair += G) xa_pair(lds, (const bf16_t*)(U_ + U_XA), KB_, VT_, Y_ + (size_t)2 * T * 512, pair, tid);
        }
        { PH_BEGIN
            GlaArgs GA; GA.Ug = (const bf16_t*)(U_ + U_GLA); GA.conv = INP(22) + (size_t)l * 4096; GA.aup = INP(23) + (size_t)l * 4096; GA.abias = INP(24) + (size_t)l * 256; GA.gnorm = INP(25) + (size_t)l * 512;
            GA.kvcT = (float*)(ws + WS_KVC); GA.dec = (float*)(ws + WS_DEC); GA.spT = (bf16_t*)(U_ + U_SPT); GA.Yg = Y_ + (size_t)T * 512;
            for (int tile = bid; tile < NA4 * 256; tile += G) gla_a_tile(lds, GA, tile, tid);
        }
#endif
        } break;
        case 5: {
#if (PHMASK >> 5) & 1
        if ((int)blockIdx.x < 128) { PH_BEGIN
            const int xcd = bid & 7, j = bid >> 3, p = xcd * 4 + (j >> 2), rg = j & 3;
            rwkv_scan_unit(lds, (const float*)(SC_ + SC_WD), (const float*)(SC_ + SC_V), (const bf16_t*)(SC_ + SC_RKKB), (float*)(U_ + U_YRAW), p, rg, tid);
        } else {
            { PH_BEGIN
            GlaArgs GA; GA.Ug = (const bf16_t*)(U_ + U_GLA); GA.conv = INP(22) + (size_t)l * 4096; GA.aup = INP(23) + (size_t)l * 4096; GA.abias = INP(24) + (size_t)l * 256; GA.gnorm = INP(25) + (size_t)l * 512;
            GA.kvcT = (float*)(ws + WS_KVC); GA.dec = (float*)(ws + WS_DEC); GA.spT = (bf16_t*)(U_ + U_SPT); GA.Yg = Y_ + (size_t)T * 512;
            for (int tile = NA4 * 256 + bid - 128; tile < 1024; tile += 128) gla_a_tile(lds, GA, tile, tid);
            }
            xcd_barrier((unsigned*)(P.ws + WS_XBAR2), xst + 2, 128u);
            { PH_BEGIN
            bf16_t* spT = (bf16_t*)(U_ + U_SPT); const float* DEC = (const float*)(ws + WS_DEC); const float* KVC = (const float*)(ws + WS_KVC);
            for (int i = (bid - 128) * 512 + tid; i < 16 * 128 * 64; i += 128 * 512) { const int bh = i >> 13, ed = i & 8191, d = i & 63; float st = 0.f;
                for (int n0 = 0; n0 < 64; n0 += 16) { float kv[16], dc[16];
#pragma unroll
                    for (int q = 0; q < 16; ++q) { kv[q] = KVC[((size_t)bh * 64 + n0 + q) * 8192 + ed]; dc[q] = DEC[((size_t)bh * 64 + n0 + q) * 64 + d]; }
#pragma unroll
                    for (int q = 0; q < 16; ++q) { spT[((size_t)bh * 64 + n0 + q) * 8192 + ed] = f2bf(st); st = st * dc[q] + kv[q]; } } }
            }
            xcd_barrier((unsigned*)(P.ws + WS_XBAR2), xst + 2, 128u);
            { PH_BEGIN
            GlaArgs GA; GA.Ug = (const bf16_t*)(U_ + U_GLA); GA.conv = INP(22) + (size_t)l * 4096; GA.aup = INP(23) + (size_t)l * 4096; GA.abias = INP(24) + (size_t)l * 256; GA.gnorm = INP(25) + (size_t)l * 512;
            GA.kvcT = (float*)(ws + WS_KVC); GA.dec = (float*)(ws + WS_DEC); GA.spT = (bf16_t*)(U_ + U_SPT); GA.Yg = Y_ + (size_t)T * 512;
            for (int tile = bid - 128; tile < 1024; tile += 128) gla_c_tile(lds, GA, tile, tid);
            }
        }
#endif
        } break;
        case 6: {
#if (PHMASK >> 6) & 1
        { PH_BEGIN
            const int lane = tid & 63, gw = bid * 8 + (tid >> 6), nw = G * 8;
            const float* lnw = INP(17) + (size_t)l * 512; const float* lnb = INP(18) + (size_t)l * 512; const float* Yraw = (const float*)(U_ + U_YRAW); const float* Vv = (const float*)(SC_ + SC_V);
            const float* BON = (const float*)(ws + WS_BON); const bf16_t* GO = (const bf16_t*)(ws + WS_GO); bf16_t* Y = Y_;
            const int kq = lane & 15, sub = lane >> 4;
#pragma unroll 4
            for (int it0 = gw * 4; it0 < 32 * SEQ; it0 += nw * 4) { const int it = it0 + sub; const int p = it >> 12, s = it & (SEQ - 1), b = p >> 3, h = p & 7, t = b * SEQ + s;
                const f32x4 y = *(const f32x4*)(Yraw + (size_t)it * 64 + kq * 4); const f32x4 vv = *(const f32x4*)(Vv + (size_t)it * 64 + kq * 4);
                const f32x4 gg = ld_bf4(GO + (size_t)t * 512 + h * 64 + kq * 4); const f32x4 lw = *(const f32x4*)(lnw + h * 64 + kq * 4), lb = *(const f32x4*)(lnb + h * 64 + kq * 4); const float bon = BON[(size_t)t * 8 + h];
                const float mean = row16_sum((y[0] + y[1]) + (y[2] + y[3])) * (1.0f / 64.0f); const f32x4 dl = y - mean;
                const float var = row16_sum((dl[0] * dl[0] + dl[1] * dl[1]) + (dl[2] * dl[2] + dl[3] * dl[3])) * (1.0f / 64.0f); const float rs = rsqrtf(var + 64e-5f);
                st_bf4(Y + (size_t)t * 512 + h * 64 + kq * 4, ((dl * rs) * lw + lb + vv * bon) * gg); }
        }
#endif
        } break;
        case 7: {
#if (PHMASK >> 7) & 1
        for (int rep = 0; rep < REPG; ++rep) {
        { PH_BEGIN
            pg8::Gemm g{XB_, (const bf16_t*)(WB + WB_WG), T, 3072, D, D, D, 0, 0}; pg8::StaticOrder S; S.init(T, 3072, G, bid, 1);
            EpiGate E{(bf16_t*)SC_, SS + (size_t)1 * T * 16}; pg8::gemm_phase(lds, g, S, E, tid);
        }
        }
#endif
        } break;
        case 8: {
#if (PHMASK >> 8) & 1
        for (int rep = 0; rep < REPG; ++rep) {
        { PH_BEGIN
            pg8::Gemm g{Y_, (const bf16_t*)(WB + WB_WBR), T, D, 512, 512, 512, (unsigned)T * 512u * 2u, (unsigned)D * 512u * 2u}; pg8::StaticOrder S; S.init(T, D, G, bid, 3);
            EpiMerge E{(const bf16_t*)SC_, (float*)(U_ + U_MG), (bf16_t*)(U_ + U_MGB)}; pg8::gemm_phase(lds, g, S, E, tid);
        }
        }
#endif
        } break;
        case 9: {
#if (PHMASK >> 9) & 1
        { PH_BEGIN
            pg8::Gemm g{(const bf16_t*)(U_ + U_MGB), (const bf16_t*)(WB + WB_WO), T, D, D, D, D, 0, 0}; pg8::StaticOrder S; S.init(T, D, G, bid, 1);
            EpiRes E{OUT, OUT, XB_, SS + (size_t)2 * T * 16, 1.0f}; pg8::gemm_phase(lds, g, S, E, tid);
        }
#endif
        } break;
        case 10: {
#if (PHMASK >> 10) & 1
        for (int rep = 0; rep < REPG; ++rep) {
        { PH_BEGIN
            pg8::Gemm g{XB_, (const bf16_t*)(WB + WB_W2A), T, 2 * FF, D, D, D, 0, 0}; pg8::StaticOrder S; S.init(T, 2 * FF, G, bid, 1);
            EpiFFNa E{(bf16_t*)U_, SS + (size_t)2 * T * 16}; pg8::gemm_phase(lds, g, S, E, tid);
        }
        }
#endif
        } break;
        case 11: {
#if (PHMASK >> 11) & 1
        { PH_BEGIN
            pg8::Gemm g{(const bf16_t*)U_, (const bf16_t*)(WB + WB_W2B), T, D, FF, FF, FF, 0, 0}; pg8::StaticOrder S; S.init(T, D, G, bid, 1);
            EpiRes E{OUT, OUT, XB_, SS + (size_t)0 * T * 16, 0.5f}; pg8::gemm_phase(lds, g, S, E, tid);
        }
#endif
        } break;
        default: break;
        }
        if (ph == 0) grid.sync();
        else xcd_barrier((unsigned*)(P.ws + WS_XBAR), xst, gridDim.x);
    }
}

extern "C" void kernel_launch(void* const* d_in, const int* in_sizes, int n_in, void* d_out, int out_size, void* d_ws, size_t ws_size, hipStream_t stream) {
    static int grid_blocks = 0;
    if (!grid_blocks) {
        if (n_in != 33 || ws_size < WS_END) { fprintf(stderr, "kernel_launch: need 33 inputs and %zu bytes of workspace (got %d, %zu)\n", (size_t)WS_END, n_in, ws_size); grid_blocks = -1; return; }
        int dev = 0, cus = 0, per_cu = 0;
        hipGetDevice(&dev); hipDeviceGetAttribute(&cus, hipDeviceAttributeMultiprocessorCount, dev);
        if (hipFuncSetAttribute((const void*)mega, hipFuncAttributeMaxDynamicSharedMemorySize, LDS_BYTES) != hipSuccess) { fprintf(stderr, "kernel_launch: hipFuncSetAttribute failed\n"); grid_blocks = -1; return; }
        if (hipOccupancyMaxActiveBlocksPerMultiprocessor(&per_cu, (const void*)mega, 512, LDS_BYTES) != hipSuccess || per_cu < 1) { fprintf(stderr, "kernel_launch: occupancy query says %d\n", per_cu); per_cu = 1; }
        (void)hipGetLastError();
        grid_blocks = cus * per_cu;
        if (grid_blocks != 256) { fprintf(stderr, "kernel_launch: this kernel splits a 256-workgroup grid in its scan phase (got %d)\n", grid_blocks); grid_blocks = -1; return; }
    }
    if (grid_blocks < 0) return;
    if (hipMemsetAsync((char*)d_ws + WS_BAR, 0, (WS_XBAR2 - WS_BAR) + XCD_BAR_WORDS * 4, stream) != hipSuccess) { fprintf(stderr, "kernel_launch: memset failed\n"); return; }
    Params p{};
    for (int i = 0; i < 33; ++i) p.in[i] = (const float*)d_in[i];
    p.out = (float*)d_out; p.ws = (unsigned char*)d_ws;
    void* args[] = {&p};
    hipError_t e = hipLaunchCooperativeKernel((const void*)mega, dim3(grid_blocks), dim3(512), args, LDS_BYTES, stream);
    if (e != hipSuccess) fprintf(stderr, "cooperative launch failed: %s (grid %d)\n", hipGetErrorString(e), grid_blocks);
}
```

```cpp
#include <hip/hip_runtime.h>
#include <hip/hip_cooperative_groups.h>
#include <cstdio>
namespace cg = cooperative_groups;
#ifndef P4SUB
#define P4SUB 7
#endif
#ifndef REP5
#define REP5 1
#endif
#ifndef REP4
#define REP4 1
#endif
#ifndef REP6
#define REP6 1
#endif
#ifndef REP0
#define REP0 1
#endif
#ifndef REPG
#define REPG 1
#endif
#ifndef REPSYNC
#define REPSYNC 1
#endif
#ifndef NA4
#define NA4 2
#endif
#ifndef PHMASK
#define PHMASK 0xFFFF
#endif

#define LAS __attribute__((address_space(3)))
typedef unsigned short bf16_t;
typedef short bf16x8 __attribute__((ext_vector_type(8)));
typedef float f32x4 __attribute__((ext_vector_type(4)));
typedef float f32x2 __attribute__((ext_vector_type(2)));
typedef unsigned u32x4 __attribute__((ext_vector_type(4)));
typedef unsigned u32x2 __attribute__((ext_vector_type(2)));

constexpr int T = 16384, D = 1024, FF = 2816, SEQ = 4096, NL = 4;
constexpr int LDS_BYTES = 139264;

constexpr size_t MB = 1024 * 1024;
constexpr size_t WS_MISC = 0;
constexpr size_t WS_SS = 1 * MB;
constexpr size_t WS_WB = 4 * MB;
constexpr size_t WB_W1A = 0;
constexpr size_t WB_W1B = WB_W1A + (size_t)5632 * 1024 * 2;
constexpr size_t WB_WIN = WB_W1B + (size_t)1024 * 2816 * 2;
constexpr size_t WB_WG = WB_WIN + (size_t)4096 * 1024 * 2;
constexpr size_t WB_WBR = WB_WG + (size_t)3072 * 1024 * 2;
constexpr size_t WB_WO = WB_WBR + (size_t)3 * 1024 * 512 * 2;
constexpr size_t WB_WKV = WB_WO + (size_t)1024 * 1024 * 2;
constexpr size_t WB_W2A = WB_WKV + (size_t)1024 * 1024 * 2;
constexpr size_t WB_W2B = WB_W2A + (size_t)5632 * 1024 * 2;
constexpr size_t WB_LW2 = WB_W2B + (size_t)1024 * 2816 * 2;
constexpr size_t WB_LA2 = WB_LW2 + 512 * 64 * 2;
constexpr size_t WB_LG2 = WB_LA2 + 512 * 64 * 2;
constexpr size_t WB_LV1 = WB_LG2 + 512 * 128 * 2;
constexpr size_t WB_LV2 = WB_LV1 + 32 * 512 * 2;
constexpr size_t WB_END = WB_LV2 + 512 * 32 * 2;
static_assert(WB_END <= 55 * MB, "weights region");
constexpr size_t WS_XB = WS_WB + 55 * MB;
constexpr size_t WS_VF = WS_XB + 32 * MB;
constexpr size_t WS_MEMN = WS_VF + 32 * MB;
constexpr size_t WS_KB = WS_MEMN + 2 * MB;
constexpr size_t WS_VT = WS_KB + 1 * MB;
constexpr size_t WS_GO = WS_VT + 1 * MB;
constexpr size_t WS_BON = WS_GO + 16 * MB;
constexpr size_t WS_Y = WS_BON + 1 * MB;
constexpr size_t WS_KVC = WS_Y + 48 * MB;
constexpr size_t WS_DEC = WS_KVC + 32 * MB;
constexpr size_t WS_SC = WS_DEC + 1 * MB;
constexpr size_t SC_WD = 0;
constexpr size_t SC_V = 32 * MB;
constexpr size_t SC_RKKB = 64 * MB;
constexpr size_t WS_U = WS_SC + 128 * MB;
constexpr size_t U_RWKV = 0;
constexpr size_t U_GLA = (size_t)T * 1792 * 2;
constexpr size_t U_XA = 2 * (size_t)T * 1792 * 2;
constexpr size_t U_YRAW = 0;
constexpr size_t U_SPT = 32 * MB;
constexpr size_t U_MG = 0;
constexpr size_t U_MGB = 64 * MB;
constexpr size_t WS_END = WS_U + 128 * MB;
static_assert(U_XA + (size_t)T * 512 * 2 <= 128 * MB, "U region");

typedef __bf16 bf16x2_t __attribute__((ext_vector_type(2)));
__device__ __forceinline__ unsigned cvt_pk_bf16(float lo, float hi) { const f32x2 v = {lo, hi}; const bf16x2_t r = __builtin_convertvector(v, bf16x2_t); return __builtin_bit_cast(unsigned, r); }
__device__ __forceinline__ bf16_t f2bf(float x) { return (bf16_t)(cvt_pk_bf16(x, 0.f) & 0xffffu); }
__device__ __forceinline__ float bf2f(bf16_t b) { return __uint_as_float(((unsigned)b) << 16); }
__device__ __forceinline__ float bflo(unsigned w) { return __uint_as_float(w << 16); }
__device__ __forceinline__ float bfhi(unsigned w) { return __uint_as_float(w & 0xffff0000u); }
__device__ __forceinline__ f32x4 ld_bf4(const bf16_t* p) { const u32x2 w = *(const u32x2*)p; return (f32x4){bflo(w.x), bfhi(w.x), bflo(w.y), bfhi(w.y)}; }
__device__ __forceinline__ void st_bf4(bf16_t* p, f32x4 v) { u32x2 w; w.x = cvt_pk_bf16(v[0], v[1]); w.y = cvt_pk_bf16(v[2], v[3]); *(u32x2*)p = w; }
__device__ __forceinline__ float sigmoidf_(float x) { return 1.0f / (1.0f + __expf(-x)); }
__device__ __forceinline__ float wave_sum(float v) { for (int o = 32; o >= 1; o >>= 1) v += __shfl_xor(v, o); return v; }
__device__ __forceinline__ f32x4 mfma16(bf16x8 a, bf16x8 b, f32x4 c) { return __builtin_amdgcn_mfma_f32_16x16x32_bf16(a, b, c, 0, 0, 0); }

__device__ __forceinline__ float row_rstd(const float* ssp, int row) {
    const f32x4* p = (const f32x4*)(ssp + (size_t)row * 16); const f32x4 a = p[0], b = p[1], c = p[2], d = p[3];
    const float t = (((a[0] + a[1]) + (a[2] + a[3])) + ((b[0] + b[1]) + (b[2] + b[3]))) + (((c[0] + c[1]) + (c[2] + c[3])) + ((d[0] + d[1]) + (d[2] + d[3])));
    return rsqrtf(t * (1.0f / 1024.0f) + 1e-6f);
}
__device__ __forceinline__ void rstd8(float (&rs)[2][4], const float* ssp, int row0, int fq) {
    f32x4 p[2][4];
#pragma unroll
    for (int ai = 0; ai < 2; ++ai)
#pragma unroll
        for (int m = 0; m < 4; ++m) p[ai][m] = *(const f32x4*)(ssp + (size_t)(row0 + ai * 128 + m * 16) * 16 + fq * 4);
#pragma unroll
    for (int ai = 0; ai < 2; ++ai)
#pragma unroll
        for (int m = 0; m < 4; ++m) { float t = (p[ai][m][0] + p[ai][m][1]) + (p[ai][m][2] + p[ai][m][3]); t += __shfl_xor(t, 16); t += __shfl_xor(t, 32); rs[ai][m] = rsqrtf(t * (1.0f / 1024.0f) + 1e-6f); }
}
namespace pg8 {
constexpr int BM = 256, BK = 64, HALF = 128, HTB = HALF * BK * 2, STAGE_BYTES = 8 * HTB, NXCD = 8, WGM = 8;
__device__ __forceinline__ int lds_byte(int r, int c) { const int st = (r >> 4) * 2 + (c >> 5), rr = r & 15, cc = c & 31, ob = rr * 64 + cc * 2; return st * 1024 + (ob ^ (((ob >> 9) & 1) << 5)); }
__device__ __forceinline__ void stage_rc(int b, int& R, int& C) { const int st = b / 1024, sb = b % 1024, swz = sb ^ (((sb >> 9) & 1) << 5); R = (st >> 1) * 16 + swz / 64; C = (st & 1) * 32 + (swz % 64) / 2; }
__device__ __forceinline__ int perm32(int rho) { const int n = rho >> 4, i = rho & 15; return 8 * (i >> 2) + 4 * n + (i & 3); }

struct Unit { int pm, pn, z; };
struct Gemm { const bf16_t* A; const bf16_t* Bt; int M, N, K, lda, ldb; unsigned zA, zB; };

struct StaticOrder {
    int nM, nN, nwg, G, c, nz;
    __device__ void init(int M, int N, int G_, int c_, int nz_) { nM = M / BM; nN = N / BM; nwg = nM * nN; G = G_; c = c_; nz = nz_; }
    __device__ bool next(int i, Unit& u) const {
        const int ti = i / nz; u.z = i - ti * nz;
        const long L = (long)ti * G + c; if (L >= nwg) return false;
        int wgid = (int)L; { const int q = nwg / NXCD, r = nwg % NXCD, xcd = wgid % NXCD, off = wgid / NXCD; wgid = (xcd < r ? xcd * (q + 1) : r * (q + 1) + (xcd - r) * q) + off; }
        const int nig = WGM * nN, gid = wgid / nig, fm = gid * WGM, gsz = (nM - fm) < WGM ? (nM - fm) : WGM;
        u.pm = fm + ((wgid % nig) % gsz); u.pn = (wgid % nig) / gsz; return true;
    }
};

template <class Epi>
__device__ __forceinline__ void gemm_phase(LAS unsigned char* lds, const Gemm g, const StaticOrder& S, const Epi& E, const int tid) {
    const int wid = __builtin_amdgcn_readfirstlane(tid >> 6), lane = tid & 63, wr = wid >> 2, wc = wid & 3, fr = lane & 15, fq = lane >> 4;
    const int K = g.K, nt = K / BK;
    unsigned voffA[2], voffB[2];
#pragma unroll
    for (int i = 0; i < 2; ++i) { int R, C; stage_rc(tid * 16 + i * 8192, R, C); const int Rb = Epi::PERM ? ((R & ~31) + perm32(R & 31)) : R;
        voffA[i] = (unsigned)(R * g.lda + C) * 2u; voffB[i] = (unsigned)(Rb * g.ldb + C) * 2u; }
    const unsigned kstep = (unsigned)(BK * 2);
    const unsigned hstepA = (unsigned)HALF * g.lda * 2u, hstepB = (unsigned)HALF * g.ldb * 2u;
    const unsigned tstepA = 2u * hstepA, tstepB = 2u * hstepB;
    const unsigned ldsw = (unsigned)wid * 1024u;
    const int aoff = lds_byte(wr * 64 + fr, fq * 8), boff = lds_byte(wc * 32 + fr, fq * 8);
    const char* const gA = (const char*)g.A; const char* const gB = (const char*)g.Bt;
#define PG8_SA(b, h) (((b) * 2 + (h)) * HTB)
#define PG8_SB(b, h) ((4 + (b) * 2 + (h)) * HTB)
#define PG8_STAGE(bufoff, gbase, soff, voff) do { _Pragma("unroll") for (int _i = 0; _i < 2; ++_i) \
        __builtin_amdgcn_global_load_lds((const unsigned*)(((gbase) + (size_t)(unsigned)(soff)) + (voff)[_i]), (LAS unsigned*)(lds + (bufoff) + ldsw + _i * 8192), 16, 0, 0); } while (0)
#define PG8_LDA(dst, b, h) do { _Pragma("unroll") for (int m = 0; m < 4; ++m) _Pragma("unroll") for (int k = 0; k < 2; ++k) dst[m][k] = *(const LAS bf16x8*)(lds + PG8_SA(b, h) + aoff + m * 2048 + k * 1024); } while (0)
#define PG8_LDB(dst, b, h) do { _Pragma("unroll") for (int n = 0; n < 2; ++n) _Pragma("unroll") for (int k = 0; k < 2; ++k) dst[n][k] = *(const LAS bf16x8*)(lds + PG8_SB(b, h) + boff + n * 2048 + k * 1024); } while (0)
#define PG8_MMA(ai, bj, At, Bt) do { __builtin_amdgcn_s_setprio(1); _Pragma("unroll") for (int m = 0; m < 4; ++m) _Pragma("unroll") for (int n = 0; n < 2; ++n) _Pragma("unroll") for (int k = 0; k < 2; ++k) \
        acc[ai][bj][m][n] = __builtin_amdgcn_mfma_f32_16x16x32_bf16(Bt[n][k], At[m][k], acc[ai][bj][m][n], 0, 0, 0); __builtin_amdgcn_s_setprio(0); } while (0)
#define PG8_WAIT_V(n) asm volatile("s_waitcnt vmcnt(" #n ")" ::: "memory")
#define PG8_WAIT_L(n) asm volatile("s_waitcnt lgkmcnt(" #n ")" ::: "memory")
#define PG8_BAR __builtin_amdgcn_s_barrier()
#define PG8_SCHED __builtin_amdgcn_sched_barrier(0)
    Unit cur, nxt; int ui = 0;
    if (!S.next(0, cur)) return;
    f32x4 acc[2][2][4][2];
#pragma unroll
    for (int a = 0; a < 2; ++a)
#pragma unroll
        for (int b = 0; b < 2; ++b)
#pragma unroll
            for (int m = 0; m < 4; ++m)
#pragma unroll
                for (int n = 0; n < 2; ++n) acc[a][b][m][n] = (f32x4){0.f, 0.f, 0.f, 0.f};
    bf16x8 At[4][2], B0[2][2], B1[2][2];
    unsigned cA = (unsigned)cur.z * g.zA + (unsigned)cur.pm * tstepA, cB = (unsigned)cur.z * g.zB + (unsigned)cur.pn * tstepB;
    PG8_STAGE(PG8_SB(0, 0), gB, cB, voffB); PG8_STAGE(PG8_SA(0, 0), gA, cA, voffA); PG8_STAGE(PG8_SB(0, 1), gB, cB + hstepB, voffB); PG8_STAGE(PG8_SA(0, 1), gA, cA + hstepA, voffA);
    if (wr == 1) PG8_BAR;
    PG8_WAIT_V(4); PG8_BAR;
    PG8_STAGE(PG8_SB(1, 0), gB, cB + kstep, voffB); PG8_STAGE(PG8_SA(1, 0), gA, cA + kstep, voffA); PG8_STAGE(PG8_SB(1, 1), gB, cB + hstepB + kstep, voffB);
    PG8_WAIT_V(6); PG8_BAR;
    for (;;) {
        const bool has_next = S.next(ui + 1, nxt);
        const unsigned nA = has_next ? (unsigned)nxt.z * g.zA + (unsigned)nxt.pm * tstepA : cA, nB = has_next ? (unsigned)nxt.z * g.zB + (unsigned)nxt.pn * tstepB : cB;
        for (int t = 0; t < nt; t += 2) {
            const bool last = (t == nt - 2);
            const unsigned a1 = cA + (unsigned)(t + 1) * kstep;
            const unsigned a2 = last ? nA : cA + (unsigned)(t + 2) * kstep, b2 = last ? nB : cB + (unsigned)(t + 2) * kstep;
            const unsigned a3 = a2 + kstep, b3 = b2 + kstep;
            PG8_LDB(B0, 0, 0); PG8_SCHED; PG8_LDA(At, 0, 0); PG8_STAGE(PG8_SA(1, 1), gA, a1 + hstepA, voffA);
            PG8_WAIT_L(8); PG8_BAR; PG8_WAIT_L(0); PG8_MMA(0, 0, At, B0); PG8_BAR; PG8_SCHED;
            PG8_LDB(B1, 0, 1); PG8_STAGE(PG8_SB(0, 0), gB, b2, voffB);
            PG8_BAR; PG8_WAIT_L(0); PG8_MMA(0, 1, At, B1); PG8_BAR;
            PG8_LDA(At, 0, 1); PG8_STAGE(PG8_SA(0, 0), gA, a2, voffA);
            PG8_BAR; PG8_WAIT_L(0); PG8_MMA(1, 0, At, B0); PG8_BAR; PG8_SCHED;
            PG8_STAGE(PG8_SB(0, 1), gB, b2 + hstepB, voffB);
            PG8_WAIT_V(6); PG8_BAR; PG8_MMA(1, 1, At, B1); PG8_BAR;
            PG8_LDB(B0, 1, 0); PG8_SCHED; PG8_LDA(At, 1, 0); PG8_STAGE(PG8_SA(0, 1), gA, a2 + hstepA, voffA);
            PG8_WAIT_L(8); PG8_BAR; PG8_WAIT_L(0); PG8_MMA(0, 0, At, B0); PG8_BAR; PG8_SCHED;
            PG8_LDB(B1, 1, 1); PG8_STAGE(PG8_SB(1, 0), gB, b3, voffB);
            PG8_BAR; PG8_WAIT_L(0); PG8_MMA(0, 1, At, B1); PG8_BAR;
            PG8_LDA(At, 1, 1); PG8_STAGE(PG8_SA(1, 0), gA, a3, voffA);
            PG8_BAR; PG8_WAIT_L(0); PG8_MMA(1, 0, At, B0); PG8_BAR; PG8_SCHED;
            PG8_STAGE(PG8_SB(1, 1), gB, b3 + hstepB, voffB);
            PG8_WAIT_V(6); PG8_BAR; PG8_MMA(1, 1, At, B1); PG8_BAR;
        }
        E(acc, cur, wr, wc, fr, fq);
        if (!has_next) break;
#pragma unroll
        for (int a = 0; a < 2; ++a)
#pragma unroll
            for (int b = 0; b < 2; ++b)
#pragma unroll
                for (int m = 0; m < 4; ++m)
#pragma unroll
                    for (int n = 0; n < 2; ++n) acc[a][b][m][n] = (f32x4){0.f, 0.f, 0.f, 0.f};
        cur = nxt; cA = nA; cB = nB; ++ui;
    }
    PG8_WAIT_V(0);
    if (wr == 0) PG8_BAR;
    PG8_BAR;
#undef PG8_SA
#undef PG8_SB
#undef PG8_STAGE
#undef PG8_LDA
#undef PG8_LDB
#undef PG8_MMA
#undef PG8_WAIT_V
#undef PG8_WAIT_L
#undef PG8_BAR
#undef PG8_SCHED
}
}
using pg8::Unit;
typedef f32x4 Acc[2][2][4][2];

struct EpiFFNa { static constexpr bool PERM = false; bf16_t* H; const float* ss;
    __device__ __forceinline__ void operator()(const Acc& acc, const Unit& u, int wr, int wc, int fr, int fq) const {
        float rs8[2][4]; rstd8(rs8, ss, u.pm * 256 + wr * 64 + fr, fq);
        const int row0 = u.pm * 256 + wr * 64 + fr, hc0 = u.pn * 128 + wc * 16 + 4 * fq;
#pragma unroll
        for (int ai = 0; ai < 2; ++ai)
#pragma unroll
            for (int m = 0; m < 4; ++m) { const int row = row0 + ai * 128 + m * 16; const float rs = rs8[ai][m];
#pragma unroll
                for (int bj = 0; bj < 2; ++bj) { const f32x4 gt = acc[ai][bj][m][0] * rs, up = acc[ai][bj][m][1] * rs; f32x4 h;
#pragma unroll
                    for (int j = 0; j < 4; ++j) h[j] = gt[j] * sigmoidf_(gt[j]) * up[j];
                    st_bf4(H + (size_t)row * FF + hc0 + bj * 64, h); } }
    }
};
struct EpiRes { static constexpr bool PERM = false; const float* xin; float* xout; bf16_t* xb; float* ss_out; float scale;
    __device__ __forceinline__ void operator()(const Acc& acc, const Unit& u, int wr, int wc, int fr, int fq) const {
        const int row0 = u.pm * 256 + wr * 64 + fr, col0 = u.pn * 256 + wc * 32 + 4 * fq;
#pragma unroll
        for (int ai = 0; ai < 2; ++ai) {
            f32x4 xv[4][2][2];
#pragma unroll
            for (int m = 0; m < 4; ++m)
#pragma unroll
                for (int bj = 0; bj < 2; ++bj)
#pragma unroll
                    for (int n = 0; n < 2; ++n) xv[m][bj][n] = *(const f32x4*)(xin + (size_t)(row0 + ai * 128 + m * 16) * D + col0 + bj * 128 + n * 16);
#pragma unroll
            for (int m = 0; m < 4; ++m) { const int row = row0 + ai * 128 + m * 16; float q = 0.f;
#pragma unroll
                for (int bj = 0; bj < 2; ++bj)
#pragma unroll
                    for (int n = 0; n < 2; ++n) { const size_t o = (size_t)row * D + col0 + bj * 128 + n * 16; const f32x4 v = xv[m][bj][n] + acc[ai][bj][m][n] * scale;
                        *(f32x4*)(xout + o) = v; st_bf4(xb + o, v); q += (v[0] * v[0] + v[1] * v[1]) + (v[2] * v[2] + v[3] * v[3]); }
                q += __shfl_xor(q, 16); q += __shfl_xor(q, 32);
                if (fq == 0) ss_out[(size_t)row * 16 + u.pn * 4 + wc] = q; }
        }
    }
};
struct EpiU { static constexpr bool PERM = true; bf16_t* Ubase; const float* ss;
    __device__ __forceinline__ void operator()(const Acc& acc, const Unit& u, int wr, int wc, int fr, int fq) const {
        float rs8[2][4]; rstd8(rs8, ss, u.pm * 256 + wr * 64 + fr, fq);
        bf16_t* base; int ld, c0;
        if (u.pn < 7) { base = (bf16_t*)((char*)Ubase + U_RWKV); ld = 1792; c0 = u.pn * 256; }
        else if (u.pn < 14) { base = (bf16_t*)((char*)Ubase + U_GLA); ld = 1792; c0 = (u.pn - 7) * 256; }
        else { base = (bf16_t*)((char*)Ubase + U_XA); ld = 512; c0 = (u.pn - 14) * 256; }
        const int row0 = u.pm * 256 + wr * 64 + fr; c0 += wc * 32 + 8 * fq;
#pragma unroll
        for (int ai = 0; ai < 2; ++ai)
#pragma unroll
            for (int m = 0; m < 4; ++m) { const int row = row0 + ai * 128 + m * 16; const float rs = rs8[ai][m];
#pragma unroll
                for (int bj = 0; bj < 2; ++bj) { const f32x4 v0 = acc[ai][bj][m][0] * rs, v1 = acc[ai][bj][m][1] * rs; u32x4 w;
                    w.x = cvt_pk_bf16(v0[0], v0[1]); w.y = cvt_pk_bf16(v0[2], v0[3]); w.z = cvt_pk_bf16(v1[0], v1[1]); w.w = cvt_pk_bf16(v1[2], v1[3]);
                    *(u32x4*)(base + (size_t)row * ld + c0 + bj * 128) = w; } }
    }
};
struct EpiGate { static constexpr bool PERM = true; unsigned char* Gt; const float* ss;
    __device__ __forceinline__ void operator()(const Acc& acc, const Unit& u, int wr, int wc, int fr, int fq) const {
        float rs8[2][4]; rstd8(rs8, ss, u.pm * 256 + wr * 64 + fr, fq);
        const int row0 = u.pm * 256 + wr * 64 + fr, c0 = u.pn * 256 + wc * 32 + 8 * fq;
#pragma unroll
        for (int ai = 0; ai < 2; ++ai)
#pragma unroll
            for (int m = 0; m < 4; ++m) { const int row = row0 + ai * 128 + m * 16; const float rs = rs8[ai][m];
#pragma unroll
                for (int bj = 0; bj < 2; ++bj) { f32x4 v0 = acc[ai][bj][m][0] * rs, v1 = acc[ai][bj][m][1] * rs;
                    unsigned q0[4], q1[4];
#pragma unroll
                    for (int j = 0; j < 4; ++j) { q0[j] = (unsigned)(sigmoidf_(v0[j]) * 255.0f + 0.5f); q1[j] = (unsigned)(sigmoidf_(v1[j]) * 255.0f + 0.5f); }
                    u32x2 w; w.x = q0[0] | (q0[1] << 8) | (q0[2] << 16) | (q0[3] << 24); w.y = q1[0] | (q1[1] << 8) | (q1[2] << 16) | (q1[3] << 24);
                    *(u32x2*)(Gt + (size_t)row * 3072 + c0 + bj * 128) = w; } }
    }
};
struct EpiMerge { static constexpr bool PERM = false; const unsigned char* Gt; float* Mg; bf16_t* Mb;
    __device__ __forceinline__ void operator()(const Acc& acc, const Unit& u, int wr, int wc, int fr, int fq) const {
        const int row0 = u.pm * 256 + wr * 64 + fr, col0 = u.pn * 256 + wc * 32 + 4 * fq;
#pragma unroll
        for (int ai = 0; ai < 2; ++ai) {
            unsigned gw[4][2][2]; u32x2 mb[4][2][2];
#pragma unroll
            for (int m = 0; m < 4; ++m)
#pragma unroll
                for (int bj = 0; bj < 2; ++bj)
#pragma unroll
                    for (int n = 0; n < 2; ++n) { const int row = row0 + ai * 128 + m * 16, col = col0 + bj * 128 + n * 16;
                        gw[m][bj][n] = *(const unsigned*)(Gt + (size_t)row * 3072 + u.z * 1024 + col);
                        mb[m][bj][n] = (u32x2){0u, 0u}; if (u.z > 0) mb[m][bj][n] = *(const u32x2*)(Mb + (size_t)row * D + col); }
#pragma unroll
            for (int m = 0; m < 4; ++m)
#pragma unroll
                for (int bj = 0; bj < 2; ++bj)
#pragma unroll
                    for (int n = 0; n < 2; ++n) { const int row = row0 + ai * 128 + m * 16, col = col0 + bj * 128 + n * 16; const unsigned g = gw[m][bj][n]; const u32x2 w = mb[m][bj][n];
                        const f32x4 gt = (f32x4){(float)(g & 0xffu), (float)((g >> 8) & 0xffu), (float)((g >> 16) & 0xffu), (float)(g >> 24)} * (1.0f / 255.0f);
                        const f32x4 v = acc[ai][bj][m][n] * gt + (f32x4){bflo(w.x), bfhi(w.x), bflo(w.y), bfhi(w.y)};
                        st_bf4(Mb + (size_t)row * D + col, v); }
        }
    }
};
struct EpiKV { static constexpr bool PERM = false; bf16_t* Kb; bf16_t* Vt; const float* rstd;
    __device__ __forceinline__ void operator()(const Acc& acc, const Unit& u, int wr, int wc, int fr, int fq) const {
        const int row0 = u.pm * 256 + wr * 64 + fr, col0 = u.pn * 256 + wc * 32 + 4 * fq;
#pragma unroll
        for (int ai = 0; ai < 2; ++ai)
#pragma unroll
            for (int m = 0; m < 4; ++m) { const int row = row0 + ai * 128 + m * 16; const float rs = rstd[row];
#pragma unroll
                for (int bj = 0; bj < 2; ++bj)
#pragma unroll
                    for (int n = 0; n < 2; ++n) { const int col = col0 + bj * 128 + n * 16; const f32x4 v = acc[ai][bj][m][n] * rs;
                        if (col < 512) st_bf4(Kb + (size_t)row * 512 + col, v);
                        else {
#pragma unroll
                            for (int j = 0; j < 4; ++j) Vt[((size_t)(row >> 8) * 512 + (col - 512 + j)) * 256 + (row & 255)] = f2bf(v[j]); } } }
    }
};

template <int MAP> __device__ __forceinline__ int colmap(int n) {
    if (MAP == 1) { const int g = n >> 5, i = n & 31; return i < 16 ? 16 * g + i : FF + 16 * g + (i - 16); }
    if (MAP == 2) { if (n < 3344) return n; if (n < 3584) return -1; return n - 240; }
    return n;
}
template <int MAP>
__device__ __forceinline__ void convT(LAS unsigned char* lds, const float* src, int ld, int coff, const float* g, bf16_t* dst, int K, int Kd, int Nd, int G, int bid, int tid) {
    const int nkt = (K + 63) >> 6, nnt = (Nd + 63) >> 6, ntile = nkt * nnt;
    LAS bf16_t* tile = (LAS bf16_t*)lds;
    for (int t = bid; t < ntile; t += G) {
        const int kt = t % nkt, ntl = t / nkt, k0 = kt * 64, n0 = ntl * 64;
        { const int nl = tid & 63, kl0 = tid >> 6, n = n0 + nl; const int c = (n < Nd) ? colmap<MAP>(n) : -1;
#pragma unroll
          for (int i = 0; i < 8; ++i) { const int kl = kl0 + 8 * i, k = k0 + kl; float v = 0.f;
              if (c >= 0 && k < K) { v = src[(size_t)k * ld + coff + c]; if (g) v *= g[k]; }
              tile[nl * 72 + kl] = f2bf(v); } }
        __syncthreads();
        { const int nl = tid >> 3, kc = (tid & 7) * 8, n = n0 + nl, k = k0 + kc;
          if (n < Nd && k < Kd) *(u32x4*)(dst + (size_t)n * Kd + k) = *(LAS u32x4*)(tile + nl * 72 + kc); }
        __syncthreads();
    }
}

template <int MAP>
__device__ __forceinline__ void convT_w(const float* src, int ld, int coff, const float* g, bf16_t* dst, int K, int Kd, int Nd, int wslot, int nslots, int lane, int tile_base) {
    const int nkt = K >> 4, nnt = (Nd + 255) >> 8, ntile = nkt * nnt;
    for (int t = ((wslot - tile_base) % nslots + nslots) % nslots; t < ntile; t += nslots) {
        const int kt = t % nkt, ntl = t / nkt, k0 = kt * 16, n = ntl * 256 + lane * 4; const int c = (n < Nd) ? colmap<MAP>(n) : -1;
        const float* sp = src + (size_t)k0 * ld + coff + (c >= 0 ? c : 0);
        f32x4 v[16];
#pragma unroll
        for (int kk = 0; kk < 16; ++kk) { v[kk] = *(const f32x4*)(sp + (size_t)kk * ld); if (g) v[kk] *= g[k0 + kk]; if (c < 0) v[kk] = (f32x4){0.f, 0.f, 0.f, 0.f}; }
        if (n < Nd) {
#pragma unroll
            for (int j = 0; j < 4; ++j) { u32x4 lo, hi;
                lo.x = cvt_pk_bf16(v[0][j], v[1][j]); lo.y = cvt_pk_bf16(v[2][j], v[3][j]); lo.z = cvt_pk_bf16(v[4][j], v[5][j]); lo.w = cvt_pk_bf16(v[6][j], v[7][j]);
                hi.x = cvt_pk_bf16(v[8][j], v[9][j]); hi.y = cvt_pk_bf16(v[10][j], v[11][j]); hi.z = cvt_pk_bf16(v[12][j], v[13][j]); hi.w = cvt_pk_bf16(v[14][j], v[15][j]);
                bf16_t* dp = dst + (size_t)(n + j) * Kd + k0; *(u32x4*)dp = lo; *(u32x4*)(dp + 8) = hi; }
        }
    }
}

template <int K>
__device__ __forceinline__ void wave_gemm(f32x4 (&acc)[4][4], LAS const unsigned char* A, int sA, const bf16_t* Bt, int fr, int fq) {
#pragma unroll
    for (int m = 0; m < 4; ++m)
#pragma unroll
        for (int n = 0; n < 4; ++n) acc[m][n] = (f32x4){0.f, 0.f, 0.f, 0.f};
#pragma unroll
    for (int ks = 0; ks < K / 32; ++ks) { bf16x8 a[4], b[4];
#pragma unroll
        for (int m = 0; m < 4; ++m) a[m] = *(LAS const bf16x8*)(A + (16 * m + fr) * sA + (ks * 32 + fq * 8) * 2);
#pragma unroll
        for (int n = 0; n < 4; ++n) b[n] = *(const bf16x8*)(Bt + (size_t)(16 * n + fr) * K + ks * 32 + fq * 8);
#pragma unroll
        for (int m = 0; m < 4; ++m)
#pragma unroll
            for (int n = 0; n < 4; ++n) acc[m][n] = mfma16(b[n], a[m], acc[m][n]); }
}

template <int K>
__device__ __forceinline__ void row_gemm(f32x4 (&acc)[4], LAS const unsigned char* Arow, const bf16_t* Bt, int fr, int fq) {
#pragma unroll
    for (int n = 0; n < 4; ++n) acc[n] = (f32x4){0.f, 0.f, 0.f, 0.f};
#pragma unroll
    for (int ks = 0; ks < K / 32; ++ks) { const bf16x8 a = *(LAS const bf16x8*)(Arow + (ks * 32 + fq * 8) * 2);
#pragma unroll
        for (int n = 0; n < 4; ++n) { const bf16x8 b = *(const bf16x8*)(Bt + (size_t)(16 * n + fr) * K + ks * 32 + fq * 8); acc[n] = mfma16(b, a, acc[n]); } }
}

struct PrepArgs { const bf16_t* U; const float *mu, *w0, *a0, *kk_, *ka, *rk, *v0; const bf16_t *w2t, *a2t, *g2t, *v1t, *v2t; float* vfirst; float* Wd; float* V; bf16_t* RKKB; bf16_t* Go; float* Bon; int layer; };

__device__ __forceinline__ f32x4 shifted4(const bf16_t* Ut, bool has_prev, int c, const float* mu) {
    const f32x4 u = ld_bf4(Ut + c); f32x4 p = (f32x4){0.f, 0.f, 0.f, 0.f}; if (has_prev) p = ld_bf4(Ut - 1792 + c);
    const f32x4 m = *(const f32x4*)(mu + c); return u + m * (p - u);
}

__device__ __forceinline__ void rwkv_prep_tile(LAS unsigned char* lds, const PrepArgs& P, int tt, int tid) {
    constexpr int SW = 144, SG = 272, SV = 1040, SVV = 80;
    LAS unsigned char* LAw = lds; LAS unsigned char* LAa = lds + 9216; LAS unsigned char* LAg = lds + 18432; LAS unsigned char* LAv = lds + 35840; LAS unsigned char* LAvv = lds + 102400;
    const int t0 = tt * 64; const int s0 = t0 & (SEQ - 1);
    const int lane = tid & 63, wave = __builtin_amdgcn_readfirstlane(tid >> 6), fr = lane & 15, fq = lane >> 4;
#pragma unroll 2
    for (int e = 0; e < 4; ++e) { const int idx = tid + 512 * e, i = idx >> 5, c = (idx & 31) * 8; const bf16_t* Ut = P.U + (size_t)(t0 + i) * 1792; const bool hp = s0 + i > 0;
        f32x4 x0 = shifted4(Ut, hp, 1536 + c, P.mu), x1 = shifted4(Ut, hp, 1536 + c + 4, P.mu);
        if (c < 64) {
#pragma unroll
            for (int q = 0; q < 4; ++q) { const float ea = __expf(2.f * x0[q]), eb = __expf(2.f * x1[q]); x0[q] = 1.f - 2.f / (ea + 1.f); x1[q] = 1.f - 2.f / (eb + 1.f); } }
        else if (c >= 128) {
#pragma unroll
            for (int q = 0; q < 4; ++q) { x0[q] = sigmoidf_(x0[q]); x1[q] = sigmoidf_(x1[q]); } }
        u32x4 o; o.x = cvt_pk_bf16(x0[0], x0[1]); o.y = cvt_pk_bf16(x0[2], x0[3]); o.z = cvt_pk_bf16(x1[0], x1[1]); o.w = cvt_pk_bf16(x1[2], x1[3]);
        LAS unsigned char* dstp = (c < 64) ? (LAw + i * SW + c * 2) : (c < 128) ? (LAa + i * SW + (c - 64) * 2) : (LAg + i * SG + (c - 128) * 2);
        *(LAS u32x4*)dstp = o; }
    if (P.layer > 0) {
#pragma unroll 2
        for (int e = 0; e < 8; ++e) { const int idx = tid + 512 * e, i = idx >> 6, c = (idx & 63) * 8; const bf16_t* Ut = P.U + (size_t)(t0 + i) * 1792; const bool hp = s0 + i > 0;
            const f32x4 x0 = shifted4(Ut, hp, 1024 + c, P.mu), x1 = shifted4(Ut, hp, 1024 + c + 4, P.mu);
            u32x4 o; o.x = cvt_pk_bf16(x0[0], x0[1]); o.y = cvt_pk_bf16(x0[2], x0[3]); o.z = cvt_pk_bf16(x1[0], x1[1]); o.w = cvt_pk_bf16(x1[2], x1[3]);
            *(LAS u32x4*)(LAv + i * SV + c * 2) = o; }
    }
    __syncthreads();
    if (P.layer > 0) {
        const int mt = wave >> 1, nt = wave & 1; f32x4 acc = (f32x4){0.f, 0.f, 0.f, 0.f};
#pragma unroll 4
        for (int ks = 0; ks < 16; ++ks) { const bf16x8 a = *(LAS const bf16x8*)(LAv + (16 * mt + fr) * SV + (ks * 32 + fq * 8) * 2);
            const bf16x8 b = *(const bf16x8*)(P.v1t + (size_t)(16 * nt + fr) * 512 + ks * 32 + fq * 8); acc = mfma16(b, a, acc); }
        u32x2 w; w.x = cvt_pk_bf16(acc[0], acc[1]); w.y = cvt_pk_bf16(acc[2], acc[3]); *(LAS u32x2*)(LAvv + (16 * mt + fr) * SVV + (16 * nt + 4 * fq) * 2) = w;
    }
    __syncthreads();
    const int h = wave, cb = 64 * h; const int b_ = t0 >> 12, p = b_ * 8 + h;
#pragma unroll 1
    for (int m = 0; m < 4; ++m) {
        const int i = 16 * m + fr; const bf16_t* Ut = P.U + (size_t)(t0 + i) * 1792; const bool hp = (s0 + i) > 0;
        int fq4 = 4 * fq; asm volatile("" : "+v"(fq4));
        f32x4 aa[4], acc[4];
        row_gemm<64>(aa, LAa + i * SW, P.a2t + (size_t)cb * 64, fr, fq);
#pragma unroll
        for (int n = 0; n < 4; ++n) { const f32x4 a0v = *(const f32x4*)(P.a0 + cb + 16 * n + fq4);
#pragma unroll
            for (int j = 0; j < 4; ++j) aa[n][j] = sigmoidf_(aa[n][j] + a0v[j]); }
        row_gemm<64>(acc, LAw + i * SW, P.w2t + (size_t)cb * 64, fr, fq);
#pragma unroll
        for (int n = 0; n < 4; ++n) { const f32x4 w0v = *(const f32x4*)(P.w0 + cb + 16 * n + fq4); f32x4 d;
#pragma unroll
            for (int j = 0; j < 4; ++j) d[j] = __expf(-0.6065306597f * sigmoidf_(acc[n][j] + w0v[j]));
            *(f32x4*)(P.Wd + ((size_t)p * SEQ + s0 + i) * 64 + 16 * n + fq4) = d; }
        row_gemm<128>(acc, LAg + i * SG, P.g2t + (size_t)cb * 128, fr, fq);
#pragma unroll
        for (int n = 0; n < 4; ++n) st_bf4(P.Go + (size_t)(t0 + i) * 512 + cb + 16 * n + fq4, acc[n]);
        asm volatile("" ::: "memory");
        if (P.layer > 0) row_gemm<32>(acc, LAvv + i * SVV, P.v2t + (size_t)cb * 32, fr, fq);
        float bon = 0.f, nk = 0.f; f32x4 kv[4], rv[4];
#pragma unroll
        for (int n = 0; n < 4; ++n) { const int c = cb + 16 * n + fq4;
            f32x4 v = shifted4(Ut, hp, 1024 + c, P.mu);
            if (P.layer > 0) { const f32x4 vf = *(const f32x4*)(P.vfirst + (size_t)(t0 + i) * 512 + c); const f32x4 v0v = *(const f32x4*)(P.v0 + c);
#pragma unroll
                for (int j = 0; j < 4; ++j) v[j] = v[j] + (vf[j] - v[j]) * sigmoidf_(v0v[j] + acc[n][j]); }
            else *(f32x4*)(P.vfirst + (size_t)(t0 + i) * 512 + c) = v;
            *(f32x4*)(P.V + ((size_t)p * SEQ + s0 + i) * 64 + 16 * n + fq4) = v;
            kv[n] = shifted4(Ut, hp, 512 + c, P.mu); rv[n] = shifted4(Ut, hp, c, P.mu);
            const f32x4 kkw = *(const f32x4*)(P.kk_ + c);
#pragma unroll
            for (int j = 0; j < 4; ++j) { const float x = kv[n][j] * kkw[j]; nk += x * x; } }
        nk += __shfl_xor(nk, 16); nk += __shfl_xor(nk, 32);
        const float inv = 1.0f / fmaxf(sqrtf(nk), 1e-12f);
        bf16_t* O = P.RKKB + ((size_t)p * SEQ + s0 + i) * 256;
#pragma unroll
        for (int n = 0; n < 4; ++n) { const int c = cb + 16 * n + fq4; const f32x4 kkw = *(const f32x4*)(P.kk_ + c), kaw = *(const f32x4*)(P.ka + c), rkw = *(const f32x4*)(P.rk + c);
            f32x4 kk, kh, bb;
#pragma unroll
            for (int j = 0; j < 4; ++j) { const float a = aa[n][j]; kk[j] = kv[n][j] * kkw[j] * inv; kh[j] = kv[n][j] * (1.f + (a - 1.f) * kaw[j]); bb[j] = kk[j] * a; bon += rv[n][j] * kh[j] * rkw[j]; }
            const int cc = 16 * n + fq4; st_bf4(O + cc, rv[n]); st_bf4(O + 64 + cc, kh); st_bf4(O + 128 + cc, kk); st_bf4(O + 192 + cc, bb); }
        bon += __shfl_xor(bon, 16); bon += __shfl_xor(bon, 32);
        if (fq == 0) P.Bon[(size_t)(t0 + i) * 8 + h] = bon;
        asm volatile("" ::: "memory");
    }
    __syncthreads();
}

constexpr int SCAN_CH = 32, SCAN_STEP_B = 1344, SCAN_SLOT_B = SCAN_CH * SCAN_STEP_B;
template <int CTRL> __device__ __forceinline__ float dpp_f(float v) { return __int_as_float(__builtin_amdgcn_update_dpp(0, __float_as_int(v), CTRL, 0xf, 0xf, true)); }
__device__ __forceinline__ float row16_sum(float v) { v += dpp_f<0xB1>(v); v += dpp_f<0x4E>(v); v += dpp_f<0x141>(v); v += dpp_f<0x140>(v); return v; }

__device__ __forceinline__ float tr16_sum(const float (&p)[16], int kq) {
    const bool b3 = (kq & 8) != 0, b2 = (kq & 4) != 0, b1 = (kq & 2) != 0, b0 = (kq & 1) != 0;
    float q[8], r[4], u[2];
#pragma unroll
    for (int t = 0; t < 8; ++t) { const float keep = b3 ? p[t + 8] : p[t], send = b3 ? p[t] : p[t + 8]; q[t] = keep + dpp_f<0x140>(send); }
#pragma unroll
    for (int t = 0; t < 4; ++t) { const float keep = b2 ? q[t + 4] : q[t], send = b2 ? q[t] : q[t + 4]; r[t] = keep + dpp_f<0x141>(send); }
#pragma unroll
    for (int t = 0; t < 2; ++t) { const float keep = b1 ? r[t + 2] : r[t], send = b1 ? r[t] : r[t + 2]; u[t] = keep + dpp_f<0x4E>(send); }
    const float keep = b0 ? u[1] : u[0], send = b0 ? u[0] : u[1];
    return keep + dpp_f<0xB1>(send);
}

__device__ __forceinline__ void scan_load_chunk(LAS unsigned char* slot, const float* Wd, const float* V, const bf16_t* RKKB, int p, int rg, int s0, int lt) {
    u32x4 r[7];
    const size_t base = (size_t)p * SEQ + s0;
#pragma unroll
    for (int j = 0; j < 2; ++j) { const int idx = lt + 256 * j, st = idx >> 4, part = idx & 15; r[j] = *(const u32x4*)(Wd + (base + st) * 64 + part * 4); }
#pragma unroll
    for (int j = 2; j < 6; ++j) { const int k = lt + 256 * (j - 2), st = k >> 5, rem = k & 31, q = rem >> 3, part = rem & 7; r[j] = *(const u32x4*)(RKKB + ((base + st) * 4 + q) * 64 + part * 8); }
    if (lt < 128) { const int st = lt >> 2, hf = lt & 3; r[6] = *(const u32x4*)(V + (base + st) * 64 + rg * 16 + hf * 4); }
#pragma unroll
    for (int j = 0; j < 2; ++j) { const int idx = lt + 256 * j, st = idx >> 4, part = idx & 15; *(LAS u32x4*)(slot + st * SCAN_STEP_B + part * 16) = r[j]; }
#pragma unroll
    for (int j = 2; j < 6; ++j) { const int k = lt + 256 * (j - 2), st = k >> 5, rem = k & 31, q = rem >> 3, part = rem & 7; const u32x4 w = r[j];
        const int Q = (q == 0) ? 4 : (q == 1) ? 2 : (q == 2) ? 3 : 1;
        LAS f32x4* d = (LAS f32x4*)(slot + st * SCAN_STEP_B + Q * 256 + part * 32);
        d[0] = (f32x4){bflo(w.x), bfhi(w.x), bflo(w.y), bfhi(w.y)}; d[1] = (f32x4){bflo(w.z), bfhi(w.z), bflo(w.w), bfhi(w.w)}; }
    if (lt < 128) { const int st = lt >> 2, hf = lt & 3; *(LAS u32x4*)(slot + st * SCAN_STEP_B + 1280 + hf * 16) = r[6]; }
}

__device__ __forceinline__ void rwkv_scan_unit(LAS unsigned char* lds, const float* Wd, const float* V, const bf16_t* RKKB, float* Yraw, int p, int rg, int tid) {
    const int lane = tid & 63, wave = __builtin_amdgcn_readfirstlane(tid >> 6);
    constexpr int NCH = SEQ / SCAN_CH;
    scan_load_chunk(lds + (tid >> 8) * SCAN_SLOT_B, Wd, V, RKKB, p, rg, (tid >> 8) * SCAN_CH, tid & 255);
    __syncthreads();
    f32x4 S = (f32x4){0.f, 0.f, 0.f, 0.f};
    const int kq = lane & 15, rl = wave * 4 + (lane >> 4);
    for (int c = 0; c < NCH; ++c) {
        if (wave >= 4) { if (c + 2 < NCH) scan_load_chunk(lds + ((c + 2) % 3) * SCAN_SLOT_B, Wd, V, RKKB, p, rg, (c + 2) * SCAN_CH, tid - 256); }
        else {
            LAS const unsigned char* sl = lds + (c % 3) * SCAN_SLOT_B + kq * 16;
            LAS const unsigned char* vl = lds + (c % 3) * SCAN_SLOT_B + 1280 + rl * 4;
            float* yo = Yraw + ((size_t)p * SEQ + c * SCAN_CH + kq) * 64 + rg * 16 + rl;
            f32x4 w = *(LAS const f32x4*)(sl), b = *(LAS const f32x4*)(sl + 256), k = *(LAS const f32x4*)(sl + 512), kk = *(LAS const f32x4*)(sl + 768), r = *(LAS const f32x4*)(sl + 1024);
            float v = *(LAS const float*)(vl); float yp[16];
#pragma unroll
            for (int st = 0; st < SCAN_CH; ++st) {
                f32x4 wn = w, bn = b, kn = k, kkn = kk, rn = r; float vn = v;
                if (st + 1 < SCAN_CH) { const int o = (st + 1) * SCAN_STEP_B;
                    wn = *(LAS const f32x4*)(sl + o); bn = *(LAS const f32x4*)(sl + o + 256); kn = *(LAS const f32x4*)(sl + o + 512); kkn = *(LAS const f32x4*)(sl + o + 768); rn = *(LAS const f32x4*)(sl + o + 1024);
                    vn = *(LAS const float*)(vl + o); }
                float sa = (S[0] * kk[0] + S[1] * kk[1]) + (S[2] * kk[2] + S[3] * kk[3]);
                const f32x4 kvt = k * v;
                sa = -row16_sum(sa);
                S = S * w + (b * sa + kvt);
                yp[st & 15] = (S[0] * r[0] + S[1] * r[1]) + (S[2] * r[2] + S[3] * r[3]);
                if ((st & 15) == 15) yo[(size_t)(st - 15) * 64] = tr16_sum(yp, kq);
                w = wn; b = bn; k = kn; kk = kkn; r = rn; v = vn;
            }
        }
        __syncthreads();
    }
}

struct GlaArgs { const bf16_t* Ug; const float *conv, *aup, *abias, *gnorm; float* kvcT; float* dec; bf16_t* spT; bf16_t* Yg; };
constexpr int GL_GC = 0;
constexpr int GL_T0 = 16640;
constexpr int GL_VT = GL_T0 + 4 * 9216;
constexpr int GL_AL = GL_VT + 18432;
constexpr int GL_RS = GL_AL + 9216;

__device__ __forceinline__ void gla_conv8(f32x4 (&out)[8], const bf16_t* Ug, const float* conv, int t0, int s0, int i0, int c0) {
    f32x4 w[4];
#pragma unroll
    for (int j = 0; j < 4; ++j) w[j] = *(const f32x4*)(conv + j * 1024 + c0);
#pragma unroll
    for (int e = 0; e < 8; ++e) { const int i = i0 + 8 * e; f32x4 a = (f32x4){0.f, 0.f, 0.f, 0.f};
#pragma unroll
        for (int j = 0; j < 4; ++j) { const int ds = 3 - j; if (s0 + i - ds >= 0) a += w[j] * ld_bf4(Ug + (size_t)(t0 + i - ds) * 1792 + c0); }
#pragma unroll
        for (int q = 0; q < 4; ++q) a[q] = a[q] * sigmoidf_(a[q]);
        out[e] = a; }
}
__device__ __forceinline__ void gla_gcum(LAS unsigned char* lds, const GlaArgs& A, int t0, int h, int tid) {
    LAS float* GC = (LAS float*)(lds + GL_GC);
    { const int d = tid & 63, i0 = tid >> 6; float au[16]; const float ab = A.abias[h * 64 + d];
#pragma unroll
      for (int j = 0; j < 16; ++j) au[j] = A.aup[j * 256 + h * 64 + d];
#pragma unroll
      for (int e = 0; e < 8; ++e) { const int i = i0 + 8 * e; const u32x4* ap = (const u32x4*)(A.Ug + (size_t)(t0 + i) * 1792 + 1024); const u32x4 a0 = ap[0], a1 = ap[1];
          float x = ab;
          x += bflo(a0.x) * au[0] + bfhi(a0.x) * au[1] + bflo(a0.y) * au[2] + bfhi(a0.y) * au[3] + bflo(a0.z) * au[4] + bfhi(a0.z) * au[5] + bflo(a0.w) * au[6] + bfhi(a0.w) * au[7];
          x += bflo(a1.x) * au[8] + bfhi(a1.x) * au[9] + bflo(a1.y) * au[10] + bfhi(a1.y) * au[11] + bflo(a1.z) * au[12] + bfhi(a1.z) * au[13] + bflo(a1.w) * au[14] + bfhi(a1.w) * au[15];
          const float ls = fminf(x, 0.f) - __logf(1.f + __expf(-fabsf(x)));
          GC[i * 65 + d] = ls * (1.0f / 16.0f); } }
    __syncthreads();
    { const int lane = tid & 63, wave = tid >> 6;
#pragma unroll
      for (int dd = 0; dd < 8; ++dd) { const int d = wave * 8 + dd; float x = GC[lane * 65 + d];
#pragma unroll
          for (int o = 1; o < 64; o <<= 1) { const float y = __shfl_up(x, o); if (lane >= o) x += y; }
          GC[lane * 65 + d] = x; } }
    __syncthreads();
}
__device__ __forceinline__ void gla_a_tile(LAS unsigned char* lds, const GlaArgs& A, int tile, int tid) {
    const int bh = tile >> 6, n = tile & 63, b = bh >> 2, h = bh & 3, t0 = b * SEQ + n * 64, s0 = n * 64;
    LAS float* GC = (LAS float*)(lds + GL_GC); LAS bf16_t* KDT = (LAS bf16_t*)(lds + GL_T0); LAS bf16_t* VT = (LAS bf16_t*)(lds + GL_VT);
    gla_gcum(lds, A, t0, h, tid);
    { const int cc = (tid & 63) * 4, i0 = tid >> 6;
      if (cc >= 64) { f32x4 o[8]; const int c0 = (cc < 128) ? 256 + h * 64 + (cc - 64) : 512 + h * 128 + (cc - 128);
          gla_conv8(o, A.Ug, A.conv, t0, s0, i0, c0);
          if (cc < 128) { const int d = cc - 64;
#pragma unroll
              for (int e = 0; e < 8; ++e) { const int i = i0 + 8 * e;
#pragma unroll
                  for (int q = 0; q < 4; ++q) KDT[(d + q) * 72 + i] = f2bf(o[e][q] * __expf(GC[63 * 65 + d + q] - GC[i * 65 + d + q])); } }
          else { const int ev = cc - 128;
#pragma unroll
              for (int e = 0; e < 8; ++e) { const int i = i0 + 8 * e;
#pragma unroll
                  for (int q = 0; q < 4; ++q) VT[(ev + q) * 72 + i] = f2bf(o[e][q]); } } } }
    if (tid < 64) A.dec[((size_t)bh * 64 + n) * 64 + tid] = __expf(GC[63 * 65 + tid]);
    __syncthreads();
    { const int lane = tid & 63, wave = tid >> 6, fr = lane & 15, fq = lane >> 4; f32x4 acc[4];
#pragma unroll
      for (int nt = 0; nt < 4; ++nt) acc[nt] = (f32x4){0.f, 0.f, 0.f, 0.f};
#pragma unroll
      for (int ks = 0; ks < 2; ++ks) { const bf16x8 a = *(LAS const bf16x8*)(VT + (16 * wave + fr) * 72 + ks * 32 + fq * 8);
#pragma unroll
          for (int nt = 0; nt < 4; ++nt) { const bf16x8 bfr = *(LAS const bf16x8*)(KDT + (16 * nt + fr) * 72 + ks * 32 + fq * 8); acc[nt] = mfma16(bfr, a, acc[nt]); } }
#pragma unroll
      for (int nt = 0; nt < 4; ++nt) *(f32x4*)(A.kvcT + (((size_t)bh * 64 + n) * 128 + 16 * wave + fr) * 64 + 16 * nt + 4 * fq) = acc[nt]; }
    __syncthreads();
}
__device__ __forceinline__ void gla_c_tile(LAS unsigned char* lds, const GlaArgs& A, int tile, int tid) {
    const int bh = tile >> 6, n = tile & 63, b = bh >> 2, h = bh & 3, t0 = b * SEQ + n * 64, s0 = n * 64;
    LAS float* GC = (LAS float*)(lds + GL_GC); LAS bf16_t* QG = (LAS bf16_t*)(lds + GL_T0); LAS bf16_t* KG = QG + 64 * 72; LAS bf16_t* QR = KG + 64 * 72; LAS bf16_t* KR = QR + 64 * 72;
    LAS bf16_t* VT = (LAS bf16_t*)(lds + GL_VT); LAS bf16_t* AL = (LAS bf16_t*)(lds + GL_AL); LAS float* RS = (LAS float*)(lds + GL_RS);
    gla_gcum(lds, A, t0, h, tid);
    { const int cc = (tid & 63) * 4, i0 = tid >> 6; f32x4 o[8];
      const int c0 = (cc < 64) ? h * 64 + cc : (cc < 128) ? 256 + h * 64 + (cc - 64) : 512 + h * 128 + (cc - 128);
      gla_conv8(o, A.Ug, A.conv, t0, s0, i0, c0);
      if (cc < 128) { const int d = cc & 63; const bool isq = cc < 64; LAS bf16_t* T1 = isq ? QG : KR; LAS bf16_t* T2 = isq ? QR : KG; const float sc = isq ? 0.125f : 1.0f;
#pragma unroll
          for (int e = 0; e < 8; ++e) { const int i = i0 + 8 * e; f32x4 x1, x2;
#pragma unroll
              for (int q = 0; q < 4; ++q) { const float eg = __expf(GC[i * 65 + d + q]); const float x = o[e][q] * sc; x1[q] = x * eg; x2[q] = x / eg; }
              u32x2 w1, w2; w1.x = cvt_pk_bf16(x1[0], x1[1]); w1.y = cvt_pk_bf16(x1[2], x1[3]); w2.x = cvt_pk_bf16(x2[0], x2[1]); w2.y = cvt_pk_bf16(x2[2], x2[3]);
              *(LAS u32x2*)(T1 + i * 72 + d) = w1; *(LAS u32x2*)(T2 + i * 72 + d) = w2; } }
      else { const int ev = cc - 128;
#pragma unroll
          for (int e = 0; e < 8; ++e) { const int i = i0 + 8 * e;
#pragma unroll
              for (int q = 0; q < 4; ++q) VT[(ev + q) * 72 + i] = f2bf(o[e][q]); } } }
    __syncthreads();
    const int lane = tid & 63, wave = tid >> 6, fr = lane & 15, fq = lane >> 4; const int mt = wave >> 1;
    {
#pragma unroll
        for (int q = 0; q < 2; ++q) { const int nt = (wave & 1) * 2 + q; f32x4 ap = (f32x4){0.f, 0.f, 0.f, 0.f}, af = ap;
#pragma unroll
            for (int ks = 0; ks < 2; ++ks) { const int ko = ks * 32 + fq * 8;
                ap = mfma16(*(LAS const bf16x8*)(KG + (16 * nt + fr) * 72 + ko), *(LAS const bf16x8*)(QG + (16 * mt + fr) * 72 + ko), ap);
                af = mfma16(*(LAS const bf16x8*)(KR + (16 * nt + fr) * 72 + ko), *(LAS const bf16x8*)(QR + (16 * mt + fr) * 72 + ko), af); }
            const int trow = 16 * mt + fr; f32x4 o;
#pragma unroll
            for (int j = 0; j < 4; ++j) { const int scol = 16 * nt + 4 * fq + j; o[j] = (scol <= trow) ? ap[j] : af[j]; }
            u32x2 w; w.x = cvt_pk_bf16(o[0], o[1]); w.y = cvt_pk_bf16(o[2], o[3]); *(LAS u32x2*)(AL + trow * 72 + 16 * nt + 4 * fq) = w; }
    }
    __syncthreads();
    f32x4 acc[4];
#pragma unroll
    for (int q = 0; q < 4; ++q) acc[q] = (f32x4){0.f, 0.f, 0.f, 0.f};
    const bf16_t* sp = A.spT + ((size_t)bh * 64 + n) * 128 * 64;
#pragma unroll
    for (int ks = 0; ks < 2; ++ks) { const int ko = ks * 32 + fq * 8; const bf16x8 a1 = *(LAS const bf16x8*)(AL + (16 * mt + fr) * 72 + ko), a2 = *(LAS const bf16x8*)(QG + (16 * mt + fr) * 72 + ko);
#pragma unroll
        for (int q = 0; q < 4; ++q) { const int nt = (wave & 1) * 4 + q;
            acc[q] = mfma16(*(LAS const bf16x8*)(VT + (16 * nt + fr) * 72 + ko), a1, acc[q]);
            acc[q] = mfma16(*(const bf16x8*)(sp + (size_t)(16 * nt + fr) * 64 + ko), a2, acc[q]); } }
    float ssq = 0.f;
#pragma unroll
    for (int q = 0; q < 4; ++q) ssq += (acc[q][0] * acc[q][0] + acc[q][1] * acc[q][1]) + (acc[q][2] * acc[q][2] + acc[q][3] * acc[q][3]);
    ssq += __shfl_xor(ssq, 16); ssq += __shfl_xor(ssq, 32);
    if (fq == 0) RS[(16 * mt + fr) * 2 + (wave & 1)] = ssq;
    __syncthreads();
    { const int i = 16 * mt + fr; const float rs = rsqrtf((RS[i * 2] + RS[i * 2 + 1]) * (1.0f / 128.0f) + 1e-6f);
#pragma unroll
      for (int q = 0; q < 4; ++q) { const int ecol = h * 128 + ((wave & 1) * 4 + q) * 16 + 4 * fq; const f32x4 nw = *(const f32x4*)(A.gnorm + ecol); const f32x4 go = ld_bf4(A.Ug + (size_t)(t0 + i) * 1792 + 1040 + ecol); f32x4 o;
#pragma unroll
          for (int j = 0; j < 4; ++j) o[j] = acc[q][j] * rs * nw[j] * go[j] * sigmoidf_(go[j]);
          st_bf4(A.Yg + (size_t)(t0 + i) * 512 + ecol, o); } }
    __syncthreads();
}

__device__ __forceinline__ void xa_tile(const bf16_t* Ux, const bf16_t* Kb, const bf16_t* Vt, bf16_t* Yx, int tile, int tid) {
    const int blk = tile & 31, h = (tile >> 5) & 3, b = tile >> 7; const int lane = tid & 63, wave = tid >> 6, fr = lane & 15, fq = lane >> 4;
    const int t = b * SEQ + blk * 128 + 16 * wave + fr;
    bf16x8 qf[4];
#pragma unroll
    for (int ks = 0; ks < 4; ++ks) qf[ks] = *(const bf16x8*)(Ux + (size_t)t * 512 + h * 128 + ks * 32 + fq * 8);
    f32x4 s[16];
#pragma unroll
    for (int nt = 0; nt < 16; ++nt) { s[nt] = (f32x4){0.f, 0.f, 0.f, 0.f}; const bf16_t* kr = Kb + (size_t)(b * 256 + 16 * nt + fr) * 512 + h * 128 + fq * 8;
#pragma unroll
        for (int ks = 0; ks < 4; ++ks) s[nt] = mfma16(*(const bf16x8*)(kr + ks * 32), qf[ks], s[nt]); }
    float mx = -1e30f;
#pragma unroll
    for (int nt = 0; nt < 16; ++nt)
#pragma unroll
        for (int j = 0; j < 4; ++j) mx = fmaxf(mx, s[nt][j]);
    mx = fmaxf(mx, __shfl_xor(mx, 16)); mx = fmaxf(mx, __shfl_xor(mx, 32));
    const float sc = 0.08838834764831845f * 1.4426950408889634f; float l = 0.f;
#pragma unroll
    for (int nt = 0; nt < 16; ++nt)
#pragma unroll
        for (int j = 0; j < 4; ++j) { const float pz = exp2f((s[nt][j] - mx) * sc); s[nt][j] = pz; l += pz; }
    l += __shfl_xor(l, 16); l += __shfl_xor(l, 32);
    f32x4 o[8];
#pragma unroll
    for (int dt = 0; dt < 8; ++dt) o[dt] = (f32x4){0.f, 0.f, 0.f, 0.f};
#pragma unroll
    for (int c = 0; c < 8; ++c) { union { u32x4 u; bf16x8 v; } pf;
        pf.u.x = cvt_pk_bf16(s[2 * c][0], s[2 * c][1]); pf.u.y = cvt_pk_bf16(s[2 * c][2], s[2 * c][3]); pf.u.z = cvt_pk_bf16(s[2 * c + 1][0], s[2 * c + 1][1]); pf.u.w = cvt_pk_bf16(s[2 * c + 1][2], s[2 * c + 1][3]);
#pragma unroll
        for (int dt = 0; dt < 8; ++dt) { const bf16_t* vr = Vt + ((size_t)b * 512 + h * 128 + 16 * dt + fr) * 256 + 32 * c + 4 * fq; union { u32x4 u; bf16x8 v; } vf;
            const u32x2 lo = *(const u32x2*)vr, hi = *(const u32x2*)(vr + 16); vf.u.x = lo.x; vf.u.y = lo.y; vf.u.z = hi.x; vf.u.w = hi.y;
            o[dt] = mfma16(vf.v, pf.v, o[dt]); } }
    const float il = 1.0f / l;
#pragma unroll
    for (int dt = 0; dt < 8; ++dt) st_bf4(Yx + (size_t)t * 512 + h * 128 + 16 * dt + 4 * fq, o[dt] * il);
}

constexpr int XK_STRIDE = 272, XV_STRIDE = 528, XV_OFF = 256 * XK_STRIDE;
__device__ __forceinline__ void xa_pair(LAS unsigned char* lds, const bf16_t* Ux, const bf16_t* Kb, const bf16_t* Vt, bf16_t* Yx, int pair, int tid) {
    const int bh = pair >> 4, b = bh >> 2, h = bh & 3, blk0 = (pair & 15) * 2; const int lane = tid & 63, wave = tid >> 6, fr = lane & 15, fq = lane >> 4;
#pragma unroll
    for (int e = 0; e < 8; ++e) { const int ch = tid + 512 * e; const int key = ch >> 4, part = ch & 15;
        *(LAS u32x4*)(lds + key * XK_STRIDE + part * 16) = *(const u32x4*)(Kb + (size_t)(b * 256 + key) * 512 + h * 128 + part * 8);
        const int dr = ch >> 5, pv = ch & 31;
        *(LAS u32x4*)(lds + XV_OFF + dr * XV_STRIDE + pv * 16) = *(const u32x4*)(Vt + ((size_t)b * 512 + h * 128 + dr) * 256 + pv * 8); }
    __syncthreads();
#pragma unroll 1
    for (int tq = 0; tq < 2; ++tq) {
        const int t = b * SEQ + (blk0 + tq) * 128 + 16 * wave + fr;
        bf16x8 qf[4];
#pragma unroll
        for (int ks = 0; ks < 4; ++ks) qf[ks] = *(const bf16x8*)(Ux + (size_t)t * 512 + h * 128 + ks * 32 + fq * 8);
        f32x4 s[16];
#pragma unroll
        for (int nt = 0; nt < 16; ++nt) { s[nt] = (f32x4){0.f, 0.f, 0.f, 0.f}; LAS const unsigned char* kr = lds + (16 * nt + fr) * XK_STRIDE + fq * 16;
#pragma unroll
            for (int ks = 0; ks < 4; ++ks) s[nt] = mfma16(*(LAS const bf16x8*)(kr + ks * 64), qf[ks], s[nt]);
            if (nt & 1) asm volatile("" ::: "memory"); }
        float mx = -1e30f;
#pragma unroll
        for (int nt = 0; nt < 16; ++nt)
#pragma unroll
            for (int j = 0; j < 4; ++j) mx = fmaxf(mx, s[nt][j]);
        mx = fmaxf(mx, __shfl_xor(mx, 16)); mx = fmaxf(mx, __shfl_xor(mx, 32));
        const float sc = 0.08838834764831845f * 1.4426950408889634f; float l = 0.f;
#pragma unroll
        for (int nt = 0; nt < 16; ++nt)
#pragma unroll
            for (int j = 0; j < 4; ++j) { const float pz = exp2f((s[nt][j] - mx) * sc); s[nt][j] = pz; l += pz; }
        l += __shfl_xor(l, 16); l += __shfl_xor(l, 32);
        f32x4 o[8];
#pragma unroll
        for (int dt = 0; dt < 8; ++dt) o[dt] = (f32x4){0.f, 0.f, 0.f, 0.f};
#pragma unroll
        for (int c = 0; c < 8; ++c) { union { u32x4 u; bf16x8 v; } pf;
            pf.u.x = cvt_pk_bf16(s[2 * c][0], s[2 * c][1]); pf.u.y = cvt_pk_bf16(s[2 * c][2], s[2 * c][3]); pf.u.z = cvt_pk_bf16(s[2 * c + 1][0], s[2 * c + 1][1]); pf.u.w = cvt_pk_bf16(s[2 * c + 1][2], s[2 * c + 1][3]);
#pragma unroll
            for (int dt = 0; dt < 8; ++dt) { LAS const unsigned char* vr = lds + XV_OFF + (16 * dt + fr) * XV_STRIDE + (32 * c + 4 * fq) * 2; union { u32x4 u; bf16x8 v; } vf;
                const u32x2 lo = *(LAS const u32x2*)vr, hi = *(LAS const u32x2*)(vr + 32); vf.u.x = lo.x; vf.u.y = lo.y; vf.u.z = hi.x; vf.u.w = hi.y;
                o[dt] = mfma16(vf.v, pf.v, o[dt]); }
            asm volatile("" ::: "memory"); }
        const float il = 1.0f / l;
#pragma unroll
        for (int dt = 0; dt < 8; ++dt) st_bf4(Yx + (size_t)t * 512 + h * 128 + 16 * dt + 4 * fq, o[dt] * il);
    }
    __syncthreads();
}

struct Params { const float* in[33]; float* out; unsigned char* ws; };

__device__ __forceinline__ int opaque0() { int z = 0; asm volatile("" : "+s"(z)); return z; }
typedef __attribute__((address_space(1))) unsigned char* gptr_t;
typedef __attribute__((address_space(1))) const float* gcf_t;
__device__ __forceinline__ int opqv(int v) { asm volatile("" : "+v"(v)); return v; }
__device__ __forceinline__ int opqs(int v) { asm volatile("" : "+s"(v)); return v; }
#define PH_BEGIN const int zi = opaque0(); unsigned char* ws = P.ws + zi; float* const OUT = P.out + zi; (void)OUT; const int tid = opqv((int)threadIdx.x); const int bid = opqs((int)blockIdx.x); const int G = opqs((int)gridDim.x); (void)tid; (void)bid; (void)G; unsigned char* WB = ws + WS_WB; float* SS = (float*)(ws + WS_SS); (void)WB; (void)SS; (void)zi;
#define INP(k) (P.in[(k)] + zi)
#define XB_ ((bf16_t*)(ws + WS_XB))
#define U_ (ws + WS_U)
#define SC_ (ws + WS_SC)
#define Y_ ((bf16_t*)(ws + WS_Y))
#define KB_ ((bf16_t*)(ws + WS_KB))
#define VT_ ((bf16_t*)(ws + WS_VT))

constexpr size_t WS_BAR = WS_MISC + 8192;
__device__ __forceinline__ void grid_bar(unsigned* ctr, unsigned target) {
    asm volatile("s_waitcnt vmcnt(0)" ::: "memory");
    __syncthreads();
    if (threadIdx.x == 0) {
        __builtin_amdgcn_fence(__ATOMIC_RELEASE, "agent");
        asm volatile("s_waitcnt vmcnt(0)" ::: "memory");
        __hip_atomic_fetch_add(ctr, 1u, __ATOMIC_RELAXED, __HIP_MEMORY_SCOPE_AGENT);
        while (__hip_atomic_load(ctr, __ATOMIC_RELAXED, __HIP_MEMORY_SCOPE_AGENT) < target) __builtin_amdgcn_s_sleep(2);
        __builtin_amdgcn_fence(__ATOMIC_ACQUIRE, "agent");
        asm volatile("s_waitcnt vmcnt(0)" ::: "memory");
    }
    __syncthreads();
}

#define XB_TMO      128
#define XB_XCNT(j)  (256  + 64 * (j))
#define XB_XSUB(j)  (1280 + 64 * (j))
#define XB_XGEN(j)  (2304 + 64 * (j))
#define XB_TOP      3328
#define XB_TOPGEN   3392
#define XCD_BAR_WORDS 3456
#define XB_SPIN_CAP (1u << 18)
constexpr size_t WS_XBAR2 = WS_MISC + 32768;
constexpr size_t WS_XBAR = WS_MISC + 16384;
__device__ __forceinline__ unsigned xb_ld(unsigned* p)              { return __hip_atomic_load(p, __ATOMIC_RELAXED, __HIP_MEMORY_SCOPE_AGENT); }
__device__ __forceinline__ unsigned xb_add(unsigned* p, unsigned v) { return __hip_atomic_fetch_add(p, v, __ATOMIC_RELAXED, __HIP_MEMORY_SCOPE_AGENT); }
__device__ __forceinline__ unsigned xb_xcc_id() { return (unsigned)__builtin_amdgcn_s_getreg((3 << 11) | 20) & 0xFu; }
#define XB_SPIN(cond, bar) do { unsigned _sp = 0; while (cond) { __builtin_amdgcn_s_sleep(1); \
    if ((++_sp & 255u) == 0u) { if (xb_ld(&(bar)[XB_TMO])) break; if (_sp > XB_SPIN_CAP) { atomicAdd(&(bar)[XB_TMO], 1u); break; } } } } while (0)
__device__ __forceinline__ void xcd_barrier_complete(unsigned* bar, unsigned x, unsigned& nloc, unsigned& nx, const unsigned G) {
    unsigned sum, cnt, mine, sp = 0u;
    for (;;) {
        sum = 0u; cnt = 0u; mine = 0u;
#pragma unroll
        for (unsigned j = 0; j < 16; ++j) { const unsigned c = xb_ld(&bar[XB_XCNT(j)]); sum += c; cnt += (c > 0u) ? 1u : 0u; mine = (j == x) ? c : mine; }
        if (sum == G) break;
        __builtin_amdgcn_s_sleep(1);
        if ((++sp & 255u) == 0u) { if (xb_ld(&bar[XB_TMO])) break; if (sp > XB_SPIN_CAP) { atomicAdd(&bar[XB_TMO], 1u); break; } }
    }
    nloc = mine > 0u ? mine : 1u; nx = cnt > 0u ? cnt : 1u;
}
__device__ __forceinline__ void xcd_barrier(unsigned* bar, volatile LAS unsigned* st, const unsigned total) {
    asm volatile("s_waitcnt vmcnt(0)" ::: "memory");
    __syncthreads();
    if (threadIdx.x == 0) {
        const unsigned x = xb_xcc_id();
        __builtin_amdgcn_s_waitcnt(0);
        unsigned nloc = st[0], nx = st[1];
        if (nloc == 0u) { xcd_barrier_complete(bar, x, nloc, nx, total); st[0] = nloc; st[1] = nx; }
        const unsigned old = xb_add(&bar[XB_XSUB(x)], 1u);
        const unsigned gen = old / nloc;
        if (old + 1u == (gen + 1u) * nloc) {
            __builtin_amdgcn_fence(__ATOMIC_RELEASE, "agent");
            asm volatile("s_waitcnt vmcnt(0)" ::: "memory");
            const unsigned og = xb_add(&bar[XB_TOP], 1u);
            const unsigned tg = og / nx;
            if (og + 1u == (tg + 1u) * nx) xb_add(&bar[XB_TOPGEN], 1u);
            else XB_SPIN(xb_ld(&bar[XB_TOPGEN]) == tg, bar);
            __builtin_amdgcn_fence(__ATOMIC_ACQUIRE, "agent");
            xb_add(&bar[XB_XGEN(x)], 1u);
            asm volatile("s_waitcnt vmcnt(0)" ::: "memory");
        } else {
            XB_SPIN(xb_ld(&bar[XB_XGEN(x)]) == gen, bar);
            __builtin_amdgcn_fence(__ATOMIC_ACQUIRE, "agent");
            asm volatile("s_waitcnt vmcnt(0)" ::: "memory");
        }
    }
    __syncthreads();
}

__global__ void __launch_bounds__(512) mega(Params P) {
    extern __shared__ __attribute__((aligned(16))) unsigned char lds_raw[];
    LAS unsigned char* lds = (LAS unsigned char*)lds_raw;
    cg::grid_group grid = cg::this_grid();
    volatile LAS unsigned* xst = (volatile LAS unsigned*)(lds + LDS_BYTES - 16);
    if (threadIdx.x == 0) { xst[0] = 0u; xst[1] = 0u; xst[2] = 0u; xst[3] = 0u; (void)xb_add(&((unsigned*)(P.ws + WS_XBAR))[XB_XCNT(xb_xcc_id())], 1u);
        if (blockIdx.x >= 128) (void)xb_add(&((unsigned*)(P.ws + WS_XBAR2))[XB_XCNT(xb_xcc_id())], 1u); }
    __syncthreads();

    unsigned nsub = 0;
    for (int ph = 0; ph < NL * 12 + 1; ++ph) {
        const int l = ph / 12, kph = ph - l * 12;
        if (ph == NL * 12) {
#if (PHMASK >> 12) & 1
    { PH_BEGIN
        const int lane = tid & 63, gw = bid * 8 + (tid >> 6), nw = G * 8;
        const float* fn = INP(32); const float* ssf = SS + (size_t)0 * T * 16; float* X = OUT;
        for (int r = gw; r < T; r += nw) { const float rs = row_rstd(ssf, r);
#pragma unroll
            for (int i = 0; i < 4; ++i) { const size_t o = (size_t)r * D + i * 256 + lane * 4; *(f32x4*)(X + o) = *(const f32x4*)(X + o) * rs * *(const f32x4*)(fn + i * 256 + lane * 4); } }
    }
#endif
            break;
        }
        switch (kph) {
        case 0: {
#if (PHMASK >> 0) & 1
        for (int rep = 0; rep < REP0; ++rep) {
        {
            { PH_BEGIN convT_w<1>(INP(3) + (size_t)l * D * 2 * FF, 2 * FF, 0, INP(2) + (size_t)l * D, (bf16_t*)(WB + WB_W1A), D, D, 2 * FF, bid * 8 + (tid >> 6), G * 8, tid & 63, 0); }
            { PH_BEGIN convT_w<0>(INP(4) + (size_t)l * FF * D, D, 0, nullptr, (bf16_t*)(WB + WB_W1B), FF, FF, D, bid * 8 + (tid >> 6), G * 8, tid & 63, 1408); }
            { PH_BEGIN convT_w<2>(INP(7) + (size_t)l * D * 6928, 6928, 0, INP(5) + (size_t)l * D, (bf16_t*)(WB + WB_WIN), D, D, 4096, bid * 8 + (tid >> 6), G * 8, tid & 63, 2112); }
            { PH_BEGIN convT_w<0>(INP(7) + (size_t)l * D * 6928, 6928, 3856, INP(5) + (size_t)l * D, (bf16_t*)(WB + WB_WG), D, D, 3072, bid * 8 + (tid >> 6), G * 8, tid & 63, 3136); }
            for (int j = 0; j < 3; ++j) { PH_BEGIN convT_w<0>(INP(27) + ((size_t)l * 3 + j) * 512 * D, D, 0, nullptr, (bf16_t*)(WB + WB_WBR) + (size_t)j * D * 512, 512, 512, D, bid * 8 + (tid >> 6), G * 8, tid & 63, 3904 + 128 * j); }
            { PH_BEGIN convT_w<0>(INP(28) + (size_t)l * D * D, D, 0, nullptr, (bf16_t*)(WB + WB_WO), D, D, D, bid * 8 + (tid >> 6), G * 8, tid & 63, 4288); }
            { PH_BEGIN convT_w<0>(INP(26) + (size_t)l * D * D, D, 0, INP(6) + (size_t)l * D, (bf16_t*)(WB + WB_WKV), D, D, D, bid * 8 + (tid >> 6), G * 8, tid & 63, 4544); }
            { PH_BEGIN convT_w<1>(INP(30) + (size_t)l * D * 2 * FF, 2 * FF, 0, INP(29) + (size_t)l * D, (bf16_t*)(WB + WB_W2A), D, D, 2 * FF, bid * 8 + (tid >> 6), G * 8, tid & 63, 4800); }
            { PH_BEGIN convT_w<0>(INP(31) + (size_t)l * FF * D, D, 0, nullptr, (bf16_t*)(WB + WB_W2B), FF, FF, D, bid * 8 + (tid >> 6), G * 8, tid & 63, 6208); }
            { PH_BEGIN convT_w<0>(INP(10) + (size_t)l * 64 * 512, 512, 0, nullptr, (bf16_t*)(WB + WB_LW2), 64, 64, 512, bid * 8 + (tid >> 6), G * 8, tid & 63, 6912); }
            { PH_BEGIN convT_w<0>(INP(12) + (size_t)l * 64 * 512, 512, 0, nullptr, (bf16_t*)(WB + WB_LA2), 64, 64, 512, bid * 8 + (tid >> 6), G * 8, tid & 63, 6920); }
            { PH_BEGIN convT_w<0>(INP(13) + (size_t)l * 128 * 512, 512, 0, nullptr, (bf16_t*)(WB + WB_LG2), 128, 128, 512, bid * 8 + (tid >> 6), G * 8, tid & 63, 6928); }
            if (l > 0) {
                { PH_BEGIN convT_w<0>(INP(20) + (size_t)(l - 1) * 512 * 32, 32, 0, nullptr, (bf16_t*)(WB + WB_LV1), 512, 512, 32, bid * 8 + (tid >> 6), G * 8, tid & 63, 6944); }
                { PH_BEGIN convT_w<0>(INP(21) + (size_t)(l - 1) * 32 * 512, 512, 0, nullptr, (bf16_t*)(WB + WB_LV2), 32, 32, 512, bid * 8 + (tid >> 6), G * 8, tid & 63, 6976); }
            }
            if (l == 0) { PH_BEGIN
                const int lane = tid & 63, gw = bid * 8 + (tid >> 6), nw = G * 8;
                float* rstd_mem = (float*)(ws + WS_MISC); bf16_t* MEMN = (bf16_t*)(ws + WS_MEMN);
                for (int r = gw; r < T + 1024; r += nw) {
                    const bool ism = r >= T; const float* src = ism ? INP(1) + (size_t)(r - T) * D : INP(0) + (size_t)r * D; bf16_t* dst = ism ? MEMN + (size_t)(r - T) * D : XB_ + (size_t)r * D; float q = 0.f;
#pragma unroll
                    for (int i = 0; i < 4; ++i) { const f32x4 v = *(const f32x4*)(src + i * 256 + lane * 4); st_bf4(dst + i * 256 + lane * 4, v); q += (v[0] * v[0] + v[1] * v[1]) + (v[2] * v[2] + v[3] * v[3]); }
                    q = wave_sum(q);
                    if (ism) { if (lane == 0) rstd_mem[r - T] = rsqrtf(q * (1.0f / 1024.0f) + 1e-6f); } else if (lane < 16) SS[(size_t)r * 16 + lane] = (lane == 0) ? q : 0.f;
                }
            }
        }
        }
#endif
        } break;
        case 1: {
#if (PHMASK >> 1) & 1
        for (int rep = 0; rep < REPG; ++rep) {
        { PH_BEGIN
            pg8::Gemm g{XB_, (const bf16_t*)(WB + WB_W1A), T, 2 * FF, D, D, D, 0, 0}; pg8::StaticOrder S; S.init(T, 2 * FF, G, bid, 1);
            EpiFFNa E{(bf16_t*)U_, SS + (size_t)0 * T * 16}; pg8::gemm_phase(lds, g, S, E, tid);
        }
        if ((int)blockIdx.x >= (int)gridDim.x - 16) { PH_BEGIN
            pg8::Gemm g2{(const bf16_t*)(ws + WS_MEMN), (const bf16_t*)(WB + WB_WKV), 1024, D, D, D, D, 0, 0}; pg8::StaticOrder S2; S2.init(1024, D, 16, bid - (G - 16), 1);
            EpiKV E2{KB_, VT_, (const float*)(ws + WS_MISC)}; pg8::gemm_phase(lds, g2, S2, E2, tid);
        }
        }
#endif
        } break;
        case 2: {
#if (PHMASK >> 2) & 1
        { PH_BEGIN
            pg8::Gemm g{(const bf16_t*)U_, (const bf16_t*)(WB + WB_W1B), T, D, FF, FF, FF, 0, 0}; pg8::StaticOrder S; S.init(T, D, G, bid, 1);
            EpiRes E{l == 0 ? INP(0) : OUT, OUT, XB_, SS + (size_t)1 * T * 16, 0.5f}; pg8::gemm_phase(lds, g, S, E, tid);
        }
#endif
        } break;
        case 3: {
#if (PHMASK >> 3) & 1
        for (int rep = 0; rep < REPG; ++rep) {
        { PH_BEGIN
            pg8::Gemm g{XB_, (const bf16_t*)(WB + WB_WIN), T, 4096, D, D, D, 0, 0}; pg8::StaticOrder S; S.init(T, 4096, G, bid, 1);
            EpiU E{(bf16_t*)U_, SS + (size_t)1 * T * 16}; pg8::gemm_phase(lds, g, S, E, tid);
        }
        }
#endif
        } break;
        case 4: {
#if (PHMASK >> 4) & 1
        { PH_BEGIN
            PrepArgs PA; PA.U = (const bf16_t*)(U_ + U_RWKV); PA.mu = INP(8) + (size_t)l * 1792; PA.w0 = INP(9) + (size_t)l * 512; PA.a0 = INP(11) + (size_t)l * 512;
            PA.kk_ = INP(14) + (size_t)l * 512; PA.ka = INP(15) + (size_t)l * 512; PA.rk = INP(16) + (size_t)l * 512; PA.v0 = INP(19) + (size_t)(l > 0 ? l - 1 : 0) * 512;
            PA.w2t = (const bf16_t*)(WB + WB_LW2); PA.a2t = (const bf16_t*)(WB + WB_LA2); PA.g2t = (const bf16_t*)(WB + WB_LG2); PA.v1t = (const bf16_t*)(WB + WB_LV1); PA.v2t = (const bf16_t*)(WB + WB_LV2);
            PA.vfirst = (float*)(ws + WS_VF); PA.Wd = (float*)(SC_ + SC_WD); PA.V = (float*)(SC_ + SC_V); PA.RKKB = (bf16_t*)(SC_ + SC_RKKB); PA.Go = (bf16_t*)(ws + WS_GO); PA.Bon = (float*)(ws + WS_BON); PA.layer = l;
            { const int tt = (bid & 7) * 32 + (bid >> 3); rwkv_prep_tile(lds, PA, tt, tid); }
        }
        { PH_BEGIN
            { const int x = bid & 7, j = bid >> 3, pm = 8 * x + (j & 7), h = j >> 3, b = pm >> 4, pq = pm & 15; const int pair = ((b * 4 + h) << 4) | pq;
              xa_pair(lds, (const bf16_t*)(U_ + U_XA), KB_, VT_, Y_ + (size_t)2 * T * 512, pair, tid); }
        }
        { PH_BEGIN
            GlaArgs GA; GA.Ug = (const bf16_t*)(U_ + U_GLA); GA.conv = INP(22) + (size_t)l * 4096; GA.aup = INP(23) + (size_t)l * 4096; GA.abias = INP(24) + (size_t)l * 256; GA.gnorm = INP(25) + (size_t)l * 512;
            GA.kvcT = (float*)(ws + WS_KVC); GA.dec = (float*)(ws + WS_DEC); GA.spT = (bf16_t*)(U_ + U_SPT); GA.Yg = Y_ + (size_t)T * 512;
            { const int x = bid & 7, j = bid >> 3, b = x >> 1, nhi = x & 1;
              for (int k = 0; k < 2; ++k) { const int idx = j * 2 + k, h = idx >> 5, n = nhi * 32 + (idx & 31); gla_a_tile(lds, GA, ((b * 4 + h) << 6) | n, tid); } }
        }
#endif
        } break;
        case 5: {
#if (PHMASK >> 5) & 1
        if ((int)blockIdx.x < 128) { PH_BEGIN
            const int xcd = bid & 7, j = bid >> 3, p = xcd * 4 + (j >> 2), rg = j & 3;
            rwkv_scan_unit(lds, (const float*)(SC_ + SC_WD), (const float*)(SC_ + SC_V), (const bf16_t*)(SC_ + SC_RKKB), (float*)(U_ + U_YRAW), p, rg, tid);
        } else {
            { PH_BEGIN
            GlaArgs GA; GA.Ug = (const bf16_t*)(U_ + U_GLA); GA.conv = INP(22) + (size_t)l * 4096; GA.aup = INP(23) + (size_t)l * 4096; GA.abias = INP(24) + (size_t)l * 256; GA.gnorm = INP(25) + (size_t)l * 512;
            GA.kvcT = (float*)(ws + WS_KVC); GA.dec = (float*)(ws + WS_DEC); GA.spT = (bf16_t*)(U_ + U_SPT); GA.Yg = Y_ + (size_t)T * 512;
            { const int x = bid & 7, j = (bid - 128) >> 3, b = x >> 1, nhi = x & 1;
              for (int k = 0; k < 4; ++k) { const int idx = j * 4 + k, h = 2 + (idx >> 5), n = nhi * 32 + (idx & 31); gla_a_tile(lds, GA, ((b * 4 + h) << 6) | n, tid); } }
            }
            xcd_barrier((unsigned*)(P.ws + WS_XBAR2), xst + 2, 128u);
            { PH_BEGIN
            bf16_t* spT = (bf16_t*)(U_ + U_SPT); const float* DEC = (const float*)(ws + WS_DEC); const float* KVC = (const float*)(ws + WS_KVC);
            for (int i = (bid - 128) * 512 + tid; i < 16 * 128 * 64; i += 128 * 512) { const int bh = i >> 13, ed = i & 8191, d = i & 63; float st = 0.f;
                for (int n0 = 0; n0 < 64; n0 += 16) { float kv[16], dc[16];
#pragma unroll
                    for (int q = 0; q < 16; ++q) { kv[q] = KVC[((size_t)bh * 64 + n0 + q) * 8192 + ed]; dc[q] = DEC[((size_t)bh * 64 + n0 + q) * 64 + d]; }
#pragma unroll
                    for (int q = 0; q < 16; ++q) { spT[((size_t)bh * 64 + n0 + q) * 8192 + ed] = f2bf(st); st = st * dc[q] + kv[q]; } } }
            }
            xcd_barrier((unsigned*)(P.ws + WS_XBAR2), xst + 2, 128u);
            { PH_BEGIN
            GlaArgs GA; GA.Ug = (const bf16_t*)(U_ + U_GLA); GA.conv = INP(22) + (size_t)l * 4096; GA.aup = INP(23) + (size_t)l * 4096; GA.abias = INP(24) + (size_t)l * 256; GA.gnorm = INP(25) + (size_t)l * 512;
            GA.kvcT = (float*)(ws + WS_KVC); GA.dec = (float*)(ws + WS_DEC); GA.spT = (bf16_t*)(U_ + U_SPT); GA.Yg = Y_ + (size_t)T * 512;
            { const int x = bid & 7, j = (bid - 128) >> 3, b = x >> 1, nhi = x & 1;
              for (int k = 0; k < 8; ++k) { const int idx = j * 8 + k, h = idx >> 5, n = nhi * 32 + (idx & 31); gla_c_tile(lds, GA, ((b * 4 + h) << 6) | n, tid); } }
            }
        }
#endif
        } break;
        case 6: {
#if (PHMASK >> 6) & 1
        { PH_BEGIN
            const int lane = tid & 63, gw = bid * 8 + (tid >> 6), nw = G * 8;
            const float* lnw = INP(17) + (size_t)l * 512; const float* lnb = INP(18) + (size_t)l * 512; const float* Yraw = (const float*)(U_ + U_YRAW); const float* Vv = (const float*)(SC_ + SC_V);
            const float* BON = (const float*)(ws + WS_BON); const bf16_t* GO = (const bf16_t*)(ws + WS_GO); bf16_t* Y = Y_;
            const int kq = lane & 15, sub = lane >> 4;
#pragma unroll 4
            for (int it0 = gw * 4; it0 < 32 * SEQ; it0 += nw * 4) { const int it = it0 + sub; const int p = it >> 12, s = it & (SEQ - 1), b = p >> 3, h = p & 7, t = b * SEQ + s;
                const f32x4 y = *(const f32x4*)(Yraw + (size_t)it * 64 + kq * 4); const f32x4 vv = *(const f32x4*)(Vv + (size_t)it * 64 + kq * 4);
                const f32x4 gg = ld_bf4(GO + (size_t)t * 512 + h * 64 + kq * 4); const f32x4 lw = *(const f32x4*)(lnw + h * 64 + kq * 4), lb = *(const f32x4*)(lnb + h * 64 + kq * 4); const float bon = BON[(size_t)t * 8 + h];
                const float mean = row16_sum((y[0] + y[1]) + (y[2] + y[3])) * (1.0f / 64.0f); const f32x4 dl = y - mean;
                const float var = row16_sum((dl[0] * dl[0] + dl[1] * dl[1]) + (dl[2] * dl[2] + dl[3] * dl[3])) * (1.0f / 64.0f); const float rs = rsqrtf(var + 64e-5f);
                st_bf4(Y + (size_t)t * 512 + h * 64 + kq * 4, ((dl * rs) * lw + lb + vv * bon) * gg); }
        }
#endif
        } break;
        case 7: {
#if (PHMASK >> 7) & 1
        for (int rep = 0; rep < REPG; ++rep) {
        { PH_BEGIN
            pg8::Gemm g{XB_, (const bf16_t*)(WB + WB_WG), T, 3072, D, D, D, 0, 0}; pg8::StaticOrder S; S.init(T, 3072, G, bid, 1);
            EpiGate E{(unsigned char*)SC_, SS + (size_t)1 * T * 16}; pg8::gemm_phase(lds, g, S, E, tid);
        }
        }
#endif
        } break;
        case 8: {
#if (PHMASK >> 8) & 1
        for (int rep = 0; rep < REPG; ++rep) {
        { PH_BEGIN
            pg8::Gemm g{Y_, (const bf16_t*)(WB + WB_WBR), T, D, 512, 512, 512, (unsigned)T * 512u * 2u, (unsigned)D * 512u * 2u}; pg8::StaticOrder S; S.init(T, D, G, bid, 3);
            EpiMerge E{(const unsigned char*)SC_, (float*)(U_ + U_MG), (bf16_t*)(U_ + U_MGB)}; pg8::gemm_phase(lds, g, S, E, tid);
        }
        }
#endif
        } break;
        case 9: {
#if (PHMASK >> 9) & 1
        { PH_BEGIN
            pg8::Gemm g{(const bf16_t*)(U_ + U_MGB), (const bf16_t*)(WB + WB_WO), T, D, D, D, D, 0, 0}; pg8::StaticOrder S; S.init(T, D, G, bid, 1);
            EpiRes E{OUT, OUT, XB_, SS + (size_t)2 * T * 16, 1.0f}; pg8::gemm_phase(lds, g, S, E, tid);
        }
#endif
        } break;
        case 10: {
#if (PHMASK >> 10) & 1
        for (int rep = 0; rep < REPG; ++rep) {
        { PH_BEGIN
            pg8::Gemm g{XB_, (const bf16_t*)(WB + WB_W2A), T, 2 * FF, D, D, D, 0, 0}; pg8::StaticOrder S; S.init(T, 2 * FF, G, bid, 1);
            EpiFFNa E{(bf16_t*)U_, SS + (size_t)2 * T * 16}; pg8::gemm_phase(lds, g, S, E, tid);
        }
        }
#endif
        } break;
        case 11: {
#if (PHMASK >> 11) & 1
        { PH_BEGIN
            pg8::Gemm g{(const bf16_t*)U_, (const bf16_t*)(WB + WB_W2B), T, D, FF, FF, FF, 0, 0}; pg8::StaticOrder S; S.init(T, D, G, bid, 1);
            EpiRes E{OUT, OUT, XB_, SS + (size_t)0 * T * 16, 0.5f}; pg8::gemm_phase(lds, g, S, E, tid);
        }
#endif
        } break;
        default: break;
        }
        if (ph == 0) grid.sync();
        else xcd_barrier((unsigned*)(P.ws + WS_XBAR), xst, gridDim.x);
    }
}

extern "C" void kernel_launch(void* const* d_in, const int* in_sizes, int n_in, void* d_out, int out_size, void* d_ws, size_t ws_size, hipStream_t stream) {
    static int grid_blocks = 0;
    if (!grid_blocks) {
        if (n_in != 33 || ws_size < WS_END) { fprintf(stderr, "kernel_launch: need 33 inputs and %zu bytes of workspace (got %d, %zu)\n", (size_t)WS_END, n_in, ws_size); grid_blocks = -1; return; }
        int dev = 0, cus = 0, per_cu = 0;
        hipGetDevice(&dev); hipDeviceGetAttribute(&cus, hipDeviceAttributeMultiprocessorCount, dev);
        if (hipFuncSetAttribute((const void*)mega, hipFuncAttributeMaxDynamicSharedMemorySize, LDS_BYTES) != hipSuccess) { fprintf(stderr, "kernel_launch: hipFuncSetAttribute failed\n"); grid_blocks = -1; return; }
        if (hipOccupancyMaxActiveBlocksPerMultiprocessor(&per_cu, (const void*)mega, 512, LDS_BYTES) != hipSuccess || per_cu < 1) { fprintf(stderr, "kernel_launch: occupancy query says %d\n", per_cu); per_cu = 1; }
        (void)hipGetLastError();
        grid_blocks = cus * per_cu;
        if (grid_blocks != 256) { fprintf(stderr, "kernel_launch: this kernel splits a 256-workgroup grid in its scan phase (got %d)\n", grid_blocks); grid_blocks = -1; return; }
    }
    if (grid_blocks < 0) return;
    if (hipMemsetAsync((char*)d_ws + WS_BAR, 0, (WS_XBAR2 - WS_BAR) + XCD_BAR_WORDS * 4, stream) != hipSuccess) { fprintf(stderr, "kernel_launch: memset failed\n"); return; }
    Params p{};
    for (int i = 0; i < 33; ++i) p.in[i] = (const float*)d_in[i];
    p.out = (float*)d_out; p.ws = (unsigned char*)d_ws;
    void* args[] = {&p};
    hipError_t e = hipLaunchCooperativeKernel((const void*)mega, dim3(grid_blocks), dim3(512), args, LDS_BYTES, stream);
    if (e != hipSuccess) fprintf(stderr, "cooperative launch failed: %s (grid %d)\n", hipGetErrorString(e), grid_blocks);
}
```

```cpp
#include <hip/hip_runtime.h>
#include <hip/hip_cooperative_groups.h>
#include <cstdio>
namespace cg = cooperative_groups;
#ifndef P4SUB
#define P4SUB 7
#endif
#ifndef REP5
#define REP5 1
#endif
#ifndef REP4
#define REP4 1
#endif
#ifndef REP6
#define REP6 1
#endif
#ifndef REP0
#define REP0 1
#endif
#ifndef REPG
#define REPG 1
#endif
#ifndef REPSYNC
#define REPSYNC 1
#endif
#ifndef NA4
#define NA4 2
#endif
#ifndef PHMASK
#define PHMASK 0xFFFF
#endif

#define LAS __attribute__((address_space(3)))
typedef unsigned short bf16_t;
typedef short bf16x8 __attribute__((ext_vector_type(8)));
typedef float f32x4 __attribute__((ext_vector_type(4)));
typedef float f32x2 __attribute__((ext_vector_type(2)));
typedef unsigned u32x4 __attribute__((ext_vector_type(4)));
typedef unsigned u32x2 __attribute__((ext_vector_type(2)));

constexpr int T = 16384, D = 1024, FF = 2816, SEQ = 4096, NL = 4;
constexpr int LDS_BYTES = 139264;

constexpr size_t MB = 1024 * 1024;
constexpr size_t WS_MISC = 0;
constexpr size_t WS_SS = 1 * MB;
constexpr size_t WS_WB = 4 * MB;
constexpr size_t WB_W1A = 0;
constexpr size_t WB_W1B = WB_W1A + (size_t)5632 * 1024 * 2;
constexpr size_t WB_WIN = WB_W1B + (size_t)1024 * 2816 * 2;
constexpr size_t WB_WG = WB_WIN + (size_t)4096 * 1024 * 2;
constexpr size_t WB_WBR = WB_WG + (size_t)3072 * 1024 * 2;
constexpr size_t WB_WO = WB_WBR + (size_t)3 * 1024 * 512 * 2;
constexpr size_t WB_WKV = WB_WO + (size_t)1024 * 1024 * 2;
constexpr size_t WB_W2A = WB_WKV + (size_t)1024 * 1024 * 2;
constexpr size_t WB_W2B = WB_W2A + (size_t)5632 * 1024 * 2;
constexpr size_t WB_LW2 = WB_W2B + (size_t)1024 * 2816 * 2;
constexpr size_t WB_LA2 = WB_LW2 + 512 * 64 * 2;
constexpr size_t WB_LG2 = WB_LA2 + 512 * 64 * 2;
constexpr size_t WB_LV1 = WB_LG2 + 512 * 128 * 2;
constexpr size_t WB_LV2 = WB_LV1 + 32 * 512 * 2;
constexpr size_t WB_END = WB_LV2 + 512 * 32 * 2;
static_assert(WB_END <= 55 * MB, "weights region");
constexpr size_t WS_XB = WS_WB + 55 * MB;
constexpr size_t WS_VF = WS_XB + 32 * MB;
constexpr size_t WS_MEMN = WS_VF + 32 * MB;
constexpr size_t WS_KB = WS_MEMN + 2 * MB;
constexpr size_t WS_VT = WS_KB + 1 * MB;
constexpr size_t WS_GO = WS_VT + 1 * MB;
constexpr size_t WS_BON = WS_GO + 16 * MB;
constexpr size_t WS_Y = WS_BON + 1 * MB;
constexpr size_t WS_KVC = WS_Y + 48 * MB;
constexpr size_t WS_DEC = WS_KVC + 32 * MB;
constexpr size_t WS_SC = WS_DEC + 1 * MB;
constexpr size_t SC_WD = 0;
constexpr size_t SC_V = 32 * MB;
constexpr size_t SC_RKKB = 64 * MB;
constexpr size_t WS_U = WS_SC + 128 * MB;
constexpr size_t U_RWKV = 0;
constexpr size_t U_GLA = (size_t)T * 1792 * 2;
constexpr size_t U_XA = 2 * (size_t)T * 1792 * 2;
constexpr size_t U_YRAW = 0;
constexpr size_t U_SPT = 32 * MB;
constexpr size_t U_MG = 0;
constexpr size_t U_MGB = 64 * MB;
constexpr size_t WS_END = WS_U + 128 * MB;
static_assert(U_XA + (size_t)T * 512 * 2 <= 128 * MB, "U region");

typedef __bf16 bf16x2_t __attribute__((ext_vector_type(2)));
__device__ __forceinline__ unsigned cvt_pk_bf16(float lo, float hi) { const f32x2 v = {lo, hi}; const bf16x2_t r = __builtin_convertvector(v, bf16x2_t); return __builtin_bit_cast(unsigned, r); }
__device__ __forceinline__ bf16_t f2bf(float x) { return (bf16_t)(cvt_pk_bf16(x, 0.f) & 0xffffu); }
__device__ __forceinline__ float bf2f(bf16_t b) { return __uint_as_float(((unsigned)b) << 16); }
__device__ __forceinline__ float bflo(unsigned w) { return __uint_as_float(w << 16); }
__device__ __forceinline__ float bfhi(unsigned w) { return __uint_as_float(w & 0xffff0000u); }
__device__ __forceinline__ f32x4 ld_bf4(const bf16_t* p) { const u32x2 w = *(const u32x2*)p; return (f32x4){bflo(w.x), bfhi(w.x), bflo(w.y), bfhi(w.y)}; }
__device__ __forceinline__ void st_bf4(bf16_t* p, f32x4 v) { u32x2 w; w.x = cvt_pk_bf16(v[0], v[1]); w.y = cvt_pk_bf16(v[2], v[3]); *(u32x2*)p = w; }
__device__ __forceinline__ float sigmoidf_(float x) { return __builtin_amdgcn_rcpf(1.0f + __expf(-x)); }
__device__ __forceinline__ float wave_sum(float v) { for (int o = 32; o >= 1; o >>= 1) v += __shfl_xor(v, o); return v; }
__device__ __forceinline__ f32x4 mfma16(bf16x8 a, bf16x8 b, f32x4 c) { return __builtin_amdgcn_mfma_f32_16x16x32_bf16(a, b, c, 0, 0, 0); }

__device__ __forceinline__ float row_rstd(const float* ssp, int row) {
    const f32x4* p = (const f32x4*)(ssp + (size_t)row * 16); const f32x4 a = p[0], b = p[1], c = p[2], d = p[3];
    const float t = (((a[0] + a[1]) + (a[2] + a[3])) + ((b[0] + b[1]) + (b[2] + b[3]))) + (((c[0] + c[1]) + (c[2] + c[3])) + ((d[0] + d[1]) + (d[2] + d[3])));
    return rsqrtf(t * (1.0f / 1024.0f) + 1e-6f);
}
__device__ __forceinline__ void rstd8(float (&rs)[2][4], const float* ssp, int row0, int fq) {
    f32x4 p[2][4];
#pragma unroll
    for (int ai = 0; ai < 2; ++ai)
#pragma unroll
        for (int m = 0; m < 4; ++m) p[ai][m] = *(const f32x4*)(ssp + (size_t)(row0 + ai * 128 + m * 16) * 16 + fq * 4);
#pragma unroll
    for (int ai = 0; ai < 2; ++ai)
#pragma unroll
        for (int m = 0; m < 4; ++m) { float t = (p[ai][m][0] + p[ai][m][1]) + (p[ai][m][2] + p[ai][m][3]); t += __shfl_xor(t, 16); t += __shfl_xor(t, 32); rs[ai][m] = rsqrtf(t * (1.0f / 1024.0f) + 1e-6f); }
}
namespace pg8 {
constexpr int BM = 256, BK = 64, HALF = 128, HTB = HALF * BK * 2, STAGE_BYTES = 8 * HTB, NXCD = 8, WGM = 8;
__device__ __forceinline__ int lds_byte(int r, int c) { const int st = (r >> 4) * 2 + (c >> 5), rr = r & 15, cc = c & 31, ob = rr * 64 + cc * 2; return st * 1024 + (ob ^ (((ob >> 9) & 1) << 5)); }
__device__ __forceinline__ void stage_rc(int b, int& R, int& C) { const int st = b / 1024, sb = b % 1024, swz = sb ^ (((sb >> 9) & 1) << 5); R = (st >> 1) * 16 + swz / 64; C = (st & 1) * 32 + (swz % 64) / 2; }
__device__ __forceinline__ int perm32(int rho) { const int n = rho >> 4, i = rho & 15; return 8 * (i >> 2) + 4 * n + (i & 3); }

struct Unit { int pm, pn, z; };
struct Gemm { const bf16_t* A; const bf16_t* Bt; int M, N, K, lda, ldb; unsigned zA, zB; };

struct StaticOrder {
    int nM, nN, nwg, G, c, nz;
    __device__ void init(int M, int N, int G_, int c_, int nz_) { nM = M / BM; nN = N / BM; nwg = nM * nN; G = G_; c = c_; nz = nz_; }
    __device__ bool next(int i, Unit& u) const {
        const int ti = i / nz; u.z = i - ti * nz;
        const long L = (long)ti * G + c; if (L >= nwg) return false;
        int wgid = (int)L; { const int q = nwg / NXCD, r = nwg % NXCD, xcd = wgid % NXCD, off = wgid / NXCD; wgid = (xcd < r ? xcd * (q + 1) : r * (q + 1) + (xcd - r) * q) + off; }
        const int nig = WGM * nN, gid = wgid / nig, fm = gid * WGM, gsz = (nM - fm) < WGM ? (nM - fm) : WGM;
        u.pm = fm + ((wgid % nig) % gsz); u.pn = (wgid % nig) / gsz; return true;
    }
};

template <class Epi>
__device__ __forceinline__ void gemm_phase(LAS unsigned char* lds, const Gemm g, const StaticOrder& S, const Epi& E, const int tid) {
    const int wid = __builtin_amdgcn_readfirstlane(tid >> 6), lane = tid & 63, wr = wid >> 2, wc = wid & 3, fr = lane & 15, fq = lane >> 4;
    const int K = g.K, nt = K / BK;
    unsigned voffA[2], voffB[2];
#pragma unroll
    for (int i = 0; i < 2; ++i) { int R, C; stage_rc(tid * 16 + i * 8192, R, C); const int Rb = Epi::PERM ? ((R & ~31) + perm32(R & 31)) : R;
        voffA[i] = (unsigned)(R * g.lda + C) * 2u; voffB[i] = (unsigned)(Rb * g.ldb + C) * 2u; }
    const unsigned kstep = (unsigned)(BK * 2);
    const unsigned hstepA = (unsigned)HALF * g.lda * 2u, hstepB = (unsigned)HALF * g.ldb * 2u;
    const unsigned tstepA = 2u * hstepA, tstepB = 2u * hstepB;
    const unsigned ldsw = (unsigned)wid * 1024u;
    const int aoff = lds_byte(wr * 64 + fr, fq * 8), boff = lds_byte(wc * 32 + fr, fq * 8);
    const char* const gA = (const char*)g.A; const char* const gB = (const char*)g.Bt;
#define PG8_SA(b, h) (((b) * 2 + (h)) * HTB)
#define PG8_SB(b, h) ((4 + (b) * 2 + (h)) * HTB)
#define PG8_STAGE(bufoff, gbase, soff, voff) do { _Pragma("unroll") for (int _i = 0; _i < 2; ++_i) \
        __builtin_amdgcn_global_load_lds((const unsigned*)(((gbase) + (size_t)(unsigned)(soff)) + (voff)[_i]), (LAS unsigned*)(lds + (bufoff) + ldsw + _i * 8192), 16, 0, 0); } while (0)
#define PG8_LDA(dst, b, h) do { _Pragma("unroll") for (int m = 0; m < 4; ++m) _Pragma("unroll") for (int k = 0; k < 2; ++k) dst[m][k] = *(const LAS bf16x8*)(lds + PG8_SA(b, h) + aoff + m * 2048 + k * 1024); } while (0)
#define PG8_LDB(dst, b, h) do { _Pragma("unroll") for (int n = 0; n < 2; ++n) _Pragma("unroll") for (int k = 0; k < 2; ++k) dst[n][k] = *(const LAS bf16x8*)(lds + PG8_SB(b, h) + boff + n * 2048 + k * 1024); } while (0)
#define PG8_MMA(ai, bj, At, Bt) do { __builtin_amdgcn_s_setprio(1); _Pragma("unroll") for (int m = 0; m < 4; ++m) _Pragma("unroll") for (int n = 0; n < 2; ++n) _Pragma("unroll") for (int k = 0; k < 2; ++k) \
        acc[ai][bj][m][n] = __builtin_amdgcn_mfma_f32_16x16x32_bf16(Bt[n][k], At[m][k], acc[ai][bj][m][n], 0, 0, 0); __builtin_amdgcn_s_setprio(0); } while (0)
#define PG8_WAIT_V(n) asm volatile("s_waitcnt vmcnt(" #n ")" ::: "memory")
#define PG8_WAIT_L(n) asm volatile("s_waitcnt lgkmcnt(" #n ")" ::: "memory")
#define PG8_BAR __builtin_amdgcn_s_barrier()
#define PG8_SCHED __builtin_amdgcn_sched_barrier(0)
    Unit cur, nxt; int ui = 0;
    if (!S.next(0, cur)) return;
    f32x4 acc[2][2][4][2];
#pragma unroll
    for (int a = 0; a < 2; ++a)
#pragma unroll
        for (int b = 0; b < 2; ++b)
#pragma unroll
            for (int m = 0; m < 4; ++m)
#pragma unroll
                for (int n = 0; n < 2; ++n) acc[a][b][m][n] = (f32x4){0.f, 0.f, 0.f, 0.f};
    bf16x8 At[4][2], B0[2][2], B1[2][2];
    unsigned cA = (unsigned)cur.z * g.zA + (unsigned)cur.pm * tstepA, cB = (unsigned)cur.z * g.zB + (unsigned)cur.pn * tstepB;
    PG8_STAGE(PG8_SB(0, 0), gB, cB, voffB); PG8_STAGE(PG8_SA(0, 0), gA, cA, voffA); PG8_STAGE(PG8_SB(0, 1), gB, cB + hstepB, voffB); PG8_STAGE(PG8_SA(0, 1), gA, cA + hstepA, voffA);
    if (wr == 1) PG8_BAR;
    PG8_WAIT_V(4); PG8_BAR;
    PG8_STAGE(PG8_SB(1, 0), gB, cB + kstep, voffB); PG8_STAGE(PG8_SA(1, 0), gA, cA + kstep, voffA); PG8_STAGE(PG8_SB(1, 1), gB, cB + hstepB + kstep, voffB);
    PG8_WAIT_V(6); PG8_BAR;
    for (;;) {
        const bool has_next = S.next(ui + 1, nxt);
        const unsigned nA = has_next ? (unsigned)nxt.z * g.zA + (unsigned)nxt.pm * tstepA : cA, nB = has_next ? (unsigned)nxt.z * g.zB + (unsigned)nxt.pn * tstepB : cB;
        for (int t = 0; t < nt; t += 2) {
            const bool last = (t == nt - 2);
            const unsigned a1 = cA + (unsigned)(t + 1) * kstep;
            const unsigned a2 = last ? nA : cA + (unsigned)(t + 2) * kstep, b2 = last ? nB : cB + (unsigned)(t + 2) * kstep;
            const unsigned a3 = a2 + kstep, b3 = b2 + kstep;
            PG8_LDB(B0, 0, 0); PG8_SCHED; PG8_LDA(At, 0, 0); PG8_STAGE(PG8_SA(1, 1), gA, a1 + hstepA, voffA);
            PG8_WAIT_L(8); PG8_BAR; PG8_WAIT_L(0); PG8_MMA(0, 0, At, B0); PG8_BAR; PG8_SCHED;
            PG8_LDB(B1, 0, 1); PG8_STAGE(PG8_SB(0, 0), gB, b2, voffB);
            PG8_BAR; PG8_WAIT_L(0); PG8_MMA(0, 1, At, B1); PG8_BAR;
            PG8_LDA(At, 0, 1); PG8_STAGE(PG8_SA(0, 0), gA, a2, voffA);
            PG8_BAR; PG8_WAIT_L(0); PG8_MMA(1, 0, At, B0); PG8_BAR; PG8_SCHED;
            PG8_STAGE(PG8_SB(0, 1), gB, b2 + hstepB, voffB);
            PG8_WAIT_V(6); PG8_BAR; PG8_MMA(1, 1, At, B1); PG8_BAR;
            PG8_LDB(B0, 1, 0); PG8_SCHED; PG8_LDA(At, 1, 0); PG8_STAGE(PG8_SA(0, 1), gA, a2 + hstepA, voffA);
            PG8_WAIT_L(8); PG8_BAR; PG8_WAIT_L(0); PG8_MMA(0, 0, At, B0); PG8_BAR; PG8_SCHED;
            PG8_LDB(B1, 1, 1); PG8_STAGE(PG8_SB(1, 0), gB, b3, voffB);
            PG8_BAR; PG8_WAIT_L(0); PG8_MMA(0, 1, At, B1); PG8_BAR;
            PG8_LDA(At, 1, 1); PG8_STAGE(PG8_SA(1, 0), gA, a3, voffA);
            PG8_BAR; PG8_WAIT_L(0); PG8_MMA(1, 0, At, B0); PG8_BAR; PG8_SCHED;
            PG8_STAGE(PG8_SB(1, 1), gB, b3 + hstepB, voffB);
            PG8_WAIT_V(6); PG8_BAR; PG8_MMA(1, 1, At, B1); PG8_BAR;
        }
        E(acc, cur, wr, wc, fr, fq);
        if (!has_next) break;
#pragma unroll
        for (int a = 0; a < 2; ++a)
#pragma unroll
            for (int b = 0; b < 2; ++b)
#pragma unroll
                for (int m = 0; m < 4; ++m)
#pragma unroll
                    for (int n = 0; n < 2; ++n) acc[a][b][m][n] = (f32x4){0.f, 0.f, 0.f, 0.f};
        cur = nxt; cA = nA; cB = nB; ++ui;
    }
    PG8_WAIT_V(0);
    if (wr == 0) PG8_BAR;
    PG8_BAR;
#undef PG8_SA
#undef PG8_SB
#undef PG8_STAGE
#undef PG8_LDA
#undef PG8_LDB
#undef PG8_MMA
#undef PG8_WAIT_V
#undef PG8_WAIT_L
#undef PG8_BAR
#undef PG8_SCHED
}
}
using pg8::Unit;
typedef f32x4 Acc[2][2][4][2];

struct EpiFFNa { static constexpr bool PERM = false; bf16_t* H; const float* ss;
    __device__ __forceinline__ void operator()(const Acc& acc, const Unit& u, int wr, int wc, int fr, int fq) const {
        float rs8[2][4]; rstd8(rs8, ss, u.pm * 256 + wr * 64 + fr, fq);
        const int row0 = u.pm * 256 + wr * 64 + fr, hc0 = u.pn * 128 + wc * 16 + 4 * fq;
#pragma unroll
        for (int ai = 0; ai < 2; ++ai)
#pragma unroll
            for (int m = 0; m < 4; ++m) { const int row = row0 + ai * 128 + m * 16; const float rs = rs8[ai][m];
#pragma unroll
                for (int bj = 0; bj < 2; ++bj) { const f32x4 gt = acc[ai][bj][m][0] * rs, up = acc[ai][bj][m][1] * rs; f32x4 h;
#pragma unroll
                    for (int j = 0; j < 4; ++j) h[j] = gt[j] * sigmoidf_(gt[j]) * up[j];
                    st_bf4(H + (size_t)row * FF + hc0 + bj * 64, h); } }
    }
};
struct EpiRes { static constexpr bool PERM = false; const float* xin; float* xout; bf16_t* xb; float* ss_out; float scale;
    __device__ __forceinline__ void operator()(const Acc& acc, const Unit& u, int wr, int wc, int fr, int fq) const {
        const int row0 = u.pm * 256 + wr * 64 + fr, col0 = u.pn * 256 + wc * 32 + 4 * fq;
#pragma unroll
        for (int ai = 0; ai < 2; ++ai) {
            f32x4 xv[4][2][2];
#pragma unroll
            for (int m = 0; m < 4; ++m)
#pragma unroll
                for (int bj = 0; bj < 2; ++bj)
#pragma unroll
                    for (int n = 0; n < 2; ++n) xv[m][bj][n] = *(const f32x4*)(xin + (size_t)(row0 + ai * 128 + m * 16) * D + col0 + bj * 128 + n * 16);
#pragma unroll
            for (int m = 0; m < 4; ++m) { const int row = row0 + ai * 128 + m * 16; float q = 0.f;
#pragma unroll
                for (int bj = 0; bj < 2; ++bj)
#pragma unroll
                    for (int n = 0; n < 2; ++n) { const size_t o = (size_t)row * D + col0 + bj * 128 + n * 16; const f32x4 v = xv[m][bj][n] + acc[ai][bj][m][n] * scale;
                        *(f32x4*)(xout + o) = v; st_bf4(xb + o, v); q += (v[0] * v[0] + v[1] * v[1]) + (v[2] * v[2] + v[3] * v[3]); }
                q += __shfl_xor(q, 16); q += __shfl_xor(q, 32);
                if (fq == 0) ss_out[(size_t)row * 16 + u.pn * 4 + wc] = q; }
        }
    }
};
struct EpiU { static constexpr bool PERM = true; bf16_t* Ubase; const float* ss;
    __device__ __forceinline__ void operator()(const Acc& acc, const Unit& u, int wr, int wc, int fr, int fq) const {
        float rs8[2][4]; rstd8(rs8, ss, u.pm * 256 + wr * 64 + fr, fq);
        bf16_t* base; int ld, c0;
        if (u.pn < 7) { base = (bf16_t*)((char*)Ubase + U_RWKV); ld = 1792; c0 = u.pn * 256; }
        else if (u.pn < 14) { base = (bf16_t*)((char*)Ubase + U_GLA); ld = 1792; c0 = (u.pn - 7) * 256; }
        else { base = (bf16_t*)((char*)Ubase + U_XA); ld = 512; c0 = (u.pn - 14) * 256; }
        const int row0 = u.pm * 256 + wr * 64 + fr; c0 += wc * 32 + 8 * fq;
#pragma unroll
        for (int ai = 0; ai < 2; ++ai)
#pragma unroll
            for (int m = 0; m < 4; ++m) { const int row = row0 + ai * 128 + m * 16; const float rs = rs8[ai][m];
#pragma unroll
                for (int bj = 0; bj < 2; ++bj) { const f32x4 v0 = acc[ai][bj][m][0] * rs, v1 = acc[ai][bj][m][1] * rs; u32x4 w;
                    w.x = cvt_pk_bf16(v0[0], v0[1]); w.y = cvt_pk_bf16(v0[2], v0[3]); w.z = cvt_pk_bf16(v1[0], v1[1]); w.w = cvt_pk_bf16(v1[2], v1[3]);
                    *(u32x4*)(base + (size_t)row * ld + c0 + bj * 128) = w; } }
    }
};
struct EpiGate { static constexpr bool PERM = true; unsigned char* Gt; const float* ss;
    __device__ __forceinline__ void operator()(const Acc& acc, const Unit& u, int wr, int wc, int fr, int fq) const {
        float rs8[2][4]; rstd8(rs8, ss, u.pm * 256 + wr * 64 + fr, fq);
        const int row0 = u.pm * 256 + wr * 64 + fr, c0 = u.pn * 256 + wc * 32 + 8 * fq;
#pragma unroll
        for (int ai = 0; ai < 2; ++ai)
#pragma unroll
            for (int m = 0; m < 4; ++m) { const int row = row0 + ai * 128 + m * 16; const float rs = rs8[ai][m];
#pragma unroll
                for (int bj = 0; bj < 2; ++bj) { f32x4 v0 = acc[ai][bj][m][0] * rs, v1 = acc[ai][bj][m][1] * rs;
                    unsigned q0[4], q1[4];
#pragma unroll
                    for (int j = 0; j < 4; ++j) { q0[j] = (unsigned)(sigmoidf_(v0[j]) * 255.0f + 0.5f); q1[j] = (unsigned)(sigmoidf_(v1[j]) * 255.0f + 0.5f); }
                    u32x2 w; w.x = q0[0] | (q0[1] << 8) | (q0[2] << 16) | (q0[3] << 24); w.y = q1[0] | (q1[1] << 8) | (q1[2] << 16) | (q1[3] << 24);
                    *(u32x2*)(Gt + (size_t)row * 3072 + c0 + bj * 128) = w; } }
    }
};
struct EpiMerge { static constexpr bool PERM = false; const unsigned char* Gt; float* Mg; bf16_t* Mb;
    __device__ __forceinline__ void operator()(const Acc& acc, const Unit& u, int wr, int wc, int fr, int fq) const {
        const int row0 = u.pm * 256 + wr * 64 + fr, col0 = u.pn * 256 + wc * 32 + 4 * fq;
#pragma unroll
        for (int ai = 0; ai < 2; ++ai) {
            unsigned gw[4][2][2]; u32x2 mb[4][2][2];
#pragma unroll
            for (int m = 0; m < 4; ++m)
#pragma unroll
                for (int bj = 0; bj < 2; ++bj)
#pragma unroll
                    for (int n = 0; n < 2; ++n) { const int row = row0 + ai * 128 + m * 16, col = col0 + bj * 128 + n * 16;
                        gw[m][bj][n] = *(const unsigned*)(Gt + (size_t)row * 3072 + u.z * 1024 + col);
                        mb[m][bj][n] = (u32x2){0u, 0u}; if (u.z > 0) mb[m][bj][n] = *(const u32x2*)(Mb + (size_t)row * D + col); }
#pragma unroll
            for (int m = 0; m < 4; ++m)
#pragma unroll
                for (int bj = 0; bj < 2; ++bj)
#pragma unroll
                    for (int n = 0; n < 2; ++n) { const int row = row0 + ai * 128 + m * 16, col = col0 + bj * 128 + n * 16; const unsigned g = gw[m][bj][n]; const u32x2 w = mb[m][bj][n];
                        const f32x4 gt = (f32x4){(float)(g & 0xffu), (float)((g >> 8) & 0xffu), (float)((g >> 16) & 0xffu), (float)(g >> 24)} * (1.0f / 255.0f);
                        const f32x4 v = acc[ai][bj][m][n] * gt + (f32x4){bflo(w.x), bfhi(w.x), bflo(w.y), bfhi(w.y)};
                        st_bf4(Mb + (size_t)row * D + col, v); }
        }
    }
};
struct EpiKV { static constexpr bool PERM = false; bf16_t* Kb; bf16_t* Vt; const float* rstd;
    __device__ __forceinline__ void operator()(const Acc& acc, const Unit& u, int wr, int wc, int fr, int fq) const {
        const int row0 = u.pm * 256 + wr * 64 + fr, col0 = u.pn * 256 + wc * 32 + 4 * fq;
#pragma unroll
        for (int ai = 0; ai < 2; ++ai)
#pragma unroll
            for (int m = 0; m < 4; ++m) { const int row = row0 + ai * 128 + m * 16; const float rs = rstd[row];
#pragma unroll
                for (int bj = 0; bj < 2; ++bj)
#pragma unroll
                    for (int n = 0; n < 2; ++n) { const int col = col0 + bj * 128 + n * 16; const f32x4 v = acc[ai][bj][m][n] * rs;
                        if (col < 512) st_bf4(Kb + (size_t)row * 512 + col, v);
                        else {
#pragma unroll
                            for (int j = 0; j < 4; ++j) Vt[((size_t)(row >> 8) * 512 + (col - 512 + j)) * 256 + (row & 255)] = f2bf(v[j]); } } }
    }
};

template <int MAP> __device__ __forceinline__ int colmap(int n) {
    if (MAP == 1) { const int g = n >> 5, i = n & 31; return i < 16 ? 16 * g + i : FF + 16 * g + (i - 16); }
    if (MAP == 2) { if (n < 3344) return n; if (n < 3584) return -1; return n - 240; }
    return n;
}
template <int MAP>
__device__ __forceinline__ void convT(LAS unsigned char* lds, const float* src, int ld, int coff, const float* g, bf16_t* dst, int K, int Kd, int Nd, int G, int bid, int tid) {
    const int nkt = (K + 63) >> 6, nnt = (Nd + 63) >> 6, ntile = nkt * nnt;
    LAS bf16_t* tile = (LAS bf16_t*)lds;
    for (int t = bid; t < ntile; t += G) {
        const int kt = t % nkt, ntl = t / nkt, k0 = kt * 64, n0 = ntl * 64;
        { const int nl = tid & 63, kl0 = tid >> 6, n = n0 + nl; const int c = (n < Nd) ? colmap<MAP>(n) : -1;
#pragma unroll
          for (int i = 0; i < 8; ++i) { const int kl = kl0 + 8 * i, k = k0 + kl; float v = 0.f;
              if (c >= 0 && k < K) { v = src[(size_t)k * ld + coff + c]; if (g) v *= g[k]; }
              tile[nl * 72 + kl] = f2bf(v); } }
        __syncthreads();
        { const int nl = tid >> 3, kc = (tid & 7) * 8, n = n0 + nl, k = k0 + kc;
          if (n < Nd && k < Kd) *(u32x4*)(dst + (size_t)n * Kd + k) = *(LAS u32x4*)(tile + nl * 72 + kc); }
        __syncthreads();
    }
}

template <int MAP>
__device__ __forceinline__ void convT_w(const float* src, int ld, int coff, const float* g, bf16_t* dst, int K, int Kd, int Nd, int wslot, int nslots, int lane, int tile_base) {
    const int nkt = K >> 4, nnt = (Nd + 255) >> 8, ntile = nkt * nnt;
    for (int t = ((wslot - tile_base) % nslots + nslots) % nslots; t < ntile; t += nslots) {
        const int kt = t % nkt, ntl = t / nkt, k0 = kt * 16, n = ntl * 256 + lane * 4; const int c = (n < Nd) ? colmap<MAP>(n) : -1;
        const float* sp = src + (size_t)k0 * ld + coff + (c >= 0 ? c : 0);
        f32x4 v[16];
#pragma unroll
        for (int kk = 0; kk < 16; ++kk) { v[kk] = *(const f32x4*)(sp + (size_t)kk * ld); if (g) v[kk] *= g[k0 + kk]; if (c < 0) v[kk] = (f32x4){0.f, 0.f, 0.f, 0.f}; }
        if (n < Nd) {
#pragma unroll
            for (int j = 0; j < 4; ++j) { u32x4 lo, hi;
                lo.x = cvt_pk_bf16(v[0][j], v[1][j]); lo.y = cvt_pk_bf16(v[2][j], v[3][j]); lo.z = cvt_pk_bf16(v[4][j], v[5][j]); lo.w = cvt_pk_bf16(v[6][j], v[7][j]);
                hi.x = cvt_pk_bf16(v[8][j], v[9][j]); hi.y = cvt_pk_bf16(v[10][j], v[11][j]); hi.z = cvt_pk_bf16(v[12][j], v[13][j]); hi.w = cvt_pk_bf16(v[14][j], v[15][j]);
                bf16_t* dp = dst + (size_t)(n + j) * Kd + k0; *(u32x4*)dp = lo; *(u32x4*)(dp + 8) = hi; }
        }
    }
}

template <int K>
__device__ __forceinline__ void wave_gemm(f32x4 (&acc)[4][4], LAS const unsigned char* A, int sA, const bf16_t* Bt, int fr, int fq) {
#pragma unroll
    for (int m = 0; m < 4; ++m)
#pragma unroll
        for (int n = 0; n < 4; ++n) acc[m][n] = (f32x4){0.f, 0.f, 0.f, 0.f};
#pragma unroll
    for (int ks = 0; ks < K / 32; ++ks) { bf16x8 a[4], b[4];
#pragma unroll
        for (int m = 0; m < 4; ++m) a[m] = *(LAS const bf16x8*)(A + (16 * m + fr) * sA + (ks * 32 + fq * 8) * 2);
#pragma unroll
        for (int n = 0; n < 4; ++n) b[n] = *(const bf16x8*)(Bt + (size_t)(16 * n + fr) * K + ks * 32 + fq * 8);
#pragma unroll
        for (int m = 0; m < 4; ++m)
#pragma unroll
            for (int n = 0; n < 4; ++n) acc[m][n] = mfma16(b[n], a[m], acc[m][n]); }
}

template <int K>
__device__ __forceinline__ void row_gemm(f32x4 (&acc)[4], LAS const unsigned char* Arow, const bf16_t* Bt, int fr, int fq) {
    bf16x8 bw[K / 32][4];
#pragma unroll
    for (int ks = 0; ks < K / 32; ++ks)
#pragma unroll
        for (int n = 0; n < 4; ++n) bw[ks][n] = *(const bf16x8*)(Bt + (size_t)(16 * n + fr) * K + ks * 32 + fq * 8);
#pragma unroll
    for (int n = 0; n < 4; ++n) acc[n] = (f32x4){0.f, 0.f, 0.f, 0.f};
#pragma unroll
    for (int ks = 0; ks < K / 32; ++ks) { const bf16x8 a = *(LAS const bf16x8*)(Arow + (ks * 32 + fq * 8) * 2);
#pragma unroll
        for (int n = 0; n < 4; ++n) acc[n] = mfma16(bw[ks][n], a, acc[n]); }
}

struct PrepArgs { const bf16_t* U; const float *mu, *w0, *a0, *kk_, *ka, *rk, *v0; const bf16_t *w2t, *a2t, *g2t, *v1t, *v2t; float* vfirst; float* Wd; float* V; bf16_t* RKKB; bf16_t* Go; float* Bon; int layer; };

__device__ __forceinline__ f32x4 shifted4(const bf16_t* Ut, bool has_prev, int c, const float* mu) {
    const f32x4 u = ld_bf4(Ut + c); f32x4 p = ld_bf4((has_prev ? Ut - 1792 : Ut) + c); const float pm = has_prev ? 1.0f : 0.0f; p = p * pm;
    const f32x4 m = *(const f32x4*)(mu + c); return u + m * (p - u);
}

__device__ __forceinline__ void rwkv_prep_tile(LAS unsigned char* lds, const PrepArgs& P, int tt, int tid) {
    constexpr int SW = 144, SG = 272, SV = 1040, SVV = 80;
    LAS unsigned char* LAw = lds; LAS unsigned char* LAa = lds + 9216; LAS unsigned char* LAg = lds + 18432; LAS unsigned char* LAv = lds + 35840; LAS unsigned char* LAvv = lds + 102400;
    const int t0 = tt * 64; const int s0 = t0 & (SEQ - 1);
    const int lane = tid & 63, wave = __builtin_amdgcn_readfirstlane(tid >> 6), fr = lane & 15, fq = lane >> 4;
    LAS float* PRM = (LAS float*)(lds + 107520);
    { PRM[tid] = P.mu[tid]; PRM[512 + tid] = P.mu[512 + tid]; PRM[1024 + tid] = P.mu[1024 + tid]; PRM[1536 + tid] = P.a0[tid]; PRM[2048 + tid] = P.w0[tid];
      PRM[2560 + tid] = P.kk_[tid]; PRM[3072 + tid] = P.ka[tid]; PRM[3584 + tid] = P.rk[tid]; PRM[4096 + tid] = P.v0[tid]; }
#pragma unroll 2
    for (int e = 0; e < 4; ++e) { const int idx = tid + 512 * e, i = idx >> 5, c = (idx & 31) * 8; const bf16_t* Ut = P.U + (size_t)(t0 + i) * 1792; const bool hp = s0 + i > 0;
        f32x4 x0 = shifted4(Ut, hp, 1536 + c, P.mu), x1 = shifted4(Ut, hp, 1536 + c + 4, P.mu);
        if (c < 64) {
#pragma unroll
            for (int q = 0; q < 4; ++q) { const float ea = __expf(2.f * x0[q]), eb = __expf(2.f * x1[q]); x0[q] = 1.f - 2.f / (ea + 1.f); x1[q] = 1.f - 2.f / (eb + 1.f); } }
        else if (c >= 128) {
#pragma unroll
            for (int q = 0; q < 4; ++q) { x0[q] = sigmoidf_(x0[q]); x1[q] = sigmoidf_(x1[q]); } }
        u32x4 o; o.x = cvt_pk_bf16(x0[0], x0[1]); o.y = cvt_pk_bf16(x0[2], x0[3]); o.z = cvt_pk_bf16(x1[0], x1[1]); o.w = cvt_pk_bf16(x1[2], x1[3]);
        LAS unsigned char* dstp = (c < 64) ? (LAw + i * SW + c * 2) : (c < 128) ? (LAa + i * SW + (c - 64) * 2) : (LAg + i * SG + (c - 128) * 2);
        *(LAS u32x4*)dstp = o; }
    if (P.layer > 0) {
#pragma unroll 2
        for (int e = 0; e < 8; ++e) { const int idx = tid + 512 * e, i = idx >> 6, c = (idx & 63) * 8; const bf16_t* Ut = P.U + (size_t)(t0 + i) * 1792; const bool hp = s0 + i > 0;
            const f32x4 x0 = shifted4(Ut, hp, 1024 + c, P.mu), x1 = shifted4(Ut, hp, 1024 + c + 4, P.mu);
            u32x4 o; o.x = cvt_pk_bf16(x0[0], x0[1]); o.y = cvt_pk_bf16(x0[2], x0[3]); o.z = cvt_pk_bf16(x1[0], x1[1]); o.w = cvt_pk_bf16(x1[2], x1[3]);
            *(LAS u32x4*)(LAv + i * SV + c * 2) = o; }
    }
    __syncthreads();
    if (P.layer > 0) {
        const int mt = wave >> 1, nt = wave & 1; f32x4 acc = (f32x4){0.f, 0.f, 0.f, 0.f};
#pragma unroll 4
        for (int ks = 0; ks < 16; ++ks) { const bf16x8 a = *(LAS const bf16x8*)(LAv + (16 * mt + fr) * SV + (ks * 32 + fq * 8) * 2);
            const bf16x8 b = *(const bf16x8*)(P.v1t + (size_t)(16 * nt + fr) * 512 + ks * 32 + fq * 8); acc = mfma16(b, a, acc); }
        u32x2 w; w.x = cvt_pk_bf16(acc[0], acc[1]); w.y = cvt_pk_bf16(acc[2], acc[3]); *(LAS u32x2*)(LAvv + (16 * mt + fr) * SVV + (16 * nt + 4 * fq) * 2) = w;
    }
    __syncthreads();
    const int h = wave, cb = 64 * h; const int b_ = t0 >> 12, p = b_ * 8 + h;
#pragma unroll 1
    for (int m = 0; m < 4; ++m) {
        const int i = 16 * m + fr; const bf16_t* Ut = P.U + (size_t)(t0 + i) * 1792; const bool hp = (s0 + i) > 0;
        int fq4 = 4 * fq; asm volatile("" : "+v"(fq4));
        u32x2 uk[4], pk[4], ur[4], pr[4], uv[4], pv[4]; f32x4 vf[4];
        { const bf16_t* Up = hp ? Ut - 1792 : Ut; const unsigned pm = hp ? 0xffffffffu : 0u;
#pragma unroll
          for (int n = 0; n < 4; ++n) { const int c = cb + 16 * n + fq4;
              uk[n] = *(const u32x2*)(Ut + 512 + c); ur[n] = *(const u32x2*)(Ut + c); uv[n] = *(const u32x2*)(Ut + 1024 + c);
              pk[n] = *(const u32x2*)(Up + 512 + c); pr[n] = *(const u32x2*)(Up + c); pv[n] = *(const u32x2*)(Up + 1024 + c);
              if (P.layer > 0) vf[n] = *(const f32x4*)(P.vfirst + (size_t)(t0 + i) * 512 + c); }
#pragma unroll
          for (int n = 0; n < 4; ++n) { pk[n].x &= pm; pk[n].y &= pm; pr[n].x &= pm; pr[n].y &= pm; pv[n].x &= pm; pv[n].y &= pm; } }
        f32x4 aa[4], acc[4];
        row_gemm<64>(aa, LAa + i * SW, P.a2t + (size_t)cb * 64, fr, fq);
        row_gemm<64>(acc, LAw + i * SW, P.w2t + (size_t)cb * 64, fr, fq);
#pragma unroll
        for (int n = 0; n < 4; ++n) { const f32x4 a0v = *(LAS const f32x4*)(PRM + 1536 + cb + 16 * n + fq4), w0v = *(LAS const f32x4*)(PRM + 2048 + cb + 16 * n + fq4); f32x4 d;
#pragma unroll
            for (int j = 0; j < 4; ++j) { aa[n][j] = sigmoidf_(aa[n][j] + a0v[j]); d[j] = __expf(-0.6065306597f * sigmoidf_(acc[n][j] + w0v[j])); }
            *(f32x4*)(P.Wd + ((size_t)p * SEQ + s0 + i) * 64 + 16 * n + fq4) = d; }
        row_gemm<128>(acc, LAg + i * SG, P.g2t + (size_t)cb * 128, fr, fq);
#pragma unroll
        for (int n = 0; n < 4; ++n) st_bf4(P.Go + (size_t)(t0 + i) * 512 + cb + 16 * n + fq4, acc[n]);
        if (P.layer > 0) row_gemm<32>(acc, LAvv + i * SVV, P.v2t + (size_t)cb * 32, fr, fq);
        float bon = 0.f, nk = 0.f; f32x4 kv[4], rv[4];
#pragma unroll
        for (int n = 0; n < 4; ++n) { const int c = cb + 16 * n + fq4;
            const f32x4 muv = *(LAS const f32x4*)(PRM + 1024 + c), muk = *(LAS const f32x4*)(PRM + 512 + c), mur = *(LAS const f32x4*)(PRM + c);
            const f32x4 v_u = (f32x4){bflo(uv[n].x), bfhi(uv[n].x), bflo(uv[n].y), bfhi(uv[n].y)}, v_p = (f32x4){bflo(pv[n].x), bfhi(pv[n].x), bflo(pv[n].y), bfhi(pv[n].y)};
            const f32x4 k_u = (f32x4){bflo(uk[n].x), bfhi(uk[n].x), bflo(uk[n].y), bfhi(uk[n].y)}, k_p = (f32x4){bflo(pk[n].x), bfhi(pk[n].x), bflo(pk[n].y), bfhi(pk[n].y)};
            const f32x4 r_u = (f32x4){bflo(ur[n].x), bfhi(ur[n].x), bflo(ur[n].y), bfhi(ur[n].y)}, r_p = (f32x4){bflo(pr[n].x), bfhi(pr[n].x), bflo(pr[n].y), bfhi(pr[n].y)};
            f32x4 v = v_u + muv * (v_p - v_u);
            if (P.layer > 0) { const f32x4 v0v = *(LAS const f32x4*)(PRM + 4096 + c);
#pragma unroll
                for (int j = 0; j < 4; ++j) v[j] = v[j] + (vf[n][j] - v[j]) * sigmoidf_(v0v[j] + acc[n][j]); }
            else *(f32x4*)(P.vfirst + (size_t)(t0 + i) * 512 + c) = v;
            *(f32x4*)(P.V + ((size_t)p * SEQ + s0 + i) * 64 + 16 * n + fq4) = v;
            kv[n] = k_u + muk * (k_p - k_u); rv[n] = r_u + mur * (r_p - r_u);
            const f32x4 kkw = *(LAS const f32x4*)(PRM + 2560 + c);
#pragma unroll
            for (int j = 0; j < 4; ++j) { const float x = kv[n][j] * kkw[j]; nk += x * x; } }
        nk += __shfl_xor(nk, 16); nk += __shfl_xor(nk, 32);
        const float inv = 1.0f / fmaxf(sqrtf(nk), 1e-12f);
        bf16_t* O = P.RKKB + ((size_t)p * SEQ + s0 + i) * 256;
#pragma unroll
        for (int n = 0; n < 4; ++n) { const int c = cb + 16 * n + fq4; const f32x4 kkw = *(LAS const f32x4*)(PRM + 2560 + c), kaw = *(LAS const f32x4*)(PRM + 3072 + c), rkw = *(LAS const f32x4*)(PRM + 3584 + c);
            f32x4 kk, kh, bb;
#pragma unroll
            for (int j = 0; j < 4; ++j) { const float a = aa[n][j]; kk[j] = kv[n][j] * kkw[j] * inv; kh[j] = kv[n][j] * (1.f + (a - 1.f) * kaw[j]); bb[j] = kk[j] * a; bon += rv[n][j] * kh[j] * rkw[j]; }
            const int cc = 16 * n + fq4; st_bf4(O + cc, rv[n]); st_bf4(O + 64 + cc, kh); st_bf4(O + 128 + cc, kk); st_bf4(O + 192 + cc, bb); }
        bon += __shfl_xor(bon, 16); bon += __shfl_xor(bon, 32);
        if (fq == 0) P.Bon[(size_t)(t0 + i) * 8 + h] = bon;
        asm volatile("" ::: "memory");
    }
    __syncthreads();
}

constexpr int SCAN_CH = 32, SCAN_STEP_B = 1344, SCAN_SLOT_B = SCAN_CH * SCAN_STEP_B;
template <int CTRL> __device__ __forceinline__ float dpp_f(float v) { return __int_as_float(__builtin_amdgcn_update_dpp(0, __float_as_int(v), CTRL, 0xf, 0xf, true)); }
__device__ __forceinline__ float row16_sum(float v) { v += dpp_f<0xB1>(v); v += dpp_f<0x4E>(v); v += dpp_f<0x141>(v); v += dpp_f<0x140>(v); return v; }

__device__ __forceinline__ float tr16_sum(const float (&p)[16], int kq) {
    const bool b3 = (kq & 8) != 0, b2 = (kq & 4) != 0, b1 = (kq & 2) != 0, b0 = (kq & 1) != 0;
    float q[8], r[4], u[2];
#pragma unroll
    for (int t = 0; t < 8; ++t) { const float keep = b3 ? p[t + 8] : p[t], send = b3 ? p[t] : p[t + 8]; q[t] = keep + dpp_f<0x140>(send); }
#pragma unroll
    for (int t = 0; t < 4; ++t) { const float keep = b2 ? q[t + 4] : q[t], send = b2 ? q[t] : q[t + 4]; r[t] = keep + dpp_f<0x141>(send); }
#pragma unroll
    for (int t = 0; t < 2; ++t) { const float keep = b1 ? r[t + 2] : r[t], send = b1 ? r[t] : r[t + 2]; u[t] = keep + dpp_f<0x4E>(send); }
    const float keep = b0 ? u[1] : u[0], send = b0 ? u[0] : u[1];
    return keep + dpp_f<0xB1>(send);
}

__device__ __forceinline__ void scan_load_chunk(LAS unsigned char* slot, const float* Wd, const float* V, const bf16_t* RKKB, int p, int rg, int s0, int lt) {
    u32x4 r[7];
    const size_t base = (size_t)p * SEQ + s0;
#pragma unroll
    for (int j = 0; j < 2; ++j) { const int idx = lt + 256 * j, st = idx >> 4, part = idx & 15; r[j] = *(const u32x4*)(Wd + (base + st) * 64 + part * 4); }
#pragma unroll
    for (int j = 2; j < 6; ++j) { const int k = lt + 256 * (j - 2), st = k >> 5, rem = k & 31, q = rem >> 3, part = rem & 7; r[j] = *(const u32x4*)(RKKB + ((base + st) * 4 + q) * 64 + part * 8); }
    if (lt < 128) { const int st = lt >> 2, hf = lt & 3; r[6] = *(const u32x4*)(V + (base + st) * 64 + rg * 16 + hf * 4); }
#pragma unroll
    for (int j = 0; j < 2; ++j) { const int idx = lt + 256 * j, st = idx >> 4, part = idx & 15; *(LAS u32x4*)(slot + st * SCAN_STEP_B + part * 16) = r[j]; }
#pragma unroll
    for (int j = 2; j < 6; ++j) { const int k = lt + 256 * (j - 2), st = k >> 5, rem = k & 31, q = rem >> 3, part = rem & 7; const u32x4 w = r[j];
        const int Q = (q == 0) ? 4 : (q == 1) ? 2 : (q == 2) ? 3 : 1;
        LAS f32x4* d = (LAS f32x4*)(slot + st * SCAN_STEP_B + Q * 256 + part * 32);
        d[0] = (f32x4){bflo(w.x), bfhi(w.x), bflo(w.y), bfhi(w.y)}; d[1] = (f32x4){bflo(w.z), bfhi(w.z), bflo(w.w), bfhi(w.w)}; }
    if (lt < 128) { const int st = lt >> 2, hf = lt & 3; *(LAS u32x4*)(slot + st * SCAN_STEP_B + 1280 + hf * 16) = r[6]; }
}

__device__ __forceinline__ void rwkv_scan_unit(LAS unsigned char* lds, const float* Wd, const float* V, const bf16_t* RKKB, float* Yraw, int p, int rg, int tid) {
    const int lane = tid & 63, wave = __builtin_amdgcn_readfirstlane(tid >> 6);
    constexpr int NCH = SEQ / SCAN_CH;
    scan_load_chunk(lds + (tid >> 8) * SCAN_SLOT_B, Wd, V, RKKB, p, rg, (tid >> 8) * SCAN_CH, tid & 255);
    __syncthreads();
    f32x4 S = (f32x4){0.f, 0.f, 0.f, 0.f};
    const int kq = lane & 15, rl = wave * 4 + (lane >> 4);
    for (int c = 0; c < NCH; ++c) {
        if (wave >= 4) { if (c + 2 < NCH) scan_load_chunk(lds + ((c + 2) % 3) * SCAN_SLOT_B, Wd, V, RKKB, p, rg, (c + 2) * SCAN_CH, tid - 256); }
        else {
            LAS const unsigned char* sl = lds + (c % 3) * SCAN_SLOT_B + kq * 16;
            LAS const unsigned char* vl = lds + (c % 3) * SCAN_SLOT_B + 1280 + rl * 4;
            float* yo = Yraw + ((size_t)p * SEQ + c * SCAN_CH + kq) * 64 + rg * 16 + rl;
            f32x4 w = *(LAS const f32x4*)(sl), b = *(LAS const f32x4*)(sl + 256), k = *(LAS const f32x4*)(sl + 512), kk = *(LAS const f32x4*)(sl + 768), r = *(LAS const f32x4*)(sl + 1024);
            float v = *(LAS const float*)(vl); float yp[16];
#pragma unroll
            for (int st = 0; st < SCAN_CH; ++st) {
                f32x4 wn = w, bn = b, kn = k, kkn = kk, rn = r; float vn = v;
                if (st + 1 < SCAN_CH) { const int o = (st + 1) * SCAN_STEP_B;
                    wn = *(LAS const f32x4*)(sl + o); bn = *(LAS const f32x4*)(sl + o + 256); kn = *(LAS const f32x4*)(sl + o + 512); kkn = *(LAS const f32x4*)(sl + o + 768); rn = *(LAS const f32x4*)(sl + o + 1024);
                    vn = *(LAS const float*)(vl + o); }
                float sa = (S[0] * kk[0] + S[1] * kk[1]) + (S[2] * kk[2] + S[3] * kk[3]);
                const f32x4 kvt = k * v;
                sa = -row16_sum(sa);
                S = S * w + (b * sa + kvt);
                yp[st & 15] = (S[0] * r[0] + S[1] * r[1]) + (S[2] * r[2] + S[3] * r[3]);
                if ((st & 15) == 15) yo[(size_t)(st - 15) * 64] = tr16_sum(yp, kq);
                w = wn; b = bn; k = kn; kk = kkn; r = rn; v = vn;
            }
        }
        __syncthreads();
    }
}

struct GlaArgs { const bf16_t* Ug; const float *conv, *aup, *abias, *gnorm; float* kvcT; float* dec; bf16_t* spT; bf16_t* Yg; };
constexpr int GL_GC = 0;
constexpr int GL_T0 = 16640;
constexpr int GL_VT = GL_T0 + 4 * 9216;
constexpr int GL_AL = GL_VT + 18432;
constexpr int GL_RS = GL_AL + 9216;

__device__ __forceinline__ void gla_conv8(f32x4 (&out)[8], const bf16_t* Ug, const float* conv, int t0, int s0, int i0, int c0) {
    f32x4 w[4];
#pragma unroll
    for (int j = 0; j < 4; ++j) w[j] = *(const f32x4*)(conv + j * 1024 + c0);
    u32x2 raw[8][4];
#pragma unroll
    for (int e = 0; e < 8; ++e)
#pragma unroll
        for (int j = 0; j < 4; ++j) { const int i = i0 + 8 * e, ds = 3 - j; const bool ok = (s0 + i - ds) >= 0; raw[e][j] = *(const u32x2*)(Ug + (size_t)(ok ? t0 + i - ds : t0) * 1792 + c0); }
#pragma unroll
    for (int e = 0; e < 8; ++e) { const int i = i0 + 8 * e; f32x4 a = (f32x4){0.f, 0.f, 0.f, 0.f};
#pragma unroll
        for (int j = 0; j < 4; ++j) { const int ds = 3 - j; const float mk = ((s0 + i - ds) >= 0) ? 1.0f : 0.0f; const u32x2 r = raw[e][j];
            a += (w[j] * mk) * (f32x4){bflo(r.x), bfhi(r.x), bflo(r.y), bfhi(r.y)}; }
#pragma unroll
        for (int q = 0; q < 4; ++q) a[q] = a[q] * sigmoidf_(a[q]);
        out[e] = a; }
}
__device__ __forceinline__ void gla_gcum(LAS unsigned char* lds, const GlaArgs& A, int t0, int h, int tid) {
    LAS float* GC = (LAS float*)(lds + GL_GC);
    { const int d = tid & 63, i0 = tid >> 6; float au[16]; const float ab = A.abias[h * 64 + d];
#pragma unroll
      for (int j = 0; j < 16; ++j) au[j] = A.aup[j * 256 + h * 64 + d];
      u32x4 al0[8], al1[8];
#pragma unroll
      for (int e = 0; e < 8; ++e) { const u32x4* ap = (const u32x4*)(A.Ug + (size_t)(t0 + i0 + 8 * e) * 1792 + 1024); al0[e] = ap[0]; al1[e] = ap[1]; }
#pragma unroll
      for (int e = 0; e < 8; ++e) { const int i = i0 + 8 * e; const u32x4 a0 = al0[e], a1 = al1[e];
          float x = ab;
          x += bflo(a0.x) * au[0] + bfhi(a0.x) * au[1] + bflo(a0.y) * au[2] + bfhi(a0.y) * au[3] + bflo(a0.z) * au[4] + bfhi(a0.z) * au[5] + bflo(a0.w) * au[6] + bfhi(a0.w) * au[7];
          x += bflo(a1.x) * au[8] + bfhi(a1.x) * au[9] + bflo(a1.y) * au[10] + bfhi(a1.y) * au[11] + bflo(a1.z) * au[12] + bfhi(a1.z) * au[13] + bflo(a1.w) * au[14] + bfhi(a1.w) * au[15];
          const float ls = fminf(x, 0.f) - __logf(1.f + __expf(-fabsf(x)));
          GC[i * 65 + d] = ls * (1.0f / 16.0f); } }
    __syncthreads();
    { const int lane = tid & 63, wave = tid >> 6;
#pragma unroll
      for (int dd = 0; dd < 8; ++dd) { const int d = wave * 8 + dd; float x = GC[lane * 65 + d];
#pragma unroll
          for (int o = 1; o < 64; o <<= 1) { const float y = __shfl_up(x, o); if (lane >= o) x += y; }
          GC[lane * 65 + d] = x; } }
    __syncthreads();
}
__device__ __forceinline__ void gla_a_tile(LAS unsigned char* lds, const GlaArgs& A, int tile, int tid) {
    const int bh = tile >> 6, n = tile & 63, b = bh >> 2, h = bh & 3, t0 = b * SEQ + n * 64, s0 = n * 64;
    LAS float* GC = (LAS float*)(lds + GL_GC); LAS bf16_t* KDT = (LAS bf16_t*)(lds + GL_T0); LAS bf16_t* VT = (LAS bf16_t*)(lds + GL_VT);
    gla_gcum(lds, A, t0, h, tid);
    { const int cc = (tid & 63) * 4, i0 = tid >> 6;
      if (cc >= 64) { f32x4 o[8]; const int c0 = (cc < 128) ? 256 + h * 64 + (cc - 64) : 512 + h * 128 + (cc - 128);
          gla_conv8(o, A.Ug, A.conv, t0, s0, i0, c0);
          if (cc < 128) { const int d = cc - 64;
#pragma unroll
              for (int e = 0; e < 8; ++e) { const int i = i0 + 8 * e;
#pragma unroll
                  for (int q = 0; q < 4; ++q) KDT[(d + q) * 72 + i] = f2bf(o[e][q] * __expf(GC[63 * 65 + d + q] - GC[i * 65 + d + q])); } }
          else { const int ev = cc - 128;
#pragma unroll
              for (int e = 0; e < 8; ++e) { const int i = i0 + 8 * e;
#pragma unroll
                  for (int q = 0; q < 4; ++q) VT[(ev + q) * 72 + i] = f2bf(o[e][q]); } } } }
    if (tid < 64) A.dec[((size_t)bh * 64 + n) * 64 + tid] = __expf(GC[63 * 65 + tid]);
    __syncthreads();
    { const int lane = tid & 63, wave = tid >> 6, fr = lane & 15, fq = lane >> 4; f32x4 acc[4];
#pragma unroll
      for (int nt = 0; nt < 4; ++nt) acc[nt] = (f32x4){0.f, 0.f, 0.f, 0.f};
#pragma unroll
      for (int ks = 0; ks < 2; ++ks) { const bf16x8 a = *(LAS const bf16x8*)(VT + (16 * wave + fr) * 72 + ks * 32 + fq * 8);
#pragma unroll
          for (int nt = 0; nt < 4; ++nt) { const bf16x8 bfr = *(LAS const bf16x8*)(KDT + (16 * nt + fr) * 72 + ks * 32 + fq * 8); acc[nt] = mfma16(bfr, a, acc[nt]); } }
#pragma unroll
      for (int nt = 0; nt < 4; ++nt) *(f32x4*)(A.kvcT + (((size_t)bh * 64 + n) * 128 + 16 * wave + fr) * 64 + 16 * nt + 4 * fq) = acc[nt]; }
    __syncthreads();
}
__device__ __forceinline__ void gla_c_tile(LAS unsigned char* lds, const GlaArgs& A, int tile, int tid) {
    const int bh = tile >> 6, n = tile & 63, b = bh >> 2, h = bh & 3, t0 = b * SEQ + n * 64, s0 = n * 64;
    LAS float* GC = (LAS float*)(lds + GL_GC); LAS bf16_t* QG = (LAS bf16_t*)(lds + GL_T0); LAS bf16_t* KG = QG + 64 * 72; LAS bf16_t* QR = KG + 64 * 72; LAS bf16_t* KR = QR + 64 * 72;
    LAS bf16_t* VT = (LAS bf16_t*)(lds + GL_VT); LAS bf16_t* AL = (LAS bf16_t*)(lds + GL_AL); LAS float* RS = (LAS float*)(lds + GL_RS);
    gla_gcum(lds, A, t0, h, tid);
    { const int cc = (tid & 63) * 4, i0 = tid >> 6; f32x4 o[8];
      const int c0 = (cc < 64) ? h * 64 + cc : (cc < 128) ? 256 + h * 64 + (cc - 64) : 512 + h * 128 + (cc - 128);
      gla_conv8(o, A.Ug, A.conv, t0, s0, i0, c0);
      if (cc < 128) { const int d = cc & 63; const bool isq = cc < 64; LAS bf16_t* T1 = isq ? QG : KR; LAS bf16_t* T2 = isq ? QR : KG; const float sc = isq ? 0.125f : 1.0f;
#pragma unroll
          for (int e = 0; e < 8; ++e) { const int i = i0 + 8 * e; f32x4 x1, x2;
#pragma unroll
              for (int q = 0; q < 4; ++q) { const float eg = __expf(GC[i * 65 + d + q]); const float x = o[e][q] * sc; x1[q] = x * eg; x2[q] = x / eg; }
              u32x2 w1, w2; w1.x = cvt_pk_bf16(x1[0], x1[1]); w1.y = cvt_pk_bf16(x1[2], x1[3]); w2.x = cvt_pk_bf16(x2[0], x2[1]); w2.y = cvt_pk_bf16(x2[2], x2[3]);
              *(LAS u32x2*)(T1 + i * 72 + d) = w1; *(LAS u32x2*)(T2 + i * 72 + d) = w2; } }
      else { const int ev = cc - 128;
#pragma unroll
          for (int e = 0; e < 8; ++e) { const int i = i0 + 8 * e;
#pragma unroll
              for (int q = 0; q < 4; ++q) VT[(ev + q) * 72 + i] = f2bf(o[e][q]); } } }
    __syncthreads();
    const int lane = tid & 63, wave = tid >> 6, fr = lane & 15, fq = lane >> 4; const int mt = wave >> 1;
    {
#pragma unroll
        for (int q = 0; q < 2; ++q) { const int nt = (wave & 1) * 2 + q; f32x4 ap = (f32x4){0.f, 0.f, 0.f, 0.f}, af = ap;
#pragma unroll
            for (int ks = 0; ks < 2; ++ks) { const int ko = ks * 32 + fq * 8;
                ap = mfma16(*(LAS const bf16x8*)(KG + (16 * nt + fr) * 72 + ko), *(LAS const bf16x8*)(QG + (16 * mt + fr) * 72 + ko), ap);
                af = mfma16(*(LAS const bf16x8*)(KR + (16 * nt + fr) * 72 + ko), *(LAS const bf16x8*)(QR + (16 * mt + fr) * 72 + ko), af); }
            const int trow = 16 * mt + fr; f32x4 o;
#pragma unroll
            for (int j = 0; j < 4; ++j) { const int scol = 16 * nt + 4 * fq + j; o[j] = (scol <= trow) ? ap[j] : af[j]; }
            u32x2 w; w.x = cvt_pk_bf16(o[0], o[1]); w.y = cvt_pk_bf16(o[2], o[3]); *(LAS u32x2*)(AL + trow * 72 + 16 * nt + 4 * fq) = w; }
    }
    __syncthreads();
    f32x4 acc[4];
#pragma unroll
    for (int q = 0; q < 4; ++q) acc[q] = (f32x4){0.f, 0.f, 0.f, 0.f};
    const bf16_t* sp = A.spT + ((size_t)bh * 64 + n) * 128 * 64;
#pragma unroll
    for (int ks = 0; ks < 2; ++ks) { const int ko = ks * 32 + fq * 8; const bf16x8 a1 = *(LAS const bf16x8*)(AL + (16 * mt + fr) * 72 + ko), a2 = *(LAS const bf16x8*)(QG + (16 * mt + fr) * 72 + ko);
#pragma unroll
        for (int q = 0; q < 4; ++q) { const int nt = (wave & 1) * 4 + q;
            acc[q] = mfma16(*(LAS const bf16x8*)(VT + (16 * nt + fr) * 72 + ko), a1, acc[q]);
            acc[q] = mfma16(*(const bf16x8*)(sp + (size_t)(16 * nt + fr) * 64 + ko), a2, acc[q]); } }
    float ssq = 0.f;
#pragma unroll
    for (int q = 0; q < 4; ++q) ssq += (acc[q][0] * acc[q][0] + acc[q][1] * acc[q][1]) + (acc[q][2] * acc[q][2] + acc[q][3] * acc[q][3]);
    ssq += __shfl_xor(ssq, 16); ssq += __shfl_xor(ssq, 32);
    if (fq == 0) RS[(16 * mt + fr) * 2 + (wave & 1)] = ssq;
    __syncthreads();
    { const int i = 16 * mt + fr; const float rs = rsqrtf((RS[i * 2] + RS[i * 2 + 1]) * (1.0f / 128.0f) + 1e-6f);
#pragma unroll
      for (int q = 0; q < 4; ++q) { const int ecol = h * 128 + ((wave & 1) * 4 + q) * 16 + 4 * fq; const f32x4 nw = *(const f32x4*)(A.gnorm + ecol); const f32x4 go = ld_bf4(A.Ug + (size_t)(t0 + i) * 1792 + 1040 + ecol); f32x4 o;
#pragma unroll
          for (int j = 0; j < 4; ++j) o[j] = acc[q][j] * rs * nw[j] * go[j] * sigmoidf_(go[j]);
          st_bf4(A.Yg + (size_t)(t0 + i) * 512 + ecol, o); } }
    __syncthreads();
}

__device__ __forceinline__ void xa_tile(const bf16_t* Ux, const bf16_t* Kb, const bf16_t* Vt, bf16_t* Yx, int tile, int tid) {
    const int blk = tile & 31, h = (tile >> 5) & 3, b = tile >> 7; const int lane = tid & 63, wave = tid >> 6, fr = lane & 15, fq = lane >> 4;
    const int t = b * SEQ + blk * 128 + 16 * wave + fr;
    bf16x8 qf[4];
#pragma unroll
    for (int ks = 0; ks < 4; ++ks) qf[ks] = *(const bf16x8*)(Ux + (size_t)t * 512 + h * 128 + ks * 32 + fq * 8);
    f32x4 s[16];
#pragma unroll
    for (int nt = 0; nt < 16; ++nt) { s[nt] = (f32x4){0.f, 0.f, 0.f, 0.f}; const bf16_t* kr = Kb + (size_t)(b * 256 + 16 * nt + fr) * 512 + h * 128 + fq * 8;
#pragma unroll
        for (int ks = 0; ks < 4; ++ks) s[nt] = mfma16(*(const bf16x8*)(kr + ks * 32), qf[ks], s[nt]); }
    float mx = -1e30f;
#pragma unroll
    for (int nt = 0; nt < 16; ++nt)
#pragma unroll
        for (int j = 0; j < 4; ++j) mx = fmaxf(mx, s[nt][j]);
    mx = fmaxf(mx, __shfl_xor(mx, 16)); mx = fmaxf(mx, __shfl_xor(mx, 32));
    const float sc = 0.08838834764831845f * 1.4426950408889634f; float l = 0.f;
#pragma unroll
    for (int nt = 0; nt < 16; ++nt)
#pragma unroll
        for (int j = 0; j < 4; ++j) { const float pz = exp2f((s[nt][j] - mx) * sc); s[nt][j] = pz; l += pz; }
    l += __shfl_xor(l, 16); l += __shfl_xor(l, 32);
    f32x4 o[8];
#pragma unroll
    for (int dt = 0; dt < 8; ++dt) o[dt] = (f32x4){0.f, 0.f, 0.f, 0.f};
#pragma unroll
    for (int c = 0; c < 8; ++c) { union { u32x4 u; bf16x8 v; } pf;
        pf.u.x = cvt_pk_bf16(s[2 * c][0], s[2 * c][1]); pf.u.y = cvt_pk_bf16(s[2 * c][2], s[2 * c][3]); pf.u.z = cvt_pk_bf16(s[2 * c + 1][0], s[2 * c + 1][1]); pf.u.w = cvt_pk_bf16(s[2 * c + 1][2], s[2 * c + 1][3]);
#pragma unroll
        for (int dt = 0; dt < 8; ++dt) { const bf16_t* vr = Vt + ((size_t)b * 512 + h * 128 + 16 * dt + fr) * 256 + 32 * c + 4 * fq; union { u32x4 u; bf16x8 v; } vf;
            const u32x2 lo = *(const u32x2*)vr, hi = *(const u32x2*)(vr + 16); vf.u.x = lo.x; vf.u.y = lo.y; vf.u.z = hi.x; vf.u.w = hi.y;
            o[dt] = mfma16(vf.v, pf.v, o[dt]); } }
    const float il = 1.0f / l;
#pragma unroll
    for (int dt = 0; dt < 8; ++dt) st_bf4(Yx + (size_t)t * 512 + h * 128 + 16 * dt + 4 * fq, o[dt] * il);
}

constexpr int XK_STRIDE = 272, XV_STRIDE = 528, XV_OFF = 256 * XK_STRIDE;
__device__ __forceinline__ void xa_pair(LAS unsigned char* lds, const bf16_t* Ux, const bf16_t* Kb, const bf16_t* Vt, bf16_t* Yx, int pair, int tid) {
    const int bh = pair >> 4, b = bh >> 2, h = bh & 3, blk0 = (pair & 15) * 2; const int lane = tid & 63, wave = tid >> 6, fr = lane & 15, fq = lane >> 4;
    u32x4 kst[8], vst[8];
#pragma unroll
    for (int e = 0; e < 8; ++e) { const int ch = tid + 512 * e; const int key = ch >> 4, part = ch & 15, dr = ch >> 5, pv = ch & 31;
        kst[e] = *(const u32x4*)(Kb + (size_t)(b * 256 + key) * 512 + h * 128 + part * 8); vst[e] = *(const u32x4*)(Vt + ((size_t)b * 512 + h * 128 + dr) * 256 + pv * 8); }
#pragma unroll
    for (int e = 0; e < 8; ++e) { const int ch = tid + 512 * e; const int key = ch >> 4, part = ch & 15, dr = ch >> 5, pv = ch & 31;
        *(LAS u32x4*)(lds + key * XK_STRIDE + part * 16) = kst[e]; *(LAS u32x4*)(lds + XV_OFF + dr * XV_STRIDE + pv * 16) = vst[e]; }
    __syncthreads();
#pragma unroll 1
    for (int tq = 0; tq < 2; ++tq) {
        const int t = b * SEQ + (blk0 + tq) * 128 + 16 * wave + fr;
        bf16x8 qf[4];
#pragma unroll
        for (int ks = 0; ks < 4; ++ks) qf[ks] = *(const bf16x8*)(Ux + (size_t)t * 512 + h * 128 + ks * 32 + fq * 8);
        f32x4 s[16];
#pragma unroll
        for (int nt = 0; nt < 16; ++nt) { s[nt] = (f32x4){0.f, 0.f, 0.f, 0.f}; LAS const unsigned char* kr = lds + (16 * nt + fr) * XK_STRIDE + fq * 16;
#pragma unroll
            for (int ks = 0; ks < 4; ++ks) s[nt] = mfma16(*(LAS const bf16x8*)(kr + ks * 64), qf[ks], s[nt]);
            if (nt & 1) asm volatile("" ::: "memory"); }
        float mx = -1e30f;
#pragma unroll
        for (int nt = 0; nt < 16; ++nt)
#pragma unroll
            for (int j = 0; j < 4; ++j) mx = fmaxf(mx, s[nt][j]);
        mx = fmaxf(mx, __shfl_xor(mx, 16)); mx = fmaxf(mx, __shfl_xor(mx, 32));
        const float sc = 0.08838834764831845f * 1.4426950408889634f; float l = 0.f;
#pragma unroll
        for (int nt = 0; nt < 16; ++nt)
#pragma unroll
            for (int j = 0; j < 4; ++j) { const float pz = exp2f((s[nt][j] - mx) * sc); s[nt][j] = pz; l += pz; }
        l += __shfl_xor(l, 16); l += __shfl_xor(l, 32);
        f32x4 o[8];
#pragma unroll
        for (int dt = 0; dt < 8; ++dt) o[dt] = (f32x4){0.f, 0.f, 0.f, 0.f};
#pragma unroll
        for (int c = 0; c < 8; ++c) { union { u32x4 u; bf16x8 v; } pf;
            pf.u.x = cvt_pk_bf16(s[2 * c][0], s[2 * c][1]); pf.u.y = cvt_pk_bf16(s[2 * c][2], s[2 * c][3]); pf.u.z = cvt_pk_bf16(s[2 * c + 1][0], s[2 * c + 1][1]); pf.u.w = cvt_pk_bf16(s[2 * c + 1][2], s[2 * c + 1][3]);
#pragma unroll
            for (int dt = 0; dt < 8; ++dt) { LAS const unsigned char* vr = lds + XV_OFF + (16 * dt + fr) * XV_STRIDE + (32 * c + 4 * fq) * 2; union { u32x4 u; bf16x8 v; } vf;
                const u32x2 lo = *(LAS const u32x2*)vr, hi = *(LAS const u32x2*)(vr + 32); vf.u.x = lo.x; vf.u.y = lo.y; vf.u.z = hi.x; vf.u.w = hi.y;
                o[dt] = mfma16(vf.v, pf.v, o[dt]); }
            asm volatile("" ::: "memory"); }
        const float il = 1.0f / l;
#pragma unroll
        for (int dt = 0; dt < 8; ++dt) st_bf4(Yx + (size_t)t * 512 + h * 128 + 16 * dt + 4 * fq, o[dt] * il);
    }
    __syncthreads();
}

struct Params { const float* in[33]; float* out; unsigned char* ws; };

__device__ __forceinline__ int opaque0() { int z = 0; asm volatile("" : "+s"(z)); return z; }
typedef __attribute__((address_space(1))) unsigned char* gptr_t;
typedef __attribute__((address_space(1))) const float* gcf_t;
__device__ __forceinline__ int opqv(int v) { asm volatile("" : "+v"(v)); return v; }
__device__ __forceinline__ int opqs(int v) { asm volatile("" : "+s"(v)); return v; }
#define PH_BEGIN const int zi = opaque0(); unsigned char* ws = P.ws + zi; float* const OUT = P.out + zi; (void)OUT; const int tid = opqv((int)threadIdx.x); const int bid = opqs((int)blockIdx.x); const int G = opqs((int)gridDim.x); (void)tid; (void)bid; (void)G; unsigned char* WB = ws + WS_WB; float* SS = (float*)(ws + WS_SS); (void)WB; (void)SS; (void)zi;
#define INP(k) (P.in[(k)] + zi)
#define XB_ ((bf16_t*)(ws + WS_XB))
#define U_ (ws + WS_U)
#define SC_ (ws + WS_SC)
#define Y_ ((bf16_t*)(ws + WS_Y))
#define KB_ ((bf16_t*)(ws + WS_KB))
#define VT_ ((bf16_t*)(ws + WS_VT))

constexpr size_t WS_BAR = WS_MISC + 8192;
__device__ __forceinline__ void grid_bar(unsigned* ctr, unsigned target) {
    asm volatile("s_waitcnt vmcnt(0)" ::: "memory");
    __syncthreads();
    if (threadIdx.x == 0) {
        __builtin_amdgcn_fence(__ATOMIC_RELEASE, "agent");
        asm volatile("s_waitcnt vmcnt(0)" ::: "memory");
        __hip_atomic_fetch_add(ctr, 1u, __ATOMIC_RELAXED, __HIP_MEMORY_SCOPE_AGENT);
        while (__hip_atomic_load(ctr, __ATOMIC_RELAXED, __HIP_MEMORY_SCOPE_AGENT) < target) __builtin_amdgcn_s_sleep(2);
        __builtin_amdgcn_fence(__ATOMIC_ACQUIRE, "agent");
        asm volatile("s_waitcnt vmcnt(0)" ::: "memory");
    }
    __syncthreads();
}

#define XB_TMO      128
#define XB_XCNT(j)  (256  + 64 * (j))
#define XB_XSUB(j)  (1280 + 64 * (j))
#define XB_XGEN(j)  (2304 + 64 * (j))
#define XB_TOP      3328
#define XB_TOPGEN   3392
#define XCD_BAR_WORDS 3456
#define XB_SPIN_CAP (1u << 18)
constexpr size_t WS_XBAR2 = WS_MISC + 32768;
constexpr size_t WS_XBAR = WS_MISC + 16384;
__device__ __forceinline__ unsigned xb_ld(unsigned* p)              { return __hip_atomic_load(p, __ATOMIC_RELAXED, __HIP_MEMORY_SCOPE_AGENT); }
__device__ __forceinline__ unsigned xb_add(unsigned* p, unsigned v) { return __hip_atomic_fetch_add(p, v, __ATOMIC_RELAXED, __HIP_MEMORY_SCOPE_AGENT); }
__device__ __forceinline__ unsigned xb_xcc_id() { return (unsigned)__builtin_amdgcn_s_getreg((3 << 11) | 20) & 0xFu; }
#define XB_SPIN(cond, bar) do { unsigned _sp = 0; while (cond) { __builtin_amdgcn_s_sleep(1); \
    if ((++_sp & 255u) == 0u) { if (xb_ld(&(bar)[XB_TMO])) break; if (_sp > XB_SPIN_CAP) { atomicAdd(&(bar)[XB_TMO], 1u); break; } } } } while (0)
__device__ __forceinline__ void xcd_barrier_complete(unsigned* bar, unsigned x, unsigned& nloc, unsigned& nx, const unsigned G) {
    unsigned sum, cnt, mine, sp = 0u;
    for (;;) {
        sum = 0u; cnt = 0u; mine = 0u;
#pragma unroll
        for (unsigned j = 0; j < 16; ++j) { const unsigned c = xb_ld(&bar[XB_XCNT(j)]); sum += c; cnt += (c > 0u) ? 1u : 0u; mine = (j == x) ? c : mine; }
        if (sum == G) break;
        __builtin_amdgcn_s_sleep(1);
        if ((++sp & 255u) == 0u) { if (xb_ld(&bar[XB_TMO])) break; if (sp > XB_SPIN_CAP) { atomicAdd(&bar[XB_TMO], 1u); break; } }
    }
    nloc = mine > 0u ? mine : 1u; nx = cnt > 0u ? cnt : 1u;
}
__device__ __forceinline__ void xcd_barrier(unsigned* bar, volatile LAS unsigned* st, const unsigned total) {
    asm volatile("s_waitcnt vmcnt(0)" ::: "memory");
    __syncthreads();
    if (threadIdx.x == 0) {
        const unsigned x = xb_xcc_id();
        __builtin_amdgcn_s_waitcnt(0);
        unsigned nloc = st[0], nx = st[1];
        if (nloc == 0u) { xcd_barrier_complete(bar, x, nloc, nx, total); st[0] = nloc; st[1] = nx; }
        const unsigned old = xb_add(&bar[XB_XSUB(x)], 1u);
        const unsigned gen = old / nloc;
        if (old + 1u == (gen + 1u) * nloc) {
            __builtin_amdgcn_fence(__ATOMIC_RELEASE, "agent");
            asm volatile("s_waitcnt vmcnt(0)" ::: "memory");
            const unsigned og = xb_add(&bar[XB_TOP], 1u);
            const unsigned tg = og / nx;
            if (og + 1u == (tg + 1u) * nx) xb_add(&bar[XB_TOPGEN], 1u);
            else XB_SPIN(xb_ld(&bar[XB_TOPGEN]) == tg, bar);
            __builtin_amdgcn_fence(__ATOMIC_ACQUIRE, "agent");
            xb_add(&bar[XB_XGEN(x)], 1u);
            asm volatile("s_waitcnt vmcnt(0)" ::: "memory");
        } else {
            XB_SPIN(xb_ld(&bar[XB_XGEN(x)]) == gen, bar);
            __builtin_amdgcn_fence(__ATOMIC_ACQUIRE, "agent");
            asm volatile("s_waitcnt vmcnt(0)" ::: "memory");
        }
    }
    __syncthreads();
}

__global__ void __launch_bounds__(512) mega(Params P) {
    extern __shared__ __attribute__((aligned(16))) unsigned char lds_raw[];
    LAS unsigned char* lds = (LAS unsigned char*)lds_raw;
    cg::grid_group grid = cg::this_grid();
    volatile LAS unsigned* xst = (volatile LAS unsigned*)(lds + LDS_BYTES - 16);
    if (threadIdx.x == 0) { xst[0] = 0u; xst[1] = 0u; xst[2] = 0u; xst[3] = 0u; (void)xb_add(&((unsigned*)(P.ws + WS_XBAR))[XB_XCNT(xb_xcc_id())], 1u);
        if (blockIdx.x >= 128) (void)xb_add(&((unsigned*)(P.ws + WS_XBAR2))[XB_XCNT(xb_xcc_id())], 1u); }
    __syncthreads();

    unsigned nsub = 0;
    for (int ph = 0; ph < NL * 12 + 1; ++ph) {
        const int l = ph / 12, kph = ph - l * 12;
        if (ph == NL * 12) {
#if (PHMASK >> 12) & 1
    { PH_BEGIN
        const int lane = tid & 63, gw = bid * 8 + (tid >> 6), nw = G * 8;
        const float* fn = INP(32); const float* ssf = SS + (size_t)0 * T * 16; float* X = OUT;
        for (int r = gw; r < T; r += nw) { const float rs = row_rstd(ssf, r);
#pragma unroll
            for (int i = 0; i < 4; ++i) { const size_t o = (size_t)r * D + i * 256 + lane * 4; *(f32x4*)(X + o) = *(const f32x4*)(X + o) * rs * *(const f32x4*)(fn + i * 256 + lane * 4); } }
    }
#endif
            break;
        }
        switch (kph) {
        case 0: {
#if (PHMASK >> 0) & 1
        for (int rep = 0; rep < REP0; ++rep) {
        {
            { PH_BEGIN convT_w<1>(INP(3) + (size_t)l * D * 2 * FF, 2 * FF, 0, INP(2) + (size_t)l * D, (bf16_t*)(WB + WB_W1A), D, D, 2 * FF, bid * 8 + (tid >> 6), G * 8, tid & 63, 0); }
            { PH_BEGIN convT_w<0>(INP(4) + (size_t)l * FF * D, D, 0, nullptr, (bf16_t*)(WB + WB_W1B), FF, FF, D, bid * 8 + (tid >> 6), G * 8, tid & 63, 1408); }
            { PH_BEGIN convT_w<2>(INP(7) + (size_t)l * D * 6928, 6928, 0, INP(5) + (size_t)l * D, (bf16_t*)(WB + WB_WIN), D, D, 4096, bid * 8 + (tid >> 6), G * 8, tid & 63, 2112); }
            { PH_BEGIN convT_w<0>(INP(7) + (size_t)l * D * 6928, 6928, 3856, INP(5) + (size_t)l * D, (bf16_t*)(WB + WB_WG), D, D, 3072, bid * 8 + (tid >> 6), G * 8, tid & 63, 3136); }
            for (int j = 0; j < 3; ++j) { PH_BEGIN convT_w<0>(INP(27) + ((size_t)l * 3 + j) * 512 * D, D, 0, nullptr, (bf16_t*)(WB + WB_WBR) + (size_t)j * D * 512, 512, 512, D, bid * 8 + (tid >> 6), G * 8, tid & 63, 3904 + 128 * j); }
            { PH_BEGIN convT_w<0>(INP(28) + (size_t)l * D * D, D, 0, nullptr, (bf16_t*)(WB + WB_WO), D, D, D, bid * 8 + (tid >> 6), G * 8, tid & 63, 4288); }
            { PH_BEGIN convT_w<0>(INP(26) + (size_t)l * D * D, D, 0, INP(6) + (size_t)l * D, (bf16_t*)(WB + WB_WKV), D, D, D, bid * 8 + (tid >> 6), G * 8, tid & 63, 4544); }
            { PH_BEGIN convT_w<1>(INP(30) + (size_t)l * D * 2 * FF, 2 * FF, 0, INP(29) + (size_t)l * D, (bf16_t*)(WB + WB_W2A), D, D, 2 * FF, bid * 8 + (tid >> 6), G * 8, tid & 63, 4800); }
            { PH_BEGIN convT_w<0>(INP(31) + (size_t)l * FF * D, D, 0, nullptr, (bf16_t*)(WB + WB_W2B), FF, FF, D, bid * 8 + (tid >> 6), G * 8, tid & 63, 6208); }
            { PH_BEGIN convT_w<0>(INP(10) + (size_t)l * 64 * 512, 512, 0, nullptr, (bf16_t*)(WB + WB_LW2), 64, 64, 512, bid * 8 + (tid >> 6), G * 8, tid & 63, 6912); }
            { PH_BEGIN convT_w<0>(INP(12) + (size_t)l * 64 * 512, 512, 0, nullptr, (bf16_t*)(WB + WB_LA2), 64, 64, 512, bid * 8 + (tid >> 6), G * 8, tid & 63, 6920); }
            { PH_BEGIN convT_w<0>(INP(13) + (size_t)l * 128 * 512, 512, 0, nullptr, (bf16_t*)(WB + WB_LG2), 128, 128, 512, bid * 8 + (tid >> 6), G * 8, tid & 63, 6928); }
            if (l > 0) {
                { PH_BEGIN convT_w<0>(INP(20) + (size_t)(l - 1) * 512 * 32, 32, 0, nullptr, (bf16_t*)(WB + WB_LV1), 512, 512, 32, bid * 8 + (tid >> 6), G * 8, tid & 63, 6944); }
                { PH_BEGIN convT_w<0>(INP(21) + (size_t)(l - 1) * 32 * 512, 512, 0, nullptr, (bf16_t*)(WB + WB_LV2), 32, 32, 512, bid * 8 + (tid >> 6), G * 8, tid & 63, 6976); }
            }
            if (l == 0) { PH_BEGIN
                const int lane = tid & 63, gw = bid * 8 + (tid >> 6), nw = G * 8;
                float* rstd_mem = (float*)(ws + WS_MISC); bf16_t* MEMN = (bf16_t*)(ws + WS_MEMN);
                for (int r = gw; r < T + 1024; r += nw) {
                    const bool ism = r >= T; const float* src = ism ? INP(1) + (size_t)(r - T) * D : INP(0) + (size_t)r * D; bf16_t* dst = ism ? MEMN + (size_t)(r - T) * D : XB_ + (size_t)r * D; float q = 0.f;
#pragma unroll
                    for (int i = 0; i < 4; ++i) { const f32x4 v = *(const f32x4*)(src + i * 256 + lane * 4); st_bf4(dst + i * 256 + lane * 4, v); q += (v[0] * v[0] + v[1] * v[1]) + (v[2] * v[2] + v[3] * v[3]); }
                    q = wave_sum(q);
                    if (ism) { if (lane == 0) rstd_mem[r - T] = rsqrtf(q * (1.0f / 1024.0f) + 1e-6f); } else if (lane < 16) SS[(size_t)r * 16 + lane] = (lane == 0) ? q : 0.f;
                }
            }
        }
        }
#endif
        } break;
        case 1: {
#if (PHMASK >> 1) & 1
        for (int rep = 0; rep < REPG; ++rep) {
        { PH_BEGIN
            pg8::Gemm g{XB_, (const bf16_t*)(WB + WB_W1A), T, 2 * FF, D, D, D, 0, 0}; pg8::StaticOrder S; S.init(T, 2 * FF, G, bid, 1);
            EpiFFNa E{(bf16_t*)U_, SS + (size_t)0 * T * 16}; pg8::gemm_phase(lds, g, S, E, tid);
        }
        if ((int)blockIdx.x >= (int)gridDim.x - 16) { PH_BEGIN
            pg8::Gemm g2{(const bf16_t*)(ws + WS_MEMN), (const bf16_t*)(WB + WB_WKV), 1024, D, D, D, D, 0, 0}; pg8::StaticOrder S2; S2.init(1024, D, 16, bid - (G - 16), 1);
            EpiKV E2{KB_, VT_, (const float*)(ws + WS_MISC)}; pg8::gemm_phase(lds, g2, S2, E2, tid);
        }
        }
#endif
        } break;
        case 2: {
#if (PHMASK >> 2) & 1
        { PH_BEGIN
            pg8::Gemm g{(const bf16_t*)U_, (const bf16_t*)(WB + WB_W1B), T, D, FF, FF, FF, 0, 0}; pg8::StaticOrder S; S.init(T, D, G, bid, 1);
            EpiRes E{l == 0 ? INP(0) : OUT, OUT, XB_, SS + (size_t)1 * T * 16, 0.5f}; pg8::gemm_phase(lds, g, S, E, tid);
        }
#endif
        } break;
        case 3: {
#if (PHMASK >> 3) & 1
        for (int rep = 0; rep < REPG; ++rep) {
        { PH_BEGIN
            pg8::Gemm g{XB_, (const bf16_t*)(WB + WB_WIN), T, 4096, D, D, D, 0, 0}; pg8::StaticOrder S; S.init(T, 4096, G, bid, 1);
            EpiU E{(bf16_t*)U_, SS + (size_t)1 * T * 16}; pg8::gemm_phase(lds, g, S, E, tid);
        }
        }
#endif
        } break;
        case 4: {
#if (PHMASK >> 4) & 1
        { PH_BEGIN
            PrepArgs PA; PA.U = (const bf16_t*)(U_ + U_RWKV); PA.mu = INP(8) + (size_t)l * 1792; PA.w0 = INP(9) + (size_t)l * 512; PA.a0 = INP(11) + (size_t)l * 512;
            PA.kk_ = INP(14) + (size_t)l * 512; PA.ka = INP(15) + (size_t)l * 512; PA.rk = INP(16) + (size_t)l * 512; PA.v0 = INP(19) + (size_t)(l > 0 ? l - 1 : 0) * 512;
            PA.w2t = (const bf16_t*)(WB + WB_LW2); PA.a2t = (const bf16_t*)(WB + WB_LA2); PA.g2t = (const bf16_t*)(WB + WB_LG2); PA.v1t = (const bf16_t*)(WB + WB_LV1); PA.v2t = (const bf16_t*)(WB + WB_LV2);
            PA.vfirst = (float*)(ws + WS_VF); PA.Wd = (float*)(SC_ + SC_WD); PA.V = (float*)(SC_ + SC_V); PA.RKKB = (bf16_t*)(SC_ + SC_RKKB); PA.Go = (bf16_t*)(ws + WS_GO); PA.Bon = (float*)(ws + WS_BON); PA.layer = l;
            { const int tt = (bid & 7) * 32 + (bid >> 3); rwkv_prep_tile(lds, PA, tt, tid); }
        }
        { PH_BEGIN
            { const int x = bid & 7, j = bid >> 3, pm = 8 * x + (j & 7), h = j >> 3, b = pm >> 4, pq = pm & 15; const int pair = ((b * 4 + h) << 4) | pq;
              xa_pair(lds, (const bf16_t*)(U_ + U_XA), KB_, VT_, Y_ + (size_t)2 * T * 512, pair, tid); }
        }
        { PH_BEGIN
            GlaArgs GA; GA.Ug = (const bf16_t*)(U_ + U_GLA); GA.conv = INP(22) + (size_t)l * 4096; GA.aup = INP(23) + (size_t)l * 4096; GA.abias = INP(24) + (size_t)l * 256; GA.gnorm = INP(25) + (size_t)l * 512;
            GA.kvcT = (float*)(ws + WS_KVC); GA.dec = (float*)(ws + WS_DEC); GA.spT = (bf16_t*)(U_ + U_SPT); GA.Yg = Y_ + (size_t)T * 512;
            { const int x = bid & 7, j = bid >> 3, b = x >> 1, nhi = x & 1;
              for (int k = 0; k < 2; ++k) { const int idx = j * 2 + k, h = idx >> 5, n = nhi * 32 + (idx & 31); gla_a_tile(lds, GA, ((b * 4 + h) << 6) | n, tid); } }
        }
#endif
        } break;
        case 5: {
#if (PHMASK >> 5) & 1
        if ((int)blockIdx.x < 128) { PH_BEGIN
            const int xcd = bid & 7, j = bid >> 3, p = xcd * 4 + (j >> 2), rg = j & 3;
            rwkv_scan_unit(lds, (const float*)(SC_ + SC_WD), (const float*)(SC_ + SC_V), (const bf16_t*)(SC_ + SC_RKKB), (float*)(U_ + U_YRAW), p, rg, tid);
        } else {
            { PH_BEGIN
            GlaArgs GA; GA.Ug = (const bf16_t*)(U_ + U_GLA); GA.conv = INP(22) + (size_t)l * 4096; GA.aup = INP(23) + (size_t)l * 4096; GA.abias = INP(24) + (size_t)l * 256; GA.gnorm = INP(25) + (size_t)l * 512;
            GA.kvcT = (float*)(ws + WS_KVC); GA.dec = (float*)(ws + WS_DEC); GA.spT = (bf16_t*)(U_ + U_SPT); GA.Yg = Y_ + (size_t)T * 512;
            { const int x = bid & 7, j = (bid - 128) >> 3, b = x >> 1, nhi = x & 1;
              for (int k = 0; k < 4; ++k) { const int idx = j * 4 + k, h = 2 + (idx >> 5), n = nhi * 32 + (idx & 31); gla_a_tile(lds, GA, ((b * 4 + h) << 6) | n, tid); } }
            }
            xcd_barrier((unsigned*)(P.ws + WS_XBAR2), xst + 2, 128u);
            { PH_BEGIN
            bf16_t* spT = (bf16_t*)(U_ + U_SPT); const float* DEC = (const float*)(ws + WS_DEC); const float* KVC = (const float*)(ws + WS_KVC);
            for (int i = (bid - 128) * 512 + tid; i < 16 * 128 * 64; i += 128 * 512) { const int bh = i >> 13, ed = i & 8191, d = i & 63; float st = 0.f;
                for (int n0 = 0; n0 < 64; n0 += 16) { float kv[16], dc[16];
#pragma unroll
                    for (int q = 0; q < 16; ++q) { kv[q] = KVC[((size_t)bh * 64 + n0 + q) * 8192 + ed]; dc[q] = DEC[((size_t)bh * 64 + n0 + q) * 64 + d]; }
#pragma unroll
                    for (int q = 0; q < 16; ++q) { spT[((size_t)bh * 64 + n0 + q) * 8192 + ed] = f2bf(st); st = st * dc[q] + kv[q]; } } }
            }
            xcd_barrier((unsigned*)(P.ws + WS_XBAR2), xst + 2, 128u);
            { PH_BEGIN
            GlaArgs GA; GA.Ug = (const bf16_t*)(U_ + U_GLA); GA.conv = INP(22) + (size_t)l * 4096; GA.aup = INP(23) + (size_t)l * 4096; GA.abias = INP(24) + (size_t)l * 256; GA.gnorm = INP(25) + (size_t)l * 512;
            GA.kvcT = (float*)(ws + WS_KVC); GA.dec = (float*)(ws + WS_DEC); GA.spT = (bf16_t*)(U_ + U_SPT); GA.Yg = Y_ + (size_t)T * 512;
            { const int x = bid & 7, j = (bid - 128) >> 3, b = x >> 1, nhi = x & 1;
              for (int k = 0; k < 8; ++k) { const int idx = j * 8 + k, h = idx >> 5, n = nhi * 32 + (idx & 31); gla_c_tile(lds, GA, ((b * 4 + h) << 6) | n, tid); } }
            }
        }
#endif
        } break;
        case 6: {
#if (PHMASK >> 6) & 1
        { PH_BEGIN
            const int lane = tid & 63, gw = bid * 8 + (tid >> 6), nw = G * 8;
            const float* lnw = INP(17) + (size_t)l * 512; const float* lnb = INP(18) + (size_t)l * 512; const float* Yraw = (const float*)(U_ + U_YRAW); const float* Vv = (const float*)(SC_ + SC_V);
            const float* BON = (const float*)(ws + WS_BON); const bf16_t* GO = (const bf16_t*)(ws + WS_GO); bf16_t* Y = Y_;
            const int kq = lane & 15, sub = lane >> 4;
#pragma unroll 4
            for (int it0 = gw * 4; it0 < 32 * SEQ; it0 += nw * 4) { const int it = it0 + sub; const int p = it >> 12, s = it & (SEQ - 1), b = p >> 3, h = p & 7, t = b * SEQ + s;
                const f32x4 y = *(const f32x4*)(Yraw + (size_t)it * 64 + kq * 4); const f32x4 vv = *(const f32x4*)(Vv + (size_t)it * 64 + kq * 4);
                const f32x4 gg = ld_bf4(GO + (size_t)t * 512 + h * 64 + kq * 4); const f32x4 lw = *(const f32x4*)(lnw + h * 64 + kq * 4), lb = *(const f32x4*)(lnb + h * 64 + kq * 4); const float bon = BON[(size_t)t * 8 + h];
                const float mean = row16_sum((y[0] + y[1]) + (y[2] + y[3])) * (1.0f / 64.0f); const f32x4 dl = y - mean;
                const float var = row16_sum((dl[0] * dl[0] + dl[1] * dl[1]) + (dl[2] * dl[2] + dl[3] * dl[3])) * (1.0f / 64.0f); const float rs = rsqrtf(var + 64e-5f);
                st_bf4(Y + (size_t)t * 512 + h * 64 + kq * 4, ((dl * rs) * lw + lb + vv * bon) * gg); }
        }
#endif
        } break;
        case 7: {
#if (PHMASK >> 7) & 1
        for (int rep = 0; rep < REPG; ++rep) {
        { PH_BEGIN
            pg8::Gemm g{XB_, (const bf16_t*)(WB + WB_WG), T, 3072, D, D, D, 0, 0}; pg8::StaticOrder S; S.init(T, 3072, G, bid, 1);
            EpiGate E{(unsigned char*)SC_, SS + (size_t)1 * T * 16}; pg8::gemm_phase(lds, g, S, E, tid);
        }
        }
#endif
        } break;
        case 8: {
#if (PHMASK >> 8) & 1
        for (int rep = 0; rep < REPG; ++rep) {
        { PH_BEGIN
            pg8::Gemm g{Y_, (const bf16_t*)(WB + WB_WBR), T, D, 512, 512, 512, (unsigned)T * 512u * 2u, (unsigned)D * 512u * 2u}; pg8::StaticOrder S; S.init(T, D, G, bid, 3);
            EpiMerge E{(const unsigned char*)SC_, (float*)(U_ + U_MG), (bf16_t*)(U_ + U_MGB)}; pg8::gemm_phase(lds, g, S, E, tid);
        }
        }
#endif
        } break;
        case 9: {
#if (PHMASK >> 9) & 1
        { PH_BEGIN
            pg8::Gemm g{(const bf16_t*)(U_ + U_MGB), (const bf16_t*)(WB + WB_WO), T, D, D, D, D, 0, 0}; pg8::StaticOrder S; S.init(T, D, G, bid, 1);
            EpiRes E{OUT, OUT, XB_, SS + (size_t)2 * T * 16, 1.0f}; pg8::gemm_phase(lds, g, S, E, tid);
        }
#endif
        } break;
        case 10: {
#if (PHMASK >> 10) & 1
        for (int rep = 0; rep < REPG; ++rep) {
        { PH_BEGIN
            pg8::Gemm g{XB_, (const bf16_t*)(WB + WB_W2A), T, 2 * FF, D, D, D, 0, 0}; pg8::StaticOrder S; S.init(T, 2 * FF, G, bid, 1);
            EpiFFNa E{(bf16_t*)U_, SS + (size_t)2 * T * 16}; pg8::gemm_phase(lds, g, S, E, tid);
        }
        }
#endif
        } break;
        case 11: {
#if (PHMASK >> 11) & 1
        { PH_BEGIN
            pg8::Gemm g{(const bf16_t*)U_, (const bf16_t*)(WB + WB_W2B), T, D, FF, FF, FF, 0, 0}; pg8::StaticOrder S; S.init(T, D, G, bid, 1);
            EpiRes E{OUT, OUT, XB_, SS + (size_t)0 * T * 16, 0.5f}; pg8::gemm_phase(lds, g, S, E, tid);
        }
#endif
        } break;
        default: break;
        }
        if (ph == 0) grid.sync();
        else xcd_barrier((unsigned*)(P.ws + WS_XBAR), xst, gridDim.x);
    }
}

extern "C" void kernel_launch(void* const* d_in, const int* in_sizes, int n_in, void* d_out, int out_size, void* d_ws, size_t ws_size, hipStream_t stream) {
    static int grid_blocks = 0;
    if (!grid_blocks) {
        if (n_in != 33 || ws_size < WS_END) { fprintf(stderr, "kernel_launch: need 33 inputs and %zu bytes of workspace (got %d, %zu)\n", (size_t)WS_END, n_in, ws_size); grid_blocks = -1; return; }
        int dev = 0, cus = 0, per_cu = 0;
        hipGetDevice(&dev); hipDeviceGetAttribute(&cus, hipDeviceAttributeMultiprocessorCount, dev);
        if (hipFuncSetAttribute((const void*)mega, hipFuncAttributeMaxDynamicSharedMemorySize, LDS_BYTES) != hipSuccess) { fprintf(stderr, "kernel_launch: hipFuncSetAttribute failed\n"); grid_blocks = -1; return; }
        if (hipOccupancyMaxActiveBlocksPerMultiprocessor(&per_cu, (const void*)mega, 512, LDS_BYTES) != hipSuccess || per_cu < 1) { fprintf(stderr, "kernel_launch: occupancy query says %d\n", per_cu); per_cu = 1; }
        (void)hipGetLastError();
        grid_blocks = cus * per_cu;
        if (grid_blocks != 256) { fprintf(stderr, "kernel_launch: this kernel splits a 256-workgroup grid in its scan phase (got %d)\n", grid_blocks); grid_blocks = -1; return; }
    }
    if (grid_blocks < 0) return;
    if (hipMemsetAsync((char*)d_ws + WS_BAR, 0, (WS_XBAR2 - WS_BAR) + XCD_BAR_WORDS * 4, stream) != hipSuccess) { fprintf(stderr, "kernel_launch: memset failed\n"); return; }
    Params p{};
    for (int i = 0; i < 33; ++i) p.in[i] = (const float*)d_in[i];
    p.out = (float*)d_out; p.ws = (unsigned char*)d_ws;
    void* args[] = {&p};
    hipError_t e = hipLaunchCooperativeKernel((const void*)mega, dim3(grid_blocks), dim3(512), args, LDS_BYTES, stream);
    if (e != hipSuccess) fprintf(stderr, "cooperative launch failed: %s (grid %d)\n", hipGetErrorString(e), grid_blocks);
}
```

```cpp
#include <hip/hip_runtime.h>
#include <hip/hip_cooperative_groups.h>
#include <cstdio>
namespace cg = cooperative_groups;
#ifndef P4SUB
#define P4SUB 7
#endif
#ifndef REP5
#define REP5 1
#endif
#ifndef REP4
#define REP4 1
#endif
#ifndef REP6
#define REP6 1
#endif
#ifndef REP0
#define REP0 1
#endif
#ifndef REPG
#define REPG 1
#endif
#ifndef REPSYNC
#define REPSYNC 1
#endif
#ifndef NA4
#define NA4 2
#endif
#ifndef PHMASK
#define PHMASK 0xFFFF
#endif

#define LAS __attribute__((address_space(3)))
typedef unsigned short bf16_t;
typedef short bf16x8 __attribute__((ext_vector_type(8)));
typedef float f32x4 __attribute__((ext_vector_type(4)));
typedef float f32x2 __attribute__((ext_vector_type(2)));
typedef unsigned u32x4 __attribute__((ext_vector_type(4)));
typedef unsigned u32x2 __attribute__((ext_vector_type(2)));

constexpr int T = 16384, D = 1024, FF = 2816, SEQ = 4096, NL = 4;
constexpr int LDS_BYTES = 139264;

constexpr size_t MB = 1024 * 1024;
constexpr size_t WS_MISC = 0;
constexpr size_t WS_SS = 1 * MB;
constexpr size_t WS_WB = 4 * MB;
constexpr size_t WB_W1A = 0;
constexpr size_t WB_W1B = WB_W1A + (size_t)5632 * 1024 * 2;
constexpr size_t WB_WIN = WB_W1B + (size_t)1024 * 2816 * 2;
constexpr size_t WB_WG = WB_WIN + (size_t)4096 * 1024 * 2;
constexpr size_t WB_WBR = WB_WG + (size_t)3072 * 1024 * 2;
constexpr size_t WB_WO = WB_WBR + (size_t)3 * 1024 * 512 * 2;
constexpr size_t WB_WKV = WB_WO + (size_t)1024 * 1024 * 2;
constexpr size_t WB_W2A = WB_WKV + (size_t)1024 * 1024 * 2;
constexpr size_t WB_W2B = WB_W2A + (size_t)5632 * 1024 * 2;
constexpr size_t WB_LW2 = WB_W2B + (size_t)1024 * 2816 * 2;
constexpr size_t WB_LA2 = WB_LW2 + 512 * 64 * 2;
constexpr size_t WB_LG2 = WB_LA2 + 512 * 64 * 2;
constexpr size_t WB_LV1 = WB_LG2 + 512 * 128 * 2;
constexpr size_t WB_LV2 = WB_LV1 + 32 * 512 * 2;
constexpr size_t WB_END = WB_LV2 + 512 * 32 * 2;
static_assert(WB_END <= 55 * MB, "weights region");
constexpr size_t WS_XB = WS_WB + 55 * MB;
constexpr size_t WS_VF = WS_XB + 32 * MB;
constexpr size_t WS_MEMN = WS_VF + 32 * MB;
constexpr size_t WS_KB = WS_MEMN + 2 * MB;
constexpr size_t WS_VT = WS_KB + 1 * MB;
constexpr size_t WS_GO = WS_VT + 1 * MB;
constexpr size_t WS_BON = WS_GO + 16 * MB;
constexpr size_t WS_Y = WS_BON + 1 * MB;
constexpr size_t WS_KVC = WS_Y + 48 * MB;
constexpr size_t WS_DEC = WS_KVC + 32 * MB;
constexpr size_t WS_SC = WS_DEC + 1 * MB;
constexpr size_t SC_WD = 0;
constexpr size_t SC_V = 32 * MB;
constexpr size_t SC_RKKB = 64 * MB;
constexpr size_t WS_U = WS_SC + 128 * MB;
constexpr size_t U_RWKV = 0;
constexpr size_t U_GLA = (size_t)T * 1792 * 2;
constexpr size_t U_XA = 2 * (size_t)T * 1792 * 2;
constexpr size_t U_YRAW = 0;
constexpr size_t U_SPT = 32 * MB;
constexpr size_t U_MG = 0;
constexpr size_t U_MGB = 64 * MB;
constexpr size_t WS_END = WS_U + 128 * MB;
static_assert(U_XA + (size_t)T * 512 * 2 <= 128 * MB, "U region");

typedef __bf16 bf16x2_t __attribute__((ext_vector_type(2)));
__device__ __forceinline__ unsigned cvt_pk_bf16(float lo, float hi) { const f32x2 v = {lo, hi}; const bf16x2_t r = __builtin_convertvector(v, bf16x2_t); return __builtin_bit_cast(unsigned, r); }
__device__ __forceinline__ bf16_t f2bf(float x) { return (bf16_t)(cvt_pk_bf16(x, 0.f) & 0xffffu); }
__device__ __forceinline__ float bf2f(bf16_t b) { return __uint_as_float(((unsigned)b) << 16); }
__device__ __forceinline__ float bflo(unsigned w) { return __uint_as_float(w << 16); }
__device__ __forceinline__ float bfhi(unsigned w) { return __uint_as_float(w & 0xffff0000u); }
__device__ __forceinline__ f32x4 ld_bf4(const bf16_t* p) { const u32x2 w = *(const u32x2*)p; return (f32x4){bflo(w.x), bfhi(w.x), bflo(w.y), bfhi(w.y)}; }
__device__ __forceinline__ void st_bf4(bf16_t* p, f32x4 v) { u32x2 w; w.x = cvt_pk_bf16(v[0], v[1]); w.y = cvt_pk_bf16(v[2], v[3]); *(u32x2*)p = w; }
__device__ __forceinline__ float sigmoidf_(float x) { return __builtin_amdgcn_rcpf(1.0f + __expf(-x)); }
__device__ __forceinline__ float wave_sum(float v) { for (int o = 32; o >= 1; o >>= 1) v += __shfl_xor(v, o); return v; }
__device__ __forceinline__ f32x4 mfma16(bf16x8 a, bf16x8 b, f32x4 c) { return __builtin_amdgcn_mfma_f32_16x16x32_bf16(a, b, c, 0, 0, 0); }

__device__ __forceinline__ float row_rstd(const float* ssp, int row) {
    const f32x4* p = (const f32x4*)(ssp + (size_t)row * 16); const f32x4 a = p[0], b = p[1], c = p[2], d = p[3];
    const float t = (((a[0] + a[1]) + (a[2] + a[3])) + ((b[0] + b[1]) + (b[2] + b[3]))) + (((c[0] + c[1]) + (c[2] + c[3])) + ((d[0] + d[1]) + (d[2] + d[3])));
    return rsqrtf(t * (1.0f / 1024.0f) + 1e-6f);
}
__device__ __forceinline__ void rstd8(float (&rs)[2][4], const float* ssp, int row0, int fq) {
    f32x4 p[2][4];
#pragma unroll
    for (int ai = 0; ai < 2; ++ai)
#pragma unroll
        for (int m = 0; m < 4; ++m) p[ai][m] = *(const f32x4*)(ssp + (size_t)(row0 + ai * 128 + m * 16) * 16 + fq * 4);
#pragma unroll
    for (int ai = 0; ai < 2; ++ai)
#pragma unroll
        for (int m = 0; m < 4; ++m) { float t = (p[ai][m][0] + p[ai][m][1]) + (p[ai][m][2] + p[ai][m][3]); t += __shfl_xor(t, 16); t += __shfl_xor(t, 32); rs[ai][m] = rsqrtf(t * (1.0f / 1024.0f) + 1e-6f); }
}
namespace pg8 {
constexpr int BM = 256, BK = 64, HALF = 128, HTB = HALF * BK * 2, STAGE_BYTES = 8 * HTB, NXCD = 8, WGM = 8;
__device__ __forceinline__ int lds_byte(int r, int c) { const int st = (r >> 4) * 2 + (c >> 5), rr = r & 15, cc = c & 31, ob = rr * 64 + cc * 2; return st * 1024 + (ob ^ (((ob >> 9) & 1) << 5)); }
__device__ __forceinline__ void stage_rc(int b, int& R, int& C) { const int st = b / 1024, sb = b % 1024, swz = sb ^ (((sb >> 9) & 1) << 5); R = (st >> 1) * 16 + swz / 64; C = (st & 1) * 32 + (swz % 64) / 2; }
__device__ __forceinline__ int perm32(int rho) { const int n = rho >> 4, i = rho & 15; return 8 * (i >> 2) + 4 * n + (i & 3); }

struct Unit { int pm, pn, z; };
struct Gemm { const bf16_t* A; const bf16_t* Bt; int M, N, K, lda, ldb; unsigned zA, zB; };

struct StaticOrder {
    int nM, nN, nwg, G, c, nz;
    __device__ void init(int M, int N, int G_, int c_, int nz_) { nM = M / BM; nN = N / BM; nwg = nM * nN; G = G_; c = c_; nz = nz_; }
    __device__ bool next(int i, Unit& u) const {
        const int ti = i / nz; u.z = i - ti * nz;
        const long L = (long)ti * G + c; if (L >= nwg) return false;
        int wgid = (int)L; { const int q = nwg / NXCD, r = nwg % NXCD, xcd = wgid % NXCD, off = wgid / NXCD; wgid = (xcd < r ? xcd * (q + 1) : r * (q + 1) + (xcd - r) * q) + off; }
        const int nig = WGM * nN, gid = wgid / nig, fm = gid * WGM, gsz = (nM - fm) < WGM ? (nM - fm) : WGM;
        u.pm = fm + ((wgid % nig) % gsz); u.pn = (wgid % nig) / gsz; return true;
    }
};

template <class Epi>
__device__ __forceinline__ void gemm_phase(LAS unsigned char* lds, const Gemm g, const StaticOrder& S, const Epi& E, const int tid) {
    const int wid = __builtin_amdgcn_readfirstlane(tid >> 6), lane = tid & 63, wr = wid >> 2, wc = wid & 3, fr = lane & 15, fq = lane >> 4;
    const int K = g.K, nt = K / BK;
    unsigned voffA[2], voffB[2];
#pragma unroll
    for (int i = 0; i < 2; ++i) { int R, C; stage_rc(tid * 16 + i * 8192, R, C); const int Rb = Epi::PERM ? ((R & ~31) + perm32(R & 31)) : R;
        voffA[i] = (unsigned)(R * g.lda + C) * 2u; voffB[i] = (unsigned)(Rb * g.ldb + C) * 2u; }
    const unsigned kstep = (unsigned)(BK * 2);
    const unsigned hstepA = (unsigned)HALF * g.lda * 2u, hstepB = (unsigned)HALF * g.ldb * 2u;
    const unsigned tstepA = 2u * hstepA, tstepB = 2u * hstepB;
    const unsigned ldsw = (unsigned)wid * 1024u;
    const int aoff = lds_byte(wr * 64 + fr, fq * 8), boff = lds_byte(wc * 32 + fr, fq * 8);
    const char* const gA = (const char*)g.A; const char* const gB = (const char*)g.Bt;
#define PG8_SA(b, h) (((b) * 2 + (h)) * HTB)
#define PG8_SB(b, h) ((4 + (b) * 2 + (h)) * HTB)
#define PG8_STAGE(bufoff, gbase, soff, voff) do { _Pragma("unroll") for (int _i = 0; _i < 2; ++_i) \
        __builtin_amdgcn_global_load_lds((const unsigned*)(((gbase) + (size_t)(unsigned)(soff)) + (voff)[_i]), (LAS unsigned*)(lds + (bufoff) + ldsw + _i * 8192), 16, 0, 0); } while (0)
#define PG8_LDA(dst, b, h) do { _Pragma("unroll") for (int m = 0; m < 4; ++m) _Pragma("unroll") for (int k = 0; k < 2; ++k) dst[m][k] = *(const LAS bf16x8*)(lds + PG8_SA(b, h) + aoff + m * 2048 + k * 1024); } while (0)
#define PG8_LDB(dst, b, h) do { _Pragma("unroll") for (int n = 0; n < 2; ++n) _Pragma("unroll") for (int k = 0; k < 2; ++k) dst[n][k] = *(const LAS bf16x8*)(lds + PG8_SB(b, h) + boff + n * 2048 + k * 1024); } while (0)
#define PG8_MMA(ai, bj, At, Bt) do { __builtin_amdgcn_s_setprio(1); _Pragma("unroll") for (int m = 0; m < 4; ++m) _Pragma("unroll") for (int n = 0; n < 2; ++n) _Pragma("unroll") for (int k = 0; k < 2; ++k) \
        acc[ai][bj][m][n] = __builtin_amdgcn_mfma_f32_16x16x32_bf16(Bt[n][k], At[m][k], acc[ai][bj][m][n], 0, 0, 0); __builtin_amdgcn_s_setprio(0); } while (0)
#define PG8_WAIT_V(n) asm volatile("s_waitcnt vmcnt(" #n ")" ::: "memory")
#define PG8_WAIT_L(n) asm volatile("s_waitcnt lgkmcnt(" #n ")" ::: "memory")
#define PG8_BAR __builtin_amdgcn_s_barrier()
#define PG8_SCHED __builtin_amdgcn_sched_barrier(0)
    Unit cur, nxt; int ui = 0;
    if (!S.next(0, cur)) return;
    f32x4 acc[2][2][4][2];
#pragma unroll
    for (int a = 0; a < 2; ++a)
#pragma unroll
        for (int b = 0; b < 2; ++b)
#pragma unroll
            for (int m = 0; m < 4; ++m)
#pragma unroll
                for (int n = 0; n < 2; ++n) acc[a][b][m][n] = (f32x4){0.f, 0.f, 0.f, 0.f};
    bf16x8 At[4][2], B0[2][2], B1[2][2];
    unsigned cA = (unsigned)cur.z * g.zA + (unsigned)cur.pm * tstepA, cB = (unsigned)cur.z * g.zB + (unsigned)cur.pn * tstepB;
    PG8_STAGE(PG8_SB(0, 0), gB, cB, voffB); PG8_STAGE(PG8_SA(0, 0), gA, cA, voffA); PG8_STAGE(PG8_SB(0, 1), gB, cB + hstepB, voffB); PG8_STAGE(PG8_SA(0, 1), gA, cA + hstepA, voffA);
    if (wr == 1) PG8_BAR;
    PG8_WAIT_V(4); PG8_BAR;
    PG8_STAGE(PG8_SB(1, 0), gB, cB + kstep, voffB); PG8_STAGE(PG8_SA(1, 0), gA, cA + kstep, voffA); PG8_STAGE(PG8_SB(1, 1), gB, cB + hstepB + kstep, voffB);
    PG8_WAIT_V(6); PG8_BAR;
    for (;;) {
        const bool has_next = S.next(ui + 1, nxt);
        const unsigned nA = has_next ? (unsigned)nxt.z * g.zA + (unsigned)nxt.pm * tstepA : cA, nB = has_next ? (unsigned)nxt.z * g.zB + (unsigned)nxt.pn * tstepB : cB;
        for (int t = 0; t < nt; t += 2) {
            const bool last = (t == nt - 2);
            const unsigned a1 = cA + (unsigned)(t + 1) * kstep;
            const unsigned a2 = last ? nA : cA + (unsigned)(t + 2) * kstep, b2 = last ? nB : cB + (unsigned)(t + 2) * kstep;
            const unsigned a3 = a2 + kstep, b3 = b2 + kstep;
            PG8_LDB(B0, 0, 0); PG8_SCHED; PG8_LDA(At, 0, 0); PG8_STAGE(PG8_SA(1, 1), gA, a1 + hstepA, voffA);
            PG8_WAIT_L(8); PG8_BAR; PG8_WAIT_L(0); PG8_MMA(0, 0, At, B0); PG8_BAR; PG8_SCHED;
            PG8_LDB(B1, 0, 1); PG8_STAGE(PG8_SB(0, 0), gB, b2, voffB);
            PG8_BAR; PG8_WAIT_L(0); PG8_MMA(0, 1, At, B1); PG8_BAR;
            PG8_LDA(At, 0, 1); PG8_STAGE(PG8_SA(0, 0), gA, a2, voffA);
            PG8_BAR; PG8_WAIT_L(0); PG8_MMA(1, 0, At, B0); PG8_BAR; PG8_SCHED;
            PG8_STAGE(PG8_SB(0, 1), gB, b2 + hstepB, voffB);
            PG8_WAIT_V(6); PG8_BAR; PG8_MMA(1, 1, At, B1); PG8_BAR;
            PG8_LDB(B0, 1, 0); PG8_SCHED; PG8_LDA(At, 1, 0); PG8_STAGE(PG8_SA(0, 1), gA, a2 + hstepA, voffA);
            PG8_WAIT_L(8); PG8_BAR; PG8_WAIT_L(0); PG8_MMA(0, 0, At, B0); PG8_BAR; PG8_SCHED;
            PG8_LDB(B1, 1, 1); PG8_STAGE(PG8_SB(1, 0), gB, b3, voffB);
            PG8_BAR; PG8_WAIT_L(0); PG8_MMA(0, 1, At, B1); PG8_BAR;
            PG8_LDA(At, 1, 1); PG8_STAGE(PG8_SA(1, 0), gA, a3, voffA);
            PG8_BAR; PG8_WAIT_L(0); PG8_MMA(1, 0, At, B0); PG8_BAR; PG8_SCHED;
            PG8_STAGE(PG8_SB(1, 1), gB, b3 + hstepB, voffB);
            PG8_WAIT_V(6); PG8_BAR; PG8_MMA(1, 1, At, B1); PG8_BAR;
        }
        E(acc, cur, wr, wc, fr, fq);
        if (!has_next) break;
#pragma unroll
        for (int a = 0; a < 2; ++a)
#pragma unroll
            for (int b = 0; b < 2; ++b)
#pragma unroll
                for (int m = 0; m < 4; ++m)
#pragma unroll
                    for (int n = 0; n < 2; ++n) acc[a][b][m][n] = (f32x4){0.f, 0.f, 0.f, 0.f};
        cur = nxt; cA = nA; cB = nB; ++ui;
    }
    PG8_WAIT_V(0);
    if (wr == 0) PG8_BAR;
    PG8_BAR;
#undef PG8_SA
#undef PG8_SB
#undef PG8_STAGE
#undef PG8_LDA
#undef PG8_LDB
#undef PG8_MMA
#undef PG8_WAIT_V
#undef PG8_WAIT_L
#undef PG8_BAR
#undef PG8_SCHED
}
}
using pg8::Unit;
typedef f32x4 Acc[2][2][4][2];

struct EpiFFNa { static constexpr bool PERM = false; bf16_t* H; const float* ss;
    __device__ __forceinline__ void operator()(const Acc& acc, const Unit& u, int wr, int wc, int fr, int fq) const {
        float rs8[2][4]; rstd8(rs8, ss, u.pm * 256 + wr * 64 + fr, fq);
        const int row0 = u.pm * 256 + wr * 64 + fr, hc0 = u.pn * 128 + wc * 16 + 4 * fq;
#pragma unroll
        for (int ai = 0; ai < 2; ++ai)
#pragma unroll
            for (int m = 0; m < 4; ++m) { const int row = row0 + ai * 128 + m * 16; const float rs = rs8[ai][m];
#pragma unroll
                for (int bj = 0; bj < 2; ++bj) { const f32x4 gt = acc[ai][bj][m][0] * rs, up = acc[ai][bj][m][1] * rs; f32x4 h;
#pragma unroll
                    for (int j = 0; j < 4; ++j) h[j] = gt[j] * sigmoidf_(gt[j]) * up[j];
                    st_bf4(H + (size_t)row * FF + hc0 + bj * 64, h); } }
    }
};
struct EpiRes { static constexpr bool PERM = false; const float* xin; float* xout; bf16_t* xb; float* ss_out; float scale;
    __device__ __forceinline__ void operator()(const Acc& acc, const Unit& u, int wr, int wc, int fr, int fq) const {
        const int row0 = u.pm * 256 + wr * 64 + fr, col0 = u.pn * 256 + wc * 32 + 4 * fq;
#pragma unroll
        for (int ai = 0; ai < 2; ++ai) {
            f32x4 xv[4][2][2];
#pragma unroll
            for (int m = 0; m < 4; ++m)
#pragma unroll
                for (int bj = 0; bj < 2; ++bj)
#pragma unroll
                    for (int n = 0; n < 2; ++n) xv[m][bj][n] = *(const f32x4*)(xin + (size_t)(row0 + ai * 128 + m * 16) * D + col0 + bj * 128 + n * 16);
#pragma unroll
            for (int m = 0; m < 4; ++m) { const int row = row0 + ai * 128 + m * 16; float q = 0.f;
#pragma unroll
                for (int bj = 0; bj < 2; ++bj)
#pragma unroll
                    for (int n = 0; n < 2; ++n) { const size_t o = (size_t)row * D + col0 + bj * 128 + n * 16; const f32x4 v = xv[m][bj][n] + acc[ai][bj][m][n] * scale;
                        *(f32x4*)(xout + o) = v; st_bf4(xb + o, v); q += (v[0] * v[0] + v[1] * v[1]) + (v[2] * v[2] + v[3] * v[3]); }
                q += __shfl_xor(q, 16); q += __shfl_xor(q, 32);
                if (fq == 0) ss_out[(size_t)row * 16 + u.pn * 4 + wc] = q; }
        }
    }
};
struct EpiU { static constexpr bool PERM = true; bf16_t* Ubase; const float* ss;
    __device__ __forceinline__ void operator()(const Acc& acc, const Unit& u, int wr, int wc, int fr, int fq) const {
        float rs8[2][4]; rstd8(rs8, ss, u.pm * 256 + wr * 64 + fr, fq);
        bf16_t* base; int ld, c0;
        if (u.pn < 7) { base = (bf16_t*)((char*)Ubase + U_RWKV); ld = 1792; c0 = u.pn * 256; }
        else if (u.pn < 14) { base = (bf16_t*)((char*)Ubase + U_GLA); ld = 1792; c0 = (u.pn - 7) * 256; }
        else { base = (bf16_t*)((char*)Ubase + U_XA); ld = 512; c0 = (u.pn - 14) * 256; }
        const int row0 = u.pm * 256 + wr * 64 + fr; c0 += wc * 32 + 8 * fq;
#pragma unroll
        for (int ai = 0; ai < 2; ++ai)
#pragma unroll
            for (int m = 0; m < 4; ++m) { const int row = row0 + ai * 128 + m * 16; const float rs = rs8[ai][m];
#pragma unroll
                for (int bj = 0; bj < 2; ++bj) { const f32x4 v0 = acc[ai][bj][m][0] * rs, v1 = acc[ai][bj][m][1] * rs; u32x4 w;
                    w.x = cvt_pk_bf16(v0[0], v0[1]); w.y = cvt_pk_bf16(v0[2], v0[3]); w.z = cvt_pk_bf16(v1[0], v1[1]); w.w = cvt_pk_bf16(v1[2], v1[3]);
                    *(u32x4*)(base + (size_t)row * ld + c0 + bj * 128) = w; } }
    }
};
struct EpiGate { static constexpr bool PERM = true; unsigned char* Gt; const float* ss;
    __device__ __forceinline__ void operator()(const Acc& acc, const Unit& u, int wr, int wc, int fr, int fq) const {
        float rs8[2][4]; rstd8(rs8, ss, u.pm * 256 + wr * 64 + fr, fq);
        const int row0 = u.pm * 256 + wr * 64 + fr, c0 = u.pn * 256 + wc * 32 + 8 * fq;
#pragma unroll
        for (int ai = 0; ai < 2; ++ai)
#pragma unroll
            for (int m = 0; m < 4; ++m) { const int row = row0 + ai * 128 + m * 16; const float rs = rs8[ai][m];
#pragma unroll
                for (int bj = 0; bj < 2; ++bj) { f32x4 v0 = acc[ai][bj][m][0] * rs, v1 = acc[ai][bj][m][1] * rs;
                    unsigned q0[4], q1[4];
#pragma unroll
                    for (int j = 0; j < 4; ++j) { q0[j] = (unsigned)(sigmoidf_(v0[j]) * 255.0f + 0.5f); q1[j] = (unsigned)(sigmoidf_(v1[j]) * 255.0f + 0.5f); }
                    u32x2 w; w.x = q0[0] | (q0[1] << 8) | (q0[2] << 16) | (q0[3] << 24); w.y = q1[0] | (q1[1] << 8) | (q1[2] << 16) | (q1[3] << 24);
                    *(u32x2*)(Gt + (size_t)row * 3072 + c0 + bj * 128) = w; } }
    }
};
struct EpiMerge { static constexpr bool PERM = false; const unsigned char* Gt; float* Mg; bf16_t* Mb;
    __device__ __forceinline__ void operator()(const Acc& acc, const Unit& u, int wr, int wc, int fr, int fq) const {
        const int row0 = u.pm * 256 + wr * 64 + fr, col0 = u.pn * 256 + wc * 32 + 4 * fq;
#pragma unroll
        for (int ai = 0; ai < 2; ++ai) {
            unsigned gw[4][2][2]; u32x2 mb[4][2][2];
#pragma unroll
            for (int m = 0; m < 4; ++m)
#pragma unroll
                for (int bj = 0; bj < 2; ++bj)
#pragma unroll
                    for (int n = 0; n < 2; ++n) { const int row = row0 + ai * 128 + m * 16, col = col0 + bj * 128 + n * 16;
                        gw[m][bj][n] = *(const unsigned*)(Gt + (size_t)row * 3072 + u.z * 1024 + col);
                        mb[m][bj][n] = (u32x2){0u, 0u}; if (u.z > 0) mb[m][bj][n] = *(const u32x2*)(Mb + (size_t)row * D + col); }
#pragma unroll
            for (int m = 0; m < 4; ++m)
#pragma unroll
                for (int bj = 0; bj < 2; ++bj)
#pragma unroll
                    for (int n = 0; n < 2; ++n) { const int row = row0 + ai * 128 + m * 16, col = col0 + bj * 128 + n * 16; const unsigned g = gw[m][bj][n]; const u32x2 w = mb[m][bj][n];
                        const f32x4 gt = (f32x4){(float)(g & 0xffu), (float)((g >> 8) & 0xffu), (float)((g >> 16) & 0xffu), (float)(g >> 24)} * (1.0f / 255.0f);
                        const f32x4 v = acc[ai][bj][m][n] * gt + (f32x4){bflo(w.x), bfhi(w.x), bflo(w.y), bfhi(w.y)};
                        st_bf4(Mb + (size_t)row * D + col, v); }
        }
    }
};
struct EpiKV { static constexpr bool PERM = false; bf16_t* Kb; bf16_t* Vt; const float* rstd;
    __device__ __forceinline__ void operator()(const Acc& acc, const Unit& u, int wr, int wc, int fr, int fq) const {
        const int row0 = u.pm * 256 + wr * 64 + fr, col0 = u.pn * 256 + wc * 32 + 4 * fq;
#pragma unroll
        for (int ai = 0; ai < 2; ++ai)
#pragma unroll
            for (int m = 0; m < 4; ++m) { const int row = row0 + ai * 128 + m * 16; const float rs = rstd[row];
#pragma unroll
                for (int bj = 0; bj < 2; ++bj)
#pragma unroll
                    for (int n = 0; n < 2; ++n) { const int col = col0 + bj * 128 + n * 16; const f32x4 v = acc[ai][bj][m][n] * rs;
                        if (col < 512) st_bf4(Kb + (size_t)row * 512 + col, v);
                        else {
#pragma unroll
                            for (int j = 0; j < 4; ++j) Vt[((size_t)(row >> 8) * 512 + (col - 512 + j)) * 256 + (row & 255)] = f2bf(v[j]); } } }
    }
};

template <int MAP> __device__ __forceinline__ int colmap(int n) {
    if (MAP == 1) { const int g = n >> 5, i = n & 31; return i < 16 ? 16 * g + i : FF + 16 * g + (i - 16); }
    if (MAP == 2) { if (n < 3344) return n; if (n < 3584) return -1; return n - 240; }
    return n;
}
template <int MAP>
__device__ __forceinline__ void convT(LAS unsigned char* lds, const float* src, int ld, int coff, const float* g, bf16_t* dst, int K, int Kd, int Nd, int G, int bid, int tid) {
    const int nkt = (K + 63) >> 6, nnt = (Nd + 63) >> 6, ntile = nkt * nnt;
    LAS bf16_t* tile = (LAS bf16_t*)lds;
    for (int t = bid; t < ntile; t += G) {
        const int kt = t % nkt, ntl = t / nkt, k0 = kt * 64, n0 = ntl * 64;
        { const int nl = tid & 63, kl0 = tid >> 6, n = n0 + nl; const int c = (n < Nd) ? colmap<MAP>(n) : -1;
#pragma unroll
          for (int i = 0; i < 8; ++i) { const int kl = kl0 + 8 * i, k = k0 + kl; float v = 0.f;
              if (c >= 0 && k < K) { v = src[(size_t)k * ld + coff + c]; if (g) v *= g[k]; }
              tile[nl * 72 + kl] = f2bf(v); } }
        __syncthreads();
        { const int nl = tid >> 3, kc = (tid & 7) * 8, n = n0 + nl, k = k0 + kc;
          if (n < Nd && k < Kd) *(u32x4*)(dst + (size_t)n * Kd + k) = *(LAS u32x4*)(tile + nl * 72 + kc); }
        __syncthreads();
    }
}

template <int MAP>
__device__ __forceinline__ void convT_w(const float* src, int ld, int coff, const float* g, bf16_t* dst, int K, int Kd, int Nd, int wslot, int nslots, int lane, int tile_base) {
    const int nkt = K >> 4, nnt = (Nd + 255) >> 8, ntile = nkt * nnt;
    for (int t = ((wslot - tile_base) % nslots + nslots) % nslots; t < ntile; t += nslots) {
        const int kt = t % nkt, ntl = t / nkt, k0 = kt * 16, n = ntl * 256 + lane * 4; const int c = (n < Nd) ? colmap<MAP>(n) : -1;
        const float* sp = src + (size_t)k0 * ld + coff + (c >= 0 ? c : 0);
        f32x4 v[16];
#pragma unroll
        for (int kk = 0; kk < 16; ++kk) { v[kk] = *(const f32x4*)(sp + (size_t)kk * ld); if (g) v[kk] *= g[k0 + kk]; if (c < 0) v[kk] = (f32x4){0.f, 0.f, 0.f, 0.f}; }
        if (n < Nd) {
#pragma unroll
            for (int j = 0; j < 4; ++j) { u32x4 lo, hi;
                lo.x = cvt_pk_bf16(v[0][j], v[1][j]); lo.y = cvt_pk_bf16(v[2][j], v[3][j]); lo.z = cvt_pk_bf16(v[4][j], v[5][j]); lo.w = cvt_pk_bf16(v[6][j], v[7][j]);
                hi.x = cvt_pk_bf16(v[8][j], v[9][j]); hi.y = cvt_pk_bf16(v[10][j], v[11][j]); hi.z = cvt_pk_bf16(v[12][j], v[13][j]); hi.w = cvt_pk_bf16(v[14][j], v[15][j]);
                bf16_t* dp = dst + (size_t)(n + j) * Kd + k0; *(u32x4*)dp = lo; *(u32x4*)(dp + 8) = hi; }
        }
    }
}

template <int K>
__device__ __forceinline__ void wave_gemm(f32x4 (&acc)[4][4], LAS const unsigned char* A, int sA, const bf16_t* Bt, int fr, int fq) {
#pragma unroll
    for (int m = 0; m < 4; ++m)
#pragma unroll
        for (int n = 0; n < 4; ++n) acc[m][n] = (f32x4){0.f, 0.f, 0.f, 0.f};
#pragma unroll
    for (int ks = 0; ks < K / 32; ++ks) { bf16x8 a[4], b[4];
#pragma unroll
        for (int m = 0; m < 4; ++m) a[m] = *(LAS const bf16x8*)(A + (16 * m + fr) * sA + (ks * 32 + fq * 8) * 2);
#pragma unroll
        for (int n = 0; n < 4; ++n) b[n] = *(const bf16x8*)(Bt + (size_t)(16 * n + fr) * K + ks * 32 + fq * 8);
#pragma unroll
        for (int m = 0; m < 4; ++m)
#pragma unroll
            for (int n = 0; n < 4; ++n) acc[m][n] = mfma16(b[n], a[m], acc[m][n]); }
}

template <int K>
__device__ __forceinline__ void row_gemm(f32x4 (&acc)[4], LAS const unsigned char* Arow, const bf16_t* Bt, int fr, int fq) {
    bf16x8 bw[K / 32][4];
#pragma unroll
    for (int ks = 0; ks < K / 32; ++ks)
#pragma unroll
        for (int n = 0; n < 4; ++n) bw[ks][n] = *(const bf16x8*)(Bt + (size_t)(16 * n + fr) * K + ks * 32 + fq * 8);
#pragma unroll
    for (int n = 0; n < 4; ++n) acc[n] = (f32x4){0.f, 0.f, 0.f, 0.f};
#pragma unroll
    for (int ks = 0; ks < K / 32; ++ks) { const bf16x8 a = *(LAS const bf16x8*)(Arow + (ks * 32 + fq * 8) * 2);
#pragma unroll
        for (int n = 0; n < 4; ++n) acc[n] = mfma16(bw[ks][n], a, acc[n]); }
}

struct PrepArgs { const bf16_t* U; const float *mu, *w0, *a0, *kk_, *ka, *rk, *v0; const bf16_t *w2t, *a2t, *g2t, *v1t, *v2t; float* vfirst; float* Wd; float* V; bf16_t* RKKB; bf16_t* Go; float* Bon; int layer; };

__device__ __forceinline__ f32x4 shifted4(const bf16_t* Ut, bool has_prev, int c, const float* mu) {
    const f32x4 u = ld_bf4(Ut + c); f32x4 p = ld_bf4((has_prev ? Ut - 1792 : Ut) + c); const float pm = has_prev ? 1.0f : 0.0f; p = p * pm;
    const f32x4 m = *(const f32x4*)(mu + c); return u + m * (p - u);
}

__device__ __forceinline__ void rwkv_prep_tile(LAS unsigned char* lds, const PrepArgs& P, int tt, int tid) {
    constexpr int SW = 144, SG = 272, SV = 1040, SVV = 80;
    LAS unsigned char* LAw = lds; LAS unsigned char* LAa = lds + 9216; LAS unsigned char* LAg = lds + 18432; LAS unsigned char* LAv = lds + 35840; LAS unsigned char* LAvv = lds + 102400;
    const int t0 = tt * 64; const int s0 = t0 & (SEQ - 1);
    const int lane = tid & 63, wave = __builtin_amdgcn_readfirstlane(tid >> 6), fr = lane & 15, fq = lane >> 4;
    LAS float* PRM = (LAS float*)(lds + 107520);
    { PRM[tid] = P.mu[tid]; PRM[512 + tid] = P.mu[512 + tid]; PRM[1024 + tid] = P.mu[1024 + tid]; PRM[1536 + tid] = P.a0[tid]; PRM[2048 + tid] = P.w0[tid];
      PRM[2560 + tid] = P.kk_[tid]; PRM[3072 + tid] = P.ka[tid]; PRM[3584 + tid] = P.rk[tid]; PRM[4096 + tid] = P.v0[tid]; }
#pragma unroll 2
    for (int e = 0; e < 4; ++e) { const int idx = tid + 512 * e, i = idx >> 5, c = (idx & 31) * 8; const bf16_t* Ut = P.U + (size_t)(t0 + i) * 1792; const bool hp = s0 + i > 0;
        f32x4 x0 = shifted4(Ut, hp, 1536 + c, P.mu), x1 = shifted4(Ut, hp, 1536 + c + 4, P.mu);
        if (c < 64) {
#pragma unroll
            for (int q = 0; q < 4; ++q) { const float ea = __expf(2.f * x0[q]), eb = __expf(2.f * x1[q]); x0[q] = 1.f - 2.f / (ea + 1.f); x1[q] = 1.f - 2.f / (eb + 1.f); } }
        else if (c >= 128) {
#pragma unroll
            for (int q = 0; q < 4; ++q) { x0[q] = sigmoidf_(x0[q]); x1[q] = sigmoidf_(x1[q]); } }
        u32x4 o; o.x = cvt_pk_bf16(x0[0], x0[1]); o.y = cvt_pk_bf16(x0[2], x0[3]); o.z = cvt_pk_bf16(x1[0], x1[1]); o.w = cvt_pk_bf16(x1[2], x1[3]);
        LAS unsigned char* dstp = (c < 64) ? (LAw + i * SW + c * 2) : (c < 128) ? (LAa + i * SW + (c - 64) * 2) : (LAg + i * SG + (c - 128) * 2);
        *(LAS u32x4*)dstp = o; }
    if (P.layer > 0) {
#pragma unroll 2
        for (int e = 0; e < 8; ++e) { const int idx = tid + 512 * e, i = idx >> 6, c = (idx & 63) * 8; const bf16_t* Ut = P.U + (size_t)(t0 + i) * 1792; const bool hp = s0 + i > 0;
            const f32x4 x0 = shifted4(Ut, hp, 1024 + c, P.mu), x1 = shifted4(Ut, hp, 1024 + c + 4, P.mu);
            u32x4 o; o.x = cvt_pk_bf16(x0[0], x0[1]); o.y = cvt_pk_bf16(x0[2], x0[3]); o.z = cvt_pk_bf16(x1[0], x1[1]); o.w = cvt_pk_bf16(x1[2], x1[3]);
            *(LAS u32x4*)(LAv + i * SV + c * 2) = o; }
    }
    __syncthreads();
    if (P.layer > 0) {
        const int mt = wave >> 1, nt = wave & 1; f32x4 acc = (f32x4){0.f, 0.f, 0.f, 0.f};
#pragma unroll 4
        for (int ks = 0; ks < 16; ++ks) { const bf16x8 a = *(LAS const bf16x8*)(LAv + (16 * mt + fr) * SV + (ks * 32 + fq * 8) * 2);
            const bf16x8 b = *(const bf16x8*)(P.v1t + (size_t)(16 * nt + fr) * 512 + ks * 32 + fq * 8); acc = mfma16(b, a, acc); }
        u32x2 w; w.x = cvt_pk_bf16(acc[0], acc[1]); w.y = cvt_pk_bf16(acc[2], acc[3]); *(LAS u32x2*)(LAvv + (16 * mt + fr) * SVV + (16 * nt + 4 * fq) * 2) = w;
    }
    __syncthreads();
    const int h = wave, cb = 64 * h; const int b_ = t0 >> 12, p = b_ * 8 + h;
#pragma unroll 1
    for (int m = 0; m < 4; ++m) {
        const int i = 16 * m + fr; const bf16_t* Ut = P.U + (size_t)(t0 + i) * 1792; const bool hp = (s0 + i) > 0;
        int fq4 = 4 * fq; asm volatile("" : "+v"(fq4));
        u32x2 uk[4], pk[4], ur[4], pr[4], uv[4], pv[4]; f32x4 vf[4];
        { const bf16_t* Up = hp ? Ut - 1792 : Ut; const unsigned pm = hp ? 0xffffffffu : 0u;
#pragma unroll
          for (int n = 0; n < 4; ++n) { const int c = cb + 16 * n + fq4;
              uk[n] = *(const u32x2*)(Ut + 512 + c); ur[n] = *(const u32x2*)(Ut + c); uv[n] = *(const u32x2*)(Ut + 1024 + c);
              pk[n] = *(const u32x2*)(Up + 512 + c); pr[n] = *(const u32x2*)(Up + c); pv[n] = *(const u32x2*)(Up + 1024 + c);
              if (P.layer > 0) vf[n] = *(const f32x4*)(P.vfirst + (size_t)(t0 + i) * 512 + c); }
#pragma unroll
          for (int n = 0; n < 4; ++n) { pk[n].x &= pm; pk[n].y &= pm; pr[n].x &= pm; pr[n].y &= pm; pv[n].x &= pm; pv[n].y &= pm; } }
        f32x4 aa[4], acc[4];
        row_gemm<64>(aa, LAa + i * SW, P.a2t + (size_t)cb * 64, fr, fq);
        row_gemm<64>(acc, LAw + i * SW, P.w2t + (size_t)cb * 64, fr, fq);
#pragma unroll
        for (int n = 0; n < 4; ++n) { const f32x4 a0v = *(LAS const f32x4*)(PRM + 1536 + cb + 16 * n + fq4), w0v = *(LAS const f32x4*)(PRM + 2048 + cb + 16 * n + fq4); f32x4 d;
#pragma unroll
            for (int j = 0; j < 4; ++j) { aa[n][j] = sigmoidf_(aa[n][j] + a0v[j]); d[j] = __expf(-0.6065306597f * sigmoidf_(acc[n][j] + w0v[j])); }
            *(f32x4*)(P.Wd + ((size_t)p * SEQ + s0 + i) * 64 + 16 * n + fq4) = d; }
        row_gemm<128>(acc, LAg + i * SG, P.g2t + (size_t)cb * 128, fr, fq);
#pragma unroll
        for (int n = 0; n < 4; ++n) st_bf4(P.Go + (size_t)(t0 + i) * 512 + cb + 16 * n + fq4, acc[n]);
        if (P.layer > 0) row_gemm<32>(acc, LAvv + i * SVV, P.v2t + (size_t)cb * 32, fr, fq);
        float bon = 0.f, nk = 0.f; f32x4 kv[4], rv[4];
#pragma unroll
        for (int n = 0; n < 4; ++n) { const int c = cb + 16 * n + fq4;
            const f32x4 muv = *(LAS const f32x4*)(PRM + 1024 + c), muk = *(LAS const f32x4*)(PRM + 512 + c), mur = *(LAS const f32x4*)(PRM + c);
            const f32x4 v_u = (f32x4){bflo(uv[n].x), bfhi(uv[n].x), bflo(uv[n].y), bfhi(uv[n].y)}, v_p = (f32x4){bflo(pv[n].x), bfhi(pv[n].x), bflo(pv[n].y), bfhi(pv[n].y)};
            const f32x4 k_u = (f32x4){bflo(uk[n].x), bfhi(uk[n].x), bflo(uk[n].y), bfhi(uk[n].y)}, k_p = (f32x4){bflo(pk[n].x), bfhi(pk[n].x), bflo(pk[n].y), bfhi(pk[n].y)};
            const f32x4 r_u = (f32x4){bflo(ur[n].x), bfhi(ur[n].x), bflo(ur[n].y), bfhi(ur[n].y)}, r_p = (f32x4){bflo(pr[n].x), bfhi(pr[n].x), bflo(pr[n].y), bfhi(pr[n].y)};
            f32x4 v = v_u + muv * (v_p - v_u);
            if (P.layer > 0) { const f32x4 v0v = *(LAS const f32x4*)(PRM + 4096 + c);
#pragma unroll
                for (int j = 0; j < 4; ++j) v[j] = v[j] + (vf[n][j] - v[j]) * sigmoidf_(v0v[j] + acc[n][j]); }
            else *(f32x4*)(P.vfirst + (size_t)(t0 + i) * 512 + c) = v;
            *(f32x4*)(P.V + ((size_t)p * SEQ + s0 + i) * 64 + 16 * n + fq4) = v;
            kv[n] = k_u + muk * (k_p - k_u); rv[n] = r_u + mur * (r_p - r_u);
            const f32x4 kkw = *(LAS const f32x4*)(PRM + 2560 + c);
#pragma unroll
            for (int j = 0; j < 4; ++j) { const float x = kv[n][j] * kkw[j]; nk += x * x; } }
        nk += __shfl_xor(nk, 16); nk += __shfl_xor(nk, 32);
        const float inv = 1.0f / fmaxf(sqrtf(nk), 1e-12f);
        bf16_t* O = P.RKKB + ((size_t)p * SEQ + s0 + i) * 256;
#pragma unroll
        for (int n = 0; n < 4; ++n) { const int c = cb + 16 * n + fq4; const f32x4 kkw = *(LAS const f32x4*)(PRM + 2560 + c), kaw = *(LAS const f32x4*)(PRM + 3072 + c), rkw = *(LAS const f32x4*)(PRM + 3584 + c);
            f32x4 kk, kh, bb;
#pragma unroll
            for (int j = 0; j < 4; ++j) { const float a = aa[n][j]; kk[j] = kv[n][j] * kkw[j] * inv; kh[j] = kv[n][j] * (1.f + (a - 1.f) * kaw[j]); bb[j] = kk[j] * a; bon += rv[n][j] * kh[j] * rkw[j]; }
            const int cc = 16 * n + fq4; st_bf4(O + cc, rv[n]); st_bf4(O + 64 + cc, kh); st_bf4(O + 128 + cc, kk); st_bf4(O + 192 + cc, bb); }
        bon += __shfl_xor(bon, 16); bon += __shfl_xor(bon, 32);
        if (fq == 0) P.Bon[(size_t)(t0 + i) * 8 + h] = bon;
        asm volatile("" ::: "memory");
    }
    __syncthreads();
}

constexpr int SCAN_CH = 32, SCAN_STEP_B = 1344, SCAN_SLOT_B = SCAN_CH * SCAN_STEP_B;
template <int CTRL> __device__ __forceinline__ float dpp_f(float v) { return __int_as_float(__builtin_amdgcn_update_dpp(0, __float_as_int(v), CTRL, 0xf, 0xf, true)); }
__device__ __forceinline__ float row16_sum(float v) { v += dpp_f<0xB1>(v); v += dpp_f<0x4E>(v); v += dpp_f<0x141>(v); v += dpp_f<0x140>(v); return v; }

__device__ __forceinline__ float tr16_sum(const float (&p)[16], int kq) {
    const bool b3 = (kq & 8) != 0, b2 = (kq & 4) != 0, b1 = (kq & 2) != 0, b0 = (kq & 1) != 0;
    float q[8], r[4], u[2];
#pragma unroll
    for (int t = 0; t < 8; ++t) { const float keep = b3 ? p[t + 8] : p[t], send = b3 ? p[t] : p[t + 8]; q[t] = keep + dpp_f<0x140>(send); }
#pragma unroll
    for (int t = 0; t < 4; ++t) { const float keep = b2 ? q[t + 4] : q[t], send = b2 ? q[t] : q[t + 4]; r[t] = keep + dpp_f<0x141>(send); }
#pragma unroll
    for (int t = 0; t < 2; ++t) { const float keep = b1 ? r[t + 2] : r[t], send = b1 ? r[t] : r[t + 2]; u[t] = keep + dpp_f<0x4E>(send); }
    const float keep = b0 ? u[1] : u[0], send = b0 ? u[0] : u[1];
    return keep + dpp_f<0xB1>(send);
}

__device__ __forceinline__ void scan_load_chunk(LAS unsigned char* slot, const float* Wd, const float* V, const bf16_t* RKKB, int p, int rg, int s0, int lt) {
    u32x4 r[7];
    const size_t base = (size_t)p * SEQ + s0;
#pragma unroll
    for (int j = 0; j < 2; ++j) { const int idx = lt + 256 * j, st = idx >> 4, part = idx & 15; r[j] = *(const u32x4*)(Wd + (base + st) * 64 + part * 4); }
#pragma unroll
    for (int j = 2; j < 6; ++j) { const int k = lt + 256 * (j - 2), st = k >> 5, rem = k & 31, q = rem >> 3, part = rem & 7; r[j] = *(const u32x4*)(RKKB + ((base + st) * 4 + q) * 64 + part * 8); }
    if (lt < 128) { const int st = lt >> 2, hf = lt & 3; r[6] = *(const u32x4*)(V + (base + st) * 64 + rg * 16 + hf * 4); }
#pragma unroll
    for (int j = 0; j < 2; ++j) { const int idx = lt + 256 * j, st = idx >> 4, part = idx & 15; *(LAS u32x4*)(slot + st * SCAN_STEP_B + part * 16) = r[j]; }
#pragma unroll
    for (int j = 2; j < 6; ++j) { const int k = lt + 256 * (j - 2), st = k >> 5, rem = k & 31, q = rem >> 3, part = rem & 7; const u32x4 w = r[j];
        const int Q = (q == 0) ? 4 : (q == 1) ? 2 : (q == 2) ? 3 : 1;
        LAS f32x4* d = (LAS f32x4*)(slot + st * SCAN_STEP_B + Q * 256 + part * 32);
        d[0] = (f32x4){bflo(w.x), bfhi(w.x), bflo(w.y), bfhi(w.y)}; d[1] = (f32x4){bflo(w.z), bfhi(w.z), bflo(w.w), bfhi(w.w)}; }
    if (lt < 128) { const int st = lt >> 2, hf = lt & 3; *(LAS u32x4*)(slot + st * SCAN_STEP_B + 1280 + hf * 16) = r[6]; }
}

__device__ __forceinline__ void rwkv_scan_unit(LAS unsigned char* lds, const float* Wd, const float* V, const bf16_t* RKKB, float* Yraw, int p, int rg, int tid) {
    const int lane = tid & 63, wave = __builtin_amdgcn_readfirstlane(tid >> 6);
    constexpr int NCH = SEQ / SCAN_CH;
    scan_load_chunk(lds + (tid >> 8) * SCAN_SLOT_B, Wd, V, RKKB, p, rg, (tid >> 8) * SCAN_CH, tid & 255);
    __syncthreads();
    f32x4 S = (f32x4){0.f, 0.f, 0.f, 0.f};
    const int kq = lane & 15, rl = wave * 4 + (lane >> 4);
    for (int c = 0; c < NCH; ++c) {
        if (wave >= 4) { if (c + 2 < NCH) scan_load_chunk(lds + ((c + 2) % 3) * SCAN_SLOT_B, Wd, V, RKKB, p, rg, (c + 2) * SCAN_CH, tid - 256); }
        else {
            LAS const unsigned char* sl = lds + (c % 3) * SCAN_SLOT_B + kq * 16;
            LAS const unsigned char* vl = lds + (c % 3) * SCAN_SLOT_B + 1280 + rl * 4;
            float* yo = Yraw + ((size_t)p * SEQ + c * SCAN_CH + kq) * 64 + rg * 16 + rl;
            f32x4 w = *(LAS const f32x4*)(sl), b = *(LAS const f32x4*)(sl + 256), k = *(LAS const f32x4*)(sl + 512), kk = *(LAS const f32x4*)(sl + 768), r = *(LAS const f32x4*)(sl + 1024);
            float v = *(LAS const float*)(vl); float yp[16];
#pragma unroll
            for (int st = 0; st < SCAN_CH; ++st) {
                f32x4 wn = w, bn = b, kn = k, kkn = kk, rn = r; float vn = v;
                if (st + 1 < SCAN_CH) { const int o = (st + 1) * SCAN_STEP_B;
                    wn = *(LAS const f32x4*)(sl + o); bn = *(LAS const f32x4*)(sl + o + 256); kn = *(LAS const f32x4*)(sl + o + 512); kkn = *(LAS const f32x4*)(sl + o + 768); rn = *(LAS const f32x4*)(sl + o + 1024);
                    vn = *(LAS const float*)(vl + o); }
                float sa = (S[0] * kk[0] + S[1] * kk[1]) + (S[2] * kk[2] + S[3] * kk[3]);
                const f32x4 kvt = k * v;
                sa = -row16_sum(sa);
                S = S * w + (b * sa + kvt);
                yp[st & 15] = (S[0] * r[0] + S[1] * r[1]) + (S[2] * r[2] + S[3] * r[3]);
                if ((st & 15) == 15) yo[(size_t)(st - 15) * 64] = tr16_sum(yp, kq);
                w = wn; b = bn; k = kn; kk = kkn; r = rn; v = vn;
            }
        }
        __syncthreads();
    }
}

struct GlaArgs { const bf16_t* Ug; const float *conv, *aup, *abias, *gnorm; float* kvcT; float* dec; bf16_t* spT; bf16_t* Yg; };
constexpr int GL_GC = 0;
constexpr int GL_T0 = 16640;
constexpr int GL_VT = GL_T0 + 4 * 9216;
constexpr int GL_AL = GL_VT + 18432;
constexpr int GL_RS = GL_AL + 9216;

__device__ __forceinline__ void gla_conv8(f32x4 (&out)[8], const bf16_t* Ug, const float* conv, int t0, int s0, int i0, int c0) {
    f32x4 w[4];
#pragma unroll
    for (int j = 0; j < 4; ++j) w[j] = *(const f32x4*)(conv + j * 1024 + c0);
    u32x2 raw[8][4];
#pragma unroll
    for (int e = 0; e < 8; ++e)
#pragma unroll
        for (int j = 0; j < 4; ++j) { const int i = i0 + 8 * e, ds = 3 - j; const bool ok = (s0 + i - ds) >= 0; raw[e][j] = *(const u32x2*)(Ug + (size_t)(ok ? t0 + i - ds : t0) * 1792 + c0); }
#pragma unroll
    for (int e = 0; e < 8; ++e) { const int i = i0 + 8 * e; f32x4 a = (f32x4){0.f, 0.f, 0.f, 0.f};
#pragma unroll
        for (int j = 0; j < 4; ++j) { const int ds = 3 - j; const float mk = ((s0 + i - ds) >= 0) ? 1.0f : 0.0f; const u32x2 r = raw[e][j];
            a += (w[j] * mk) * (f32x4){bflo(r.x), bfhi(r.x), bflo(r.y), bfhi(r.y)}; }
#pragma unroll
        for (int q = 0; q < 4; ++q) a[q] = a[q] * sigmoidf_(a[q]);
        out[e] = a; }
}
__device__ __forceinline__ void gla_gcum(LAS unsigned char* lds, const GlaArgs& A, int t0, int h, int tid) {
    LAS float* GC = (LAS float*)(lds + GL_GC);
    { const int d = tid & 63, i0 = tid >> 6; float au[16]; const float ab = A.abias[h * 64 + d];
#pragma unroll
      for (int j = 0; j < 16; ++j) au[j] = A.aup[j * 256 + h * 64 + d];
      u32x4 al0[8], al1[8];
#pragma unroll
      for (int e = 0; e < 8; ++e) { const u32x4* ap = (const u32x4*)(A.Ug + (size_t)(t0 + i0 + 8 * e) * 1792 + 1024); al0[e] = ap[0]; al1[e] = ap[1]; }
#pragma unroll
      for (int e = 0; e < 8; ++e) { const int i = i0 + 8 * e; const u32x4 a0 = al0[e], a1 = al1[e];
          float x = ab;
          x += bflo(a0.x) * au[0] + bfhi(a0.x) * au[1] + bflo(a0.y) * au[2] + bfhi(a0.y) * au[3] + bflo(a0.z) * au[4] + bfhi(a0.z) * au[5] + bflo(a0.w) * au[6] + bfhi(a0.w) * au[7];
          x += bflo(a1.x) * au[8] + bfhi(a1.x) * au[9] + bflo(a1.y) * au[10] + bfhi(a1.y) * au[11] + bflo(a1.z) * au[12] + bfhi(a1.z) * au[13] + bflo(a1.w) * au[14] + bfhi(a1.w) * au[15];
          const float ls = fminf(x, 0.f) - __logf(1.f + __expf(-fabsf(x)));
          GC[i * 65 + d] = ls * (1.0f / 16.0f); } }
    __syncthreads();
    { const int lane = tid & 63, wave = tid >> 6;
#pragma unroll
      for (int dd = 0; dd < 8; ++dd) { const int d = wave * 8 + dd; float x = GC[lane * 65 + d];
#pragma unroll
          for (int o = 1; o < 64; o <<= 1) { const float y = __shfl_up(x, o); if (lane >= o) x += y; }
          GC[lane * 65 + d] = x; } }
    __syncthreads();
}
__device__ __forceinline__ void gla_a_tile(LAS unsigned char* lds, const GlaArgs& A, int tile, int tid) {
    const int bh = tile >> 6, n = tile & 63, b = bh >> 2, h = bh & 3, t0 = b * SEQ + n * 64, s0 = n * 64;
    LAS float* GC = (LAS float*)(lds + GL_GC); LAS bf16_t* KDT = (LAS bf16_t*)(lds + GL_T0); LAS bf16_t* VT = (LAS bf16_t*)(lds + GL_VT);
    gla_gcum(lds, A, t0, h, tid);
    { const int cc = (tid & 63) * 4, i0 = tid >> 6;
      if (cc >= 64) { f32x4 o[8]; const int c0 = (cc < 128) ? 256 + h * 64 + (cc - 64) : 512 + h * 128 + (cc - 128);
          gla_conv8(o, A.Ug, A.conv, t0, s0, i0, c0);
          if (cc < 128) { const int d = cc - 64;
#pragma unroll
              for (int e = 0; e < 8; ++e) { const int i = i0 + 8 * e;
#pragma unroll
                  for (int q = 0; q < 4; ++q) KDT[(d + q) * 72 + i] = f2bf(o[e][q] * __expf(GC[63 * 65 + d + q] - GC[i * 65 + d + q])); } }
          else { const int ev = cc - 128;
#pragma unroll
              for (int e = 0; e < 8; ++e) { const int i = i0 + 8 * e;
#pragma unroll
                  for (int q = 0; q < 4; ++q) VT[(ev + q) * 72 + i] = f2bf(o[e][q]); } } } }
    if (tid < 64) A.dec[((size_t)bh * 64 + n) * 64 + tid] = __expf(GC[63 * 65 + tid]);
    __syncthreads();
    { const int lane = tid & 63, wave = tid >> 6, fr = lane & 15, fq = lane >> 4; f32x4 acc[4];
#pragma unroll
      for (int nt = 0; nt < 4; ++nt) acc[nt] = (f32x4){0.f, 0.f, 0.f, 0.f};
#pragma unroll
      for (int ks = 0; ks < 2; ++ks) { const bf16x8 a = *(LAS const bf16x8*)(VT + (16 * wave + fr) * 72 + ks * 32 + fq * 8);
#pragma unroll
          for (int nt = 0; nt < 4; ++nt) { const bf16x8 bfr = *(LAS const bf16x8*)(KDT + (16 * nt + fr) * 72 + ks * 32 + fq * 8); acc[nt] = mfma16(bfr, a, acc[nt]); } }
#pragma unroll
      for (int nt = 0; nt < 4; ++nt) *(f32x4*)(A.kvcT + (((size_t)bh * 64 + n) * 128 + 16 * wave + fr) * 64 + 16 * nt + 4 * fq) = acc[nt]; }
    __syncthreads();
}
__device__ __forceinline__ void gla_c_tile(LAS unsigned char* lds, const GlaArgs& A, int tile, int tid) {
    const int bh = tile >> 6, n = tile & 63, b = bh >> 2, h = bh & 3, t0 = b * SEQ + n * 64, s0 = n * 64;
    LAS float* GC = (LAS float*)(lds + GL_GC); LAS bf16_t* QG = (LAS bf16_t*)(lds + GL_T0); LAS bf16_t* KG = QG + 64 * 72; LAS bf16_t* QR = KG + 64 * 72; LAS bf16_t* KR = QR + 64 * 72;
    LAS bf16_t* VT = (LAS bf16_t*)(lds + GL_VT); LAS bf16_t* AL = (LAS bf16_t*)(lds + GL_AL); LAS float* RS = (LAS float*)(lds + GL_RS);
    gla_gcum(lds, A, t0, h, tid);
    { const int cc = (tid & 63) * 4, i0 = tid >> 6; f32x4 o[8];
      const int c0 = (cc < 64) ? h * 64 + cc : (cc < 128) ? 256 + h * 64 + (cc - 64) : 512 + h * 128 + (cc - 128);
      gla_conv8(o, A.Ug, A.conv, t0, s0, i0, c0);
      if (cc < 128) { const int d = cc & 63; const bool isq = cc < 64; LAS bf16_t* T1 = isq ? QG : KR; LAS bf16_t* T2 = isq ? QR : KG; const float sc = isq ? 0.125f : 1.0f;
#pragma unroll
          for (int e = 0; e < 8; ++e) { const int i = i0 + 8 * e; f32x4 x1, x2;
#pragma unroll
              for (int q = 0; q < 4; ++q) { const float eg = __expf(GC[i * 65 + d + q]); const float x = o[e][q] * sc; x1[q] = x * eg; x2[q] = x / eg; }
              u32x2 w1, w2; w1.x = cvt_pk_bf16(x1[0], x1[1]); w1.y = cvt_pk_bf16(x1[2], x1[3]); w2.x = cvt_pk_bf16(x2[0], x2[1]); w2.y = cvt_pk_bf16(x2[2], x2[3]);
              *(LAS u32x2*)(T1 + i * 72 + d) = w1; *(LAS u32x2*)(T2 + i * 72 + d) = w2; } }
      else { const int ev = cc - 128;
#pragma unroll
          for (int e = 0; e < 8; ++e) { const int i = i0 + 8 * e;
#pragma unroll
              for (int q = 0; q < 4; ++q) VT[(ev + q) * 72 + i] = f2bf(o[e][q]); } } }
    __syncthreads();
    const int lane = tid & 63, wave = tid >> 6, fr = lane & 15, fq = lane >> 4; const int mt = wave >> 1;
    {
#pragma unroll
        for (int q = 0; q < 2; ++q) { const int nt = (wave & 1) * 2 + q; f32x4 ap = (f32x4){0.f, 0.f, 0.f, 0.f}, af = ap;
#pragma unroll
            for (int ks = 0; ks < 2; ++ks) { const int ko = ks * 32 + fq * 8;
                ap = mfma16(*(LAS const bf16x8*)(KG + (16 * nt + fr) * 72 + ko), *(LAS const bf16x8*)(QG + (16 * mt + fr) * 72 + ko), ap);
                af = mfma16(*(LAS const bf16x8*)(KR + (16 * nt + fr) * 72 + ko), *(LAS const bf16x8*)(QR + (16 * mt + fr) * 72 + ko), af); }
            const int trow = 16 * mt + fr; f32x4 o;
#pragma unroll
            for (int j = 0; j < 4; ++j) { const int scol = 16 * nt + 4 * fq + j; o[j] = (scol <= trow) ? ap[j] : af[j]; }
            u32x2 w; w.x = cvt_pk_bf16(o[0], o[1]); w.y = cvt_pk_bf16(o[2], o[3]); *(LAS u32x2*)(AL + trow * 72 + 16 * nt + 4 * fq) = w; }
    }
    __syncthreads();
    f32x4 acc[4];
#pragma unroll
    for (int q = 0; q < 4; ++q) acc[q] = (f32x4){0.f, 0.f, 0.f, 0.f};
    const bf16_t* sp = A.spT + ((size_t)bh * 64 + n) * 128 * 64;
#pragma unroll
    for (int ks = 0; ks < 2; ++ks) { const int ko = ks * 32 + fq * 8; const bf16x8 a1 = *(LAS const bf16x8*)(AL + (16 * mt + fr) * 72 + ko), a2 = *(LAS const bf16x8*)(QG + (16 * mt + fr) * 72 + ko);
#pragma unroll
        for (int q = 0; q < 4; ++q) { const int nt = (wave & 1) * 4 + q;
            acc[q] = mfma16(*(LAS const bf16x8*)(VT + (16 * nt + fr) * 72 + ko), a1, acc[q]);
            acc[q] = mfma16(*(const bf16x8*)(sp + (size_t)(16 * nt + fr) * 64 + ko), a2, acc[q]); } }
    float ssq = 0.f;
#pragma unroll
    for (int q = 0; q < 4; ++q) ssq += (acc[q][0] * acc[q][0] + acc[q][1] * acc[q][1]) + (acc[q][2] * acc[q][2] + acc[q][3] * acc[q][3]);
    ssq += __shfl_xor(ssq, 16); ssq += __shfl_xor(ssq, 32);
    if (fq == 0) RS[(16 * mt + fr) * 2 + (wave & 1)] = ssq;
    __syncthreads();
    { const int i = 16 * mt + fr; const float rs = rsqrtf((RS[i * 2] + RS[i * 2 + 1]) * (1.0f / 128.0f) + 1e-6f);
#pragma unroll
      for (int q = 0; q < 4; ++q) { const int ecol = h * 128 + ((wave & 1) * 4 + q) * 16 + 4 * fq; const f32x4 nw = *(const f32x4*)(A.gnorm + ecol); const f32x4 go = ld_bf4(A.Ug + (size_t)(t0 + i) * 1792 + 1040 + ecol); f32x4 o;
#pragma unroll
          for (int j = 0; j < 4; ++j) o[j] = acc[q][j] * rs * nw[j] * go[j] * sigmoidf_(go[j]);
          st_bf4(A.Yg + (size_t)(t0 + i) * 512 + ecol, o); } }
    __syncthreads();
}

__device__ __forceinline__ void xa_tile(const bf16_t* Ux, const bf16_t* Kb, const bf16_t* Vt, bf16_t* Yx, int tile, int tid) {
    const int blk = tile & 31, h = (tile >> 5) & 3, b = tile >> 7; const int lane = tid & 63, wave = tid >> 6, fr = lane & 15, fq = lane >> 4;
    const int t = b * SEQ + blk * 128 + 16 * wave + fr;
    bf16x8 qf[4];
#pragma unroll
    for (int ks = 0; ks < 4; ++ks) qf[ks] = *(const bf16x8*)(Ux + (size_t)t * 512 + h * 128 + ks * 32 + fq * 8);
    f32x4 s[16];
#pragma unroll
    for (int nt = 0; nt < 16; ++nt) { s[nt] = (f32x4){0.f, 0.f, 0.f, 0.f}; const bf16_t* kr = Kb + (size_t)(b * 256 + 16 * nt + fr) * 512 + h * 128 + fq * 8;
#pragma unroll
        for (int ks = 0; ks < 4; ++ks) s[nt] = mfma16(*(const bf16x8*)(kr + ks * 32), qf[ks], s[nt]); }
    float mx = -1e30f;
#pragma unroll
    for (int nt = 0; nt < 16; ++nt)
#pragma unroll
        for (int j = 0; j < 4; ++j) mx = fmaxf(mx, s[nt][j]);
    mx = fmaxf(mx, __shfl_xor(mx, 16)); mx = fmaxf(mx, __shfl_xor(mx, 32));
    const float sc = 0.08838834764831845f * 1.4426950408889634f; float l = 0.f;
#pragma unroll
    for (int nt = 0; nt < 16; ++nt)
#pragma unroll
        for (int j = 0; j < 4; ++j) { const float pz = exp2f((s[nt][j] - mx) * sc); s[nt][j] = pz; l += pz; }
    l += __shfl_xor(l, 16); l += __shfl_xor(l, 32);
    f32x4 o[8];
#pragma unroll
    for (int dt = 0; dt < 8; ++dt) o[dt] = (f32x4){0.f, 0.f, 0.f, 0.f};
#pragma unroll
    for (int c = 0; c < 8; ++c) { union { u32x4 u; bf16x8 v; } pf;
        pf.u.x = cvt_pk_bf16(s[2 * c][0], s[2 * c][1]); pf.u.y = cvt_pk_bf16(s[2 * c][2], s[2 * c][3]); pf.u.z = cvt_pk_bf16(s[2 * c + 1][0], s[2 * c + 1][1]); pf.u.w = cvt_pk_bf16(s[2 * c + 1][2], s[2 * c + 1][3]);
#pragma unroll
        for (int dt = 0; dt < 8; ++dt) { const bf16_t* vr = Vt + ((size_t)b * 512 + h * 128 + 16 * dt + fr) * 256 + 32 * c + 4 * fq; union { u32x4 u; bf16x8 v; } vf;
            const u32x2 lo = *(const u32x2*)vr, hi = *(const u32x2*)(vr + 16); vf.u.x = lo.x; vf.u.y = lo.y; vf.u.z = hi.x; vf.u.w = hi.y;
            o[dt] = mfma16(vf.v, pf.v, o[dt]); } }
    const float il = 1.0f / l;
#pragma unroll
    for (int dt = 0; dt < 8; ++dt) st_bf4(Yx + (size_t)t * 512 + h * 128 + 16 * dt + 4 * fq, o[dt] * il);
}

constexpr int XK_STRIDE = 272, XV_STRIDE = 528, XV_OFF = 256 * XK_STRIDE;
__device__ __forceinline__ void xa_pair(LAS unsigned char* lds, const bf16_t* Ux, const bf16_t* Kb, const bf16_t* Vt, bf16_t* Yx, int pair, int tid) {
    const int bh = pair >> 4, b = bh >> 2, h = bh & 3, blk0 = (pair & 15) * 2; const int lane = tid & 63, wave = tid >> 6, fr = lane & 15, fq = lane >> 4;
    u32x4 kst[8], vst[8];
#pragma unroll
    for (int e = 0; e < 8; ++e) { const int ch = tid + 512 * e; const int key = ch >> 4, part = ch & 15, dr = ch >> 5, pv = ch & 31;
        kst[e] = *(const u32x4*)(Kb + (size_t)(b * 256 + key) * 512 + h * 128 + part * 8); vst[e] = *(const u32x4*)(Vt + ((size_t)b * 512 + h * 128 + dr) * 256 + pv * 8); }
#pragma unroll
    for (int e = 0; e < 8; ++e) { const int ch = tid + 512 * e; const int key = ch >> 4, part = ch & 15, dr = ch >> 5, pv = ch & 31;
        *(LAS u32x4*)(lds + key * XK_STRIDE + part * 16) = kst[e]; *(LAS u32x4*)(lds + XV_OFF + dr * XV_STRIDE + pv * 16) = vst[e]; }
    __syncthreads();
#pragma unroll 1
    for (int tq = 0; tq < 2; ++tq) {
        const int t = b * SEQ + (blk0 + tq) * 128 + 16 * wave + fr;
        bf16x8 qf[4];
#pragma unroll
        for (int ks = 0; ks < 4; ++ks) qf[ks] = *(const bf16x8*)(Ux + (size_t)t * 512 + h * 128 + ks * 32 + fq * 8);
        f32x4 s[16];
#pragma unroll
        for (int nt = 0; nt < 16; ++nt) { s[nt] = (f32x4){0.f, 0.f, 0.f, 0.f}; LAS const unsigned char* kr = lds + (16 * nt + fr) * XK_STRIDE + fq * 16;
#pragma unroll
            for (int ks = 0; ks < 4; ++ks) s[nt] = mfma16(*(LAS const bf16x8*)(kr + ks * 64), qf[ks], s[nt]);
            if (nt & 1) asm volatile("" ::: "memory"); }
        float mx = -1e30f;
#pragma unroll
        for (int nt = 0; nt < 16; ++nt)
#pragma unroll
            for (int j = 0; j < 4; ++j) mx = fmaxf(mx, s[nt][j]);
        mx = fmaxf(mx, __shfl_xor(mx, 16)); mx = fmaxf(mx, __shfl_xor(mx, 32));
        const float sc = 0.08838834764831845f * 1.4426950408889634f; float l = 0.f;
#pragma unroll
        for (int nt = 0; nt < 16; ++nt)
#pragma unroll
            for (int j = 0; j < 4; ++j) { const float pz = exp2f((s[nt][j] - mx) * sc); s[nt][j] = pz; l += pz; }
        l += __shfl_xor(l, 16); l += __shfl_xor(l, 32);
        f32x4 o[8];
#pragma unroll
        for (int dt = 0; dt < 8; ++dt) o[dt] = (f32x4){0.f, 0.f, 0.f, 0.f};
#pragma unroll
        for (int c = 0; c < 8; ++c) { union { u32x4 u; bf16x8 v; } pf;
            pf.u.x = cvt_pk_bf16(s[2 * c][0], s[2 * c][1]); pf.u.y = cvt_pk_bf16(s[2 * c][2], s[2 * c][3]); pf.u.z = cvt_pk_bf16(s[2 * c + 1][0], s[2 * c + 1][1]); pf.u.w = cvt_pk_bf16(s[2 * c + 1][2], s[2 * c + 1][3]);
#pragma unroll
            for (int dt = 0; dt < 8; ++dt) { LAS const unsigned char* vr = lds + XV_OFF + (16 * dt + fr) * XV_STRIDE + (32 * c + 4 * fq) * 2; union { u32x4 u; bf16x8 v; } vf;
                const u32x2 lo = *(LAS const u32x2*)vr, hi = *(LAS const u32x2*)(vr + 32); vf.u.x = lo.x; vf.u.y = lo.y; vf.u.z = hi.x; vf.u.w = hi.y;
                o[dt] = mfma16(vf.v, pf.v, o[dt]); }
            asm volatile("" ::: "memory"); }
        const float il = 1.0f / l;
#pragma unroll
        for (int dt = 0; dt < 8; ++dt) st_bf4(Yx + (size_t)t * 512 + h * 128 + 16 * dt + 4 * fq, o[dt] * il);
    }
    __syncthreads();
}

struct Params { const float* in[33]; float* out; unsigned char* ws; };

__device__ __forceinline__ int opaque0() { int z = 0; asm volatile("" : "+s"(z)); return z; }
typedef __attribute__((address_space(1))) unsigned char* gptr_t;
typedef __attribute__((address_space(1))) const float* gcf_t;
__device__ __forceinline__ int opqv(int v) { asm volatile("" : "+v"(v)); return v; }
__device__ __forceinline__ int opqs(int v) { asm volatile("" : "+s"(v)); return v; }
#define PH_BEGIN const int zi = opaque0(); unsigned char* ws = P.ws + zi; float* const OUT = P.out + zi; (void)OUT; const int tid = opqv((int)threadIdx.x); const int bid = opqs((int)blockIdx.x); const int G = opqs((int)gridDim.x); (void)tid; (void)bid; (void)G; unsigned char* WB = ws + WS_WB; float* SS = (float*)(ws + WS_SS); (void)WB; (void)SS; (void)zi;
#define INP(k) (P.in[(k)] + zi)
#define XB_ ((bf16_t*)(ws + WS_XB))
#define U_ (ws + WS_U)
#define SC_ (ws + WS_SC)
#define Y_ ((bf16_t*)(ws + WS_Y))
#define KB_ ((bf16_t*)(ws + WS_KB))
#define VT_ ((bf16_t*)(ws + WS_VT))

constexpr size_t WS_BAR = WS_MISC + 8192;
__device__ __forceinline__ void grid_bar(unsigned* ctr, unsigned target) {
    asm volatile("s_waitcnt vmcnt(0)" ::: "memory");
    __syncthreads();
    if (threadIdx.x == 0) {
        __builtin_amdgcn_fence(__ATOMIC_RELEASE, "agent");
        asm volatile("s_waitcnt vmcnt(0)" ::: "memory");
        __hip_atomic_fetch_add(ctr, 1u, __ATOMIC_RELAXED, __HIP_MEMORY_SCOPE_AGENT);
        while (__hip_atomic_load(ctr, __ATOMIC_RELAXED, __HIP_MEMORY_SCOPE_AGENT) < target) __builtin_amdgcn_s_sleep(2);
        __builtin_amdgcn_fence(__ATOMIC_ACQUIRE, "agent");
        asm volatile("s_waitcnt vmcnt(0)" ::: "memory");
    }
    __syncthreads();
}

#define XB_TMO      128
#define XB_XCNT(j)  (256  + 64 * (j))
#define XB_XSUB(j)  (1280 + 64 * (j))
#define XB_XGEN(j)  (2304 + 64 * (j))
#define XB_TOP      3328
#define XB_TOPGEN   3392
#define XCD_BAR_WORDS 3456
#define XB_SPIN_CAP (1u << 18)
constexpr size_t WS_XBAR2 = WS_MISC + 32768;
constexpr size_t WS_XBAR = WS_MISC + 16384;
__device__ __forceinline__ unsigned xb_ld(unsigned* p)              { return __hip_atomic_load(p, __ATOMIC_RELAXED, __HIP_MEMORY_SCOPE_AGENT); }
__device__ __forceinline__ unsigned xb_add(unsigned* p, unsigned v) { return __hip_atomic_fetch_add(p, v, __ATOMIC_RELAXED, __HIP_MEMORY_SCOPE_AGENT); }
__device__ __forceinline__ unsigned xb_xcc_id() { return (unsigned)__builtin_amdgcn_s_getreg((3 << 11) | 20) & 0xFu; }
#define XB_SPIN(cond, bar) do { unsigned _sp = 0; while (cond) { __builtin_amdgcn_s_sleep(1); \
    if ((++_sp & 255u) == 0u) { if (xb_ld(&(bar)[XB_TMO])) break; if (_sp > XB_SPIN_CAP) { atomicAdd(&(bar)[XB_TMO], 1u); break; } } } } while (0)
__device__ __forceinline__ void xcd_barrier_complete(unsigned* bar, unsigned x, unsigned& nloc, unsigned& nx, const unsigned G) {
    unsigned sum, cnt, mine, sp = 0u;
    for (;;) {
        sum = 0u; cnt = 0u; mine = 0u;
#pragma unroll
        for (unsigned j = 0; j < 16; ++j) { const unsigned c = xb_ld(&bar[XB_XCNT(j)]); sum += c; cnt += (c > 0u) ? 1u : 0u; mine = (j == x) ? c : mine; }
        if (sum == G) break;
        __builtin_amdgcn_s_sleep(1);
        if ((++sp & 255u) == 0u) { if (xb_ld(&bar[XB_TMO])) break; if (sp > XB_SPIN_CAP) { atomicAdd(&bar[XB_TMO], 1u); break; } }
    }
    nloc = mine > 0u ? mine : 1u; nx = cnt > 0u ? cnt : 1u;
}
__device__ __forceinline__ void xcd_barrier(unsigned* bar, volatile LAS unsigned* st, const unsigned total) {
    asm volatile("s_waitcnt vmcnt(0)" ::: "memory");
    __syncthreads();
    if (threadIdx.x == 0) {
        const unsigned x = xb_xcc_id();
        __builtin_amdgcn_s_waitcnt(0);
        unsigned nloc = st[0], nx = st[1];
        if (nloc == 0u) { xcd_barrier_complete(bar, x, nloc, nx, total); st[0] = nloc; st[1] = nx; }
        const unsigned old = xb_add(&bar[XB_XSUB(x)], 1u);
        const unsigned gen = old / nloc;
        if (old + 1u == (gen + 1u) * nloc) {
            __builtin_amdgcn_fence(__ATOMIC_RELEASE, "agent");
            asm volatile("s_waitcnt vmcnt(0)" ::: "memory");
            const unsigned og = xb_add(&bar[XB_TOP], 1u);
            const unsigned tg = og / nx;
            if (og + 1u == (tg + 1u) * nx) xb_add(&bar[XB_TOPGEN], 1u);
            else XB_SPIN(xb_ld(&bar[XB_TOPGEN]) == tg, bar);
            __builtin_amdgcn_fence(__ATOMIC_ACQUIRE, "agent");
            xb_add(&bar[XB_XGEN(x)], 1u);
            asm volatile("s_waitcnt vmcnt(0)" ::: "memory");
        } else {
            XB_SPIN(xb_ld(&bar[XB_XGEN(x)]) == gen, bar);
            __builtin_amdgcn_fence(__ATOMIC_ACQUIRE, "agent");
            asm volatile("s_waitcnt vmcnt(0)" ::: "memory");
        }
    }
    __syncthreads();
}

__global__ void __launch_bounds__(512) mega(Params P) {
    extern __shared__ __attribute__((aligned(16))) unsigned char lds_raw[];
    LAS unsigned char* lds = (LAS unsigned char*)lds_raw;
    cg::grid_group grid = cg::this_grid();
    volatile LAS unsigned* xst = (volatile LAS unsigned*)(lds + LDS_BYTES - 16);
    if (threadIdx.x == 0) { xst[0] = 0u; xst[1] = 0u; xst[2] = 0u; xst[3] = 0u; (void)xb_add(&((unsigned*)(P.ws + WS_XBAR))[XB_XCNT(xb_xcc_id())], 1u);
        if (blockIdx.x >= 128) (void)xb_add(&((unsigned*)(P.ws + WS_XBAR2))[XB_XCNT(xb_xcc_id())], 1u); }
    __syncthreads();

    unsigned nsub = 0;
    for (int ph = 0; ph < NL * 12 + 1; ++ph) {
        const int l = ph / 12, kph = ph - l * 12;
        if (ph == NL * 12) {
#if (PHMASK >> 12) & 1
    { PH_BEGIN
        const int lane = tid & 63, gw = bid * 8 + (tid >> 6), nw = G * 8;
        const float* fn = INP(32); const float* ssf = SS + (size_t)0 * T * 16; float* X = OUT;
        for (int r = gw; r < T; r += nw) { const float rs = row_rstd(ssf, r);
#pragma unroll
            for (int i = 0; i < 4; ++i) { const size_t o = (size_t)r * D + i * 256 + lane * 4; *(f32x4*)(X + o) = *(const f32x4*)(X + o) * rs * *(const f32x4*)(fn + i * 256 + lane * 4); } }
    }
#endif
            break;
        }
        switch (kph) {
        case 0: {
#if (PHMASK >> 0) & 1
        for (int rep = 0; rep < REP0; ++rep) {
        {
            { PH_BEGIN convT_w<1>(INP(3) + (size_t)l * D * 2 * FF, 2 * FF, 0, INP(2) + (size_t)l * D, (bf16_t*)(WB + WB_W1A), D, D, 2 * FF, bid * 8 + (tid >> 6), G * 8, tid & 63, 0); }
            { PH_BEGIN convT_w<0>(INP(4) + (size_t)l * FF * D, D, 0, nullptr, (bf16_t*)(WB + WB_W1B), FF, FF, D, bid * 8 + (tid >> 6), G * 8, tid & 63, 1408); }
            { PH_BEGIN convT_w<2>(INP(7) + (size_t)l * D * 6928, 6928, 0, INP(5) + (size_t)l * D, (bf16_t*)(WB + WB_WIN), D, D, 4096, bid * 8 + (tid >> 6), G * 8, tid & 63, 2112); }
            { PH_BEGIN convT_w<0>(INP(7) + (size_t)l * D * 6928, 6928, 3856, INP(5) + (size_t)l * D, (bf16_t*)(WB + WB_WG), D, D, 3072, bid * 8 + (tid >> 6), G * 8, tid & 63, 3136); }
            for (int j = 0; j < 3; ++j) { PH_BEGIN convT_w<0>(INP(27) + ((size_t)l * 3 + j) * 512 * D, D, 0, nullptr, (bf16_t*)(WB + WB_WBR) + (size_t)j * D * 512, 512, 512, D, bid * 8 + (tid >> 6), G * 8, tid & 63, 3904 + 128 * j); }
            { PH_BEGIN convT_w<0>(INP(28) + (size_t)l * D * D, D, 0, nullptr, (bf16_t*)(WB + WB_WO), D, D, D, bid * 8 + (tid >> 6), G * 8, tid & 63, 4288); }
            { PH_BEGIN convT_w<0>(INP(26) + (size_t)l * D * D, D, 0, INP(6) + (size_t)l * D, (bf16_t*)(WB + WB_WKV), D, D, D, bid * 8 + (tid >> 6), G * 8, tid & 63, 4544); }
            { PH_BEGIN convT_w<1>(INP(30) + (size_t)l * D * 2 * FF, 2 * FF, 0, INP(29) + (size_t)l * D, (bf16_t*)(WB + WB_W2A), D, D, 2 * FF, bid * 8 + (tid >> 6), G * 8, tid & 63, 4800); }
            { PH_BEGIN convT_w<0>(INP(31) + (size_t)l * FF * D, D, 0, nullptr, (bf16_t*)(WB + WB_W2B), FF, FF, D, bid * 8 + (tid >> 6), G * 8, tid & 63, 6208); }
            { PH_BEGIN convT_w<0>(INP(10) + (size_t)l * 64 * 512, 512, 0, nullptr, (bf16_t*)(WB + WB_LW2), 64, 64, 512, bid * 8 + (tid >> 6), G * 8, tid & 63, 6912); }
            { PH_BEGIN convT_w<0>(INP(12) + (size_t)l * 64 * 512, 512, 0, nullptr, (bf16_t*)(WB + WB_LA2), 64, 64, 512, bid * 8 + (tid >> 6), G * 8, tid & 63, 6920); }
            { PH_BEGIN convT_w<0>(INP(13) + (size_t)l * 128 * 512, 512, 0, nullptr, (bf16_t*)(WB + WB_LG2), 128, 128, 512, bid * 8 + (tid >> 6), G * 8, tid & 63, 6928); }
            if (l > 0) {
                { PH_BEGIN convT_w<0>(INP(20) + (size_t)(l - 1) * 512 * 32, 32, 0, nullptr, (bf16_t*)(WB + WB_LV1), 512, 512, 32, bid * 8 + (tid >> 6), G * 8, tid & 63, 6944); }
                { PH_BEGIN convT_w<0>(INP(21) + (size_t)(l - 1) * 32 * 512, 512, 0, nullptr, (bf16_t*)(WB + WB_LV2), 32, 32, 512, bid * 8 + (tid >> 6), G * 8, tid & 63, 6976); }
            }
            if (l == 0) { PH_BEGIN
                const int lane = tid & 63, gw = bid * 8 + (tid >> 6), nw = G * 8;
                float* rstd_mem = (float*)(ws + WS_MISC); bf16_t* MEMN = (bf16_t*)(ws + WS_MEMN);
                for (int r = gw; r < T + 1024; r += nw) {
                    const bool ism = r >= T; const float* src = ism ? INP(1) + (size_t)(r - T) * D : INP(0) + (size_t)r * D; bf16_t* dst = ism ? MEMN + (size_t)(r - T) * D : XB_ + (size_t)r * D; float q = 0.f;
#pragma unroll
                    for (int i = 0; i < 4; ++i) { const f32x4 v = *(const f32x4*)(src + i * 256 + lane * 4); st_bf4(dst + i * 256 + lane * 4, v); q += (v[0] * v[0] + v[1] * v[1]) + (v[2] * v[2] + v[3] * v[3]); }
                    q = wave_sum(q);
                    if (ism) { if (lane == 0) rstd_mem[r - T] = rsqrtf(q * (1.0f / 1024.0f) + 1e-6f); } else if (lane < 16) SS[(size_t)r * 16 + lane] = (lane == 0) ? q : 0.f;
                }
            }
        }
        }
#endif
        } break;
        case 1: {
#if (PHMASK >> 1) & 1
        for (int rep = 0; rep < REPG; ++rep) {
        { PH_BEGIN
            pg8::Gemm g{XB_, (const bf16_t*)(WB + WB_W1A), T, 2 * FF, D, D, D, 0, 0}; pg8::StaticOrder S; S.init(T, 2 * FF, G, bid, 1);
            EpiFFNa E{(bf16_t*)U_, SS + (size_t)0 * T * 16}; pg8::gemm_phase(lds, g, S, E, tid);
        }
        if ((int)blockIdx.x >= (int)gridDim.x - 16) { PH_BEGIN
            pg8::Gemm g2{(const bf16_t*)(ws + WS_MEMN), (const bf16_t*)(WB + WB_WKV), 1024, D, D, D, D, 0, 0}; pg8::StaticOrder S2; S2.init(1024, D, 16, bid - (G - 16), 1);
            EpiKV E2{KB_, VT_, (const float*)(ws + WS_MISC)}; pg8::gemm_phase(lds, g2, S2, E2, tid);
        }
        }
#endif
        } break;
        case 2: {
#if (PHMASK >> 2) & 1
        { PH_BEGIN
            pg8::Gemm g{(const bf16_t*)U_, (const bf16_t*)(WB + WB_W1B), T, D, FF, FF, FF, 0, 0}; pg8::StaticOrder S; S.init(T, D, G, bid, 1);
            EpiRes E{l == 0 ? INP(0) : OUT, OUT, XB_, SS + (size_t)1 * T * 16, 0.5f}; pg8::gemm_phase(lds, g, S, E, tid);
        }
#endif
        } break;
        case 3: {
#if (PHMASK >> 3) & 1
        for (int rep = 0; rep < REPG; ++rep) {
        { PH_BEGIN
            pg8::Gemm g{XB_, (const bf16_t*)(WB + WB_WIN), T, 4096, D, D, D, 0, 0}; pg8::StaticOrder S; S.init(T, 4096, G, bid, 1);
            EpiU E{(bf16_t*)U_, SS + (size_t)1 * T * 16}; pg8::gemm_phase(lds, g, S, E, tid);
        }
        }
#endif
        } break;
        case 4: {
#if (PHMASK >> 4) & 1
        { PH_BEGIN
            PrepArgs PA; PA.U = (const bf16_t*)(U_ + U_RWKV); PA.mu = INP(8) + (size_t)l * 1792; PA.w0 = INP(9) + (size_t)l * 512; PA.a0 = INP(11) + (size_t)l * 512;
            PA.kk_ = INP(14) + (size_t)l * 512; PA.ka = INP(15) + (size_t)l * 512; PA.rk = INP(16) + (size_t)l * 512; PA.v0 = INP(19) + (size_t)(l > 0 ? l - 1 : 0) * 512;
            PA.w2t = (const bf16_t*)(WB + WB_LW2); PA.a2t = (const bf16_t*)(WB + WB_LA2); PA.g2t = (const bf16_t*)(WB + WB_LG2); PA.v1t = (const bf16_t*)(WB + WB_LV1); PA.v2t = (const bf16_t*)(WB + WB_LV2);
            PA.vfirst = (float*)(ws + WS_VF); PA.Wd = (float*)(SC_ + SC_WD); PA.V = (float*)(SC_ + SC_V); PA.RKKB = (bf16_t*)(SC_ + SC_RKKB); PA.Go = (bf16_t*)(ws + WS_GO); PA.Bon = (float*)(ws + WS_BON); PA.layer = l;
            { const int tt = (bid & 7) * 32 + (bid >> 3); rwkv_prep_tile(lds, PA, tt, tid); }
        }
        { PH_BEGIN
            { const int x = bid & 7, j = bid >> 3, pm = 8 * x + (j & 7), h = j >> 3, b = pm >> 4, pq = pm & 15; const int pair = ((b * 4 + h) << 4) | pq;
              xa_pair(lds, (const bf16_t*)(U_ + U_XA), KB_, VT_, Y_ + (size_t)2 * T * 512, pair, tid); }
        }
        { PH_BEGIN
            GlaArgs GA; GA.Ug = (const bf16_t*)(U_ + U_GLA); GA.conv = INP(22) + (size_t)l * 4096; GA.aup = INP(23) + (size_t)l * 4096; GA.abias = INP(24) + (size_t)l * 256; GA.gnorm = INP(25) + (size_t)l * 512;
            GA.kvcT = (float*)(ws + WS_KVC); GA.dec = (float*)(ws + WS_DEC); GA.spT = (bf16_t*)(U_ + U_SPT); GA.Yg = Y_ + (size_t)T * 512;
            { const int x = bid & 7, j = bid >> 3, b = x >> 1, nhi = x & 1;
              for (int k = 0; k < 0; ++k) { const int idx = j * 2 + k, h = idx >> 5, n = nhi * 32 + (idx & 31); gla_a_tile(lds, GA, ((b * 4 + h) << 6) | n, tid); } }
        }
#endif
        } break;
        case 5: {
#if (PHMASK >> 5) & 1
        if ((int)blockIdx.x < 128) { PH_BEGIN
            const int xcd = bid & 7, j = bid >> 3, p = xcd * 4 + (j >> 2), rg = j & 3;
            rwkv_scan_unit(lds, (const float*)(SC_ + SC_WD), (const float*)(SC_ + SC_V), (const bf16_t*)(SC_ + SC_RKKB), (float*)(U_ + U_YRAW), p, rg, tid);
        } else {
            { PH_BEGIN
            GlaArgs GA; GA.Ug = (const bf16_t*)(U_ + U_GLA); GA.conv = INP(22) + (size_t)l * 4096; GA.aup = INP(23) + (size_t)l * 4096; GA.abias = INP(24) + (size_t)l * 256; GA.gnorm = INP(25) + (size_t)l * 512;
            GA.kvcT = (float*)(ws + WS_KVC); GA.dec = (float*)(ws + WS_DEC); GA.spT = (bf16_t*)(U_ + U_SPT); GA.Yg = Y_ + (size_t)T * 512;
            { const int x = bid & 7, j = (bid - 128) >> 3, b = x >> 1, nhi = x & 1;
              for (int k = 0; k < 8; ++k) { const int idx = j * 8 + k, h = idx >> 5, n = nhi * 32 + (idx & 31); gla_a_tile(lds, GA, ((b * 4 + h) << 6) | n, tid); } }
            }
            xcd_barrier((unsigned*)(P.ws + WS_XBAR2), xst + 2, 128u);
            { PH_BEGIN
            bf16_t* spT = (bf16_t*)(U_ + U_SPT); const float* DEC = (const float*)(ws + WS_DEC); const float* KVC = (const float*)(ws + WS_KVC);
            for (int i = (bid - 128) * 512 + tid; i < 16 * 128 * 64; i += 128 * 512) { const int bh = i >> 13, ed = i & 8191, d = i & 63; float st = 0.f;
                for (int n0 = 0; n0 < 64; n0 += 16) { float kv[16], dc[16];
#pragma unroll
                    for (int q = 0; q < 16; ++q) { kv[q] = KVC[((size_t)bh * 64 + n0 + q) * 8192 + ed]; dc[q] = DEC[((size_t)bh * 64 + n0 + q) * 64 + d]; }
#pragma unroll
                    for (int q = 0; q < 16; ++q) { spT[((size_t)bh * 64 + n0 + q) * 8192 + ed] = f2bf(st); st = st * dc[q] + kv[q]; } } }
            }
            xcd_barrier((unsigned*)(P.ws + WS_XBAR2), xst + 2, 128u);
            { PH_BEGIN
            GlaArgs GA; GA.Ug = (const bf16_t*)(U_ + U_GLA); GA.conv = INP(22) + (size_t)l * 4096; GA.aup = INP(23) + (size_t)l * 4096; GA.abias = INP(24) + (size_t)l * 256; GA.gnorm = INP(25) + (size_t)l * 512;
            GA.kvcT = (float*)(ws + WS_KVC); GA.dec = (float*)(ws + WS_DEC); GA.spT = (bf16_t*)(U_ + U_SPT); GA.Yg = Y_ + (size_t)T * 512;
            { const int x = bid & 7, j = (bid - 128) >> 3, b = x >> 1, nhi = x & 1;
              for (int k = 0; k < 8; ++k) { const int idx = j * 8 + k, h = idx >> 5, n = nhi * 32 + (idx & 31); gla_c_tile(lds, GA, ((b * 4 + h) << 6) | n, tid); } }
            }
        }
#endif
        } break;
        case 6: {
#if (PHMASK >> 6) & 1
        { PH_BEGIN
            const int lane = tid & 63, gw = bid * 8 + (tid >> 6), nw = G * 8;
            const float* lnw = INP(17) + (size_t)l * 512; const float* lnb = INP(18) + (size_t)l * 512; const float* Yraw = (const float*)(U_ + U_YRAW); const float* Vv = (const float*)(SC_ + SC_V);
            const float* BON = (const float*)(ws + WS_BON); const bf16_t* GO = (const bf16_t*)(ws + WS_GO); bf16_t* Y = Y_;
            const int kq = lane & 15, sub = lane >> 4;
#pragma unroll 4
            for (int it0 = gw * 4; it0 < 32 * SEQ; it0 += nw * 4) { const int it = it0 + sub; const int p = it >> 12, s = it & (SEQ - 1), b = p >> 3, h = p & 7, t = b * SEQ + s;
                const f32x4 y = *(const f32x4*)(Yraw + (size_t)it * 64 + kq * 4); const f32x4 vv = *(const f32x4*)(Vv + (size_t)it * 64 + kq * 4);
                const f32x4 gg = ld_bf4(GO + (size_t)t * 512 + h * 64 + kq * 4); const f32x4 lw = *(const f32x4*)(lnw + h * 64 + kq * 4), lb = *(const f32x4*)(lnb + h * 64 + kq * 4); const float bon = BON[(size_t)t * 8 + h];
                const float mean = row16_sum((y[0] + y[1]) + (y[2] + y[3])) * (1.0f / 64.0f); const f32x4 dl = y - mean;
                const float var = row16_sum((dl[0] * dl[0] + dl[1] * dl[1]) + (dl[2] * dl[2] + dl[3] * dl[3])) * (1.0f / 64.0f); const float rs = rsqrtf(var + 64e-5f);
                st_bf4(Y + (size_t)t * 512 + h * 64 + kq * 4, ((dl * rs) * lw + lb + vv * bon) * gg); }
        }
#endif
        } break;
        case 7: {
#if (PHMASK >> 7) & 1
        for (int rep = 0; rep < REPG; ++rep) {
        { PH_BEGIN
            pg8::Gemm g{XB_, (const bf16_t*)(WB + WB_WG), T, 3072, D, D, D, 0, 0}; pg8::StaticOrder S; S.init(T, 3072, G, bid, 1);
            EpiGate E{(unsigned char*)SC_, SS + (size_t)1 * T * 16}; pg8::gemm_phase(lds, g, S, E, tid);
        }
        }
#endif
        } break;
        case 8: {
#if (PHMASK >> 8) & 1
        for (int rep = 0; rep < REPG; ++rep) {
        { PH_BEGIN
            pg8::Gemm g{Y_, (const bf16_t*)(WB + WB_WBR), T, D, 512, 512, 512, (unsigned)T * 512u * 2u, (unsigned)D * 512u * 2u}; pg8::StaticOrder S; S.init(T, D, G, bid, 3);
            EpiMerge E{(const unsigned char*)SC_, (float*)(U_ + U_MG), (bf16_t*)(U_ + U_MGB)}; pg8::gemm_phase(lds, g, S, E, tid);
        }
        }
#endif
        } break;
        case 9: {
#if (PHMASK >> 9) & 1
        { PH_BEGIN
            pg8::Gemm g{(const bf16_t*)(U_ + U_MGB), (const bf16_t*)(WB + WB_WO), T, D, D, D, D, 0, 0}; pg8::StaticOrder S; S.init(T, D, G, bid, 1);
            EpiRes E{OUT, OUT, XB_, SS + (size_t)2 * T * 16, 1.0f}; pg8::gemm_phase(lds, g, S, E, tid);
        }
#endif
        } break;
        case 10: {
#if (PHMASK >> 10) & 1
        for (int rep = 0; rep < REPG; ++rep) {
        { PH_BEGIN
            pg8::Gemm g{XB_, (const bf16_t*)(WB + WB_W2A), T, 2 * FF, D, D, D, 0, 0}; pg8::StaticOrder S; S.init(T, 2 * FF, G, bid, 1);
            EpiFFNa E{(bf16_t*)U_, SS + (size_t)2 * T * 16}; pg8::gemm_phase(lds, g, S, E, tid);
        }
        }
#endif
        } break;
        case 11: {
#if (PHMASK >> 11) & 1
        { PH_BEGIN
            pg8::Gemm g{(const bf16_t*)U_, (const bf16_t*)(WB + WB_W2B), T, D, FF, FF, FF, 0, 0}; pg8::StaticOrder S; S.init(T, D, G, bid, 1);
            EpiRes E{OUT, OUT, XB_, SS + (size_t)0 * T * 16, 0.5f}; pg8::gemm_phase(lds, g, S, E, tid);
        }
#endif
        } break;
        default: break;
        }
        if (ph == 0) grid.sync();
        else xcd_barrier((unsigned*)(P.ws + WS_XBAR), xst, gridDim.x);
    }
}

extern "C" void kernel_launch(void* const* d_in, const int* in_sizes, int n_in, void* d_out, int out_size, void* d_ws, size_t ws_size, hipStream_t stream) {
    static int grid_blocks = 0;
    if (!grid_blocks) {
        if (n_in != 33 || ws_size < WS_END) { fprintf(stderr, "kernel_launch: need 33 inputs and %zu bytes of workspace (got %d, %zu)\n", (size_t)WS_END, n_in, ws_size); grid_blocks = -1; return; }
        int dev = 0, cus = 0, per_cu = 0;
        hipGetDevice(&dev); hipDeviceGetAttribute(&cus, hipDeviceAttributeMultiprocessorCount, dev);
        if (hipFuncSetAttribute((const void*)mega, hipFuncAttributeMaxDynamicSharedMemorySize, LDS_BYTES) != hipSuccess) { fprintf(stderr, "kernel_launch: hipFuncSetAttribute failed\n"); grid_blocks = -1; return; }
        if (hipOccupancyMaxActiveBlocksPerMultiprocessor(&per_cu, (const void*)mega, 512, LDS_BYTES) != hipSuccess || per_cu < 1) { fprintf(stderr, "kernel_launch: occupancy query says %d\n", per_cu); per_cu = 1; }
        (void)hipGetLastError();
        grid_blocks = cus * per_cu;
        if (grid_blocks != 256) { fprintf(stderr, "kernel_launch: this kernel splits a 256-workgroup grid in its scan phase (got %d)\n", grid_blocks); grid_blocks = -1; return; }
    }
    if (grid_blocks < 0) return;
    if (hipMemsetAsync((char*)d_ws + WS_BAR, 0, (WS_XBAR2 - WS_BAR) + XCD_BAR_WORDS * 4, stream) != hipSuccess) { fprintf(stderr, "kernel_launch: memset failed\n"); return; }
    Params p{};
    for (int i = 0; i < 33; ++i) p.in[i] = (const float*)d_in[i];
    p.out = (float*)d_out; p.ws = (unsigned char*)d_ws;
    void* args[] = {&p};
    hipError_t e = hipLaunchCooperativeKernel((const void*)mega, dim3(grid_blocks), dim3(512), args, LDS_BYTES, stream);
    if (e != hipSuccess) fprintf(stderr, "cooperative launch failed: %s (grid %d)\n", hipGetErrorString(e), grid_blocks);
}
```

```cpp
#include <hip/hip_runtime.h>
#include <hip/hip_cooperative_groups.h>
#include <cstdio>
namespace cg = cooperative_groups;
#ifndef P4SUB
#define P4SUB 7
#endif
#ifndef REP5
#define REP5 1
#endif
#ifndef REP4
#define REP4 1
#endif
#ifndef REP6
#define REP6 1
#endif
#ifndef REP0
#define REP0 1
#endif
#ifndef REPG
#define REPG 1
#endif
#ifndef REPSYNC
#define REPSYNC 1
#endif
#ifndef NA4
#define NA4 2
#endif
#ifndef PHMASK
#define PHMASK 0xFFFF
#endif

#define LAS __attribute__((address_space(3)))
typedef unsigned short bf16_t;
typedef short bf16x8 __attribute__((ext_vector_type(8)));
typedef float f32x4 __attribute__((ext_vector_type(4)));
typedef float f32x2 __attribute__((ext_vector_type(2)));
typedef unsigned u32x4 __attribute__((ext_vector_type(4)));
typedef unsigned u32x2 __attribute__((ext_vector_type(2)));

constexpr int T = 16384, D = 1024, FF = 2816, SEQ = 4096, NL = 4;
constexpr int LDS_BYTES = 139264;

constexpr size_t MB = 1024 * 1024;
constexpr size_t WS_MISC = 0;
constexpr size_t WS_SS = 1 * MB;
constexpr size_t WS_WB = 4 * MB;
constexpr size_t WB_W1A = 0;
constexpr size_t WB_W1B = WB_W1A + (size_t)5632 * 1024 * 2;
constexpr size_t WB_WIN = WB_W1B + (size_t)1024 * 2816 * 2;
constexpr size_t WB_WG = WB_WIN + (size_t)4096 * 1024 * 2;
constexpr size_t WB_WBR = WB_WG + (size_t)3072 * 1024 * 2;
constexpr size_t WB_WO = WB_WBR + (size_t)3 * 1024 * 512 * 2;
constexpr size_t WB_WKV = WB_WO + (size_t)1024 * 1024 * 2;
constexpr size_t WB_W2A = WB_WKV + (size_t)1024 * 1024 * 2;
constexpr size_t WB_W2B = WB_W2A + (size_t)5632 * 1024 * 2;
constexpr size_t WB_LW2 = WB_W2B + (size_t)1024 * 2816 * 2;
constexpr size_t WB_LA2 = WB_LW2 + 512 * 64 * 2;
constexpr size_t WB_LG2 = WB_LA2 + 512 * 64 * 2;
constexpr size_t WB_LV1 = WB_LG2 + 512 * 128 * 2;
constexpr size_t WB_LV2 = WB_LV1 + 32 * 512 * 2;
constexpr size_t WB_END = WB_LV2 + 512 * 32 * 2;
static_assert(WB_END <= 55 * MB, "weights region");
constexpr size_t WS_XB = WS_WB + 55 * MB;
constexpr size_t WS_VF = WS_XB + 32 * MB;
constexpr size_t WS_MEMN = WS_VF + 32 * MB;
constexpr size_t WS_KB = WS_MEMN + 2 * MB;
constexpr size_t WS_VT = WS_KB + 1 * MB;
constexpr size_t WS_GO = WS_VT + 1 * MB;
constexpr size_t WS_BON = WS_GO + 16 * MB;
constexpr size_t WS_Y = WS_BON + 1 * MB;
constexpr size_t WS_KVC = WS_Y + 48 * MB;
constexpr size_t WS_DEC = WS_KVC + 32 * MB;
constexpr size_t WS_SC = WS_DEC + 1 * MB;
constexpr size_t SC_WD = 0;
constexpr size_t SC_V = 32 * MB;
constexpr size_t SC_RKKB = 64 * MB;
constexpr size_t WS_U = WS_SC + 128 * MB;
constexpr size_t U_RWKV = 0;
constexpr size_t U_GLA = (size_t)T * 1792 * 2;
constexpr size_t U_XA = 2 * (size_t)T * 1792 * 2;
constexpr size_t U_YRAW = 0;
constexpr size_t U_SPT = 32 * MB;
constexpr size_t U_MG = 0;
constexpr size_t U_MGB = 64 * MB;
constexpr size_t WS_END = WS_U + 128 * MB;
static_assert(U_XA + (size_t)T * 512 * 2 <= 128 * MB, "U region");

typedef __bf16 bf16x2_t __attribute__((ext_vector_type(2)));
__device__ __forceinline__ unsigned cvt_pk_bf16(float lo, float hi) { const f32x2 v = {lo, hi}; const bf16x2_t r = __builtin_convertvector(v, bf16x2_t); return __builtin_bit_cast(unsigned, r); }
__device__ __forceinline__ bf16_t f2bf(float x) { return (bf16_t)(cvt_pk_bf16(x, 0.f) & 0xffffu); }
__device__ __forceinline__ float bf2f(bf16_t b) { return __uint_as_float(((unsigned)b) << 16); }
__device__ __forceinline__ float bflo(unsigned w) { return __uint_as_float(w << 16); }
__device__ __forceinline__ float bfhi(unsigned w) { return __uint_as_float(w & 0xffff0000u); }
__device__ __forceinline__ f32x4 ld_bf4(const bf16_t* p) { const u32x2 w = *(const u32x2*)p; return (f32x4){bflo(w.x), bfhi(w.x), bflo(w.y), bfhi(w.y)}; }
__device__ __forceinline__ void st_bf4(bf16_t* p, f32x4 v) { u32x2 w; w.x = cvt_pk_bf16(v[0], v[1]); w.y = cvt_pk_bf16(v[2], v[3]); *(u32x2*)p = w; }
__device__ __forceinline__ float sigmoidf_(float x) { return __builtin_amdgcn_rcpf(1.0f + __expf(-x)); }
__device__ __forceinline__ float wave_sum(float v) { for (int o = 32; o >= 1; o >>= 1) v += __shfl_xor(v, o); return v; }
__device__ __forceinline__ f32x4 mfma16(bf16x8 a, bf16x8 b, f32x4 c) { return __builtin_amdgcn_mfma_f32_16x16x32_bf16(a, b, c, 0, 0, 0); }

__device__ __forceinline__ float row_rstd(const float* ssp, int row) {
    const f32x4* p = (const f32x4*)(ssp + (size_t)row * 16); const f32x4 a = p[0], b = p[1], c = p[2], d = p[3];
    const float t = (((a[0] + a[1]) + (a[2] + a[3])) + ((b[0] + b[1]) + (b[2] + b[3]))) + (((c[0] + c[1]) + (c[2] + c[3])) + ((d[0] + d[1]) + (d[2] + d[3])));
    return rsqrtf(t * (1.0f / 1024.0f) + 1e-6f);
}
__device__ __forceinline__ void rstd8(float (&rs)[2][4], const float* ssp, int row0, int fq) {
    f32x4 p[2][4];
#pragma unroll
    for (int ai = 0; ai < 2; ++ai)
#pragma unroll
        for (int m = 0; m < 4; ++m) p[ai][m] = *(const f32x4*)(ssp + (size_t)(row0 + ai * 128 + m * 16) * 16 + fq * 4);
#pragma unroll
    for (int ai = 0; ai < 2; ++ai)
#pragma unroll
        for (int m = 0; m < 4; ++m) { float t = (p[ai][m][0] + p[ai][m][1]) + (p[ai][m][2] + p[ai][m][3]); t += __shfl_xor(t, 16); t += __shfl_xor(t, 32); rs[ai][m] = rsqrtf(t * (1.0f / 1024.0f) + 1e-6f); }
}
namespace pg8 {
constexpr int BM = 256, BK = 64, HALF = 128, HTB = HALF * BK * 2, STAGE_BYTES = 8 * HTB, NXCD = 8, WGM = 8;
__device__ __forceinline__ int lds_byte(int r, int c) { const int st = (r >> 4) * 2 + (c >> 5), rr = r & 15, cc = c & 31, ob = rr * 64 + cc * 2; return st * 1024 + (ob ^ (((ob >> 9) & 1) << 5)); }
__device__ __forceinline__ void stage_rc(int b, int& R, int& C) { const int st = b / 1024, sb = b % 1024, swz = sb ^ (((sb >> 9) & 1) << 5); R = (st >> 1) * 16 + swz / 64; C = (st & 1) * 32 + (swz % 64) / 2; }
__device__ __forceinline__ int perm32(int rho) { const int n = rho >> 4, i = rho & 15; return 8 * (i >> 2) + 4 * n + (i & 3); }

struct Unit { int pm, pn, z; };
struct Gemm { const bf16_t* A; const bf16_t* Bt; int M, N, K, lda, ldb; unsigned zA, zB; };

struct StaticOrder {
    int nM, nN, nwg, G, c, nz;
    __device__ void init(int M, int N, int G_, int c_, int nz_) { nM = M / BM; nN = N / BM; nwg = nM * nN; G = G_; c = c_; nz = nz_; }
    __device__ bool next(int i, Unit& u) const {
        const int ti = i / nz; u.z = i - ti * nz;
        const long L = (long)ti * G + c; if (L >= nwg) return false;
        int wgid = (int)L; { const int q = nwg / NXCD, r = nwg % NXCD, xcd = wgid % NXCD, off = wgid / NXCD; wgid = (xcd < r ? xcd * (q + 1) : r * (q + 1) + (xcd - r) * q) + off; }
        const int nig = WGM * nN, gid = wgid / nig, fm = gid * WGM, gsz = (nM - fm) < WGM ? (nM - fm) : WGM;
        u.pm = fm + ((wgid % nig) % gsz); u.pn = (wgid % nig) / gsz; return true;
    }
};

template <class Epi>
__device__ __forceinline__ void gemm_phase(LAS unsigned char* lds, const Gemm g, const StaticOrder& S, const Epi& E, const int tid) {
    const int wid = __builtin_amdgcn_readfirstlane(tid >> 6), lane = tid & 63, wr = wid >> 2, wc = wid & 3, fr = lane & 15, fq = lane >> 4;
    const int K = g.K, nt = K / BK;
    unsigned voffA[2], voffB[2];
#pragma unroll
    for (int i = 0; i < 2; ++i) { int R, C; stage_rc(tid * 16 + i * 8192, R, C); const int Rb = Epi::PERM ? ((R & ~31) + perm32(R & 31)) : R;
        voffA[i] = (unsigned)(R * g.lda + C) * 2u; voffB[i] = (unsigned)(Rb * g.ldb + C) * 2u; }
    const unsigned kstep = (unsigned)(BK * 2);
    const unsigned hstepA = (unsigned)HALF * g.lda * 2u, hstepB = (unsigned)HALF * g.ldb * 2u;
    const unsigned tstepA = 2u * hstepA, tstepB = 2u * hstepB;
    const unsigned ldsw = (unsigned)wid * 1024u;
    const int aoff = lds_byte(wr * 64 + fr, fq * 8), boff = lds_byte(wc * 32 + fr, fq * 8);
    const char* const gA = (const char*)g.A; const char* const gB = (const char*)g.Bt;
#define PG8_SA(b, h) (((b) * 2 + (h)) * HTB)
#define PG8_SB(b, h) ((4 + (b) * 2 + (h)) * HTB)
#define PG8_STAGE(bufoff, gbase, soff, voff) do { _Pragma("unroll") for (int _i = 0; _i < 2; ++_i) \
        __builtin_amdgcn_global_load_lds((const unsigned*)(((gbase) + (size_t)(unsigned)(soff)) + (voff)[_i]), (LAS unsigned*)(lds + (bufoff) + ldsw + _i * 8192), 16, 0, 0); } while (0)
#define PG8_LDA(dst, b, h) do { _Pragma("unroll") for (int m = 0; m < 4; ++m) _Pragma("unroll") for (int k = 0; k < 2; ++k) dst[m][k] = *(const LAS bf16x8*)(lds + PG8_SA(b, h) + aoff + m * 2048 + k * 1024); } while (0)
#define PG8_LDB(dst, b, h) do { _Pragma("unroll") for (int n = 0; n < 2; ++n) _Pragma("unroll") for (int k = 0; k < 2; ++k) dst[n][k] = *(const LAS bf16x8*)(lds + PG8_SB(b, h) + boff + n * 2048 + k * 1024); } while (0)
#define PG8_MMA(ai, bj, At, Bt) do { __builtin_amdgcn_s_setprio(1); _Pragma("unroll") for (int m = 0; m < 4; ++m) _Pragma("unroll") for (int n = 0; n < 2; ++n) _Pragma("unroll") for (int k = 0; k < 2; ++k) \
        acc[ai][bj][m][n] = __builtin_amdgcn_mfma_f32_16x16x32_bf16(Bt[n][k], At[m][k], acc[ai][bj][m][n], 0, 0, 0); __builtin_amdgcn_s_setprio(0); } while (0)
#define PG8_WAIT_V(n) asm volatile("s_waitcnt vmcnt(" #n ")" ::: "memory")
#define PG8_WAIT_L(n) asm volatile("s_waitcnt lgkmcnt(" #n ")" ::: "memory")
#define PG8_BAR __builtin_amdgcn_s_barrier()
#define PG8_SCHED __builtin_amdgcn_sched_barrier(0)
    Unit cur, nxt; int ui = 0;
    if (!S.next(0, cur)) return;
    f32x4 acc[2][2][4][2];
#pragma unroll
    for (int a = 0; a < 2; ++a)
#pragma unroll
        for (int b = 0; b < 2; ++b)
#pragma unroll
            for (int m = 0; m < 4; ++m)
#pragma unroll
                for (int n = 0; n < 2; ++n) acc[a][b][m][n] = (f32x4){0.f, 0.f, 0.f, 0.f};
    bf16x8 At[4][2], B0[2][2], B1[2][2];
    unsigned cA = (unsigned)cur.z * g.zA + (unsigned)cur.pm * tstepA, cB = (unsigned)cur.z * g.zB + (unsigned)cur.pn * tstepB;
    PG8_STAGE(PG8_SB(0, 0), gB, cB, voffB); PG8_STAGE(PG8_SA(0, 0), gA, cA, voffA); PG8_STAGE(PG8_SB(0, 1), gB, cB + hstepB, voffB); PG8_STAGE(PG8_SA(0, 1), gA, cA + hstepA, voffA);
    if (wr == 1) PG8_BAR;
    PG8_WAIT_V(4); PG8_BAR;
    PG8_STAGE(PG8_SB(1, 0), gB, cB + kstep, voffB); PG8_STAGE(PG8_SA(1, 0), gA, cA + kstep, voffA); PG8_STAGE(PG8_SB(1, 1), gB, cB + hstepB + kstep, voffB);
    PG8_WAIT_V(6); PG8_BAR;
    for (;;) {
        const bool has_next = S.next(ui + 1, nxt);
        const unsigned nA = has_next ? (unsigned)nxt.z * g.zA + (unsigned)nxt.pm * tstepA : cA, nB = has_next ? (unsigned)nxt.z * g.zB + (unsigned)nxt.pn * tstepB : cB;
        for (int t = 0; t < nt; t += 2) {
            const bool last = (t == nt - 2);
            const unsigned a1 = cA + (unsigned)(t + 1) * kstep;
            const unsigned a2 = last ? nA : cA + (unsigned)(t + 2) * kstep, b2 = last ? nB : cB + (unsigned)(t + 2) * kstep;
            const unsigned a3 = a2 + kstep, b3 = b2 + kstep;
            PG8_LDB(B0, 0, 0); PG8_SCHED; PG8_LDA(At, 0, 0); PG8_STAGE(PG8_SA(1, 1), gA, a1 + hstepA, voffA);
            PG8_WAIT_L(8); PG8_BAR; PG8_WAIT_L(0); PG8_MMA(0, 0, At, B0); PG8_BAR; PG8_SCHED;
            PG8_LDB(B1, 0, 1); PG8_STAGE(PG8_SB(0, 0), gB, b2, voffB);
            PG8_BAR; PG8_WAIT_L(0); PG8_MMA(0, 1, At, B1); PG8_BAR;
            PG8_LDA(At, 0, 1); PG8_STAGE(PG8_SA(0, 0), gA, a2, voffA);
            PG8_BAR; PG8_WAIT_L(0); PG8_MMA(1, 0, At, B0); PG8_BAR; PG8_SCHED;
            PG8_STAGE(PG8_SB(0, 1), gB, b2 + hstepB, voffB);
            PG8_WAIT_V(6); PG8_BAR; PG8_MMA(1, 1, At, B1); PG8_BAR;
            PG8_LDB(B0, 1, 0); PG8_SCHED; PG8_LDA(At, 1, 0); PG8_STAGE(PG8_SA(0, 1), gA, a2 + hstepA, voffA);
            PG8_WAIT_L(8); PG8_BAR; PG8_WAIT_L(0); PG8_MMA(0, 0, At, B0); PG8_BAR; PG8_SCHED;
            PG8_LDB(B1, 1, 1); PG8_STAGE(PG8_SB(1, 0), gB, b3, voffB);
            PG8_BAR; PG8_WAIT_L(0); PG8_MMA(0, 1, At, B1); PG8_BAR;
            PG8_LDA(At, 1, 1); PG8_STAGE(PG8_SA(1, 0), gA, a3, voffA);
            PG8_BAR; PG8_WAIT_L(0); PG8_MMA(1, 0, At, B0); PG8_BAR; PG8_SCHED;
            PG8_STAGE(PG8_SB(1, 1), gB, b3 + hstepB, voffB);
            PG8_WAIT_V(6); PG8_BAR; PG8_MMA(1, 1, At, B1); PG8_BAR;
        }
        E(acc, cur, wr, wc, fr, fq);
        if (!has_next) break;
#pragma unroll
        for (int a = 0; a < 2; ++a)
#pragma unroll
            for (int b = 0; b < 2; ++b)
#pragma unroll
                for (int m = 0; m < 4; ++m)
#pragma unroll
                    for (int n = 0; n < 2; ++n) acc[a][b][m][n] = (f32x4){0.f, 0.f, 0.f, 0.f};
        cur = nxt; cA = nA; cB = nB; ++ui;
    }
    PG8_WAIT_V(0);
    if (wr == 0) PG8_BAR;
    PG8_BAR;
#undef PG8_SA
#undef PG8_SB
#undef PG8_STAGE
#undef PG8_LDA
#undef PG8_LDB
#undef PG8_MMA
#undef PG8_WAIT_V
#undef PG8_WAIT_L
#undef PG8_BAR
#undef PG8_SCHED
}
}
using pg8::Unit;
typedef f32x4 Acc[2][2][4][2];

struct EpiFFNa { static constexpr bool PERM = false; bf16_t* H; const float* ss;
    __device__ __forceinline__ void operator()(const Acc& acc, const Unit& u, int wr, int wc, int fr, int fq) const {
        float rs8[2][4]; rstd8(rs8, ss, u.pm * 256 + wr * 64 + fr, fq);
        const int row0 = u.pm * 256 + wr * 64 + fr, hc0 = u.pn * 128 + wc * 16 + 4 * fq;
#pragma unroll
        for (int ai = 0; ai < 2; ++ai)
#pragma unroll
            for (int m = 0; m < 4; ++m) { const int row = row0 + ai * 128 + m * 16; const float rs = rs8[ai][m];
#pragma unroll
                for (int bj = 0; bj < 2; ++bj) { const f32x4 gt = acc[ai][bj][m][0] * rs, up = acc[ai][bj][m][1] * rs; f32x4 h;
#pragma unroll
                    for (int j = 0; j < 4; ++j) h[j] = gt[j] * sigmoidf_(gt[j]) * up[j];
                    st_bf4(H + (size_t)row * FF + hc0 + bj * 64, h); } }
    }
};
struct EpiRes { static constexpr bool PERM = false; const float* xin; float* xout; bf16_t* xb; float* ss_out; float scale;
    __device__ __forceinline__ void operator()(const Acc& acc, const Unit& u, int wr, int wc, int fr, int fq) const {
        const int row0 = u.pm * 256 + wr * 64 + fr, col0 = u.pn * 256 + wc * 32 + 4 * fq;
#pragma unroll
        for (int ai = 0; ai < 2; ++ai) {
            f32x4 xv[4][2][2];
#pragma unroll
            for (int m = 0; m < 4; ++m)
#pragma unroll
                for (int bj = 0; bj < 2; ++bj)
#pragma unroll
                    for (int n = 0; n < 2; ++n) xv[m][bj][n] = *(const f32x4*)(xin + (size_t)(row0 + ai * 128 + m * 16) * D + col0 + bj * 128 + n * 16);
#pragma unroll
            for (int m = 0; m < 4; ++m) { const int row = row0 + ai * 128 + m * 16; float q = 0.f;
#pragma unroll
                for (int bj = 0; bj < 2; ++bj)
#pragma unroll
                    for (int n = 0; n < 2; ++n) { const size_t o = (size_t)row * D + col0 + bj * 128 + n * 16; const f32x4 v = xv[m][bj][n] + acc[ai][bj][m][n] * scale;
                        *(f32x4*)(xout + o) = v; st_bf4(xb + o, v); q += (v[0] * v[0] + v[1] * v[1]) + (v[2] * v[2] + v[3] * v[3]); }
                q += __shfl_xor(q, 16); q += __shfl_xor(q, 32);
                if (fq == 0) ss_out[(size_t)row * 16 + u.pn * 4 + wc] = q; }
        }
    }
};
struct EpiU { static constexpr bool PERM = true; bf16_t* Ubase; const float* ss;
    __device__ __forceinline__ void operator()(const Acc& acc, const Unit& u, int wr, int wc, int fr, int fq) const {
        float rs8[2][4]; rstd8(rs8, ss, u.pm * 256 + wr * 64 + fr, fq);
        bf16_t* base; int ld, c0;
        if (u.pn < 7) { base = (bf16_t*)((char*)Ubase + U_RWKV); ld = 1792; c0 = u.pn * 256; }
        else if (u.pn < 14) { base = (bf16_t*)((char*)Ubase + U_GLA); ld = 1792; c0 = (u.pn - 7) * 256; }
        else { base = (bf16_t*)((char*)Ubase + U_XA); ld = 512; c0 = (u.pn - 14) * 256; }
        const int row0 = u.pm * 256 + wr * 64 + fr; c0 += wc * 32 + 8 * fq;
#pragma unroll
        for (int ai = 0; ai < 2; ++ai)
#pragma unroll
            for (int m = 0; m < 4; ++m) { const int row = row0 + ai * 128 + m * 16; const float rs = rs8[ai][m];
#pragma unroll
                for (int bj = 0; bj < 2; ++bj) { const f32x4 v0 = acc[ai][bj][m][0] * rs, v1 = acc[ai][bj][m][1] * rs; u32x4 w;
                    w.x = cvt_pk_bf16(v0[0], v0[1]); w.y = cvt_pk_bf16(v0[2], v0[3]); w.z = cvt_pk_bf16(v1[0], v1[1]); w.w = cvt_pk_bf16(v1[2], v1[3]);
                    *(u32x4*)(base + (size_t)row * ld + c0 + bj * 128) = w; } }
    }
};
struct EpiGate { static constexpr bool PERM = true; unsigned char* Gt; const float* ss;
    __device__ __forceinline__ void operator()(const Acc& acc, const Unit& u, int wr, int wc, int fr, int fq) const {
        float rs8[2][4]; rstd8(rs8, ss, u.pm * 256 + wr * 64 + fr, fq);
        const int row0 = u.pm * 256 + wr * 64 + fr, c0 = u.pn * 256 + wc * 32 + 8 * fq;
#pragma unroll
        for (int ai = 0; ai < 2; ++ai)
#pragma unroll
            for (int m = 0; m < 4; ++m) { const int row = row0 + ai * 128 + m * 16; const float rs = rs8[ai][m];
#pragma unroll
                for (int bj = 0; bj < 2; ++bj) { f32x4 v0 = acc[ai][bj][m][0] * rs, v1 = acc[ai][bj][m][1] * rs;
                    unsigned q0[4], q1[4];
#pragma unroll
                    for (int j = 0; j < 4; ++j) { q0[j] = (unsigned)(sigmoidf_(v0[j]) * 255.0f + 0.5f); q1[j] = (unsigned)(sigmoidf_(v1[j]) * 255.0f + 0.5f); }
                    u32x2 w; w.x = q0[0] | (q0[1] << 8) | (q0[2] << 16) | (q0[3] << 24); w.y = q1[0] | (q1[1] << 8) | (q1[2] << 16) | (q1[3] << 24);
                    *(u32x2*)(Gt + (size_t)row * 3072 + c0 + bj * 128) = w; } }
    }
};
struct EpiMerge { static constexpr bool PERM = false; const unsigned char* Gt; float* Mg; bf16_t* Mb;
    __device__ __forceinline__ void operator()(const Acc& acc, const Unit& u, int wr, int wc, int fr, int fq) const {
        const int row0 = u.pm * 256 + wr * 64 + fr, col0 = u.pn * 256 + wc * 32 + 4 * fq;
#pragma unroll
        for (int ai = 0; ai < 2; ++ai) {
            unsigned gw[4][2][2]; u32x2 mb[4][2][2];
#pragma unroll
            for (int m = 0; m < 4; ++m)
#pragma unroll
                for (int bj = 0; bj < 2; ++bj)
#pragma unroll
                    for (int n = 0; n < 2; ++n) { const int row = row0 + ai * 128 + m * 16, col = col0 + bj * 128 + n * 16;
                        gw[m][bj][n] = *(const unsigned*)(Gt + (size_t)row * 3072 + u.z * 1024 + col);
                        mb[m][bj][n] = (u32x2){0u, 0u}; if (u.z > 0) mb[m][bj][n] = *(const u32x2*)(Mb + (size_t)row * D + col); }
#pragma unroll
            for (int m = 0; m < 4; ++m)
#pragma unroll
                for (int bj = 0; bj < 2; ++bj)
#pragma unroll
                    for (int n = 0; n < 2; ++n) { const int row = row0 + ai * 128 + m * 16, col = col0 + bj * 128 + n * 16; const unsigned g = gw[m][bj][n]; const u32x2 w = mb[m][bj][n];
                        const f32x4 gt = (f32x4){(float)(g & 0xffu), (float)((g >> 8) & 0xffu), (float)((g >> 16) & 0xffu), (float)(g >> 24)} * (1.0f / 255.0f);
                        const f32x4 v = acc[ai][bj][m][n] * gt + (f32x4){bflo(w.x), bfhi(w.x), bflo(w.y), bfhi(w.y)};
                        st_bf4(Mb + (size_t)row * D + col, v); }
        }
    }
};
struct EpiKV { static constexpr bool PERM = false; bf16_t* Kb; bf16_t* Vt; const float* rstd;
    __device__ __forceinline__ void operator()(const Acc& acc, const Unit& u, int wr, int wc, int fr, int fq) const {
        const int row0 = u.pm * 256 + wr * 64 + fr, col0 = u.pn * 256 + wc * 32 + 4 * fq;
#pragma unroll
        for (int ai = 0; ai < 2; ++ai)
#pragma unroll
            for (int m = 0; m < 4; ++m) { const int row = row0 + ai * 128 + m * 16; const float rs = rstd[row];
#pragma unroll
                for (int bj = 0; bj < 2; ++bj)
#pragma unroll
                    for (int n = 0; n < 2; ++n) { const int col = col0 + bj * 128 + n * 16; const f32x4 v = acc[ai][bj][m][n] * rs;
                        if (col < 512) st_bf4(Kb + (size_t)row * 512 + col, v);
                        else {
#pragma unroll
                            for (int j = 0; j < 4; ++j) Vt[((size_t)(row >> 8) * 512 + (col - 512 + j)) * 256 + (row & 255)] = f2bf(v[j]); } } }
    }
};

template <int MAP> __device__ __forceinline__ int colmap(int n) {
    if (MAP == 1) { const int g = n >> 5, i = n & 31; return i < 16 ? 16 * g + i : FF + 16 * g + (i - 16); }
    if (MAP == 2) { if (n < 3344) return n; if (n < 3584) return -1; return n - 240; }
    return n;
}
template <int MAP>
__device__ __forceinline__ void convT(LAS unsigned char* lds, const float* src, int ld, int coff, const float* g, bf16_t* dst, int K, int Kd, int Nd, int G, int bid, int tid) {
    const int nkt = (K + 63) >> 6, nnt = (Nd + 63) >> 6, ntile = nkt * nnt;
    LAS bf16_t* tile = (LAS bf16_t*)lds;
    for (int t = bid; t < ntile; t += G) {
        const int kt = t % nkt, ntl = t / nkt, k0 = kt * 64, n0 = ntl * 64;
        { const int nl = tid & 63, kl0 = tid >> 6, n = n0 + nl; const int c = (n < Nd) ? colmap<MAP>(n) : -1;
#pragma unroll
          for (int i = 0; i < 8; ++i) { const int kl = kl0 + 8 * i, k = k0 + kl; float v = 0.f;
              if (c >= 0 && k < K) { v = src[(size_t)k * ld + coff + c]; if (g) v *= g[k]; }
              tile[nl * 72 + kl] = f2bf(v); } }
        __syncthreads();
        { const int nl = tid >> 3, kc = (tid & 7) * 8, n = n0 + nl, k = k0 + kc;
          if (n < Nd && k < Kd) *(u32x4*)(dst + (size_t)n * Kd + k) = *(LAS u32x4*)(tile + nl * 72 + kc); }
        __syncthreads();
    }
}

template <int MAP>
__device__ __forceinline__ void convT_w(const float* src, int ld, int coff, const float* g, bf16_t* dst, int K, int Kd, int Nd, int wslot, int nslots, int lane, int tile_base) {
    const int nkt = K >> 4, nnt = (Nd + 255) >> 8, ntile = nkt * nnt;
    for (int t = ((wslot - tile_base) % nslots + nslots) % nslots; t < ntile; t += nslots) {
        const int kt = t % nkt, ntl = t / nkt, k0 = kt * 16, n = ntl * 256 + lane * 4; const int c = (n < Nd) ? colmap<MAP>(n) : -1;
        const float* sp = src + (size_t)k0 * ld + coff + (c >= 0 ? c : 0);
        f32x4 v[16], gv[4];
#pragma unroll
        for (int q = 0; q < 4; ++q) gv[q] = (f32x4){1.f, 1.f, 1.f, 1.f};
        if (g) {
#pragma unroll
            for (int q = 0; q < 4; ++q) gv[q] = *(const f32x4*)(g + k0 + 4 * q); }
#pragma unroll
        for (int kk = 0; kk < 16; ++kk) v[kk] = *(const f32x4*)(sp + (size_t)kk * ld);
        const float cm = (c < 0) ? 0.0f : 1.0f;
#pragma unroll
        for (int kk = 0; kk < 16; ++kk) v[kk] = v[kk] * (gv[kk >> 2][kk & 3] * cm);
        if (n < Nd) {
#pragma unroll
            for (int j = 0; j < 4; ++j) { u32x4 lo, hi;
                lo.x = cvt_pk_bf16(v[0][j], v[1][j]); lo.y = cvt_pk_bf16(v[2][j], v[3][j]); lo.z = cvt_pk_bf16(v[4][j], v[5][j]); lo.w = cvt_pk_bf16(v[6][j], v[7][j]);
                hi.x = cvt_pk_bf16(v[8][j], v[9][j]); hi.y = cvt_pk_bf16(v[10][j], v[11][j]); hi.z = cvt_pk_bf16(v[12][j], v[13][j]); hi.w = cvt_pk_bf16(v[14][j], v[15][j]);
                bf16_t* dp = dst + (size_t)(n + j) * Kd + k0; *(u32x4*)dp = lo; *(u32x4*)(dp + 8) = hi; }
        }
    }
}

template <int K>
__device__ __forceinline__ void wave_gemm(f32x4 (&acc)[4][4], LAS const unsigned char* A, int sA, const bf16_t* Bt, int fr, int fq) {
#pragma unroll
    for (int m = 0; m < 4; ++m)
#pragma unroll
        for (int n = 0; n < 4; ++n) acc[m][n] = (f32x4){0.f, 0.f, 0.f, 0.f};
#pragma unroll
    for (int ks = 0; ks < K / 32; ++ks) { bf16x8 a[4], b[4];
#pragma unroll
        for (int m = 0; m < 4; ++m) a[m] = *(LAS const bf16x8*)(A + (16 * m + fr) * sA + (ks * 32 + fq * 8) * 2);
#pragma unroll
        for (int n = 0; n < 4; ++n) b[n] = *(const bf16x8*)(Bt + (size_t)(16 * n + fr) * K + ks * 32 + fq * 8);
#pragma unroll
        for (int m = 0; m < 4; ++m)
#pragma unroll
            for (int n = 0; n < 4; ++n) acc[m][n] = mfma16(b[n], a[m], acc[m][n]); }
}

template <int K>
__device__ __forceinline__ void row_gemm(f32x4 (&acc)[4], LAS const unsigned char* Arow, const bf16_t* Bt, int fr, int fq) {
    bf16x8 bw[K / 32][4];
#pragma unroll
    for (int ks = 0; ks < K / 32; ++ks)
#pragma unroll
        for (int n = 0; n < 4; ++n) bw[ks][n] = *(const bf16x8*)(Bt + (size_t)(16 * n + fr) * K + ks * 32 + fq * 8);
#pragma unroll
    for (int n = 0; n < 4; ++n) acc[n] = (f32x4){0.f, 0.f, 0.f, 0.f};
#pragma unroll
    for (int ks = 0; ks < K / 32; ++ks) { const bf16x8 a = *(LAS const bf16x8*)(Arow + (ks * 32 + fq * 8) * 2);
#pragma unroll
        for (int n = 0; n < 4; ++n) acc[n] = mfma16(bw[ks][n], a, acc[n]); }
}

struct PrepArgs { const bf16_t* U; const float *mu, *w0, *a0, *kk_, *ka, *rk, *v0; const bf16_t *w2t, *a2t, *g2t, *v1t, *v2t; float* vfirst; float* Wd; float* V; bf16_t* RKKB; bf16_t* Go; float* Bon; int layer; };

__device__ __forceinline__ f32x4 shifted4(const bf16_t* Ut, bool has_prev, int c, const float* mu) {
    const f32x4 u = ld_bf4(Ut + c); f32x4 p = ld_bf4((has_prev ? Ut - 1792 : Ut) + c); const float pm = has_prev ? 1.0f : 0.0f; p = p * pm;
    const f32x4 m = *(const f32x4*)(mu + c); return u + m * (p - u);
}

__device__ __forceinline__ void rwkv_prep_tile(LAS unsigned char* lds, const PrepArgs& P, int tt, int tid) {
    constexpr int SW = 144, SG = 272, SV = 1040, SVV = 80;
    LAS unsigned char* LAw = lds; LAS unsigned char* LAa = lds + 9216; LAS unsigned char* LAg = lds + 18432; LAS unsigned char* LAv = lds + 35840; LAS unsigned char* LAvv = lds + 102400;
    const int t0 = tt * 64; const int s0 = t0 & (SEQ - 1);
    const int lane = tid & 63, wave = __builtin_amdgcn_readfirstlane(tid >> 6), fr = lane & 15, fq = lane >> 4;
    LAS float* PRM = (LAS float*)(lds + 107520);
    { PRM[tid] = P.mu[tid]; PRM[512 + tid] = P.mu[512 + tid]; PRM[1024 + tid] = P.mu[1024 + tid]; PRM[1536 + tid] = P.a0[tid]; PRM[2048 + tid] = P.w0[tid];
      PRM[2560 + tid] = P.kk_[tid]; PRM[3072 + tid] = P.ka[tid]; PRM[3584 + tid] = P.rk[tid]; PRM[4096 + tid] = P.v0[tid]; }
#pragma unroll 2
    for (int e = 0; e < 4; ++e) { const int idx = tid + 512 * e, i = idx >> 5, c = (idx & 31) * 8; const bf16_t* Ut = P.U + (size_t)(t0 + i) * 1792; const bool hp = s0 + i > 0;
        f32x4 x0 = shifted4(Ut, hp, 1536 + c, P.mu), x1 = shifted4(Ut, hp, 1536 + c + 4, P.mu);
        if (c < 64) {
#pragma unroll
            for (int q = 0; q < 4; ++q) { const float ea = __expf(2.f * x0[q]), eb = __expf(2.f * x1[q]); x0[q] = 1.f - 2.f / (ea + 1.f); x1[q] = 1.f - 2.f / (eb + 1.f); } }
        else if (c >= 128) {
#pragma unroll
            for (int q = 0; q < 4; ++q) { x0[q] = sigmoidf_(x0[q]); x1[q] = sigmoidf_(x1[q]); } }
        u32x4 o; o.x = cvt_pk_bf16(x0[0], x0[1]); o.y = cvt_pk_bf16(x0[2], x0[3]); o.z = cvt_pk_bf16(x1[0], x1[1]); o.w = cvt_pk_bf16(x1[2], x1[3]);
        LAS unsigned char* dstp = (c < 64) ? (LAw + i * SW + c * 2) : (c < 128) ? (LAa + i * SW + (c - 64) * 2) : (LAg + i * SG + (c - 128) * 2);
        *(LAS u32x4*)dstp = o; }
    if (P.layer > 0) {
#pragma unroll 2
        for (int e = 0; e < 8; ++e) { const int idx = tid + 512 * e, i = idx >> 6, c = (idx & 63) * 8; const bf16_t* Ut = P.U + (size_t)(t0 + i) * 1792; const bool hp = s0 + i > 0;
            const f32x4 x0 = shifted4(Ut, hp, 1024 + c, P.mu), x1 = shifted4(Ut, hp, 1024 + c + 4, P.mu);
            u32x4 o; o.x = cvt_pk_bf16(x0[0], x0[1]); o.y = cvt_pk_bf16(x0[2], x0[3]); o.z = cvt_pk_bf16(x1[0], x1[1]); o.w = cvt_pk_bf16(x1[2], x1[3]);
            *(LAS u32x4*)(LAv + i * SV + c * 2) = o; }
    }
    __syncthreads();
    if (P.layer > 0) {
        const int mt = wave >> 1, nt = wave & 1; f32x4 acc = (f32x4){0.f, 0.f, 0.f, 0.f};
#pragma unroll 4
        for (int ks = 0; ks < 16; ++ks) { const bf16x8 a = *(LAS const bf16x8*)(LAv + (16 * mt + fr) * SV + (ks * 32 + fq * 8) * 2);
            const bf16x8 b = *(const bf16x8*)(P.v1t + (size_t)(16 * nt + fr) * 512 + ks * 32 + fq * 8); acc = mfma16(b, a, acc); }
        u32x2 w; w.x = cvt_pk_bf16(acc[0], acc[1]); w.y = cvt_pk_bf16(acc[2], acc[3]); *(LAS u32x2*)(LAvv + (16 * mt + fr) * SVV + (16 * nt + 4 * fq) * 2) = w;
    }
    __syncthreads();
    const int h = wave, cb = 64 * h; const int b_ = t0 >> 12, p = b_ * 8 + h;
#pragma unroll 1
    for (int m = 0; m < 4; ++m) {
        const int i = 16 * m + fr; const bf16_t* Ut = P.U + (size_t)(t0 + i) * 1792; const bool hp = (s0 + i) > 0;
        int fq4 = 4 * fq; asm volatile("" : "+v"(fq4));
        u32x2 uk[4], pk[4], ur[4], pr[4], uv[4], pv[4]; f32x4 vf[4];
        { const bf16_t* Up = hp ? Ut - 1792 : Ut; const unsigned pm = hp ? 0xffffffffu : 0u;
#pragma unroll
          for (int n = 0; n < 4; ++n) { const int c = cb + 16 * n + fq4;
              uk[n] = *(const u32x2*)(Ut + 512 + c); ur[n] = *(const u32x2*)(Ut + c); uv[n] = *(const u32x2*)(Ut + 1024 + c);
              pk[n] = *(const u32x2*)(Up + 512 + c); pr[n] = *(const u32x2*)(Up + c); pv[n] = *(const u32x2*)(Up + 1024 + c);
              if (P.layer > 0) vf[n] = *(const f32x4*)(P.vfirst + (size_t)(t0 + i) * 512 + c); }
#pragma unroll
          for (int n = 0; n < 4; ++n) { pk[n].x &= pm; pk[n].y &= pm; pr[n].x &= pm; pr[n].y &= pm; pv[n].x &= pm; pv[n].y &= pm; } }
        f32x4 aa[4], acc[4];
        row_gemm<64>(aa, LAa + i * SW, P.a2t + (size_t)cb * 64, fr, fq);
        row_gemm<64>(acc, LAw + i * SW, P.w2t + (size_t)cb * 64, fr, fq);
#pragma unroll
        for (int n = 0; n < 4; ++n) { const f32x4 a0v = *(LAS const f32x4*)(PRM + 1536 + cb + 16 * n + fq4), w0v = *(LAS const f32x4*)(PRM + 2048 + cb + 16 * n + fq4); f32x4 d;
#pragma unroll
            for (int j = 0; j < 4; ++j) { aa[n][j] = sigmoidf_(aa[n][j] + a0v[j]); d[j] = __expf(-0.6065306597f * sigmoidf_(acc[n][j] + w0v[j])); }
            *(f32x4*)(P.Wd + ((size_t)p * SEQ + s0 + i) * 64 + 16 * n + fq4) = d; }
        row_gemm<128>(acc, LAg + i * SG, P.g2t + (size_t)cb * 128, fr, fq);
#pragma unroll
        for (int n = 0; n < 4; ++n) st_bf4(P.Go + (size_t)(t0 + i) * 512 + cb + 16 * n + fq4, acc[n]);
        if (P.layer > 0) row_gemm<32>(acc, LAvv + i * SVV, P.v2t + (size_t)cb * 32, fr, fq);
        float bon = 0.f, nk = 0.f; f32x4 kv[4], rv[4];
#pragma unroll
        for (int n = 0; n < 4; ++n) { const int c = cb + 16 * n + fq4;
            const f32x4 muv = *(LAS const f32x4*)(PRM + 1024 + c), muk = *(LAS const f32x4*)(PRM + 512 + c), mur = *(LAS const f32x4*)(PRM + c);
            const f32x4 v_u = (f32x4){bflo(uv[n].x), bfhi(uv[n].x), bflo(uv[n].y), bfhi(uv[n].y)}, v_p = (f32x4){bflo(pv[n].x), bfhi(pv[n].x), bflo(pv[n].y), bfhi(pv[n].y)};
            const f32x4 k_u = (f32x4){bflo(uk[n].x), bfhi(uk[n].x), bflo(uk[n].y), bfhi(uk[n].y)}, k_p = (f32x4){bflo(pk[n].x), bfhi(pk[n].x), bflo(pk[n].y), bfhi(pk[n].y)};
            const f32x4 r_u = (f32x4){bflo(ur[n].x), bfhi(ur[n].x), bflo(ur[n].y), bfhi(ur[n].y)}, r_p = (f32x4){bflo(pr[n].x), bfhi(pr[n].x), bflo(pr[n].y), bfhi(pr[n].y)};
            f32x4 v = v_u + muv * (v_p - v_u);
            if (P.layer > 0) { const f32x4 v0v = *(LAS const f32x4*)(PRM + 4096 + c);
#pragma unroll
                for (int j = 0; j < 4; ++j) v[j] = v[j] + (vf[n][j] - v[j]) * sigmoidf_(v0v[j] + acc[n][j]); }
            else *(f32x4*)(P.vfirst + (size_t)(t0 + i) * 512 + c) = v;
            *(f32x4*)(P.V + ((size_t)p * SEQ + s0 + i) * 64 + 16 * n + fq4) = v;
            kv[n] = k_u + muk * (k_p - k_u); rv[n] = r_u + mur * (r_p - r_u);
            const f32x4 kkw = *(LAS const f32x4*)(PRM + 2560 + c);
#pragma unroll
            for (int j = 0; j < 4; ++j) { const float x = kv[n][j] * kkw[j]; nk += x * x; } }
        nk += __shfl_xor(nk, 16); nk += __shfl_xor(nk, 32);
        const float inv = 1.0f / fmaxf(sqrtf(nk), 1e-12f);
        bf16_t* O = P.RKKB + ((size_t)p * SEQ + s0 + i) * 256;
#pragma unroll
        for (int n = 0; n < 4; ++n) { const int c = cb + 16 * n + fq4; const f32x4 kkw = *(LAS const f32x4*)(PRM + 2560 + c), kaw = *(LAS const f32x4*)(PRM + 3072 + c), rkw = *(LAS const f32x4*)(PRM + 3584 + c);
            f32x4 kk, kh, bb;
#pragma unroll
            for (int j = 0; j < 4; ++j) { const float a = aa[n][j]; kk[j] = kv[n][j] * kkw[j] * inv; kh[j] = kv[n][j] * (1.f + (a - 1.f) * kaw[j]); bb[j] = kk[j] * a; bon += rv[n][j] * kh[j] * rkw[j]; }
            const int cc = 16 * n + fq4; st_bf4(O + cc, rv[n]); st_bf4(O + 64 + cc, kh); st_bf4(O + 128 + cc, kk); st_bf4(O + 192 + cc, bb); }
        bon += __shfl_xor(bon, 16); bon += __shfl_xor(bon, 32);
        if (fq == 0) P.Bon[(size_t)(t0 + i) * 8 + h] = bon;
        asm volatile("" ::: "memory");
    }
    __syncthreads();
}

constexpr int SCAN_CH = 32, SCAN_STEP_B = 1344, SCAN_SLOT_B = SCAN_CH * SCAN_STEP_B;
template <int CTRL> __device__ __forceinline__ float dpp_f(float v) { return __int_as_float(__builtin_amdgcn_update_dpp(0, __float_as_int(v), CTRL, 0xf, 0xf, true)); }
__device__ __forceinline__ float row16_sum(float v) { v += dpp_f<0xB1>(v); v += dpp_f<0x4E>(v); v += dpp_f<0x141>(v); v += dpp_f<0x140>(v); return v; }

__device__ __forceinline__ float tr16_sum(const float (&p)[16], int kq) {
    const bool b3 = (kq & 8) != 0, b2 = (kq & 4) != 0, b1 = (kq & 2) != 0, b0 = (kq & 1) != 0;
    float q[8], r[4], u[2];
#pragma unroll
    for (int t = 0; t < 8; ++t) { const float keep = b3 ? p[t + 8] : p[t], send = b3 ? p[t] : p[t + 8]; q[t] = keep + dpp_f<0x140>(send); }
#pragma unroll
    for (int t = 0; t < 4; ++t) { const float keep = b2 ? q[t + 4] : q[t], send = b2 ? q[t] : q[t + 4]; r[t] = keep + dpp_f<0x141>(send); }
#pragma unroll
    for (int t = 0; t < 2; ++t) { const float keep = b1 ? r[t + 2] : r[t], send = b1 ? r[t] : r[t + 2]; u[t] = keep + dpp_f<0x4E>(send); }
    const float keep = b0 ? u[1] : u[0], send = b0 ? u[0] : u[1];
    return keep + dpp_f<0xB1>(send);
}

__device__ __forceinline__ void scan_load_chunk(LAS unsigned char* slot, const float* Wd, const float* V, const bf16_t* RKKB, int p, int rg, int s0, int lt) {
    u32x4 r[7];
    const size_t base = (size_t)p * SEQ + s0;
#pragma unroll
    for (int j = 0; j < 2; ++j) { const int idx = lt + 256 * j, st = idx >> 4, part = idx & 15; r[j] = *(const u32x4*)(Wd + (base + st) * 64 + part * 4); }
#pragma unroll
    for (int j = 2; j < 6; ++j) { const int k = lt + 256 * (j - 2), st = k >> 5, rem = k & 31, q = rem >> 3, part = rem & 7; r[j] = *(const u32x4*)(RKKB + ((base + st) * 4 + q) * 64 + part * 8); }
    if (lt < 128) { const int st = lt >> 2, hf = lt & 3; r[6] = *(const u32x4*)(V + (base + st) * 64 + rg * 16 + hf * 4); }
#pragma unroll
    for (int j = 0; j < 2; ++j) { const int idx = lt + 256 * j, st = idx >> 4, part = idx & 15; *(LAS u32x4*)(slot + st * SCAN_STEP_B + part * 16) = r[j]; }
#pragma unroll
    for (int j = 2; j < 6; ++j) { const int k = lt + 256 * (j - 2), st = k >> 5, rem = k & 31, q = rem >> 3, part = rem & 7; const u32x4 w = r[j];
        const int Q = (q == 0) ? 4 : (q == 1) ? 2 : (q == 2) ? 3 : 1;
        LAS f32x4* d = (LAS f32x4*)(slot + st * SCAN_STEP_B + Q * 256 + part * 32);
        d[0] = (f32x4){bflo(w.x), bfhi(w.x), bflo(w.y), bfhi(w.y)}; d[1] = (f32x4){bflo(w.z), bfhi(w.z), bflo(w.w), bfhi(w.w)}; }
    if (lt < 128) { const int st = lt >> 2, hf = lt & 3; *(LAS u32x4*)(slot + st * SCAN_STEP_B + 1280 + hf * 16) = r[6]; }
}

__device__ __forceinline__ void rwkv_scan_unit(LAS unsigned char* lds, const float* Wd, const float* V, const bf16_t* RKKB, float* Yraw, int p, int rg, int tid) {
    const int lane = tid & 63, wave = __builtin_amdgcn_readfirstlane(tid >> 6);
    constexpr int NCH = SEQ / SCAN_CH;
    scan_load_chunk(lds + (tid >> 8) * SCAN_SLOT_B, Wd, V, RKKB, p, rg, (tid >> 8) * SCAN_CH, tid & 255);
    __syncthreads();
    f32x4 S = (f32x4){0.f, 0.f, 0.f, 0.f};
    const int kq = lane & 15, rl = wave * 4 + (lane >> 4);
    for (int c = 0; c < NCH; ++c) {
        if (wave >= 4) { if (c + 2 < NCH) scan_load_chunk(lds + ((c + 2) % 3) * SCAN_SLOT_B, Wd, V, RKKB, p, rg, (c + 2) * SCAN_CH, tid - 256); }
        else {
            LAS const unsigned char* sl = lds + (c % 3) * SCAN_SLOT_B + kq * 16;
            LAS const unsigned char* vl = lds + (c % 3) * SCAN_SLOT_B + 1280 + rl * 4;
            float* yo = Yraw + ((size_t)p * SEQ + c * SCAN_CH + kq) * 64 + rg * 16 + rl;
            f32x4 w = *(LAS const f32x4*)(sl), b = *(LAS const f32x4*)(sl + 256), k = *(LAS const f32x4*)(sl + 512), kk = *(LAS const f32x4*)(sl + 768), r = *(LAS const f32x4*)(sl + 1024);
            float v = *(LAS const float*)(vl); float yp[16];
#pragma unroll
            for (int st = 0; st < SCAN_CH; ++st) {
                f32x4 wn = w, bn = b, kn = k, kkn = kk, rn = r; float vn = v;
                if (st + 1 < SCAN_CH) { const int o = (st + 1) * SCAN_STEP_B;
                    wn = *(LAS const f32x4*)(sl + o); bn = *(LAS const f32x4*)(sl + o + 256); kn = *(LAS const f32x4*)(sl + o + 512); kkn = *(LAS const f32x4*)(sl + o + 768); rn = *(LAS const f32x4*)(sl + o + 1024);
                    vn = *(LAS const float*)(vl + o); }
                float sa = (S[0] * kk[0] + S[1] * kk[1]) + (S[2] * kk[2] + S[3] * kk[3]);
                const f32x4 kvt = k * v;
                sa = -row16_sum(sa);
                S = S * w + (b * sa + kvt);
                yp[st & 15] = (S[0] * r[0] + S[1] * r[1]) + (S[2] * r[2] + S[3] * r[3]);
                if ((st & 15) == 15) yo[(size_t)(st - 15) * 64] = tr16_sum(yp, kq);
                w = wn; b = bn; k = kn; kk = kkn; r = rn; v = vn;
            }
        }
        __syncthreads();
    }
}

struct GlaArgs { const bf16_t* Ug; const float *conv, *aup, *abias, *gnorm; float* kvcT; float* dec; bf16_t* spT; bf16_t* Yg; };
constexpr int GL_GC = 0;
constexpr int GL_T0 = 16640;
constexpr int GL_VT = GL_T0 + 4 * 9216;
constexpr int GL_AL = GL_VT + 18432;
constexpr int GL_RS = GL_AL + 9216;

__device__ __forceinline__ void gla_conv8(f32x4 (&out)[8], const bf16_t* Ug, const float* conv, int t0, int s0, int i0, int c0) {
    f32x4 w[4];
#pragma unroll
    for (int j = 0; j < 4; ++j) w[j] = *(const f32x4*)(conv + j * 1024 + c0);
    u32x2 raw[8][4];
#pragma unroll
    for (int e = 0; e < 8; ++e)
#pragma unroll
        for (int j = 0; j < 4; ++j) { const int i = i0 + 8 * e, ds = 3 - j; const bool ok = (s0 + i - ds) >= 0; raw[e][j] = *(const u32x2*)(Ug + (size_t)(ok ? t0 + i - ds : t0) * 1792 + c0); }
#pragma unroll
    for (int e = 0; e < 8; ++e) { const int i = i0 + 8 * e; f32x4 a = (f32x4){0.f, 0.f, 0.f, 0.f};
#pragma unroll
        for (int j = 0; j < 4; ++j) { const int ds = 3 - j; const float mk = ((s0 + i - ds) >= 0) ? 1.0f : 0.0f; const u32x2 r = raw[e][j];
            a += (w[j] * mk) * (f32x4){bflo(r.x), bfhi(r.x), bflo(r.y), bfhi(r.y)}; }
#pragma unroll
        for (int q = 0; q < 4; ++q) a[q] = a[q] * sigmoidf_(a[q]);
        out[e] = a; }
}
__device__ __forceinline__ void gla_gcum(LAS unsigned char* lds, const GlaArgs& A, int t0, int h, int tid) {
    LAS float* GC = (LAS float*)(lds + GL_GC);
    { const int d = tid & 63, i0 = tid >> 6; float au[16]; const float ab = A.abias[h * 64 + d];
#pragma unroll
      for (int j = 0; j < 16; ++j) au[j] = A.aup[j * 256 + h * 64 + d];
      u32x4 al0[8], al1[8];
#pragma unroll
      for (int e = 0; e < 8; ++e) { const u32x4* ap = (const u32x4*)(A.Ug + (size_t)(t0 + i0 + 8 * e) * 1792 + 1024); al0[e] = ap[0]; al1[e] = ap[1]; }
#pragma unroll
      for (int e = 0; e < 8; ++e) { const int i = i0 + 8 * e; const u32x4 a0 = al0[e], a1 = al1[e];
          float x = ab;
          x += bflo(a0.x) * au[0] + bfhi(a0.x) * au[1] + bflo(a0.y) * au[2] + bfhi(a0.y) * au[3] + bflo(a0.z) * au[4] + bfhi(a0.z) * au[5] + bflo(a0.w) * au[6] + bfhi(a0.w) * au[7];
          x += bflo(a1.x) * au[8] + bfhi(a1.x) * au[9] + bflo(a1.y) * au[10] + bfhi(a1.y) * au[11] + bflo(a1.z) * au[12] + bfhi(a1.z) * au[13] + bflo(a1.w) * au[14] + bfhi(a1.w) * au[15];
          const float ls = fminf(x, 0.f) - __logf(1.f + __expf(-fabsf(x)));
          GC[i * 65 + d] = ls * (1.0f / 16.0f); } }
    __syncthreads();
    { const int lane = tid & 63, wave = tid >> 6;
#pragma unroll
      for (int dd = 0; dd < 8; ++dd) { const int d = wave * 8 + dd; float x = GC[lane * 65 + d];
#pragma unroll
          for (int o = 1; o < 64; o <<= 1) { const float y = __shfl_up(x, o); if (lane >= o) x += y; }
          GC[lane * 65 + d] = x; } }
    __syncthreads();
}
__device__ __forceinline__ void gla_a_tile(LAS unsigned char* lds, const GlaArgs& A, int tile, int tid) {
    const int bh = tile >> 6, n = tile & 63, b = bh >> 2, h = bh & 3, t0 = b * SEQ + n * 64, s0 = n * 64;
    LAS float* GC = (LAS float*)(lds + GL_GC); LAS bf16_t* KDT = (LAS bf16_t*)(lds + GL_T0); LAS bf16_t* VT = (LAS bf16_t*)(lds + GL_VT);
    gla_gcum(lds, A, t0, h, tid);
    { const int cc = (tid & 63) * 4, i0 = tid >> 6;
      if (cc >= 64) { f32x4 o[8]; const int c0 = (cc < 128) ? 256 + h * 64 + (cc - 64) : 512 + h * 128 + (cc - 128);
          gla_conv8(o, A.Ug, A.conv, t0, s0, i0, c0);
          if (cc < 128) { const int d = cc - 64;
#pragma unroll
              for (int e = 0; e < 8; ++e) { const int i = i0 + 8 * e;
#pragma unroll
                  for (int q = 0; q < 4; ++q) KDT[(d + q) * 72 + i] = f2bf(o[e][q] * __expf(GC[63 * 65 + d + q] - GC[i * 65 + d + q])); } }
          else { const int ev = cc - 128;
#pragma unroll
              for (int e = 0; e < 8; ++e) { const int i = i0 + 8 * e;
#pragma unroll
                  for (int q = 0; q < 4; ++q) VT[(ev + q) * 72 + i] = f2bf(o[e][q]); } } } }
    if (tid < 64) A.dec[((size_t)bh * 64 + n) * 64 + tid] = __expf(GC[63 * 65 + tid]);
    __syncthreads();
    { const int lane = tid & 63, wave = tid >> 6, fr = lane & 15, fq = lane >> 4; f32x4 acc[4];
#pragma unroll
      for (int nt = 0; nt < 4; ++nt) acc[nt] = (f32x4){0.f, 0.f, 0.f, 0.f};
#pragma unroll
      for (int ks = 0; ks < 2; ++ks) { const bf16x8 a = *(LAS const bf16x8*)(VT + (16 * wave + fr) * 72 + ks * 32 + fq * 8);
#pragma unroll
          for (int nt = 0; nt < 4; ++nt) { const bf16x8 bfr = *(LAS const bf16x8*)(KDT + (16 * nt + fr) * 72 + ks * 32 + fq * 8); acc[nt] = mfma16(bfr, a, acc[nt]); } }
#pragma unroll
      for (int nt = 0; nt < 4; ++nt) *(f32x4*)(A.kvcT + (((size_t)bh * 64 + n) * 128 + 16 * wave + fr) * 64 + 16 * nt + 4 * fq) = acc[nt]; }
    __syncthreads();
}
__device__ __forceinline__ void gla_c_tile(LAS unsigned char* lds, const GlaArgs& A, int tile, int tid) {
    const int bh = tile >> 6, n = tile & 63, b = bh >> 2, h = bh & 3, t0 = b * SEQ + n * 64, s0 = n * 64;
    LAS float* GC = (LAS float*)(lds + GL_GC); LAS bf16_t* QG = (LAS bf16_t*)(lds + GL_T0); LAS bf16_t* KG = QG + 64 * 72; LAS bf16_t* QR = KG + 64 * 72; LAS bf16_t* KR = QR + 64 * 72;
    LAS bf16_t* VT = (LAS bf16_t*)(lds + GL_VT); LAS bf16_t* AL = (LAS bf16_t*)(lds + GL_AL); LAS float* RS = (LAS float*)(lds + GL_RS);
    gla_gcum(lds, A, t0, h, tid);
    { const int cc = (tid & 63) * 4, i0 = tid >> 6; f32x4 o[8];
      const int c0 = (cc < 64) ? h * 64 + cc : (cc < 128) ? 256 + h * 64 + (cc - 64) : 512 + h * 128 + (cc - 128);
      gla_conv8(o, A.Ug, A.conv, t0, s0, i0, c0);
      if (cc < 128) { const int d = cc & 63; const bool isq = cc < 64; LAS bf16_t* T1 = isq ? QG : KR; LAS bf16_t* T2 = isq ? QR : KG; const float sc = isq ? 0.125f : 1.0f;
#pragma unroll
          for (int e = 0; e < 8; ++e) { const int i = i0 + 8 * e; f32x4 x1, x2;
#pragma unroll
              for (int q = 0; q < 4; ++q) { const float eg = __expf(GC[i * 65 + d + q]); const float x = o[e][q] * sc; x1[q] = x * eg; x2[q] = x / eg; }
              u32x2 w1, w2; w1.x = cvt_pk_bf16(x1[0], x1[1]); w1.y = cvt_pk_bf16(x1[2], x1[3]); w2.x = cvt_pk_bf16(x2[0], x2[1]); w2.y = cvt_pk_bf16(x2[2], x2[3]);
              *(LAS u32x2*)(T1 + i * 72 + d) = w1; *(LAS u32x2*)(T2 + i * 72 + d) = w2; } }
      else { const int ev = cc - 128;
#pragma unroll
          for (int e = 0; e < 8; ++e) { const int i = i0 + 8 * e;
#pragma unroll
              for (int q = 0; q < 4; ++q) VT[(ev + q) * 72 + i] = f2bf(o[e][q]); } } }
    __syncthreads();
    const int lane = tid & 63, wave = tid >> 6, fr = lane & 15, fq = lane >> 4; const int mt = wave >> 1;
    {
#pragma unroll
        for (int q = 0; q < 2; ++q) { const int nt = (wave & 1) * 2 + q; f32x4 ap = (f32x4){0.f, 0.f, 0.f, 0.f}, af = ap;
#pragma unroll
            for (int ks = 0; ks < 2; ++ks) { const int ko = ks * 32 + fq * 8;
                ap = mfma16(*(LAS const bf16x8*)(KG + (16 * nt + fr) * 72 + ko), *(LAS const bf16x8*)(QG + (16 * mt + fr) * 72 + ko), ap);
                af = mfma16(*(LAS const bf16x8*)(KR + (16 * nt + fr) * 72 + ko), *(LAS const bf16x8*)(QR + (16 * mt + fr) * 72 + ko), af); }
            const int trow = 16 * mt + fr; f32x4 o;
#pragma unroll
            for (int j = 0; j < 4; ++j) { const int scol = 16 * nt + 4 * fq + j; o[j] = (scol <= trow) ? ap[j] : af[j]; }
            u32x2 w; w.x = cvt_pk_bf16(o[0], o[1]); w.y = cvt_pk_bf16(o[2], o[3]); *(LAS u32x2*)(AL + trow * 72 + 16 * nt + 4 * fq) = w; }
    }
    __syncthreads();
    f32x4 acc[4];
#pragma unroll
    for (int q = 0; q < 4; ++q) acc[q] = (f32x4){0.f, 0.f, 0.f, 0.f};
    const bf16_t* sp = A.spT + ((size_t)bh * 64 + n) * 128 * 64;
#pragma unroll
    for (int ks = 0; ks < 2; ++ks) { const int ko = ks * 32 + fq * 8; const bf16x8 a1 = *(LAS const bf16x8*)(AL + (16 * mt + fr) * 72 + ko), a2 = *(LAS const bf16x8*)(QG + (16 * mt + fr) * 72 + ko);
#pragma unroll
        for (int q = 0; q < 4; ++q) { const int nt = (wave & 1) * 4 + q;
            acc[q] = mfma16(*(LAS const bf16x8*)(VT + (16 * nt + fr) * 72 + ko), a1, acc[q]);
            acc[q] = mfma16(*(const bf16x8*)(sp + (size_t)(16 * nt + fr) * 64 + ko), a2, acc[q]); } }
    float ssq = 0.f;
#pragma unroll
    for (int q = 0; q < 4; ++q) ssq += (acc[q][0] * acc[q][0] + acc[q][1] * acc[q][1]) + (acc[q][2] * acc[q][2] + acc[q][3] * acc[q][3]);
    ssq += __shfl_xor(ssq, 16); ssq += __shfl_xor(ssq, 32);
    if (fq == 0) RS[(16 * mt + fr) * 2 + (wave & 1)] = ssq;
    __syncthreads();
    { const int i = 16 * mt + fr; const float rs = rsqrtf((RS[i * 2] + RS[i * 2 + 1]) * (1.0f / 128.0f) + 1e-6f);
#pragma unroll
      for (int q = 0; q < 4; ++q) { const int ecol = h * 128 + ((wave & 1) * 4 + q) * 16 + 4 * fq; const f32x4 nw = *(const f32x4*)(A.gnorm + ecol); const f32x4 go = ld_bf4(A.Ug + (size_t)(t0 + i) * 1792 + 1040 + ecol); f32x4 o;
#pragma unroll
          for (int j = 0; j < 4; ++j) o[j] = acc[q][j] * rs * nw[j] * go[j] * sigmoidf_(go[j]);
          st_bf4(A.Yg + (size_t)(t0 + i) * 512 + ecol, o); } }
    __syncthreads();
}

__device__ __forceinline__ void xa_tile(const bf16_t* Ux, const bf16_t* Kb, const bf16_t* Vt, bf16_t* Yx, int tile, int tid) {
    const int blk = tile & 31, h = (tile >> 5) & 3, b = tile >> 7; const int lane = tid & 63, wave = tid >> 6, fr = lane & 15, fq = lane >> 4;
    const int t = b * SEQ + blk * 128 + 16 * wave + fr;
    bf16x8 qf[4];
#pragma unroll
    for (int ks = 0; ks < 4; ++ks) qf[ks] = *(const bf16x8*)(Ux + (size_t)t * 512 + h * 128 + ks * 32 + fq * 8);
    f32x4 s[16];
#pragma unroll
    for (int nt = 0; nt < 16; ++nt) { s[nt] = (f32x4){0.f, 0.f, 0.f, 0.f}; const bf16_t* kr = Kb + (size_t)(b * 256 + 16 * nt + fr) * 512 + h * 128 + fq * 8;
#pragma unroll
        for (int ks = 0; ks < 4; ++ks) s[nt] = mfma16(*(const bf16x8*)(kr + ks * 32), qf[ks], s[nt]); }
    float mx = -1e30f;
#pragma unroll
    for (int nt = 0; nt < 16; ++nt)
#pragma unroll
        for (int j = 0; j < 4; ++j) mx = fmaxf(mx, s[nt][j]);
    mx = fmaxf(mx, __shfl_xor(mx, 16)); mx = fmaxf(mx, __shfl_xor(mx, 32));
    const float sc = 0.08838834764831845f * 1.4426950408889634f; float l = 0.f;
#pragma unroll
    for (int nt = 0; nt < 16; ++nt)
#pragma unroll
        for (int j = 0; j < 4; ++j) { const float pz = exp2f((s[nt][j] - mx) * sc); s[nt][j] = pz; l += pz; }
    l += __shfl_xor(l, 16); l += __shfl_xor(l, 32);
    f32x4 o[8];
#pragma unroll
    for (int dt = 0; dt < 8; ++dt) o[dt] = (f32x4){0.f, 0.f, 0.f, 0.f};
#pragma unroll
    for (int c = 0; c < 8; ++c) { union { u32x4 u; bf16x8 v; } pf;
        pf.u.x = cvt_pk_bf16(s[2 * c][0], s[2 * c][1]); pf.u.y = cvt_pk_bf16(s[2 * c][2], s[2 * c][3]); pf.u.z = cvt_pk_bf16(s[2 * c + 1][0], s[2 * c + 1][1]); pf.u.w = cvt_pk_bf16(s[2 * c + 1][2], s[2 * c + 1][3]);
#pragma unroll
        for (int dt = 0; dt < 8; ++dt) { const bf16_t* vr = Vt + ((size_t)b * 512 + h * 128 + 16 * dt + fr) * 256 + 32 * c + 4 * fq; union { u32x4 u; bf16x8 v; } vf;
            const u32x2 lo = *(const u32x2*)vr, hi = *(const u32x2*)(vr + 16); vf.u.x = lo.x; vf.u.y = lo.y; vf.u.z = hi.x; vf.u.w = hi.y;
            o[dt] = mfma16(vf.v, pf.v, o[dt]); } }
    const float il = 1.0f / l;
#pragma unroll
    for (int dt = 0; dt < 8; ++dt) st_bf4(Yx + (size_t)t * 512 + h * 128 + 16 * dt + 4 * fq, o[dt] * il);
}

constexpr int XK_STRIDE = 272, XV_STRIDE = 528, XV_OFF = 256 * XK_STRIDE;
__device__ __forceinline__ void xa_pair(LAS unsigned char* lds, const bf16_t* Ux, const bf16_t* Kb, const bf16_t* Vt, bf16_t* Yx, int pair, int tid) {
    const int bh = pair >> 4, b = bh >> 2, h = bh & 3, blk0 = (pair & 15) * 2; const int lane = tid & 63, wave = tid >> 6, fr = lane & 15, fq = lane >> 4;
    u32x4 kst[8], vst[8];
#pragma unroll
    for (int e = 0; e < 8; ++e) { const int ch = tid + 512 * e; const int key = ch >> 4, part = ch & 15, dr = ch >> 5, pv = ch & 31;
        kst[e] = *(const u32x4*)(Kb + (size_t)(b * 256 + key) * 512 + h * 128 + part * 8); vst[e] = *(const u32x4*)(Vt + ((size_t)b * 512 + h * 128 + dr) * 256 + pv * 8); }
#pragma unroll
    for (int e = 0; e < 8; ++e) { const int ch = tid + 512 * e; const int key = ch >> 4, part = ch & 15, dr = ch >> 5, pv = ch & 31;
        *(LAS u32x4*)(lds + key * XK_STRIDE + part * 16) = kst[e]; *(LAS u32x4*)(lds + XV_OFF + dr * XV_STRIDE + pv * 16) = vst[e]; }
    __syncthreads();
#pragma unroll 1
    for (int tq = 0; tq < 2; ++tq) {
        const int t = b * SEQ + (blk0 + tq) * 128 + 16 * wave + fr;
        bf16x8 qf[4];
#pragma unroll
        for (int ks = 0; ks < 4; ++ks) qf[ks] = *(const bf16x8*)(Ux + (size_t)t * 512 + h * 128 + ks * 32 + fq * 8);
        f32x4 s[16];
#pragma unroll
        for (int nt = 0; nt < 16; ++nt) { s[nt] = (f32x4){0.f, 0.f, 0.f, 0.f}; LAS const unsigned char* kr = lds + (16 * nt + fr) * XK_STRIDE + fq * 16;
#pragma unroll
            for (int ks = 0; ks < 4; ++ks) s[nt] = mfma16(*(LAS const bf16x8*)(kr + ks * 64), qf[ks], s[nt]);
            if (nt & 1) asm volatile("" ::: "memory"); }
        float mx = -1e30f;
#pragma unroll
        for (int nt = 0; nt < 16; ++nt)
#pragma unroll
            for (int j = 0; j < 4; ++j) mx = fmaxf(mx, s[nt][j]);
        mx = fmaxf(mx, __shfl_xor(mx, 16)); mx = fmaxf(mx, __shfl_xor(mx, 32));
        const float sc = 0.08838834764831845f * 1.4426950408889634f; float l = 0.f;
#pragma unroll
        for (int nt = 0; nt < 16; ++nt)
#pragma unroll
            for (int j = 0; j < 4; ++j) { const float pz = exp2f((s[nt][j] - mx) * sc); s[nt][j] = pz; l += pz; }
        l += __shfl_xor(l, 16); l += __shfl_xor(l, 32);
        f32x4 o[8];
#pragma unroll
        for (int dt = 0; dt < 8; ++dt) o[dt] = (f32x4){0.f, 0.f, 0.f, 0.f};
#pragma unroll
        for (int c = 0; c < 8; ++c) { union { u32x4 u; bf16x8 v; } pf;
            pf.u.x = cvt_pk_bf16(s[2 * c][0], s[2 * c][1]); pf.u.y = cvt_pk_bf16(s[2 * c][2], s[2 * c][3]); pf.u.z = cvt_pk_bf16(s[2 * c + 1][0], s[2 * c + 1][1]); pf.u.w = cvt_pk_bf16(s[2 * c + 1][2], s[2 * c + 1][3]);
#pragma unroll
            for (int dt = 0; dt < 8; ++dt) { LAS const unsigned char* vr = lds + XV_OFF + (16 * dt + fr) * XV_STRIDE + (32 * c + 4 * fq) * 2; union { u32x4 u; bf16x8 v; } vf;
                const u32x2 lo = *(LAS const u32x2*)vr, hi = *(LAS const u32x2*)(vr + 32); vf.u.x = lo.x; vf.u.y = lo.y; vf.u.z = hi.x; vf.u.w = hi.y;
                o[dt] = mfma16(vf.v, pf.v, o[dt]); }
            asm volatile("" ::: "memory"); }
        const float il = 1.0f / l;
#pragma unroll
        for (int dt = 0; dt < 8; ++dt) st_bf4(Yx + (size_t)t * 512 + h * 128 + 16 * dt + 4 * fq, o[dt] * il);
    }
    __syncthreads();
}

struct Params { const float* in[33]; float* out; unsigned char* ws; };

__device__ __forceinline__ int opaque0() { int z = 0; asm volatile("" : "+s"(z)); return z; }
typedef __attribute__((address_space(1))) unsigned char* gptr_t;
typedef __attribute__((address_space(1))) const float* gcf_t;
__device__ __forceinline__ int opqv(int v) { asm volatile("" : "+v"(v)); return v; }
__device__ __forceinline__ int opqs(int v) { asm volatile("" : "+s"(v)); return v; }
#define PH_BEGIN const int zi = opaque0(); unsigned char* ws = P.ws + zi; float* const OUT = P.out + zi; (void)OUT; const int tid = opqv((int)threadIdx.x); const int bid = opqs((int)blockIdx.x); const int G = opqs((int)gridDim.x); (void)tid; (void)bid; (void)G; unsigned char* WB = ws + WS_WB; float* SS = (float*)(ws + WS_SS); (void)WB; (void)SS; (void)zi;
#define INP(k) (P.in[(k)] + zi)
#define XB_ ((bf16_t*)(ws + WS_XB))
#define U_ (ws + WS_U)
#define SC_ (ws + WS_SC)
#define Y_ ((bf16_t*)(ws + WS_Y))
#define KB_ ((bf16_t*)(ws + WS_KB))
#define VT_ ((bf16_t*)(ws + WS_VT))

constexpr size_t WS_BAR = WS_MISC + 8192;
__device__ __forceinline__ void grid_bar(unsigned* ctr, unsigned target) {
    asm volatile("s_waitcnt vmcnt(0)" ::: "memory");
    __syncthreads();
    if (threadIdx.x == 0) {
        __builtin_amdgcn_fence(__ATOMIC_RELEASE, "agent");
        asm volatile("s_waitcnt vmcnt(0)" ::: "memory");
        __hip_atomic_fetch_add(ctr, 1u, __ATOMIC_RELAXED, __HIP_MEMORY_SCOPE_AGENT);
        while (__hip_atomic_load(ctr, __ATOMIC_RELAXED, __HIP_MEMORY_SCOPE_AGENT) < target) __builtin_amdgcn_s_sleep(2);
        __builtin_amdgcn_fence(__ATOMIC_ACQUIRE, "agent");
        asm volatile("s_waitcnt vmcnt(0)" ::: "memory");
    }
    __syncthreads();
}

#define XB_TMO      128
#define XB_XCNT(j)  (256  + 64 * (j))
#define XB_XSUB(j)  (1280 + 64 * (j))
#define XB_XGEN(j)  (2304 + 64 * (j))
#define XB_TOP      3328
#define XB_TOPGEN   3392
#define XCD_BAR_WORDS 3456
#define XB_SPIN_CAP (1u << 18)
constexpr size_t WS_XBAR2 = WS_MISC + 32768;
constexpr size_t WS_XBAR = WS_MISC + 16384;
__device__ __forceinline__ unsigned xb_ld(unsigned* p)              { return __hip_atomic_load(p, __ATOMIC_RELAXED, __HIP_MEMORY_SCOPE_AGENT); }
__device__ __forceinline__ unsigned xb_add(unsigned* p, unsigned v) { return __hip_atomic_fetch_add(p, v, __ATOMIC_RELAXED, __HIP_MEMORY_SCOPE_AGENT); }
__device__ __forceinline__ unsigned xb_xcc_id() { return (unsigned)__builtin_amdgcn_s_getreg((3 << 11) | 20) & 0xFu; }
#define XB_SPIN(cond, bar) do { unsigned _sp = 0; while (cond) { __builtin_amdgcn_s_sleep(1); \
    if ((++_sp & 255u) == 0u) { if (xb_ld(&(bar)[XB_TMO])) break; if (_sp > XB_SPIN_CAP) { atomicAdd(&(bar)[XB_TMO], 1u); break; } } } } while (0)
__device__ __forceinline__ void xcd_barrier_complete(unsigned* bar, unsigned x, unsigned& nloc, unsigned& nx, const unsigned G) {
    unsigned sum, cnt, mine, sp = 0u;
    for (;;) {
        sum = 0u; cnt = 0u; mine = 0u;
#pragma unroll
        for (unsigned j = 0; j < 16; ++j) { const unsigned c = xb_ld(&bar[XB_XCNT(j)]); sum += c; cnt += (c > 0u) ? 1u : 0u; mine = (j == x) ? c : mine; }
        if (sum == G) break;
        __builtin_amdgcn_s_sleep(1);
        if ((++sp & 255u) == 0u) { if (xb_ld(&bar[XB_TMO])) break; if (sp > XB_SPIN_CAP) { atomicAdd(&bar[XB_TMO], 1u); break; } }
    }
    nloc = mine > 0u ? mine : 1u; nx = cnt > 0u ? cnt : 1u;
}
__device__ __forceinline__ void xcd_barrier(unsigned* bar, volatile LAS unsigned* st, const unsigned total) {
    asm volatile("s_waitcnt vmcnt(0)" ::: "memory");
    __syncthreads();
    if (threadIdx.x == 0) {
        const unsigned x = xb_xcc_id();
        __builtin_amdgcn_s_waitcnt(0);
        unsigned nloc = st[0], nx = st[1];
        if (nloc == 0u) { xcd_barrier_complete(bar, x, nloc, nx, total); st[0] = nloc; st[1] = nx; }
        const unsigned old = xb_add(&bar[XB_XSUB(x)], 1u);
        const unsigned gen = old / nloc;
        if (old + 1u == (gen + 1u) * nloc) {
            __builtin_amdgcn_fence(__ATOMIC_RELEASE, "agent");
            asm volatile("s_waitcnt vmcnt(0)" ::: "memory");
            const unsigned og = xb_add(&bar[XB_TOP], 1u);
            const unsigned tg = og / nx;
            if (og + 1u == (tg + 1u) * nx) xb_add(&bar[XB_TOPGEN], 1u);
            else XB_SPIN(xb_ld(&bar[XB_TOPGEN]) == tg, bar);
            __builtin_amdgcn_fence(__ATOMIC_ACQUIRE, "agent");
            xb_add(&bar[XB_XGEN(x)], 1u);
            asm volatile("s_waitcnt vmcnt(0)" ::: "memory");
        } else {
            XB_SPIN(xb_ld(&bar[XB_XGEN(x)]) == gen, bar);
            __builtin_amdgcn_fence(__ATOMIC_ACQUIRE, "agent");
            asm volatile("s_waitcnt vmcnt(0)" ::: "memory");
        }
    }
    __syncthreads();
}

__global__ void __launch_bounds__(512) mega(Params P) {
    extern __shared__ __attribute__((aligned(16))) unsigned char lds_raw[];
    LAS unsigned char* lds = (LAS unsigned char*)lds_raw;
    cg::grid_group grid = cg::this_grid();
    volatile LAS unsigned* xst = (volatile LAS unsigned*)(lds + LDS_BYTES - 16);
    if (threadIdx.x == 0) { xst[0] = 0u; xst[1] = 0u; xst[2] = 0u; xst[3] = 0u; (void)xb_add(&((unsigned*)(P.ws + WS_XBAR))[XB_XCNT(xb_xcc_id())], 1u);
        if (blockIdx.x >= 128) (void)xb_add(&((unsigned*)(P.ws + WS_XBAR2))[XB_XCNT(xb_xcc_id())], 1u); }
    __syncthreads();

    unsigned nsub = 0;
    for (int ph = 0; ph < NL * 12 + 1; ++ph) {
        const int l = ph / 12, kph = ph - l * 12;
        if (kph == 7 && ph != NL * 12) continue;
        if (ph == NL * 12) {
#if (PHMASK >> 12) & 1
    { PH_BEGIN
        const int lane = tid & 63, gw = bid * 8 + (tid >> 6), nw = G * 8;
        const float* fn = INP(32); const float* ssf = SS + (size_t)0 * T * 16; float* X = OUT;
        for (int r = gw; r < T; r += nw) { const float rs = row_rstd(ssf, r);
#pragma unroll
            for (int i = 0; i < 4; ++i) { const size_t o = (size_t)r * D + i * 256 + lane * 4; *(f32x4*)(X + o) = *(const f32x4*)(X + o) * rs * *(const f32x4*)(fn + i * 256 + lane * 4); } }
    }
#endif
            break;
        }
        switch (kph) {
        case 0: {
#if (PHMASK >> 0) & 1
        for (int rep = 0; rep < REP0; ++rep) {
        {
            { PH_BEGIN convT_w<1>(INP(3) + (size_t)l * D * 2 * FF, 2 * FF, 0, INP(2) + (size_t)l * D, (bf16_t*)(WB + WB_W1A), D, D, 2 * FF, bid * 8 + (tid >> 6), G * 8, tid & 63, 0); }
            { PH_BEGIN convT_w<0>(INP(4) + (size_t)l * FF * D, D, 0, nullptr, (bf16_t*)(WB + WB_W1B), FF, FF, D, bid * 8 + (tid >> 6), G * 8, tid & 63, 1408); }
            { PH_BEGIN convT_w<2>(INP(7) + (size_t)l * D * 6928, 6928, 0, INP(5) + (size_t)l * D, (bf16_t*)(WB + WB_WIN), D, D, 4096, bid * 8 + (tid >> 6), G * 8, tid & 63, 2112); }
            { PH_BEGIN convT_w<0>(INP(7) + (size_t)l * D * 6928, 6928, 3856, INP(5) + (size_t)l * D, (bf16_t*)(WB + WB_WG), D, D, 3072, bid * 8 + (tid >> 6), G * 8, tid & 63, 3136); }
            for (int j = 0; j < 3; ++j) { PH_BEGIN convT_w<0>(INP(27) + ((size_t)l * 3 + j) * 512 * D, D, 0, nullptr, (bf16_t*)(WB + WB_WBR) + (size_t)j * D * 512, 512, 512, D, bid * 8 + (tid >> 6), G * 8, tid & 63, 3904 + 128 * j); }
            { PH_BEGIN convT_w<0>(INP(28) + (size_t)l * D * D, D, 0, nullptr, (bf16_t*)(WB + WB_WO), D, D, D, bid * 8 + (tid >> 6), G * 8, tid & 63, 4288); }
            { PH_BEGIN convT_w<0>(INP(26) + (size_t)l * D * D, D, 0, INP(6) + (size_t)l * D, (bf16_t*)(WB + WB_WKV), D, D, D, bid * 8 + (tid >> 6), G * 8, tid & 63, 4544); }
            { PH_BEGIN convT_w<1>(INP(30) + (size_t)l * D * 2 * FF, 2 * FF, 0, INP(29) + (size_t)l * D, (bf16_t*)(WB + WB_W2A), D, D, 2 * FF, bid * 8 + (tid >> 6), G * 8, tid & 63, 4800); }
            { PH_BEGIN convT_w<0>(INP(31) + (size_t)l * FF * D, D, 0, nullptr, (bf16_t*)(WB + WB_W2B), FF, FF, D, bid * 8 + (tid >> 6), G * 8, tid & 63, 6208); }
            { PH_BEGIN convT_w<0>(INP(10) + (size_t)l * 64 * 512, 512, 0, nullptr, (bf16_t*)(WB + WB_LW2), 64, 64, 512, bid * 8 + (tid >> 6), G * 8, tid & 63, 6912); }
            { PH_BEGIN convT_w<0>(INP(12) + (size_t)l * 64 * 512, 512, 0, nullptr, (bf16_t*)(WB + WB_LA2), 64, 64, 512, bid * 8 + (tid >> 6), G * 8, tid & 63, 6920); }
            { PH_BEGIN convT_w<0>(INP(13) + (size_t)l * 128 * 512, 512, 0, nullptr, (bf16_t*)(WB + WB_LG2), 128, 128, 512, bid * 8 + (tid >> 6), G * 8, tid & 63, 6928); }
            if (l > 0) {
                { PH_BEGIN convT_w<0>(INP(20) + (size_t)(l - 1) * 512 * 32, 32, 0, nullptr, (bf16_t*)(WB + WB_LV1), 512, 512, 32, bid * 8 + (tid >> 6), G * 8, tid & 63, 6944); }
                { PH_BEGIN convT_w<0>(INP(21) + (size_t)(l - 1) * 32 * 512, 512, 0, nullptr, (bf16_t*)(WB + WB_LV2), 32, 32, 512, bid * 8 + (tid >> 6), G * 8, tid & 63, 6976); }
            }
            if (l == 0) { PH_BEGIN
                const int lane = tid & 63, gw = bid * 8 + (tid >> 6), nw = G * 8;
                float* rstd_mem = (float*)(ws + WS_MISC); bf16_t* MEMN = (bf16_t*)(ws + WS_MEMN);
                for (int r = gw; r < T + 1024; r += nw) {
                    const bool ism = r >= T; const float* src = ism ? INP(1) + (size_t)(r - T) * D : INP(0) + (size_t)r * D; bf16_t* dst = ism ? MEMN + (size_t)(r - T) * D : XB_ + (size_t)r * D; float q = 0.f;
#pragma unroll
                    for (int i = 0; i < 4; ++i) { const f32x4 v = *(const f32x4*)(src + i * 256 + lane * 4); st_bf4(dst + i * 256 + lane * 4, v); q += (v[0] * v[0] + v[1] * v[1]) + (v[2] * v[2] + v[3] * v[3]); }
                    q = wave_sum(q);
                    if (ism) { if (lane == 0) rstd_mem[r - T] = rsqrtf(q * (1.0f / 1024.0f) + 1e-6f); } else if (lane < 16) SS[(size_t)r * 16 + lane] = (lane == 0) ? q : 0.f;
                }
            }
        }
        }
#endif
        } break;
        case 1: {
#if (PHMASK >> 1) & 1
        for (int rep = 0; rep < REPG; ++rep) {
        { PH_BEGIN
            pg8::Gemm g{XB_, (const bf16_t*)(WB + WB_W1A), T, 2 * FF, D, D, D, 0, 0}; pg8::StaticOrder S; S.init(T, 2 * FF, G, bid, 1);
            EpiFFNa E{(bf16_t*)U_, SS + (size_t)0 * T * 16}; pg8::gemm_phase(lds, g, S, E, tid);
        }
        if ((int)blockIdx.x >= (int)gridDim.x - 16) { PH_BEGIN
            pg8::Gemm g2{(const bf16_t*)(ws + WS_MEMN), (const bf16_t*)(WB + WB_WKV), 1024, D, D, D, D, 0, 0}; pg8::StaticOrder S2; S2.init(1024, D, 16, bid - (G - 16), 1);
            EpiKV E2{KB_, VT_, (const float*)(ws + WS_MISC)}; pg8::gemm_phase(lds, g2, S2, E2, tid);
        }
        }
#endif
        } break;
        case 2: {
#if (PHMASK >> 2) & 1
        { PH_BEGIN
            pg8::Gemm g{(const bf16_t*)U_, (const bf16_t*)(WB + WB_W1B), T, D, FF, FF, FF, 0, 0}; pg8::StaticOrder S; S.init(T, D, G, bid, 1);
            EpiRes E{l == 0 ? INP(0) : OUT, OUT, XB_, SS + (size_t)1 * T * 16, 0.5f}; pg8::gemm_phase(lds, g, S, E, tid);
        }
#endif
        } break;
        case 3: {
#if (PHMASK >> 3) & 1
        for (int rep = 0; rep < REPG; ++rep) {
        { PH_BEGIN
            pg8::Gemm g{XB_, (const bf16_t*)(WB + WB_WIN), T, 4096, D, D, D, 0, 0}; pg8::StaticOrder S; S.init(T, 4096, G, bid, 1);
            EpiU E{(bf16_t*)U_, SS + (size_t)1 * T * 16}; pg8::gemm_phase(lds, g, S, E, tid);
        }
        }
#endif
        } break;
        case 4: {
#if (PHMASK >> 4) & 1
        { PH_BEGIN
            PrepArgs PA; PA.U = (const bf16_t*)(U_ + U_RWKV); PA.mu = INP(8) + (size_t)l * 1792; PA.w0 = INP(9) + (size_t)l * 512; PA.a0 = INP(11) + (size_t)l * 512;
            PA.kk_ = INP(14) + (size_t)l * 512; PA.ka = INP(15) + (size_t)l * 512; PA.rk = INP(16) + (size_t)l * 512; PA.v0 = INP(19) + (size_t)(l > 0 ? l - 1 : 0) * 512;
            PA.w2t = (const bf16_t*)(WB + WB_LW2); PA.a2t = (const bf16_t*)(WB + WB_LA2); PA.g2t = (const bf16_t*)(WB + WB_LG2); PA.v1t = (const bf16_t*)(WB + WB_LV1); PA.v2t = (const bf16_t*)(WB + WB_LV2);
            PA.vfirst = (float*)(ws + WS_VF); PA.Wd = (float*)(SC_ + SC_WD); PA.V = (float*)(SC_ + SC_V); PA.RKKB = (bf16_t*)(SC_ + SC_RKKB); PA.Go = (bf16_t*)(ws + WS_GO); PA.Bon = (float*)(ws + WS_BON); PA.layer = l;
            { const int tt = (bid & 7) * 32 + (bid >> 3); rwkv_prep_tile(lds, PA, tt, tid); }
        }
        { PH_BEGIN
            GlaArgs GA; GA.Ug = (const bf16_t*)(U_ + U_GLA); GA.conv = INP(22) + (size_t)l * 4096; GA.aup = INP(23) + (size_t)l * 4096; GA.abias = INP(24) + (size_t)l * 256; GA.gnorm = INP(25) + (size_t)l * 512;
            GA.kvcT = (float*)(ws + WS_KVC); GA.dec = (float*)(ws + WS_DEC); GA.spT = (bf16_t*)(U_ + U_SPT); GA.Yg = Y_ + (size_t)T * 512;
            { const int x = bid & 7, j = bid >> 3, b = x >> 1, nhi = x & 1;
              for (int k = 0; k < 0; ++k) { const int idx = j * 2 + k, h = idx >> 5, n = nhi * 32 + (idx & 31); gla_a_tile(lds, GA, ((b * 4 + h) << 6) | n, tid); } }
        }
#endif
        } break;
        case 5: {
#if (PHMASK >> 5) & 1
        if ((int)blockIdx.x < 128) { PH_BEGIN
            const int xcd = bid & 7, j = bid >> 3, p = xcd * 4 + (j >> 2), rg = j & 3;
            rwkv_scan_unit(lds, (const float*)(SC_ + SC_WD), (const float*)(SC_ + SC_V), (const bf16_t*)(SC_ + SC_RKKB), (float*)(U_ + U_YRAW), p, rg, tid);
        } else {
            { PH_BEGIN
            GlaArgs GA; GA.Ug = (const bf16_t*)(U_ + U_GLA); GA.conv = INP(22) + (size_t)l * 4096; GA.aup = INP(23) + (size_t)l * 4096; GA.abias = INP(24) + (size_t)l * 256; GA.gnorm = INP(25) + (size_t)l * 512;
            GA.kvcT = (float*)(ws + WS_KVC); GA.dec = (float*)(ws + WS_DEC); GA.spT = (bf16_t*)(U_ + U_SPT); GA.Yg = Y_ + (size_t)T * 512;
            { const int x = bid & 7, j = (bid - 128) >> 3, b = x >> 1, nhi = x & 1;
              for (int k = 0; k < 8; ++k) { const int idx = j * 8 + k, h = idx >> 5, n = nhi * 32 + (idx & 31); gla_a_tile(lds, GA, ((b * 4 + h) << 6) | n, tid); } }
            }
            xcd_barrier((unsigned*)(P.ws + WS_XBAR2), xst + 2, 128u);
            { PH_BEGIN
            bf16_t* spT = (bf16_t*)(U_ + U_SPT); const float* DEC = (const float*)(ws + WS_DEC); const float* KVC = (const float*)(ws + WS_KVC);
            for (int i = (bid - 128) * 512 + tid; i < 16 * 128 * 64; i += 128 * 512) { const int bh = i >> 13, ed = i & 8191, d = i & 63; float st = 0.f;
                for (int n0 = 0; n0 < 64; n0 += 16) { float kv[16], dc[16];
#pragma unroll
                    for (int q = 0; q < 16; ++q) { kv[q] = KVC[((size_t)bh * 64 + n0 + q) * 8192 + ed]; dc[q] = DEC[((size_t)bh * 64 + n0 + q) * 64 + d]; }
#pragma unroll
                    for (int q = 0; q < 16; ++q) { spT[((size_t)bh * 64 + n0 + q) * 8192 + ed] = f2bf(st); st = st * dc[q] + kv[q]; } } }
            }
            xcd_barrier((unsigned*)(P.ws + WS_XBAR2), xst + 2, 128u);
            { PH_BEGIN
            GlaArgs GA; GA.Ug = (const bf16_t*)(U_ + U_GLA); GA.conv = INP(22) + (size_t)l * 4096; GA.aup = INP(23) + (size_t)l * 4096; GA.abias = INP(24) + (size_t)l * 256; GA.gnorm = INP(25) + (size_t)l * 512;
            GA.kvcT = (float*)(ws + WS_KVC); GA.dec = (float*)(ws + WS_DEC); GA.spT = (bf16_t*)(U_ + U_SPT); GA.Yg = Y_ + (size_t)T * 512;
            { const int x = bid & 7, j = (bid - 128) >> 3, b = x >> 1, nhi = x & 1;
              for (int k = 0; k < 8; ++k) { const int idx = j * 8 + k, h = idx >> 5, n = nhi * 32 + (idx & 31); gla_c_tile(lds, GA, ((b * 4 + h) << 6) | n, tid); } }
            }
            { PH_BEGIN
              const int x = bid & 7, j = (bid - 128) >> 3;
              for (int k = 0; k < 2; ++k) { const int jj = 2 * j + k, pm = 8 * x + (jj & 7), h = jj >> 3, b = pm >> 4, pq = pm & 15;
                  xa_pair(lds, (const bf16_t*)(U_ + U_XA), KB_, VT_, Y_ + (size_t)2 * T * 512, ((b * 4 + h) << 4) | pq, tid); }
            }
        }
#endif
        } break;
        case 6: {
#if (PHMASK >> 6) & 1
        { PH_BEGIN
            const int lane = tid & 63, gw = bid * 8 + (tid >> 6), nw = G * 8;
            const float* lnw = INP(17) + (size_t)l * 512; const float* lnb = INP(18) + (size_t)l * 512; const float* Yraw = (const float*)(U_ + U_YRAW); const float* Vv = (const float*)(SC_ + SC_V);
            const float* BON = (const float*)(ws + WS_BON); const bf16_t* GO = (const bf16_t*)(ws + WS_GO); bf16_t* Y = Y_;
            const int kq = lane & 15, sub = lane >> 4;
            for (int it0 = gw * 4; it0 < 32 * SEQ; it0 += nw * 16) {
                f32x4 y[4], vv[4], gg[4], lw[4], lb[4]; float bon[4];
#pragma unroll
                for (int q = 0; q < 4; ++q) { const int it = it0 + q * nw * 4 + sub; const int p = it >> 12, s2 = it & (SEQ - 1), b = p >> 3, h = p & 7, t = b * SEQ + s2;
                    y[q] = *(const f32x4*)(Yraw + (size_t)it * 64 + kq * 4); vv[q] = *(const f32x4*)(Vv + (size_t)it * 64 + kq * 4); gg[q] = ld_bf4(GO + (size_t)t * 512 + h * 64 + kq * 4);
                    lw[q] = *(const f32x4*)(lnw + h * 64 + kq * 4); lb[q] = *(const f32x4*)(lnb + h * 64 + kq * 4); bon[q] = BON[(size_t)t * 8 + h]; }
#pragma unroll
                for (int q = 0; q < 4; ++q) { const int it = it0 + q * nw * 4 + sub; const int p = it >> 12, s2 = it & (SEQ - 1), b = p >> 3, h = p & 7, t = b * SEQ + s2;
                    const float mean = row16_sum((y[q][0] + y[q][1]) + (y[q][2] + y[q][3])) * (1.0f / 64.0f); const f32x4 dl = y[q] - mean;
                    const float var = row16_sum((dl[0] * dl[0] + dl[1] * dl[1]) + (dl[2] * dl[2] + dl[3] * dl[3])) * (1.0f / 64.0f); const float rs = rsqrtf(var + 64e-5f);
                    st_bf4(Y + (size_t)t * 512 + h * 64 + kq * 4, ((dl * rs) * lw[q] + lb[q] + vv[q] * bon[q]) * gg[q]); } }
        }
        { PH_BEGIN
            pg8::Gemm g{XB_, (const bf16_t*)(WB + WB_WG), T, 3072, D, D, D, 0, 0}; pg8::StaticOrder S; S.init(T, 3072, G, bid, 1);
            EpiGate E{(unsigned char*)(SC_ + SC_RKKB), SS + (size_t)1 * T * 16}; pg8::gemm_phase(lds, g, S, E, tid);
        }
#endif
        } break;
        case 7: break;
        case 8: {
#if (PHMASK >> 8) & 1
        for (int rep = 0; rep < REPG; ++rep) {
        { PH_BEGIN
            pg8::Gemm g{Y_, (const bf16_t*)(WB + WB_WBR), T, D, 512, 512, 512, (unsigned)T * 512u * 2u, (unsigned)D * 512u * 2u}; pg8::StaticOrder S; S.init(T, D, G, bid, 3);
            EpiMerge E{(const unsigned char*)(SC_ + SC_RKKB), (float*)(U_ + U_MG), (bf16_t*)(U_ + U_MGB)}; pg8::gemm_phase(lds, g, S, E, tid);
        }
        }
#endif
        } break;
        case 9: {
#if (PHMASK >> 9) & 1
        { PH_BEGIN
            pg8::Gemm g{(const bf16_t*)(U_ + U_MGB), (const bf16_t*)(WB + WB_WO), T, D, D, D, D, 0, 0}; pg8::StaticOrder S; S.init(T, D, G, bid, 1);
            EpiRes E{OUT, OUT, XB_, SS + (size_t)2 * T * 16, 1.0f}; pg8::gemm_phase(lds, g, S, E, tid);
        }
#endif
        } break;
        case 10: {
#if (PHMASK >> 10) & 1
        for (int rep = 0; rep < REPG; ++rep) {
        { PH_BEGIN
            pg8::Gemm g{XB_, (const bf16_t*)(WB + WB_W2A), T, 2 * FF, D, D, D, 0, 0}; pg8::StaticOrder S; S.init(T, 2 * FF, G, bid, 1);
            EpiFFNa E{(bf16_t*)U_, SS + (size_t)2 * T * 16}; pg8::gemm_phase(lds, g, S, E, tid);
        }
        }
#endif
        } break;
        case 11: {
#if (PHMASK >> 11) & 1
        { PH_BEGIN
            pg8::Gemm g{(const bf16_t*)U_, (const bf16_t*)(WB + WB_W2B), T, D, FF, FF, FF, 0, 0}; pg8::StaticOrder S; S.init(T, D, G, bid, 1);
            EpiRes E{OUT, OUT, XB_, SS + (size_t)0 * T * 16, 0.5f}; pg8::gemm_phase(lds, g, S, E, tid);
        }
#endif
        } break;
        default: break;
        }
        if (ph == 0) grid.sync();
        else xcd_barrier((unsigned*)(P.ws + WS_XBAR), xst, gridDim.x);
    }
}

extern "C" void kernel_launch(void* const* d_in, const int* in_sizes, int n_in, void* d_out, int out_size, void* d_ws, size_t ws_size, hipStream_t stream) {
    static int grid_blocks = 0;
    if (!grid_blocks) {
        if (n_in != 33 || ws_size < WS_END) { fprintf(stderr, "kernel_launch: need 33 inputs and %zu bytes of workspace (got %d, %zu)\n", (size_t)WS_END, n_in, ws_size); grid_blocks = -1; return; }
        int dev = 0, cus = 0, per_cu = 0;
        hipGetDevice(&dev); hipDeviceGetAttribute(&cus, hipDeviceAttributeMultiprocessorCount, dev);
        if (hipFuncSetAttribute((const void*)mega, hipFuncAttributeMaxDynamicSharedMemorySize, LDS_BYTES) != hipSuccess) { fprintf(stderr, "kernel_launch: hipFuncSetAttribute failed\n"); grid_blocks = -1; return; }
        if (hipOccupancyMaxActiveBlocksPerMultiprocessor(&per_cu, (const void*)mega, 512, LDS_BYTES) != hipSuccess || per_cu < 1) { fprintf(stderr, "kernel_launch: occupancy query says %d\n", per_cu); per_cu = 1; }
        (void)hipGetLastError();
        grid_blocks = cus * per_cu;
        if (grid_blocks != 256) { fprintf(stderr, "kernel_launch: this kernel splits a 256-workgroup grid in its scan phase (got %d)\n", grid_blocks); grid_blocks = -1; return; }
    }
    if (grid_blocks < 0) return;
    if (hipMemsetAsync((char*)d_ws + WS_BAR, 0, (WS_XBAR2 - WS_BAR) + XCD_BAR_WORDS * 4, stream) != hipSuccess) { fprintf(stderr, "kernel_launch: memset failed\n"); return; }
    Params p{};
    for (int i = 0; i < 33; ++i) p.in[i] = (const float*)d_in[i];
    p.out = (float*)d_out; p.ws = (unsigned char*)d_ws;
    void* args[] = {&p};
    hipError_t e = hipLaunchCooperativeKernel((const void*)mega, dim3(grid_blocks), dim3(512), args, LDS_BYTES, stream);
    if (e != hipSuccess) fprintf(stderr, "cooperative launch failed: %s (grid %d)\n", hipGetErrorString(e), grid_blocks);
}
```

```cpp
#include <hip/hip_runtime.h>
#include <hip/hip_cooperative_groups.h>
#include <cstdio>
namespace cg = cooperative_groups;
#ifndef P4SUB
#define P4SUB 7
#endif
#ifndef REP5
#define REP5 1
#endif
#ifndef REP4
#define REP4 1
#endif
#ifndef REP6
#define REP6 1
#endif
#ifndef REP0
#define REP0 1
#endif
#ifndef REPG
#define REPG 1
#endif
#ifndef REPSYNC
#define REPSYNC 1
#endif
#ifndef NA4
#define NA4 2
#endif
#ifndef PHMASK
#define PHMASK 0xFFFF
#endif

#define LAS __attribute__((address_space(3)))
typedef unsigned short bf16_t;
typedef short bf16x8 __attribute__((ext_vector_type(8)));
typedef float f32x4 __attribute__((ext_vector_type(4)));
typedef float f32x2 __attribute__((ext_vector_type(2)));
typedef unsigned u32x4 __attribute__((ext_vector_type(4)));
typedef unsigned u32x2 __attribute__((ext_vector_type(2)));

constexpr int T = 16384, D = 1024, FF = 2816, SEQ = 4096, NL = 4;
constexpr int LDS_BYTES = 139264;

constexpr size_t MB = 1024 * 1024;
constexpr size_t WS_MISC = 0;
constexpr size_t WS_SS = 1 * MB;
constexpr size_t WS_WB = 4 * MB;
constexpr size_t WB_W1A = 0;
constexpr size_t WB_W1B = WB_W1A + (size_t)5632 * 1024 * 2;
constexpr size_t WB_WIN = WB_W1B + (size_t)1024 * 2816 * 2;
constexpr size_t WB_WG = WB_WIN + (size_t)4096 * 1024 * 2;
constexpr size_t WB_WBR = WB_WG + (size_t)3072 * 1024 * 2;
constexpr size_t WB_WO = WB_WBR + (size_t)3 * 1024 * 512 * 2;
constexpr size_t WB_WKV = WB_WO + (size_t)1024 * 1024 * 2;
constexpr size_t WB_W2A = WB_WKV + (size_t)1024 * 1024 * 2;
constexpr size_t WB_W2B = WB_W2A + (size_t)5632 * 1024 * 2;
constexpr size_t WB_LW2 = WB_W2B + (size_t)1024 * 2816 * 2;
constexpr size_t WB_LA2 = WB_LW2 + 512 * 64 * 2;
constexpr size_t WB_LG2 = WB_LA2 + 512 * 64 * 2;
constexpr size_t WB_LV1 = WB_LG2 + 512 * 128 * 2;
constexpr size_t WB_LV2 = WB_LV1 + 32 * 512 * 2;
constexpr size_t WB_END = WB_LV2 + 512 * 32 * 2;
static_assert(WB_END <= 55 * MB, "weights region");
constexpr size_t WS_XB = WS_WB + 55 * MB;
constexpr size_t WS_VF = WS_XB + 32 * MB;
constexpr size_t WS_MEMN = WS_VF + 32 * MB;
constexpr size_t WS_KB = WS_MEMN + 2 * MB;
constexpr size_t WS_VT = WS_KB + 1 * MB;
constexpr size_t WS_GO = WS_VT + 1 * MB;
constexpr size_t WS_BON = WS_GO + 16 * MB;
constexpr size_t WS_Y = WS_BON + 1 * MB;
constexpr size_t WS_KVC = WS_Y + 48 * MB;
constexpr size_t WS_DEC = WS_KVC + 32 * MB;
constexpr size_t WS_SC = WS_DEC + 1 * MB;
constexpr size_t SC_WD = 0;
constexpr size_t SC_V = 32 * MB;
constexpr size_t SC_RKKB = 64 * MB;
constexpr size_t WS_U = WS_SC + 128 * MB;
constexpr size_t U_RWKV = 0;
constexpr size_t U_GLA = (size_t)T * 1792 * 2;
constexpr size_t U_XA = 2 * (size_t)T * 1792 * 2;
constexpr size_t U_YRAW = 0;
constexpr size_t U_SPT = 32 * MB;
constexpr size_t U_MG = 0;
constexpr size_t U_MGB = 64 * MB;
constexpr size_t WS_END = WS_U + 128 * MB;
static_assert(U_XA + (size_t)T * 512 * 2 <= 128 * MB, "U region");

typedef __bf16 bf16x2_t __attribute__((ext_vector_type(2)));
__device__ __forceinline__ unsigned cvt_pk_bf16(float lo, float hi) { const f32x2 v = {lo, hi}; const bf16x2_t r = __builtin_convertvector(v, bf16x2_t); return __builtin_bit_cast(unsigned, r); }
__device__ __forceinline__ bf16_t f2bf(float x) { return (bf16_t)(cvt_pk_bf16(x, 0.f) & 0xffffu); }
__device__ __forceinline__ float bf2f(bf16_t b) { return __uint_as_float(((unsigned)b) << 16); }
__device__ __forceinline__ float bflo(unsigned w) { return __uint_as_float(w << 16); }
__device__ __forceinline__ float bfhi(unsigned w) { return __uint_as_float(w & 0xffff0000u); }
__device__ __forceinline__ f32x4 ld_bf4(const bf16_t* p) { const u32x2 w = *(const u32x2*)p; return (f32x4){bflo(w.x), bfhi(w.x), bflo(w.y), bfhi(w.y)}; }
__device__ __forceinline__ void st_bf4(bf16_t* p, f32x4 v) { u32x2 w; w.x = cvt_pk_bf16(v[0], v[1]); w.y = cvt_pk_bf16(v[2], v[3]); *(u32x2*)p = w; }
__device__ __forceinline__ float sigmoidf_(float x) { return __builtin_amdgcn_rcpf(1.0f + __expf(-x)); }
__device__ __forceinline__ float wave_sum(float v) { for (int o = 32; o >= 1; o >>= 1) v += __shfl_xor(v, o); return v; }
__device__ __forceinline__ f32x4 mfma16(bf16x8 a, bf16x8 b, f32x4 c) { return __builtin_amdgcn_mfma_f32_16x16x32_bf16(a, b, c, 0, 0, 0); }

__device__ __forceinline__ float row_rstd(const float* ssp, int row) {
    const f32x4* p = (const f32x4*)(ssp + (size_t)row * 16); const f32x4 a = p[0], b = p[1], c = p[2], d = p[3];
    const float t = (((a[0] + a[1]) + (a[2] + a[3])) + ((b[0] + b[1]) + (b[2] + b[3]))) + (((c[0] + c[1]) + (c[2] + c[3])) + ((d[0] + d[1]) + (d[2] + d[3])));
    return rsqrtf(t * (1.0f / 1024.0f) + 1e-6f);
}
__device__ __forceinline__ void rstd8(float (&rs)[2][4], const float* ssp, int row0, int fq) {
    f32x4 p[2][4];
#pragma unroll
    for (int ai = 0; ai < 2; ++ai)
#pragma unroll
        for (int m = 0; m < 4; ++m) p[ai][m] = *(const f32x4*)(ssp + (size_t)(row0 + ai * 128 + m * 16) * 16 + fq * 4);
#pragma unroll
    for (int ai = 0; ai < 2; ++ai)
#pragma unroll
        for (int m = 0; m < 4; ++m) { float t = (p[ai][m][0] + p[ai][m][1]) + (p[ai][m][2] + p[ai][m][3]); t += __shfl_xor(t, 16); t += __shfl_xor(t, 32); rs[ai][m] = rsqrtf(t * (1.0f / 1024.0f) + 1e-6f); }
}
namespace pg8 {
constexpr int BM = 256, BK = 64, HALF = 128, HTB = HALF * BK * 2, STAGE_BYTES = 8 * HTB, NXCD = 8, WGM = 8;
__device__ __forceinline__ int lds_byte(int r, int c) { const int st = (r >> 4) * 2 + (c >> 5), rr = r & 15, cc = c & 31, ob = rr * 64 + cc * 2; return st * 1024 + (ob ^ (((ob >> 9) & 1) << 5)); }
__device__ __forceinline__ void stage_rc(int b, int& R, int& C) { const int st = b / 1024, sb = b % 1024, swz = sb ^ (((sb >> 9) & 1) << 5); R = (st >> 1) * 16 + swz / 64; C = (st & 1) * 32 + (swz % 64) / 2; }
__device__ __forceinline__ int perm32(int rho) { const int n = rho >> 4, i = rho & 15; return 8 * (i >> 2) + 4 * n + (i & 3); }

struct Unit { int pm, pn, z; };
struct Gemm { const bf16_t* A; const bf16_t* Bt; int M, N, K, lda, ldb; unsigned zA, zB; };

struct StaticOrder {
    int nM, nN, nwg, G, c, nz;
    __device__ void init(int M, int N, int G_, int c_, int nz_) { nM = M / BM; nN = N / BM; nwg = nM * nN; G = G_; c = c_; nz = nz_; }
    __device__ bool next(int i, Unit& u) const {
        const int ti = i / nz; u.z = i - ti * nz;
        const long L = (long)ti * G + c; if (L >= nwg) return false;
        int wgid = (int)L; { const int q = nwg / NXCD, r = nwg % NXCD, xcd = wgid % NXCD, off = wgid / NXCD; wgid = (xcd < r ? xcd * (q + 1) : r * (q + 1) + (xcd - r) * q) + off; }
        const int nig = WGM * nN, gid = wgid / nig, fm = gid * WGM, gsz = (nM - fm) < WGM ? (nM - fm) : WGM;
        u.pm = fm + ((wgid % nig) % gsz); u.pn = (wgid % nig) / gsz; return true;
    }
};

template <class Epi>
__device__ __forceinline__ void gemm_phase(LAS unsigned char* lds, const Gemm g, const StaticOrder& S, const Epi& E, const int tid) {
    const int wid = __builtin_amdgcn_readfirstlane(tid >> 6), lane = tid & 63, wr = wid >> 2, wc = wid & 3, fr = lane & 15, fq = lane >> 4;
    const int K = g.K, nt = K / BK;
    unsigned voffA[2], voffB[2];
#pragma unroll
    for (int i = 0; i < 2; ++i) { int R, C; stage_rc(tid * 16 + i * 8192, R, C); const int Rb = Epi::PERM ? ((R & ~31) + perm32(R & 31)) : R;
        voffA[i] = (unsigned)(R * g.lda + C) * 2u; voffB[i] = (unsigned)(Rb * g.ldb + C) * 2u; }
    const unsigned kstep = (unsigned)(BK * 2);
    const unsigned hstepA = (unsigned)HALF * g.lda * 2u, hstepB = (unsigned)HALF * g.ldb * 2u;
    const unsigned tstepA = 2u * hstepA, tstepB = 2u * hstepB;
    const unsigned ldsw = (unsigned)wid * 1024u;
    const int aoff = lds_byte(wr * 64 + fr, fq * 8), boff = lds_byte(wc * 32 + fr, fq * 8);
    const char* const gA = (const char*)g.A; const char* const gB = (const char*)g.Bt;
#define PG8_SA(b, h) (((b) * 2 + (h)) * HTB)
#define PG8_SB(b, h) ((4 + (b) * 2 + (h)) * HTB)
#define PG8_STAGE(bufoff, gbase, soff, voff) do { _Pragma("unroll") for (int _i = 0; _i < 2; ++_i) \
        __builtin_amdgcn_global_load_lds((const unsigned*)(((gbase) + (size_t)(unsigned)(soff)) + (voff)[_i]), (LAS unsigned*)(lds + (bufoff) + ldsw + _i * 8192), 16, 0, 0); } while (0)
#define PG8_LDA(dst, b, h) do { _Pragma("unroll") for (int m = 0; m < 4; ++m) _Pragma("unroll") for (int k = 0; k < 2; ++k) dst[m][k] = *(const LAS bf16x8*)(lds + PG8_SA(b, h) + aoff + m * 2048 + k * 1024); } while (0)
#define PG8_LDB(dst, b, h) do { _Pragma("unroll") for (int n = 0; n < 2; ++n) _Pragma("unroll") for (int k = 0; k < 2; ++k) dst[n][k] = *(const LAS bf16x8*)(lds + PG8_SB(b, h) + boff + n * 2048 + k * 1024); } while (0)
#define PG8_MMA(ai, bj, At, Bt) do { __builtin_amdgcn_s_setprio(1); _Pragma("unroll") for (int m = 0; m < 4; ++m) _Pragma("unroll") for (int n = 0; n < 2; ++n) _Pragma("unroll") for (int k = 0; k < 2; ++k) \
        acc[ai][bj][m][n] = __builtin_amdgcn_mfma_f32_16x16x32_bf16(Bt[n][k], At[m][k], acc[ai][bj][m][n], 0, 0, 0); __builtin_amdgcn_s_setprio(0); } while (0)
#define PG8_WAIT_V(n) asm volatile("s_waitcnt vmcnt(" #n ")" ::: "memory")
#define PG8_WAIT_L(n) asm volatile("s_waitcnt lgkmcnt(" #n ")" ::: "memory")
#define PG8_BAR __builtin_amdgcn_s_barrier()
#define PG8_SCHED __builtin_amdgcn_sched_barrier(0)
    Unit cur, nxt; int ui = 0;
    if (!S.next(0, cur)) return;
    f32x4 acc[2][2][4][2];
#pragma unroll
    for (int a = 0; a < 2; ++a)
#pragma unroll
        for (int b = 0; b < 2; ++b)
#pragma unroll
            for (int m = 0; m < 4; ++m)
#pragma unroll
                for (int n = 0; n < 2; ++n) acc[a][b][m][n] = (f32x4){0.f, 0.f, 0.f, 0.f};
    bf16x8 At[4][2], B0[2][2], B1[2][2];
    unsigned cA = (unsigned)cur.z * g.zA + (unsigned)cur.pm * tstepA, cB = (unsigned)cur.z * g.zB + (unsigned)cur.pn * tstepB;
    PG8_STAGE(PG8_SB(0, 0), gB, cB, voffB); PG8_STAGE(PG8_SA(0, 0), gA, cA, voffA); PG8_STAGE(PG8_SB(0, 1), gB, cB + hstepB, voffB); PG8_STAGE(PG8_SA(0, 1), gA, cA + hstepA, voffA);
    if (wr == 1) PG8_BAR;
    PG8_WAIT_V(4); PG8_BAR;
    PG8_STAGE(PG8_SB(1, 0), gB, cB + kstep, voffB); PG8_STAGE(PG8_SA(1, 0), gA, cA + kstep, voffA); PG8_STAGE(PG8_SB(1, 1), gB, cB + hstepB + kstep, voffB);
    PG8_WAIT_V(6); PG8_BAR;
    for (;;) {
        const bool has_next = S.next(ui + 1, nxt);
        const unsigned nA = has_next ? (unsigned)nxt.z * g.zA + (unsigned)nxt.pm * tstepA : cA, nB = has_next ? (unsigned)nxt.z * g.zB + (unsigned)nxt.pn * tstepB : cB;
        for (int t = 0; t < nt; t += 2) {
            const bool last = (t == nt - 2);
            const unsigned a1 = cA + (unsigned)(t + 1) * kstep;
            const unsigned a2 = last ? nA : cA + (unsigned)(t + 2) * kstep, b2 = last ? nB : cB + (unsigned)(t + 2) * kstep;
            const unsigned a3 = a2 + kstep, b3 = b2 + kstep;
            PG8_LDB(B0, 0, 0); PG8_SCHED; PG8_LDA(At, 0, 0); PG8_STAGE(PG8_SA(1, 1), gA, a1 + hstepA, voffA);
            PG8_WAIT_L(8); PG8_BAR; PG8_WAIT_L(0); PG8_MMA(0, 0, At, B0); PG8_BAR; PG8_SCHED;
            PG8_LDB(B1, 0, 1); PG8_STAGE(PG8_SB(0, 0), gB, b2, voffB);
            PG8_BAR; PG8_WAIT_L(0); PG8_MMA(0, 1, At, B1); PG8_BAR;
            PG8_LDA(At, 0, 1); PG8_STAGE(PG8_SA(0, 0), gA, a2, voffA);
            PG8_BAR; PG8_WAIT_L(0); PG8_MMA(1, 0, At, B0); PG8_BAR; PG8_SCHED;
            PG8_STAGE(PG8_SB(0, 1), gB, b2 + hstepB, voffB);
            PG8_WAIT_V(6); PG8_BAR; PG8_MMA(1, 1, At, B1); PG8_BAR;
            PG8_LDB(B0, 1, 0); PG8_SCHED; PG8_LDA(At, 1, 0); PG8_STAGE(PG8_SA(0, 1), gA, a2 + hstepA, voffA);
            PG8_WAIT_L(8); PG8_BAR; PG8_WAIT_L(0); PG8_MMA(0, 0, At, B0); PG8_BAR; PG8_SCHED;
            PG8_LDB(B1, 1, 1); PG8_STAGE(PG8_SB(1, 0), gB, b3, voffB);
            PG8_BAR; PG8_WAIT_L(0); PG8_MMA(0, 1, At, B1); PG8_BAR;
            PG8_LDA(At, 1, 1); PG8_STAGE(PG8_SA(1, 0), gA, a3, voffA);
            PG8_BAR; PG8_WAIT_L(0); PG8_MMA(1, 0, At, B0); PG8_BAR; PG8_SCHED;
            PG8_STAGE(PG8_SB(1, 1), gB, b3 + hstepB, voffB);
            PG8_WAIT_V(6); PG8_BAR; PG8_MMA(1, 1, At, B1); PG8_BAR;
        }
        E(acc, cur, wr, wc, fr, fq);
        if (!has_next) break;
#pragma unroll
        for (int a = 0; a < 2; ++a)
#pragma unroll
            for (int b = 0; b < 2; ++b)
#pragma unroll
                for (int m = 0; m < 4; ++m)
#pragma unroll
                    for (int n = 0; n < 2; ++n) acc[a][b][m][n] = (f32x4){0.f, 0.f, 0.f, 0.f};
        cur = nxt; cA = nA; cB = nB; ++ui;
    }
    PG8_WAIT_V(0);
    if (wr == 0) PG8_BAR;
    PG8_BAR;
#undef PG8_SA
#undef PG8_SB
#undef PG8_STAGE
#undef PG8_LDA
#undef PG8_LDB
#undef PG8_MMA
#undef PG8_WAIT_V
#undef PG8_WAIT_L
#undef PG8_BAR
#undef PG8_SCHED
}
}
using pg8::Unit;
typedef f32x4 Acc[2][2][4][2];

struct EpiFFNa { static constexpr bool PERM = true; bf16_t* H; const float* ss;
    __device__ __forceinline__ void operator()(const Acc& acc, const Unit& u, int wr, int wc, int fr, int fq) const {
        float rs8[2][4]; rstd8(rs8, ss, u.pm * 256 + wr * 64 + fr, fq);
        const int row0 = u.pm * 256 + wr * 64 + fr, hc0 = u.pn * 128 + wc * 32 + 8 * fq;
#pragma unroll
        for (int ai = 0; ai < 2; ++ai)
#pragma unroll
            for (int m = 0; m < 4; ++m) { const int row = row0 + ai * 128 + m * 16; const float rs = rs8[ai][m]; f32x4 h[2];
#pragma unroll
                for (int n = 0; n < 2; ++n) { const f32x4 gt = acc[ai][0][m][n] * rs, up = acc[ai][1][m][n] * rs;
#pragma unroll
                    for (int jj = 0; jj < 4; ++jj) h[n][jj] = gt[jj] * sigmoidf_(gt[jj]) * up[jj]; }
                u32x4 w; w.x = cvt_pk_bf16(h[0][0], h[0][1]); w.y = cvt_pk_bf16(h[0][2], h[0][3]); w.z = cvt_pk_bf16(h[1][0], h[1][1]); w.w = cvt_pk_bf16(h[1][2], h[1][3]);
                *(u32x4*)(H + (size_t)row * FF + hc0) = w; }
    }
};
struct EpiRes { static constexpr bool PERM = true; const float* xin; float* xout; bf16_t* xb; float* ss_out; float scale;
    __device__ __forceinline__ void operator()(const Acc& acc, const Unit& u, int wr, int wc, int fr, int fq) const {
        const int row0 = u.pm * 256 + wr * 64 + fr, col0 = u.pn * 256 + wc * 32 + 8 * fq;
#pragma unroll
        for (int ai = 0; ai < 2; ++ai) {
            f32x4 xv[4][2][2];
#pragma unroll
            for (int m = 0; m < 4; ++m)
#pragma unroll
                for (int bj = 0; bj < 2; ++bj)
#pragma unroll
                    for (int n = 0; n < 2; ++n) xv[m][bj][n] = *(const f32x4*)(xin + (size_t)(row0 + ai * 128 + m * 16) * D + col0 + bj * 128 + n * 4);
#pragma unroll
            for (int m = 0; m < 4; ++m) { const int row = row0 + ai * 128 + m * 16; float q = 0.f;
#pragma unroll
                for (int bj = 0; bj < 2; ++bj) { const size_t o = (size_t)row * D + col0 + bj * 128;
                    const f32x4 v0 = xv[m][bj][0] + acc[ai][bj][m][0] * scale, v1 = xv[m][bj][1] + acc[ai][bj][m][1] * scale;
                    *(f32x4*)(xout + o) = v0; *(f32x4*)(xout + o + 4) = v1;
                    u32x4 w; w.x = cvt_pk_bf16(v0[0], v0[1]); w.y = cvt_pk_bf16(v0[2], v0[3]); w.z = cvt_pk_bf16(v1[0], v1[1]); w.w = cvt_pk_bf16(v1[2], v1[3]); *(u32x4*)(xb + o) = w;
                    q += ((v0[0] * v0[0] + v0[1] * v0[1]) + (v0[2] * v0[2] + v0[3] * v0[3])) + ((v1[0] * v1[0] + v1[1] * v1[1]) + (v1[2] * v1[2] + v1[3] * v1[3])); }
                q += __shfl_xor(q, 16); q += __shfl_xor(q, 32);
                if (fq == 0) ss_out[(size_t)row * 16 + u.pn * 4 + wc] = q; }
        }
    }
};
struct EpiU { static constexpr bool PERM = true; bf16_t* Ubase; const float* ss;
    __device__ __forceinline__ void operator()(const Acc& acc, const Unit& u, int wr, int wc, int fr, int fq) const {
        float rs8[2][4]; rstd8(rs8, ss, u.pm * 256 + wr * 64 + fr, fq);
        bf16_t* base; int ld, c0;
        if (u.pn < 7) { base = (bf16_t*)((char*)Ubase + U_RWKV); ld = 1792; c0 = u.pn * 256; }
        else if (u.pn < 14) { base = (bf16_t*)((char*)Ubase + U_GLA); ld = 1792; c0 = (u.pn - 7) * 256; }
        else { base = (bf16_t*)((char*)Ubase + U_XA); ld = 512; c0 = (u.pn - 14) * 256; }
        const int row0 = u.pm * 256 + wr * 64 + fr; c0 += wc * 32 + 8 * fq;
#pragma unroll
        for (int ai = 0; ai < 2; ++ai)
#pragma unroll
            for (int m = 0; m < 4; ++m) { const int row = row0 + ai * 128 + m * 16; const float rs = rs8[ai][m];
#pragma unroll
                for (int bj = 0; bj < 2; ++bj) { const f32x4 v0 = acc[ai][bj][m][0] * rs, v1 = acc[ai][bj][m][1] * rs; u32x4 w;
                    w.x = cvt_pk_bf16(v0[0], v0[1]); w.y = cvt_pk_bf16(v0[2], v0[3]); w.z = cvt_pk_bf16(v1[0], v1[1]); w.w = cvt_pk_bf16(v1[2], v1[3]);
                    *(u32x4*)(base + (size_t)row * ld + c0 + bj * 128) = w; } }
    }
};
struct EpiGate { static constexpr bool PERM = true; unsigned char* Gt; const float* ss;
    __device__ __forceinline__ void operator()(const Acc& acc, const Unit& u, int wr, int wc, int fr, int fq) const {
        float rs8[2][4]; rstd8(rs8, ss, u.pm * 256 + wr * 64 + fr, fq);
        const int row0 = u.pm * 256 + wr * 64 + fr, c0 = u.pn * 256 + wc * 32 + 8 * fq;
#pragma unroll
        for (int ai = 0; ai < 2; ++ai)
#pragma unroll
            for (int m = 0; m < 4; ++m) { const int row = row0 + ai * 128 + m * 16; const float rs = rs8[ai][m];
#pragma unroll
                for (int bj = 0; bj < 2; ++bj) { f32x4 v0 = acc[ai][bj][m][0] * rs, v1 = acc[ai][bj][m][1] * rs;
                    unsigned q0[4], q1[4];
#pragma unroll
                    for (int j = 0; j < 4; ++j) { q0[j] = (unsigned)(sigmoidf_(v0[j]) * 255.0f + 0.5f); q1[j] = (unsigned)(sigmoidf_(v1[j]) * 255.0f + 0.5f); }
                    u32x2 w; w.x = q0[0] | (q0[1] << 8) | (q0[2] << 16) | (q0[3] << 24); w.y = q1[0] | (q1[1] << 8) | (q1[2] << 16) | (q1[3] << 24);
                    *(u32x2*)(Gt + (size_t)row * 3072 + c0 + bj * 128) = w; } }
    }
};
struct EpiMerge { static constexpr bool PERM = true; const unsigned char* Gt; float* Mg; bf16_t* Mb;
    __device__ __forceinline__ void operator()(const Acc& acc, const Unit& u, int wr, int wc, int fr, int fq) const {
        const int row0 = u.pm * 256 + wr * 64 + fr, col0 = u.pn * 256 + wc * 32 + 8 * fq;
#pragma unroll
        for (int ai = 0; ai < 2; ++ai) {
            u32x2 gw[4][2]; u32x4 mb[4][2];
#pragma unroll
            for (int m = 0; m < 4; ++m)
#pragma unroll
                for (int bj = 0; bj < 2; ++bj) { const int row = row0 + ai * 128 + m * 16, col = col0 + bj * 128;
                    gw[m][bj] = *(const u32x2*)(Gt + (size_t)row * 3072 + u.z * 1024 + col);
                    mb[m][bj] = (u32x4){0u, 0u, 0u, 0u}; if (u.z > 0) mb[m][bj] = *(const u32x4*)(Mb + (size_t)row * D + col); }
#pragma unroll
            for (int m = 0; m < 4; ++m)
#pragma unroll
                for (int bj = 0; bj < 2; ++bj) { const int row = row0 + ai * 128 + m * 16, col = col0 + bj * 128; const u32x2 g = gw[m][bj]; const u32x4 w = mb[m][bj];
                    const f32x4 g0 = (f32x4){(float)(g.x & 0xffu), (float)((g.x >> 8) & 0xffu), (float)((g.x >> 16) & 0xffu), (float)(g.x >> 24)} * (1.0f / 255.0f);
                    const f32x4 g1 = (f32x4){(float)(g.y & 0xffu), (float)((g.y >> 8) & 0xffu), (float)((g.y >> 16) & 0xffu), (float)(g.y >> 24)} * (1.0f / 255.0f);
                    const f32x4 v0 = acc[ai][bj][m][0] * g0 + (f32x4){bflo(w.x), bfhi(w.x), bflo(w.y), bfhi(w.y)};
                    const f32x4 v1 = acc[ai][bj][m][1] * g1 + (f32x4){bflo(w.z), bfhi(w.z), bflo(w.w), bfhi(w.w)};
                    u32x4 o; o.x = cvt_pk_bf16(v0[0], v0[1]); o.y = cvt_pk_bf16(v0[2], v0[3]); o.z = cvt_pk_bf16(v1[0], v1[1]); o.w = cvt_pk_bf16(v1[2], v1[3]);
                    *(u32x4*)(Mb + (size_t)row * D + col) = o; }
        }
    }
};
struct EpiKV { static constexpr bool PERM = false; bf16_t* Kb; bf16_t* Vt; const float* rstd;
    __device__ __forceinline__ void operator()(const Acc& acc, const Unit& u, int wr, int wc, int fr, int fq) const {
        const int row0 = u.pm * 256 + wr * 64 + fr, col0 = u.pn * 256 + wc * 32 + 4 * fq;
#pragma unroll
        for (int ai = 0; ai < 2; ++ai)
#pragma unroll
            for (int m = 0; m < 4; ++m) { const int row = row0 + ai * 128 + m * 16; const float rs = rstd[row];
#pragma unroll
                for (int bj = 0; bj < 2; ++bj)
#pragma unroll
                    for (int n = 0; n < 2; ++n) { const int col = col0 + bj * 128 + n * 16; const f32x4 v = acc[ai][bj][m][n] * rs;
                        if (col < 512) st_bf4(Kb + (size_t)row * 512 + col, v);
                        else {
#pragma unroll
                            for (int j = 0; j < 4; ++j) Vt[((size_t)(row >> 8) * 512 + (col - 512 + j)) * 256 + (row & 255)] = f2bf(v[j]); } } }
    }
};

template <int MAP> __device__ __forceinline__ int colmap(int n) {
    if (MAP == 1) { const int tl = n >> 8, r = n & 255; return r < 128 ? 128 * tl + r : FF + 128 * tl + (r - 128); }
    if (MAP == 2) { if (n < 3344) return n; if (n < 3584) return -1; return n - 240; }
    return n;
}
template <int MAP>
__device__ __forceinline__ void convT(LAS unsigned char* lds, const float* src, int ld, int coff, const float* g, bf16_t* dst, int K, int Kd, int Nd, int G, int bid, int tid) {
    const int nkt = (K + 63) >> 6, nnt = (Nd + 63) >> 6, ntile = nkt * nnt;
    LAS bf16_t* tile = (LAS bf16_t*)lds;
    for (int t = bid; t < ntile; t += G) {
        const int kt = t % nkt, ntl = t / nkt, k0 = kt * 64, n0 = ntl * 64;
        { const int nl = tid & 63, kl0 = tid >> 6, n = n0 + nl; const int c = (n < Nd) ? colmap<MAP>(n) : -1;
#pragma unroll
          for (int i = 0; i < 8; ++i) { const int kl = kl0 + 8 * i, k = k0 + kl; float v = 0.f;
              if (c >= 0 && k < K) { v = src[(size_t)k * ld + coff + c]; if (g) v *= g[k]; }
              tile[nl * 72 + kl] = f2bf(v); } }
        __syncthreads();
        { const int nl = tid >> 3, kc = (tid & 7) * 8, n = n0 + nl, k = k0 + kc;
          if (n < Nd && k < Kd) *(u32x4*)(dst + (size_t)n * Kd + k) = *(LAS u32x4*)(tile + nl * 72 + kc); }
        __syncthreads();
    }
}

template <int MAP>
__device__ __forceinline__ void convT_w(const float* src, int ld, int coff, const float* g, bf16_t* dst, int K, int Kd, int Nd, int wslot, int nslots, int lane, int tile_base) {
    const int nkt = K >> 4, nnt = (Nd + 255) >> 8, ntile = nkt * nnt;
    for (int t = ((wslot - tile_base) % nslots + nslots) % nslots; t < ntile; t += nslots) {
        const int kt = t % nkt, ntl = t / nkt, k0 = kt * 16, n = ntl * 256 + lane * 4; const int c = (n < Nd) ? colmap<MAP>(n) : -1;
        const float* sp = src + (size_t)k0 * ld + coff + (c >= 0 ? c : 0);
        f32x4 v[16], gv[4];
#pragma unroll
        for (int q = 0; q < 4; ++q) gv[q] = (f32x4){1.f, 1.f, 1.f, 1.f};
        if (g) {
#pragma unroll
            for (int q = 0; q < 4; ++q) gv[q] = *(const f32x4*)(g + k0 + 4 * q); }
#pragma unroll
        for (int kk = 0; kk < 16; ++kk) v[kk] = *(const f32x4*)(sp + (size_t)kk * ld);
        const float cm = (c < 0) ? 0.0f : 1.0f;
#pragma unroll
        for (int kk = 0; kk < 16; ++kk) v[kk] = v[kk] * (gv[kk >> 2][kk & 3] * cm);
        if (n < Nd) {
#pragma unroll
            for (int j = 0; j < 4; ++j) { u32x4 lo, hi;
                lo.x = cvt_pk_bf16(v[0][j], v[1][j]); lo.y = cvt_pk_bf16(v[2][j], v[3][j]); lo.z = cvt_pk_bf16(v[4][j], v[5][j]); lo.w = cvt_pk_bf16(v[6][j], v[7][j]);
                hi.x = cvt_pk_bf16(v[8][j], v[9][j]); hi.y = cvt_pk_bf16(v[10][j], v[11][j]); hi.z = cvt_pk_bf16(v[12][j], v[13][j]); hi.w = cvt_pk_bf16(v[14][j], v[15][j]);
                bf16_t* dp = dst + (size_t)(n + j) * Kd + k0; *(u32x4*)dp = lo; *(u32x4*)(dp + 8) = hi; }
        }
    }
}

template <int K>
__device__ __forceinline__ void wave_gemm(f32x4 (&acc)[4][4], LAS const unsigned char* A, int sA, const bf16_t* Bt, int fr, int fq) {
#pragma unroll
    for (int m = 0; m < 4; ++m)
#pragma unroll
        for (int n = 0; n < 4; ++n) acc[m][n] = (f32x4){0.f, 0.f, 0.f, 0.f};
#pragma unroll
    for (int ks = 0; ks < K / 32; ++ks) { bf16x8 a[4], b[4];
#pragma unroll
        for (int m = 0; m < 4; ++m) a[m] = *(LAS const bf16x8*)(A + (16 * m + fr) * sA + (ks * 32 + fq * 8) * 2);
#pragma unroll
        for (int n = 0; n < 4; ++n) b[n] = *(const bf16x8*)(Bt + (size_t)(16 * n + fr) * K + ks * 32 + fq * 8);
#pragma unroll
        for (int m = 0; m < 4; ++m)
#pragma unroll
            for (int n = 0; n < 4; ++n) acc[m][n] = mfma16(b[n], a[m], acc[m][n]); }
}

template <int K>
__device__ __forceinline__ void row_gemm(f32x4 (&acc)[4], LAS const unsigned char* Arow, const bf16_t* Bt, int fr, int fq) {
    bf16x8 bw[K / 32][4];
#pragma unroll
    for (int ks = 0; ks < K / 32; ++ks)
#pragma unroll
        for (int n = 0; n < 4; ++n) bw[ks][n] = *(const bf16x8*)(Bt + (size_t)(16 * n + fr) * K + ks * 32 + fq * 8);
#pragma unroll
    for (int n = 0; n < 4; ++n) acc[n] = (f32x4){0.f, 0.f, 0.f, 0.f};
#pragma unroll
    for (int ks = 0; ks < K / 32; ++ks) { const bf16x8 a = *(LAS const bf16x8*)(Arow + (ks * 32 + fq * 8) * 2);
#pragma unroll
        for (int n = 0; n < 4; ++n) acc[n] = mfma16(bw[ks][n], a, acc[n]); }
}

struct PrepArgs { const bf16_t* U; const float *mu, *w0, *a0, *kk_, *ka, *rk, *v0; const bf16_t *w2t, *a2t, *g2t, *v1t, *v2t; float* vfirst; float* Wd; float* V; bf16_t* RKKB; bf16_t* Go; float* Bon; int layer; };

__device__ __forceinline__ f32x4 shifted4(const bf16_t* Ut, bool has_prev, int c, const float* mu) {
    const f32x4 u = ld_bf4(Ut + c); f32x4 p = ld_bf4((has_prev ? Ut - 1792 : Ut) + c); const float pm = has_prev ? 1.0f : 0.0f; p = p * pm;
    const f32x4 m = *(const f32x4*)(mu + c); return u + m * (p - u);
}

__device__ __forceinline__ void rwkv_prep_tile(LAS unsigned char* lds, const PrepArgs& P, int tt, int tid) {
    constexpr int SW = 144, SG = 272, SV = 1040, SVV = 80;
    LAS unsigned char* LAw = lds; LAS unsigned char* LAa = lds + 9216; LAS unsigned char* LAg = lds + 18432; LAS unsigned char* LAv = lds + 35840; LAS unsigned char* LAvv = lds + 102400;
    const int t0 = tt * 64; const int s0 = t0 & (SEQ - 1);
    const int lane = tid & 63, wave = __builtin_amdgcn_readfirstlane(tid >> 6), fr = lane & 15, fq = lane >> 4;
    LAS float* PRM = (LAS float*)(lds + 107520);
    { PRM[tid] = P.mu[tid]; PRM[512 + tid] = P.mu[512 + tid]; PRM[1024 + tid] = P.mu[1024 + tid]; PRM[1536 + tid] = P.a0[tid]; PRM[2048 + tid] = P.w0[tid];
      PRM[2560 + tid] = P.kk_[tid]; PRM[3072 + tid] = P.ka[tid]; PRM[3584 + tid] = P.rk[tid]; PRM[4096 + tid] = P.v0[tid]; }
#pragma unroll 2
    for (int e = 0; e < 4; ++e) { const int idx = tid + 512 * e, i = idx >> 5, c = (idx & 31) * 8; const bf16_t* Ut = P.U + (size_t)(t0 + i) * 1792; const bool hp = s0 + i > 0;
        f32x4 x0 = shifted4(Ut, hp, 1536 + c, P.mu), x1 = shifted4(Ut, hp, 1536 + c + 4, P.mu);
        if (c < 64) {
#pragma unroll
            for (int q = 0; q < 4; ++q) { const float ea = __expf(2.f * x0[q]), eb = __expf(2.f * x1[q]); x0[q] = 1.f - 2.f / (ea + 1.f); x1[q] = 1.f - 2.f / (eb + 1.f); } }
        else if (c >= 128) {
#pragma unroll
            for (int q = 0; q < 4; ++q) { x0[q] = sigmoidf_(x0[q]); x1[q] = sigmoidf_(x1[q]); } }
        u32x4 o; o.x = cvt_pk_bf16(x0[0], x0[1]); o.y = cvt_pk_bf16(x0[2], x0[3]); o.z = cvt_pk_bf16(x1[0], x1[1]); o.w = cvt_pk_bf16(x1[2], x1[3]);
        LAS unsigned char* dstp = (c < 64) ? (LAw + i * SW + c * 2) : (c < 128) ? (LAa + i * SW + (c - 64) * 2) : (LAg + i * SG + (c - 128) * 2);
        *(LAS u32x4*)dstp = o; }
    if (P.layer > 0) {
#pragma unroll 2
        for (int e = 0; e < 8; ++e) { const int idx = tid + 512 * e, i = idx >> 6, c = (idx & 63) * 8; const bf16_t* Ut = P.U + (size_t)(t0 + i) * 1792; const bool hp = s0 + i > 0;
            const f32x4 x0 = shifted4(Ut, hp, 1024 + c, P.mu), x1 = shifted4(Ut, hp, 1024 + c + 4, P.mu);
            u32x4 o; o.x = cvt_pk_bf16(x0[0], x0[1]); o.y = cvt_pk_bf16(x0[2], x0[3]); o.z = cvt_pk_bf16(x1[0], x1[1]); o.w = cvt_pk_bf16(x1[2], x1[3]);
            *(LAS u32x4*)(LAv + i * SV + c * 2) = o; }
    }
    __syncthreads();
    if (P.layer > 0) {
        const int mt = wave >> 1, nt = wave & 1; f32x4 acc = (f32x4){0.f, 0.f, 0.f, 0.f};
#pragma unroll 4
        for (int ks = 0; ks < 16; ++ks) { const bf16x8 a = *(LAS const bf16x8*)(LAv + (16 * mt + fr) * SV + (ks * 32 + fq * 8) * 2);
            const bf16x8 b = *(const bf16x8*)(P.v1t + (size_t)(16 * nt + fr) * 512 + ks * 32 + fq * 8); acc = mfma16(b, a, acc); }
        u32x2 w; w.x = cvt_pk_bf16(acc[0], acc[1]); w.y = cvt_pk_bf16(acc[2], acc[3]); *(LAS u32x2*)(LAvv + (16 * mt + fr) * SVV + (16 * nt + 4 * fq) * 2) = w;
    }
    __syncthreads();
    const int h = wave, cb = 64 * h; const int b_ = t0 >> 12, p = b_ * 8 + h;
#pragma unroll 1
    for (int m = 0; m < 4; ++m) {
        const int i = 16 * m + fr; const bf16_t* Ut = P.U + (size_t)(t0 + i) * 1792; const bool hp = (s0 + i) > 0;
        int fq4 = 4 * fq; asm volatile("" : "+v"(fq4));
        u32x2 uk[4], pk[4], ur[4], pr[4], uv[4], pv[4]; f32x4 vf[4];
        { const bf16_t* Up = hp ? Ut - 1792 : Ut; const unsigned pm = hp ? 0xffffffffu : 0u;
#pragma unroll
          for (int n = 0; n < 4; ++n) { const int c = cb + 16 * n + fq4;
              uk[n] = *(const u32x2*)(Ut + 512 + c); ur[n] = *(const u32x2*)(Ut + c); uv[n] = *(const u32x2*)(Ut + 1024 + c);
              pk[n] = *(const u32x2*)(Up + 512 + c); pr[n] = *(const u32x2*)(Up + c); pv[n] = *(const u32x2*)(Up + 1024 + c);
              if (P.layer > 0) vf[n] = *(const f32x4*)(P.vfirst + (size_t)(t0 + i) * 512 + c); }
#pragma unroll
          for (int n = 0; n < 4; ++n) { pk[n].x &= pm; pk[n].y &= pm; pr[n].x &= pm; pr[n].y &= pm; pv[n].x &= pm; pv[n].y &= pm; } }
        f32x4 aa[4], acc[4];
        row_gemm<64>(aa, LAa + i * SW, P.a2t + (size_t)cb * 64, fr, fq);
        row_gemm<64>(acc, LAw + i * SW, P.w2t + (size_t)cb * 64, fr, fq);
#pragma unroll
        for (int n = 0; n < 4; ++n) { const f32x4 a0v = *(LAS const f32x4*)(PRM + 1536 + cb + 16 * n + fq4), w0v = *(LAS const f32x4*)(PRM + 2048 + cb + 16 * n + fq4); f32x4 d;
#pragma unroll
            for (int j = 0; j < 4; ++j) { aa[n][j] = sigmoidf_(aa[n][j] + a0v[j]); d[j] = __expf(-0.6065306597f * sigmoidf_(acc[n][j] + w0v[j])); }
            *(f32x4*)(P.Wd + ((size_t)p * SEQ + s0 + i) * 64 + 16 * n + fq4) = d; }
        row_gemm<128>(acc, LAg + i * SG, P.g2t + (size_t)cb * 128, fr, fq);
#pragma unroll
        for (int n = 0; n < 4; ++n) st_bf4(P.Go + (size_t)(t0 + i) * 512 + cb + 16 * n + fq4, acc[n]);
        if (P.layer > 0) row_gemm<32>(acc, LAvv + i * SVV, P.v2t + (size_t)cb * 32, fr, fq);
        float bon = 0.f, nk = 0.f; f32x4 kv[4], rv[4];
#pragma unroll
        for (int n = 0; n < 4; ++n) { const int c = cb + 16 * n + fq4;
            const f32x4 muv = *(LAS const f32x4*)(PRM + 1024 + c), muk = *(LAS const f32x4*)(PRM + 512 + c), mur = *(LAS const f32x4*)(PRM + c);
            const f32x4 v_u = (f32x4){bflo(uv[n].x), bfhi(uv[n].x), bflo(uv[n].y), bfhi(uv[n].y)}, v_p = (f32x4){bflo(pv[n].x), bfhi(pv[n].x), bflo(pv[n].y), bfhi(pv[n].y)};
            const f32x4 k_u = (f32x4){bflo(uk[n].x), bfhi(uk[n].x), bflo(uk[n].y), bfhi(uk[n].y)}, k_p = (f32x4){bflo(pk[n].x), bfhi(pk[n].x), bflo(pk[n].y), bfhi(pk[n].y)};
            const f32x4 r_u = (f32x4){bflo(ur[n].x), bfhi(ur[n].x), bflo(ur[n].y), bfhi(ur[n].y)}, r_p = (f32x4){bflo(pr[n].x), bfhi(pr[n].x), bflo(pr[n].y), bfhi(pr[n].y)};
            f32x4 v = v_u + muv * (v_p - v_u);
            if (P.layer > 0) { const f32x4 v0v = *(LAS const f32x4*)(PRM + 4096 + c);
#pragma unroll
                for (int j = 0; j < 4; ++j) v[j] = v[j] + (vf[n][j] - v[j]) * sigmoidf_(v0v[j] + acc[n][j]); }
            else *(f32x4*)(P.vfirst + (size_t)(t0 + i) * 512 + c) = v;
            *(f32x4*)(P.V + ((size_t)p * SEQ + s0 + i) * 64 + 16 * n + fq4) = v;
            kv[n] = k_u + muk * (k_p - k_u); rv[n] = r_u + mur * (r_p - r_u);
            const f32x4 kkw = *(LAS const f32x4*)(PRM + 2560 + c);
#pragma unroll
            for (int j = 0; j < 4; ++j) { const float x = kv[n][j] * kkw[j]; nk += x * x; } }
        nk += __shfl_xor(nk, 16); nk += __shfl_xor(nk, 32);
        const float inv = 1.0f / fmaxf(sqrtf(nk), 1e-12f);
        bf16_t* O = P.RKKB + ((size_t)p * SEQ + s0 + i) * 256;
#pragma unroll
        for (int n = 0; n < 4; ++n) { const int c = cb + 16 * n + fq4; const f32x4 kkw = *(LAS const f32x4*)(PRM + 2560 + c), kaw = *(LAS const f32x4*)(PRM + 3072 + c), rkw = *(LAS const f32x4*)(PRM + 3584 + c);
            f32x4 kk, kh, bb;
#pragma unroll
            for (int j = 0; j < 4; ++j) { const float a = aa[n][j]; kk[j] = kv[n][j] * kkw[j] * inv; kh[j] = kv[n][j] * (1.f + (a - 1.f) * kaw[j]); bb[j] = kk[j] * a; bon += rv[n][j] * kh[j] * rkw[j]; }
            const int cc = 16 * n + fq4; st_bf4(O + cc, rv[n]); st_bf4(O + 64 + cc, kh); st_bf4(O + 128 + cc, kk); st_bf4(O + 192 + cc, bb); }
        bon += __shfl_xor(bon, 16); bon += __shfl_xor(bon, 32);
        if (fq == 0) P.Bon[(size_t)(t0 + i) * 8 + h] = bon;
        asm volatile("" ::: "memory");
    }
    __syncthreads();
}

constexpr int SCAN_CH = 32, SCAN_STEP_B = 1344, SCAN_SLOT_B = SCAN_CH * SCAN_STEP_B;
template <int CTRL> __device__ __forceinline__ float dpp_f(float v) { return __int_as_float(__builtin_amdgcn_update_dpp(0, __float_as_int(v), CTRL, 0xf, 0xf, true)); }
__device__ __forceinline__ float row16_sum(float v) { v += dpp_f<0xB1>(v); v += dpp_f<0x4E>(v); v += dpp_f<0x141>(v); v += dpp_f<0x140>(v); return v; }

__device__ __forceinline__ float tr16_sum(const float (&p)[16], int kq) {
    const bool b3 = (kq & 8) != 0, b2 = (kq & 4) != 0, b1 = (kq & 2) != 0, b0 = (kq & 1) != 0;
    float q[8], r[4], u[2];
#pragma unroll
    for (int t = 0; t < 8; ++t) { const float keep = b3 ? p[t + 8] : p[t], send = b3 ? p[t] : p[t + 8]; q[t] = keep + dpp_f<0x140>(send); }
#pragma unroll
    for (int t = 0; t < 4; ++t) { const float keep = b2 ? q[t + 4] : q[t], send = b2 ? q[t] : q[t + 4]; r[t] = keep + dpp_f<0x141>(send); }
#pragma unroll
    for (int t = 0; t < 2; ++t) { const float keep = b1 ? r[t + 2] : r[t], send = b1 ? r[t] : r[t + 2]; u[t] = keep + dpp_f<0x4E>(send); }
    const float keep = b0 ? u[1] : u[0], send = b0 ? u[0] : u[1];
    return keep + dpp_f<0xB1>(send);
}

__device__ __forceinline__ void scan_load_chunk(LAS unsigned char* slot, const float* Wd, const float* V, const bf16_t* RKKB, int p, int rg, int s0, int lt) {
    u32x4 r[7];
    const size_t base = (size_t)p * SEQ + s0;
#pragma unroll
    for (int j = 0; j < 2; ++j) { const int idx = lt + 256 * j, st = idx >> 4, part = idx & 15; r[j] = *(const u32x4*)(Wd + (base + st) * 64 + part * 4); }
#pragma unroll
    for (int j = 2; j < 6; ++j) { const int k = lt + 256 * (j - 2), st = k >> 5, rem = k & 31, q = rem >> 3, part = rem & 7; r[j] = *(const u32x4*)(RKKB + ((base + st) * 4 + q) * 64 + part * 8); }
    if (lt < 128) { const int st = lt >> 2, hf = lt & 3; r[6] = *(const u32x4*)(V + (base + st) * 64 + rg * 16 + hf * 4); }
#pragma unroll
    for (int j = 0; j < 2; ++j) { const int idx = lt + 256 * j, st = idx >> 4, part = idx & 15; *(LAS u32x4*)(slot + st * SCAN_STEP_B + part * 16) = r[j]; }
#pragma unroll
    for (int j = 2; j < 6; ++j) { const int k = lt + 256 * (j - 2), st = k >> 5, rem = k & 31, q = rem >> 3, part = rem & 7; const u32x4 w = r[j];
        const int Q = (q == 0) ? 4 : (q == 1) ? 2 : (q == 2) ? 3 : 1;
        LAS f32x4* d = (LAS f32x4*)(slot + st * SCAN_STEP_B + Q * 256 + part * 32);
        d[0] = (f32x4){bflo(w.x), bfhi(w.x), bflo(w.y), bfhi(w.y)}; d[1] = (f32x4){bflo(w.z), bfhi(w.z), bflo(w.w), bfhi(w.w)}; }
    if (lt < 128) { const int st = lt >> 2, hf = lt & 3; *(LAS u32x4*)(slot + st * SCAN_STEP_B + 1280 + hf * 16) = r[6]; }
}

__device__ __forceinline__ void rwkv_scan_unit(LAS unsigned char* lds, const float* Wd, const float* V, const bf16_t* RKKB, float* Yraw, int p, int rg, int tid) {
    const int lane = tid & 63, wave = __builtin_amdgcn_readfirstlane(tid >> 6);
    constexpr int NCH = SEQ / SCAN_CH;
    scan_load_chunk(lds + (tid >> 8) * SCAN_SLOT_B, Wd, V, RKKB, p, rg, (tid >> 8) * SCAN_CH, tid & 255);
    __syncthreads();
    f32x4 S = (f32x4){0.f, 0.f, 0.f, 0.f};
    const int kq = lane & 15, rl = wave * 4 + (lane >> 4);
    for (int c = 0; c < NCH; ++c) {
        if (wave >= 4) { if (c + 2 < NCH) scan_load_chunk(lds + ((c + 2) % 3) * SCAN_SLOT_B, Wd, V, RKKB, p, rg, (c + 2) * SCAN_CH, tid - 256); }
        else {
            LAS const unsigned char* sl = lds + (c % 3) * SCAN_SLOT_B + kq * 16;
            LAS const unsigned char* vl = lds + (c % 3) * SCAN_SLOT_B + 1280 + rl * 4;
            float* yo = Yraw + ((size_t)p * SEQ + c * SCAN_CH + kq) * 64 + rg * 16 + rl;
            f32x4 w = *(LAS const f32x4*)(sl), b = *(LAS const f32x4*)(sl + 256), k = *(LAS const f32x4*)(sl + 512), kk = *(LAS const f32x4*)(sl + 768), r = *(LAS const f32x4*)(sl + 1024);
            float v = *(LAS const float*)(vl); float yp[16];
#pragma unroll
            for (int st = 0; st < SCAN_CH; ++st) {
                f32x4 wn = w, bn = b, kn = k, kkn = kk, rn = r; float vn = v;
                if (st + 1 < SCAN_CH) { const int o = (st + 1) * SCAN_STEP_B;
                    wn = *(LAS const f32x4*)(sl + o); bn = *(LAS const f32x4*)(sl + o + 256); kn = *(LAS const f32x4*)(sl + o + 512); kkn = *(LAS const f32x4*)(sl + o + 768); rn = *(LAS const f32x4*)(sl + o + 1024);
                    vn = *(LAS const float*)(vl + o); }
                float sa = (S[0] * kk[0] + S[1] * kk[1]) + (S[2] * kk[2] + S[3] * kk[3]);
                const f32x4 kvt = k * v;
                sa = -row16_sum(sa);
                S = S * w + (b * sa + kvt);
                yp[st & 15] = (S[0] * r[0] + S[1] * r[1]) + (S[2] * r[2] + S[3] * r[3]);
                if ((st & 15) == 15) yo[(size_t)(st - 15) * 64] = tr16_sum(yp, kq);
                w = wn; b = bn; k = kn; kk = kkn; r = rn; v = vn;
            }
        }
        __syncthreads();
    }
}

struct GlaArgs { const bf16_t* Ug; const float *conv, *aup, *abias, *gnorm; float* kvcT; float* dec; bf16_t* spT; bf16_t* Yg; };
constexpr int GL_GC = 0;
constexpr int GL_T0 = 16640;
constexpr int GL_VT = GL_T0 + 4 * 9216;
constexpr int GL_AL = GL_VT + 18432;
constexpr int GL_RS = GL_AL + 9216;

__device__ __forceinline__ void gla_conv8(f32x4 (&out)[8], const bf16_t* Ug, const float* conv, int t0, int s0, int i0, int c0) {
    f32x4 w[4];
#pragma unroll
    for (int j = 0; j < 4; ++j) w[j] = *(const f32x4*)(conv + j * 1024 + c0);
    u32x2 raw[8][4];
#pragma unroll
    for (int e = 0; e < 8; ++e)
#pragma unroll
        for (int j = 0; j < 4; ++j) { const int i = i0 + 8 * e, ds = 3 - j; const bool ok = (s0 + i - ds) >= 0; raw[e][j] = *(const u32x2*)(Ug + (size_t)(ok ? t0 + i - ds : t0) * 1792 + c0); }
#pragma unroll
    for (int e = 0; e < 8; ++e) { const int i = i0 + 8 * e; f32x4 a = (f32x4){0.f, 0.f, 0.f, 0.f};
#pragma unroll
        for (int j = 0; j < 4; ++j) { const int ds = 3 - j; const float mk = ((s0 + i - ds) >= 0) ? 1.0f : 0.0f; const u32x2 r = raw[e][j];
            a += (w[j] * mk) * (f32x4){bflo(r.x), bfhi(r.x), bflo(r.y), bfhi(r.y)}; }
#pragma unroll
        for (int q = 0; q < 4; ++q) a[q] = a[q] * sigmoidf_(a[q]);
        out[e] = a; }
}
__device__ __forceinline__ void gla_gcum(LAS unsigned char* lds, const GlaArgs& A, int t0, int h, int tid) {
    LAS float* GC = (LAS float*)(lds + GL_GC);
    { const int d = tid & 63, i0 = tid >> 6; float au[16]; const float ab = A.abias[h * 64 + d];
#pragma unroll
      for (int j = 0; j < 16; ++j) au[j] = A.aup[j * 256 + h * 64 + d];
      u32x4 al0[8], al1[8];
#pragma unroll
      for (int e = 0; e < 8; ++e) { const u32x4* ap = (const u32x4*)(A.Ug + (size_t)(t0 + i0 + 8 * e) * 1792 + 1024); al0[e] = ap[0]; al1[e] = ap[1]; }
#pragma unroll
      for (int e = 0; e < 8; ++e) { const int i = i0 + 8 * e; const u32x4 a0 = al0[e], a1 = al1[e];
          float x = ab;
          x += bflo(a0.x) * au[0] + bfhi(a0.x) * au[1] + bflo(a0.y) * au[2] + bfhi(a0.y) * au[3] + bflo(a0.z) * au[4] + bfhi(a0.z) * au[5] + bflo(a0.w) * au[6] + bfhi(a0.w) * au[7];
          x += bflo(a1.x) * au[8] + bfhi(a1.x) * au[9] + bflo(a1.y) * au[10] + bfhi(a1.y) * au[11] + bflo(a1.z) * au[12] + bfhi(a1.z) * au[13] + bflo(a1.w) * au[14] + bfhi(a1.w) * au[15];
          const float ls = fminf(x, 0.f) - __logf(1.f + __expf(-fabsf(x)));
          GC[i * 65 + d] = ls * (1.0f / 16.0f); } }
    __syncthreads();
    { const int lane = tid & 63, wave = tid >> 6;
#pragma unroll
      for (int dd = 0; dd < 8; ++dd) { const int d = wave * 8 + dd; float x = GC[lane * 65 + d];
#pragma unroll
          for (int o = 1; o < 64; o <<= 1) { const float y = __shfl_up(x, o); if (lane >= o) x += y; }
          GC[lane * 65 + d] = x; } }
    __syncthreads();
}
__device__ __forceinline__ void gla_a_tile(LAS unsigned char* lds, const GlaArgs& A, int tile, int tid) {
    const int bh = tile >> 6, n = tile & 63, b = bh >> 2, h = bh & 3, t0 = b * SEQ + n * 64, s0 = n * 64;
    LAS float* GC = (LAS float*)(lds + GL_GC); LAS bf16_t* KDT = (LAS bf16_t*)(lds + GL_T0); LAS bf16_t* VT = (LAS bf16_t*)(lds + GL_VT);
    gla_gcum(lds, A, t0, h, tid);
    { const int cc = (tid & 63) * 4, i0 = tid >> 6;
      if (cc >= 64) { f32x4 o[8]; const int c0 = (cc < 128) ? 256 + h * 64 + (cc - 64) : 512 + h * 128 + (cc - 128);
          gla_conv8(o, A.Ug, A.conv, t0, s0, i0, c0);
          if (cc < 128) { const int d = cc - 64;
#pragma unroll
              for (int e = 0; e < 8; ++e) { const int i = i0 + 8 * e;
#pragma unroll
                  for (int q = 0; q < 4; ++q) KDT[(d + q) * 72 + i] = f2bf(o[e][q] * __expf(GC[63 * 65 + d + q] - GC[i * 65 + d + q])); } }
          else { const int ev = cc - 128;
#pragma unroll
              for (int e = 0; e < 8; ++e) { const int i = i0 + 8 * e;
#pragma unroll
                  for (int q = 0; q < 4; ++q) VT[(ev + q) * 72 + i] = f2bf(o[e][q]); } } } }
    if (tid < 64) A.dec[((size_t)bh * 64 + n) * 64 + tid] = __expf(GC[63 * 65 + tid]);
    __syncthreads();
    { const int lane = tid & 63, wave = tid >> 6, fr = lane & 15, fq = lane >> 4; f32x4 acc[4];
#pragma unroll
      for (int nt = 0; nt < 4; ++nt) acc[nt] = (f32x4){0.f, 0.f, 0.f, 0.f};
#pragma unroll
      for (int ks = 0; ks < 2; ++ks) { const bf16x8 a = *(LAS const bf16x8*)(VT + (16 * wave + fr) * 72 + ks * 32 + fq * 8);
#pragma unroll
          for (int nt = 0; nt < 4; ++nt) { const bf16x8 bfr = *(LAS const bf16x8*)(KDT + (16 * nt + fr) * 72 + ks * 32 + fq * 8); acc[nt] = mfma16(bfr, a, acc[nt]); } }
#pragma unroll
      for (int nt = 0; nt < 4; ++nt) *(f32x4*)(A.kvcT + (((size_t)bh * 64 + n) * 128 + 16 * wave + fr) * 64 + 16 * nt + 4 * fq) = acc[nt]; }
    __syncthreads();
}
__device__ __forceinline__ void gla_c_tile(LAS unsigned char* lds, const GlaArgs& A, int tile, int tid) {
    const int bh = tile >> 6, n = tile & 63, b = bh >> 2, h = bh & 3, t0 = b * SEQ + n * 64, s0 = n * 64;
    LAS float* GC = (LAS float*)(lds + GL_GC); LAS bf16_t* QG = (LAS bf16_t*)(lds + GL_T0); LAS bf16_t* KG = QG + 64 * 72; LAS bf16_t* QR = KG + 64 * 72; LAS bf16_t* KR = QR + 64 * 72;
    LAS bf16_t* VT = (LAS bf16_t*)(lds + GL_VT); LAS bf16_t* AL = (LAS bf16_t*)(lds + GL_AL); LAS float* RS = (LAS float*)(lds + GL_RS);
    gla_gcum(lds, A, t0, h, tid);
    { const int cc = (tid & 63) * 4, i0 = tid >> 6; f32x4 o[8];
      const int c0 = (cc < 64) ? h * 64 + cc : (cc < 128) ? 256 + h * 64 + (cc - 64) : 512 + h * 128 + (cc - 128);
      gla_conv8(o, A.Ug, A.conv, t0, s0, i0, c0);
      if (cc < 128) { const int d = cc & 63; const bool isq = cc < 64; LAS bf16_t* T1 = isq ? QG : KR; LAS bf16_t* T2 = isq ? QR : KG; const float sc = isq ? 0.125f : 1.0f;
#pragma unroll
          for (int e = 0; e < 8; ++e) { const int i = i0 + 8 * e; f32x4 x1, x2;
#pragma unroll
              for (int q = 0; q < 4; ++q) { const float eg = __expf(GC[i * 65 + d + q]); const float x = o[e][q] * sc; x1[q] = x * eg; x2[q] = x / eg; }
              u32x2 w1, w2; w1.x = cvt_pk_bf16(x1[0], x1[1]); w1.y = cvt_pk_bf16(x1[2], x1[3]); w2.x = cvt_pk_bf16(x2[0], x2[1]); w2.y = cvt_pk_bf16(x2[2], x2[3]);
              *(LAS u32x2*)(T1 + i * 72 + d) = w1; *(LAS u32x2*)(T2 + i * 72 + d) = w2; } }
      else { const int ev = cc - 128;
#pragma unroll
          for (int e = 0; e < 8; ++e) { const int i = i0 + 8 * e;
#pragma unroll
              for (int q = 0; q < 4; ++q) VT[(ev + q) * 72 + i] = f2bf(o[e][q]); } } }
    __syncthreads();
    const int lane = tid & 63, wave = tid >> 6, fr = lane & 15, fq = lane >> 4; const int mt = wave >> 1;
    {
#pragma unroll
        for (int q = 0; q < 2; ++q) { const int nt = (wave & 1) * 2 + q; f32x4 ap = (f32x4){0.f, 0.f, 0.f, 0.f}, af = ap;
#pragma unroll
            for (int ks = 0; ks < 2; ++ks) { const int ko = ks * 32 + fq * 8;
                ap = mfma16(*(LAS const bf16x8*)(KG + (16 * nt + fr) * 72 + ko), *(LAS const bf16x8*)(QG + (16 * mt + fr) * 72 + ko), ap);
                af = mfma16(*(LAS const bf16x8*)(KR + (16 * nt + fr) * 72 + ko), *(LAS const bf16x8*)(QR + (16 * mt + fr) * 72 + ko), af); }
            const int trow = 16 * mt + fr; f32x4 o;
#pragma unroll
            for (int j = 0; j < 4; ++j) { const int scol = 16 * nt + 4 * fq + j; o[j] = (scol <= trow) ? ap[j] : af[j]; }
            u32x2 w; w.x = cvt_pk_bf16(o[0], o[1]); w.y = cvt_pk_bf16(o[2], o[3]); *(LAS u32x2*)(AL + trow * 72 + 16 * nt + 4 * fq) = w; }
    }
    __syncthreads();
    f32x4 acc[4];
#pragma unroll
    for (int q = 0; q < 4; ++q) acc[q] = (f32x4){0.f, 0.f, 0.f, 0.f};
    const bf16_t* sp = A.spT + ((size_t)bh * 64 + n) * 128 * 64;
#pragma unroll
    for (int ks = 0; ks < 2; ++ks) { const int ko = ks * 32 + fq * 8; const bf16x8 a1 = *(LAS const bf16x8*)(AL + (16 * mt + fr) * 72 + ko), a2 = *(LAS const bf16x8*)(QG + (16 * mt + fr) * 72 + ko);
#pragma unroll
        for (int q = 0; q < 4; ++q) { const int nt = (wave & 1) * 4 + q;
            acc[q] = mfma16(*(LAS const bf16x8*)(VT + (16 * nt + fr) * 72 + ko), a1, acc[q]);
            acc[q] = mfma16(*(const bf16x8*)(sp + (size_t)(16 * nt + fr) * 64 + ko), a2, acc[q]); } }
    float ssq = 0.f;
#pragma unroll
    for (int q = 0; q < 4; ++q) ssq += (acc[q][0] * acc[q][0] + acc[q][1] * acc[q][1]) + (acc[q][2] * acc[q][2] + acc[q][3] * acc[q][3]);
    ssq += __shfl_xor(ssq, 16); ssq += __shfl_xor(ssq, 32);
    if (fq == 0) RS[(16 * mt + fr) * 2 + (wave & 1)] = ssq;
    __syncthreads();
    { const int i = 16 * mt + fr; const float rs = rsqrtf((RS[i * 2] + RS[i * 2 + 1]) * (1.0f / 128.0f) + 1e-6f);
#pragma unroll
      for (int q = 0; q < 4; ++q) { const int ecol = h * 128 + ((wave & 1) * 4 + q) * 16 + 4 * fq; const f32x4 nw = *(const f32x4*)(A.gnorm + ecol); const f32x4 go = ld_bf4(A.Ug + (size_t)(t0 + i) * 1792 + 1040 + ecol); f32x4 o;
#pragma unroll
          for (int j = 0; j < 4; ++j) o[j] = acc[q][j] * rs * nw[j] * go[j] * sigmoidf_(go[j]);
          st_bf4(A.Yg + (size_t)(t0 + i) * 512 + ecol, o); } }
    __syncthreads();
}

__device__ __forceinline__ void xa_tile(const bf16_t* Ux, const bf16_t* Kb, const bf16_t* Vt, bf16_t* Yx, int tile, int tid) {
    const int blk = tile & 31, h = (tile >> 5) & 3, b = tile >> 7; const int lane = tid & 63, wave = tid >> 6, fr = lane & 15, fq = lane >> 4;
    const int t = b * SEQ + blk * 128 + 16 * wave + fr;
    bf16x8 qf[4];
#pragma unroll
    for (int ks = 0; ks < 4; ++ks) qf[ks] = *(const bf16x8*)(Ux + (size_t)t * 512 + h * 128 + ks * 32 + fq * 8);
    f32x4 s[16];
#pragma unroll
    for (int nt = 0; nt < 16; ++nt) { s[nt] = (f32x4){0.f, 0.f, 0.f, 0.f}; const bf16_t* kr = Kb + (size_t)(b * 256 + 16 * nt + fr) * 512 + h * 128 + fq * 8;
#pragma unroll
        for (int ks = 0; ks < 4; ++ks) s[nt] = mfma16(*(const bf16x8*)(kr + ks * 32), qf[ks], s[nt]); }
    float mx = -1e30f;
#pragma unroll
    for (int nt = 0; nt < 16; ++nt)
#pragma unroll
        for (int j = 0; j < 4; ++j) mx = fmaxf(mx, s[nt][j]);
    mx = fmaxf(mx, __shfl_xor(mx, 16)); mx = fmaxf(mx, __shfl_xor(mx, 32));
    const float sc = 0.08838834764831845f * 1.4426950408889634f; float l = 0.f;
#pragma unroll
    for (int nt = 0; nt < 16; ++nt)
#pragma unroll
        for (int j = 0; j < 4; ++j) { const float pz = exp2f((s[nt][j] - mx) * sc); s[nt][j] = pz; l += pz; }
    l += __shfl_xor(l, 16); l += __shfl_xor(l, 32);
    f32x4 o[8];
#pragma unroll
    for (int dt = 0; dt < 8; ++dt) o[dt] = (f32x4){0.f, 0.f, 0.f, 0.f};
#pragma unroll
    for (int c = 0; c < 8; ++c) { union { u32x4 u; bf16x8 v; } pf;
        pf.u.x = cvt_pk_bf16(s[2 * c][0], s[2 * c][1]); pf.u.y = cvt_pk_bf16(s[2 * c][2], s[2 * c][3]); pf.u.z = cvt_pk_bf16(s[2 * c + 1][0], s[2 * c + 1][1]); pf.u.w = cvt_pk_bf16(s[2 * c + 1][2], s[2 * c + 1][3]);
#pragma unroll
        for (int dt = 0; dt < 8; ++dt) { const bf16_t* vr = Vt + ((size_t)b * 512 + h * 128 + 16 * dt + fr) * 256 + 32 * c + 4 * fq; union { u32x4 u; bf16x8 v; } vf;
            const u32x2 lo = *(const u32x2*)vr, hi = *(const u32x2*)(vr + 16); vf.u.x = lo.x; vf.u.y = lo.y; vf.u.z = hi.x; vf.u.w = hi.y;
            o[dt] = mfma16(vf.v, pf.v, o[dt]); } }
    const float il = 1.0f / l;
#pragma unroll
    for (int dt = 0; dt < 8; ++dt) st_bf4(Yx + (size_t)t * 512 + h * 128 + 16 * dt + 4 * fq, o[dt] * il);
}

constexpr int XK_STRIDE = 272, XV_STRIDE = 528, XV_OFF = 256 * XK_STRIDE;
__device__ __forceinline__ void xa_pair(LAS unsigned char* lds, const bf16_t* Ux, const bf16_t* Kb, const bf16_t* Vt, bf16_t* Yx, int pair, int tid) {
    const int bh = pair >> 4, b = bh >> 2, h = bh & 3, blk0 = (pair & 15) * 2; const int lane = tid & 63, wave = tid >> 6, fr = lane & 15, fq = lane >> 4;
    u32x4 kst[8], vst[8];
#pragma unroll
    for (int e = 0; e < 8; ++e) { const int ch = tid + 512 * e; const int key = ch >> 4, part = ch & 15, dr = ch >> 5, pv = ch & 31;
        kst[e] = *(const u32x4*)(Kb + (size_t)(b * 256 + key) * 512 + h * 128 + part * 8); vst[e] = *(const u32x4*)(Vt + ((size_t)b * 512 + h * 128 + dr) * 256 + pv * 8); }
#pragma unroll
    for (int e = 0; e < 8; ++e) { const int ch = tid + 512 * e; const int key = ch >> 4, part = ch & 15, dr = ch >> 5, pv = ch & 31;
        *(LAS u32x4*)(lds + key * XK_STRIDE + part * 16) = kst[e]; *(LAS u32x4*)(lds + XV_OFF + dr * XV_STRIDE + pv * 16) = vst[e]; }
    __syncthreads();
#pragma unroll 1
    for (int tq = 0; tq < 2; ++tq) {
        const int t = b * SEQ + (blk0 + tq) * 128 + 16 * wave + fr;
        bf16x8 qf[4];
#pragma unroll
        for (int ks = 0; ks < 4; ++ks) qf[ks] = *(const bf16x8*)(Ux + (size_t)t * 512 + h * 128 + ks * 32 + fq * 8);
        f32x4 s[16];
#pragma unroll
        for (int nt = 0; nt < 16; ++nt) { s[nt] = (f32x4){0.f, 0.f, 0.f, 0.f}; LAS const unsigned char* kr = lds + (16 * nt + fr) * XK_STRIDE + fq * 16;
#pragma unroll
            for (int ks = 0; ks < 4; ++ks) s[nt] = mfma16(*(LAS const bf16x8*)(kr + ks * 64), qf[ks], s[nt]);
            if (nt & 1) asm volatile("" ::: "memory"); }
        float mx = -1e30f;
#pragma unroll
        for (int nt = 0; nt < 16; ++nt)
#pragma unroll
            for (int j = 0; j < 4; ++j) mx = fmaxf(mx, s[nt][j]);
        mx = fmaxf(mx, __shfl_xor(mx, 16)); mx = fmaxf(mx, __shfl_xor(mx, 32));
        const float sc = 0.08838834764831845f * 1.4426950408889634f; float l = 0.f;
#pragma unroll
        for (int nt = 0; nt < 16; ++nt)
#pragma unroll
            for (int j = 0; j < 4; ++j) { const float pz = exp2f((s[nt][j] - mx) * sc); s[nt][j] = pz; l += pz; }
        l += __shfl_xor(l, 16); l += __shfl_xor(l, 32);
        f32x4 o[8];
#pragma unroll
        for (int dt = 0; dt < 8; ++dt) o[dt] = (f32x4){0.f, 0.f, 0.f, 0.f};
#pragma unroll
        for (int c = 0; c < 8; ++c) { union { u32x4 u; bf16x8 v; } pf;
            pf.u.x = cvt_pk_bf16(s[2 * c][0], s[2 * c][1]); pf.u.y = cvt_pk_bf16(s[2 * c][2], s[2 * c][3]); pf.u.z = cvt_pk_bf16(s[2 * c + 1][0], s[2 * c + 1][1]); pf.u.w = cvt_pk_bf16(s[2 * c + 1][2], s[2 * c + 1][3]);
#pragma unroll
            for (int dt = 0; dt < 8; ++dt) { LAS const unsigned char* vr = lds + XV_OFF + (16 * dt + fr) * XV_STRIDE + (32 * c + 4 * fq) * 2; union { u32x4 u; bf16x8 v; } vf;
                const u32x2 lo = *(LAS const u32x2*)vr, hi = *(LAS const u32x2*)(vr + 32); vf.u.x = lo.x; vf.u.y = lo.y; vf.u.z = hi.x; vf.u.w = hi.y;
                o[dt] = mfma16(vf.v, pf.v, o[dt]); }
            asm volatile("" ::: "memory"); }
        const float il = 1.0f / l;
#pragma unroll
        for (int dt = 0; dt < 8; ++dt) st_bf4(Yx + (size_t)t * 512 + h * 128 + 16 * dt + 4 * fq, o[dt] * il);
    }
    __syncthreads();
}

struct Params { const float* in[33]; float* out; unsigned char* ws; };

__device__ __forceinline__ int opaque0() { int z = 0; asm volatile("" : "+s"(z)); return z; }
typedef __attribute__((address_space(1))) unsigned char* gptr_t;
typedef __attribute__((address_space(1))) const float* gcf_t;
__device__ __forceinline__ int opqv(int v) { asm volatile("" : "+v"(v)); return v; }
__device__ __forceinline__ int opqs(int v) { asm volatile("" : "+s"(v)); return v; }
#define PH_BEGIN const int zi = opaque0(); unsigned char* ws = P.ws + zi; float* const OUT = P.out + zi; (void)OUT; const int tid = opqv((int)threadIdx.x); const int bid = opqs((int)blockIdx.x); const int G = opqs((int)gridDim.x); (void)tid; (void)bid; (void)G; unsigned char* WB = ws + WS_WB; float* SS = (float*)(ws + WS_SS); (void)WB; (void)SS; (void)zi;
#define INP(k) (P.in[(k)] + zi)
#define XB_ ((bf16_t*)(ws + WS_XB))
#define U_ (ws + WS_U)
#define SC_ (ws + WS_SC)
#define Y_ ((bf16_t*)(ws + WS_Y))
#define KB_ ((bf16_t*)(ws + WS_KB))
#define VT_ ((bf16_t*)(ws + WS_VT))

constexpr size_t WS_BAR = WS_MISC + 8192;
__device__ __forceinline__ void grid_bar(unsigned* ctr, unsigned target) {
    asm volatile("s_waitcnt vmcnt(0)" ::: "memory");
    __syncthreads();
    if (threadIdx.x == 0) {
        __builtin_amdgcn_fence(__ATOMIC_RELEASE, "agent");
        asm volatile("s_waitcnt vmcnt(0)" ::: "memory");
        __hip_atomic_fetch_add(ctr, 1u, __ATOMIC_RELAXED, __HIP_MEMORY_SCOPE_AGENT);
        while (__hip_atomic_load(ctr, __ATOMIC_RELAXED, __HIP_MEMORY_SCOPE_AGENT) < target) __builtin_amdgcn_s_sleep(2);
        __builtin_amdgcn_fence(__ATOMIC_ACQUIRE, "agent");
        asm volatile("s_waitcnt vmcnt(0)" ::: "memory");
    }
    __syncthreads();
}

#define XB_TMO      128
#define XB_XCNT(j)  (256  + 64 * (j))
#define XB_XSUB(j)  (1280 + 64 * (j))
#define XB_XGEN(j)  (2304 + 64 * (j))
#define XB_TOP      3328
#define XB_TOPGEN   3392
#define XCD_BAR_WORDS 3456
#define XB_SPIN_CAP (1u << 18)
constexpr size_t WS_XBAR2 = WS_MISC + 32768;
constexpr size_t WS_XBAR = WS_MISC + 16384;
__device__ __forceinline__ unsigned xb_ld(unsigned* p)              { return __hip_atomic_load(p, __ATOMIC_RELAXED, __HIP_MEMORY_SCOPE_AGENT); }
__device__ __forceinline__ unsigned xb_add(unsigned* p, unsigned v) { return __hip_atomic_fetch_add(p, v, __ATOMIC_RELAXED, __HIP_MEMORY_SCOPE_AGENT); }
__device__ __forceinline__ unsigned xb_xcc_id() { return (unsigned)__builtin_amdgcn_s_getreg((3 << 11) | 20) & 0xFu; }
#define XB_SPIN(cond, bar) do { unsigned _sp = 0; while (cond) { __builtin_amdgcn_s_sleep(1); \
    if ((++_sp & 255u) == 0u) { if (xb_ld(&(bar)[XB_TMO])) break; if (_sp > XB_SPIN_CAP) { atomicAdd(&(bar)[XB_TMO], 1u); break; } } } } while (0)
__device__ __forceinline__ void xcd_barrier_complete(unsigned* bar, unsigned x, unsigned& nloc, unsigned& nx, const unsigned G) {
    unsigned sum, cnt, mine, sp = 0u;
    for (;;) {
        sum = 0u; cnt = 0u; mine = 0u;
#pragma unroll
        for (unsigned j = 0; j < 16; ++j) { const unsigned c = xb_ld(&bar[XB_XCNT(j)]); sum += c; cnt += (c > 0u) ? 1u : 0u; mine = (j == x) ? c : mine; }
        if (sum == G) break;
        __builtin_amdgcn_s_sleep(1);
        if ((++sp & 255u) == 0u) { if (xb_ld(&bar[XB_TMO])) break; if (sp > XB_SPIN_CAP) { atomicAdd(&bar[XB_TMO], 1u); break; } }
    }
    nloc = mine > 0u ? mine : 1u; nx = cnt > 0u ? cnt : 1u;
}
__device__ __forceinline__ void xcd_barrier(unsigned* bar, volatile LAS unsigned* st, const unsigned total) {
    asm volatile("s_waitcnt vmcnt(0)" ::: "memory");
    __syncthreads();
    if (threadIdx.x == 0) {
        const unsigned x = xb_xcc_id();
        __builtin_amdgcn_s_waitcnt(0);
        unsigned nloc = st[0], nx = st[1];
        if (nloc == 0u) { xcd_barrier_complete(bar, x, nloc, nx, total); st[0] = nloc; st[1] = nx; }
        const unsigned old = xb_add(&bar[XB_XSUB(x)], 1u);
        const unsigned gen = old / nloc;
        if (old + 1u == (gen + 1u) * nloc) {
            __builtin_amdgcn_fence(__ATOMIC_RELEASE, "agent");
            asm volatile("s_waitcnt vmcnt(0)" ::: "memory");
            const unsigned og = xb_add(&bar[XB_TOP], 1u);
            const unsigned tg = og / nx;
            if (og + 1u == (tg + 1u) * nx) xb_add(&bar[XB_TOPGEN], 1u);
            else XB_SPIN(xb_ld(&bar[XB_TOPGEN]) == tg, bar);
            __builtin_amdgcn_fence(__ATOMIC_ACQUIRE, "agent");
            xb_add(&bar[XB_XGEN(x)], 1u);
            asm volatile("s_waitcnt vmcnt(0)" ::: "memory");
        } else {
            XB_SPIN(xb_ld(&bar[XB_XGEN(x)]) == gen, bar);
            __builtin_amdgcn_fence(__ATOMIC_ACQUIRE, "agent");
            asm volatile("s_waitcnt vmcnt(0)" ::: "memory");
        }
    }
    __syncthreads();
}

__global__ void __launch_bounds__(512) mega(Params P) {
    extern __shared__ __attribute__((aligned(16))) unsigned char lds_raw[];
    LAS unsigned char* lds = (LAS unsigned char*)lds_raw;
    cg::grid_group grid = cg::this_grid();
    volatile LAS unsigned* xst = (volatile LAS unsigned*)(lds + LDS_BYTES - 16);
    if (threadIdx.x == 0) { xst[0] = 0u; xst[1] = 0u; xst[2] = 0u; xst[3] = 0u; (void)xb_add(&((unsigned*)(P.ws + WS_XBAR))[XB_XCNT(xb_xcc_id())], 1u);
        if (blockIdx.x >= 128) (void)xb_add(&((unsigned*)(P.ws + WS_XBAR2))[XB_XCNT(xb_xcc_id())], 1u); }
    __syncthreads();

    unsigned nsub = 0;
    for (int ph = 0; ph < NL * 12 + 1; ++ph) {
        const int l = ph / 12, kph = ph - l * 12;
        if (kph == 7 && ph != NL * 12) continue;
        if (ph == NL * 12) {
#if (PHMASK >> 12) & 1
    { PH_BEGIN
        const int lane = tid & 63, gw = bid * 8 + (tid >> 6), nw = G * 8;
        const float* fn = INP(32); const float* ssf = SS + (size_t)0 * T * 16; float* X = OUT;
        for (int r = gw; r < T; r += nw) { const float rs = row_rstd(ssf, r);
#pragma unroll
            for (int i = 0; i < 4; ++i) { const size_t o = (size_t)r * D + i * 256 + lane * 4; *(f32x4*)(X + o) = *(const f32x4*)(X + o) * rs * *(const f32x4*)(fn + i * 256 + lane * 4); } }
    }
#endif
            break;
        }
        switch (kph) {
        case 0: {
#if (PHMASK >> 0) & 1
        for (int rep = 0; rep < REP0; ++rep) {
        {
            { PH_BEGIN convT_w<1>(INP(3) + (size_t)l * D * 2 * FF, 2 * FF, 0, INP(2) + (size_t)l * D, (bf16_t*)(WB + WB_W1A), D, D, 2 * FF, bid * 8 + (tid >> 6), G * 8, tid & 63, 0); }
            { PH_BEGIN convT_w<0>(INP(4) + (size_t)l * FF * D, D, 0, nullptr, (bf16_t*)(WB + WB_W1B), FF, FF, D, bid * 8 + (tid >> 6), G * 8, tid & 63, 1408); }
            { PH_BEGIN convT_w<2>(INP(7) + (size_t)l * D * 6928, 6928, 0, INP(5) + (size_t)l * D, (bf16_t*)(WB + WB_WIN), D, D, 4096, bid * 8 + (tid >> 6), G * 8, tid & 63, 2112); }
            { PH_BEGIN convT_w<0>(INP(7) + (size_t)l * D * 6928, 6928, 3856, INP(5) + (size_t)l * D, (bf16_t*)(WB + WB_WG), D, D, 3072, bid * 8 + (tid >> 6), G * 8, tid & 63, 3136); }
            for (int j = 0; j < 3; ++j) { PH_BEGIN convT_w<0>(INP(27) + ((size_t)l * 3 + j) * 512 * D, D, 0, nullptr, (bf16_t*)(WB + WB_WBR) + (size_t)j * D * 512, 512, 512, D, bid * 8 + (tid >> 6), G * 8, tid & 63, 3904 + 128 * j); }
            { PH_BEGIN convT_w<0>(INP(28) + (size_t)l * D * D, D, 0, nullptr, (bf16_t*)(WB + WB_WO), D, D, D, bid * 8 + (tid >> 6), G * 8, tid & 63, 4288); }
            { PH_BEGIN convT_w<0>(INP(26) + (size_t)l * D * D, D, 0, INP(6) + (size_t)l * D, (bf16_t*)(WB + WB_WKV), D, D, D, bid * 8 + (tid >> 6), G * 8, tid & 63, 4544); }
            { PH_BEGIN convT_w<1>(INP(30) + (size_t)l * D * 2 * FF, 2 * FF, 0, INP(29) + (size_t)l * D, (bf16_t*)(WB + WB_W2A), D, D, 2 * FF, bid * 8 + (tid >> 6), G * 8, tid & 63, 4800); }
            { PH_BEGIN convT_w<0>(INP(31) + (size_t)l * FF * D, D, 0, nullptr, (bf16_t*)(WB + WB_W2B), FF, FF, D, bid * 8 + (tid >> 6), G * 8, tid & 63, 6208); }
            { PH_BEGIN convT_w<0>(INP(10) + (size_t)l * 64 * 512, 512, 0, nullptr, (bf16_t*)(WB + WB_LW2), 64, 64, 512, bid * 8 + (tid >> 6), G * 8, tid & 63, 6912); }
            { PH_BEGIN convT_w<0>(INP(12) + (size_t)l * 64 * 512, 512, 0, nullptr, (bf16_t*)(WB + WB_LA2), 64, 64, 512, bid * 8 + (tid >> 6), G * 8, tid & 63, 6920); }
            { PH_BEGIN convT_w<0>(INP(13) + (size_t)l * 128 * 512, 512, 0, nullptr, (bf16_t*)(WB + WB_LG2), 128, 128, 512, bid * 8 + (tid >> 6), G * 8, tid & 63, 6928); }
            if (l > 0) {
                { PH_BEGIN convT_w<0>(INP(20) + (size_t)(l - 1) * 512 * 32, 32, 0, nullptr, (bf16_t*)(WB + WB_LV1), 512, 512, 32, bid * 8 + (tid >> 6), G * 8, tid & 63, 6944); }
                { PH_BEGIN convT_w<0>(INP(21) + (size_t)(l - 1) * 32 * 512, 512, 0, nullptr, (bf16_t*)(WB + WB_LV2), 32, 32, 512, bid * 8 + (tid >> 6), G * 8, tid & 63, 6976); }
            }
            if (l == 0) { PH_BEGIN
                const int lane = tid & 63, gw = bid * 8 + (tid >> 6), nw = G * 8;
                float* rstd_mem = (float*)(ws + WS_MISC); bf16_t* MEMN = (bf16_t*)(ws + WS_MEMN);
                for (int r = gw; r < T + 1024; r += nw) {
                    const bool ism = r >= T; const float* src = ism ? INP(1) + (size_t)(r - T) * D : INP(0) + (size_t)r * D; bf16_t* dst = ism ? MEMN + (size_t)(r - T) * D : XB_ + (size_t)r * D; float q = 0.f;
#pragma unroll
                    for (int i = 0; i < 4; ++i) { const f32x4 v = *(const f32x4*)(src + i * 256 + lane * 4); st_bf4(dst + i * 256 + lane * 4, v); q += (v[0] * v[0] + v[1] * v[1]) + (v[2] * v[2] + v[3] * v[3]); }
                    q = wave_sum(q);
                    if (ism) { if (lane == 0) rstd_mem[r - T] = rsqrtf(q * (1.0f / 1024.0f) + 1e-6f); } else if (lane < 16) SS[(size_t)r * 16 + lane] = (lane == 0) ? q : 0.f;
                }
            }
        }
        }
#endif
        } break;
        case 1: {
#if (PHMASK >> 1) & 1
        for (int rep = 0; rep < REPG; ++rep) {
        { PH_BEGIN
            pg8::Gemm g{XB_, (const bf16_t*)(WB + WB_W1A), T, 2 * FF, D, D, D, 0, 0}; pg8::StaticOrder S; S.init(T, 2 * FF, G, bid, 1);
            EpiFFNa E{(bf16_t*)U_, SS + (size_t)0 * T * 16}; pg8::gemm_phase(lds, g, S, E, tid);
        }
        if ((int)blockIdx.x >= (int)gridDim.x - 16) { PH_BEGIN
            pg8::Gemm g2{(const bf16_t*)(ws + WS_MEMN), (const bf16_t*)(WB + WB_WKV), 1024, D, D, D, D, 0, 0}; pg8::StaticOrder S2; S2.init(1024, D, 16, bid - (G - 16), 1);
            EpiKV E2{KB_, VT_, (const float*)(ws + WS_MISC)}; pg8::gemm_phase(lds, g2, S2, E2, tid);
        }
        }
#endif
        } break;
        case 2: {
#if (PHMASK >> 2) & 1
        { PH_BEGIN
            pg8::Gemm g{(const bf16_t*)U_, (const bf16_t*)(WB + WB_W1B), T, D, FF, FF, FF, 0, 0}; pg8::StaticOrder S; S.init(T, D, G, bid, 1);
            EpiRes E{l == 0 ? INP(0) : OUT, OUT, XB_, SS + (size_t)1 * T * 16, 0.5f}; pg8::gemm_phase(lds, g, S, E, tid);
        }
#endif
        } break;
        case 3: {
#if (PHMASK >> 3) & 1
        for (int rep = 0; rep < REPG; ++rep) {
        { PH_BEGIN
            pg8::Gemm g{XB_, (const bf16_t*)(WB + WB_WIN), T, 4096, D, D, D, 0, 0}; pg8::StaticOrder S; S.init(T, 4096, G, bid, 1);
            EpiU E{(bf16_t*)U_, SS + (size_t)1 * T * 16}; pg8::gemm_phase(lds, g, S, E, tid);
        }
        }
#endif
        } break;
        case 4: {
#if (PHMASK >> 4) & 1
        { PH_BEGIN
            PrepArgs PA; PA.U = (const bf16_t*)(U_ + U_RWKV); PA.mu = INP(8) + (size_t)l * 1792; PA.w0 = INP(9) + (size_t)l * 512; PA.a0 = INP(11) + (size_t)l * 512;
            PA.kk_ = INP(14) + (size_t)l * 512; PA.ka = INP(15) + (size_t)l * 512; PA.rk = INP(16) + (size_t)l * 512; PA.v0 = INP(19) + (size_t)(l > 0 ? l - 1 : 0) * 512;
            PA.w2t = (const bf16_t*)(WB + WB_LW2); PA.a2t = (const bf16_t*)(WB + WB_LA2); PA.g2t = (const bf16_t*)(WB + WB_LG2); PA.v1t = (const bf16_t*)(WB + WB_LV1); PA.v2t = (const bf16_t*)(WB + WB_LV2);
            PA.vfirst = (float*)(ws + WS_VF); PA.Wd = (float*)(SC_ + SC_WD); PA.V = (float*)(SC_ + SC_V); PA.RKKB = (bf16_t*)(SC_ + SC_RKKB); PA.Go = (bf16_t*)(ws + WS_GO); PA.Bon = (float*)(ws + WS_BON); PA.layer = l;
            { const int tt = (bid & 7) * 32 + (bid >> 3); rwkv_prep_tile(lds, PA, tt, tid); }
        }
        { PH_BEGIN
            GlaArgs GA; GA.Ug = (const bf16_t*)(U_ + U_GLA); GA.conv = INP(22) + (size_t)l * 4096; GA.aup = INP(23) + (size_t)l * 4096; GA.abias = INP(24) + (size_t)l * 256; GA.gnorm = INP(25) + (size_t)l * 512;
            GA.kvcT = (float*)(ws + WS_KVC); GA.dec = (float*)(ws + WS_DEC); GA.spT = (bf16_t*)(U_ + U_SPT); GA.Yg = Y_ + (size_t)T * 512;
            { const int x = bid & 7, j = bid >> 3, b = x >> 1, nhi = x & 1;
              for (int k = 0; k < 0; ++k) { const int idx = j * 2 + k, h = idx >> 5, n = nhi * 32 + (idx & 31); gla_a_tile(lds, GA, ((b * 4 + h) << 6) | n, tid); } }
        }
#endif
        } break;
        case 5: {
#if (PHMASK >> 5) & 1
        if ((int)blockIdx.x < 128) { PH_BEGIN
            const int xcd = bid & 7, j = bid >> 3, p = xcd * 4 + (j >> 2), rg = j & 3;
            rwkv_scan_unit(lds, (const float*)(SC_ + SC_WD), (const float*)(SC_ + SC_V), (const bf16_t*)(SC_ + SC_RKKB), (float*)(U_ + U_YRAW), p, rg, tid);
        } else {
            { PH_BEGIN
            GlaArgs GA; GA.Ug = (const bf16_t*)(U_ + U_GLA); GA.conv = INP(22) + (size_t)l * 4096; GA.aup = INP(23) + (size_t)l * 4096; GA.abias = INP(24) + (size_t)l * 256; GA.gnorm = INP(25) + (size_t)l * 512;
            GA.kvcT = (float*)(ws + WS_KVC); GA.dec = (float*)(ws + WS_DEC); GA.spT = (bf16_t*)(U_ + U_SPT); GA.Yg = Y_ + (size_t)T * 512;
            { const int x = bid & 7, j = (bid - 128) >> 3, b = x >> 1, nhi = x & 1;
              for (int k = 0; k < 8; ++k) { const int idx = j * 8 + k, h = idx >> 5, n = nhi * 32 + (idx & 31); gla_a_tile(lds, GA, ((b * 4 + h) << 6) | n, tid); } }
            }
            xcd_barrier((unsigned*)(P.ws + WS_XBAR2), xst + 2, 128u);
            { PH_BEGIN
            bf16_t* spT = (bf16_t*)(U_ + U_SPT); const float* DEC = (const float*)(ws + WS_DEC); const float* KVC = (const float*)(ws + WS_KVC);
            for (int i = (bid - 128) * 512 + tid; i < 16 * 128 * 64; i += 128 * 512) { const int bh = i >> 13, ed = i & 8191, d = i & 63; float st = 0.f;
                for (int n0 = 0; n0 < 64; n0 += 16) { float kv[16], dc[16];
#pragma unroll
                    for (int q = 0; q < 16; ++q) { kv[q] = KVC[((size_t)bh * 64 + n0 + q) * 8192 + ed]; dc[q] = DEC[((size_t)bh * 64 + n0 + q) * 64 + d]; }
#pragma unroll
                    for (int q = 0; q < 16; ++q) { spT[((size_t)bh * 64 + n0 + q) * 8192 + ed] = f2bf(st); st = st * dc[q] + kv[q]; } } }
            }
            xcd_barrier((unsigned*)(P.ws + WS_XBAR2), xst + 2, 128u);
            { PH_BEGIN
            GlaArgs GA; GA.Ug = (const bf16_t*)(U_ + U_GLA); GA.conv = INP(22) + (size_t)l * 4096; GA.aup = INP(23) + (size_t)l * 4096; GA.abias = INP(24) + (size_t)l * 256; GA.gnorm = INP(25) + (size_t)l * 512;
            GA.kvcT = (float*)(ws + WS_KVC); GA.dec = (float*)(ws + WS_DEC); GA.spT = (bf16_t*)(U_ + U_SPT); GA.Yg = Y_ + (size_t)T * 512;
            { const int x = bid & 7, j = (bid - 128) >> 3, b = x >> 1, nhi = x & 1;
              for (int k = 0; k < 8; ++k) { const int idx = j * 8 + k, h = idx >> 5, n = nhi * 32 + (idx & 31); gla_c_tile(lds, GA, ((b * 4 + h) << 6) | n, tid); } }
            }
            { PH_BEGIN
              const int x = bid & 7, j = (bid - 128) >> 3;
              for (int k = 0; k < 2; ++k) { const int jj = 2 * j + k, pm = 8 * x + (jj & 7), h = jj >> 3, b = pm >> 4, pq = pm & 15;
                  xa_pair(lds, (const bf16_t*)(U_ + U_XA), KB_, VT_, Y_ + (size_t)2 * T * 512, ((b * 4 + h) << 4) | pq, tid); }
            }
        }
#endif
        } break;
        case 6: {
#if (PHMASK >> 6) & 1
        { PH_BEGIN
            const int lane = tid & 63, gw = bid * 8 + (tid >> 6), nw = G * 8;
            const float* lnw = INP(17) + (size_t)l * 512; const float* lnb = INP(18) + (size_t)l * 512; const float* Yraw = (const float*)(U_ + U_YRAW); const float* Vv = (const float*)(SC_ + SC_V);
            const float* BON = (const float*)(ws + WS_BON); const bf16_t* GO = (const bf16_t*)(ws + WS_GO); bf16_t* Y = Y_;
            const int kq = lane & 15, sub = lane >> 4;
            for (int it0 = gw * 4; it0 < 32 * SEQ; it0 += nw * 16) {
                f32x4 y[4], vv[4], gg[4], lw[4], lb[4]; float bon[4];
#pragma unroll
                for (int q = 0; q < 4; ++q) { const int it = it0 + q * nw * 4 + sub; const int p = it >> 12, s2 = it & (SEQ - 1), b = p >> 3, h = p & 7, t = b * SEQ + s2;
                    y[q] = *(const f32x4*)(Yraw + (size_t)it * 64 + kq * 4); vv[q] = *(const f32x4*)(Vv + (size_t)it * 64 + kq * 4); gg[q] = ld_bf4(GO + (size_t)t * 512 + h * 64 + kq * 4);
                    lw[q] = *(const f32x4*)(lnw + h * 64 + kq * 4); lb[q] = *(const f32x4*)(lnb + h * 64 + kq * 4); bon[q] = BON[(size_t)t * 8 + h]; }
#pragma unroll
                for (int q = 0; q < 4; ++q) { const int it = it0 + q * nw * 4 + sub; const int p = it >> 12, s2 = it & (SEQ - 1), b = p >> 3, h = p & 7, t = b * SEQ + s2;
                    const float mean = row16_sum((y[q][0] + y[q][1]) + (y[q][2] + y[q][3])) * (1.0f / 64.0f); const f32x4 dl = y[q] - mean;
                    const float var = row16_sum((dl[0] * dl[0] + dl[1] * dl[1]) + (dl[2] * dl[2] + dl[3] * dl[3])) * (1.0f / 64.0f); const float rs = rsqrtf(var + 64e-5f);
                    st_bf4(Y + (size_t)t * 512 + h * 64 + kq * 4, ((dl * rs) * lw[q] + lb[q] + vv[q] * bon[q]) * gg[q]); } }
        }
        { PH_BEGIN
            pg8::Gemm g{XB_, (const bf16_t*)(WB + WB_WG), T, 3072, D, D, D, 0, 0}; pg8::StaticOrder S; S.init(T, 3072, G, bid, 1);
            EpiGate E{(unsigned char*)(SC_ + SC_RKKB), SS + (size_t)1 * T * 16}; pg8::gemm_phase(lds, g, S, E, tid);
        }
#endif
        } break;
        case 7: break;
        case 8: {
#if (PHMASK >> 8) & 1
        for (int rep = 0; rep < REPG; ++rep) {
        { PH_BEGIN
            pg8::Gemm g{Y_, (const bf16_t*)(WB + WB_WBR), T, D, 512, 512, 512, (unsigned)T * 512u * 2u, (unsigned)D * 512u * 2u}; pg8::StaticOrder S; S.init(T, D, G, bid, 3);
            EpiMerge E{(const unsigned char*)(SC_ + SC_RKKB), (float*)(U_ + U_MG), (bf16_t*)(U_ + U_MGB)}; pg8::gemm_phase(lds, g, S, E, tid);
        }
        }
#endif
        } break;
        case 9: {
#if (PHMASK >> 9) & 1
        { PH_BEGIN
            pg8::Gemm g{(const bf16_t*)(U_ + U_MGB), (const bf16_t*)(WB + WB_WO), T, D, D, D, D, 0, 0}; pg8::StaticOrder S; S.init(T, D, G, bid, 1);
            EpiRes E{OUT, OUT, XB_, SS + (size_t)2 * T * 16, 1.0f}; pg8::gemm_phase(lds, g, S, E, tid);
        }
#endif
        } break;
        case 10: {
#if (PHMASK >> 10) & 1
        for (int rep = 0; rep < REPG; ++rep) {
        { PH_BEGIN
            pg8::Gemm g{XB_, (const bf16_t*)(WB + WB_W2A), T, 2 * FF, D, D, D, 0, 0}; pg8::StaticOrder S; S.init(T, 2 * FF, G, bid, 1);
            EpiFFNa E{(bf16_t*)U_, SS + (size_t)2 * T * 16}; pg8::gemm_phase(lds, g, S, E, tid);
        }
        }
#endif
        } break;
        case 11: {
#if (PHMASK >> 11) & 1
        { PH_BEGIN
            pg8::Gemm g{(const bf16_t*)U_, (const bf16_t*)(WB + WB_W2B), T, D, FF, FF, FF, 0, 0}; pg8::StaticOrder S; S.init(T, D, G, bid, 1);
            EpiRes E{OUT, OUT, XB_, SS + (size_t)0 * T * 16, 0.5f}; pg8::gemm_phase(lds, g, S, E, tid);
        }
#endif
        } break;
        default: break;
        }
        if (ph == 0) grid.sync();
        else xcd_barrier((unsigned*)(P.ws + WS_XBAR), xst, gridDim.x);
    }
}

extern "C" void kernel_launch(void* const* d_in, const int* in_sizes, int n_in, void* d_out, int out_size, void* d_ws, size_t ws_size, hipStream_t stream) {
    static int grid_blocks = 0;
    if (!grid_blocks) {
        if (n_in != 33 || ws_size < WS_END) { fprintf(stderr, "kernel_launch: need 33 inputs and %zu bytes of workspace (got %d, %zu)\n", (size_t)WS_END, n_in, ws_size); grid_blocks = -1; return; }
        int dev = 0, cus = 0, per_cu = 0;
        hipGetDevice(&dev); hipDeviceGetAttribute(&cus, hipDeviceAttributeMultiprocessorCount, dev);
        if (hipFuncSetAttribute((const void*)mega, hipFuncAttributeMaxDynamicSharedMemorySize, LDS_BYTES) != hipSuccess) { fprintf(stderr, "kernel_launch: hipFuncSetAttribute failed\n"); grid_blocks = -1; return; }
        if (hipOccupancyMaxActiveBlocksPerMultiprocessor(&per_cu, (const void*)mega, 512, LDS_BYTES) != hipSuccess || per_cu < 1) { fprintf(stderr, "kernel_launch: occupancy query says %d\n", per_cu); per_cu = 1; }
        (void)hipGetLastError();
        grid_blocks = cus * per_cu;
        if (grid_blocks != 256) { fprintf(stderr, "kernel_launch: this kernel splits a 256-workgroup grid in its scan phase (got %d)\n", grid_blocks); grid_blocks = -1; return; }
    }
    if (grid_blocks < 0) return;
    if (hipMemsetAsync((char*)d_ws + WS_BAR, 0, (WS_XBAR2 - WS_BAR) + XCD_BAR_WORDS * 4, stream) != hipSuccess) { fprintf(stderr, "kernel_launch: memset failed\n"); return; }
    Params p{};
    for (int i = 0; i < 33; ++i) p.in[i] = (const float*)d_in[i];
    p.out = (float*)d_out; p.ws = (unsigned char*)d_ws;
    void* args[] = {&p};
    hipError_t e = hipLaunchCooperativeKernel((const void*)mega, dim3(grid_blocks), dim3(512), args, LDS_BYTES, stream);
    if (e != hipSuccess) fprintf(stderr, "cooperative launch failed: %s (grid %d)\n", hipGetErrorString(e), grid_blocks);
}
```

```cpp
#include <hip/hip_runtime.h>
#include <hip/hip_cooperative_groups.h>
#include <cstdio>
namespace cg = cooperative_groups;
#ifndef P4SUB
#define P4SUB 7
#endif
#ifndef REP5
#define REP5 1
#endif
#ifndef REP4
#define REP4 1
#endif
#ifndef REP6
#define REP6 1
#endif
#ifndef REP0
#define REP0 1
#endif
#ifndef REPG
#define REPG 1
#endif
#ifndef REPSYNC
#define REPSYNC 1
#endif
#ifndef NA4
#define NA4 2
#endif
#ifndef PHMASK
#define PHMASK 0xFFFF
#endif

#define LAS __attribute__((address_space(3)))
typedef unsigned short bf16_t;
typedef short bf16x8 __attribute__((ext_vector_type(8)));
typedef float f32x4 __attribute__((ext_vector_type(4)));
typedef float f32x2 __attribute__((ext_vector_type(2)));
typedef unsigned u32x4 __attribute__((ext_vector_type(4)));
typedef unsigned u32x2 __attribute__((ext_vector_type(2)));

constexpr int T = 16384, D = 1024, FF = 2816, SEQ = 4096, NL = 4;
constexpr int LDS_BYTES = 139264;

constexpr size_t MB = 1024 * 1024;
constexpr size_t WS_MISC = 0;
constexpr size_t WS_SS = 1 * MB;
constexpr size_t WS_WB = 4 * MB;
constexpr size_t WB_W1A = 0;
constexpr size_t WB_W1B = WB_W1A + (size_t)5632 * 1024 * 2;
constexpr size_t WB_WIN = WB_W1B + (size_t)1024 * 2816 * 2;
constexpr size_t WB_WG = WB_WIN + (size_t)4096 * 1024 * 2;
constexpr size_t WB_WBR = WB_WG + (size_t)3072 * 1024 * 2;
constexpr size_t WB_WO = WB_WBR + (size_t)3 * 1024 * 512 * 2;
constexpr size_t WB_WKV = WB_WO + (size_t)1024 * 1024 * 2;
constexpr size_t WB_W2A = WB_WKV + (size_t)1024 * 1024 * 2;
constexpr size_t WB_W2B = WB_W2A + (size_t)5632 * 1024 * 2;
constexpr size_t WB_LW2 = WB_W2B + (size_t)1024 * 2816 * 2;
constexpr size_t WB_LA2 = WB_LW2 + 512 * 64 * 2;
constexpr size_t WB_LG2 = WB_LA2 + 512 * 64 * 2;
constexpr size_t WB_LV1 = WB_LG2 + 512 * 128 * 2;
constexpr size_t WB_LV2 = WB_LV1 + 32 * 512 * 2;
constexpr size_t WB_END = WB_LV2 + 512 * 32 * 2;
static_assert(WB_END <= 55 * MB, "weights region");
constexpr size_t WS_XB = WS_WB + 55 * MB;
constexpr size_t WS_VF = WS_XB + 32 * MB;
constexpr size_t WS_MEMN = WS_VF + 32 * MB;
constexpr size_t WS_KB = WS_MEMN + 2 * MB;
constexpr size_t WS_VT = WS_KB + 1 * MB;
constexpr size_t WS_GO = WS_VT + 1 * MB;
constexpr size_t WS_BON = WS_GO + 16 * MB;
constexpr size_t WS_Y = WS_BON + 1 * MB;
constexpr size_t WS_KVC = WS_Y + 48 * MB;
constexpr size_t WS_DEC = WS_KVC + 32 * MB;
constexpr size_t WS_SC = WS_DEC + 1 * MB;
constexpr size_t SC_WD = 0;
constexpr size_t SC_V = 32 * MB;
constexpr size_t SC_RKKB = 64 * MB;
constexpr size_t WS_U = WS_SC + 128 * MB;
constexpr size_t U_RWKV = 0;
constexpr size_t U_GLA = (size_t)T * 1792 * 2;
constexpr size_t U_XA = 2 * (size_t)T * 1792 * 2;
constexpr size_t U_YRAW = 0;
constexpr size_t U_SPT = 32 * MB;
constexpr size_t U_MG = 0;
constexpr size_t U_MGB = 64 * MB;
constexpr size_t WS_END = WS_U + 128 * MB;
static_assert(U_XA + (size_t)T * 512 * 2 <= 128 * MB, "U region");

typedef __bf16 bf16x2_t __attribute__((ext_vector_type(2)));
__device__ __forceinline__ unsigned cvt_pk_bf16(float lo, float hi) { const f32x2 v = {lo, hi}; const bf16x2_t r = __builtin_convertvector(v, bf16x2_t); return __builtin_bit_cast(unsigned, r); }
__device__ __forceinline__ bf16_t f2bf(float x) { return (bf16_t)(cvt_pk_bf16(x, 0.f) & 0xffffu); }
__device__ __forceinline__ float bf2f(bf16_t b) { return __uint_as_float(((unsigned)b) << 16); }
__device__ __forceinline__ float bflo(unsigned w) { return __uint_as_float(w << 16); }
__device__ __forceinline__ float bfhi(unsigned w) { return __uint_as_float(w & 0xffff0000u); }
__device__ __forceinline__ f32x4 ld_bf4(const bf16_t* p) { const u32x2 w = *(const u32x2*)p; return (f32x4){bflo(w.x), bfhi(w.x), bflo(w.y), bfhi(w.y)}; }
__device__ __forceinline__ void st_bf4(bf16_t* p, f32x4 v) { u32x2 w; w.x = cvt_pk_bf16(v[0], v[1]); w.y = cvt_pk_bf16(v[2], v[3]); *(u32x2*)p = w; }
__device__ __forceinline__ float sigmoidf_(float x) { return __builtin_amdgcn_rcpf(1.0f + __expf(-x)); }
__device__ __forceinline__ float wave_sum(float v) { for (int o = 32; o >= 1; o >>= 1) v += __shfl_xor(v, o); return v; }
__device__ __forceinline__ f32x4 mfma16(bf16x8 a, bf16x8 b, f32x4 c) { return __builtin_amdgcn_mfma_f32_16x16x32_bf16(a, b, c, 0, 0, 0); }

__device__ __forceinline__ float row_rstd(const float* ssp, int row) {
    const f32x4* p = (const f32x4*)(ssp + (size_t)row * 16); const f32x4 a = p[0], b = p[1], c = p[2], d = p[3];
    const float t = (((a[0] + a[1]) + (a[2] + a[3])) + ((b[0] + b[1]) + (b[2] + b[3]))) + (((c[0] + c[1]) + (c[2] + c[3])) + ((d[0] + d[1]) + (d[2] + d[3])));
    return rsqrtf(t * (1.0f / 1024.0f) + 1e-6f);
}
__device__ __forceinline__ void rstd8(float (&rs)[2][4], const float* ssp, int row0, int fq) {
    f32x4 p[2][4];
#pragma unroll
    for (int ai = 0; ai < 2; ++ai)
#pragma unroll
        for (int m = 0; m < 4; ++m) p[ai][m] = *(const f32x4*)(ssp + (size_t)(row0 + ai * 128 + m * 16) * 16 + fq * 4);
#pragma unroll
    for (int ai = 0; ai < 2; ++ai)
#pragma unroll
        for (int m = 0; m < 4; ++m) { float t = (p[ai][m][0] + p[ai][m][1]) + (p[ai][m][2] + p[ai][m][3]); t += __shfl_xor(t, 16); t += __shfl_xor(t, 32); rs[ai][m] = rsqrtf(t * (1.0f / 1024.0f) + 1e-6f); }
}
namespace pg8 {
constexpr int BM = 256, BK = 64, HALF = 128, HTB = HALF * BK * 2, STAGE_BYTES = 8 * HTB, NXCD = 8, WGM = 8;
__device__ __forceinline__ int lds_byte(int r, int c) { const int st = (r >> 4) * 2 + (c >> 5), rr = r & 15, cc = c & 31, ob = rr * 64 + cc * 2; return st * 1024 + (ob ^ (((ob >> 9) & 1) << 5)); }
__device__ __forceinline__ void stage_rc(int b, int& R, int& C) { const int st = b / 1024, sb = b % 1024, swz = sb ^ (((sb >> 9) & 1) << 5); R = (st >> 1) * 16 + swz / 64; C = (st & 1) * 32 + (swz % 64) / 2; }
__device__ __forceinline__ int perm32(int rho) { const int n = rho >> 4, i = rho & 15; return 8 * (i >> 2) + 4 * n + (i & 3); }

struct Unit { int pm, pn, z; };
struct Gemm { const bf16_t* A; const bf16_t* Bt; int M, N, K, lda, ldb; unsigned zA, zB; };

struct StaticOrder {
    int nM, nN, nwg, G, c, nz;
    __device__ void init(int M, int N, int G_, int c_, int nz_) { nM = M / BM; nN = N / BM; nwg = nM * nN; G = G_; c = c_; nz = nz_; }
    __device__ bool next(int i, Unit& u) const {
        const int ti = i / nz; u.z = i - ti * nz;
        const long L = (long)ti * G + c; if (L >= nwg) return false;
        int wgid = (int)L; { const int q = nwg / NXCD, r = nwg % NXCD, xcd = wgid % NXCD, off = wgid / NXCD; wgid = (xcd < r ? xcd * (q + 1) : r * (q + 1) + (xcd - r) * q) + off; }
        const int nig = WGM * nN, gid = wgid / nig, fm = gid * WGM, gsz = (nM - fm) < WGM ? (nM - fm) : WGM;
        u.pm = fm + ((wgid % nig) % gsz); u.pn = (wgid % nig) / gsz; return true;
    }
};

template <class Epi>
__device__ __forceinline__ void gemm_phase(LAS unsigned char* lds, const Gemm g, const StaticOrder& S, const Epi& E, const int tid) {
    const int wid = __builtin_amdgcn_readfirstlane(tid >> 6), lane = tid & 63, wr = wid >> 2, wc = wid & 3, fr = lane & 15, fq = lane >> 4;
    const int K = g.K, nt = K / BK;
    unsigned voffA[2], voffB[2];
#pragma unroll
    for (int i = 0; i < 2; ++i) { int R, C; stage_rc(tid * 16 + i * 8192, R, C); const int Rb = Epi::PERM ? ((R & ~31) + perm32(R & 31)) : R;
        voffA[i] = (unsigned)(R * g.lda + C) * 2u; voffB[i] = (unsigned)(Rb * g.ldb + C) * 2u; }
    const unsigned kstep = (unsigned)(BK * 2);
    const unsigned hstepA = (unsigned)HALF * g.lda * 2u, hstepB = (unsigned)HALF * g.ldb * 2u;
    const unsigned tstepA = 2u * hstepA, tstepB = 2u * hstepB;
    const unsigned ldsw = (unsigned)wid * 1024u;
    const int aoff = lds_byte(wr * 64 + fr, fq * 8), boff = lds_byte(wc * 32 + fr, fq * 8);
    const char* const gA = (const char*)g.A; const char* const gB = (const char*)g.Bt;
#define PG8_SA(b, h) (((b) * 2 + (h)) * HTB)
#define PG8_SB(b, h) ((4 + (b) * 2 + (h)) * HTB)
#define PG8_STAGE(bufoff, gbase, soff, voff) do { _Pragma("unroll") for (int _i = 0; _i < 2; ++_i) \
        __builtin_amdgcn_global_load_lds((const unsigned*)(((gbase) + (size_t)(unsigned)(soff)) + (voff)[_i]), (LAS unsigned*)(lds + (bufoff) + ldsw + _i * 8192), 16, 0, 0); } while (0)
#define PG8_LDA(dst, b, h) do { _Pragma("unroll") for (int m = 0; m < 4; ++m) _Pragma("unroll") for (int k = 0; k < 2; ++k) dst[m][k] = *(const LAS bf16x8*)(lds + PG8_SA(b, h) + aoff + m * 2048 + k * 1024); } while (0)
#define PG8_LDB(dst, b, h) do { _Pragma("unroll") for (int n = 0; n < 2; ++n) _Pragma("unroll") for (int k = 0; k < 2; ++k) dst[n][k] = *(const LAS bf16x8*)(lds + PG8_SB(b, h) + boff + n * 2048 + k * 1024); } while (0)
#define PG8_MMA(ai, bj, At, Bt) do { __builtin_amdgcn_s_setprio(1); _Pragma("unroll") for (int m = 0; m < 4; ++m) _Pragma("unroll") for (int n = 0; n < 2; ++n) _Pragma("unroll") for (int k = 0; k < 2; ++k) \
        acc[ai][bj][m][n] = __builtin_amdgcn_mfma_f32_16x16x32_bf16(Bt[n][k], At[m][k], acc[ai][bj][m][n], 0, 0, 0); __builtin_amdgcn_s_setprio(0); } while (0)
#define PG8_WAIT_V(n) asm volatile("s_waitcnt vmcnt(" #n ")" ::: "memory")
#define PG8_WAIT_L(n) asm volatile("s_waitcnt lgkmcnt(" #n ")" ::: "memory")
#define PG8_BAR __builtin_amdgcn_s_barrier()
#define PG8_SCHED __builtin_amdgcn_sched_barrier(0)
    Unit cur, nxt; int ui = 0;
    if (!S.next(0, cur)) return;
    f32x4 acc[2][2][4][2];
#pragma unroll
    for (int a = 0; a < 2; ++a)
#pragma unroll
        for (int b = 0; b < 2; ++b)
#pragma unroll
            for (int m = 0; m < 4; ++m)
#pragma unroll
                for (int n = 0; n < 2; ++n) acc[a][b][m][n] = (f32x4){0.f, 0.f, 0.f, 0.f};
    bf16x8 At[4][2], B0[2][2], B1[2][2];
    unsigned cA = (unsigned)cur.z * g.zA + (unsigned)cur.pm * tstepA, cB = (unsigned)cur.z * g.zB + (unsigned)cur.pn * tstepB;
    PG8_STAGE(PG8_SB(0, 0), gB, cB, voffB); PG8_STAGE(PG8_SA(0, 0), gA, cA, voffA); PG8_STAGE(PG8_SB(0, 1), gB, cB + hstepB, voffB); PG8_STAGE(PG8_SA(0, 1), gA, cA + hstepA, voffA);
    if (wr == 1) PG8_BAR;
    PG8_WAIT_V(4); PG8_BAR;
    PG8_STAGE(PG8_SB(1, 0), gB, cB + kstep, voffB); PG8_STAGE(PG8_SA(1, 0), gA, cA + kstep, voffA); PG8_STAGE(PG8_SB(1, 1), gB, cB + hstepB + kstep, voffB);
    PG8_WAIT_V(6); PG8_BAR;
    for (;;) {
        const bool has_next = S.next(ui + 1, nxt);
        const unsigned nA = has_next ? (unsigned)nxt.z * g.zA + (unsigned)nxt.pm * tstepA : cA, nB = has_next ? (unsigned)nxt.z * g.zB + (unsigned)nxt.pn * tstepB : cB;
        for (int t = 0; t < nt; t += 2) {
            const bool last = (t == nt - 2);
            const unsigned a1 = cA + (unsigned)(t + 1) * kstep;
            const unsigned a2 = last ? nA : cA + (unsigned)(t + 2) * kstep, b2 = last ? nB : cB + (unsigned)(t + 2) * kstep;
            const unsigned a3 = a2 + kstep, b3 = b2 + kstep;
            PG8_LDB(B0, 0, 0); PG8_SCHED; PG8_LDA(At, 0, 0); PG8_STAGE(PG8_SA(1, 1), gA, a1 + hstepA, voffA);
            PG8_WAIT_L(8); PG8_BAR; PG8_WAIT_L(0); PG8_MMA(0, 0, At, B0); PG8_BAR; PG8_SCHED;
            PG8_LDB(B1, 0, 1); PG8_STAGE(PG8_SB(0, 0), gB, b2, voffB);
            PG8_BAR; PG8_WAIT_L(0); PG8_MMA(0, 1, At, B1); PG8_BAR;
            PG8_LDA(At, 0, 1); PG8_STAGE(PG8_SA(0, 0), gA, a2, voffA);
            PG8_BAR; PG8_WAIT_L(0); PG8_MMA(1, 0, At, B0); PG8_BAR; PG8_SCHED;
            PG8_STAGE(PG8_SB(0, 1), gB, b2 + hstepB, voffB);
            PG8_WAIT_V(6); PG8_BAR; PG8_MMA(1, 1, At, B1); PG8_BAR;
            PG8_LDB(B0, 1, 0); PG8_SCHED; PG8_LDA(At, 1, 0); PG8_STAGE(PG8_SA(0, 1), gA, a2 + hstepA, voffA);
            PG8_WAIT_L(8); PG8_BAR; PG8_WAIT_L(0); PG8_MMA(0, 0, At, B0); PG8_BAR; PG8_SCHED;
            PG8_LDB(B1, 1, 1); PG8_STAGE(PG8_SB(1, 0), gB, b3, voffB);
            PG8_BAR; PG8_WAIT_L(0); PG8_MMA(0, 1, At, B1); PG8_BAR;
            PG8_LDA(At, 1, 1); PG8_STAGE(PG8_SA(1, 0), gA, a3, voffA);
            PG8_BAR; PG8_WAIT_L(0); PG8_MMA(1, 0, At, B0); PG8_BAR; PG8_SCHED;
            PG8_STAGE(PG8_SB(1, 1), gB, b3 + hstepB, voffB);
            PG8_WAIT_V(6); PG8_BAR; PG8_MMA(1, 1, At, B1); PG8_BAR;
        }
        E(acc, cur, wr, wc, fr, fq);
        if (!has_next) break;
#pragma unroll
        for (int a = 0; a < 2; ++a)
#pragma unroll
            for (int b = 0; b < 2; ++b)
#pragma unroll
                for (int m = 0; m < 4; ++m)
#pragma unroll
                    for (int n = 0; n < 2; ++n) acc[a][b][m][n] = (f32x4){0.f, 0.f, 0.f, 0.f};
        cur = nxt; cA = nA; cB = nB; ++ui;
    }
    PG8_WAIT_V(0);
    if (wr == 0) PG8_BAR;
    PG8_BAR;
#undef PG8_SA
#undef PG8_SB
#undef PG8_STAGE
#undef PG8_LDA
#undef PG8_LDB
#undef PG8_MMA
#undef PG8_WAIT_V
#undef PG8_WAIT_L
#undef PG8_BAR
#undef PG8_SCHED
}
}
using pg8::Unit;
typedef f32x4 Acc[2][2][4][2];

struct EpiFFNa { static constexpr bool PERM = true; bf16_t* H; const float* ss;
    __device__ __forceinline__ void operator()(const Acc& acc, const Unit& u, int wr, int wc, int fr, int fq) const {
        float rs8[2][4]; rstd8(rs8, ss, u.pm * 256 + wr * 64 + fr, fq);
        const int row0 = u.pm * 256 + wr * 64 + fr, hc0 = u.pn * 128 + wc * 32 + 8 * fq;
#pragma unroll
        for (int ai = 0; ai < 2; ++ai)
#pragma unroll
            for (int m = 0; m < 4; ++m) { const int row = row0 + ai * 128 + m * 16; const float rs = rs8[ai][m]; f32x4 h[2];
#pragma unroll
                for (int n = 0; n < 2; ++n) { const f32x4 gt = acc[ai][0][m][n] * rs, up = acc[ai][1][m][n] * rs;
#pragma unroll
                    for (int jj = 0; jj < 4; ++jj) h[n][jj] = gt[jj] * sigmoidf_(gt[jj]) * up[jj]; }
                u32x4 w; w.x = cvt_pk_bf16(h[0][0], h[0][1]); w.y = cvt_pk_bf16(h[0][2], h[0][3]); w.z = cvt_pk_bf16(h[1][0], h[1][1]); w.w = cvt_pk_bf16(h[1][2], h[1][3]);
                *(u32x4*)(H + (size_t)row * FF + hc0) = w; }
    }
};
struct EpiRes { static constexpr bool PERM = true; const float* xin; float* xout; bf16_t* xb; float* ss_out; float scale;
    __device__ __forceinline__ void operator()(const Acc& acc, const Unit& u, int wr, int wc, int fr, int fq) const {
        const int row0 = u.pm * 256 + wr * 64 + fr, col0 = u.pn * 256 + wc * 32 + 8 * fq;
#pragma unroll
        for (int ai = 0; ai < 2; ++ai) {
            f32x4 xv[4][2][2];
#pragma unroll
            for (int m = 0; m < 4; ++m)
#pragma unroll
                for (int bj = 0; bj < 2; ++bj)
#pragma unroll
                    for (int n = 0; n < 2; ++n) xv[m][bj][n] = *(const f32x4*)(xin + (size_t)(row0 + ai * 128 + m * 16) * D + col0 + bj * 128 + n * 4);
#pragma unroll
            for (int m = 0; m < 4; ++m) { const int row = row0 + ai * 128 + m * 16; float q = 0.f;
#pragma unroll
                for (int bj = 0; bj < 2; ++bj) { const size_t o = (size_t)row * D + col0 + bj * 128;
                    const f32x4 v0 = xv[m][bj][0] + acc[ai][bj][m][0] * scale, v1 = xv[m][bj][1] + acc[ai][bj][m][1] * scale;
                    *(f32x4*)(xout + o) = v0; *(f32x4*)(xout + o + 4) = v1;
                    u32x4 w; w.x = cvt_pk_bf16(v0[0], v0[1]); w.y = cvt_pk_bf16(v0[2], v0[3]); w.z = cvt_pk_bf16(v1[0], v1[1]); w.w = cvt_pk_bf16(v1[2], v1[3]); *(u32x4*)(xb + o) = w;
                    q += ((v0[0] * v0[0] + v0[1] * v0[1]) + (v0[2] * v0[2] + v0[3] * v0[3])) + ((v1[0] * v1[0] + v1[1] * v1[1]) + (v1[2] * v1[2] + v1[3] * v1[3])); }
                q += __shfl_xor(q, 16); q += __shfl_xor(q, 32);
                if (fq == 0) ss_out[(size_t)row * 16 + u.pn * 4 + wc] = q; }
        }
    }
};
struct EpiU { static constexpr bool PERM = true; bf16_t* Ubase; const float* ss;
    __device__ __forceinline__ void operator()(const Acc& acc, const Unit& u, int wr, int wc, int fr, int fq) const {
        float rs8[2][4]; rstd8(rs8, ss, u.pm * 256 + wr * 64 + fr, fq);
        bf16_t* base; int ld, c0;
        if (u.pn < 7) { base = (bf16_t*)((char*)Ubase + U_RWKV); ld = 1792; c0 = u.pn * 256; }
        else if (u.pn < 14) { base = (bf16_t*)((char*)Ubase + U_GLA); ld = 1792; c0 = (u.pn - 7) * 256; }
        else { base = (bf16_t*)((char*)Ubase + U_XA); ld = 512; c0 = (u.pn - 14) * 256; }
        const int row0 = u.pm * 256 + wr * 64 + fr; c0 += wc * 32 + 8 * fq;
#pragma unroll
        for (int ai = 0; ai < 2; ++ai)
#pragma unroll
            for (int m = 0; m < 4; ++m) { const int row = row0 + ai * 128 + m * 16; const float rs = rs8[ai][m];
#pragma unroll
                for (int bj = 0; bj < 2; ++bj) { const f32x4 v0 = acc[ai][bj][m][0] * rs, v1 = acc[ai][bj][m][1] * rs; u32x4 w;
                    w.x = cvt_pk_bf16(v0[0], v0[1]); w.y = cvt_pk_bf16(v0[2], v0[3]); w.z = cvt_pk_bf16(v1[0], v1[1]); w.w = cvt_pk_bf16(v1[2], v1[3]);
                    *(u32x4*)(base + (size_t)row * ld + c0 + bj * 128) = w; } }
    }
};
struct EpiGate { static constexpr bool PERM = true; unsigned char* Gt; const float* ss;
    __device__ __forceinline__ void operator()(const Acc& acc, const Unit& u, int wr, int wc, int fr, int fq) const {
        float rs8[2][4]; rstd8(rs8, ss, u.pm * 256 + wr * 64 + fr, fq);
        const int row0 = u.pm * 256 + wr * 64 + fr, c0 = u.pn * 256 + wc * 64 + 16 * fq;
#pragma unroll
        for (int ai = 0; ai < 2; ++ai)
#pragma unroll
            for (int m = 0; m < 4; ++m) { const int row = row0 + ai * 128 + m * 16; const float rs = rs8[ai][m]; unsigned wq[4];
#pragma unroll
                for (int bj = 0; bj < 2; ++bj)
#pragma unroll
                    for (int n = 0; n < 2; ++n) { const f32x4 v = acc[ai][bj][m][n] * rs; unsigned q[4];
#pragma unroll
                        for (int jj = 0; jj < 4; ++jj) q[jj] = (unsigned)(sigmoidf_(v[jj]) * 255.0f + 0.5f);
                        wq[bj * 2 + n] = q[0] | (q[1] << 8) | (q[2] << 16) | (q[3] << 24); }
                *(u32x4*)(Gt + (size_t)row * 3072 + c0) = (u32x4){wq[0], wq[1], wq[2], wq[3]}; }
    }
};
struct EpiMerge { static constexpr bool PERM = true; const unsigned char* Gt; float* Mg; bf16_t* Mb;
    __device__ __forceinline__ void operator()(const Acc& acc, const Unit& u, int wr, int wc, int fr, int fq) const {
        const int row0 = u.pm * 256 + wr * 64 + fr, col0 = u.pn * 256 + wc * 32 + 8 * fq;
#pragma unroll
        for (int ai = 0; ai < 2; ++ai) {
            u32x2 gw[4][2]; u32x4 mb[4][2];
#pragma unroll
            for (int m = 0; m < 4; ++m) { const int row = row0 + ai * 128 + m * 16;
                const u32x4 g4 = *(const u32x4*)(Gt + (size_t)row * 3072 + (u.z * 4 + u.pn) * 256 + wc * 64 + 16 * fq);
                gw[m][0] = (u32x2){g4.x, g4.y}; gw[m][1] = (u32x2){g4.z, g4.w};
#pragma unroll
                for (int bj = 0; bj < 2; ++bj) { const int col = col0 + bj * 128;
                    mb[m][bj] = (u32x4){0u, 0u, 0u, 0u}; if (u.z > 0) mb[m][bj] = *(const u32x4*)(Mb + (size_t)row * D + col); } }
#pragma unroll
            for (int m = 0; m < 4; ++m)
#pragma unroll
                for (int bj = 0; bj < 2; ++bj) { const int row = row0 + ai * 128 + m * 16, col = col0 + bj * 128; const u32x2 g = gw[m][bj]; const u32x4 w = mb[m][bj];
                    const f32x4 g0 = (f32x4){(float)(g.x & 0xffu), (float)((g.x >> 8) & 0xffu), (float)((g.x >> 16) & 0xffu), (float)(g.x >> 24)} * (1.0f / 255.0f);
                    const f32x4 g1 = (f32x4){(float)(g.y & 0xffu), (float)((g.y >> 8) & 0xffu), (float)((g.y >> 16) & 0xffu), (float)(g.y >> 24)} * (1.0f / 255.0f);
                    const f32x4 v0 = acc[ai][bj][m][0] * g0 + (f32x4){bflo(w.x), bfhi(w.x), bflo(w.y), bfhi(w.y)};
                    const f32x4 v1 = acc[ai][bj][m][1] * g1 + (f32x4){bflo(w.z), bfhi(w.z), bflo(w.w), bfhi(w.w)};
                    u32x4 o; o.x = cvt_pk_bf16(v0[0], v0[1]); o.y = cvt_pk_bf16(v0[2], v0[3]); o.z = cvt_pk_bf16(v1[0], v1[1]); o.w = cvt_pk_bf16(v1[2], v1[3]);
                    *(u32x4*)(Mb + (size_t)row * D + col) = o; }
        }
    }
};
struct EpiKV { static constexpr bool PERM = false; bf16_t* Kb; bf16_t* Vt; const float* rstd;
    __device__ __forceinline__ void operator()(const Acc& acc, const Unit& u, int wr, int wc, int fr, int fq) const {
        const int row0 = u.pm * 256 + wr * 64 + fr, col0 = u.pn * 256 + wc * 32 + 4 * fq;
#pragma unroll
        for (int ai = 0; ai < 2; ++ai)
#pragma unroll
            for (int m = 0; m < 4; ++m) { const int row = row0 + ai * 128 + m * 16; const float rs = rstd[row];
#pragma unroll
                for (int bj = 0; bj < 2; ++bj)
#pragma unroll
                    for (int n = 0; n < 2; ++n) { const int col = col0 + bj * 128 + n * 16; const f32x4 v = acc[ai][bj][m][n] * rs;
                        if (col < 512) st_bf4(Kb + (size_t)row * 512 + col, v);
                        else {
#pragma unroll
                            for (int j = 0; j < 4; ++j) Vt[((size_t)(row >> 8) * 512 + (col - 512 + j)) * 256 + (row & 255)] = f2bf(v[j]); } } }
    }
};

template <int MAP> __device__ __forceinline__ int colmap(int n) {
    if (MAP == 1) { const int tl = n >> 8, r = n & 255; return r < 128 ? 128 * tl + r : FF + 128 * tl + (r - 128); }
    if (MAP == 2) { if (n < 3344) return n; if (n < 3584) return -1; return n - 240; }
    return n;
}
template <int MAP>
__device__ __forceinline__ void convT(LAS unsigned char* lds, const float* src, int ld, int coff, const float* g, bf16_t* dst, int K, int Kd, int Nd, int G, int bid, int tid) {
    const int nkt = (K + 63) >> 6, nnt = (Nd + 63) >> 6, ntile = nkt * nnt;
    LAS bf16_t* tile = (LAS bf16_t*)lds;
    for (int t = bid; t < ntile; t += G) {
        const int kt = t % nkt, ntl = t / nkt, k0 = kt * 64, n0 = ntl * 64;
        { const int nl = tid & 63, kl0 = tid >> 6, n = n0 + nl; const int c = (n < Nd) ? colmap<MAP>(n) : -1;
#pragma unroll
          for (int i = 0; i < 8; ++i) { const int kl = kl0 + 8 * i, k = k0 + kl; float v = 0.f;
              if (c >= 0 && k < K) { v = src[(size_t)k * ld + coff + c]; if (g) v *= g[k]; }
              tile[nl * 72 + kl] = f2bf(v); } }
        __syncthreads();
        { const int nl = tid >> 3, kc = (tid & 7) * 8, n = n0 + nl, k = k0 + kc;
          if (n < Nd && k < Kd) *(u32x4*)(dst + (size_t)n * Kd + k) = *(LAS u32x4*)(tile + nl * 72 + kc); }
        __syncthreads();
    }
}

template <int MAP>
__device__ __forceinline__ void convT_w(const float* src, int ld, int coff, const float* g, bf16_t* dst, int K, int Kd, int Nd, int wslot, int nslots, int lane, int tile_base) {
    const int nkt = K >> 4, nnt = (Nd + 255) >> 8, ntile = nkt * nnt;
    for (int t = ((wslot - tile_base) % nslots + nslots) % nslots; t < ntile; t += nslots) {
        const int kt = t % nkt, ntl = t / nkt, k0 = kt * 16, n = ntl * 256 + lane * 4; const int c = (n < Nd) ? colmap<MAP>(n) : -1;
        const float* sp = src + (size_t)k0 * ld + coff + (c >= 0 ? c : 0);
        f32x4 v[16], gv[4];
#pragma unroll
        for (int q = 0; q < 4; ++q) gv[q] = (f32x4){1.f, 1.f, 1.f, 1.f};
        if (g) {
#pragma unroll
            for (int q = 0; q < 4; ++q) gv[q] = *(const f32x4*)(g + k0 + 4 * q); }
#pragma unroll
        for (int kk = 0; kk < 16; ++kk) v[kk] = *(const f32x4*)(sp + (size_t)kk * ld);
        const float cm = (c < 0) ? 0.0f : 1.0f;
#pragma unroll
        for (int kk = 0; kk < 16; ++kk) v[kk] = v[kk] * (gv[kk >> 2][kk & 3] * cm);
        if (n < Nd) {
#pragma unroll
            for (int j = 0; j < 4; ++j) { u32x4 lo, hi;
                lo.x = cvt_pk_bf16(v[0][j], v[1][j]); lo.y = cvt_pk_bf16(v[2][j], v[3][j]); lo.z = cvt_pk_bf16(v[4][j], v[5][j]); lo.w = cvt_pk_bf16(v[6][j], v[7][j]);
                hi.x = cvt_pk_bf16(v[8][j], v[9][j]); hi.y = cvt_pk_bf16(v[10][j], v[11][j]); hi.z = cvt_pk_bf16(v[12][j], v[13][j]); hi.w = cvt_pk_bf16(v[14][j], v[15][j]);
                bf16_t* dp = dst + (size_t)(n + j) * Kd + k0; *(u32x4*)dp = lo; *(u32x4*)(dp + 8) = hi; }
        }
    }
}

template <int K>
__device__ __forceinline__ void wave_gemm(f32x4 (&acc)[4][4], LAS const unsigned char* A, int sA, const bf16_t* Bt, int fr, int fq) {
#pragma unroll
    for (int m = 0; m < 4; ++m)
#pragma unroll
        for (int n = 0; n < 4; ++n) acc[m][n] = (f32x4){0.f, 0.f, 0.f, 0.f};
#pragma unroll
    for (int ks = 0; ks < K / 32; ++ks) { bf16x8 a[4], b[4];
#pragma unroll
        for (int m = 0; m < 4; ++m) a[m] = *(LAS const bf16x8*)(A + (16 * m + fr) * sA + (ks * 32 + fq * 8) * 2);
#pragma unroll
        for (int n = 0; n < 4; ++n) b[n] = *(const bf16x8*)(Bt + (size_t)(16 * n + fr) * K + ks * 32 + fq * 8);
#pragma unroll
        for (int m = 0; m < 4; ++m)
#pragma unroll
            for (int n = 0; n < 4; ++n) acc[m][n] = mfma16(b[n], a[m], acc[m][n]); }
}

template <int K>
__device__ __forceinline__ void row_gemm(f32x4 (&acc)[4], LAS const unsigned char* Arow, const bf16_t* Bt, int fr, int fq) {
    bf16x8 bw[K / 32][4];
#pragma unroll
    for (int ks = 0; ks < K / 32; ++ks)
#pragma unroll
        for (int n = 0; n < 4; ++n) bw[ks][n] = *(const bf16x8*)(Bt + (size_t)(16 * n + fr) * K + ks * 32 + fq * 8);
#pragma unroll
    for (int n = 0; n < 4; ++n) acc[n] = (f32x4){0.f, 0.f, 0.f, 0.f};
#pragma unroll
    for (int ks = 0; ks < K / 32; ++ks) { const bf16x8 a = *(LAS const bf16x8*)(Arow + (ks * 32 + fq * 8) * 2);
#pragma unroll
        for (int n = 0; n < 4; ++n) acc[n] = mfma16(bw[ks][n], a, acc[n]); }
}

struct PrepArgs { const bf16_t* U; const float *mu, *w0, *a0, *kk_, *ka, *rk, *v0; const bf16_t *w2t, *a2t, *g2t, *v1t, *v2t; float* vfirst; float* Wd; float* V; bf16_t* RKKB; bf16_t* Go; float* Bon; int layer; };

__device__ __forceinline__ f32x4 shifted4(const bf16_t* Ut, bool has_prev, int c, const float* mu) {
    const f32x4 u = ld_bf4(Ut + c); f32x4 p = ld_bf4((has_prev ? Ut - 1792 : Ut) + c); const float pm = has_prev ? 1.0f : 0.0f; p = p * pm;
    const f32x4 m = *(const f32x4*)(mu + c); return u + m * (p - u);
}

__device__ __forceinline__ void rwkv_prep_tile(LAS unsigned char* lds, const PrepArgs& P, int tt, int tid) {
    constexpr int SW = 144, SG = 272, SV = 1040, SVV = 80;
    LAS unsigned char* LAw = lds; LAS unsigned char* LAa = lds + 9216; LAS unsigned char* LAg = lds + 18432; LAS unsigned char* LAv = lds + 35840; LAS unsigned char* LAvv = lds + 102400;
    const int t0 = tt * 64; const int s0 = t0 & (SEQ - 1);
    const int lane = tid & 63, wave = __builtin_amdgcn_readfirstlane(tid >> 6), fr = lane & 15, fq = lane >> 4;
    LAS float* PRM = (LAS float*)(lds + 107520);
    { PRM[tid] = P.mu[tid]; PRM[512 + tid] = P.mu[512 + tid]; PRM[1024 + tid] = P.mu[1024 + tid]; PRM[1536 + tid] = P.a0[tid]; PRM[2048 + tid] = P.w0[tid];
      PRM[2560 + tid] = P.kk_[tid]; PRM[3072 + tid] = P.ka[tid]; PRM[3584 + tid] = P.rk[tid]; PRM[4096 + tid] = P.v0[tid]; }
#pragma unroll 2
    for (int e = 0; e < 4; ++e) { const int idx = tid + 512 * e, i = idx >> 5, c = (idx & 31) * 8; const bf16_t* Ut = P.U + (size_t)(t0 + i) * 1792; const bool hp = s0 + i > 0;
        f32x4 x0 = shifted4(Ut, hp, 1536 + c, P.mu), x1 = shifted4(Ut, hp, 1536 + c + 4, P.mu);
        if (c < 64) {
#pragma unroll
            for (int q = 0; q < 4; ++q) { const float ea = __expf(2.f * x0[q]), eb = __expf(2.f * x1[q]); x0[q] = 1.f - 2.f / (ea + 1.f); x1[q] = 1.f - 2.f / (eb + 1.f); } }
        else if (c >= 128) {
#pragma unroll
            for (int q = 0; q < 4; ++q) { x0[q] = sigmoidf_(x0[q]); x1[q] = sigmoidf_(x1[q]); } }
        u32x4 o; o.x = cvt_pk_bf16(x0[0], x0[1]); o.y = cvt_pk_bf16(x0[2], x0[3]); o.z = cvt_pk_bf16(x1[0], x1[1]); o.w = cvt_pk_bf16(x1[2], x1[3]);
        LAS unsigned char* dstp = (c < 64) ? (LAw + i * SW + c * 2) : (c < 128) ? (LAa + i * SW + (c - 64) * 2) : (LAg + i * SG + (c - 128) * 2);
        *(LAS u32x4*)dstp = o; }
    if (P.layer > 0) {
#pragma unroll 2
        for (int e = 0; e < 8; ++e) { const int idx = tid + 512 * e, i = idx >> 6, c = (idx & 63) * 8; const bf16_t* Ut = P.U + (size_t)(t0 + i) * 1792; const bool hp = s0 + i > 0;
            const f32x4 x0 = shifted4(Ut, hp, 1024 + c, P.mu), x1 = shifted4(Ut, hp, 1024 + c + 4, P.mu);
            u32x4 o; o.x = cvt_pk_bf16(x0[0], x0[1]); o.y = cvt_pk_bf16(x0[2], x0[3]); o.z = cvt_pk_bf16(x1[0], x1[1]); o.w = cvt_pk_bf16(x1[2], x1[3]);
            *(LAS u32x4*)(LAv + i * SV + c * 2) = o; }
    }
    __syncthreads();
    if (P.layer > 0) {
        const int mt = wave >> 1, nt = wave & 1; f32x4 acc = (f32x4){0.f, 0.f, 0.f, 0.f};
#pragma unroll 4
        for (int ks = 0; ks < 16; ++ks) { const bf16x8 a = *(LAS const bf16x8*)(LAv + (16 * mt + fr) * SV + (ks * 32 + fq * 8) * 2);
            const bf16x8 b = *(const bf16x8*)(P.v1t + (size_t)(16 * nt + fr) * 512 + ks * 32 + fq * 8); acc = mfma16(b, a, acc); }
        u32x2 w; w.x = cvt_pk_bf16(acc[0], acc[1]); w.y = cvt_pk_bf16(acc[2], acc[3]); *(LAS u32x2*)(LAvv + (16 * mt + fr) * SVV + (16 * nt + 4 * fq) * 2) = w;
    }
    __syncthreads();
    const int h = wave, cb = 64 * h; const int b_ = t0 >> 12, p = b_ * 8 + h;
#pragma unroll 1
    for (int m = 0; m < 4; ++m) {
        const int i = 16 * m + fr; const bf16_t* Ut = P.U + (size_t)(t0 + i) * 1792; const bool hp = (s0 + i) > 0;
        int fq4 = 4 * fq; asm volatile("" : "+v"(fq4));
        u32x2 uk[4], pk[4], ur[4], pr[4], uv[4], pv[4]; f32x4 vf[4];
        { const bf16_t* Up = hp ? Ut - 1792 : Ut; const unsigned pm = hp ? 0xffffffffu : 0u;
#pragma unroll
          for (int n = 0; n < 4; ++n) { const int c = cb + 16 * n + fq4;
              uk[n] = *(const u32x2*)(Ut + 512 + c); ur[n] = *(const u32x2*)(Ut + c); uv[n] = *(const u32x2*)(Ut + 1024 + c);
              pk[n] = *(const u32x2*)(Up + 512 + c); pr[n] = *(const u32x2*)(Up + c); pv[n] = *(const u32x2*)(Up + 1024 + c);
              if (P.layer > 0) vf[n] = *(const f32x4*)(P.vfirst + (size_t)(t0 + i) * 512 + c); }
#pragma unroll
          for (int n = 0; n < 4; ++n) { pk[n].x &= pm; pk[n].y &= pm; pr[n].x &= pm; pr[n].y &= pm; pv[n].x &= pm; pv[n].y &= pm; } }
        f32x4 aa[4], acc[4];
        row_gemm<64>(aa, LAa + i * SW, P.a2t + (size_t)cb * 64, fr, fq);
        row_gemm<64>(acc, LAw + i * SW, P.w2t + (size_t)cb * 64, fr, fq);
#pragma unroll
        for (int n = 0; n < 4; ++n) { const f32x4 a0v = *(LAS const f32x4*)(PRM + 1536 + cb + 16 * n + fq4), w0v = *(LAS const f32x4*)(PRM + 2048 + cb + 16 * n + fq4); f32x4 d;
#pragma unroll
            for (int j = 0; j < 4; ++j) { aa[n][j] = sigmoidf_(aa[n][j] + a0v[j]); d[j] = __expf(-0.6065306597f * sigmoidf_(acc[n][j] + w0v[j])); }
            *(f32x4*)(P.Wd + ((size_t)p * SEQ + s0 + i) * 64 + 16 * n + fq4) = d; }
        row_gemm<128>(acc, LAg + i * SG, P.g2t + (size_t)cb * 128, fr, fq);
#pragma unroll
        for (int n = 0; n < 4; ++n) st_bf4(P.Go + (size_t)(t0 + i) * 512 + cb + 16 * n + fq4, acc[n]);
        if (P.layer > 0) row_gemm<32>(acc, LAvv + i * SVV, P.v2t + (size_t)cb * 32, fr, fq);
        float bon = 0.f, nk = 0.f; f32x4 kv[4], rv[4];
#pragma unroll
        for (int n = 0; n < 4; ++n) { const int c = cb + 16 * n + fq4;
            const f32x4 muv = *(LAS const f32x4*)(PRM + 1024 + c), muk = *(LAS const f32x4*)(PRM + 512 + c), mur = *(LAS const f32x4*)(PRM + c);
            const f32x4 v_u = (f32x4){bflo(uv[n].x), bfhi(uv[n].x), bflo(uv[n].y), bfhi(uv[n].y)}, v_p = (f32x4){bflo(pv[n].x), bfhi(pv[n].x), bflo(pv[n].y), bfhi(pv[n].y)};
            const f32x4 k_u = (f32x4){bflo(uk[n].x), bfhi(uk[n].x), bflo(uk[n].y), bfhi(uk[n].y)}, k_p = (f32x4){bflo(pk[n].x), bfhi(pk[n].x), bflo(pk[n].y), bfhi(pk[n].y)};
            const f32x4 r_u = (f32x4){bflo(ur[n].x), bfhi(ur[n].x), bflo(ur[n].y), bfhi(ur[n].y)}, r_p = (f32x4){bflo(pr[n].x), bfhi(pr[n].x), bflo(pr[n].y), bfhi(pr[n].y)};
            f32x4 v = v_u + muv * (v_p - v_u);
            if (P.layer > 0) { const f32x4 v0v = *(LAS const f32x4*)(PRM + 4096 + c);
#pragma unroll
                for (int j = 0; j < 4; ++j) v[j] = v[j] + (vf[n][j] - v[j]) * sigmoidf_(v0v[j] + acc[n][j]); }
            else *(f32x4*)(P.vfirst + (size_t)(t0 + i) * 512 + c) = v;
            *(f32x4*)(P.V + ((size_t)p * SEQ + s0 + i) * 64 + 16 * n + fq4) = v;
            kv[n] = k_u + muk * (k_p - k_u); rv[n] = r_u + mur * (r_p - r_u);
            const f32x4 kkw = *(LAS const f32x4*)(PRM + 2560 + c);
#pragma unroll
            for (int j = 0; j < 4; ++j) { const float x = kv[n][j] * kkw[j]; nk += x * x; } }
        nk += __shfl_xor(nk, 16); nk += __shfl_xor(nk, 32);
        const float inv = 1.0f / fmaxf(sqrtf(nk), 1e-12f);
        bf16_t* O = P.RKKB + ((size_t)p * SEQ + s0 + i) * 256;
#pragma unroll
        for (int n = 0; n < 4; ++n) { const int c = cb + 16 * n + fq4; const f32x4 kkw = *(LAS const f32x4*)(PRM + 2560 + c), kaw = *(LAS const f32x4*)(PRM + 3072 + c), rkw = *(LAS const f32x4*)(PRM + 3584 + c);
            f32x4 kk, kh, bb;
#pragma unroll
            for (int j = 0; j < 4; ++j) { const float a = aa[n][j]; kk[j] = kv[n][j] * kkw[j] * inv; kh[j] = kv[n][j] * (1.f + (a - 1.f) * kaw[j]); bb[j] = kk[j] * a; bon += rv[n][j] * kh[j] * rkw[j]; }
            const int cc = 16 * n + fq4; st_bf4(O + cc, rv[n]); st_bf4(O + 64 + cc, kh); st_bf4(O + 128 + cc, kk); st_bf4(O + 192 + cc, bb); }
        bon += __shfl_xor(bon, 16); bon += __shfl_xor(bon, 32);
        if (fq == 0) P.Bon[(size_t)(t0 + i) * 8 + h] = bon;
        asm volatile("" ::: "memory");
    }
    __syncthreads();
}

constexpr int SCAN_CH = 32, SCAN_STEP_B = 1344, SCAN_SLOT_B = SCAN_CH * SCAN_STEP_B;
template <int CTRL> __device__ __forceinline__ float dpp_f(float v) { return __int_as_float(__builtin_amdgcn_update_dpp(0, __float_as_int(v), CTRL, 0xf, 0xf, true)); }
__device__ __forceinline__ float row16_sum(float v) { v += dpp_f<0xB1>(v); v += dpp_f<0x4E>(v); v += dpp_f<0x141>(v); v += dpp_f<0x140>(v); return v; }

__device__ __forceinline__ float tr16_sum(const float (&p)[16], int kq) {
    const bool b3 = (kq & 8) != 0, b2 = (kq & 4) != 0, b1 = (kq & 2) != 0, b0 = (kq & 1) != 0;
    float q[8], r[4], u[2];
#pragma unroll
    for (int t = 0; t < 8; ++t) { const float keep = b3 ? p[t + 8] : p[t], send = b3 ? p[t] : p[t + 8]; q[t] = keep + dpp_f<0x140>(send); }
#pragma unroll
    for (int t = 0; t < 4; ++t) { const float keep = b2 ? q[t + 4] : q[t], send = b2 ? q[t] : q[t + 4]; r[t] = keep + dpp_f<0x141>(send); }
#pragma unroll
    for (int t = 0; t < 2; ++t) { const float keep = b1 ? r[t + 2] : r[t], send = b1 ? r[t] : r[t + 2]; u[t] = keep + dpp_f<0x4E>(send); }
    const float keep = b0 ? u[1] : u[0], send = b0 ? u[0] : u[1];
    return keep + dpp_f<0xB1>(send);
}

__device__ __forceinline__ void scan_load_chunk(LAS unsigned char* slot, const float* Wd, const float* V, const bf16_t* RKKB, int p, int rg, int s0, int lt) {
    u32x4 r[7];
    const size_t base = (size_t)p * SEQ + s0;
#pragma unroll
    for (int j = 0; j < 2; ++j) { const int idx = lt + 256 * j, st = idx >> 4, part = idx & 15; r[j] = *(const u32x4*)(Wd + (base + st) * 64 + part * 4); }
#pragma unroll
    for (int j = 2; j < 6; ++j) { const int k = lt + 256 * (j - 2), st = k >> 5, rem = k & 31, q = rem >> 3, part = rem & 7; r[j] = *(const u32x4*)(RKKB + ((base + st) * 4 + q) * 64 + part * 8); }
    if (lt < 128) { const int st = lt >> 2, hf = lt & 3; r[6] = *(const u32x4*)(V + (base + st) * 64 + rg * 16 + hf * 4); }
#pragma unroll
    for (int j = 0; j < 2; ++j) { const int idx = lt + 256 * j, st = idx >> 4, part = idx & 15; *(LAS u32x4*)(slot + st * SCAN_STEP_B + part * 16) = r[j]; }
#pragma unroll
    for (int j = 2; j < 6; ++j) { const int k = lt + 256 * (j - 2), st = k >> 5, rem = k & 31, q = rem >> 3, part = rem & 7; const u32x4 w = r[j];
        const int Q = (q == 0) ? 4 : (q == 1) ? 2 : (q == 2) ? 3 : 1;
        LAS f32x4* d = (LAS f32x4*)(slot + st * SCAN_STEP_B + Q * 256 + part * 32);
        d[0] = (f32x4){bflo(w.x), bfhi(w.x), bflo(w.y), bfhi(w.y)}; d[1] = (f32x4){bflo(w.z), bfhi(w.z), bflo(w.w), bfhi(w.w)}; }
    if (lt < 128) { const int st = lt >> 2, hf = lt & 3; *(LAS u32x4*)(slot + st * SCAN_STEP_B + 1280 + hf * 16) = r[6]; }
}

__device__ __forceinline__ void rwkv_scan_unit(LAS unsigned char* lds, const float* Wd, const float* V, const bf16_t* RKKB, float* Yraw, int p, int rg, int tid) {
    const int lane = tid & 63, wave = __builtin_amdgcn_readfirstlane(tid >> 6);
    constexpr int NCH = SEQ / SCAN_CH;
    scan_load_chunk(lds + (tid >> 8) * SCAN_SLOT_B, Wd, V, RKKB, p, rg, (tid >> 8) * SCAN_CH, tid & 255);
    __syncthreads();
    f32x4 S = (f32x4){0.f, 0.f, 0.f, 0.f};
    const int kq = lane & 15, rl = wave * 4 + (lane >> 4);
    for (int c = 0; c < NCH; ++c) {
        if (wave >= 4) { if (c + 2 < NCH) scan_load_chunk(lds + ((c + 2) % 3) * SCAN_SLOT_B, Wd, V, RKKB, p, rg, (c + 2) * SCAN_CH, tid - 256); }
        else {
            LAS const unsigned char* sl = lds + (c % 3) * SCAN_SLOT_B + kq * 16;
            LAS const unsigned char* vl = lds + (c % 3) * SCAN_SLOT_B + 1280 + rl * 4;
            float* yo = Yraw + ((size_t)p * SEQ + c * SCAN_CH + kq) * 64 + rg * 16 + rl;
            f32x4 w = *(LAS const f32x4*)(sl), b = *(LAS const f32x4*)(sl + 256), k = *(LAS const f32x4*)(sl + 512), kk = *(LAS const f32x4*)(sl + 768), r = *(LAS const f32x4*)(sl + 1024);
            float v = *(LAS const float*)(vl); float yp[16];
#pragma unroll
            for (int st = 0; st < SCAN_CH; ++st) {
                f32x4 wn = w, bn = b, kn = k, kkn = kk, rn = r; float vn = v;
                if (st + 1 < SCAN_CH) { const int o = (st + 1) * SCAN_STEP_B;
                    wn = *(LAS const f32x4*)(sl + o); bn = *(LAS const f32x4*)(sl + o + 256); kn = *(LAS const f32x4*)(sl + o + 512); kkn = *(LAS const f32x4*)(sl + o + 768); rn = *(LAS const f32x4*)(sl + o + 1024);
                    vn = *(LAS const float*)(vl + o); }
                float sa = (S[0] * kk[0] + S[1] * kk[1]) + (S[2] * kk[2] + S[3] * kk[3]);
                const f32x4 kvt = k * v;
                sa = -row16_sum(sa);
                S = S * w + (b * sa + kvt);
                yp[st & 15] = (S[0] * r[0] + S[1] * r[1]) + (S[2] * r[2] + S[3] * r[3]);
                if ((st & 15) == 15) yo[(size_t)(st - 15) * 64] = tr16_sum(yp, kq);
                w = wn; b = bn; k = kn; kk = kkn; r = rn; v = vn;
            }
        }
        __syncthreads();
    }
}

struct GlaArgs { const bf16_t* Ug; const float *conv, *aup, *abias, *gnorm; float* kvcT; float* dec; bf16_t* spT; bf16_t* Yg; };
constexpr int GL_GC = 0;
constexpr int GL_T0 = 16640;
constexpr int GL_VT = GL_T0 + 4 * 9216;
constexpr int GL_AL = GL_VT + 18432;
constexpr int GL_RS = GL_AL + 9216;

__device__ __forceinline__ void gla_conv8(f32x4 (&out)[8], const bf16_t* Ug, const float* conv, int t0, int s0, int i0, int c0) {
    f32x4 w[4];
#pragma unroll
    for (int j = 0; j < 4; ++j) w[j] = *(const f32x4*)(conv + j * 1024 + c0);
    u32x2 raw[8][4];
#pragma unroll
    for (int e = 0; e < 8; ++e)
#pragma unroll
        for (int j = 0; j < 4; ++j) { const int i = i0 + 8 * e, ds = 3 - j; const bool ok = (s0 + i - ds) >= 0; raw[e][j] = *(const u32x2*)(Ug + (size_t)(ok ? t0 + i - ds : t0) * 1792 + c0); }
#pragma unroll
    for (int e = 0; e < 8; ++e) { const int i = i0 + 8 * e; f32x4 a = (f32x4){0.f, 0.f, 0.f, 0.f};
#pragma unroll
        for (int j = 0; j < 4; ++j) { const int ds = 3 - j; const float mk = ((s0 + i - ds) >= 0) ? 1.0f : 0.0f; const u32x2 r = raw[e][j];
            a += (w[j] * mk) * (f32x4){bflo(r.x), bfhi(r.x), bflo(r.y), bfhi(r.y)}; }
#pragma unroll
        for (int q = 0; q < 4; ++q) a[q] = a[q] * sigmoidf_(a[q]);
        out[e] = a; }
}
__device__ __forceinline__ void gla_gcum(LAS unsigned char* lds, const GlaArgs& A, int t0, int h, int tid) {
    LAS float* GC = (LAS float*)(lds + GL_GC);
    { const int d = tid & 63, i0 = tid >> 6; float au[16]; const float ab = A.abias[h * 64 + d];
#pragma unroll
      for (int j = 0; j < 16; ++j) au[j] = A.aup[j * 256 + h * 64 + d];
      u32x4 al0[8], al1[8];
#pragma unroll
      for (int e = 0; e < 8; ++e) { const u32x4* ap = (const u32x4*)(A.Ug + (size_t)(t0 + i0 + 8 * e) * 1792 + 1024); al0[e] = ap[0]; al1[e] = ap[1]; }
#pragma unroll
      for (int e = 0; e < 8; ++e) { const int i = i0 + 8 * e; const u32x4 a0 = al0[e], a1 = al1[e];
          float x = ab;
          x += bflo(a0.x) * au[0] + bfhi(a0.x) * au[1] + bflo(a0.y) * au[2] + bfhi(a0.y) * au[3] + bflo(a0.z) * au[4] + bfhi(a0.z) * au[5] + bflo(a0.w) * au[6] + bfhi(a0.w) * au[7];
          x += bflo(a1.x) * au[8] + bfhi(a1.x) * au[9] + bflo(a1.y) * au[10] + bfhi(a1.y) * au[11] + bflo(a1.z) * au[12] + bfhi(a1.z) * au[13] + bflo(a1.w) * au[14] + bfhi(a1.w) * au[15];
          const float ls = fminf(x, 0.f) - __logf(1.f + __expf(-fabsf(x)));
          GC[i * 65 + d] = ls * (1.0f / 16.0f); } }
    __syncthreads();
    { const int lane = tid & 63, wave = tid >> 6;
#pragma unroll
      for (int dd = 0; dd < 8; ++dd) { const int d = wave * 8 + dd; float x = GC[lane * 65 + d];
#pragma unroll
          for (int o = 1; o < 64; o <<= 1) { const float y = __shfl_up(x, o); if (lane >= o) x += y; }
          GC[lane * 65 + d] = x; } }
    __syncthreads();
}
__device__ __forceinline__ void gla_a_tile(LAS unsigned char* lds, const GlaArgs& A, int tile, int tid) {
    const int bh = tile >> 6, n = tile & 63, b = bh >> 2, h = bh & 3, t0 = b * SEQ + n * 64, s0 = n * 64;
    LAS float* GC = (LAS float*)(lds + GL_GC); LAS bf16_t* KDT = (LAS bf16_t*)(lds + GL_T0); LAS bf16_t* VT = (LAS bf16_t*)(lds + GL_VT);
    gla_gcum(lds, A, t0, h, tid);
    { const int cc = (tid & 63) * 4, i0 = tid >> 6;
      if (cc >= 64) { f32x4 o[8]; const int c0 = (cc < 128) ? 256 + h * 64 + (cc - 64) : 512 + h * 128 + (cc - 128);
          gla_conv8(o, A.Ug, A.conv, t0, s0, i0, c0);
          if (cc < 128) { const int d = cc - 64;
#pragma unroll
              for (int e = 0; e < 8; ++e) { const int i = i0 + 8 * e;
#pragma unroll
                  for (int q = 0; q < 4; ++q) KDT[(d + q) * 72 + i] = f2bf(o[e][q] * __expf(GC[63 * 65 + d + q] - GC[i * 65 + d + q])); } }
          else { const int ev = cc - 128;
#pragma unroll
              for (int e = 0; e < 8; ++e) { const int i = i0 + 8 * e;
#pragma unroll
                  for (int q = 0; q < 4; ++q) VT[(ev + q) * 72 + i] = f2bf(o[e][q]); } } } }
    if (tid < 64) A.dec[((size_t)bh * 64 + n) * 64 + tid] = __expf(GC[63 * 65 + tid]);
    __syncthreads();
    { const int lane = tid & 63, wave = tid >> 6, fr = lane & 15, fq = lane >> 4; f32x4 acc[4];
#pragma unroll
      for (int nt = 0; nt < 4; ++nt) acc[nt] = (f32x4){0.f, 0.f, 0.f, 0.f};
#pragma unroll
      for (int ks = 0; ks < 2; ++ks) { const bf16x8 a = *(LAS const bf16x8*)(VT + (16 * wave + fr) * 72 + ks * 32 + fq * 8);
#pragma unroll
          for (int nt = 0; nt < 4; ++nt) { const bf16x8 bfr = *(LAS const bf16x8*)(KDT + (16 * nt + fr) * 72 + ks * 32 + fq * 8); acc[nt] = mfma16(bfr, a, acc[nt]); } }
#pragma unroll
      for (int nt = 0; nt < 4; ++nt) *(f32x4*)(A.kvcT + (((size_t)bh * 64 + n) * 128 + 16 * wave + fr) * 64 + 16 * nt + 4 * fq) = acc[nt]; }
    __syncthreads();
}
__device__ __forceinline__ void gla_c_tile(LAS unsigned char* lds, const GlaArgs& A, int tile, int tid) {
    const int bh = tile >> 6, n = tile & 63, b = bh >> 2, h = bh & 3, t0 = b * SEQ + n * 64, s0 = n * 64;
    LAS float* GC = (LAS float*)(lds + GL_GC); LAS bf16_t* QG = (LAS bf16_t*)(lds + GL_T0); LAS bf16_t* KG = QG + 64 * 72; LAS bf16_t* QR = KG + 64 * 72; LAS bf16_t* KR = QR + 64 * 72;
    LAS bf16_t* VT = (LAS bf16_t*)(lds + GL_VT); LAS bf16_t* AL = (LAS bf16_t*)(lds + GL_AL); LAS float* RS = (LAS float*)(lds + GL_RS);
    gla_gcum(lds, A, t0, h, tid);
    { const int cc = (tid & 63) * 4, i0 = tid >> 6; f32x4 o[8];
      const int c0 = (cc < 64) ? h * 64 + cc : (cc < 128) ? 256 + h * 64 + (cc - 64) : 512 + h * 128 + (cc - 128);
      gla_conv8(o, A.Ug, A.conv, t0, s0, i0, c0);
      if (cc < 128) { const int d = cc & 63; const bool isq = cc < 64; LAS bf16_t* T1 = isq ? QG : KR; LAS bf16_t* T2 = isq ? QR : KG; const float sc = isq ? 0.125f : 1.0f;
#pragma unroll
          for (int e = 0; e < 8; ++e) { const int i = i0 + 8 * e; f32x4 x1, x2;
#pragma unroll
              for (int q = 0; q < 4; ++q) { const float eg = __expf(GC[i * 65 + d + q]); const float x = o[e][q] * sc; x1[q] = x * eg; x2[q] = x / eg; }
              u32x2 w1, w2; w1.x = cvt_pk_bf16(x1[0], x1[1]); w1.y = cvt_pk_bf16(x1[2], x1[3]); w2.x = cvt_pk_bf16(x2[0], x2[1]); w2.y = cvt_pk_bf16(x2[2], x2[3]);
              *(LAS u32x2*)(T1 + i * 72 + d) = w1; *(LAS u32x2*)(T2 + i * 72 + d) = w2; } }
      else { const int ev = cc - 128;
#pragma unroll
          for (int e = 0; e < 8; ++e) { const int i = i0 + 8 * e;
#pragma unroll
              for (int q = 0; q < 4; ++q) VT[(ev + q) * 72 + i] = f2bf(o[e][q]); } } }
    __syncthreads();
    const int lane = tid & 63, wave = tid >> 6, fr = lane & 15, fq = lane >> 4; const int mt = wave >> 1;
    {
#pragma unroll
        for (int q = 0; q < 2; ++q) { const int nt = (wave & 1) * 2 + q; f32x4 ap = (f32x4){0.f, 0.f, 0.f, 0.f}, af = ap;
#pragma unroll
            for (int ks = 0; ks < 2; ++ks) { const int ko = ks * 32 + fq * 8;
                ap = mfma16(*(LAS const bf16x8*)(KG + (16 * nt + fr) * 72 + ko), *(LAS const bf16x8*)(QG + (16 * mt + fr) * 72 + ko), ap);
                af = mfma16(*(LAS const bf16x8*)(KR + (16 * nt + fr) * 72 + ko), *(LAS const bf16x8*)(QR + (16 * mt + fr) * 72 + ko), af); }
            const int trow = 16 * mt + fr; f32x4 o;
#pragma unroll
            for (int j = 0; j < 4; ++j) { const int scol = 16 * nt + 4 * fq + j; o[j] = (scol <= trow) ? ap[j] : af[j]; }
            u32x2 w; w.x = cvt_pk_bf16(o[0], o[1]); w.y = cvt_pk_bf16(o[2], o[3]); *(LAS u32x2*)(AL + trow * 72 + 16 * nt + 4 * fq) = w; }
    }
    __syncthreads();
    f32x4 acc[4];
#pragma unroll
    for (int q = 0; q < 4; ++q) acc[q] = (f32x4){0.f, 0.f, 0.f, 0.f};
    const bf16_t* sp = A.spT + ((size_t)bh * 64 + n) * 128 * 64;
#pragma unroll
    for (int ks = 0; ks < 2; ++ks) { const int ko = ks * 32 + fq * 8; const bf16x8 a1 = *(LAS const bf16x8*)(AL + (16 * mt + fr) * 72 + ko), a2 = *(LAS const bf16x8*)(QG + (16 * mt + fr) * 72 + ko);
#pragma unroll
        for (int q = 0; q < 4; ++q) { const int nt = (wave & 1) * 4 + q;
            acc[q] = mfma16(*(LAS const bf16x8*)(VT + (16 * nt + fr) * 72 + ko), a1, acc[q]);
            acc[q] = mfma16(*(const bf16x8*)(sp + (size_t)(16 * nt + fr) * 64 + ko), a2, acc[q]); } }
    float ssq = 0.f;
#pragma unroll
    for (int q = 0; q < 4; ++q) ssq += (acc[q][0] * acc[q][0] + acc[q][1] * acc[q][1]) + (acc[q][2] * acc[q][2] + acc[q][3] * acc[q][3]);
    ssq += __shfl_xor(ssq, 16); ssq += __shfl_xor(ssq, 32);
    if (fq == 0) RS[(16 * mt + fr) * 2 + (wave & 1)] = ssq;
    __syncthreads();
    { const int i = 16 * mt + fr; const float rs = rsqrtf((RS[i * 2] + RS[i * 2 + 1]) * (1.0f / 128.0f) + 1e-6f);
#pragma unroll
      for (int q = 0; q < 4; ++q) { const int ecol = h * 128 + ((wave & 1) * 4 + q) * 16 + 4 * fq; const f32x4 nw = *(const f32x4*)(A.gnorm + ecol); const f32x4 go = ld_bf4(A.Ug + (size_t)(t0 + i) * 1792 + 1040 + ecol); f32x4 o;
#pragma unroll
          for (int j = 0; j < 4; ++j) o[j] = acc[q][j] * rs * nw[j] * go[j] * sigmoidf_(go[j]);
          st_bf4(A.Yg + (size_t)(t0 + i) * 512 + ecol, o); } }
    __syncthreads();
}

__device__ __forceinline__ void xa_tile(const bf16_t* Ux, const bf16_t* Kb, const bf16_t* Vt, bf16_t* Yx, int tile, int tid) {
    const int blk = tile & 31, h = (tile >> 5) & 3, b = tile >> 7; const int lane = tid & 63, wave = tid >> 6, fr = lane & 15, fq = lane >> 4;
    const int t = b * SEQ + blk * 128 + 16 * wave + fr;
    bf16x8 qf[4];
#pragma unroll
    for (int ks = 0; ks < 4; ++ks) qf[ks] = *(const bf16x8*)(Ux + (size_t)t * 512 + h * 128 + ks * 32 + fq * 8);
    f32x4 s[16];
#pragma unroll
    for (int nt = 0; nt < 16; ++nt) { s[nt] = (f32x4){0.f, 0.f, 0.f, 0.f}; const bf16_t* kr = Kb + (size_t)(b * 256 + 16 * nt + fr) * 512 + h * 128 + fq * 8;
#pragma unroll
        for (int ks = 0; ks < 4; ++ks) s[nt] = mfma16(*(const bf16x8*)(kr + ks * 32), qf[ks], s[nt]); }
    float mx = -1e30f;
#pragma unroll
    for (int nt = 0; nt < 16; ++nt)
#pragma unroll
        for (int j = 0; j < 4; ++j) mx = fmaxf(mx, s[nt][j]);
    mx = fmaxf(mx, __shfl_xor(mx, 16)); mx = fmaxf(mx, __shfl_xor(mx, 32));
    const float sc = 0.08838834764831845f * 1.4426950408889634f; float l = 0.f;
#pragma unroll
    for (int nt = 0; nt < 16; ++nt)
#pragma unroll
        for (int j = 0; j < 4; ++j) { const float pz = exp2f((s[nt][j] - mx) * sc); s[nt][j] = pz; l += pz; }
    l += __shfl_xor(l, 16); l += __shfl_xor(l, 32);
    f32x4 o[8];
#pragma unroll
    for (int dt = 0; dt < 8; ++dt) o[dt] = (f32x4){0.f, 0.f, 0.f, 0.f};
#pragma unroll
    for (int c = 0; c < 8; ++c) { union { u32x4 u; bf16x8 v; } pf;
        pf.u.x = cvt_pk_bf16(s[2 * c][0], s[2 * c][1]); pf.u.y = cvt_pk_bf16(s[2 * c][2], s[2 * c][3]); pf.u.z = cvt_pk_bf16(s[2 * c + 1][0], s[2 * c + 1][1]); pf.u.w = cvt_pk_bf16(s[2 * c + 1][2], s[2 * c + 1][3]);
#pragma unroll
        for (int dt = 0; dt < 8; ++dt) { const bf16_t* vr = Vt + ((size_t)b * 512 + h * 128 + 16 * dt + fr) * 256 + 32 * c + 4 * fq; union { u32x4 u; bf16x8 v; } vf;
            const u32x2 lo = *(const u32x2*)vr, hi = *(const u32x2*)(vr + 16); vf.u.x = lo.x; vf.u.y = lo.y; vf.u.z = hi.x; vf.u.w = hi.y;
            o[dt] = mfma16(vf.v, pf.v, o[dt]); } }
    const float il = 1.0f / l;
#pragma unroll
    for (int dt = 0; dt < 8; ++dt) st_bf4(Yx + (size_t)t * 512 + h * 128 + 16 * dt + 4 * fq, o[dt] * il);
}

constexpr int XK_STRIDE = 272, XV_STRIDE = 528, XV_OFF = 256 * XK_STRIDE;
__device__ __forceinline__ void xa_pair(LAS unsigned char* lds, const bf16_t* Ux, const bf16_t* Kb, const bf16_t* Vt, bf16_t* Yx, int pair, int tid) {
    const int bh = pair >> 4, b = bh >> 2, h = bh & 3, blk0 = (pair & 15) * 2; const int lane = tid & 63, wave = tid >> 6, fr = lane & 15, fq = lane >> 4;
    u32x4 kst[8], vst[8];
#pragma unroll
    for (int e = 0; e < 8; ++e) { const int ch = tid + 512 * e; const int key = ch >> 4, part = ch & 15, dr = ch >> 5, pv = ch & 31;
        kst[e] = *(const u32x4*)(Kb + (size_t)(b * 256 + key) * 512 + h * 128 + part * 8); vst[e] = *(const u32x4*)(Vt + ((size_t)b * 512 + h * 128 + dr) * 256 + pv * 8); }
#pragma unroll
    for (int e = 0; e < 8; ++e) { const int ch = tid + 512 * e; const int key = ch >> 4, part = ch & 15, dr = ch >> 5, pv = ch & 31;
        *(LAS u32x4*)(lds + key * XK_STRIDE + part * 16) = kst[e]; *(LAS u32x4*)(lds + XV_OFF + dr * XV_STRIDE + pv * 16) = vst[e]; }
    __syncthreads();
#pragma unroll 1
    for (int tq = 0; tq < 2; ++tq) {
        const int t = b * SEQ + (blk0 + tq) * 128 + 16 * wave + fr;
        bf16x8 qf[4];
#pragma unroll
        for (int ks = 0; ks < 4; ++ks) qf[ks] = *(const bf16x8*)(Ux + (size_t)t * 512 + h * 128 + ks * 32 + fq * 8);
        f32x4 s[16];
#pragma unroll
        for (int nt = 0; nt < 16; ++nt) { s[nt] = (f32x4){0.f, 0.f, 0.f, 0.f}; LAS const unsigned char* kr = lds + (16 * nt + fr) * XK_STRIDE + fq * 16;
#pragma unroll
            for (int ks = 0; ks < 4; ++ks) s[nt] = mfma16(*(LAS const bf16x8*)(kr + ks * 64), qf[ks], s[nt]);
            if (nt & 1) asm volatile("" ::: "memory"); }
        float mx = -1e30f;
#pragma unroll
        for (int nt = 0; nt < 16; ++nt)
#pragma unroll
            for (int j = 0; j < 4; ++j) mx = fmaxf(mx, s[nt][j]);
        mx = fmaxf(mx, __shfl_xor(mx, 16)); mx = fmaxf(mx, __shfl_xor(mx, 32));
        const float sc = 0.08838834764831845f * 1.4426950408889634f; float l = 0.f;
#pragma unroll
        for (int nt = 0; nt < 16; ++nt)
#pragma unroll
            for (int j = 0; j < 4; ++j) { const float pz = exp2f((s[nt][j] - mx) * sc); s[nt][j] = pz; l += pz; }
        l += __shfl_xor(l, 16); l += __shfl_xor(l, 32);
        f32x4 o[8];
#pragma unroll
        for (int dt = 0; dt < 8; ++dt) o[dt] = (f32x4){0.f, 0.f, 0.f, 0.f};
#pragma unroll
        for (int c = 0; c < 8; ++c) { union { u32x4 u; bf16x8 v; } pf;
            pf.u.x = cvt_pk_bf16(s[2 * c][0], s[2 * c][1]); pf.u.y = cvt_pk_bf16(s[2 * c][2], s[2 * c][3]); pf.u.z = cvt_pk_bf16(s[2 * c + 1][0], s[2 * c + 1][1]); pf.u.w = cvt_pk_bf16(s[2 * c + 1][2], s[2 * c + 1][3]);
#pragma unroll
            for (int dt = 0; dt < 8; ++dt) { LAS const unsigned char* vr = lds + XV_OFF + (16 * dt + fr) * XV_STRIDE + (32 * c + 4 * fq) * 2; union { u32x4 u; bf16x8 v; } vf;
                const u32x2 lo = *(LAS const u32x2*)vr, hi = *(LAS const u32x2*)(vr + 32); vf.u.x = lo.x; vf.u.y = lo.y; vf.u.z = hi.x; vf.u.w = hi.y;
                o[dt] = mfma16(vf.v, pf.v, o[dt]); }
            asm volatile("" ::: "memory"); }
        const float il = 1.0f / l;
#pragma unroll
        for (int dt = 0; dt < 8; ++dt) st_bf4(Yx + (size_t)t * 512 + h * 128 + 16 * dt + 4 * fq, o[dt] * il);
    }
    __syncthreads();
}

struct Params { const float* in[33]; float* out; unsigned char* ws; };

__device__ __forceinline__ int opaque0() { int z = 0; asm volatile("" : "+s"(z)); return z; }
typedef __attribute__((address_space(1))) unsigned char* gptr_t;
typedef __attribute__((address_space(1))) const float* gcf_t;
__device__ __forceinline__ int opqv(int v) { asm volatile("" : "+v"(v)); return v; }
__device__ __forceinline__ int opqs(int v) { asm volatile("" : "+s"(v)); return v; }
#define PH_BEGIN const int zi = opaque0(); unsigned char* ws = P.ws + zi; float* const OUT = P.out + zi; (void)OUT; const int tid = opqv((int)threadIdx.x); const int bid = opqs((int)blockIdx.x); const int G = opqs((int)gridDim.x); (void)tid; (void)bid; (void)G; unsigned char* WB = ws + WS_WB; float* SS = (float*)(ws + WS_SS); (void)WB; (void)SS; (void)zi;
#define INP(k) (P.in[(k)] + zi)
#define XB_ ((bf16_t*)(ws + WS_XB))
#define U_ (ws + WS_U)
#define SC_ (ws + WS_SC)
#define Y_ ((bf16_t*)(ws + WS_Y))
#define KB_ ((bf16_t*)(ws + WS_KB))
#define VT_ ((bf16_t*)(ws + WS_VT))

constexpr size_t WS_BAR = WS_MISC + 8192;
__device__ __forceinline__ void grid_bar(unsigned* ctr, unsigned target) {
    asm volatile("s_waitcnt vmcnt(0)" ::: "memory");
    __syncthreads();
    if (threadIdx.x == 0) {
        __builtin_amdgcn_fence(__ATOMIC_RELEASE, "agent");
        asm volatile("s_waitcnt vmcnt(0)" ::: "memory");
        __hip_atomic_fetch_add(ctr, 1u, __ATOMIC_RELAXED, __HIP_MEMORY_SCOPE_AGENT);
        while (__hip_atomic_load(ctr, __ATOMIC_RELAXED, __HIP_MEMORY_SCOPE_AGENT) < target) __builtin_amdgcn_s_sleep(2);
        __builtin_amdgcn_fence(__ATOMIC_ACQUIRE, "agent");
        asm volatile("s_waitcnt vmcnt(0)" ::: "memory");
    }
    __syncthreads();
}

#define XB_TMO      128
#define XB_XCNT(j)  (256  + 64 * (j))
#define XB_XSUB(j)  (1280 + 64 * (j))
#define XB_XGEN(j)  (2304 + 64 * (j))
#define XB_TOP      3328
#define XB_TOPGEN   3392
#define XCD_BAR_WORDS 3456
#define XB_SPIN_CAP (1u << 18)
constexpr size_t WS_XBAR2 = WS_MISC + 32768;
constexpr size_t WS_XBAR = WS_MISC + 16384;
__device__ __forceinline__ unsigned xb_ld(unsigned* p)              { return __hip_atomic_load(p, __ATOMIC_RELAXED, __HIP_MEMORY_SCOPE_AGENT); }
__device__ __forceinline__ unsigned xb_add(unsigned* p, unsigned v) { return __hip_atomic_fetch_add(p, v, __ATOMIC_RELAXED, __HIP_MEMORY_SCOPE_AGENT); }
__device__ __forceinline__ unsigned xb_xcc_id() { return (unsigned)__builtin_amdgcn_s_getreg((3 << 11) | 20) & 0xFu; }
#define XB_SPIN(cond, bar) do { unsigned _sp = 0; while (cond) { __builtin_amdgcn_s_sleep(1); \
    if ((++_sp & 255u) == 0u) { if (xb_ld(&(bar)[XB_TMO])) break; if (_sp > XB_SPIN_CAP) { atomicAdd(&(bar)[XB_TMO], 1u); break; } } } } while (0)
__device__ __forceinline__ void xcd_barrier_complete(unsigned* bar, unsigned x, unsigned& nloc, unsigned& nx, const unsigned G) {
    unsigned sum, cnt, mine, sp = 0u;
    for (;;) {
        sum = 0u; cnt = 0u; mine = 0u;
#pragma unroll
        for (unsigned j = 0; j < 16; ++j) { const unsigned c = xb_ld(&bar[XB_XCNT(j)]); sum += c; cnt += (c > 0u) ? 1u : 0u; mine = (j == x) ? c : mine; }
        if (sum == G) break;
        __builtin_amdgcn_s_sleep(1);
        if ((++sp & 255u) == 0u) { if (xb_ld(&bar[XB_TMO])) break; if (sp > XB_SPIN_CAP) { atomicAdd(&bar[XB_TMO], 1u); break; } }
    }
    nloc = mine > 0u ? mine : 1u; nx = cnt > 0u ? cnt : 1u;
}
__device__ __forceinline__ void xcd_barrier(unsigned* bar, volatile LAS unsigned* st, const unsigned total) {
    asm volatile("s_waitcnt vmcnt(0)" ::: "memory");
    __syncthreads();
    if (threadIdx.x == 0) {
        const unsigned x = xb_xcc_id();
        __builtin_amdgcn_s_waitcnt(0);
        unsigned nloc = st[0], nx = st[1];
        if (nloc == 0u) { xcd_barrier_complete(bar, x, nloc, nx, total); st[0] = nloc; st[1] = nx; }
        const unsigned old = xb_add(&bar[XB_XSUB(x)], 1u);
        const unsigned gen = old / nloc;
        if (old + 1u == (gen + 1u) * nloc) {
            __builtin_amdgcn_fence(__ATOMIC_RELEASE, "agent");
            asm volatile("s_waitcnt vmcnt(0)" ::: "memory");
            const unsigned og = xb_add(&bar[XB_TOP], 1u);
            const unsigned tg = og / nx;
            if (og + 1u == (tg + 1u) * nx) xb_add(&bar[XB_TOPGEN], 1u);
            else XB_SPIN(xb_ld(&bar[XB_TOPGEN]) == tg, bar);
            __builtin_amdgcn_fence(__ATOMIC_ACQUIRE, "agent");
            xb_add(&bar[XB_XGEN(x)], 1u);
            asm volatile("s_waitcnt vmcnt(0)" ::: "memory");
        } else {
            XB_SPIN(xb_ld(&bar[XB_XGEN(x)]) == gen, bar);
            __builtin_amdgcn_fence(__ATOMIC_ACQUIRE, "agent");
            asm volatile("s_waitcnt vmcnt(0)" ::: "memory");
        }
    }
    __syncthreads();
}

__global__ void __launch_bounds__(512) mega(Params P) {
    extern __shared__ __attribute__((aligned(16))) unsigned char lds_raw[];
    LAS unsigned char* lds = (LAS unsigned char*)lds_raw;
    cg::grid_group grid = cg::this_grid();
    volatile LAS unsigned* xst = (volatile LAS unsigned*)(lds + LDS_BYTES - 16);
    if (threadIdx.x == 0) { xst[0] = 0u; xst[1] = 0u; xst[2] = 0u; xst[3] = 0u; (void)xb_add(&((unsigned*)(P.ws + WS_XBAR))[XB_XCNT(xb_xcc_id())], 1u);
        if (blockIdx.x >= 128) (void)xb_add(&((unsigned*)(P.ws + WS_XBAR2))[XB_XCNT(xb_xcc_id())], 1u); }
    __syncthreads();

    unsigned nsub = 0;
    for (int ph = 0; ph < NL * 12 + 1; ++ph) {
        const int l = ph / 12, kph = ph - l * 12;
        if (kph == 7 && ph != NL * 12) continue;
        if (ph == NL * 12) {
#if (PHMASK >> 12) & 1
    { PH_BEGIN
        const int lane = tid & 63, gw = bid * 8 + (tid >> 6), nw = G * 8;
        const float* fn = INP(32); const float* ssf = SS + (size_t)0 * T * 16; float* X = OUT;
        for (int r = gw; r < T; r += nw) { const float rs = row_rstd(ssf, r);
#pragma unroll
            for (int i = 0; i < 4; ++i) { const size_t o = (size_t)r * D + i * 256 + lane * 4; *(f32x4*)(X + o) = *(const f32x4*)(X + o) * rs * *(const f32x4*)(fn + i * 256 + lane * 4); } }
    }
#endif
            break;
        }
        switch (kph) {
        case 0: {
#if (PHMASK >> 0) & 1
        for (int rep = 0; rep < REP0; ++rep) {
        {
            { PH_BEGIN convT_w<1>(INP(3) + (size_t)l * D * 2 * FF, 2 * FF, 0, INP(2) + (size_t)l * D, (bf16_t*)(WB + WB_W1A), D, D, 2 * FF, bid * 8 + (tid >> 6), G * 8, tid & 63, 0); }
            { PH_BEGIN convT_w<0>(INP(4) + (size_t)l * FF * D, D, 0, nullptr, (bf16_t*)(WB + WB_W1B), FF, FF, D, bid * 8 + (tid >> 6), G * 8, tid & 63, 1408); }
            { PH_BEGIN convT_w<2>(INP(7) + (size_t)l * D * 6928, 6928, 0, INP(5) + (size_t)l * D, (bf16_t*)(WB + WB_WIN), D, D, 4096, bid * 8 + (tid >> 6), G * 8, tid & 63, 2112); }
            { PH_BEGIN convT_w<0>(INP(7) + (size_t)l * D * 6928, 6928, 3856, INP(5) + (size_t)l * D, (bf16_t*)(WB + WB_WG), D, D, 3072, bid * 8 + (tid >> 6), G * 8, tid & 63, 3136); }
            for (int j = 0; j < 3; ++j) { PH_BEGIN convT_w<0>(INP(27) + ((size_t)l * 3 + j) * 512 * D, D, 0, nullptr, (bf16_t*)(WB + WB_WBR) + (size_t)j * D * 512, 512, 512, D, bid * 8 + (tid >> 6), G * 8, tid & 63, 3904 + 128 * j); }
            { PH_BEGIN convT_w<0>(INP(28) + (size_t)l * D * D, D, 0, nullptr, (bf16_t*)(WB + WB_WO), D, D, D, bid * 8 + (tid >> 6), G * 8, tid & 63, 4288); }
            { PH_BEGIN convT_w<0>(INP(26) + (size_t)l * D * D, D, 0, INP(6) + (size_t)l * D, (bf16_t*)(WB + WB_WKV), D, D, D, bid * 8 + (tid >> 6), G * 8, tid & 63, 4544); }
            { PH_BEGIN convT_w<1>(INP(30) + (size_t)l * D * 2 * FF, 2 * FF, 0, INP(29) + (size_t)l * D, (bf16_t*)(WB + WB_W2A), D, D, 2 * FF, bid * 8 + (tid >> 6), G * 8, tid & 63, 4800); }
            { PH_BEGIN convT_w<0>(INP(31) + (size_t)l * FF * D, D, 0, nullptr, (bf16_t*)(WB + WB_W2B), FF, FF, D, bid * 8 + (tid >> 6), G * 8, tid & 63, 6208); }
            { PH_BEGIN convT_w<0>(INP(10) + (size_t)l * 64 * 512, 512, 0, nullptr, (bf16_t*)(WB + WB_LW2), 64, 64, 512, bid * 8 + (tid >> 6), G * 8, tid & 63, 6912); }
            { PH_BEGIN convT_w<0>(INP(12) + (size_t)l * 64 * 512, 512, 0, nullptr, (bf16_t*)(WB + WB_LA2), 64, 64, 512, bid * 8 + (tid >> 6), G * 8, tid & 63, 6920); }
            { PH_BEGIN convT_w<0>(INP(13) + (size_t)l * 128 * 512, 512, 0, nullptr, (bf16_t*)(WB + WB_LG2), 128, 128, 512, bid * 8 + (tid >> 6), G * 8, tid & 63, 6928); }
            if (l > 0) {
                { PH_BEGIN convT_w<0>(INP(20) + (size_t)(l - 1) * 512 * 32, 32, 0, nullptr, (bf16_t*)(WB + WB_LV1), 512, 512, 32, bid * 8 + (tid >> 6), G * 8, tid & 63, 6944); }
                { PH_BEGIN convT_w<0>(INP(21) + (size_t)(l - 1) * 32 * 512, 512, 0, nullptr, (bf16_t*)(WB + WB_LV2), 32, 32, 512, bid * 8 + (tid >> 6), G * 8, tid & 63, 6976); }
            }
            if (l == 0) { PH_BEGIN
                const int lane = tid & 63, gw = bid * 8 + (tid >> 6), nw = G * 8;
                float* rstd_mem = (float*)(ws + WS_MISC); bf16_t* MEMN = (bf16_t*)(ws + WS_MEMN);
                for (int r = gw; r < T + 1024; r += nw) {
                    const bool ism = r >= T; const float* src = ism ? INP(1) + (size_t)(r - T) * D : INP(0) + (size_t)r * D; bf16_t* dst = ism ? MEMN + (size_t)(r - T) * D : XB_ + (size_t)r * D; float q = 0.f;
#pragma unroll
                    for (int i = 0; i < 4; ++i) { const f32x4 v = *(const f32x4*)(src + i * 256 + lane * 4); st_bf4(dst + i * 256 + lane * 4, v); q += (v[0] * v[0] + v[1] * v[1]) + (v[2] * v[2] + v[3] * v[3]); }
                    q = wave_sum(q);
                    if (ism) { if (lane == 0) rstd_mem[r - T] = rsqrtf(q * (1.0f / 1024.0f) + 1e-6f); } else if (lane < 16) SS[(size_t)r * 16 + lane] = (lane == 0) ? q : 0.f;
                }
            }
        }
        }
#endif
        } break;
        case 1: {
#if (PHMASK >> 1) & 1
        for (int rep = 0; rep < REPG; ++rep) {
        { PH_BEGIN
            pg8::Gemm g{XB_, (const bf16_t*)(WB + WB_W1A), T, 2 * FF, D, D, D, 0, 0}; pg8::StaticOrder S; S.init(T, 2 * FF, G, bid, 1);
            EpiFFNa E{(bf16_t*)U_, SS + (size_t)0 * T * 16}; pg8::gemm_phase(lds, g, S, E, tid);
        }
        if ((int)blockIdx.x >= (int)gridDim.x - 16) { PH_BEGIN
            pg8::Gemm g2{(const bf16_t*)(ws + WS_MEMN), (const bf16_t*)(WB + WB_WKV), 1024, D, D, D, D, 0, 0}; pg8::StaticOrder S2; S2.init(1024, D, 16, bid - (G - 16), 1);
            EpiKV E2{KB_, VT_, (const float*)(ws + WS_MISC)}; pg8::gemm_phase(lds, g2, S2, E2, tid);
        }
        }
#endif
        } break;
        case 2: {
#if (PHMASK >> 2) & 1
        { PH_BEGIN
            pg8::Gemm g{(const bf16_t*)U_, (const bf16_t*)(WB + WB_W1B), T, D, FF, FF, FF, 0, 0}; pg8::StaticOrder S; S.init(T, D, G, bid, 1);
            EpiRes E{l == 0 ? INP(0) : OUT, OUT, XB_, SS + (size_t)1 * T * 16, 0.5f}; pg8::gemm_phase(lds, g, S, E, tid);
        }
#endif
        } break;
        case 3: {
#if (PHMASK >> 3) & 1
        for (int rep = 0; rep < REPG; ++rep) {
        { PH_BEGIN
            pg8::Gemm g{XB_, (const bf16_t*)(WB + WB_WIN), T, 4096, D, D, D, 0, 0}; pg8::StaticOrder S; S.init(T, 4096, G, bid, 1);
            EpiU E{(bf16_t*)U_, SS + (size_t)1 * T * 16}; pg8::gemm_phase(lds, g, S, E, tid);
        }
        }
#endif
        } break;
        case 4: {
#if (PHMASK >> 4) & 1
        { PH_BEGIN
            PrepArgs PA; PA.U = (const bf16_t*)(U_ + U_RWKV); PA.mu = INP(8) + (size_t)l * 1792; PA.w0 = INP(9) + (size_t)l * 512; PA.a0 = INP(11) + (size_t)l * 512;
            PA.kk_ = INP(14) + (size_t)l * 512; PA.ka = INP(15) + (size_t)l * 512; PA.rk = INP(16) + (size_t)l * 512; PA.v0 = INP(19) + (size_t)(l > 0 ? l - 1 : 0) * 512;
            PA.w2t = (const bf16_t*)(WB + WB_LW2); PA.a2t = (const bf16_t*)(WB + WB_LA2); PA.g2t = (const bf16_t*)(WB + WB_LG2); PA.v1t = (const bf16_t*)(WB + WB_LV1); PA.v2t = (const bf16_t*)(WB + WB_LV2);
            PA.vfirst = (float*)(ws + WS_VF); PA.Wd = (float*)(SC_ + SC_WD); PA.V = (float*)(SC_ + SC_V); PA.RKKB = (bf16_t*)(SC_ + SC_RKKB); PA.Go = (bf16_t*)(ws + WS_GO); PA.Bon = (float*)(ws + WS_BON); PA.layer = l;
            { const int tt = (bid & 7) * 32 + (bid >> 3); rwkv_prep_tile(lds, PA, tt, tid); }
        }
        { PH_BEGIN
            GlaArgs GA; GA.Ug = (const bf16_t*)(U_ + U_GLA); GA.conv = INP(22) + (size_t)l * 4096; GA.aup = INP(23) + (size_t)l * 4096; GA.abias = INP(24) + (size_t)l * 256; GA.gnorm = INP(25) + (size_t)l * 512;
            GA.kvcT = (float*)(ws + WS_KVC); GA.dec = (float*)(ws + WS_DEC); GA.spT = (bf16_t*)(U_ + U_SPT); GA.Yg = Y_ + (size_t)T * 512;
            { const int x = bid & 7, j = bid >> 3, b = x >> 1, nhi = x & 1;
              for (int k = 0; k < 0; ++k) { const int idx = j * 2 + k, h = idx >> 5, n = nhi * 32 + (idx & 31); gla_a_tile(lds, GA, ((b * 4 + h) << 6) | n, tid); } }
        }
#endif
        } break;
        case 5: {
#if (PHMASK >> 5) & 1
        if ((int)blockIdx.x < 128) { PH_BEGIN
            const int xcd = bid & 7, j = bid >> 3, p = xcd * 4 + (j >> 2), rg = j & 3;
            rwkv_scan_unit(lds, (const float*)(SC_ + SC_WD), (const float*)(SC_ + SC_V), (const bf16_t*)(SC_ + SC_RKKB), (float*)(U_ + U_YRAW), p, rg, tid);
        } else {
            { PH_BEGIN
            GlaArgs GA; GA.Ug = (const bf16_t*)(U_ + U_GLA); GA.conv = INP(22) + (size_t)l * 4096; GA.aup = INP(23) + (size_t)l * 4096; GA.abias = INP(24) + (size_t)l * 256; GA.gnorm = INP(25) + (size_t)l * 512;
            GA.kvcT = (float*)(ws + WS_KVC); GA.dec = (float*)(ws + WS_DEC); GA.spT = (bf16_t*)(U_ + U_SPT); GA.Yg = Y_ + (size_t)T * 512;
            { const int x = bid & 7, j = (bid - 128) >> 3, b = x >> 1, nhi = x & 1;
              for (int k = 0; k < 8; ++k) { const int idx = j * 8 + k, h = idx >> 5, n = nhi * 32 + (idx & 31); gla_a_tile(lds, GA, ((b * 4 + h) << 6) | n, tid); } }
            }
            xcd_barrier((unsigned*)(P.ws + WS_XBAR2), xst + 2, 128u);
            { PH_BEGIN
            bf16_t* spT = (bf16_t*)(U_ + U_SPT); const float* DEC = (const float*)(ws + WS_DEC); const float* KVC = (const float*)(ws + WS_KVC);
            for (int i = (bid - 128) * 512 + tid; i < 16 * 128 * 64; i += 128 * 512) { const int bh = i >> 13, ed = i & 8191, d = i & 63; float st = 0.f;
                for (int n0 = 0; n0 < 64; n0 += 16) { float kv[16], dc[16];
#pragma unroll
                    for (int q = 0; q < 16; ++q) { kv[q] = KVC[((size_t)bh * 64 + n0 + q) * 8192 + ed]; dc[q] = DEC[((size_t)bh * 64 + n0 + q) * 64 + d]; }
#pragma unroll
                    for (int q = 0; q < 16; ++q) { spT[((size_t)bh * 64 + n0 + q) * 8192 + ed] = f2bf(st); st = st * dc[q] + kv[q]; } } }
            }
            xcd_barrier((unsigned*)(P.ws + WS_XBAR2), xst + 2, 128u);
            { PH_BEGIN
            GlaArgs GA; GA.Ug = (const bf16_t*)(U_ + U_GLA); GA.conv = INP(22) + (size_t)l * 4096; GA.aup = INP(23) + (size_t)l * 4096; GA.abias = INP(24) + (size_t)l * 256; GA.gnorm = INP(25) + (size_t)l * 512;
            GA.kvcT = (float*)(ws + WS_KVC); GA.dec = (float*)(ws + WS_DEC); GA.spT = (bf16_t*)(U_ + U_SPT); GA.Yg = Y_ + (size_t)T * 512;
            { const int x = bid & 7, j = (bid - 128) >> 3, b = x >> 1, nhi = x & 1;
              for (int k = 0; k < 8; ++k) { const int idx = j * 8 + k, h = idx >> 5, n = nhi * 32 + (idx & 31); gla_c_tile(lds, GA, ((b * 4 + h) << 6) | n, tid); } }
            }
            { PH_BEGIN
              const int x = bid & 7, j = (bid - 128) >> 3;
              for (int k = 0; k < 2; ++k) { const int jj = 2 * j + k, pm = 8 * x + (jj & 7), h = jj >> 3, b = pm >> 4, pq = pm & 15;
                  xa_pair(lds, (const bf16_t*)(U_ + U_XA), KB_, VT_, Y_ + (size_t)2 * T * 512, ((b * 4 + h) << 4) | pq, tid); }
            }
        }
#endif
        } break;
        case 6: {
#if (PHMASK >> 6) & 1
        { PH_BEGIN
            const int lane = tid & 63, gw = bid * 8 + (tid >> 6), nw = G * 8;
            const float* lnw = INP(17) + (size_t)l * 512; const float* lnb = INP(18) + (size_t)l * 512; const float* Yraw = (const float*)(U_ + U_YRAW); const float* Vv = (const float*)(SC_ + SC_V);
            const float* BON = (const float*)(ws + WS_BON); const bf16_t* GO = (const bf16_t*)(ws + WS_GO); bf16_t* Y = Y_;
            const int kq = lane & 15, sub = lane >> 4;
            for (int it0 = gw * 4; it0 < 32 * SEQ; it0 += nw * 16) {
                f32x4 y[4], vv[4], gg[4], lw[4], lb[4]; float bon[4];
#pragma unroll
                for (int q = 0; q < 4; ++q) { const int it = it0 + q * nw * 4 + sub; const int p = it >> 12, s2 = it & (SEQ - 1), b = p >> 3, h = p & 7, t = b * SEQ + s2;
                    y[q] = *(const f32x4*)(Yraw + (size_t)it * 64 + kq * 4); vv[q] = *(const f32x4*)(Vv + (size_t)it * 64 + kq * 4); gg[q] = ld_bf4(GO + (size_t)t * 512 + h * 64 + kq * 4);
                    lw[q] = *(const f32x4*)(lnw + h * 64 + kq * 4); lb[q] = *(const f32x4*)(lnb + h * 64 + kq * 4); bon[q] = BON[(size_t)t * 8 + h]; }
#pragma unroll
                for (int q = 0; q < 4; ++q) { const int it = it0 + q * nw * 4 + sub; const int p = it >> 12, s2 = it & (SEQ - 1), b = p >> 3, h = p & 7, t = b * SEQ + s2;
                    const float mean = row16_sum((y[q][0] + y[q][1]) + (y[q][2] + y[q][3])) * (1.0f / 64.0f); const f32x4 dl = y[q] - mean;
                    const float var = row16_sum((dl[0] * dl[0] + dl[1] * dl[1]) + (dl[2] * dl[2] + dl[3] * dl[3])) * (1.0f / 64.0f); const float rs = rsqrtf(var + 64e-5f);
                    st_bf4(Y + (size_t)t * 512 + h * 64 + kq * 4, ((dl * rs) * lw[q] + lb[q] + vv[q] * bon[q]) * gg[q]); } }
        }
        { PH_BEGIN
            pg8::Gemm g{XB_, (const bf16_t*)(WB + WB_WG), T, 3072, D, D, D, 0, 0}; pg8::StaticOrder S; S.init(T, 3072, G, bid, 1);
            EpiGate E{(unsigned char*)(SC_ + SC_RKKB), SS + (size_t)1 * T * 16}; pg8::gemm_phase(lds, g, S, E, tid);
        }
#endif
        } break;
        case 7: break;
        case 8: {
#if (PHMASK >> 8) & 1
        for (int rep = 0; rep < REPG; ++rep) {
        { PH_BEGIN
            pg8::Gemm g{Y_, (const bf16_t*)(WB + WB_WBR), T, D, 512, 512, 512, (unsigned)T * 512u * 2u, (unsigned)D * 512u * 2u}; pg8::StaticOrder S; S.init(T, D, G, bid, 3);
            EpiMerge E{(const unsigned char*)(SC_ + SC_RKKB), (float*)(U_ + U_MG), (bf16_t*)(U_ + U_MGB)}; pg8::gemm_phase(lds, g, S, E, tid);
        }
        }
#endif
        } break;
        case 9: {
#if (PHMASK >> 9) & 1
        { PH_BEGIN
            pg8::Gemm g{(const bf16_t*)(U_ + U_MGB), (const bf16_t*)(WB + WB_WO), T, D, D, D, D, 0, 0}; pg8::StaticOrder S; S.init(T, D, G, bid, 1);
            EpiRes E{OUT, OUT, XB_, SS + (size_t)2 * T * 16, 1.0f}; pg8::gemm_phase(lds, g, S, E, tid);
        }
#endif
        } break;
        case 10: {
#if (PHMASK >> 10) & 1
        for (int rep = 0; rep < REPG; ++rep) {
        { PH_BEGIN
            pg8::Gemm g{XB_, (const bf16_t*)(WB + WB_W2A), T, 2 * FF, D, D, D, 0, 0}; pg8::StaticOrder S; S.init(T, 2 * FF, G, bid, 1);
            EpiFFNa E{(bf16_t*)U_, SS + (size_t)2 * T * 16}; pg8::gemm_phase(lds, g, S, E, tid);
        }
        }
#endif
        } break;
        case 11: {
#if (PHMASK >> 11) & 1
        { PH_BEGIN
            pg8::Gemm g{(const bf16_t*)U_, (const bf16_t*)(WB + WB_W2B), T, D, FF, FF, FF, 0, 0}; pg8::StaticOrder S; S.init(T, D, G, bid, 1);
            EpiRes E{OUT, OUT, XB_, SS + (size_t)0 * T * 16, 0.5f}; pg8::gemm_phase(lds, g, S, E, tid);
        }
#endif
        } break;
        default: break;
        }
        if (ph == 0) grid.sync();
        else xcd_barrier((unsigned*)(P.ws + WS_XBAR), xst, gridDim.x);
    }
}

extern "C" void kernel_launch(void* const* d_in, const int* in_sizes, int n_in, void* d_out, int out_size, void* d_ws, size_t ws_size, hipStream_t stream) {
    static int grid_blocks = 0;
    if (!grid_blocks) {
        if (n_in != 33 || ws_size < WS_END) { fprintf(stderr, "kernel_launch: need 33 inputs and %zu bytes of workspace (got %d, %zu)\n", (size_t)WS_END, n_in, ws_size); grid_blocks = -1; return; }
        int dev = 0, cus = 0, per_cu = 0;
        hipGetDevice(&dev); hipDeviceGetAttribute(&cus, hipDeviceAttributeMultiprocessorCount, dev);
        if (hipFuncSetAttribute((const void*)mega, hipFuncAttributeMaxDynamicSharedMemorySize, LDS_BYTES) != hipSuccess) { fprintf(stderr, "kernel_launch: hipFuncSetAttribute failed\n"); grid_blocks = -1; return; }
        if (hipOccupancyMaxActiveBlocksPerMultiprocessor(&per_cu, (const void*)mega, 512, LDS_BYTES) != hipSuccess || per_cu < 1) { fprintf(stderr, "kernel_launch: occupancy query says %d\n", per_cu); per_cu = 1; }
        (void)hipGetLastError();
        grid_blocks = cus * per_cu;
        if (grid_blocks != 256) { fprintf(stderr, "kernel_launch: this kernel splits a 256-workgroup grid in its scan phase (got %d)\n", grid_blocks); grid_blocks = -1; return; }
    }
    if (grid_blocks < 0) return;
    if (hipMemsetAsync((char*)d_ws + WS_BAR, 0, (WS_XBAR2 - WS_BAR) + XCD_BAR_WORDS * 4, stream) != hipSuccess) { fprintf(stderr, "kernel_launch: memset failed\n"); return; }
    Params p{};
    for (int i = 0; i < 33; ++i) p.in[i] = (const float*)d_in[i];
    p.out = (float*)d_out; p.ws = (unsigned char*)d_ws;
    void* args[] = {&p};
    hipError_t e = hipLaunchCooperativeKernel((const void*)mega, dim3(grid_blocks), dim3(512), args, LDS_BYTES, stream);
    if (e != hipSuccess) fprintf(stderr, "cooperative launch failed: %s (grid %d)\n", hipGetErrorString(e), grid_blocks);
}
```
